# Optimizing an MI355X kernel written in HIP

```python
import math
import jax, jax.numpy as jnp
from jax import lax
import numpy as np

D_MODEL = 2048
BATCH = 4
SEQ = 2048
DEPTH = 4

GDN_HEADS = 8
GDN_HEAD_DIM = 128
GDN_WIDTH = GDN_HEADS * GDN_HEAD_DIM
GDN_CONV = 4
GDN_CHUNK = 64
RWKV_HEAD_DIM = 64
RWKV_HEADS = 16
RWKV_WIDTH = RWKV_HEADS * RWKV_HEAD_DIM
RWKV_DECAY_LORA = 96
RWKV_ICLR_LORA = 96
RWKV_SHIFT_COLS = 3 * RWKV_WIDTH + RWKV_DECAY_LORA + RWKV_ICLR_LORA
RWKV_LN_EPS = 64e-5
S5_GROUP = 16
S5_WIDTH = 1024
S5_GROUPS = S5_WIDTH // S5_GROUP
S5_STATE = 64
N_BRANCH = 3
BRANCH_WIDTH = 1024
NORM_EPS = 1e-6

SPLIT_SIZES = (3 * GDN_WIDTH, GDN_WIDTH, GDN_HEADS, GDN_HEADS,
               RWKV_SHIFT_COLS, RWKV_WIDTH,
               S5_WIDTH, S5_WIDTH,
               N_BRANCH * D_MODEL)
IN_COLS = sum(SPLIT_SIZES)

kernel_name = "hybrid_gdn_rwkv7_s5_gated_merge"


def _split_cols(t, sizes):
    out, start = [], 0
    for s in sizes:
        out.append(t[..., start:start + s])
        start += s
    return out


def rms_norm(x, w, eps=NORM_EPS):
    xf = x.astype(jnp.float32)
    y = xf * lax.rsqrt(jnp.mean(xf * xf, axis=-1, keepdims=True) + eps)
    return (y * w.astype(jnp.float32)).astype(x.dtype)


def l2_normalize(x, eps=1e-6):
    return x * lax.rsqrt(jnp.sum(x * x, axis=-1, keepdims=True) + eps)


def causal_depthwise_conv(x, w):
    k_width, ch = w.shape
    return lax.conv_general_dilated(x, w[:, None, :].astype(x.dtype), window_strides=(1,),
                                    padding=[(k_width - 1, 0)],
                                    dimension_numbers=('NWC', 'WIO', 'NWC'),
                                    feature_group_count=ch)


def _to_chunks(t, n):
    bsz, _, h = t.shape[:3]
    t = t.reshape((bsz, n, GDN_CHUNK, h) + t.shape[3:])
    return t.transpose((1, 0, 3, 2) + tuple(range(4, t.ndim)))


def gated_delta_rule_chunked(q, k, v, beta, g):
    bsz, seq, h, dk = q.shape
    dv = v.shape[-1]
    n = seq // GDN_CHUNK
    q, k, v, beta, g = (_to_chunks(t, n) for t in (q, k, v, beta, g))
    g_cum = jnp.cumsum(g, axis=-1)
    idx = jnp.arange(GDN_CHUNK)
    strict = idx[:, None] > idx[None, :]
    incl = idx[:, None] >= idx[None, :]
    diff = g_cum[..., :, None] - g_cum[..., None, :]
    decay_strict = jnp.exp(jnp.where(strict, diff, -jnp.inf))
    decay_incl = jnp.exp(jnp.where(incl, diff, -jnp.inf))
    k_beta = k * beta[..., None]
    lower = jnp.einsum('nbhcd,nbhsd->nbhcs', k_beta, k) * decay_strict
    eye = jnp.eye(GDN_CHUNK, dtype=q.dtype)
    t_mat = lax.linalg.triangular_solve(eye + lower, jnp.broadcast_to(eye, lower.shape),
                                        left_side=True, lower=True)
    u = jnp.einsum('nbhcs,nbhse->nbhce', t_mat, v * beta[..., None])
    w = jnp.einsum('nbhcs,nbhsd->nbhcd', t_mat, k_beta * jnp.exp(g_cum)[..., None])
    attn = jnp.einsum('nbhcd,nbhsd->nbhcs', q, k) * decay_incl
    q_dec = q * jnp.exp(g_cum)[..., None]
    g_last = g_cum[..., -1]
    k_dec = k * jnp.exp(g_last[..., None] - g_cum)[..., None]

    def step(state, xs):
        q_i, k_i, u_i, w_i, a_i, gl_i = xs
        v_new = u_i - jnp.einsum('bhcd,bhde->bhce', w_i, state)
        o_i = (jnp.einsum('bhcd,bhde->bhce', q_i, state)
               + jnp.einsum('bhcs,bhse->bhce', a_i, v_new))
        state = state * jnp.exp(gl_i)[..., None, None] + jnp.einsum('bhcd,bhce->bhde', k_i, v_new)
        return state, o_i

    s0 = jnp.zeros((bsz, h, dk, dv), jnp.float32)
    _, o = lax.scan(step, s0, (q_dec, k_dec, u, w, attn, g_last))
    return o.transpose(1, 0, 3, 2, 4).reshape(bsz, seq, h, dv)


def gdn_branch(qkv, z, b_logit, a_logit, conv_w, a_log, dt_bias, norm_w):
    bsz, seq, _ = qkv.shape
    qkv = jax.nn.silu(causal_depthwise_conv(qkv, conv_w)).astype(jnp.float32)
    q, k, v = jnp.split(qkv, 3, axis=-1)
    hs = (bsz, seq, GDN_HEADS, GDN_HEAD_DIM)
    q = l2_normalize(q.reshape(hs)) * (GDN_HEAD_DIM ** -0.5)
    k = l2_normalize(k.reshape(hs))
    v = v.reshape(hs)
    beta = jax.nn.sigmoid(b_logit.astype(jnp.float32))
    g = -jnp.exp(a_log.astype(jnp.float32)) * jax.nn.softplus(
        a_logit.astype(jnp.float32) + dt_bias.astype(jnp.float32))
    o = gated_delta_rule_chunked(q, k, v, beta, g)
    o = rms_norm(o, norm_w) * jax.nn.silu(z.astype(jnp.float32).reshape(hs))
    return o.reshape(bsz, seq, GDN_WIDTH)


def rwkv7_scan(r, w, k, v, kk, a):
    bsz, seq, h, n = r.shape

    def step(state, xs):
        r_t, w_t, k_t, v_t, kk_t, a_t = xs
        sa = jnp.einsum('bhvk,bhk->bhv', state, -kk_t)
        state = (state * w_t[:, :, None, :] + sa[..., None] * (kk_t * a_t)[:, :, None, :]
                 + v_t[..., None] * k_t[:, :, None, :])
        return state, jnp.einsum('bhvk,bhk->bhv', state, r_t)

    xs = tuple(t.transpose(1, 0, 2, 3) for t in (r, w, k, v, kk, a))
    s0 = jnp.zeros((bsz, h, n, n), jnp.float32)
    _, y = lax.scan(step, s0, xs)
    return y.transpose(1, 0, 2, 3)


def rwkv7_branch(feat, z, mu, w0, w_up, a0, a_up, k_k, k_a, r_k, lnx_w, lnx_b):
    bsz, seq, _ = feat.shape
    f32 = jnp.float32
    feat = feat.astype(f32)
    prev = jnp.pad(feat[:, :-1], ((0, 0), (1, 0), (0, 0)))
    feat = feat + (prev - feat) * mu.astype(f32)
    r, k, v, wl, al = _split_cols(feat, (RWKV_WIDTH,) * 3 + (RWKV_DECAY_LORA, RWKV_ICLR_LORA))
    w_pre = w0.astype(f32) + jnp.tanh(wl) @ w_up.astype(f32)
    decay = jnp.exp(-jnp.exp(-jax.nn.softplus(-w_pre) - 0.5))
    a = jax.nn.sigmoid(a0.astype(f32) + al @ a_up.astype(f32))
    hs = (bsz, seq, RWKV_HEADS, RWKV_HEAD_DIM)
    kk = l2_normalize((k * k_k.astype(f32)).reshape(hs))
    k = k * (1.0 + (a - 1.0) * k_a.astype(f32))
    r, k, v, a, decay = (t.reshape(hs) for t in (r, k, v, a, decay))
    y = rwkv7_scan(r, decay, k, v, kk, a)
    mean = jnp.mean(y, axis=-1, keepdims=True)
    var = jnp.mean(jnp.square(y - mean), axis=-1, keepdims=True)
    y = ((y - mean) * lax.rsqrt(var + RWKV_LN_EPS) * lnx_w.astype(f32).reshape(RWKV_HEADS, RWKV_HEAD_DIM)
         + lnx_b.astype(f32).reshape(RWKV_HEADS, RWKV_HEAD_DIM))
    y = y + jnp.sum(r * k * r_k.astype(f32), axis=-1, keepdims=True) * v
    y = y * jax.nn.silu(z.astype(f32).reshape(hs))
    return y.reshape(bsz, seq, RWKV_WIDTH)


def s5_branch(u, z, a_re, a_im, log_dt, b_re, b_im, c_re, c_im, d_skip, glu_w, glu_b):
    bsz, seq, _ = u.shape
    f32 = jnp.float32
    u = u.astype(f32)
    ug = u.reshape(bsz, seq, S5_GROUPS, S5_GROUP)
    a_re, a_im, b_re, b_im, c_re, c_im = (t.astype(f32) for t in (a_re, a_im, b_re, b_im, c_re, c_im))
    dt = jnp.exp(log_dt.astype(f32))[:, None]
    mag = jnp.exp(a_re * dt)
    ab_re, ab_im = mag * jnp.cos(a_im * dt), mag * jnp.sin(a_im * dt)
    den = a_re * a_re + a_im * a_im
    coef_re = ((ab_re - 1.0) * a_re + ab_im * a_im) / den
    coef_im = (ab_im * a_re - (ab_re - 1.0) * a_im) / den
    bb_re = coef_re[..., None] * b_re - coef_im[..., None] * b_im
    bb_im = coef_re[..., None] * b_im + coef_im[..., None] * b_re
    bu_re = jnp.einsum('gpc,blgc->blgp', bb_re, ug)
    bu_im = jnp.einsum('gpc,blgc->blgp', bb_im, ug)
    shp = (1, seq, S5_GROUPS, S5_STATE)
    a_re_t = jnp.broadcast_to(ab_re, shp)
    a_im_t = jnp.broadcast_to(ab_im, shp)

    def combine(e1, e2):
        a1r, a1i, b1r, b1i = e1
        a2r, a2i, b2r, b2i = e2
        return (a1r * a2r - a1i * a2i, a1r * a2i + a1i * a2r,
                a2r * b1r - a2i * b1i + b2r, a2r * b1i + a2i * b1r + b2i)

    _, _, s_re, s_im = lax.associative_scan(combine, (a_re_t, a_im_t, bu_re, bu_im), axis=1)
    y = jnp.einsum('gcp,blgp->blgc', c_re, s_re) - jnp.einsum('gcp,blgp->blgc', c_im, s_im)
    y = y.reshape(bsz, seq, S5_WIDTH) + d_skip.astype(f32) * u
    y = jax.nn.gelu(y)
    y = y * jax.nn.sigmoid(y @ glu_w.astype(f32) + glu_b.astype(f32))
    return y * jax.nn.silu(z.astype(f32))


def setup_inputs(seed: int = 0) -> dict:
    key = jax.random.key(seed)
    ks = iter(jax.random.split(key, 40))
    f32 = jnp.float32

    def nrm(shape, s):
        return s * jax.random.normal(next(ks), shape, f32)

    def unif(shape, lo, hi):
        return jax.random.uniform(next(ks), shape, f32, lo, hi)

    gdn_dt = jnp.exp(unif((DEPTH, GDN_HEADS), math.log(1e-3), math.log(1e-1)))
    return {
        "x": nrm((BATCH, SEQ, D_MODEL), 1.0),
        "norm_w": 1.0 + nrm((DEPTH, D_MODEL), 0.02),
        "w_in": nrm((DEPTH, D_MODEL, IN_COLS), D_MODEL ** -0.5),
        "gdn_conv_w": nrm((DEPTH, GDN_CONV, 3 * GDN_WIDTH), GDN_CONV ** -0.5),
        "gdn_a_log": jnp.log(unif((DEPTH, GDN_HEADS), 1.0, 16.0)),
        "gdn_dt_bias": jnp.log(jnp.expm1(gdn_dt)),
        "gdn_norm_w": 1.0 + nrm((DEPTH, GDN_HEAD_DIM), 0.02),
        "rwkv_mu": unif((DEPTH, RWKV_SHIFT_COLS), 0.0, 1.0),
        "rwkv_w0": unif((DEPTH, RWKV_WIDTH), -6.5, -1.5),
        "rwkv_w_up": nrm((DEPTH, RWKV_DECAY_LORA, RWKV_WIDTH), 0.5 * RWKV_DECAY_LORA ** -0.5),
        "rwkv_a0": nrm((DEPTH, RWKV_WIDTH), 0.1),
        "rwkv_a_up": nrm((DEPTH, RWKV_ICLR_LORA, RWKV_WIDTH), 0.5 * RWKV_ICLR_LORA ** -0.5),
        "rwkv_k_k": 0.85 + nrm((DEPTH, RWKV_WIDTH), 0.05),
        "rwkv_k_a": 1.0 + nrm((DEPTH, RWKV_WIDTH), 0.05),
        "rwkv_r_k": nrm((DEPTH, RWKV_HEADS, RWKV_HEAD_DIM), 0.1),
        "rwkv_lnx_w": 1.0 + nrm((DEPTH, RWKV_WIDTH), 0.02),
        "rwkv_lnx_b": nrm((DEPTH, RWKV_WIDTH), 0.02),
        "s5_a_re": -0.5 + nrm((DEPTH, S5_GROUPS, S5_STATE), 0.01),
        "s5_a_im": jnp.pi * jnp.arange(S5_STATE, dtype=f32)[None, None, :] + nrm((DEPTH, S5_GROUPS, S5_STATE), 0.01),
        "s5_log_dt": unif((DEPTH, S5_GROUPS), math.log(1e-3), math.log(1e-1)),
        "s5_b_re": nrm((DEPTH, S5_GROUPS, S5_STATE, S5_GROUP), (2 * S5_GROUP) ** -0.5),
        "s5_b_im": nrm((DEPTH, S5_GROUPS, S5_STATE, S5_GROUP), (2 * S5_GROUP) ** -0.5),
        "s5_c_re": nrm((DEPTH, S5_GROUPS, S5_GROUP, S5_STATE), (2 * S5_STATE) ** -0.5),
        "s5_c_im": nrm((DEPTH, S5_GROUPS, S5_GROUP, S5_STATE), (2 * S5_STATE) ** -0.5),
        "s5_d": nrm((DEPTH, S5_WIDTH), 1.0),
        "s5_glu_w": nrm((DEPTH, S5_WIDTH, S5_WIDTH), S5_WIDTH ** -0.5),
        "s5_glu_b": nrm((DEPTH, S5_WIDTH), 0.02),
        "gate_b": nrm((DEPTH, N_BRANCH, D_MODEL), 0.02),
        "w_branch": nrm((DEPTH, N_BRANCH, BRANCH_WIDTH, D_MODEL), BRANCH_WIDTH ** -0.5),
        "w_out": nrm((DEPTH, D_MODEL, D_MODEL), D_MODEL ** -0.5),
        "final_norm_w": 1.0 + nrm((D_MODEL,), 0.02),
    }


def reference(x, norm_w, w_in, gdn_conv_w, gdn_a_log, gdn_dt_bias, gdn_norm_w,
              rwkv_mu, rwkv_w0, rwkv_w_up, rwkv_a0, rwkv_a_up, rwkv_k_k, rwkv_k_a, rwkv_r_k,
              rwkv_lnx_w, rwkv_lnx_b,
              s5_a_re, s5_a_im, s5_log_dt, s5_b_re, s5_b_im, s5_c_re, s5_c_im, s5_d,
              s5_glu_w, s5_glu_b,
              gate_b, w_branch, w_out, final_norm_w):
    bsz, seq, _ = x.shape
    for i in range(DEPTH):
        h = rms_norm(x, norm_w[i])
        proj = h @ w_in[i]
        (g_qkv, g_z, g_b, g_a, r_feat, r_z, s_u, s_z, gate_logits) = _split_cols(proj, SPLIT_SIZES)
        o_a = gdn_branch(g_qkv, g_z, g_b, g_a, gdn_conv_w[i], gdn_a_log[i], gdn_dt_bias[i], gdn_norm_w[i])
        o_b = rwkv7_branch(r_feat, r_z, rwkv_mu[i], rwkv_w0[i], rwkv_w_up[i], rwkv_a0[i], rwkv_a_up[i],
                           rwkv_k_k[i], rwkv_k_a[i], rwkv_r_k[i], rwkv_lnx_w[i], rwkv_lnx_b[i])
        o_c = s5_branch(s_u, s_z, s5_a_re[i], s5_a_im[i], s5_log_dt[i], s5_b_re[i], s5_b_im[i],
                        s5_c_re[i], s5_c_im[i], s5_d[i], s5_glu_w[i], s5_glu_b[i])
        branches = jnp.stack([o_a, o_b, o_c], axis=2)
        branch_proj = jnp.einsum('blnc,ncd->blnd', branches, w_branch[i].astype(jnp.float32))
        gates = jax.nn.sigmoid(gate_logits.astype(jnp.float32).reshape(bsz, seq, N_BRANCH, D_MODEL)
                               + gate_b[i].astype(jnp.float32))
        merged = jnp.sum(gates * branch_proj, axis=2)
        x = x + (merged @ w_out[i].astype(jnp.float32)).astype(x.dtype)
    return rms_norm(x, final_norm_w)
```

```cpp
#include <hip/hip_runtime.h>
#include <hip/hip_cooperative_groups.h>
#include <cstdio>
#include <cstdint>
namespace cg = cooperative_groups;
namespace pg8 {
#define PG8_LAS __attribute__((address_space(3)))
typedef unsigned short bf16_t;
typedef short bf16x8 __attribute__((ext_vector_type(8)));
typedef float f32x4 __attribute__((ext_vector_type(4)));
typedef unsigned u32x4 __attribute__((ext_vector_type(4)));
constexpr int BM = 256, BK = 64, HALF = 128, HTB = HALF * BK * 2  , STAGE_BYTES = 8 * HTB, NXCD = 8, WGM = 8;

__host__ __device__ __forceinline__ int lds_byte(int r, int c) { const int st = (r >> 4) * 2 + (c >> 5), rr = r & 15, cc = c & 31, ob = rr * 64 + cc * 2; return st * 1024 + (ob ^ (((ob >> 9) & 1) << 5)); }
__host__ __device__ __forceinline__ void stage_rc(int b, int& R, int& C) { const int st = b / 1024, sb = b % 1024, swz = sb ^ (((sb >> 9) & 1) << 5); R = (st >> 1) * 16 + swz / 64; C = (st & 1) * 32 + (swz % 64) / 2; }
__host__ __device__ __forceinline__ int perm32(int rho) { const int n = rho >> 4, i = rho & 15; return 8 * (i >> 2) + 4 * n + (i & 3); }

struct Unit { int pm, pn; };
struct Gemm { const bf16_t* A; const bf16_t* Bt; int M, N, K; };

struct StaticOrder {
    int nM, nN, nwg, G, c;
    __host__ __device__ void init(int M, int N, int G_, int c_) { nM = M / BM; nN = N / BM; nwg = nM * nN; G = G_; c = c_; }
    __host__ __device__ bool next(int i, Unit& u) const {
        const long L = (long)i * G + c; if (L >= nwg) return false;
        int wgid = (int)L; { const int q = nwg / NXCD, r = nwg % NXCD, xcd = wgid % NXCD, off = wgid / NXCD; wgid = (xcd < r ? xcd * (q + 1) : r * (q + 1) + (xcd - r) * q) + off; }
        const int nig = WGM * nN, gid = wgid / nig, fm = gid * WGM, gsz = (nM - fm) < WGM ? (nM - fm) : WGM;
        u.pm = fm + ((wgid % nig) % gsz); u.pn = (wgid % nig) / gsz; return true;
    }
    __device__ __forceinline__ void a_ready(const Unit&) const {}
    __device__ __forceinline__ void done(const Unit&) const {}
};

__device__ __forceinline__ unsigned cvt_pk_bf16(float lo, float hi) { unsigned r; asm volatile("v_cvt_pk_bf16_f32 %0, %1, %2" : "=v"(r) : "v"(lo), "v"(hi)); return r; }
typedef float f32x2 __attribute__((ext_vector_type(2)));
__device__ __forceinline__ f32x2 gelu_pk(f32x2 v) {
    const f32x2 av = __builtin_elementwise_abs(v), d = av * 0.2316418882f + 1.0f;
    f32x2 t; t.x = __builtin_amdgcn_rcpf(d.x); t.y = __builtin_amdgcn_rcpf(d.y);
    f32x2 q = t * 0.5307027145f + (-0.7265760135f); q = q * t + 0.7107068705f; q = q * t + (-0.142248368f); q = q * t + 0.127414796f; q = q * t;
    const f32x2 s = (v * v) * (-0.72134752044f);
    f32x2 e; e.x = __builtin_amdgcn_exp2f(s.x); e.y = __builtin_amdgcn_exp2f(s.y);
    const f32x2 m = v * (q * e), r = v - m;
    f32x2 o; o.x = v.x < 0.f ? m.x : r.x; o.y = v.y < 0.f ? m.y : r.y; return o;
}

template <int ACT  > struct EpiBf16 {
    static constexpr bool PERM = true, AFTER_DRAIN = false; static_assert(ACT == 0 || ACT == 1, "EpiBf16: ACT is 0 (none) or 1 (gelu_pk)");
    bf16_t* O; int ldc; const float* bias; int split_cols; size_t split_stride; float scale0;
    __device__ __forceinline__ void operator()(const f32x4 (&acc)[2][2][4][2], const Unit& u, int wr, int wc, int fr, int fq) const {
        const int row0 = u.pm * BM + wr * 64 + fr; int colt = u.pn * BM; bf16_t* base = O;
        float sc = 1.f; if (split_cols) { const int t = colt / split_cols; base += (size_t)t * split_stride; colt -= t * split_cols; if (t == 0) sc = scale0; }
        const int col0 = colt + wc * 32 + 8 * fq, bcol0 = u.pn * BM + wc * 32 + 8 * fq;
        f32x4 bv[2][2];
#pragma unroll
        for (int bj = 0; bj < 2; ++bj)
#pragma unroll
            for (int n = 0; n < 2; ++n) bv[bj][n] = bias ? *(const f32x4*)(bias + bcol0 + bj * HALF + 4 * n) : (f32x4){0.f, 0.f, 0.f, 0.f};
#pragma unroll
        for (int ai = 0; ai < 2; ++ai)
#pragma unroll
            for (int m = 0; m < 4; ++m) { bf16_t* rowp = base + (size_t)(row0 + ai * HALF + m * 16) * ldc + col0;
#pragma unroll
                for (int bj = 0; bj < 2; ++bj) { f32x4 v0 = acc[ai][bj][m][0] + bv[bj][0], v1 = acc[ai][bj][m][1] + bv[bj][1];
                    if (ACT == 1) { f32x2 a = gelu_pk((f32x2){v0[0], v0[1]}), b = gelu_pk((f32x2){v0[2], v0[3]}), c = gelu_pk((f32x2){v1[0], v1[1]}), d = gelu_pk((f32x2){v1[2], v1[3]});
                        v0 = (f32x4){a.x, a.y, b.x, b.y}; v1 = (f32x4){c.x, c.y, d.x, d.y}; }
                    v0 = v0 * sc; v1 = v1 * sc; u32x4 w; w.x = cvt_pk_bf16(v0[0], v0[1]); w.y = cvt_pk_bf16(v0[2], v0[3]); w.z = cvt_pk_bf16(v1[0], v1[1]); w.w = cvt_pk_bf16(v1[2], v1[3]);
                    *(u32x4*)(rowp + bj * HALF) = w; } }
    }
};

template <class Epi, class Sched, bool ALIGN_EPI = false, bool SP2 = false>
__device__ __forceinline__ void gemm_phase(PG8_LAS unsigned char* lds, const Gemm g, const Sched& S, const Epi& E) {
    int tid_ = threadIdx.x; asm volatile("" : "+v"(tid_));
    const int tid = tid_, wid = __builtin_amdgcn_readfirstlane(tid >> 6), lane = tid & 63, wr = wid >> 2, wc = wid & 3, fr = lane & 15, fq = lane >> 4;
    const int K = g.K, nt = K / BK;
    unsigned voffA[2], voffB[2];
#pragma unroll
    for (int i = 0; i < 2; ++i) { int R, C; stage_rc(tid * 16 + i * 8192, R, C); const int Rb = Epi::PERM ? ((R & ~31) + perm32(R & 31)) : R;
        voffA[i] = (unsigned)(R * K + C) * 2u; voffB[i] = (unsigned)(Rb * K + C) * 2u; }
    const size_t kstep = (size_t)(BK * 2);
    const size_t hstep = (size_t)HALF * K * 2;
    const size_t tstep = 2 * hstep;
    const unsigned ldsw = (unsigned)wid * 1024u;
    const int aoff = lds_byte(wr * 64 + fr, fq * 8), boff = lds_byte(wc * 32 + fr, fq * 8);
#define PG8_SA(b, h) (((b) * 2 + (h)) * HTB)
#define PG8_SB(b, h) ((4 + (b) * 2 + (h)) * HTB)
#define PG8_STAGE(bufoff, gbase, voff) do { _Pragma("unroll") for (int _i = 0; _i < 2; ++_i) \
        __builtin_amdgcn_global_load_lds((const unsigned*)((const char*)(gbase) + (voff)[_i]), (PG8_LAS unsigned*)(lds + (bufoff) + ldsw + _i * 8192), 16, 0, 0); } while (0)
#define PG8_LDA(dst, b, h) do { _Pragma("unroll") for (int m = 0; m < 4; ++m) _Pragma("unroll") for (int k = 0; k < 2; ++k) dst[m][k] = *(const PG8_LAS bf16x8*)(lds + PG8_SA(b, h) + aoff + m * 2048 + k * 1024); } while (0)
#define PG8_LDB(dst, b, h) do { _Pragma("unroll") for (int n = 0; n < 2; ++n) _Pragma("unroll") for (int k = 0; k < 2; ++k) dst[n][k] = *(const PG8_LAS bf16x8*)(lds + PG8_SB(b, h) + boff + n * 2048 + k * 1024); } while (0)
#define PG8_MMA(ai, bj, At, Bt) do { __builtin_amdgcn_s_setprio(1); _Pragma("unroll") for (int m = 0; m < 4; ++m) _Pragma("unroll") for (int n = 0; n < 2; ++n) _Pragma("unroll") for (int k = 0; k < 2; ++k) \
        acc[ai][bj][m][n] = __builtin_amdgcn_mfma_f32_16x16x32_bf16(Bt[n][k], At[m][k], acc[ai][bj][m][n], 0, 0, 0); __builtin_amdgcn_s_setprio(0); } while (0)
#define PG8_WAIT_V(n) asm volatile("s_waitcnt vmcnt(" #n ")" ::: "memory")
#define PG8_WAIT_L(n) asm volatile("s_waitcnt lgkmcnt(" #n ")" ::: "memory")
#define PG8_BAR __builtin_amdgcn_s_barrier()
#define PG8_SCHED __builtin_amdgcn_sched_barrier(0)
    Unit cur, nxt; int ui = 0;
    if (!S.next(0, cur)) return;
    f32x4 acc[2][2][4][2];
#pragma unroll
    for (int a = 0; a < 2; ++a)
#pragma unroll
        for (int b = 0; b < 2; ++b)
#pragma unroll
            for (int m = 0; m < 4; ++m)
#pragma unroll
                for (int n = 0; n < 2; ++n) acc[a][b][m][n] = (f32x4){0.f, 0.f, 0.f, 0.f};
    bf16x8 At[4][2], B0[2][2], B1[2][2];
    const char* cA = (const char*)g.A + (size_t)cur.pm * tstep; const char* cB = (const char*)g.Bt + (size_t)cur.pn * tstep;
    S.a_ready(cur);
    if constexpr (SP2) {
        PG8_STAGE(PG8_SB(0, 0), cB, voffB); PG8_STAGE(PG8_SB(0, 1), cB + hstep, voffB); PG8_STAGE(PG8_SA(0, 0), cA, voffA); PG8_STAGE(PG8_SA(0, 1), cA + hstep, voffA);
        if (wr == 1) PG8_BAR;
        PG8_WAIT_V(2); PG8_BAR;
        PG8_STAGE(PG8_SB(1, 0), cB + kstep, voffB); PG8_STAGE(PG8_SA(1, 0), cA + kstep, voffA); PG8_STAGE(PG8_SB(1, 1), cB + hstep + kstep, voffB);
        PG8_WAIT_V(6); PG8_BAR;
    } else {
        PG8_STAGE(PG8_SB(0, 0), cB, voffB); PG8_STAGE(PG8_SA(0, 0), cA, voffA); PG8_STAGE(PG8_SB(0, 1), cB + hstep, voffB); PG8_STAGE(PG8_SA(0, 1), cA + hstep, voffA);
        if (wr == 1) PG8_BAR;
        PG8_WAIT_V(4); PG8_BAR;
        PG8_STAGE(PG8_SB(1, 0), cB + kstep, voffB); PG8_STAGE(PG8_SA(1, 0), cA + kstep, voffA); PG8_STAGE(PG8_SB(1, 1), cB + hstep + kstep, voffB);
        PG8_WAIT_V(6); PG8_BAR;
    }
    for (;;) {
        const bool has_next = S.next(ui + 1, nxt);
        const char* nA = has_next ? (const char*)g.A + (size_t)nxt.pm * tstep : cA; const char* nB = has_next ? (const char*)g.Bt + (size_t)nxt.pn * tstep : cB;
        for (int t = 0; t < nt; t += 2) {
            const bool last = (t == nt - 2);
            const char* a1 = cA + (size_t)(t + 1) * kstep;
            const char* a2 = last ? nA : cA + (size_t)(t + 2) * kstep; const char* b2 = last ? nB : cB + (size_t)(t + 2) * kstep;
            const char* a3 = a2 + kstep; const char* b3 = b2 + kstep;
            if (last && has_next) S.a_ready(nxt);
            if constexpr (SP2) {
            PG8_LDB(B0, 0, 0); PG8_LDB(B1, 0, 1); PG8_SCHED; PG8_LDA(At, 0, 0); PG8_STAGE(PG8_SA(1, 1), a1 + hstep, voffA);
            PG8_WAIT_V(8); PG8_WAIT_L(0); PG8_BAR; PG8_MMA(0, 0, At, B0); PG8_MMA(0, 1, At, B1); PG8_BAR; PG8_SCHED;
            PG8_LDA(At, 0, 1); PG8_STAGE(PG8_SB(0, 0), b2, voffB); PG8_STAGE(PG8_SB(0, 1), b2 + hstep, voffB); PG8_STAGE(PG8_SA(0, 0), a2, voffA);
            PG8_WAIT_V(8); PG8_WAIT_L(0); PG8_BAR; PG8_MMA(1, 0, At, B0); PG8_MMA(1, 1, At, B1); PG8_BAR; PG8_SCHED;
            PG8_LDB(B0, 1, 0); PG8_LDB(B1, 1, 1); PG8_SCHED; PG8_LDA(At, 1, 0); PG8_STAGE(PG8_SA(0, 1), a2 + hstep, voffA);
            PG8_WAIT_V(8); PG8_WAIT_L(0); PG8_BAR; PG8_MMA(0, 0, At, B0); PG8_MMA(0, 1, At, B1); PG8_BAR; PG8_SCHED;
            PG8_LDA(At, 1, 1); PG8_STAGE(PG8_SB(1, 0), b3, voffB); PG8_STAGE(PG8_SB(1, 1), b3 + hstep, voffB); PG8_STAGE(PG8_SA(1, 0), a3, voffA);
            PG8_WAIT_V(8); PG8_WAIT_L(0); PG8_BAR; PG8_MMA(1, 0, At, B0); PG8_MMA(1, 1, At, B1); PG8_BAR; PG8_SCHED;
            } else {
            PG8_LDB(B0, 0, 0); PG8_SCHED; PG8_LDA(At, 0, 0); PG8_STAGE(PG8_SA(1, 1), a1 + hstep, voffA);
            PG8_WAIT_L(8); PG8_BAR; PG8_WAIT_L(0); PG8_MMA(0, 0, At, B0); PG8_BAR; PG8_SCHED;
            PG8_LDB(B1, 0, 1); PG8_STAGE(PG8_SB(0, 0), b2, voffB);
            PG8_BAR; PG8_WAIT_L(0); PG8_MMA(0, 1, At, B1); PG8_BAR;
            PG8_LDA(At, 0, 1); PG8_STAGE(PG8_SA(0, 0), a2, voffA);
            PG8_BAR; PG8_WAIT_L(0); PG8_MMA(1, 0, At, B0); PG8_BAR; PG8_SCHED;
            PG8_STAGE(PG8_SB(0, 1), b2 + hstep, voffB);
            PG8_WAIT_V(6); PG8_BAR; PG8_MMA(1, 1, At, B1); PG8_BAR;
            PG8_LDB(B0, 1, 0); PG8_SCHED; PG8_LDA(At, 1, 0); PG8_STAGE(PG8_SA(0, 1), a2 + hstep, voffA);
            PG8_WAIT_L(8); PG8_BAR; PG8_WAIT_L(0); PG8_MMA(0, 0, At, B0); PG8_BAR; PG8_SCHED;
            PG8_LDB(B1, 1, 1); PG8_STAGE(PG8_SB(1, 0), b3, voffB);
            PG8_BAR; PG8_WAIT_L(0); PG8_MMA(0, 1, At, B1); PG8_BAR;
            PG8_LDA(At, 1, 1); PG8_STAGE(PG8_SA(1, 0), a3, voffA);
            PG8_BAR; PG8_WAIT_L(0); PG8_MMA(1, 0, At, B0); PG8_BAR; PG8_SCHED;
            PG8_STAGE(PG8_SB(1, 1), b3 + hstep, voffB);
            PG8_WAIT_V(6); PG8_BAR; PG8_MMA(1, 1, At, B1); PG8_BAR;
            }
        }
        if constexpr (ALIGN_EPI) { if (wr == 0) PG8_BAR; }
        if constexpr (!Epi::AFTER_DRAIN) { E(acc, cur, wr, wc, fr, fq); S.done(cur); }
        if (!has_next) break;
#pragma unroll
        for (int a = 0; a < 2; ++a)
#pragma unroll
            for (int b = 0; b < 2; ++b)
#pragma unroll
                for (int m = 0; m < 4; ++m)
#pragma unroll
                    for (int n = 0; n < 2; ++n) acc[a][b][m][n] = (f32x4){0.f, 0.f, 0.f, 0.f};
        cur = nxt; cA = nA; cB = nB; ++ui;
        if constexpr (ALIGN_EPI) { if (wr == 1) PG8_BAR; }
    }
    PG8_WAIT_V(0);
    if constexpr (!ALIGN_EPI) { if (wr == 0) PG8_BAR; }
    PG8_BAR;
    if constexpr (Epi::AFTER_DRAIN) { E.fused(acc, cur, wr, wc, fr, fq, lds, wid, lane); S.done(cur); }
#undef PG8_SA
#undef PG8_SB
#undef PG8_STAGE
#undef PG8_LDA
#undef PG8_LDB
#undef PG8_MMA
#undef PG8_WAIT_V
#undef PG8_WAIT_L
#undef PG8_BAR
#undef PG8_SCHED
}
}

#define GAS __attribute__((address_space(1)))
#define LAS __attribute__((address_space(3)))
typedef unsigned short bf16;
typedef unsigned u32x4 __attribute__((ext_vector_type(4)));
typedef unsigned u32x2 __attribute__((ext_vector_type(2)));
typedef float f32x4 __attribute__((ext_vector_type(4)));
typedef float f32x2 __attribute__((ext_vector_type(2)));

constexpr int NBATCH = 4, SEQ = 2048, TOK = NBATCH * SEQ, DM = 2048, DEPTH = 4;
constexpr int NIN = 16592, NINP = 16640;
constexpr int C_GQKV = 0, C_GZ = 3072, C_GB = 4096, C_GA = 4104, C_RF = 4112, C_RZ = 7376, C_SU = 8400, C_SZ = 9424, C_GATE = 10448;
constexpr int NWAVES = 8, NTHREADS = 512;
constexpr int LDS_BYTES = 147456;
constexpr int PH_PER_LAYER = 7, NPHASES = 1 + DEPTH * PH_PER_LAYER;

constexpr size_t MiB = 1u << 20;
constexpr size_t WS_WIN = 0, WS_WGLU = 260 * MiB, WS_WBR = 268 * MiB, WS_WOUT = 316 * MiB, WS_XN = 348 * MiB, WS_PROJ = 380 * MiB;
constexpr size_t WS_GQ = 640 * MiB, WS_GK = 672 * MiB, WS_GV = 704 * MiB, WS_GEG = 736 * MiB, WS_GBE = 737 * MiB, WS_GO = 738 * MiB;
constexpr size_t WS_RR = 770 * MiB, WS_RW = 802 * MiB, WS_RK = 834 * MiB, WS_RV = 866 * MiB, WS_RKK = 898 * MiB, WS_RKA = 930 * MiB, WS_RBON = 962 * MiB, WS_RY = 963 * MiB;
constexpr size_t WS_SY = 995 * MiB, WS_OBR = 1011 * MiB, WS_ACCF = 1059 * MiB, WS_MRG = 1123 * MiB, WS_END = 1155 * MiB;
static_assert((size_t)DEPTH * NINP * DM * 2 == 260 * MiB && (size_t)TOK * NINP * 2 == 260 * MiB, "ws map");

__device__ __forceinline__ unsigned f2bf(float f) { unsigned u = __builtin_bit_cast(unsigned, f); return (u + 0x7fffu + ((u >> 16) & 1u)) >> 16; }
__device__ __forceinline__ unsigned pk2(float lo, float hi) { return f2bf(lo) | (f2bf(hi) << 16); }
__device__ __forceinline__ float bflo(unsigned w) { return __builtin_bit_cast(float, w << 16); }
__device__ __forceinline__ float bfhi(unsigned w) { return __builtin_bit_cast(float, w & 0xffff0000u); }
__device__ __forceinline__ float bf1(bf16 h) { return __builtin_bit_cast(float, (unsigned)h << 16); }
__device__ __forceinline__ float sigmoidf_(float x) { return 1.f / (1.f + __expf(-x)); }
__device__ __forceinline__ float siluf_(float x) { return x / (1.f + __expf(-x)); }
__device__ __forceinline__ float softplusf_(float x) { return x > 20.f ? x : log1pf(expf(x)); }
__device__ __forceinline__ float gelu_tanh(float y) { const float t = 0.7978845608028654f * (y + 0.044715f * y * y * y); const float th = 1.f - 2.f / (1.f + __expf(2.f * t)); return 0.5f * y * (1.f + th); }
template <int CTRL> __device__ __forceinline__ float dppf(float v) { return __builtin_bit_cast(float, __builtin_amdgcn_update_dpp(0, __builtin_bit_cast(int, v), CTRL, 0xF, 0xF, true)); }
__device__ __forceinline__ float allred8(float v) { v += dppf<0xB1>(v); v += dppf<0x4E>(v); v += dppf<0x141>(v); return v; }
__device__ __forceinline__ float allred16(float v) { v = allred8(v); v += dppf<0x140>(v); return v; }
__device__ __forceinline__ float wave_sum(float v) {
#pragma unroll
    for (int o = 1; o < 64; o <<= 1) v += __shfl_xor(v, o);
    return v;
}
__device__ __forceinline__ void unpack8(const u32x4 w, float (&f)[8]) { f[0] = bflo(w.x); f[1] = bfhi(w.x); f[2] = bflo(w.y); f[3] = bfhi(w.y); f[4] = bflo(w.z); f[5] = bfhi(w.z); f[6] = bflo(w.w); f[7] = bfhi(w.w); }
__device__ __forceinline__ u32x4 pack8(const float (&f)[8]) { u32x4 w; w.x = pk2(f[0], f[1]); w.y = pk2(f[2], f[3]); w.z = pk2(f[4], f[5]); w.w = pk2(f[6], f[7]); return w; }

namespace pg8 {
struct EpiGlu {
    static constexpr bool PERM = true, AFTER_DRAIN = false;
    const bf16* Y1; const bf16* PROJ; const float* bias; bf16* O;
    __device__ __forceinline__ void operator()(const f32x4 (&acc)[2][2][4][2], const Unit& u, int wr, int wc, int fr, int fq) const {
        int row0 = u.pm * BM + wr * 64 + fr, col0 = u.pn * BM + wc * 32 + 8 * fq;
        asm volatile("" : "+v"(row0), "+v"(col0));
#pragma unroll
        for (int bj = 0; bj < 2; ++bj) {
            const int col = col0 + bj * HALF;
            const f32x4 b0 = *(const f32x4*)(bias + col), b1 = *(const f32x4*)(bias + col + 4);
#pragma unroll
            for (int ai = 0; ai < 2; ++ai)
#pragma unroll
                for (int m = 0; m < 4; ++m) {
                    const size_t row = (size_t)(row0 + ai * HALF + m * 16);
                    const u32x4 y8 = *(const u32x4*)(Y1 + row * 1024 + col), z8 = *(const u32x4*)(PROJ + row * NINP + C_SZ + col);
                    float y[8], z[8], o[8]; unpack8(y8, y); unpack8(z8, z);
                    const f32x4 v0 = acc[ai][bj][m][0] + b0, v1 = acc[ai][bj][m][1] + b1;
                    const float a[8] = {v0[0], v0[1], v0[2], v0[3], v1[0], v1[1], v1[2], v1[3]};
#pragma unroll
                    for (int e = 0; e < 8; ++e) o[e] = y[e] * sigmoidf_(a[e]) * siluf_(z[e]);
                    *(u32x4*)(O + row * 1024 + col) = pack8(o);
                    asm volatile("" ::: "memory");
                }
        }
    }
};
struct EpiBranch {
    static constexpr bool PERM = true, AFTER_DRAIN = false;
    const bf16* PROJ; const float* gate_b; float* ACCF; bf16* MRG;
    __device__ __forceinline__ void operator()(const f32x4 (&acc)[2][2][4][2], const Unit& u, int wr, int wc, int fr, int fq) const {
        const int br = u.pm >> 5, pm = u.pm & 31, pn = u.pn & 7;
        int row0 = pm * BM + wr * 64 + fr, col0 = pn * BM + wc * 32 + 8 * fq;
        asm volatile("" : "+v"(row0), "+v"(col0));
#pragma unroll
        for (int bj = 0; bj < 2; ++bj) {
            const int col = col0 + bj * HALF;
            const f32x4 g0 = *(const f32x4*)(gate_b + br * DM + col), g1 = *(const f32x4*)(gate_b + br * DM + col + 4);
            const float gb[8] = {g0[0], g0[1], g0[2], g0[3], g1[0], g1[1], g1[2], g1[3]};
#pragma unroll
            for (int ai = 0; ai < 2; ++ai)
#pragma unroll
                for (int m = 0; m < 4; ++m) {
                    const size_t row = (size_t)(row0 + ai * HALF + m * 16);
                    const u32x4 l8 = *(const u32x4*)(PROJ + row * NINP + C_GATE + br * DM + col);
                    float gl[8], o[8]; unpack8(l8, gl);
                    const f32x4 v0 = acc[ai][bj][m][0], v1 = acc[ai][bj][m][1];
                    const float a[8] = {v0[0], v0[1], v0[2], v0[3], v1[0], v1[1], v1[2], v1[3]};
#pragma unroll
                    for (int e = 0; e < 8; ++e) o[e] = sigmoidf_(gl[e] + gb[e]) * a[e];
                    float* ap = ACCF + row * DM + col;
                    if (br > 0) { const f32x4 p0 = *(const f32x4*)ap, p1 = *(const f32x4*)(ap + 4);
                        o[0] += p0[0]; o[1] += p0[1]; o[2] += p0[2]; o[3] += p0[3]; o[4] += p1[0]; o[5] += p1[1]; o[6] += p1[2]; o[7] += p1[3]; }
                    if (br < 2) { *(f32x4*)ap = (f32x4){o[0], o[1], o[2], o[3]}; *(f32x4*)(ap + 4) = (f32x4){o[4], o[5], o[6], o[7]}; }
                    else *(u32x4*)(MRG + row * DM + col) = pack8(o);
                    asm volatile("" ::: "memory");
                }
        }
    }
};
struct EpiResid {
    static constexpr bool PERM = true, AFTER_DRAIN = false;
    const float* base; float* out;
    __device__ __forceinline__ void operator()(const f32x4 (&acc)[2][2][4][2], const Unit& u, int wr, int wc, int fr, int fq) const {
        int row0 = u.pm * BM + wr * 64 + fr, col0 = u.pn * BM + wc * 32 + 8 * fq;
        asm volatile("" : "+v"(row0), "+v"(col0));
#pragma unroll
        for (int ai = 0; ai < 2; ++ai)
#pragma unroll
            for (int m = 0; m < 4; ++m)
#pragma unroll
                for (int bj = 0; bj < 2; ++bj) {
                    const size_t off = (size_t)(row0 + ai * HALF + m * 16) * DM + col0 + bj * HALF;
                    const f32x4 p0 = *(const f32x4*)(base + off), p1 = *(const f32x4*)(base + off + 4);
                    *(f32x4*)(out + off) = p0 + acc[ai][bj][m][0]; *(f32x4*)(out + off + 4) = p1 + acc[ai][bj][m][1];
                }
    }
};
struct BranchOrder {
    StaticOrder base;
    __device__ bool next(int i, Unit& u) const { Unit t; const int r = i / 3, br = i - 3 * r; if (!base.next(r, t)) return false; u.pm = br * 32 + t.pm; u.pn = br * 8 + t.pn; return true; }
    __device__ __forceinline__ void a_ready(const Unit&) const {}
    __device__ __forceinline__ void done(const Unit&) const {}
};
}

struct Args { const float* in[31]; float* out; unsigned char* ws; int ph_lo, ph_hi; };
struct Ctx { int tid, lane, wave, vcu, G, gw, NGW; LAS unsigned char* lds; unsigned char* ws; };

__device__ __forceinline__ void transpose_item(const float* W, int K, int N, bf16* WT, LAS float* scr, int kb, int nb, int lane) {
    const int k0 = 64 * kb, n0 = 32 * nb, n = n0 + (lane & 31); const bool nv = n < N;
#pragma unroll 8
    for (int i = 0; i < 32; ++i) { const int kk = 2 * i + (lane >> 5); scr[kk * 33 + (lane & 31)] = nv ? W[(size_t)(k0 + kk) * N + n] : 0.f; }
    asm volatile("s_waitcnt lgkmcnt(0)" ::: "memory");
    const int c = lane & 7;
#pragma unroll
    for (int j = 0; j < 4; ++j) { const int nn = (lane >> 3) + 8 * j; const LAS float* s = scr + (8 * c) * 33 + nn;
        u32x4 o; o.x = pk2(s[0 * 33], s[1 * 33]); o.y = pk2(s[2 * 33], s[3 * 33]); o.z = pk2(s[4 * 33], s[5 * 33]); o.w = pk2(s[6 * 33], s[7 * 33]);
        *(u32x4*)(WT + (size_t)(n0 + nn) * K + k0 + 8 * c) = o; }
    asm volatile("s_waitcnt lgkmcnt(0)" ::: "memory");
}

__device__ __forceinline__ void rms_row(const float* xrow, const float* w, bf16* obf, float* of32, int lane) {
    f32x4 v[8]; float s = 0.f;
#pragma unroll
    for (int j = 0; j < 8; ++j) { v[j] = *(const f32x4*)(xrow + 4 * lane + 256 * j); s += (v[j].x * v[j].x + v[j].y * v[j].y) + (v[j].z * v[j].z + v[j].w * v[j].w); }
    const float r = 1.f / sqrtf(wave_sum(s) * (1.f / DM) + 1e-6f);
#pragma unroll
    for (int j = 0; j < 8; ++j) { const f32x4 ww = *(const f32x4*)(w + 4 * lane + 256 * j); const f32x4 o = v[j] * r * ww;
        if (obf) { u32x2 p; p.x = pk2(o.x, o.y); p.y = pk2(o.z, o.w); *(u32x2*)(obf + 4 * lane + 256 * j) = p; }
        else *(f32x4*)(of32 + 4 * lane + 256 * j) = o; }
}

__device__ __forceinline__ void phase0(const Ctx& F, const Args& a) {
    LAS float* scr = (LAS float*)(F.lds + F.wave * 16384);
    constexpr int I_IN = 32 * 520, I_GLU = 16 * 32, I_BR = 16 * 64, I_OUT = 32 * 64, IL = I_IN + I_GLU + 3 * I_BR + I_OUT;
    bf16* WIN = (bf16*)(F.ws + WS_WIN); bf16* WGLU = (bf16*)(F.ws + WS_WGLU); bf16* WBR = (bf16*)(F.ws + WS_WBR); bf16* WOUT = (bf16*)(F.ws + WS_WOUT);
    for (int it = F.gw; it < DEPTH * IL; it += F.NGW) {
        const int l = it / IL; int r = it - l * IL;
        if (r < I_IN) { transpose_item(a.in[2] + (size_t)l * DM * NIN, DM, NIN, WIN + (size_t)l * NINP * DM, scr, r / 520, r % 520, F.lane); continue; } r -= I_IN;
        if (r < I_GLU) { transpose_item(a.in[25] + (size_t)l * 1024 * 1024, 1024, 1024, WGLU + (size_t)l * 1024 * 1024, scr, r / 32, r % 32, F.lane); continue; } r -= I_GLU;
        if (r < 3 * I_BR) { const int br = r / I_BR, r2 = r - br * I_BR;
            transpose_item(a.in[28] + (size_t)(l * 3 + br) * 1024 * DM, 1024, DM, WBR + (size_t)(l * 3 + br) * DM * 1024, scr, r2 / 64, r2 % 64, F.lane); continue; } r -= 3 * I_BR;
        transpose_item(a.in[29] + (size_t)l * DM * DM, DM, DM, WOUT + (size_t)l * DM * DM, scr, r / 64, r % 64, F.lane);
    }
    bf16* XN = (bf16*)(F.ws + WS_XN);
    for (int m = F.gw; m < TOK; m += F.NGW) rms_row(a.in[0] + (size_t)m * DM, a.in[1], XN + (size_t)m * DM, nullptr, F.lane);
}

__device__ __forceinline__ void prep_gdn(const Ctx& F, const Args& a, int l) {
    const bf16* PROJ = (const bf16*)(F.ws + WS_PROJ);
    float* GQ = (float*)(F.ws + WS_GQ); float* GK = (float*)(F.ws + WS_GK); float* GV = (float*)(F.ws + WS_GV); float* GEG = (float*)(F.ws + WS_GEG); float* GBE = (float*)(F.ws + WS_GBE);
    const float* cw = a.in[3] + (size_t)l * 4 * 3072;
    for (int it = F.gw; it < 2048; it += F.NGW) {
        const int h = it & 7, ch = (it >> 3) & 63, b = it >> 9;
        const int t0 = ch * 32; const int c = 2 * F.lane;
        float w[3][4][2], hist[3][3][2];
#pragma unroll
        for (int p = 0; p < 3; ++p)
#pragma unroll
            for (int j = 0; j < 4; ++j) { const f32x2 ww = *(const f32x2*)(cw + j * 3072 + p * 1024 + h * 128 + c); w[p][j][0] = ww.x; w[p][j][1] = ww.y; }
#pragma unroll
        for (int p = 0; p < 3; ++p)
#pragma unroll
            for (int j = 0; j < 3; ++j) { const int t = t0 - 3 + j; unsigned x = 0u;
                if (t >= 0) x = *(const unsigned*)(PROJ + (size_t)(b * SEQ + t) * NINP + C_GQKV + p * 1024 + h * 128 + c);
                hist[p][j][0] = bflo(x); hist[p][j][1] = bfhi(x); }
        const float alog = a.in[4][l * 8 + h], dtb = a.in[5][l * 8 + h]; const float aexp = expf(alog);
        for (int tt = 0; tt < 32; ++tt) {
            const size_t tok = (size_t)(b * SEQ + t0 + tt);
            float o[3][2];
#pragma unroll
            for (int p = 0; p < 3; ++p) {
                const unsigned x = *(const unsigned*)(PROJ + tok * NINP + C_GQKV + p * 1024 + h * 128 + c);
                const float x0 = bflo(x), x1 = bfhi(x);
                const float y0 = w[p][0][0] * hist[p][0][0] + w[p][1][0] * hist[p][1][0] + w[p][2][0] * hist[p][2][0] + w[p][3][0] * x0;
                const float y1 = w[p][0][1] * hist[p][0][1] + w[p][1][1] * hist[p][1][1] + w[p][2][1] * hist[p][2][1] + w[p][3][1] * x1;
                hist[p][0][0] = hist[p][1][0]; hist[p][1][0] = hist[p][2][0]; hist[p][2][0] = x0;
                hist[p][0][1] = hist[p][1][1]; hist[p][1][1] = hist[p][2][1]; hist[p][2][1] = x1;
                o[p][0] = siluf_(y0); o[p][1] = siluf_(y1);
            }
            const float sq = wave_sum(o[0][0] * o[0][0] + o[0][1] * o[0][1]), sk = wave_sum(o[1][0] * o[1][0] + o[1][1] * o[1][1]);
            const float rq = 0.08838834764831845f / sqrtf(sq + 1e-6f), rk = 1.f / sqrtf(sk + 1e-6f);
            const size_t off = tok * 1024 + h * 128 + c;
            *(f32x2*)(GQ + off) = (f32x2){o[0][0] * rq, o[0][1] * rq};
            *(f32x2*)(GK + off) = (f32x2){o[1][0] * rk, o[1][1] * rk};
            *(f32x2*)(GV + off) = (f32x2){o[2][0], o[2][1]};
            if (F.lane == 0) {
                const float bl = bf1(PROJ[tok * NINP + C_GB + h]), al = bf1(PROJ[tok * NINP + C_GA + h]);
                GBE[tok * 8 + h] = sigmoidf_(bl);
                GEG[tok * 8 + h] = expf(-aexp * softplusf_(al + dtb));
            }
        }
    }
}

__device__ __forceinline__ float mix2(unsigned c, unsigned p, float mu0, float mu1, float& o1) {
    const float c0 = bflo(c), c1 = bfhi(c), p0 = bflo(p), p1 = bfhi(p);
    o1 = c1 + (p1 - c1) * mu1; return c0 + (p0 - c0) * mu0;
}
__device__ __forceinline__ void prep_rwkv(const Ctx& F, const Args& a, int l) {
    const bf16* PROJ = (const bf16*)(F.ws + WS_PROJ);
    float* RR = (float*)(F.ws + WS_RR); float* RW = (float*)(F.ws + WS_RW); float* RK = (float*)(F.ws + WS_RK); float* RV = (float*)(F.ws + WS_RV);
    float* RKK = (float*)(F.ws + WS_RKK); float* RKA = (float*)(F.ws + WS_RKA); float* RBON = (float*)(F.ws + WS_RBON);
    const float* mu = a.in[7] + (size_t)l * 3264; const float* w0 = a.in[8] + l * 1024; const float* wup = a.in[9] + (size_t)l * 96 * 1024;
    const float* a0 = a.in[10] + l * 1024; const float* aup = a.in[11] + (size_t)l * 96 * 1024; const float* kk_ = a.in[12] + l * 1024; const float* ka_ = a.in[13] + l * 1024; const float* rk_ = a.in[14] + l * 1024;
    LAS float* A1 = (LAS float*)F.lds; LAS float* A2 = A1 + 16 * 96;
    const int j = F.tid, c = 2 * j;
    const f32x2 mur = *(const f32x2*)(mu + c), muk = *(const f32x2*)(mu + 1024 + c), muv = *(const f32x2*)(mu + 2048 + c);
    const f32x2 w0v = *(const f32x2*)(w0 + c), a0v = *(const f32x2*)(a0 + c), kkv = *(const f32x2*)(kk_ + c), kav = *(const f32x2*)(ka_ + c), rkv = *(const f32x2*)(rk_ + c);
    for (int tile = F.vcu; tile < TOK / 16; tile += F.G) {
        __syncthreads();
        for (int e = F.tid; e < 16 * 192; e += NTHREADS) {
            const int tl = e / 192, i = e - tl * 192; const size_t tok = (size_t)tile * 16 + tl;
            const float cur = bf1(PROJ[tok * NINP + C_RF + 3072 + i]);
            const float prv = (tok & (SEQ - 1)) ? bf1(PROJ[(tok - 1) * NINP + C_RF + 3072 + i]) : 0.f;
            const float m = cur + (prv - cur) * mu[3072 + i];
            if (i < 96) A1[tl * 96 + i] = tanhf(m); else A2[tl * 96 + i - 96] = m;
        }
        __syncthreads();
        float accw[16][2], acca[16][2];
#pragma unroll
        for (int tl = 0; tl < 16; ++tl) { accw[tl][0] = 0.f; accw[tl][1] = 0.f; acca[tl][0] = 0.f; acca[tl][1] = 0.f; }
        for (int i = 0; i < 96; i += 4) {
            f32x2 wu[4], au[4];
#pragma unroll
            for (int q = 0; q < 4; ++q) { wu[q] = *(const f32x2*)(wup + (size_t)(i + q) * 1024 + c); au[q] = *(const f32x2*)(aup + (size_t)(i + q) * 1024 + c); }
#pragma unroll
            for (int tl = 0; tl < 16; ++tl) {
                const f32x4 x1 = *(const LAS f32x4*)(A1 + tl * 96 + i), x2 = *(const LAS f32x4*)(A2 + tl * 96 + i);
#pragma unroll
                for (int q = 0; q < 4; ++q) { accw[tl][0] += x1[q] * wu[q].x; accw[tl][1] += x1[q] * wu[q].y; acca[tl][0] += x2[q] * au[q].x; acca[tl][1] += x2[q] * au[q].y; }
            }
        }
#pragma unroll
        for (int tl = 0; tl < 16; ++tl) {
            const size_t tok = (size_t)tile * 16 + tl; const bool hp = (tok & (SEQ - 1)) != 0;
            const bf16* cp = PROJ + tok * NINP + C_RF + c; const bf16* pp = cp - NINP;
            const unsigned cr = *(const unsigned*)cp, ck = *(const unsigned*)(cp + 1024), cv = *(const unsigned*)(cp + 2048);
            const unsigned pr = hp ? *(const unsigned*)pp : 0u, pk = hp ? *(const unsigned*)(pp + 1024) : 0u, pv = hp ? *(const unsigned*)(pp + 2048) : 0u;
            float r1, k1, v1; const float r0 = mix2(cr, pr, mur.x, mur.y, r1), k0 = mix2(ck, pk, muk.x, muk.y, k1), v0 = mix2(cv, pv, muv.x, muv.y, v1);
            const float wp0 = w0v.x + accw[tl][0], wp1 = w0v.y + accw[tl][1];
            const float d0 = expf(-expf(-softplusf_(-wp0) - 0.5f)), d1 = expf(-expf(-softplusf_(-wp1) - 0.5f));
            const float aa0 = sigmoidf_(a0v.x + acca[tl][0]), aa1 = sigmoidf_(a0v.y + acca[tl][1]);
            const float q0 = k0 * kkv.x, q1 = k1 * kkv.y;
            float ss = q0 * q0 + q1 * q1;
#pragma unroll
            for (int o = 1; o < 32; o <<= 1) ss += __shfl_xor(ss, o);
            const float rn = 1.f / sqrtf(ss + 1e-6f); const float n0 = q0 * rn, n1 = q1 * rn;
            const float km0 = k0 * (1.f + (aa0 - 1.f) * kav.x), km1 = k1 * (1.f + (aa1 - 1.f) * kav.y);
            float bo = r0 * km0 * rkv.x + r1 * km1 * rkv.y;
#pragma unroll
            for (int o = 1; o < 32; o <<= 1) bo += __shfl_xor(bo, o);
            const size_t off = tok * 1024 + c;
            *(f32x2*)(RR + off) = (f32x2){r0, r1}; *(f32x2*)(RW + off) = (f32x2){d0, d1}; *(f32x2*)(RK + off) = (f32x2){km0, km1}; *(f32x2*)(RV + off) = (f32x2){v0, v1};
            *(f32x2*)(RKK + off) = (f32x2){-n0, -n1}; *(f32x2*)(RKA + off) = (f32x2){n0 * aa0, n1 * aa1};
            if ((F.lane & 31) == 0) RBON[tok * 16 + (c >> 6)] = bo;
        }
    }
}

#ifndef SCM
#define SCM 7
#endif
struct GStep { f32x4 k0, k1, q0, q1; float v, eg, be; };
__device__ __forceinline__ void gdn_load(GStep& s, const float* kp, const float* qp, const float* vp, const float* ep, const float* bp, int t) {
    s.k0 = *(const f32x4*)(kp + (size_t)t * 1024); s.k1 = *(const f32x4*)(kp + (size_t)t * 1024 + 4);
    s.q0 = *(const f32x4*)(qp + (size_t)t * 1024); s.q1 = *(const f32x4*)(qp + (size_t)t * 1024 + 4);
    s.v = vp[(size_t)t * 1024]; s.eg = ep[t * 8]; s.be = bp[t * 8];
}
__device__ __forceinline__ void gdn_step(const GStep& s, float (&S)[8], float* op, int t, bool wr) {
    float ks = (s.k0.x * S[0] + s.k0.y * S[1]) + (s.k0.z * S[2] + s.k0.w * S[3]) + ((s.k1.x * S[4] + s.k1.y * S[5]) + (s.k1.z * S[6] + s.k1.w * S[7]));
    ks = allred16(ks);
    const float cc = s.be * (s.v - s.eg * ks);
    S[0] = s.eg * S[0] + cc * s.k0.x; S[1] = s.eg * S[1] + cc * s.k0.y; S[2] = s.eg * S[2] + cc * s.k0.z; S[3] = s.eg * S[3] + cc * s.k0.w;
    S[4] = s.eg * S[4] + cc * s.k1.x; S[5] = s.eg * S[5] + cc * s.k1.y; S[6] = s.eg * S[6] + cc * s.k1.z; S[7] = s.eg * S[7] + cc * s.k1.w;
    float o = (s.q0.x * S[0] + s.q0.y * S[1]) + (s.q0.z * S[2] + s.q0.w * S[3]) + ((s.q1.x * S[4] + s.q1.y * S[5]) + (s.q1.z * S[6] + s.q1.w * S[7]));
    o = allred16(o);
    if (wr) op[(size_t)t * 1024] = o;
}
__device__ __forceinline__ void gdn_scan(const Ctx& F, int it) {
    const int bh = it >> 5, cgp = it & 31, b = bh >> 3, h = bh & 7, col = cgp * 4 + (F.lane >> 4), rg = F.lane & 15;
    const size_t base = (size_t)b * SEQ;
    const float* kp = (const float*)(F.ws + WS_GK) + base * 1024 + h * 128 + rg * 8;
    const float* qp = (const float*)(F.ws + WS_GQ) + base * 1024 + h * 128 + rg * 8;
    const float* vp = (const float*)(F.ws + WS_GV) + base * 1024 + h * 128 + col;
    const float* ep = (const float*)(F.ws + WS_GEG) + base * 8 + h; const float* bp = (const float*)(F.ws + WS_GBE) + base * 8 + h;
    float* op = (float*)(F.ws + WS_GO) + base * 1024 + h * 128 + col;
    float S[8] = {0.f, 0.f, 0.f, 0.f, 0.f, 0.f, 0.f, 0.f};
    const bool wr = rg == 0;
    GStep A[2], B[2];
#pragma unroll
    for (int j = 0; j < 2; ++j) gdn_load(A[j], kp, qp, vp, ep, bp, j);
    for (int t = 0; t < SEQ; t += 4) {
#pragma unroll
        for (int j = 0; j < 2; ++j) gdn_load(B[j], kp, qp, vp, ep, bp, t + 2 + j);
#pragma unroll
        for (int j = 0; j < 2; ++j) gdn_step(A[j], S, op, t + j, wr);
        const int tn = (t + 4 < SEQ) ? t + 4 : SEQ - 2;
#pragma unroll
        for (int j = 0; j < 2; ++j) gdn_load(A[j], kp, qp, vp, ep, bp, tn + j);
#pragma unroll
        for (int j = 0; j < 2; ++j) gdn_step(B[j], S, op, t + 2 + j, wr);
    }
}

struct RStep { f32x4 w0, w1, n0, n1, a0, a1, k0, k1, r0, r1; float v; };
__device__ __forceinline__ void rwkv_load(RStep& s, const float* wp, const float* np, const float* ap, const float* kp, const float* rp, const float* vp, int t) {
    const size_t o = (size_t)t * 1024;
    s.w0 = *(const f32x4*)(wp + o); s.w1 = *(const f32x4*)(wp + o + 4); s.n0 = *(const f32x4*)(np + o); s.n1 = *(const f32x4*)(np + o + 4);
    s.a0 = *(const f32x4*)(ap + o); s.a1 = *(const f32x4*)(ap + o + 4); s.k0 = *(const f32x4*)(kp + o); s.k1 = *(const f32x4*)(kp + o + 4);
    s.r0 = *(const f32x4*)(rp + o); s.r1 = *(const f32x4*)(rp + o + 4); s.v = vp[o];
}
__device__ __forceinline__ void rwkv_step(const RStep& s, float (&S)[8], float* op, int t, bool wr) {
    float sa = (S[0] * s.n0.x + S[1] * s.n0.y) + (S[2] * s.n0.z + S[3] * s.n0.w) + ((S[4] * s.n1.x + S[5] * s.n1.y) + (S[6] * s.n1.z + S[7] * s.n1.w));
    sa = allred8(sa);
    S[0] = S[0] * s.w0.x + sa * s.a0.x + s.v * s.k0.x; S[1] = S[1] * s.w0.y + sa * s.a0.y + s.v * s.k0.y;
    S[2] = S[2] * s.w0.z + sa * s.a0.z + s.v * s.k0.z; S[3] = S[3] * s.w0.w + sa * s.a0.w + s.v * s.k0.w;
    S[4] = S[4] * s.w1.x + sa * s.a1.x + s.v * s.k1.x; S[5] = S[5] * s.w1.y + sa * s.a1.y + s.v * s.k1.y;
    S[6] = S[6] * s.w1.z + sa * s.a1.z + s.v * s.k1.z; S[7] = S[7] * s.w1.w + sa * s.a1.w + s.v * s.k1.w;
    float y = (S[0] * s.r0.x + S[1] * s.r0.y) + (S[2] * s.r0.z + S[3] * s.r0.w) + ((S[4] * s.r1.x + S[5] * s.r1.y) + (S[6] * s.r1.z + S[7] * s.r1.w));
    y = allred8(y);
    if (wr) op[(size_t)t * 1024] = y;
}
__device__ __forceinline__ void rwkv_scan(const Ctx& F, int it) {
    const int bh = it >> 3, rgp = it & 7, b = bh >> 4, h = bh & 15, row = rgp * 8 + (F.lane >> 3), cg = F.lane & 7;
    const size_t base = (size_t)b * SEQ * 1024 + h * 64;
    const float* wp = (const float*)(F.ws + WS_RW) + base + cg * 8; const float* np = (const float*)(F.ws + WS_RKK) + base + cg * 8;
    const float* ap = (const float*)(F.ws + WS_RKA) + base + cg * 8; const float* kp = (const float*)(F.ws + WS_RK) + base + cg * 8;
    const float* rp = (const float*)(F.ws + WS_RR) + base + cg * 8; const float* vp = (const float*)(F.ws + WS_RV) + base + row;
    float* op = (float*)(F.ws + WS_RY) + base + row;
    float S[8] = {0.f, 0.f, 0.f, 0.f, 0.f, 0.f, 0.f, 0.f};
    const bool wr = cg == 0;
    RStep A, B;
    rwkv_load(A, wp, np, ap, kp, rp, vp, 0);
    for (int t = 0; t < SEQ; t += 2) {
        rwkv_load(B, wp, np, ap, kp, rp, vp, t + 1);
        rwkv_step(A, S, op, t, wr);
        const int tn = (t + 2 < SEQ) ? t + 2 : SEQ - 1;
        rwkv_load(A, wp, np, ap, kp, rp, vp, tn);
        rwkv_step(B, S, op, t + 1, wr);
    }
}

constexpr int S5_ROW = 132;
__device__ __forceinline__ void s5_scan(const Ctx& F, const Args& a, int l, int it, LAS float* sb) {
    const int b = it >> 6, g = it & 63, p = F.lane, tl = F.lane >> 4, c = F.lane & 15;
    const bf16* PROJ = (const bf16*)(F.ws + WS_PROJ); bf16* SY = (bf16*)(F.ws + WS_SY);
    const size_t gp = ((size_t)l * 64 + g) * 64 + p;
    const float dt = expf(a.in[19][l * 64 + g]); const float are = a.in[17][gp], aim = a.in[18][gp];
    const float mag = expf(are * dt), abr = mag * cosf(aim * dt), abi = mag * sinf(aim * dt);
    const float den = are * are + aim * aim, cr = ((abr - 1.f) * are + abi * aim) / den, ci = (abi * are - (abr - 1.f) * aim) / den;
    float Bre[16], Bim[16];
#pragma unroll
    for (int q = 0; q < 4; ++q) { const f32x4 br = *(const f32x4*)(a.in[20] + gp * 16 + 4 * q), bi = *(const f32x4*)(a.in[21] + gp * 16 + 4 * q);
#pragma unroll
        for (int e = 0; e < 4; ++e) { Bre[4 * q + e] = cr * br[e] - ci * bi[e]; Bim[4 * q + e] = cr * bi[e] + ci * br[e]; } }
    LAS float* cl = sb + 4 * S5_ROW;
    { const size_t cb = ((size_t)l * 64 + g) * 16 * 64;
#pragma unroll
      for (int q = 0; q < 16; ++q) { cl[q * S5_ROW + p] = a.in[22][cb + q * 64 + p]; cl[q * S5_ROW + 64 + p] = a.in[23][cb + q * 64 + p]; } }
    const float dsk = a.in[24][l * 1024 + g * 16 + c];
    const bf16* up = PROJ + (size_t)b * SEQ * NINP + C_SU + g * 16;
    LAS float* ub = cl + 16 * S5_ROW;
    bf16 ucur = up[(size_t)tl * NINP + c], unxt = up[(size_t)(4 + tl) * NINP + c];
    float sr = 0.f, si = 0.f;
#define WFENCE() do { __builtin_amdgcn_fence(__ATOMIC_RELEASE, "wavefront"); __builtin_amdgcn_wave_barrier(); __builtin_amdgcn_fence(__ATOMIC_ACQUIRE, "wavefront"); } while (0)
    for (int t = 0; t < SEQ; t += 4) {
        const float uf = bf1(ucur);
        ub[F.lane] = uf;
        WFENCE();
        const int tn = (t + 8 < SEQ) ? t + 8 : t;
        const bf16 unn = up[(size_t)(tn + tl) * NINP + c];
#pragma unroll
        for (int j = 0; j < 4; ++j) {
            float br = 0.f, bi = 0.f;
#pragma unroll
            for (int q = 0; q < 4; ++q) { const f32x4 u4 = *(const LAS f32x4*)(ub + j * 16 + 4 * q);
#pragma unroll
                for (int e = 0; e < 4; ++e) { br += Bre[4 * q + e] * u4[e]; bi += Bim[4 * q + e] * u4[e]; } }
            const float nr = abr * sr - abi * si + br, ni = abr * si + abi * sr + bi; sr = nr; si = ni;
            sb[j * S5_ROW + p] = sr; sb[j * S5_ROW + 64 + p] = si;
        }
        WFENCE();
        float y0 = 0.f, y1 = 0.f;
#pragma unroll 2
        for (int q = 0; q < 16; ++q) { const f32x4 xr = *(const LAS f32x4*)(sb + tl * S5_ROW + 4 * q), xi = *(const LAS f32x4*)(sb + tl * S5_ROW + 64 + 4 * q);
            const f32x4 kr = *(const LAS f32x4*)(cl + c * S5_ROW + 4 * q), ki = *(const LAS f32x4*)(cl + c * S5_ROW + 64 + 4 * q);
            y0 += kr.x * xr.x + kr.y * xr.y + kr.z * xr.z + kr.w * xr.w;
            y1 += ki.x * xi.x + ki.y * xi.y + ki.z * xi.z + ki.w * xi.w; }
        WFENCE();
        const float y = (y0 - y1) + dsk * uf;
        SY[((size_t)b * SEQ + t + tl) * 1024 + g * 16 + c] = (bf16)f2bf(gelu_tanh(y));
        ucur = unxt; unxt = unn;
    }
#undef WFENCE
}

__device__ __forceinline__ void scan_phase(const Ctx& F, const Args& a, int l) {
    if (F.wave < 4) { if (SCM & 1) for (int it = F.vcu * 4 + F.wave; it < 1024; it += F.G * 4) gdn_scan(F, it); }
    else if (F.wave < 6) { if (SCM & 2) for (int it = F.vcu * 2 + (F.wave - 4); it < 512; it += F.G * 2) rwkv_scan(F, it); }
    else if (F.wave == 6) { if (SCM & 4) for (int it = F.vcu; it < 256; it += F.G) s5_scan(F, a, l, it, (LAS float*)F.lds); }
}

__device__ __forceinline__ void post_phase(const Ctx& F, const Args& a, int l) {
    const bf16* PROJ = (const bf16*)(F.ws + WS_PROJ); bf16* OBR = (bf16*)(F.ws + WS_OBR);
    const float* GO = (const float*)(F.ws + WS_GO); const float* RY = (const float*)(F.ws + WS_RY); const float* RV = (const float*)(F.ws + WS_RV); const float* RBON = (const float*)(F.ws + WS_RBON);
    const int c0 = 16 * F.lane;
    float nw[16], lw[16], lb[16];
#pragma unroll
    for (int e = 0; e < 16; ++e) { nw[e] = a.in[6][l * 128 + (c0 & 127) + e]; lw[e] = a.in[15][l * 1024 + c0 + e]; lb[e] = a.in[16][l * 1024 + c0 + e]; }
    for (int tok = F.gw; tok < TOK; tok += F.NGW) {
        { float o[16];
#pragma unroll
          for (int q = 0; q < 4; ++q) { const f32x4 v = *(const f32x4*)(GO + (size_t)tok * 1024 + c0 + 4 * q); o[4 * q] = v.x; o[4 * q + 1] = v.y; o[4 * q + 2] = v.z; o[4 * q + 3] = v.w; }
          float ss = 0.f;
#pragma unroll
          for (int e = 0; e < 16; ++e) ss += o[e] * o[e];
          ss = allred8(ss);
          const float rs = 1.f / sqrtf(ss * (1.f / 128.f) + 1e-6f);
          float z[16]; { float z0[8], z1[8]; unpack8(*(const u32x4*)(PROJ + (size_t)tok * NINP + C_GZ + c0), z0); unpack8(*(const u32x4*)(PROJ + (size_t)tok * NINP + C_GZ + c0 + 8), z1);
#pragma unroll
              for (int e = 0; e < 8; ++e) { z[e] = z0[e]; z[8 + e] = z1[e]; } }
          float r0[8], r1[8];
#pragma unroll
          for (int e = 0; e < 8; ++e) { r0[e] = o[e] * rs * nw[e] * siluf_(z[e]); r1[e] = o[8 + e] * rs * nw[8 + e] * siluf_(z[8 + e]); }
          *(u32x4*)(OBR + (size_t)tok * 1024 + c0) = pack8(r0); *(u32x4*)(OBR + (size_t)tok * 1024 + c0 + 8) = pack8(r1); }
        { float y[16], v[16];
#pragma unroll
          for (int q = 0; q < 4; ++q) { const f32x4 t = *(const f32x4*)(RY + (size_t)tok * 1024 + c0 + 4 * q); y[4 * q] = t.x; y[4 * q + 1] = t.y; y[4 * q + 2] = t.z; y[4 * q + 3] = t.w;
              const f32x4 w = *(const f32x4*)(RV + (size_t)tok * 1024 + c0 + 4 * q); v[4 * q] = w.x; v[4 * q + 1] = w.y; v[4 * q + 2] = w.z; v[4 * q + 3] = w.w; }
          float s = 0.f;
#pragma unroll
          for (int e = 0; e < 16; ++e) s += y[e];
          s += dppf<0xB1>(s); s += dppf<0x4E>(s);
          const float mean = s * (1.f / 64.f); float q2 = 0.f;
#pragma unroll
          for (int e = 0; e < 16; ++e) { const float d = y[e] - mean; q2 += d * d; }
          q2 += dppf<0xB1>(q2); q2 += dppf<0x4E>(q2);
          const float rs = 1.f / sqrtf(q2 * (1.f / 64.f) + 64e-5f);
          const float bon = RBON[(size_t)tok * 16 + (c0 >> 6)];
          float z[16]; { float z0[8], z1[8]; unpack8(*(const u32x4*)(PROJ + (size_t)tok * NINP + C_RZ + c0), z0); unpack8(*(const u32x4*)(PROJ + (size_t)tok * NINP + C_RZ + c0 + 8), z1);
#pragma unroll
              for (int e = 0; e < 8; ++e) { z[e] = z0[e]; z[8 + e] = z1[e]; } }
          float r0[8], r1[8];
#pragma unroll
          for (int e = 0; e < 8; ++e) { r0[e] = ((y[e] - mean) * rs * lw[e] + lb[e] + bon * v[e]) * siluf_(z[e]); r1[e] = ((y[8 + e] - mean) * rs * lw[8 + e] + lb[8 + e] + bon * v[8 + e]) * siluf_(z[8 + e]); }
          bf16* ob = OBR + (size_t)TOK * 1024 + (size_t)tok * 1024 + c0;
          *(u32x4*)ob = pack8(r0); *(u32x4*)(ob + 8) = pack8(r1); }
    }
}

#ifndef PHM
#define PHM 0xFFFF
#endif
__global__ void __launch_bounds__(NTHREADS, 2) hybrid_fwd(Args a) {
    extern __shared__ __attribute__((aligned(16))) unsigned char lds_raw[];
    Ctx F;
    F.lds = (LAS unsigned char*)lds_raw; F.ws = a.ws;
    F.G = gridDim.x; { const int bx = blockIdx.x; F.vcu = (F.G % 8 == 0) ? (bx % 8) * (F.G / 8) + bx / 8 : bx; }
    F.NGW = F.G * NWAVES;
    cg::grid_group grid = cg::this_grid();
    bf16* XN = (bf16*)(a.ws + WS_XN); bf16* PROJ = (bf16*)(a.ws + WS_PROJ);
    for (int ph = a.ph_lo; ph < a.ph_hi; ++ph) {
        { int t_ = threadIdx.x; asm volatile("" : "+v"(t_)); F.tid = t_; F.lane = t_ & 63; F.wave = __builtin_amdgcn_readfirstlane(t_ >> 6); F.gw = F.vcu * NWAVES + F.wave; }
        if (ph == 0) { if (PHM & 1) phase0(F, a); }
        else {
            const int l = (ph - 1) / PH_PER_LAYER, k = (ph - 1) % PH_PER_LAYER;
            if (k == 0 && (PHM & 2)) {
                pg8::Gemm g{XN, (const bf16*)(a.ws + WS_WIN) + (size_t)l * NINP * DM, TOK, NINP, DM}; pg8::StaticOrder S; S.init(TOK, NINP, F.G, (int)blockIdx.x);
                pg8::EpiBf16<0> E{PROJ, NINP, nullptr, 0, 0, 1.f};
                pg8::gemm_phase<pg8::EpiBf16<0>, pg8::StaticOrder, true, true>(F.lds, g, S, E);
            } else if (k == 1) { if (PHM & 4) prep_gdn(F, a, l); if (PHM & 8) prep_rwkv(F, a, l); }
            else if (k == 2) { if (PHM & 16) scan_phase(F, a, l); }
            else if (k == 3 && (PHM & 32)) {
                if (PHM & 256) post_phase(F, a, l);
                __syncthreads();
                pg8::Gemm g{(const bf16*)(a.ws + WS_SY), (const bf16*)(a.ws + WS_WGLU) + (size_t)l * 1024 * 1024, TOK, 1024, 1024}; pg8::StaticOrder S; S.init(TOK, 1024, F.G, (int)blockIdx.x);
                pg8::EpiGlu E{(const bf16*)(a.ws + WS_SY), PROJ, a.in[26] + l * 1024, (bf16*)(a.ws + WS_OBR) + (size_t)2 * TOK * 1024};
                pg8::gemm_phase<pg8::EpiGlu, pg8::StaticOrder, true, true>(F.lds, g, S, E);
            } else if (k == 4 && (PHM & 64)) {
                pg8::Gemm g{(const bf16*)(a.ws + WS_OBR), (const bf16*)(a.ws + WS_WBR) + (size_t)l * 3 * DM * 1024, 3 * TOK, 3 * DM, 1024};
                pg8::BranchOrder S; S.base.init(TOK, DM, F.G, (int)blockIdx.x);
                pg8::EpiBranch E{PROJ, a.in[27] + (size_t)l * 3 * DM, (float*)(a.ws + WS_ACCF), (bf16*)(a.ws + WS_MRG)};
                pg8::gemm_phase<pg8::EpiBranch, pg8::BranchOrder, true, true>(F.lds, g, S, E);
            } else if (k == 5 && (PHM & 128)) {
                pg8::Gemm g{(const bf16*)(a.ws + WS_MRG), (const bf16*)(a.ws + WS_WOUT) + (size_t)l * DM * DM, TOK, DM, DM}; pg8::StaticOrder S; S.init(TOK, DM, F.G, (int)blockIdx.x);
                pg8::EpiResid E{l == 0 ? a.in[0] : a.out, a.out};
                pg8::gemm_phase<pg8::EpiResid, pg8::StaticOrder, true, true>(F.lds, g, S, E);
            } else if (k == 6) {
                if (l + 1 < DEPTH) { for (int m = F.gw; m < TOK; m += F.NGW) rms_row(a.out + (size_t)m * DM, a.in[1] + (size_t)(l + 1) * DM, XN + (size_t)m * DM, nullptr, F.lane); }
                else { for (int m = F.gw; m < TOK; m += F.NGW) rms_row(a.out + (size_t)m * DM, a.in[30], nullptr, a.out + (size_t)m * DM, F.lane); }
            }
        }
        if (ph + 1 < a.ph_hi) { __threadfence(); grid.sync(); __builtin_amdgcn_fence(__ATOMIC_ACQUIRE, "agent"); }
    }
}

#ifndef MK_MULTI
#define MK_MULTI 0
#endif
extern "C" void kernel_launch(void* const* d_in, const int* in_sizes, int n_in, void* d_out, int out_size, void* d_ws, size_t ws_size, hipStream_t stream) {
    static int grid = 0;
    if (grid == 0) {
        if (n_in != 31 || out_size != TOK * DM || ws_size < WS_END) { fprintf(stderr, "kernel_launch: unexpected shapes (n_in %d out %d ws %zu)\n", n_in, out_size, ws_size); grid = -1; return; }
        int dev = 0, cus = 0, per_cu = 0;
        hipGetDevice(&dev); hipDeviceGetAttribute(&cus, hipDeviceAttributeMultiprocessorCount, dev);
        if (hipFuncSetAttribute((const void*)hybrid_fwd, hipFuncAttributeMaxDynamicSharedMemorySize, LDS_BYTES) != hipSuccess) { fprintf(stderr, "kernel_launch: hipFuncSetAttribute failed\n"); grid = -1; return; }
        if (hipOccupancyMaxActiveBlocksPerMultiprocessor(&per_cu, (const void*)hybrid_fwd, NTHREADS, LDS_BYTES) != hipSuccess || per_cu < 1) per_cu = 1;
        (void)hipGetLastError();
        grid = cus * per_cu;
        fprintf(stderr, "kernel_launch: grid %d (cus %d x %d)\n", grid, cus, per_cu);
    }
    if (grid < 0) return;
    Args a{};
    for (int i = 0; i < 31; ++i) a.in[i] = (const float*)d_in[i];
    a.out = (float*)d_out; a.ws = (unsigned char*)d_ws;
#if MK_MULTI
    for (int ph = 0; ph < NPHASES; ++ph) { a.ph_lo = ph; a.ph_hi = ph + 1; hipLaunchKernelGGL(hybrid_fwd, dim3(grid), dim3(NTHREADS), LDS_BYTES, stream, a); }
#else
    a.ph_lo = 0; a.ph_hi = NPHASES;
    void* args[] = {&a};
    const hipError_t e = hipLaunchCooperativeKernel((const void*)hybrid_fwd, dim3(grid), dim3(NTHREADS), args, LDS_BYTES, stream);
    if (e != hipSuccess) fprintf(stderr, "kernel_launch: cooperative launch failed: %s (grid %d)\n", hipGetErrorString(e), grid);
#endif
}
```

```cpp
#include <hip/hip_runtime.h>
#include <hip/hip_cooperative_groups.h>
#include <cstdio>
#include <cstdint>
namespace cg = cooperative_groups;
namespace pg8 {
#define PG8_LAS __attribute__((address_space(3)))
typedef unsigned short bf16_t;
typedef short bf16x8 __attribute__((ext_vector_type(8)));
typedef float f32x4 __attribute__((ext_vector_type(4)));
typedef unsigned u32x4 __attribute__((ext_vector_type(4)));
constexpr int BM = 256, BK = 64, HALF = 128, HTB = HALF * BK * 2  , STAGE_BYTES = 8 * HTB, NXCD = 8, WGM = 8;

__host__ __device__ __forceinline__ int lds_byte(int r, int c) { const int st = (r >> 4) * 2 + (c >> 5), rr = r & 15, cc = c & 31, ob = rr * 64 + cc * 2; return st * 1024 + (ob ^ (((ob >> 9) & 1) << 5)); }
__host__ __device__ __forceinline__ void stage_rc(int b, int& R, int& C) { const int st = b / 1024, sb = b % 1024, swz = sb ^ (((sb >> 9) & 1) << 5); R = (st >> 1) * 16 + swz / 64; C = (st & 1) * 32 + (swz % 64) / 2; }
__host__ __device__ __forceinline__ int perm32(int rho) { const int n = rho >> 4, i = rho & 15; return 8 * (i >> 2) + 4 * n + (i & 3); }

struct Unit { int pm, pn; };
struct Gemm { const bf16_t* A; const bf16_t* Bt; int M, N, K; };

struct StaticOrder {
    int nM, nN, nwg, G, c;
    __host__ __device__ void init(int M, int N, int G_, int c_) { nM = M / BM; nN = N / BM; nwg = nM * nN; G = G_; c = c_; }
    __host__ __device__ bool next(int i, Unit& u) const {
        const long L = (long)i * G + c; if (L >= nwg) return false;
        int wgid = (int)L; { const int q = nwg / NXCD, r = nwg % NXCD, xcd = wgid % NXCD, off = wgid / NXCD; wgid = (xcd < r ? xcd * (q + 1) : r * (q + 1) + (xcd - r) * q) + off; }
        const int nig = WGM * nN, gid = wgid / nig, fm = gid * WGM, gsz = (nM - fm) < WGM ? (nM - fm) : WGM;
        u.pm = fm + ((wgid % nig) % gsz); u.pn = (wgid % nig) / gsz; return true;
    }
    __device__ __forceinline__ void a_ready(const Unit&) const {}
    __device__ __forceinline__ void done(const Unit&) const {}
};

__device__ __forceinline__ unsigned cvt_pk_bf16(float lo, float hi) { unsigned r; asm volatile("v_cvt_pk_bf16_f32 %0, %1, %2" : "=v"(r) : "v"(lo), "v"(hi)); return r; }
typedef float f32x2 __attribute__((ext_vector_type(2)));
__device__ __forceinline__ f32x2 gelu_pk(f32x2 v) {
    const f32x2 av = __builtin_elementwise_abs(v), d = av * 0.2316418882f + 1.0f;
    f32x2 t; t.x = __builtin_amdgcn_rcpf(d.x); t.y = __builtin_amdgcn_rcpf(d.y);
    f32x2 q = t * 0.5307027145f + (-0.7265760135f); q = q * t + 0.7107068705f; q = q * t + (-0.142248368f); q = q * t + 0.127414796f; q = q * t;
    const f32x2 s = (v * v) * (-0.72134752044f);
    f32x2 e; e.x = __builtin_amdgcn_exp2f(s.x); e.y = __builtin_amdgcn_exp2f(s.y);
    const f32x2 m = v * (q * e), r = v - m;
    f32x2 o; o.x = v.x < 0.f ? m.x : r.x; o.y = v.y < 0.f ? m.y : r.y; return o;
}

template <int ACT  > struct EpiBf16 {
    static constexpr bool PERM = true, AFTER_DRAIN = false; static_assert(ACT == 0 || ACT == 1, "EpiBf16: ACT is 0 (none) or 1 (gelu_pk)");
    bf16_t* O; int ldc; const float* bias; int split_cols; size_t split_stride; float scale0;
    __device__ __forceinline__ void operator()(const f32x4 (&acc)[2][2][4][2], const Unit& u, int wr, int wc, int fr, int fq) const {
        const int row0 = u.pm * BM + wr * 64 + fr; int colt = u.pn * BM; bf16_t* base = O;
        float sc = 1.f; if (split_cols) { const int t = colt / split_cols; base += (size_t)t * split_stride; colt -= t * split_cols; if (t == 0) sc = scale0; }
        const int col0 = colt + wc * 32 + 8 * fq, bcol0 = u.pn * BM + wc * 32 + 8 * fq;
        f32x4 bv[2][2];
#pragma unroll
        for (int bj = 0; bj < 2; ++bj)
#pragma unroll
            for (int n = 0; n < 2; ++n) bv[bj][n] = bias ? *(const f32x4*)(bias + bcol0 + bj * HALF + 4 * n) : (f32x4){0.f, 0.f, 0.f, 0.f};
#pragma unroll
        for (int ai = 0; ai < 2; ++ai)
#pragma unroll
            for (int m = 0; m < 4; ++m) { bf16_t* rowp = base + (size_t)(row0 + ai * HALF + m * 16) * ldc + col0;
#pragma unroll
                for (int bj = 0; bj < 2; ++bj) { f32x4 v0 = acc[ai][bj][m][0] + bv[bj][0], v1 = acc[ai][bj][m][1] + bv[bj][1];
                    if (ACT == 1) { f32x2 a = gelu_pk((f32x2){v0[0], v0[1]}), b = gelu_pk((f32x2){v0[2], v0[3]}), c = gelu_pk((f32x2){v1[0], v1[1]}), d = gelu_pk((f32x2){v1[2], v1[3]});
                        v0 = (f32x4){a.x, a.y, b.x, b.y}; v1 = (f32x4){c.x, c.y, d.x, d.y}; }
                    v0 = v0 * sc; v1 = v1 * sc; u32x4 w; w.x = cvt_pk_bf16(v0[0], v0[1]); w.y = cvt_pk_bf16(v0[2], v0[3]); w.z = cvt_pk_bf16(v1[0], v1[1]); w.w = cvt_pk_bf16(v1[2], v1[3]);
                    *(u32x4*)(rowp + bj * HALF) = w; } }
    }
};

template <class Epi, class Sched, bool ALIGN_EPI = false, bool SP2 = false>
__device__ __forceinline__ void gemm_phase(PG8_LAS unsigned char* lds, const Gemm g, const Sched& S, const Epi& E) {
    int tid_ = threadIdx.x; asm volatile("" : "+v"(tid_));
    const int tid = tid_, wid = __builtin_amdgcn_readfirstlane(tid >> 6), lane = tid & 63, wr = wid >> 2, wc = wid & 3, fr = lane & 15, fq = lane >> 4;
    const int K = g.K, nt = K / BK;
    unsigned voffA[2], voffB[2];
#pragma unroll
    for (int i = 0; i < 2; ++i) { int R, C; stage_rc(tid * 16 + i * 8192, R, C); const int Rb = Epi::PERM ? ((R & ~31) + perm32(R & 31)) : R;
        voffA[i] = (unsigned)(R * K + C) * 2u; voffB[i] = (unsigned)(Rb * K + C) * 2u; }
    const size_t kstep = (size_t)(BK * 2);
    const size_t hstep = (size_t)HALF * K * 2;
    const size_t tstep = 2 * hstep;
    const unsigned ldsw = (unsigned)wid * 1024u;
    const int aoff = lds_byte(wr * 64 + fr, fq * 8), boff = lds_byte(wc * 32 + fr, fq * 8);
#define PG8_SA(b, h) (((b) * 2 + (h)) * HTB)
#define PG8_SB(b, h) ((4 + (b) * 2 + (h)) * HTB)
#define PG8_STAGE(bufoff, gbase, voff) do { _Pragma("unroll") for (int _i = 0; _i < 2; ++_i) \
        __builtin_amdgcn_global_load_lds((const unsigned*)((const char*)(gbase) + (voff)[_i]), (PG8_LAS unsigned*)(lds + (bufoff) + ldsw + _i * 8192), 16, 0, 0); } while (0)
#define PG8_LDA(dst, b, h) do { _Pragma("unroll") for (int m = 0; m < 4; ++m) _Pragma("unroll") for (int k = 0; k < 2; ++k) dst[m][k] = *(const PG8_LAS bf16x8*)(lds + PG8_SA(b, h) + aoff + m * 2048 + k * 1024); } while (0)
#define PG8_LDB(dst, b, h) do { _Pragma("unroll") for (int n = 0; n < 2; ++n) _Pragma("unroll") for (int k = 0; k < 2; ++k) dst[n][k] = *(const PG8_LAS bf16x8*)(lds + PG8_SB(b, h) + boff + n * 2048 + k * 1024); } while (0)
#define PG8_MMA(ai, bj, At, Bt) do { __builtin_amdgcn_s_setprio(1); _Pragma("unroll") for (int m = 0; m < 4; ++m) _Pragma("unroll") for (int n = 0; n < 2; ++n) _Pragma("unroll") for (int k = 0; k < 2; ++k) \
        acc[ai][bj][m][n] = __builtin_amdgcn_mfma_f32_16x16x32_bf16(Bt[n][k], At[m][k], acc[ai][bj][m][n], 0, 0, 0); __builtin_amdgcn_s_setprio(0); } while (0)
#define PG8_WAIT_V(n) asm volatile("s_waitcnt vmcnt(" #n ")" ::: "memory")
#define PG8_WAIT_L(n) asm volatile("s_waitcnt lgkmcnt(" #n ")" ::: "memory")
#define PG8_BAR __builtin_amdgcn_s_barrier()
#define PG8_SCHED __builtin_amdgcn_sched_barrier(0)
    Unit cur, nxt; int ui = 0;
    if (!S.next(0, cur)) return;
    f32x4 acc[2][2][4][2];
#pragma unroll
    for (int a = 0; a < 2; ++a)
#pragma unroll
        for (int b = 0; b < 2; ++b)
#pragma unroll
            for (int m = 0; m < 4; ++m)
#pragma unroll
                for (int n = 0; n < 2; ++n) acc[a][b][m][n] = (f32x4){0.f, 0.f, 0.f, 0.f};
    bf16x8 At[4][2], B0[2][2], B1[2][2];
    const char* cA = (const char*)g.A + (size_t)cur.pm * tstep; const char* cB = (const char*)g.Bt + (size_t)cur.pn * tstep;
    S.a_ready(cur);
    if constexpr (SP2) {
        PG8_STAGE(PG8_SB(0, 0), cB, voffB); PG8_STAGE(PG8_SB(0, 1), cB + hstep, voffB); PG8_STAGE(PG8_SA(0, 0), cA, voffA); PG8_STAGE(PG8_SA(0, 1), cA + hstep, voffA);
        if (wr == 1) PG8_BAR;
        PG8_WAIT_V(2); PG8_BAR;
        PG8_STAGE(PG8_SB(1, 0), cB + kstep, voffB); PG8_STAGE(PG8_SA(1, 0), cA + kstep, voffA); PG8_STAGE(PG8_SB(1, 1), cB + hstep + kstep, voffB);
        PG8_WAIT_V(6); PG8_BAR;
    } else {
        PG8_STAGE(PG8_SB(0, 0), cB, voffB); PG8_STAGE(PG8_SA(0, 0), cA, voffA); PG8_STAGE(PG8_SB(0, 1), cB + hstep, voffB); PG8_STAGE(PG8_SA(0, 1), cA + hstep, voffA);
        if (wr == 1) PG8_BAR;
        PG8_WAIT_V(4); PG8_BAR;
        PG8_STAGE(PG8_SB(1, 0), cB + kstep, voffB); PG8_STAGE(PG8_SA(1, 0), cA + kstep, voffA); PG8_STAGE(PG8_SB(1, 1), cB + hstep + kstep, voffB);
        PG8_WAIT_V(6); PG8_BAR;
    }
    for (;;) {
        const bool has_next = S.next(ui + 1, nxt);
        const char* nA = has_next ? (const char*)g.A + (size_t)nxt.pm * tstep : cA; const char* nB = has_next ? (const char*)g.Bt + (size_t)nxt.pn * tstep : cB;
        for (int t = 0; t < nt; t += 2) {
            const bool last = (t == nt - 2);
            const char* a1 = cA + (size_t)(t + 1) * kstep;
            const char* a2 = last ? nA : cA + (size_t)(t + 2) * kstep; const char* b2 = last ? nB : cB + (size_t)(t + 2) * kstep;
            const char* a3 = a2 + kstep; const char* b3 = b2 + kstep;
            if (last && has_next) S.a_ready(nxt);
            if constexpr (SP2) {
            PG8_LDB(B0, 0, 0); PG8_LDB(B1, 0, 1); PG8_SCHED; PG8_LDA(At, 0, 0); PG8_STAGE(PG8_SA(1, 1), a1 + hstep, voffA);
            PG8_WAIT_V(8); PG8_WAIT_L(0); PG8_BAR; PG8_MMA(0, 0, At, B0); PG8_MMA(0, 1, At, B1); PG8_BAR; PG8_SCHED;
            PG8_LDA(At, 0, 1); PG8_STAGE(PG8_SB(0, 0), b2, voffB); PG8_STAGE(PG8_SB(0, 1), b2 + hstep, voffB); PG8_STAGE(PG8_SA(0, 0), a2, voffA);
            PG8_WAIT_V(8); PG8_WAIT_L(0); PG8_BAR; PG8_MMA(1, 0, At, B0); PG8_MMA(1, 1, At, B1); PG8_BAR; PG8_SCHED;
            PG8_LDB(B0, 1, 0); PG8_LDB(B1, 1, 1); PG8_SCHED; PG8_LDA(At, 1, 0); PG8_STAGE(PG8_SA(0, 1), a2 + hstep, voffA);
            PG8_WAIT_V(8); PG8_WAIT_L(0); PG8_BAR; PG8_MMA(0, 0, At, B0); PG8_MMA(0, 1, At, B1); PG8_BAR; PG8_SCHED;
            PG8_LDA(At, 1, 1); PG8_STAGE(PG8_SB(1, 0), b3, voffB); PG8_STAGE(PG8_SB(1, 1), b3 + hstep, voffB); PG8_STAGE(PG8_SA(1, 0), a3, voffA);
            PG8_WAIT_V(8); PG8_WAIT_L(0); PG8_BAR; PG8_MMA(1, 0, At, B0); PG8_MMA(1, 1, At, B1); PG8_BAR; PG8_SCHED;
            } else {
            PG8_LDB(B0, 0, 0); PG8_SCHED; PG8_LDA(At, 0, 0); PG8_STAGE(PG8_SA(1, 1), a1 + hstep, voffA);
            PG8_WAIT_L(8); PG8_BAR; PG8_WAIT_L(0); PG8_MMA(0, 0, At, B0); PG8_BAR; PG8_SCHED;
            PG8_LDB(B1, 0, 1); PG8_STAGE(PG8_SB(0, 0), b2, voffB);
            PG8_BAR; PG8_WAIT_L(0); PG8_MMA(0, 1, At, B1); PG8_BAR;
            PG8_LDA(At, 0, 1); PG8_STAGE(PG8_SA(0, 0), a2, voffA);
            PG8_BAR; PG8_WAIT_L(0); PG8_MMA(1, 0, At, B0); PG8_BAR; PG8_SCHED;
            PG8_STAGE(PG8_SB(0, 1), b2 + hstep, voffB);
            PG8_WAIT_V(6); PG8_BAR; PG8_MMA(1, 1, At, B1); PG8_BAR;
            PG8_LDB(B0, 1, 0); PG8_SCHED; PG8_LDA(At, 1, 0); PG8_STAGE(PG8_SA(0, 1), a2 + hstep, voffA);
            PG8_WAIT_L(8); PG8_BAR; PG8_WAIT_L(0); PG8_MMA(0, 0, At, B0); PG8_BAR; PG8_SCHED;
            PG8_LDB(B1, 1, 1); PG8_STAGE(PG8_SB(1, 0), b3, voffB);
            PG8_BAR; PG8_WAIT_L(0); PG8_MMA(0, 1, At, B1); PG8_BAR;
            PG8_LDA(At, 1, 1); PG8_STAGE(PG8_SA(1, 0), a3, voffA);
            PG8_BAR; PG8_WAIT_L(0); PG8_MMA(1, 0, At, B0); PG8_BAR; PG8_SCHED;
            PG8_STAGE(PG8_SB(1, 1), b3 + hstep, voffB);
            PG8_WAIT_V(6); PG8_BAR; PG8_MMA(1, 1, At, B1); PG8_BAR;
            }
        }
        if constexpr (ALIGN_EPI) { if (wr == 0) PG8_BAR; }
        if constexpr (!Epi::AFTER_DRAIN) { E(acc, cur, wr, wc, fr, fq); S.done(cur); }
        if (!has_next) break;
#pragma unroll
        for (int a = 0; a < 2; ++a)
#pragma unroll
            for (int b = 0; b < 2; ++b)
#pragma unroll
                for (int m = 0; m < 4; ++m)
#pragma unroll
                    for (int n = 0; n < 2; ++n) acc[a][b][m][n] = (f32x4){0.f, 0.f, 0.f, 0.f};
        cur = nxt; cA = nA; cB = nB; ++ui;
        if constexpr (ALIGN_EPI) { if (wr == 1) PG8_BAR; }
    }
    PG8_WAIT_V(0);
    if constexpr (!ALIGN_EPI) { if (wr == 0) PG8_BAR; }
    PG8_BAR;
    if constexpr (Epi::AFTER_DRAIN) { E.fused(acc, cur, wr, wc, fr, fq, lds, wid, lane); S.done(cur); }
#undef PG8_SA
#undef PG8_SB
#undef PG8_STAGE
#undef PG8_LDA
#undef PG8_LDB
#undef PG8_MMA
#undef PG8_WAIT_V
#undef PG8_WAIT_L
#undef PG8_BAR
#undef PG8_SCHED
}
}

#define GAS __attribute__((address_space(1)))
#define LAS __attribute__((address_space(3)))
typedef unsigned short bf16;
typedef unsigned u32x4 __attribute__((ext_vector_type(4)));
typedef unsigned u32x2 __attribute__((ext_vector_type(2)));
typedef float f32x4 __attribute__((ext_vector_type(4)));
typedef float f32x2 __attribute__((ext_vector_type(2)));

constexpr int NBATCH = 4, SEQ = 2048, TOK = NBATCH * SEQ, DM = 2048, DEPTH = 4;
constexpr int NIN = 16592, NINP = 16640;
constexpr int C_GQKV = 0, C_GZ = 3072, C_GB = 4096, C_GA = 4104, C_RF = 4112, C_RZ = 7376, C_SU = 8400, C_SZ = 9424, C_GATE = 10448;
constexpr int NWAVES = 8, NTHREADS = 512;
constexpr int LDS_BYTES = 147456;
constexpr int PH_PER_LAYER = 7, NPHASES = 1 + DEPTH * PH_PER_LAYER;

constexpr size_t MiB = 1u << 20;
constexpr size_t WS_WIN = 0, WS_WGLU = 260 * MiB, WS_WBR = 268 * MiB, WS_WOUT = 316 * MiB, WS_XN = 348 * MiB, WS_PROJ = 380 * MiB;
constexpr size_t WS_GQ = 640 * MiB, WS_GK = 672 * MiB, WS_GV = 704 * MiB, WS_GEG = 736 * MiB, WS_GBE = 737 * MiB, WS_GO = 738 * MiB;
constexpr size_t WS_RR = 770 * MiB, WS_RW = 802 * MiB, WS_RK = 834 * MiB, WS_RV = 866 * MiB, WS_RKK = 898 * MiB, WS_RKA = 930 * MiB, WS_RBON = 962 * MiB, WS_RY = 963 * MiB;
constexpr size_t WS_SY = 995 * MiB, WS_OBR = 1011 * MiB, WS_ACCF = 1059 * MiB, WS_MRG = 1123 * MiB, WS_CTL = 1155 * MiB, WS_END = 1156 * MiB;
constexpr size_t CTL_ZERO_BYTES = 65536;
constexpr int MISC_OFF = 131072;
static_assert((size_t)DEPTH * NINP * DM * 2 == 260 * MiB && (size_t)TOK * NINP * 2 == 260 * MiB, "ws map");

__device__ __forceinline__ unsigned f2bf(float f) { unsigned u = __builtin_bit_cast(unsigned, f); return (u + 0x7fffu + ((u >> 16) & 1u)) >> 16; }
__device__ __forceinline__ unsigned pk2(float lo, float hi) { return f2bf(lo) | (f2bf(hi) << 16); }
__device__ __forceinline__ float bflo(unsigned w) { return __builtin_bit_cast(float, w << 16); }
__device__ __forceinline__ float bfhi(unsigned w) { return __builtin_bit_cast(float, w & 0xffff0000u); }
__device__ __forceinline__ float bf1(bf16 h) { return __builtin_bit_cast(float, (unsigned)h << 16); }
__device__ __forceinline__ float sigmoidf_(float x) { return 1.f / (1.f + __expf(-x)); }
__device__ __forceinline__ float siluf_(float x) { return x / (1.f + __expf(-x)); }
__device__ __forceinline__ float softplusf_(float x) { return x > 20.f ? x : log1pf(expf(x)); }
__device__ __forceinline__ float gelu_tanh(float y) { const float t = 0.7978845608028654f * (y + 0.044715f * y * y * y); const float th = 1.f - 2.f / (1.f + __expf(2.f * t)); return 0.5f * y * (1.f + th); }
template <int CTRL> __device__ __forceinline__ float dppf(float v) { return __builtin_bit_cast(float, __builtin_amdgcn_update_dpp(0, __builtin_bit_cast(int, v), CTRL, 0xF, 0xF, true)); }
__device__ __forceinline__ float allred8(float v) { v += dppf<0xB1>(v); v += dppf<0x4E>(v); v += dppf<0x141>(v); return v; }
__device__ __forceinline__ float allred16(float v) { v = allred8(v); v += dppf<0x140>(v); return v; }
__device__ __forceinline__ float wave_sum(float v) {
#pragma unroll
    for (int o = 1; o < 64; o <<= 1) v += __shfl_xor(v, o);
    return v;
}
__device__ __forceinline__ void unpack8(const u32x4 w, float (&f)[8]) { f[0] = bflo(w.x); f[1] = bfhi(w.x); f[2] = bflo(w.y); f[3] = bfhi(w.y); f[4] = bflo(w.z); f[5] = bfhi(w.z); f[6] = bflo(w.w); f[7] = bfhi(w.w); }
__device__ __forceinline__ u32x4 pack8(const float (&f)[8]) { u32x4 w; w.x = pk2(f[0], f[1]); w.y = pk2(f[2], f[3]); w.z = pk2(f[4], f[5]); w.w = pk2(f[6], f[7]); return w; }

namespace pg8 {
struct EpiGlu {
    static constexpr bool PERM = true, AFTER_DRAIN = false;
    const bf16* Y1; const bf16* PROJ; const float* bias; bf16* O;
    __device__ __forceinline__ void operator()(const f32x4 (&acc)[2][2][4][2], const Unit& u, int wr, int wc, int fr, int fq) const {
        int row0 = u.pm * BM + wr * 64 + fr, col0 = u.pn * BM + wc * 32 + 8 * fq;
        asm volatile("" : "+v"(row0), "+v"(col0));
#pragma unroll
        for (int bj = 0; bj < 2; ++bj) {
            const int col = col0 + bj * HALF;
            const f32x4 b0 = *(const f32x4*)(bias + col), b1 = *(const f32x4*)(bias + col + 4);
#pragma unroll
            for (int ai = 0; ai < 2; ++ai)
#pragma unroll
                for (int m = 0; m < 4; ++m) {
                    const size_t row = (size_t)(row0 + ai * HALF + m * 16);
                    const u32x4 y8 = *(const u32x4*)(Y1 + row * 1024 + col), z8 = *(const u32x4*)(PROJ + row * NINP + C_SZ + col);
                    float y[8], z[8], o[8]; unpack8(y8, y); unpack8(z8, z);
                    const f32x4 v0 = acc[ai][bj][m][0] + b0, v1 = acc[ai][bj][m][1] + b1;
                    const float a[8] = {v0[0], v0[1], v0[2], v0[3], v1[0], v1[1], v1[2], v1[3]};
#pragma unroll
                    for (int e = 0; e < 8; ++e) o[e] = y[e] * sigmoidf_(a[e]) * siluf_(z[e]);
                    *(u32x4*)(O + row * 1024 + col) = pack8(o);
                    asm volatile("" ::: "memory");
                }
        }
    }
};
struct EpiBranch {
    static constexpr bool PERM = true, AFTER_DRAIN = false;
    const bf16* PROJ; const float* gate_b; float* ACCF; bf16* MRG;
    __device__ __forceinline__ void operator()(const f32x4 (&acc)[2][2][4][2], const Unit& u, int wr, int wc, int fr, int fq) const {
        const int br = u.pm >> 5, pm = u.pm & 31, pn = u.pn & 7;
        int row0 = pm * BM + wr * 64 + fr, col0 = pn * BM + wc * 32 + 8 * fq;
        asm volatile("" : "+v"(row0), "+v"(col0));
#pragma unroll
        for (int bj = 0; bj < 2; ++bj) {
            const int col = col0 + bj * HALF;
            const f32x4 g0 = *(const f32x4*)(gate_b + br * DM + col), g1 = *(const f32x4*)(gate_b + br * DM + col + 4);
            const float gb[8] = {g0[0], g0[1], g0[2], g0[3], g1[0], g1[1], g1[2], g1[3]};
#pragma unroll
            for (int ai = 0; ai < 2; ++ai)
#pragma unroll
                for (int m = 0; m < 4; ++m) {
                    const size_t row = (size_t)(row0 + ai * HALF + m * 16);
                    const u32x4 l8 = *(const u32x4*)(PROJ + row * NINP + C_GATE + br * DM + col);
                    float gl[8], o[8]; unpack8(l8, gl);
                    const f32x4 v0 = acc[ai][bj][m][0], v1 = acc[ai][bj][m][1];
                    const float a[8] = {v0[0], v0[1], v0[2], v0[3], v1[0], v1[1], v1[2], v1[3]};
#pragma unroll
                    for (int e = 0; e < 8; ++e) o[e] = sigmoidf_(gl[e] + gb[e]) * a[e];
                    float* ap = ACCF + row * DM + col;
                    if (br > 0) { const f32x4 p0 = *(const f32x4*)ap, p1 = *(const f32x4*)(ap + 4);
                        o[0] += p0[0]; o[1] += p0[1]; o[2] += p0[2]; o[3] += p0[3]; o[4] += p1[0]; o[5] += p1[1]; o[6] += p1[2]; o[7] += p1[3]; }
                    if (br < 2) { *(f32x4*)ap = (f32x4){o[0], o[1], o[2], o[3]}; *(f32x4*)(ap + 4) = (f32x4){o[4], o[5], o[6], o[7]}; }
                    else *(u32x4*)(MRG + row * DM + col) = pack8(o);
                    asm volatile("" ::: "memory");
                }
        }
    }
};
struct EpiResid {
    static constexpr bool PERM = true, AFTER_DRAIN = false;
    const float* base; float* out;
    __device__ __forceinline__ void operator()(const f32x4 (&acc)[2][2][4][2], const Unit& u, int wr, int wc, int fr, int fq) const {
        int row0 = u.pm * BM + wr * 64 + fr, col0 = u.pn * BM + wc * 32 + 8 * fq;
        asm volatile("" : "+v"(row0), "+v"(col0));
#pragma unroll
        for (int ai = 0; ai < 2; ++ai)
#pragma unroll
            for (int m = 0; m < 4; ++m)
#pragma unroll
                for (int bj = 0; bj < 2; ++bj) {
                    const size_t off = (size_t)(row0 + ai * HALF + m * 16) * DM + col0 + bj * HALF;
                    const f32x4 p0 = *(const f32x4*)(base + off), p1 = *(const f32x4*)(base + off + 4);
                    *(f32x4*)(out + off) = p0 + acc[ai][bj][m][0]; *(f32x4*)(out + off + 4) = p1 + acc[ai][bj][m][1];
                }
    }
};
struct BranchOrder {
    StaticOrder base;
    __device__ bool next(int i, Unit& u) const { Unit t; const int r = i / 3, br = i - 3 * r; if (!base.next(r, t)) return false; u.pm = br * 32 + t.pm; u.pn = br * 8 + t.pn; return true; }
    __device__ __forceinline__ void a_ready(const Unit&) const {}
    __device__ __forceinline__ void done(const Unit&) const {}
};
}

#define XB_TMO      128
#define XB_XCNT(j)  (256  + 64 * (j))
#define XB_XSUB(j)  (1280 + 64 * (j))
#define XB_XGEN(j)  (2304 + 64 * (j))
#define XB_TOP      3328
#define XB_TOPGEN   3392
#define XCD_BAR_WORDS 3456
#define XB_SPIN_CAP (1u << 18)

__device__ __forceinline__ unsigned xb_ld(unsigned* p)              { return __hip_atomic_load(p, __ATOMIC_RELAXED, __HIP_MEMORY_SCOPE_AGENT); }
__device__ __forceinline__ unsigned xb_add(unsigned* p, unsigned v) { return __hip_atomic_fetch_add(p, v, __ATOMIC_RELAXED, __HIP_MEMORY_SCOPE_AGENT); }
__device__ __forceinline__ unsigned xb_xcc_id() { return (unsigned)__builtin_amdgcn_s_getreg((3 << 11) | 20) & 0xFu; }
#define XB_SPIN(cond, bar) do { unsigned _sp = 0; while (cond) { __builtin_amdgcn_s_sleep(1); \
    if ((++_sp & 255u) == 0u) { if (xb_ld(&(bar)[XB_TMO])) break; if (_sp > XB_SPIN_CAP) { atomicAdd(&(bar)[XB_TMO], 1u); break; } } } } while (0)

struct XcdBarrier {
    unsigned* bar; unsigned x;
    volatile LAS unsigned* st;
};

__device__ __forceinline__ XcdBarrier xcd_barrier_post(unsigned* bar, volatile LAS unsigned* st) {
    XcdBarrier b; b.bar = bar; b.x = xb_xcc_id(); b.st = st;
    if (threadIdx.x == 0) (void)xb_add(&bar[XB_XCNT(b.x)], 1u);
    return b;
}
__device__ __forceinline__ void xcd_barrier_complete(unsigned* bar, unsigned x, unsigned& nloc, unsigned& nx) {
    const unsigned G = gridDim.x * gridDim.y * gridDim.z;
    unsigned sum, cnt, mine, sp = 0u;
    for (;;) {
        sum = 0u; cnt = 0u; mine = 0u;
#pragma unroll
        for (unsigned j = 0; j < 16; ++j) { const unsigned c = xb_ld(&bar[XB_XCNT(j)]); sum += c; cnt += (c > 0u) ? 1u : 0u; mine = (j == x) ? c : mine; }
        if (sum == G) break;
        __builtin_amdgcn_s_sleep(1);
        if ((++sp & 255u) == 0u) { if (xb_ld(&bar[XB_TMO])) break; if (sp > XB_SPIN_CAP) { atomicAdd(&bar[XB_TMO], 1u); break; } }
    }
    nloc = mine > 0u ? mine : 1u; nx = cnt > 0u ? cnt : 1u;
}

__device__ __forceinline__ void xcd_barrier(const XcdBarrier& b) {
    asm volatile("s_waitcnt vmcnt(0)" ::: "memory");
    __syncthreads();
    if (threadIdx.x == 0) {
        unsigned* bar = b.bar;
        __builtin_amdgcn_s_waitcnt(0);
        unsigned nloc = b.st[0], nx = b.st[1];
        if (nloc == 0u) { xcd_barrier_complete(bar, b.x, nloc, nx); b.st[0] = nloc; b.st[1] = nx; }
        const unsigned old = xb_add(&bar[XB_XSUB(b.x)], 1u);
        const unsigned gen = old / nloc;
        if (old + 1u == (gen + 1u) * nloc) {
            __builtin_amdgcn_fence(__ATOMIC_RELEASE, "agent");
            asm volatile("s_waitcnt vmcnt(0)" ::: "memory");
            const unsigned og = xb_add(&bar[XB_TOP], 1u);
            const unsigned tg = og / nx;
            if (og + 1u == (tg + 1u) * nx) xb_add(&bar[XB_TOPGEN], 1u);
            else XB_SPIN(xb_ld(&bar[XB_TOPGEN]) == tg, bar);
            __builtin_amdgcn_fence(__ATOMIC_ACQUIRE, "agent");
            xb_add(&bar[XB_XGEN(b.x)], 1u);
            asm volatile("s_waitcnt vmcnt(0)" ::: "memory");
        } else {
            XB_SPIN(xb_ld(&bar[XB_XGEN(b.x)]) == gen, bar);
            __builtin_amdgcn_fence(__ATOMIC_ACQUIRE, "agent");
            asm volatile("s_waitcnt vmcnt(0)" ::: "memory");
        }
    }
    __syncthreads();
}

struct Args { const float* in[31]; float* out; unsigned char* ws; int ph_lo, ph_hi; };
struct Ctx { int tid, lane, wave, vcu, G, gw, NGW; LAS unsigned char* lds; unsigned char* ws; };

__device__ __forceinline__ void transpose_item(const float* W, int K, int N, bf16* WT, LAS float* scr, int kb, int nb, int lane) {
    const int k0 = 64 * kb, n0 = 32 * nb, n = n0 + (lane & 31); const bool nv = n < N;
#pragma unroll 8
    for (int i = 0; i < 32; ++i) { const int kk = 2 * i + (lane >> 5); scr[kk * 33 + (lane & 31)] = nv ? W[(size_t)(k0 + kk) * N + n] : 0.f; }
    asm volatile("s_waitcnt lgkmcnt(0)" ::: "memory");
    const int c = lane & 7;
#pragma unroll
    for (int j = 0; j < 4; ++j) { const int nn = (lane >> 3) + 8 * j; const LAS float* s = scr + (8 * c) * 33 + nn;
        u32x4 o; o.x = pk2(s[0 * 33], s[1 * 33]); o.y = pk2(s[2 * 33], s[3 * 33]); o.z = pk2(s[4 * 33], s[5 * 33]); o.w = pk2(s[6 * 33], s[7 * 33]);
        *(u32x4*)(WT + (size_t)(n0 + nn) * K + k0 + 8 * c) = o; }
    asm volatile("s_waitcnt lgkmcnt(0)" ::: "memory");
}

__device__ __forceinline__ void rms_row(const float* xrow, const float* w, bf16* obf, float* of32, int lane) {
    f32x4 v[8]; float s = 0.f;
#pragma unroll
    for (int j = 0; j < 8; ++j) { v[j] = *(const f32x4*)(xrow + 4 * lane + 256 * j); s += (v[j].x * v[j].x + v[j].y * v[j].y) + (v[j].z * v[j].z + v[j].w * v[j].w); }
    const float r = 1.f / sqrtf(wave_sum(s) * (1.f / DM) + 1e-6f);
#pragma unroll
    for (int j = 0; j < 8; ++j) { const f32x4 ww = *(const f32x4*)(w + 4 * lane + 256 * j); const f32x4 o = v[j] * r * ww;
        if (obf) { u32x2 p; p.x = pk2(o.x, o.y); p.y = pk2(o.z, o.w); *(u32x2*)(obf + 4 * lane + 256 * j) = p; }
        else *(f32x4*)(of32 + 4 * lane + 256 * j) = o; }
}

__device__ __forceinline__ void phase0(const Ctx& F, const Args& a) {
    LAS float* scr = (LAS float*)(F.lds + F.wave * 16384);
    constexpr int I_IN = 32 * 520, I_GLU = 16 * 32, I_BR = 16 * 64, I_OUT = 32 * 64, IL = I_IN + I_GLU + 3 * I_BR + I_OUT;
    bf16* WIN = (bf16*)(F.ws + WS_WIN); bf16* WGLU = (bf16*)(F.ws + WS_WGLU); bf16* WBR = (bf16*)(F.ws + WS_WBR); bf16* WOUT = (bf16*)(F.ws + WS_WOUT);
    for (int it = F.gw; it < DEPTH * IL; it += F.NGW) {
        const int l = it / IL; int r = it - l * IL;
        if (r < I_IN) { transpose_item(a.in[2] + (size_t)l * DM * NIN, DM, NIN, WIN + (size_t)l * NINP * DM, scr, r / 520, r % 520, F.lane); continue; } r -= I_IN;
        if (r < I_GLU) { transpose_item(a.in[25] + (size_t)l * 1024 * 1024, 1024, 1024, WGLU + (size_t)l * 1024 * 1024, scr, r / 32, r % 32, F.lane); continue; } r -= I_GLU;
        if (r < 3 * I_BR) { const int br = r / I_BR, r2 = r - br * I_BR;
            transpose_item(a.in[28] + (size_t)(l * 3 + br) * 1024 * DM, 1024, DM, WBR + (size_t)(l * 3 + br) * DM * 1024, scr, r2 / 64, r2 % 64, F.lane); continue; } r -= 3 * I_BR;
        transpose_item(a.in[29] + (size_t)l * DM * DM, DM, DM, WOUT + (size_t)l * DM * DM, scr, r / 64, r % 64, F.lane);
    }
    bf16* XN = (bf16*)(F.ws + WS_XN);
    for (int m = F.gw; m < TOK; m += F.NGW) rms_row(a.in[0] + (size_t)m * DM, a.in[1], XN + (size_t)m * DM, nullptr, F.lane);
}

__device__ __forceinline__ void prep_gdn(const Ctx& F, const Args& a, int l) {
    const bf16* PROJ = (const bf16*)(F.ws + WS_PROJ);
    float* GQ = (float*)(F.ws + WS_GQ); float* GK = (float*)(F.ws + WS_GK); float* GV = (float*)(F.ws + WS_GV); float* GEG = (float*)(F.ws + WS_GEG); float* GBE = (float*)(F.ws + WS_GBE);
    const float* cw = a.in[3] + (size_t)l * 4 * 3072;
    for (int it = F.gw; it < 2048; it += F.NGW) {
        const int h = it & 7, ch = (it >> 3) & 63, b = it >> 9;
        const int t0 = ch * 32; const int c = 2 * F.lane;
        float w[3][4][2], hist[3][3][2];
#pragma unroll
        for (int p = 0; p < 3; ++p)
#pragma unroll
            for (int j = 0; j < 4; ++j) { const f32x2 ww = *(const f32x2*)(cw + j * 3072 + p * 1024 + h * 128 + c); w[p][j][0] = ww.x; w[p][j][1] = ww.y; }
#pragma unroll
        for (int p = 0; p < 3; ++p)
#pragma unroll
            for (int j = 0; j < 3; ++j) { const int t = t0 - 3 + j; unsigned x = 0u;
                if (t >= 0) x = *(const unsigned*)(PROJ + (size_t)(b * SEQ + t) * NINP + C_GQKV + p * 1024 + h * 128 + c);
                hist[p][j][0] = bflo(x); hist[p][j][1] = bfhi(x); }
        const float alog = a.in[4][l * 8 + h], dtb = a.in[5][l * 8 + h]; const float aexp = expf(alog);
        for (int tt = 0; tt < 32; ++tt) {
            const size_t tok = (size_t)(b * SEQ + t0 + tt);
            float o[3][2];
#pragma unroll
            for (int p = 0; p < 3; ++p) {
                const unsigned x = *(const unsigned*)(PROJ + tok * NINP + C_GQKV + p * 1024 + h * 128 + c);
                const float x0 = bflo(x), x1 = bfhi(x);
                const float y0 = w[p][0][0] * hist[p][0][0] + w[p][1][0] * hist[p][1][0] + w[p][2][0] * hist[p][2][0] + w[p][3][0] * x0;
                const float y1 = w[p][0][1] * hist[p][0][1] + w[p][1][1] * hist[p][1][1] + w[p][2][1] * hist[p][2][1] + w[p][3][1] * x1;
                hist[p][0][0] = hist[p][1][0]; hist[p][1][0] = hist[p][2][0]; hist[p][2][0] = x0;
                hist[p][0][1] = hist[p][1][1]; hist[p][1][1] = hist[p][2][1]; hist[p][2][1] = x1;
                o[p][0] = siluf_(y0); o[p][1] = siluf_(y1);
            }
            const float sq = wave_sum(o[0][0] * o[0][0] + o[0][1] * o[0][1]), sk = wave_sum(o[1][0] * o[1][0] + o[1][1] * o[1][1]);
            const float rq = 0.08838834764831845f / sqrtf(sq + 1e-6f), rk = 1.f / sqrtf(sk + 1e-6f);
            const size_t off = tok * 1024 + h * 128 + c;
            *(f32x2*)(GQ + off) = (f32x2){o[0][0] * rq, o[0][1] * rq};
            *(f32x2*)(GK + off) = (f32x2){o[1][0] * rk, o[1][1] * rk};
            *(f32x2*)(GV + off) = (f32x2){o[2][0], o[2][1]};
            if (F.lane == 0) {
                const float bl = bf1(PROJ[tok * NINP + C_GB + h]), al = bf1(PROJ[tok * NINP + C_GA + h]);
                GBE[tok * 8 + h] = sigmoidf_(bl);
                GEG[tok * 8 + h] = expf(-aexp * softplusf_(al + dtb));
            }
        }
    }
}

__device__ __forceinline__ float mix2(unsigned c, unsigned p, float mu0, float mu1, float& o1) {
    const float c0 = bflo(c), c1 = bfhi(c), p0 = bflo(p), p1 = bfhi(p);
    o1 = c1 + (p1 - c1) * mu1; return c0 + (p0 - c0) * mu0;
}
__device__ __forceinline__ void prep_rwkv(const Ctx& F, const Args& a, int l) {
    const bf16* PROJ = (const bf16*)(F.ws + WS_PROJ);
    float* RR = (float*)(F.ws + WS_RR); float* RW = (float*)(F.ws + WS_RW); float* RK = (float*)(F.ws + WS_RK); float* RV = (float*)(F.ws + WS_RV);
    float* RKK = (float*)(F.ws + WS_RKK); float* RKA = (float*)(F.ws + WS_RKA); float* RBON = (float*)(F.ws + WS_RBON);
    const float* mu = a.in[7] + (size_t)l * 3264; const float* w0 = a.in[8] + l * 1024; const float* wup = a.in[9] + (size_t)l * 96 * 1024;
    const float* a0 = a.in[10] + l * 1024; const float* aup = a.in[11] + (size_t)l * 96 * 1024; const float* kk_ = a.in[12] + l * 1024; const float* ka_ = a.in[13] + l * 1024; const float* rk_ = a.in[14] + l * 1024;
    LAS float* A1 = (LAS float*)F.lds; LAS float* A2 = A1 + 16 * 96;
    const int j = F.tid, c = 2 * j;
    const f32x2 mur = *(const f32x2*)(mu + c), muk = *(const f32x2*)(mu + 1024 + c), muv = *(const f32x2*)(mu + 2048 + c);
    const f32x2 w0v = *(const f32x2*)(w0 + c), a0v = *(const f32x2*)(a0 + c), kkv = *(const f32x2*)(kk_ + c), kav = *(const f32x2*)(ka_ + c), rkv = *(const f32x2*)(rk_ + c);
    for (int tile = F.vcu; tile < TOK / 16; tile += F.G) {
        __syncthreads();
        for (int e = F.tid; e < 16 * 192; e += NTHREADS) {
            const int tl = e / 192, i = e - tl * 192; const size_t tok = (size_t)tile * 16 + tl;
            const float cur = bf1(PROJ[tok * NINP + C_RF + 3072 + i]);
            const float prv = (tok & (SEQ - 1)) ? bf1(PROJ[(tok - 1) * NINP + C_RF + 3072 + i]) : 0.f;
            const float m = cur + (prv - cur) * mu[3072 + i];
            if (i < 96) A1[tl * 96 + i] = tanhf(m); else A2[tl * 96 + i - 96] = m;
        }
        __syncthreads();
        float accw[16][2], acca[16][2];
#pragma unroll
        for (int tl = 0; tl < 16; ++tl) { accw[tl][0] = 0.f; accw[tl][1] = 0.f; acca[tl][0] = 0.f; acca[tl][1] = 0.f; }
        for (int i = 0; i < 96; i += 4) {
            f32x2 wu[4], au[4];
#pragma unroll
            for (int q = 0; q < 4; ++q) { wu[q] = *(const f32x2*)(wup + (size_t)(i + q) * 1024 + c); au[q] = *(const f32x2*)(aup + (size_t)(i + q) * 1024 + c); }
#pragma unroll
            for (int tl = 0; tl < 16; ++tl) {
                const f32x4 x1 = *(const LAS f32x4*)(A1 + tl * 96 + i), x2 = *(const LAS f32x4*)(A2 + tl * 96 + i);
#pragma unroll
                for (int q = 0; q < 4; ++q) { accw[tl][0] += x1[q] * wu[q].x; accw[tl][1] += x1[q] * wu[q].y; acca[tl][0] += x2[q] * au[q].x; acca[tl][1] += x2[q] * au[q].y; }
            }
        }
#pragma unroll
        for (int tl = 0; tl < 16; ++tl) {
            const size_t tok = (size_t)tile * 16 + tl; const bool hp = (tok & (SEQ - 1)) != 0;
            const bf16* cp = PROJ + tok * NINP + C_RF + c; const bf16* pp = cp - NINP;
            const unsigned cr = *(const unsigned*)cp, ck = *(const unsigned*)(cp + 1024), cv = *(const unsigned*)(cp + 2048);
            const unsigned pr = hp ? *(const unsigned*)pp : 0u, pk = hp ? *(const unsigned*)(pp + 1024) : 0u, pv = hp ? *(const unsigned*)(pp + 2048) : 0u;
            float r1, k1, v1; const float r0 = mix2(cr, pr, mur.x, mur.y, r1), k0 = mix2(ck, pk, muk.x, muk.y, k1), v0 = mix2(cv, pv, muv.x, muv.y, v1);
            const float wp0 = w0v.x + accw[tl][0], wp1 = w0v.y + accw[tl][1];
            const float d0 = expf(-expf(-softplusf_(-wp0) - 0.5f)), d1 = expf(-expf(-softplusf_(-wp1) - 0.5f));
            const float aa0 = sigmoidf_(a0v.x + acca[tl][0]), aa1 = sigmoidf_(a0v.y + acca[tl][1]);
            const float q0 = k0 * kkv.x, q1 = k1 * kkv.y;
            float ss = q0 * q0 + q1 * q1;
#pragma unroll
            for (int o = 1; o < 32; o <<= 1) ss += __shfl_xor(ss, o);
            const float rn = 1.f / sqrtf(ss + 1e-6f); const float n0 = q0 * rn, n1 = q1 * rn;
            const float km0 = k0 * (1.f + (aa0 - 1.f) * kav.x), km1 = k1 * (1.f + (aa1 - 1.f) * kav.y);
            float bo = r0 * km0 * rkv.x + r1 * km1 * rkv.y;
#pragma unroll
            for (int o = 1; o < 32; o <<= 1) bo += __shfl_xor(bo, o);
            const size_t off = tok * 1024 + c;
            *(f32x2*)(RR + off) = (f32x2){r0, r1}; *(f32x2*)(RW + off) = (f32x2){d0, d1}; *(f32x2*)(RK + off) = (f32x2){km0, km1}; *(f32x2*)(RV + off) = (f32x2){v0, v1};
            *(f32x2*)(RKK + off) = (f32x2){-n0, -n1}; *(f32x2*)(RKA + off) = (f32x2){n0 * aa0, n1 * aa1};
            if ((F.lane & 31) == 0) RBON[tok * 16 + (c >> 6)] = bo;
        }
    }
}

#ifndef SCM
#define SCM 7
#endif
struct GStep { f32x4 k0, k1, q0, q1; float v, eg, be; };
__device__ __forceinline__ void gdn_load(GStep& s, const float* kp, const float* qp, const float* vp, const float* ep, const float* bp, int t) {
    s.k0 = *(const f32x4*)(kp + (size_t)t * 1024); s.k1 = *(const f32x4*)(kp + (size_t)t * 1024 + 4);
    s.q0 = *(const f32x4*)(qp + (size_t)t * 1024); s.q1 = *(const f32x4*)(qp + (size_t)t * 1024 + 4);
    s.v = vp[(size_t)t * 1024]; s.eg = ep[t * 8]; s.be = bp[t * 8];
}
__device__ __forceinline__ void gdn_step(const GStep& s, float (&S)[8], float* op, int t, bool wr) {
    float ks = (s.k0.x * S[0] + s.k0.y * S[1]) + (s.k0.z * S[2] + s.k0.w * S[3]) + ((s.k1.x * S[4] + s.k1.y * S[5]) + (s.k1.z * S[6] + s.k1.w * S[7]));
    ks = allred16(ks);
    const float cc = s.be * (s.v - s.eg * ks);
    S[0] = s.eg * S[0] + cc * s.k0.x; S[1] = s.eg * S[1] + cc * s.k0.y; S[2] = s.eg * S[2] + cc * s.k0.z; S[3] = s.eg * S[3] + cc * s.k0.w;
    S[4] = s.eg * S[4] + cc * s.k1.x; S[5] = s.eg * S[5] + cc * s.k1.y; S[6] = s.eg * S[6] + cc * s.k1.z; S[7] = s.eg * S[7] + cc * s.k1.w;
    float o = (s.q0.x * S[0] + s.q0.y * S[1]) + (s.q0.z * S[2] + s.q0.w * S[3]) + ((s.q1.x * S[4] + s.q1.y * S[5]) + (s.q1.z * S[6] + s.q1.w * S[7]));
    o = allred16(o);
    if (wr) op[(size_t)t * 1024] = o;
}
__device__ __forceinline__ void gdn_scan(const Ctx& F, int it) {
    const int bh = it >> 5, cgp = it & 31, b = bh >> 3, h = bh & 7, col = cgp * 4 + (F.lane >> 4), rg = F.lane & 15;
    const size_t base = (size_t)b * SEQ;
    const float* kp = (const float*)(F.ws + WS_GK) + base * 1024 + h * 128 + rg * 8;
    const float* qp = (const float*)(F.ws + WS_GQ) + base * 1024 + h * 128 + rg * 8;
    const float* vp = (const float*)(F.ws + WS_GV) + base * 1024 + h * 128 + col;
    const float* ep = (const float*)(F.ws + WS_GEG) + base * 8 + h; const float* bp = (const float*)(F.ws + WS_GBE) + base * 8 + h;
    float* op = (float*)(F.ws + WS_GO) + base * 1024 + h * 128 + col;
    float S[8] = {0.f, 0.f, 0.f, 0.f, 0.f, 0.f, 0.f, 0.f};
    const bool wr = rg == 0;
    GStep A[2], B[2];
#pragma unroll
    for (int j = 0; j < 2; ++j) gdn_load(A[j], kp, qp, vp, ep, bp, j);
    for (int t = 0; t < SEQ; t += 4) {
#pragma unroll
        for (int j = 0; j < 2; ++j) gdn_load(B[j], kp, qp, vp, ep, bp, t + 2 + j);
#pragma unroll
        for (int j = 0; j < 2; ++j) gdn_step(A[j], S, op, t + j, wr);
        const int tn = (t + 4 < SEQ) ? t + 4 : SEQ - 2;
#pragma unroll
        for (int j = 0; j < 2; ++j) gdn_load(A[j], kp, qp, vp, ep, bp, tn + j);
#pragma unroll
        for (int j = 0; j < 2; ++j) gdn_step(B[j], S, op, t + 2 + j, wr);
    }
}

struct RStep { f32x4 w0, w1, n0, n1, a0, a1, k0, k1, r0, r1; float v; };
__device__ __forceinline__ void rwkv_load(RStep& s, const float* wp, const float* np, const float* ap, const float* kp, const float* rp, const float* vp, int t) {
    const size_t o = (size_t)t * 1024;
    s.w0 = *(const f32x4*)(wp + o); s.w1 = *(const f32x4*)(wp + o + 4); s.n0 = *(const f32x4*)(np + o); s.n1 = *(const f32x4*)(np + o + 4);
    s.a0 = *(const f32x4*)(ap + o); s.a1 = *(const f32x4*)(ap + o + 4); s.k0 = *(const f32x4*)(kp + o); s.k1 = *(const f32x4*)(kp + o + 4);
    s.r0 = *(const f32x4*)(rp + o); s.r1 = *(const f32x4*)(rp + o + 4); s.v = vp[o];
}
__device__ __forceinline__ void rwkv_step(const RStep& s, float (&S)[8], float* op, int t, bool wr) {
    float sa = (S[0] * s.n0.x + S[1] * s.n0.y) + (S[2] * s.n0.z + S[3] * s.n0.w) + ((S[4] * s.n1.x + S[5] * s.n1.y) + (S[6] * s.n1.z + S[7] * s.n1.w));
    sa = allred8(sa);
    S[0] = S[0] * s.w0.x + sa * s.a0.x + s.v * s.k0.x; S[1] = S[1] * s.w0.y + sa * s.a0.y + s.v * s.k0.y;
    S[2] = S[2] * s.w0.z + sa * s.a0.z + s.v * s.k0.z; S[3] = S[3] * s.w0.w + sa * s.a0.w + s.v * s.k0.w;
    S[4] = S[4] * s.w1.x + sa * s.a1.x + s.v * s.k1.x; S[5] = S[5] * s.w1.y + sa * s.a1.y + s.v * s.k1.y;
    S[6] = S[6] * s.w1.z + sa * s.a1.z + s.v * s.k1.z; S[7] = S[7] * s.w1.w + sa * s.a1.w + s.v * s.k1.w;
    float y = (S[0] * s.r0.x + S[1] * s.r0.y) + (S[2] * s.r0.z + S[3] * s.r0.w) + ((S[4] * s.r1.x + S[5] * s.r1.y) + (S[6] * s.r1.z + S[7] * s.r1.w));
    y = allred8(y);
    if (wr) op[(size_t)t * 1024] = y;
}
__device__ __forceinline__ void rwkv_scan(const Ctx& F, int it) {
    const int bh = it >> 3, rgp = it & 7, b = bh >> 4, h = bh & 15, row = rgp * 8 + (F.lane >> 3), cg = F.lane & 7;
    const size_t base = (size_t)b * SEQ * 1024 + h * 64;
    const float* wp = (const float*)(F.ws + WS_RW) + base + cg * 8; const float* np = (const float*)(F.ws + WS_RKK) + base + cg * 8;
    const float* ap = (const float*)(F.ws + WS_RKA) + base + cg * 8; const float* kp = (const float*)(F.ws + WS_RK) + base + cg * 8;
    const float* rp = (const float*)(F.ws + WS_RR) + base + cg * 8; const float* vp = (const float*)(F.ws + WS_RV) + base + row;
    float* op = (float*)(F.ws + WS_RY) + base + row;
    float S[8] = {0.f, 0.f, 0.f, 0.f, 0.f, 0.f, 0.f, 0.f};
    const bool wr = cg == 0;
    RStep A, B;
    rwkv_load(A, wp, np, ap, kp, rp, vp, 0);
    for (int t = 0; t < SEQ; t += 2) {
        rwkv_load(B, wp, np, ap, kp, rp, vp, t + 1);
        rwkv_step(A, S, op, t, wr);
        const int tn = (t + 2 < SEQ) ? t + 2 : SEQ - 1;
        rwkv_load(A, wp, np, ap, kp, rp, vp, tn);
        rwkv_step(B, S, op, t + 1, wr);
    }
}

constexpr int S5_ROW = 132;
__device__ __forceinline__ void s5_scan(const Ctx& F, const Args& a, int l, int it, LAS float* sb) {
    const int b = it >> 6, g = it & 63, p = F.lane, tl = F.lane >> 4, c = F.lane & 15;
    const bf16* PROJ = (const bf16*)(F.ws + WS_PROJ); bf16* SY = (bf16*)(F.ws + WS_SY);
    const size_t gp = ((size_t)l * 64 + g) * 64 + p;
    const float dt = expf(a.in[19][l * 64 + g]); const float are = a.in[17][gp], aim = a.in[18][gp];
    const float mag = expf(are * dt), abr = mag * cosf(aim * dt), abi = mag * sinf(aim * dt);
    const float den = are * are + aim * aim, cr = ((abr - 1.f) * are + abi * aim) / den, ci = (abi * are - (abr - 1.f) * aim) / den;
    float Bre[16], Bim[16];
#pragma unroll
    for (int q = 0; q < 4; ++q) { const f32x4 br = *(const f32x4*)(a.in[20] + gp * 16 + 4 * q), bi = *(const f32x4*)(a.in[21] + gp * 16 + 4 * q);
#pragma unroll
        for (int e = 0; e < 4; ++e) { Bre[4 * q + e] = cr * br[e] - ci * bi[e]; Bim[4 * q + e] = cr * bi[e] + ci * br[e]; } }
    LAS float* cl = sb + 4 * S5_ROW;
    { const size_t cb = ((size_t)l * 64 + g) * 16 * 64;
#pragma unroll
      for (int q = 0; q < 16; ++q) { cl[q * S5_ROW + p] = a.in[22][cb + q * 64 + p]; cl[q * S5_ROW + 64 + p] = a.in[23][cb + q * 64 + p]; } }
    const float dsk = a.in[24][l * 1024 + g * 16 + c];
    const bf16* up = PROJ + (size_t)b * SEQ * NINP + C_SU + g * 16;
    LAS float* ub = cl + 16 * S5_ROW;
    bf16 ucur = up[(size_t)tl * NINP + c], unxt = up[(size_t)(4 + tl) * NINP + c];
    float sr = 0.f, si = 0.f;
#define WFENCE() do { __builtin_amdgcn_fence(__ATOMIC_RELEASE, "wavefront"); __builtin_amdgcn_wave_barrier(); __builtin_amdgcn_fence(__ATOMIC_ACQUIRE, "wavefront"); } while (0)
    for (int t = 0; t < SEQ; t += 4) {
        const float uf = bf1(ucur);
        ub[F.lane] = uf;
        WFENCE();
        const int tn = (t + 8 < SEQ) ? t + 8 : t;
        const bf16 unn = up[(size_t)(tn + tl) * NINP + c];
#pragma unroll
        for (int j = 0; j < 4; ++j) {
            float br = 0.f, bi = 0.f;
#pragma unroll
            for (int q = 0; q < 4; ++q) { const f32x4 u4 = *(const LAS f32x4*)(ub + j * 16 + 4 * q);
#pragma unroll
                for (int e = 0; e < 4; ++e) { br += Bre[4 * q + e] * u4[e]; bi += Bim[4 * q + e] * u4[e]; } }
            const float nr = abr * sr - abi * si + br, ni = abr * si + abi * sr + bi; sr = nr; si = ni;
            sb[j * S5_ROW + p] = sr; sb[j * S5_ROW + 64 + p] = si;
        }
        WFENCE();
        float y0 = 0.f, y1 = 0.f;
#pragma unroll 2
        for (int q = 0; q < 16; ++q) { const f32x4 xr = *(const LAS f32x4*)(sb + tl * S5_ROW + 4 * q), xi = *(const LAS f32x4*)(sb + tl * S5_ROW + 64 + 4 * q);
            const f32x4 kr = *(const LAS f32x4*)(cl + c * S5_ROW + 4 * q), ki = *(const LAS f32x4*)(cl + c * S5_ROW + 64 + 4 * q);
            y0 += kr.x * xr.x + kr.y * xr.y + kr.z * xr.z + kr.w * xr.w;
            y1 += ki.x * xi.x + ki.y * xi.y + ki.z * xi.z + ki.w * xi.w; }
        WFENCE();
        const float y = (y0 - y1) + dsk * uf;
        SY[((size_t)b * SEQ + t + tl) * 1024 + g * 16 + c] = (bf16)f2bf(gelu_tanh(y));
        ucur = unxt; unxt = unn;
    }
#undef WFENCE
}

__device__ __forceinline__ void scan_phase(const Ctx& F, const Args& a, int l) {
    if (F.wave < 4) { if (SCM & 1) for (int it = F.vcu * 4 + F.wave; it < 1024; it += F.G * 4) gdn_scan(F, it); }
    else if (F.wave < 6) { if (SCM & 2) for (int it = F.vcu * 2 + (F.wave - 4); it < 512; it += F.G * 2) rwkv_scan(F, it); }
    else if (F.wave == 6) { if (SCM & 4) for (int it = F.vcu; it < 256; it += F.G) s5_scan(F, a, l, it, (LAS float*)F.lds); }
}

__device__ __forceinline__ void post_phase(const Ctx& F, const Args& a, int l) {
    const bf16* PROJ = (const bf16*)(F.ws + WS_PROJ); bf16* OBR = (bf16*)(F.ws + WS_OBR);
    const float* GO = (const float*)(F.ws + WS_GO); const float* RY = (const float*)(F.ws + WS_RY); const float* RV = (const float*)(F.ws + WS_RV); const float* RBON = (const float*)(F.ws + WS_RBON);
    const int c0 = 16 * F.lane;
    float nw[16], lw[16], lb[16];
#pragma unroll
    for (int e = 0; e < 16; ++e) { nw[e] = a.in[6][l * 128 + (c0 & 127) + e]; lw[e] = a.in[15][l * 1024 + c0 + e]; lb[e] = a.in[16][l * 1024 + c0 + e]; }
    for (int tok = F.gw; tok < TOK; tok += F.NGW) {
        { float o[16];
#pragma unroll
          for (int q = 0; q < 4; ++q) { const f32x4 v = *(const f32x4*)(GO + (size_t)tok * 1024 + c0 + 4 * q); o[4 * q] = v.x; o[4 * q + 1] = v.y; o[4 * q + 2] = v.z; o[4 * q + 3] = v.w; }
          float ss = 0.f;
#pragma unroll
          for (int e = 0; e < 16; ++e) ss += o[e] * o[e];
          ss = allred8(ss);
          const float rs = 1.f / sqrtf(ss * (1.f / 128.f) + 1e-6f);
          float z[16]; { float z0[8], z1[8]; unpack8(*(const u32x4*)(PROJ + (size_t)tok * NINP + C_GZ + c0), z0); unpack8(*(const u32x4*)(PROJ + (size_t)tok * NINP + C_GZ + c0 + 8), z1);
#pragma unroll
              for (int e = 0; e < 8; ++e) { z[e] = z0[e]; z[8 + e] = z1[e]; } }
          float r0[8], r1[8];
#pragma unroll
          for (int e = 0; e < 8; ++e) { r0[e] = o[e] * rs * nw[e] * siluf_(z[e]); r1[e] = o[8 + e] * rs * nw[8 + e] * siluf_(z[8 + e]); }
          *(u32x4*)(OBR + (size_t)tok * 1024 + c0) = pack8(r0); *(u32x4*)(OBR + (size_t)tok * 1024 + c0 + 8) = pack8(r1); }
        { float y[16], v[16];
#pragma unroll
          for (int q = 0; q < 4; ++q) { const f32x4 t = *(const f32x4*)(RY + (size_t)tok * 1024 + c0 + 4 * q); y[4 * q] = t.x; y[4 * q + 1] = t.y; y[4 * q + 2] = t.z; y[4 * q + 3] = t.w;
              const f32x4 w = *(const f32x4*)(RV + (size_t)tok * 1024 + c0 + 4 * q); v[4 * q] = w.x; v[4 * q + 1] = w.y; v[4 * q + 2] = w.z; v[4 * q + 3] = w.w; }
          float s = 0.f;
#pragma unroll
          for (int e = 0; e < 16; ++e) s += y[e];
          s += dppf<0xB1>(s); s += dppf<0x4E>(s);
          const float mean = s * (1.f / 64.f); float q2 = 0.f;
#pragma unroll
          for (int e = 0; e < 16; ++e) { const float d = y[e] - mean; q2 += d * d; }
          q2 += dppf<0xB1>(q2); q2 += dppf<0x4E>(q2);
          const float rs = 1.f / sqrtf(q2 * (1.f / 64.f) + 64e-5f);
          const float bon = RBON[(size_t)tok * 16 + (c0 >> 6)];
          float z[16]; { float z0[8], z1[8]; unpack8(*(const u32x4*)(PROJ + (size_t)tok * NINP + C_RZ + c0), z0); unpack8(*(const u32x4*)(PROJ + (size_t)tok * NINP + C_RZ + c0 + 8), z1);
#pragma unroll
              for (int e = 0; e < 8; ++e) { z[e] = z0[e]; z[8 + e] = z1[e]; } }
          float r0[8], r1[8];
#pragma unroll
          for (int e = 0; e < 8; ++e) { r0[e] = ((y[e] - mean) * rs * lw[e] + lb[e] + bon * v[e]) * siluf_(z[e]); r1[e] = ((y[8 + e] - mean) * rs * lw[8 + e] + lb[8 + e] + bon * v[8 + e]) * siluf_(z[8 + e]); }
          bf16* ob = OBR + (size_t)TOK * 1024 + (size_t)tok * 1024 + c0;
          *(u32x4*)ob = pack8(r0); *(u32x4*)(ob + 8) = pack8(r1); }
    }
}

#ifndef PHM
#define PHM 0xFFFF
#endif
#ifndef REPM
#define REPM 0
#endif
__global__ void __launch_bounds__(NTHREADS, 2) hybrid_fwd(Args a) {
    extern __shared__ __attribute__((aligned(16))) unsigned char lds_raw[];
    Ctx F;
    F.lds = (LAS unsigned char*)lds_raw; F.ws = a.ws;
    F.G = gridDim.x; { const int bx = blockIdx.x; F.vcu = (F.G % 8 == 0) ? (bx % 8) * (F.G / 8) + bx / 8 : bx; }
    F.NGW = F.G * NWAVES;
    cg::grid_group grid = cg::this_grid();
    if (threadIdx.x < 8) ((volatile LAS unsigned*)(F.lds + MISC_OFF))[threadIdx.x] = 0u;
    __syncthreads();
    XcdBarrier bar = xcd_barrier_post((unsigned*)(a.ws + WS_CTL), (volatile LAS unsigned*)(F.lds + MISC_OFF));
    bf16* XN = (bf16*)(a.ws + WS_XN); bf16* PROJ = (bf16*)(a.ws + WS_PROJ);
    int rep = 0;
    for (int ph = a.ph_lo; ph < a.ph_hi; ) {
        { int t_ = threadIdx.x; asm volatile("" : "+v"(t_)); F.tid = t_; F.lane = t_ & 63; F.wave = __builtin_amdgcn_readfirstlane(t_ >> 6); F.gw = F.vcu * NWAVES + F.wave; }
        if (ph == 0) { if (PHM & 1) phase0(F, a);
            if (REPM & 128) { if (!rep) { rep = 1; __syncthreads(); continue; } rep = 0; } }
        else {
            const int l = (ph - 1) / PH_PER_LAYER, k = (ph - 1) % PH_PER_LAYER;
            if (k == 0 && (PHM & 2)) {
                pg8::Gemm g{XN, (const bf16*)(a.ws + WS_WIN) + (size_t)l * NINP * DM, TOK, NINP, DM}; pg8::StaticOrder S; S.init(TOK, NINP, F.G, (int)blockIdx.x);
                pg8::EpiBf16<0> E{PROJ, NINP, nullptr, 0, 0, 1.f};
                pg8::gemm_phase<pg8::EpiBf16<0>, pg8::StaticOrder, true, true>(F.lds, g, S, E);
            } else if (k == 1) { if (PHM & 4) prep_gdn(F, a, l); if (PHM & 8) prep_rwkv(F, a, l); }
            else if (k == 2) { if (PHM & 16) scan_phase(F, a, l); }
            else if (k == 3 && (PHM & 32)) {
                if (PHM & 256) post_phase(F, a, l);
                __syncthreads();
                pg8::Gemm g{(const bf16*)(a.ws + WS_SY), (const bf16*)(a.ws + WS_WGLU) + (size_t)l * 1024 * 1024, TOK, 1024, 1024}; pg8::StaticOrder S; S.init(TOK, 1024, F.G, (int)blockIdx.x);
                pg8::EpiGlu E{(const bf16*)(a.ws + WS_SY), PROJ, a.in[26] + l * 1024, (bf16*)(a.ws + WS_OBR) + (size_t)2 * TOK * 1024};
                pg8::gemm_phase<pg8::EpiGlu, pg8::StaticOrder, true, true>(F.lds, g, S, E);
            } else if (k == 4 && (PHM & 64)) {
                pg8::Gemm g{(const bf16*)(a.ws + WS_OBR), (const bf16*)(a.ws + WS_WBR) + (size_t)l * 3 * DM * 1024, 3 * TOK, 3 * DM, 1024};
                pg8::BranchOrder S; S.base.init(TOK, DM, F.G, (int)blockIdx.x);
                pg8::EpiBranch E{PROJ, a.in[27] + (size_t)l * 3 * DM, (float*)(a.ws + WS_ACCF), (bf16*)(a.ws + WS_MRG)};
                pg8::gemm_phase<pg8::EpiBranch, pg8::BranchOrder, true, true>(F.lds, g, S, E);
            } else if (k == 5 && (PHM & 128)) {
                pg8::Gemm g{(const bf16*)(a.ws + WS_MRG), (const bf16*)(a.ws + WS_WOUT) + (size_t)l * DM * DM, TOK, DM, DM}; pg8::StaticOrder S; S.init(TOK, DM, F.G, (int)blockIdx.x);
                pg8::EpiResid E{l == 0 ? a.in[0] : a.out, a.out};
                pg8::gemm_phase<pg8::EpiResid, pg8::StaticOrder, true, true>(F.lds, g, S, E);
            } else if (k == 6) {
                if (l + 1 < DEPTH) { for (int m = F.gw; m < TOK; m += F.NGW) rms_row(a.out + (size_t)m * DM, a.in[1] + (size_t)(l + 1) * DM, XN + (size_t)m * DM, nullptr, F.lane); }
                else { for (int m = F.gw; m < TOK; m += F.NGW) rms_row(a.out + (size_t)m * DM, a.in[30], nullptr, a.out + (size_t)m * DM, F.lane); }
            }
            if (REPM && !rep && ((REPM >> k) & 1)) { rep = 1; __syncthreads(); continue; }
            rep = 0;
        }
        if (ph + 1 < a.ph_hi) {
            if (ph == 0) { __threadfence(); grid.sync(); __builtin_amdgcn_fence(__ATOMIC_ACQUIRE, "agent"); }
            else xcd_barrier(bar);
            if (REPM & 256) xcd_barrier(bar);
        }
        ++ph;
    }
}

#ifndef MK_MULTI
#define MK_MULTI 0
#endif
extern "C" void kernel_launch(void* const* d_in, const int* in_sizes, int n_in, void* d_out, int out_size, void* d_ws, size_t ws_size, hipStream_t stream) {
    static int grid = 0;
    if (grid == 0) {
        if (n_in != 31 || out_size != TOK * DM || ws_size < WS_END) { fprintf(stderr, "kernel_launch: unexpected shapes (n_in %d out %d ws %zu)\n", n_in, out_size, ws_size); grid = -1; return; }
        int dev = 0, cus = 0, per_cu = 0;
        hipGetDevice(&dev); hipDeviceGetAttribute(&cus, hipDeviceAttributeMultiprocessorCount, dev);
        if (hipFuncSetAttribute((const void*)hybrid_fwd, hipFuncAttributeMaxDynamicSharedMemorySize, LDS_BYTES) != hipSuccess) { fprintf(stderr, "kernel_launch: hipFuncSetAttribute failed\n"); grid = -1; return; }
        if (hipOccupancyMaxActiveBlocksPerMultiprocessor(&per_cu, (const void*)hybrid_fwd, NTHREADS, LDS_BYTES) != hipSuccess || per_cu < 1) per_cu = 1;
        (void)hipGetLastError();
        grid = cus * per_cu;
        fprintf(stderr, "kernel_launch: grid %d (cus %d x %d)\n", grid, cus, per_cu);
    }
    if (grid < 0) return;
    if (hipMemsetAsync((char*)d_ws + WS_CTL, 0, CTL_ZERO_BYTES, stream) != hipSuccess) { fprintf(stderr, "kernel_launch: memset failed\n"); return; }
    Args a{};
    for (int i = 0; i < 31; ++i) a.in[i] = (const float*)d_in[i];
    a.out = (float*)d_out; a.ws = (unsigned char*)d_ws;
#if MK_MULTI
    for (int ph = 0; ph < NPHASES; ++ph) { a.ph_lo = ph; a.ph_hi = ph + 1; hipLaunchKernelGGL(hybrid_fwd, dim3(grid), dim3(NTHREADS), LDS_BYTES, stream, a); }
#else
    a.ph_lo = 0; a.ph_hi = NPHASES;
    void* args[] = {&a};
    const hipError_t e = hipLaunchCooperativeKernel((const void*)hybrid_fwd, dim3(grid), dim3(NTHREADS), args, LDS_BYTES, stream);
    if (e != hipSuccess) fprintf(stderr, "kernel_launch: cooperative launch failed: %s (grid %d)\n", hipGetErrorString(e), grid);
#endif
}
```

```cpp
#include <hip/hip_runtime.h>
#include <hip/hip_cooperative_groups.h>
#include <cstdio>
#include <cstdint>
namespace cg = cooperative_groups;
namespace pg8 {
#define PG8_LAS __attribute__((address_space(3)))
typedef unsigned short bf16_t;
typedef short bf16x8 __attribute__((ext_vector_type(8)));
typedef float f32x4 __attribute__((ext_vector_type(4)));
typedef unsigned u32x4 __attribute__((ext_vector_type(4)));
constexpr int BM = 256, BK = 64, HALF = 128, HTB = HALF * BK * 2  , STAGE_BYTES = 8 * HTB, NXCD = 8, WGM = 8;

__host__ __device__ __forceinline__ int lds_byte(int r, int c) { const int st = (r >> 4) * 2 + (c >> 5), rr = r & 15, cc = c & 31, ob = rr * 64 + cc * 2; return st * 1024 + (ob ^ (((ob >> 9) & 1) << 5)); }
__host__ __device__ __forceinline__ void stage_rc(int b, int& R, int& C) { const int st = b / 1024, sb = b % 1024, swz = sb ^ (((sb >> 9) & 1) << 5); R = (st >> 1) * 16 + swz / 64; C = (st & 1) * 32 + (swz % 64) / 2; }
__host__ __device__ __forceinline__ int perm32(int rho) { const int n = rho >> 4, i = rho & 15; return 8 * (i >> 2) + 4 * n + (i & 3); }

struct Unit { int pm, pn; };
struct Gemm { const bf16_t* A; const bf16_t* Bt; int M, N, K; };

struct StaticOrder {
    int nM, nN, nwg, G, c;
    __host__ __device__ void init(int M, int N, int G_, int c_) { nM = M / BM; nN = N / BM; nwg = nM * nN; G = G_; c = c_; }
    __host__ __device__ bool next(int i, Unit& u) const {
        const long L = (long)i * G + c; if (L >= nwg) return false;
        int wgid = (int)L; { const int q = nwg / NXCD, r = nwg % NXCD, xcd = wgid % NXCD, off = wgid / NXCD; wgid = (xcd < r ? xcd * (q + 1) : r * (q + 1) + (xcd - r) * q) + off; }
        const int nig = WGM * nN, gid = wgid / nig, fm = gid * WGM, gsz = (nM - fm) < WGM ? (nM - fm) : WGM;
        u.pm = fm + ((wgid % nig) % gsz); u.pn = (wgid % nig) / gsz; return true;
    }
    __device__ __forceinline__ void a_ready(const Unit&) const {}
    __device__ __forceinline__ void done(const Unit&) const {}
};

__device__ __forceinline__ unsigned cvt_pk_bf16(float lo, float hi) { unsigned r; asm volatile("v_cvt_pk_bf16_f32 %0, %1, %2" : "=v"(r) : "v"(lo), "v"(hi)); return r; }
typedef float f32x2 __attribute__((ext_vector_type(2)));
__device__ __forceinline__ f32x2 gelu_pk(f32x2 v) {
    const f32x2 av = __builtin_elementwise_abs(v), d = av * 0.2316418882f + 1.0f;
    f32x2 t; t.x = __builtin_amdgcn_rcpf(d.x); t.y = __builtin_amdgcn_rcpf(d.y);
    f32x2 q = t * 0.5307027145f + (-0.7265760135f); q = q * t + 0.7107068705f; q = q * t + (-0.142248368f); q = q * t + 0.127414796f; q = q * t;
    const f32x2 s = (v * v) * (-0.72134752044f);
    f32x2 e; e.x = __builtin_amdgcn_exp2f(s.x); e.y = __builtin_amdgcn_exp2f(s.y);
    const f32x2 m = v * (q * e), r = v - m;
    f32x2 o; o.x = v.x < 0.f ? m.x : r.x; o.y = v.y < 0.f ? m.y : r.y; return o;
}

template <int ACT  > struct EpiBf16 {
    static constexpr bool PERM = true, AFTER_DRAIN = false; static_assert(ACT == 0 || ACT == 1, "EpiBf16: ACT is 0 (none) or 1 (gelu_pk)");
    bf16_t* O; int ldc; const float* bias; int split_cols; size_t split_stride; float scale0;
    __device__ __forceinline__ void operator()(const f32x4 (&acc)[2][2][4][2], const Unit& u, int wr, int wc, int fr, int fq) const {
        const int row0 = u.pm * BM + wr * 64 + fr; int colt = u.pn * BM; bf16_t* base = O;
        float sc = 1.f; if (split_cols) { const int t = colt / split_cols; base += (size_t)t * split_stride; colt -= t * split_cols; if (t == 0) sc = scale0; }
        const int col0 = colt + wc * 32 + 8 * fq, bcol0 = u.pn * BM + wc * 32 + 8 * fq;
        f32x4 bv[2][2];
#pragma unroll
        for (int bj = 0; bj < 2; ++bj)
#pragma unroll
            for (int n = 0; n < 2; ++n) bv[bj][n] = bias ? *(const f32x4*)(bias + bcol0 + bj * HALF + 4 * n) : (f32x4){0.f, 0.f, 0.f, 0.f};
#pragma unroll
        for (int ai = 0; ai < 2; ++ai)
#pragma unroll
            for (int m = 0; m < 4; ++m) { bf16_t* rowp = base + (size_t)(row0 + ai * HALF + m * 16) * ldc + col0;
#pragma unroll
                for (int bj = 0; bj < 2; ++bj) { f32x4 v0 = acc[ai][bj][m][0] + bv[bj][0], v1 = acc[ai][bj][m][1] + bv[bj][1];
                    if (ACT == 1) { f32x2 a = gelu_pk((f32x2){v0[0], v0[1]}), b = gelu_pk((f32x2){v0[2], v0[3]}), c = gelu_pk((f32x2){v1[0], v1[1]}), d = gelu_pk((f32x2){v1[2], v1[3]});
                        v0 = (f32x4){a.x, a.y, b.x, b.y}; v1 = (f32x4){c.x, c.y, d.x, d.y}; }
                    v0 = v0 * sc; v1 = v1 * sc; u32x4 w; w.x = cvt_pk_bf16(v0[0], v0[1]); w.y = cvt_pk_bf16(v0[2], v0[3]); w.z = cvt_pk_bf16(v1[0], v1[1]); w.w = cvt_pk_bf16(v1[2], v1[3]);
                    *(u32x4*)(rowp + bj * HALF) = w; } }
    }
};

template <class Epi, class Sched, bool ALIGN_EPI = false, bool SP2 = false>
__device__ __forceinline__ void gemm_phase(PG8_LAS unsigned char* lds, const Gemm g, const Sched& S, const Epi& E) {
    int tid_ = threadIdx.x; asm volatile("" : "+v"(tid_));
    const int tid = tid_, wid = __builtin_amdgcn_readfirstlane(tid >> 6), lane = tid & 63, wr = wid >> 2, wc = wid & 3, fr = lane & 15, fq = lane >> 4;
    const int K = g.K, nt = K / BK;
    unsigned voffA[2], voffB[2];
#pragma unroll
    for (int i = 0; i < 2; ++i) { int R, C; stage_rc(tid * 16 + i * 8192, R, C); const int Rb = Epi::PERM ? ((R & ~31) + perm32(R & 31)) : R;
        voffA[i] = (unsigned)(R * K + C) * 2u; voffB[i] = (unsigned)(Rb * K + C) * 2u; }
    const size_t kstep = (size_t)(BK * 2);
    const size_t hstep = (size_t)HALF * K * 2;
    const size_t tstep = 2 * hstep;
    const unsigned ldsw = (unsigned)wid * 1024u;
    const int aoff = lds_byte(wr * 64 + fr, fq * 8), boff = lds_byte(wc * 32 + fr, fq * 8);
#define PG8_SA(b, h) (((b) * 2 + (h)) * HTB)
#define PG8_SB(b, h) ((4 + (b) * 2 + (h)) * HTB)
#define PG8_STAGE(bufoff, gbase, voff) do { _Pragma("unroll") for (int _i = 0; _i < 2; ++_i) \
        __builtin_amdgcn_global_load_lds((const unsigned*)((const char*)(gbase) + (voff)[_i]), (PG8_LAS unsigned*)(lds + (bufoff) + ldsw + _i * 8192), 16, 0, 0); } while (0)
#define PG8_LDA(dst, b, h) do { _Pragma("unroll") for (int m = 0; m < 4; ++m) _Pragma("unroll") for (int k = 0; k < 2; ++k) dst[m][k] = *(const PG8_LAS bf16x8*)(lds + PG8_SA(b, h) + aoff + m * 2048 + k * 1024); } while (0)
#define PG8_LDB(dst, b, h) do { _Pragma("unroll") for (int n = 0; n < 2; ++n) _Pragma("unroll") for (int k = 0; k < 2; ++k) dst[n][k] = *(const PG8_LAS bf16x8*)(lds + PG8_SB(b, h) + boff + n * 2048 + k * 1024); } while (0)
#define PG8_MMA(ai, bj, At, Bt) do { __builtin_amdgcn_s_setprio(1); _Pragma("unroll") for (int m = 0; m < 4; ++m) _Pragma("unroll") for (int n = 0; n < 2; ++n) _Pragma("unroll") for (int k = 0; k < 2; ++k) \
        acc[ai][bj][m][n] = __builtin_amdgcn_mfma_f32_16x16x32_bf16(Bt[n][k], At[m][k], acc[ai][bj][m][n], 0, 0, 0); __builtin_amdgcn_s_setprio(0); } while (0)
#define PG8_WAIT_V(n) asm volatile("s_waitcnt vmcnt(" #n ")" ::: "memory")
#define PG8_WAIT_L(n) asm volatile("s_waitcnt lgkmcnt(" #n ")" ::: "memory")
#define PG8_BAR __builtin_amdgcn_s_barrier()
#define PG8_SCHED __builtin_amdgcn_sched_barrier(0)
    Unit cur, nxt; int ui = 0;
    if (!S.next(0, cur)) return;
    f32x4 acc[2][2][4][2];
#pragma unroll
    for (int a = 0; a < 2; ++a)
#pragma unroll
        for (int b = 0; b < 2; ++b)
#pragma unroll
            for (int m = 0; m < 4; ++m)
#pragma unroll
                for (int n = 0; n < 2; ++n) acc[a][b][m][n] = (f32x4){0.f, 0.f, 0.f, 0.f};
    bf16x8 At[4][2], B0[2][2], B1[2][2];
    const char* cA = (const char*)g.A + (size_t)cur.pm * tstep; const char* cB = (const char*)g.Bt + (size_t)cur.pn * tstep;
    S.a_ready(cur);
    if constexpr (SP2) {
        PG8_STAGE(PG8_SB(0, 0), cB, voffB); PG8_STAGE(PG8_SB(0, 1), cB + hstep, voffB); PG8_STAGE(PG8_SA(0, 0), cA, voffA); PG8_STAGE(PG8_SA(0, 1), cA + hstep, voffA);
        if (wr == 1) PG8_BAR;
        PG8_WAIT_V(2); PG8_BAR;
        PG8_STAGE(PG8_SB(1, 0), cB + kstep, voffB); PG8_STAGE(PG8_SA(1, 0), cA + kstep, voffA); PG8_STAGE(PG8_SB(1, 1), cB + hstep + kstep, voffB);
        PG8_WAIT_V(6); PG8_BAR;
    } else {
        PG8_STAGE(PG8_SB(0, 0), cB, voffB); PG8_STAGE(PG8_SA(0, 0), cA, voffA); PG8_STAGE(PG8_SB(0, 1), cB + hstep, voffB); PG8_STAGE(PG8_SA(0, 1), cA + hstep, voffA);
        if (wr == 1) PG8_BAR;
        PG8_WAIT_V(4); PG8_BAR;
        PG8_STAGE(PG8_SB(1, 0), cB + kstep, voffB); PG8_STAGE(PG8_SA(1, 0), cA + kstep, voffA); PG8_STAGE(PG8_SB(1, 1), cB + hstep + kstep, voffB);
        PG8_WAIT_V(6); PG8_BAR;
    }
    for (;;) {
        const bool has_next = S.next(ui + 1, nxt);
        const char* nA = has_next ? (const char*)g.A + (size_t)nxt.pm * tstep : cA; const char* nB = has_next ? (const char*)g.Bt + (size_t)nxt.pn * tstep : cB;
        for (int t = 0; t < nt; t += 2) {
            const bool last = (t == nt - 2);
            const char* a1 = cA + (size_t)(t + 1) * kstep;
            const char* a2 = last ? nA : cA + (size_t)(t + 2) * kstep; const char* b2 = last ? nB : cB + (size_t)(t + 2) * kstep;
            const char* a3 = a2 + kstep; const char* b3 = b2 + kstep;
            if (last && has_next) S.a_ready(nxt);
            if constexpr (SP2) {
            PG8_LDB(B0, 0, 0); PG8_LDB(B1, 0, 1); PG8_SCHED; PG8_LDA(At, 0, 0); PG8_STAGE(PG8_SA(1, 1), a1 + hstep, voffA);
            PG8_WAIT_V(8); PG8_WAIT_L(0); PG8_BAR; PG8_MMA(0, 0, At, B0); PG8_MMA(0, 1, At, B1); PG8_BAR; PG8_SCHED;
            PG8_LDA(At, 0, 1); PG8_STAGE(PG8_SB(0, 0), b2, voffB); PG8_STAGE(PG8_SB(0, 1), b2 + hstep, voffB); PG8_STAGE(PG8_SA(0, 0), a2, voffA);
            PG8_WAIT_V(8); PG8_WAIT_L(0); PG8_BAR; PG8_MMA(1, 0, At, B0); PG8_MMA(1, 1, At, B1); PG8_BAR; PG8_SCHED;
            PG8_LDB(B0, 1, 0); PG8_LDB(B1, 1, 1); PG8_SCHED; PG8_LDA(At, 1, 0); PG8_STAGE(PG8_SA(0, 1), a2 + hstep, voffA);
            PG8_WAIT_V(8); PG8_WAIT_L(0); PG8_BAR; PG8_MMA(0, 0, At, B0); PG8_MMA(0, 1, At, B1); PG8_BAR; PG8_SCHED;
            PG8_LDA(At, 1, 1); PG8_STAGE(PG8_SB(1, 0), b3, voffB); PG8_STAGE(PG8_SB(1, 1), b3 + hstep, voffB); PG8_STAGE(PG8_SA(1, 0), a3, voffA);
            PG8_WAIT_V(8); PG8_WAIT_L(0); PG8_BAR; PG8_MMA(1, 0, At, B0); PG8_MMA(1, 1, At, B1); PG8_BAR; PG8_SCHED;
            } else {
            PG8_LDB(B0, 0, 0); PG8_SCHED; PG8_LDA(At, 0, 0); PG8_STAGE(PG8_SA(1, 1), a1 + hstep, voffA);
            PG8_WAIT_L(8); PG8_BAR; PG8_WAIT_L(0); PG8_MMA(0, 0, At, B0); PG8_BAR; PG8_SCHED;
            PG8_LDB(B1, 0, 1); PG8_STAGE(PG8_SB(0, 0), b2, voffB);
            PG8_BAR; PG8_WAIT_L(0); PG8_MMA(0, 1, At, B1); PG8_BAR;
            PG8_LDA(At, 0, 1); PG8_STAGE(PG8_SA(0, 0), a2, voffA);
            PG8_BAR; PG8_WAIT_L(0); PG8_MMA(1, 0, At, B0); PG8_BAR; PG8_SCHED;
            PG8_STAGE(PG8_SB(0, 1), b2 + hstep, voffB);
            PG8_WAIT_V(6); PG8_BAR; PG8_MMA(1, 1, At, B1); PG8_BAR;
            PG8_LDB(B0, 1, 0); PG8_SCHED; PG8_LDA(At, 1, 0); PG8_STAGE(PG8_SA(0, 1), a2 + hstep, voffA);
            PG8_WAIT_L(8); PG8_BAR; PG8_WAIT_L(0); PG8_MMA(0, 0, At, B0); PG8_BAR; PG8_SCHED;
            PG8_LDB(B1, 1, 1); PG8_STAGE(PG8_SB(1, 0), b3, voffB);
            PG8_BAR; PG8_WAIT_L(0); PG8_MMA(0, 1, At, B1); PG8_BAR;
            PG8_LDA(At, 1, 1); PG8_STAGE(PG8_SA(1, 0), a3, voffA);
            PG8_BAR; PG8_WAIT_L(0); PG8_MMA(1, 0, At, B0); PG8_BAR; PG8_SCHED;
            PG8_STAGE(PG8_SB(1, 1), b3 + hstep, voffB);
            PG8_WAIT_V(6); PG8_BAR; PG8_MMA(1, 1, At, B1); PG8_BAR;
            }
        }
        if constexpr (ALIGN_EPI) { if (wr == 0) PG8_BAR; }
        if constexpr (!Epi::AFTER_DRAIN) { E(acc, cur, wr, wc, fr, fq); S.done(cur); }
        if (!has_next) break;
#pragma unroll
        for (int a = 0; a < 2; ++a)
#pragma unroll
            for (int b = 0; b < 2; ++b)
#pragma unroll
                for (int m = 0; m < 4; ++m)
#pragma unroll
                    for (int n = 0; n < 2; ++n) acc[a][b][m][n] = (f32x4){0.f, 0.f, 0.f, 0.f};
        cur = nxt; cA = nA; cB = nB; ++ui;
        if constexpr (ALIGN_EPI) { if (wr == 1) PG8_BAR; }
    }
    PG8_WAIT_V(0);
    if constexpr (!ALIGN_EPI) { if (wr == 0) PG8_BAR; }
    PG8_BAR;
    if constexpr (Epi::AFTER_DRAIN) { E.fused(acc, cur, wr, wc, fr, fq, lds, wid, lane); S.done(cur); }
#undef PG8_SA
#undef PG8_SB
#undef PG8_STAGE
#undef PG8_LDA
#undef PG8_LDB
#undef PG8_MMA
#undef PG8_WAIT_V
#undef PG8_WAIT_L
#undef PG8_BAR
#undef PG8_SCHED
}
}

#define GAS __attribute__((address_space(1)))
#define LAS __attribute__((address_space(3)))
typedef unsigned short bf16;
typedef unsigned u32x4 __attribute__((ext_vector_type(4)));
typedef unsigned u32x2 __attribute__((ext_vector_type(2)));
typedef float f32x4 __attribute__((ext_vector_type(4)));
typedef float f32x2 __attribute__((ext_vector_type(2)));

constexpr int NBATCH = 4, SEQ = 2048, TOK = NBATCH * SEQ, DM = 2048, DEPTH = 4;
constexpr int NIN = 16592, NINP = 16640;
constexpr int C_GQKV = 0, C_GZ = 3072, C_GB = 4096, C_GA = 4104, C_RF = 4112, C_RZ = 7376, C_SU = 8400, C_SZ = 9424, C_GATE = 10448;
constexpr int NWAVES = 8, NTHREADS = 512;
constexpr int LDS_BYTES = 147456;
constexpr int PH_PER_LAYER = 7, NPHASES = 1 + DEPTH * PH_PER_LAYER;

constexpr size_t MiB = 1u << 20;
constexpr size_t WS_WIN = 0, WS_WGLU = 260 * MiB, WS_WBR = 268 * MiB, WS_WOUT = 316 * MiB, WS_XN = 348 * MiB, WS_PROJ = 380 * MiB;
constexpr size_t WS_GQ = 640 * MiB, WS_GK = 672 * MiB, WS_GV = 704 * MiB, WS_GEG = 736 * MiB, WS_GBE = 737 * MiB, WS_GO = 738 * MiB;
constexpr size_t WS_RR = 770 * MiB, WS_RW = 802 * MiB, WS_RK = 834 * MiB, WS_RV = 866 * MiB, WS_RKK = 898 * MiB, WS_RKA = 930 * MiB, WS_RBON = 962 * MiB, WS_RY = 963 * MiB;
constexpr size_t WS_SY = 995 * MiB, WS_OBR = 1011 * MiB, WS_ACCF = 1059 * MiB, WS_MRG = 1123 * MiB, WS_CTL = 1155 * MiB, WS_END = 1156 * MiB;
constexpr size_t CTL_ZERO_BYTES = 65536;
constexpr int MISC_OFF = 131072;
static_assert((size_t)DEPTH * NINP * DM * 2 == 260 * MiB && (size_t)TOK * NINP * 2 == 260 * MiB, "ws map");

__device__ __forceinline__ unsigned f2bf(float f) { unsigned u = __builtin_bit_cast(unsigned, f); return (u + 0x7fffu + ((u >> 16) & 1u)) >> 16; }
__device__ __forceinline__ unsigned pk2(float lo, float hi) { return f2bf(lo) | (f2bf(hi) << 16); }
__device__ __forceinline__ float bflo(unsigned w) { return __builtin_bit_cast(float, w << 16); }
__device__ __forceinline__ float bfhi(unsigned w) { return __builtin_bit_cast(float, w & 0xffff0000u); }
__device__ __forceinline__ float bf1(bf16 h) { return __builtin_bit_cast(float, (unsigned)h << 16); }
__device__ __forceinline__ float sigmoidf_(float x) { return 1.f / (1.f + __expf(-x)); }
__device__ __forceinline__ float siluf_(float x) { return x / (1.f + __expf(-x)); }
__device__ __forceinline__ float softplusf_(float x) { return x > 20.f ? x : log1pf(expf(x)); }
__device__ __forceinline__ float gelu_tanh(float y) { const float t = 0.7978845608028654f * (y + 0.044715f * y * y * y); const float th = 1.f - 2.f / (1.f + __expf(2.f * t)); return 0.5f * y * (1.f + th); }
template <int CTRL> __device__ __forceinline__ float dppf(float v) { return __builtin_bit_cast(float, __builtin_amdgcn_update_dpp(0, __builtin_bit_cast(int, v), CTRL, 0xF, 0xF, true)); }
__device__ __forceinline__ float allred8(float v) { v += dppf<0xB1>(v); v += dppf<0x4E>(v); v += dppf<0x141>(v); return v; }
__device__ __forceinline__ float allred16(float v) { v = allred8(v); v += dppf<0x140>(v); return v; }
__device__ __forceinline__ float wave_sum(float v) {
#pragma unroll
    for (int o = 1; o < 64; o <<= 1) v += __shfl_xor(v, o);
    return v;
}
__device__ __forceinline__ void unpack8(const u32x4 w, float (&f)[8]) { f[0] = bflo(w.x); f[1] = bfhi(w.x); f[2] = bflo(w.y); f[3] = bfhi(w.y); f[4] = bflo(w.z); f[5] = bfhi(w.z); f[6] = bflo(w.w); f[7] = bfhi(w.w); }
__device__ __forceinline__ u32x4 pack8(const float (&f)[8]) { u32x4 w; w.x = pk2(f[0], f[1]); w.y = pk2(f[2], f[3]); w.z = pk2(f[4], f[5]); w.w = pk2(f[6], f[7]); return w; }

namespace pg8 {
struct EpiGlu {
    static constexpr bool PERM = true, AFTER_DRAIN = false;
    const bf16* Y1; const bf16* PROJ; const float* bias; bf16* O;
    __device__ __forceinline__ void operator()(const f32x4 (&acc)[2][2][4][2], const Unit& u, int wr, int wc, int fr, int fq) const {
        int row0 = u.pm * BM + wr * 64 + fr, col0 = u.pn * BM + wc * 32 + 8 * fq;
        asm volatile("" : "+v"(row0), "+v"(col0));
#pragma unroll
        for (int bj = 0; bj < 2; ++bj) {
            const int col = col0 + bj * HALF;
            const f32x4 b0 = *(const f32x4*)(bias + col), b1 = *(const f32x4*)(bias + col + 4);
#pragma unroll
            for (int ai = 0; ai < 2; ++ai)
#pragma unroll
                for (int m = 0; m < 4; ++m) {
                    const size_t row = (size_t)(row0 + ai * HALF + m * 16);
                    const u32x4 y8 = *(const u32x4*)(Y1 + row * 1024 + col), z8 = *(const u32x4*)(PROJ + row * NINP + C_SZ + col);
                    float y[8], z[8], o[8]; unpack8(y8, y); unpack8(z8, z);
                    const f32x4 v0 = acc[ai][bj][m][0] + b0, v1 = acc[ai][bj][m][1] + b1;
                    const float a[8] = {v0[0], v0[1], v0[2], v0[3], v1[0], v1[1], v1[2], v1[3]};
#pragma unroll
                    for (int e = 0; e < 8; ++e) o[e] = y[e] * sigmoidf_(a[e]) * siluf_(z[e]);
                    *(u32x4*)(O + row * 1024 + col) = pack8(o);
                    asm volatile("" ::: "memory");
                }
        }
    }
};
struct EpiBranch {
    static constexpr bool PERM = true, AFTER_DRAIN = false;
    const bf16* PROJ; const float* gate_b; float* ACCF; bf16* MRG;
    __device__ __forceinline__ void operator()(const f32x4 (&acc)[2][2][4][2], const Unit& u, int wr, int wc, int fr, int fq) const {
        const int br = u.pm >> 5, pm = u.pm & 31, pn = u.pn & 7;
        int row0 = pm * BM + wr * 64 + fr, col0 = pn * BM + wc * 32 + 8 * fq;
        asm volatile("" : "+v"(row0), "+v"(col0));
#pragma unroll
        for (int bj = 0; bj < 2; ++bj) {
            const int col = col0 + bj * HALF;
            const f32x4 g0 = *(const f32x4*)(gate_b + br * DM + col), g1 = *(const f32x4*)(gate_b + br * DM + col + 4);
            const float gb[8] = {g0[0], g0[1], g0[2], g0[3], g1[0], g1[1], g1[2], g1[3]};
#pragma unroll
            for (int ai = 0; ai < 2; ++ai)
#pragma unroll
                for (int m = 0; m < 4; ++m) {
                    const size_t row = (size_t)(row0 + ai * HALF + m * 16);
                    const u32x4 l8 = *(const u32x4*)(PROJ + row * NINP + C_GATE + br * DM + col);
                    float gl[8], o[8]; unpack8(l8, gl);
                    const f32x4 v0 = acc[ai][bj][m][0], v1 = acc[ai][bj][m][1];
                    const float a[8] = {v0[0], v0[1], v0[2], v0[3], v1[0], v1[1], v1[2], v1[3]};
#pragma unroll
                    for (int e = 0; e < 8; ++e) o[e] = sigmoidf_(gl[e] + gb[e]) * a[e];
                    float* ap = ACCF + row * DM + col;
                    if (br > 0) { const f32x4 p0 = *(const f32x4*)ap, p1 = *(const f32x4*)(ap + 4);
                        o[0] += p0[0]; o[1] += p0[1]; o[2] += p0[2]; o[3] += p0[3]; o[4] += p1[0]; o[5] += p1[1]; o[6] += p1[2]; o[7] += p1[3]; }
                    if (br < 2) { *(f32x4*)ap = (f32x4){o[0], o[1], o[2], o[3]}; *(f32x4*)(ap + 4) = (f32x4){o[4], o[5], o[6], o[7]}; }
                    else *(u32x4*)(MRG + row * DM + col) = pack8(o);
                    asm volatile("" ::: "memory");
                }
        }
    }
};
struct EpiResid {
    static constexpr bool PERM = true, AFTER_DRAIN = false;
    const float* base; float* out;
    __device__ __forceinline__ void operator()(const f32x4 (&acc)[2][2][4][2], const Unit& u, int wr, int wc, int fr, int fq) const {
        int row0 = u.pm * BM + wr * 64 + fr, col0 = u.pn * BM + wc * 32 + 8 * fq;
        asm volatile("" : "+v"(row0), "+v"(col0));
#pragma unroll
        for (int ai = 0; ai < 2; ++ai)
#pragma unroll
            for (int m = 0; m < 4; ++m)
#pragma unroll
                for (int bj = 0; bj < 2; ++bj) {
                    const size_t off = (size_t)(row0 + ai * HALF + m * 16) * DM + col0 + bj * HALF;
                    const f32x4 p0 = *(const f32x4*)(base + off), p1 = *(const f32x4*)(base + off + 4);
                    *(f32x4*)(out + off) = p0 + acc[ai][bj][m][0]; *(f32x4*)(out + off + 4) = p1 + acc[ai][bj][m][1];
                }
    }
};
struct BranchOrder {
    StaticOrder base;
    __device__ bool next(int i, Unit& u) const { Unit t; const int r = i / 3, br = i - 3 * r; if (!base.next(r, t)) return false; u.pm = br * 32 + t.pm; u.pn = br * 8 + t.pn; return true; }
    __device__ __forceinline__ void a_ready(const Unit&) const {}
    __device__ __forceinline__ void done(const Unit&) const {}
};
}

#define XB_TMO      128
#define XB_XCNT(j)  (256  + 64 * (j))
#define XB_XSUB(j)  (1280 + 64 * (j))
#define XB_XGEN(j)  (2304 + 64 * (j))
#define XB_TOP      3328
#define XB_TOPGEN   3392
#define XCD_BAR_WORDS 3456
#define XB_SPIN_CAP (1u << 18)

__device__ __forceinline__ unsigned xb_ld(unsigned* p)              { return __hip_atomic_load(p, __ATOMIC_RELAXED, __HIP_MEMORY_SCOPE_AGENT); }
__device__ __forceinline__ unsigned xb_add(unsigned* p, unsigned v) { return __hip_atomic_fetch_add(p, v, __ATOMIC_RELAXED, __HIP_MEMORY_SCOPE_AGENT); }
__device__ __forceinline__ unsigned xb_xcc_id() { return (unsigned)__builtin_amdgcn_s_getreg((3 << 11) | 20) & 0xFu; }
#define XB_SPIN(cond, bar) do { unsigned _sp = 0; while (cond) { __builtin_amdgcn_s_sleep(1); \
    if ((++_sp & 255u) == 0u) { if (xb_ld(&(bar)[XB_TMO])) break; if (_sp > XB_SPIN_CAP) { atomicAdd(&(bar)[XB_TMO], 1u); break; } } } } while (0)

struct XcdBarrier {
    unsigned* bar; unsigned x;
    volatile LAS unsigned* st;
};

__device__ __forceinline__ XcdBarrier xcd_barrier_post(unsigned* bar, volatile LAS unsigned* st) {
    XcdBarrier b; b.bar = bar; b.x = xb_xcc_id(); b.st = st;
    if (threadIdx.x == 0) (void)xb_add(&bar[XB_XCNT(b.x)], 1u);
    return b;
}
__device__ __forceinline__ void xcd_barrier_complete(unsigned* bar, unsigned x, unsigned& nloc, unsigned& nx) {
    const unsigned G = gridDim.x * gridDim.y * gridDim.z;
    unsigned sum, cnt, mine, sp = 0u;
    for (;;) {
        sum = 0u; cnt = 0u; mine = 0u;
#pragma unroll
        for (unsigned j = 0; j < 16; ++j) { const unsigned c = xb_ld(&bar[XB_XCNT(j)]); sum += c; cnt += (c > 0u) ? 1u : 0u; mine = (j == x) ? c : mine; }
        if (sum == G) break;
        __builtin_amdgcn_s_sleep(1);
        if ((++sp & 255u) == 0u) { if (xb_ld(&bar[XB_TMO])) break; if (sp > XB_SPIN_CAP) { atomicAdd(&bar[XB_TMO], 1u); break; } }
    }
    nloc = mine > 0u ? mine : 1u; nx = cnt > 0u ? cnt : 1u;
}

__device__ __forceinline__ void xcd_barrier(const XcdBarrier& b) {
    asm volatile("s_waitcnt vmcnt(0)" ::: "memory");
    __syncthreads();
    if (threadIdx.x == 0) {
        unsigned* bar = b.bar;
        __builtin_amdgcn_s_waitcnt(0);
        unsigned nloc = b.st[0], nx = b.st[1];
        if (nloc == 0u) { xcd_barrier_complete(bar, b.x, nloc, nx); b.st[0] = nloc; b.st[1] = nx; }
        const unsigned old = xb_add(&bar[XB_XSUB(b.x)], 1u);
        const unsigned gen = old / nloc;
        if (old + 1u == (gen + 1u) * nloc) {
            __builtin_amdgcn_fence(__ATOMIC_RELEASE, "agent");
            asm volatile("s_waitcnt vmcnt(0)" ::: "memory");
            const unsigned og = xb_add(&bar[XB_TOP], 1u);
            const unsigned tg = og / nx;
            if (og + 1u == (tg + 1u) * nx) xb_add(&bar[XB_TOPGEN], 1u);
            else XB_SPIN(xb_ld(&bar[XB_TOPGEN]) == tg, bar);
            __builtin_amdgcn_fence(__ATOMIC_ACQUIRE, "agent");
            xb_add(&bar[XB_XGEN(b.x)], 1u);
            asm volatile("s_waitcnt vmcnt(0)" ::: "memory");
        } else {
            XB_SPIN(xb_ld(&bar[XB_XGEN(b.x)]) == gen, bar);
            __builtin_amdgcn_fence(__ATOMIC_ACQUIRE, "agent");
            asm volatile("s_waitcnt vmcnt(0)" ::: "memory");
        }
    }
    __syncthreads();
}

struct Args { const float* in[31]; float* out; unsigned char* ws; int ph_lo, ph_hi; };
struct Ctx { int tid, lane, wave, vcu, G, gw, NGW; LAS unsigned char* lds; unsigned char* ws; };

__device__ __forceinline__ void transpose_item(const float* W, int K, int N, bf16* WT, LAS float* scr, int kb, int nb, int lane) {
    const int k0 = 64 * kb, n0 = 32 * nb, n = n0 + (lane & 31); const bool nv = n < N;
#pragma unroll 8
    for (int i = 0; i < 32; ++i) { const int kk = 2 * i + (lane >> 5); scr[kk * 33 + (lane & 31)] = nv ? W[(size_t)(k0 + kk) * N + n] : 0.f; }
    asm volatile("s_waitcnt lgkmcnt(0)" ::: "memory");
    const int c = lane & 7;
#pragma unroll
    for (int j = 0; j < 4; ++j) { const int nn = (lane >> 3) + 8 * j; const LAS float* s = scr + (8 * c) * 33 + nn;
        u32x4 o; o.x = pk2(s[0 * 33], s[1 * 33]); o.y = pk2(s[2 * 33], s[3 * 33]); o.z = pk2(s[4 * 33], s[5 * 33]); o.w = pk2(s[6 * 33], s[7 * 33]);
        *(u32x4*)(WT + (size_t)(n0 + nn) * K + k0 + 8 * c) = o; }
    asm volatile("s_waitcnt lgkmcnt(0)" ::: "memory");
}

__device__ __forceinline__ void rms_row(const float* xrow, const float* w, bf16* obf, float* of32, int lane) {
    f32x4 v[8]; float s = 0.f;
#pragma unroll
    for (int j = 0; j < 8; ++j) { v[j] = *(const f32x4*)(xrow + 4 * lane + 256 * j); s += (v[j].x * v[j].x + v[j].y * v[j].y) + (v[j].z * v[j].z + v[j].w * v[j].w); }
    const float r = 1.f / sqrtf(wave_sum(s) * (1.f / DM) + 1e-6f);
#pragma unroll
    for (int j = 0; j < 8; ++j) { const f32x4 ww = *(const f32x4*)(w + 4 * lane + 256 * j); const f32x4 o = v[j] * r * ww;
        if (obf) { u32x2 p; p.x = pk2(o.x, o.y); p.y = pk2(o.z, o.w); *(u32x2*)(obf + 4 * lane + 256 * j) = p; }
        else *(f32x4*)(of32 + 4 * lane + 256 * j) = o; }
}

__device__ __forceinline__ void phase0(const Ctx& F, const Args& a) {
    LAS float* scr = (LAS float*)(F.lds + F.wave * 16384);
    constexpr int I_IN = 32 * 520, I_GLU = 16 * 32, I_BR = 16 * 64, I_OUT = 32 * 64, IL = I_IN + I_GLU + 3 * I_BR + I_OUT;
    bf16* WIN = (bf16*)(F.ws + WS_WIN); bf16* WGLU = (bf16*)(F.ws + WS_WGLU); bf16* WBR = (bf16*)(F.ws + WS_WBR); bf16* WOUT = (bf16*)(F.ws + WS_WOUT);
    for (int it = F.gw; it < DEPTH * IL; it += F.NGW) {
        const int l = it / IL; int r = it - l * IL;
        if (r < I_IN) { transpose_item(a.in[2] + (size_t)l * DM * NIN, DM, NIN, WIN + (size_t)l * NINP * DM, scr, r / 520, r % 520, F.lane); continue; } r -= I_IN;
        if (r < I_GLU) { transpose_item(a.in[25] + (size_t)l * 1024 * 1024, 1024, 1024, WGLU + (size_t)l * 1024 * 1024, scr, r / 32, r % 32, F.lane); continue; } r -= I_GLU;
        if (r < 3 * I_BR) { const int br = r / I_BR, r2 = r - br * I_BR;
            transpose_item(a.in[28] + (size_t)(l * 3 + br) * 1024 * DM, 1024, DM, WBR + (size_t)(l * 3 + br) * DM * 1024, scr, r2 / 64, r2 % 64, F.lane); continue; } r -= 3 * I_BR;
        transpose_item(a.in[29] + (size_t)l * DM * DM, DM, DM, WOUT + (size_t)l * DM * DM, scr, r / 64, r % 64, F.lane);
    }
    bf16* XN = (bf16*)(F.ws + WS_XN);
    for (int m = F.gw; m < TOK; m += F.NGW) rms_row(a.in[0] + (size_t)m * DM, a.in[1], XN + (size_t)m * DM, nullptr, F.lane);
}

__device__ __forceinline__ void prep_gdn(const Ctx& F, const Args& a, int l) {
    const bf16* PROJ = (const bf16*)(F.ws + WS_PROJ);
    float* GQ = (float*)(F.ws + WS_GQ); float* GK = (float*)(F.ws + WS_GK); float* GV = (float*)(F.ws + WS_GV); float* GEG = (float*)(F.ws + WS_GEG); float* GBE = (float*)(F.ws + WS_GBE);
    const float* cw = a.in[3] + (size_t)l * 4 * 3072;
    for (int it = F.gw; it < 2048; it += F.NGW) {
        const int h = it & 7, ch = (it >> 3) & 63, b = it >> 9;
        const int t0 = ch * 32; const int c = 2 * F.lane;
        float w[3][4][2], hist[3][3][2];
#pragma unroll
        for (int p = 0; p < 3; ++p)
#pragma unroll
            for (int j = 0; j < 4; ++j) { const f32x2 ww = *(const f32x2*)(cw + j * 3072 + p * 1024 + h * 128 + c); w[p][j][0] = ww.x; w[p][j][1] = ww.y; }
#pragma unroll
        for (int p = 0; p < 3; ++p)
#pragma unroll
            for (int j = 0; j < 3; ++j) { const int t = t0 - 3 + j; unsigned x = 0u;
                if (t >= 0) x = *(const unsigned*)(PROJ + (size_t)(b * SEQ + t) * NINP + C_GQKV + p * 1024 + h * 128 + c);
                hist[p][j][0] = bflo(x); hist[p][j][1] = bfhi(x); }
        const float alog = a.in[4][l * 8 + h], dtb = a.in[5][l * 8 + h]; const float aexp = expf(alog);
        for (int tt = 0; tt < 32; ++tt) {
            const size_t tok = (size_t)(b * SEQ + t0 + tt);
            float o[3][2];
#pragma unroll
            for (int p = 0; p < 3; ++p) {
                const unsigned x = *(const unsigned*)(PROJ + tok * NINP + C_GQKV + p * 1024 + h * 128 + c);
                const float x0 = bflo(x), x1 = bfhi(x);
                const float y0 = w[p][0][0] * hist[p][0][0] + w[p][1][0] * hist[p][1][0] + w[p][2][0] * hist[p][2][0] + w[p][3][0] * x0;
                const float y1 = w[p][0][1] * hist[p][0][1] + w[p][1][1] * hist[p][1][1] + w[p][2][1] * hist[p][2][1] + w[p][3][1] * x1;
                hist[p][0][0] = hist[p][1][0]; hist[p][1][0] = hist[p][2][0]; hist[p][2][0] = x0;
                hist[p][0][1] = hist[p][1][1]; hist[p][1][1] = hist[p][2][1]; hist[p][2][1] = x1;
                o[p][0] = siluf_(y0); o[p][1] = siluf_(y1);
            }
            const float sq = wave_sum(o[0][0] * o[0][0] + o[0][1] * o[0][1]), sk = wave_sum(o[1][0] * o[1][0] + o[1][1] * o[1][1]);
            const float rq = 0.08838834764831845f / sqrtf(sq + 1e-6f), rk = 1.f / sqrtf(sk + 1e-6f);
            const size_t off = tok * 1024 + h * 128 + c;
            *(f32x2*)(GQ + off) = (f32x2){o[0][0] * rq, o[0][1] * rq};
            *(f32x2*)(GK + off) = (f32x2){o[1][0] * rk, o[1][1] * rk};
            *(f32x2*)(GV + off) = (f32x2){o[2][0], o[2][1]};
            if (F.lane == 0) {
                const float bl = bf1(PROJ[tok * NINP + C_GB + h]), al = bf1(PROJ[tok * NINP + C_GA + h]);
                GBE[tok * 8 + h] = sigmoidf_(bl);
                GEG[tok * 8 + h] = expf(-aexp * softplusf_(al + dtb));
            }
        }
    }
}

__device__ __forceinline__ float mix2(unsigned c, unsigned p, float mu0, float mu1, float& o1) {
    const float c0 = bflo(c), c1 = bfhi(c), p0 = bflo(p), p1 = bfhi(p);
    o1 = c1 + (p1 - c1) * mu1; return c0 + (p0 - c0) * mu0;
}
__device__ __forceinline__ void prep_rwkv(const Ctx& F, const Args& a, int l) {
    const bf16* PROJ = (const bf16*)(F.ws + WS_PROJ);
    float* RR = (float*)(F.ws + WS_RR); float* RW = (float*)(F.ws + WS_RW); float* RK = (float*)(F.ws + WS_RK); float* RV = (float*)(F.ws + WS_RV);
    float* RKK = (float*)(F.ws + WS_RKK); float* RKA = (float*)(F.ws + WS_RKA); float* RBON = (float*)(F.ws + WS_RBON);
    const float* mu = a.in[7] + (size_t)l * 3264; const float* w0 = a.in[8] + l * 1024; const float* wup = a.in[9] + (size_t)l * 96 * 1024;
    const float* a0 = a.in[10] + l * 1024; const float* aup = a.in[11] + (size_t)l * 96 * 1024; const float* kk_ = a.in[12] + l * 1024; const float* ka_ = a.in[13] + l * 1024; const float* rk_ = a.in[14] + l * 1024;
    LAS float* A1 = (LAS float*)F.lds; LAS float* A2 = A1 + 16 * 96;
    const int j = F.tid, c = 2 * j;
    const f32x2 mur = *(const f32x2*)(mu + c), muk = *(const f32x2*)(mu + 1024 + c), muv = *(const f32x2*)(mu + 2048 + c);
    const f32x2 w0v = *(const f32x2*)(w0 + c), a0v = *(const f32x2*)(a0 + c), kkv = *(const f32x2*)(kk_ + c), kav = *(const f32x2*)(ka_ + c), rkv = *(const f32x2*)(rk_ + c);
    for (int tile = F.vcu; tile < TOK / 16; tile += F.G) {
        __syncthreads();
        for (int e = F.tid; e < 16 * 192; e += NTHREADS) {
            const int tl = e / 192, i = e - tl * 192; const size_t tok = (size_t)tile * 16 + tl;
            const float cur = bf1(PROJ[tok * NINP + C_RF + 3072 + i]);
            const float prv = (tok & (SEQ - 1)) ? bf1(PROJ[(tok - 1) * NINP + C_RF + 3072 + i]) : 0.f;
            const float m = cur + (prv - cur) * mu[3072 + i];
            if (i < 96) A1[tl * 96 + i] = tanhf(m); else A2[tl * 96 + i - 96] = m;
        }
        __syncthreads();
        float accw[16][2], acca[16][2];
#pragma unroll
        for (int tl = 0; tl < 16; ++tl) { accw[tl][0] = 0.f; accw[tl][1] = 0.f; acca[tl][0] = 0.f; acca[tl][1] = 0.f; }
        for (int i = 0; i < 96; i += 4) {
            f32x2 wu[4], au[4];
#pragma unroll
            for (int q = 0; q < 4; ++q) { wu[q] = *(const f32x2*)(wup + (size_t)(i + q) * 1024 + c); au[q] = *(const f32x2*)(aup + (size_t)(i + q) * 1024 + c); }
#pragma unroll
            for (int tl = 0; tl < 16; ++tl) {
                const f32x4 x1 = *(const LAS f32x4*)(A1 + tl * 96 + i), x2 = *(const LAS f32x4*)(A2 + tl * 96 + i);
#pragma unroll
                for (int q = 0; q < 4; ++q) { accw[tl][0] += x1[q] * wu[q].x; accw[tl][1] += x1[q] * wu[q].y; acca[tl][0] += x2[q] * au[q].x; acca[tl][1] += x2[q] * au[q].y; }
            }
        }
#pragma unroll
        for (int tl = 0; tl < 16; ++tl) {
            const size_t tok = (size_t)tile * 16 + tl; const bool hp = (tok & (SEQ - 1)) != 0;
            const bf16* cp = PROJ + tok * NINP + C_RF + c; const bf16* pp = cp - NINP;
            const unsigned cr = *(const unsigned*)cp, ck = *(const unsigned*)(cp + 1024), cv = *(const unsigned*)(cp + 2048);
            const unsigned pr = hp ? *(const unsigned*)pp : 0u, pk = hp ? *(const unsigned*)(pp + 1024) : 0u, pv = hp ? *(const unsigned*)(pp + 2048) : 0u;
            float r1, k1, v1; const float r0 = mix2(cr, pr, mur.x, mur.y, r1), k0 = mix2(ck, pk, muk.x, muk.y, k1), v0 = mix2(cv, pv, muv.x, muv.y, v1);
            const float wp0 = w0v.x + accw[tl][0], wp1 = w0v.y + accw[tl][1];
            const float d0 = expf(-expf(-softplusf_(-wp0) - 0.5f)), d1 = expf(-expf(-softplusf_(-wp1) - 0.5f));
            const float aa0 = sigmoidf_(a0v.x + acca[tl][0]), aa1 = sigmoidf_(a0v.y + acca[tl][1]);
            const float q0 = k0 * kkv.x, q1 = k1 * kkv.y;
            float ss = q0 * q0 + q1 * q1;
#pragma unroll
            for (int o = 1; o < 32; o <<= 1) ss += __shfl_xor(ss, o);
            const float rn = 1.f / sqrtf(ss + 1e-6f); const float n0 = q0 * rn, n1 = q1 * rn;
            const float km0 = k0 * (1.f + (aa0 - 1.f) * kav.x), km1 = k1 * (1.f + (aa1 - 1.f) * kav.y);
            float bo = r0 * km0 * rkv.x + r1 * km1 * rkv.y;
#pragma unroll
            for (int o = 1; o < 32; o <<= 1) bo += __shfl_xor(bo, o);
            const size_t off = tok * 1024 + c;
            *(f32x2*)(RR + off) = (f32x2){r0, r1}; *(f32x2*)(RW + off) = (f32x2){d0, d1}; *(f32x2*)(RK + off) = (f32x2){km0, km1}; *(f32x2*)(RV + off) = (f32x2){v0, v1};
            *(f32x2*)(RKK + off) = (f32x2){-n0, -n1}; *(f32x2*)(RKA + off) = (f32x2){n0 * aa0, n1 * aa1};
            if ((F.lane & 31) == 0) RBON[tok * 16 + (c >> 6)] = bo;
        }
    }
}

#ifndef SCM
#define SCM 7
#endif
constexpr int CH = 32;
#define WFENCE() do { __builtin_amdgcn_fence(__ATOMIC_RELEASE, "wavefront"); __builtin_amdgcn_wave_barrier(); __builtin_amdgcn_fence(__ATOMIC_ACQUIRE, "wavefront"); } while (0)

struct GStep { f32x4 k0, k1, q0, q1; float v, eg, be; };
constexpr int G_BUF = 2 * CH * 128 + CH * 32 + 2 * CH;
__device__ __forceinline__ void gdn_lds(GStep& s, const LAS float* buf, int st, int rg, int colL) {
    s.k0 = *(const LAS f32x4*)(buf + st * 128 + rg * 8); s.k1 = *(const LAS f32x4*)(buf + st * 128 + rg * 8 + 4);
    s.q0 = *(const LAS f32x4*)(buf + CH * 128 + st * 128 + rg * 8); s.q1 = *(const LAS f32x4*)(buf + CH * 128 + st * 128 + rg * 8 + 4);
    s.v = buf[2 * CH * 128 + st * 32 + colL]; s.eg = buf[2 * CH * 128 + CH * 32 + st]; s.be = buf[2 * CH * 128 + CH * 32 + CH + st];
}
__device__ __forceinline__ void gdn_step(const GStep& s, float (&S)[8], float* op, int t, bool wr) {
    float ks = (s.k0.x * S[0] + s.k0.y * S[1]) + (s.k0.z * S[2] + s.k0.w * S[3]) + ((s.k1.x * S[4] + s.k1.y * S[5]) + (s.k1.z * S[6] + s.k1.w * S[7]));
    ks = allred16(ks);
    const float cc = s.be * (s.v - s.eg * ks);
    S[0] = s.eg * S[0] + cc * s.k0.x; S[1] = s.eg * S[1] + cc * s.k0.y; S[2] = s.eg * S[2] + cc * s.k0.z; S[3] = s.eg * S[3] + cc * s.k0.w;
    S[4] = s.eg * S[4] + cc * s.k1.x; S[5] = s.eg * S[5] + cc * s.k1.y; S[6] = s.eg * S[6] + cc * s.k1.z; S[7] = s.eg * S[7] + cc * s.k1.w;
    float o = (s.q0.x * S[0] + s.q0.y * S[1]) + (s.q0.z * S[2] + s.q0.w * S[3]) + ((s.q1.x * S[4] + s.q1.y * S[5]) + (s.q1.z * S[6] + s.q1.w * S[7]));
    o = allred16(o);
    if (wr) op[(size_t)t * 1024] = o;
}
struct GStage { f32x4 k[2], q[2], v; float e; };
__device__ __forceinline__ void gdn_gload(GStage& g, const float* GK, const float* GQ, const float* GV, const float* GEG, const float* GBE, int t0, int tid) {
#pragma unroll
    for (int r = 0; r < 2; ++r) { const int i = tid + 512 * r, st = i >> 5, f4 = i & 31; g.k[r] = *(const f32x4*)(GK + (size_t)(t0 + st) * 1024 + 4 * f4); g.q[r] = *(const f32x4*)(GQ + (size_t)(t0 + st) * 1024 + 4 * f4); }
    if (tid < 256) g.v = *(const f32x4*)(GV + (size_t)(t0 + (tid >> 3)) * 1024 + 4 * (tid & 7));
    else if (tid < 288) g.e = GEG[(size_t)(t0 + tid - 256) * 8];
    else if (tid < 320) g.e = GBE[(size_t)(t0 + tid - 288) * 8];
}
__device__ __forceinline__ void gdn_gstore(const GStage& g, LAS float* buf, int tid) {
#pragma unroll
    for (int r = 0; r < 2; ++r) { const int i = tid + 512 * r; *(LAS f32x4*)(buf + 4 * i) = g.k[r]; *(LAS f32x4*)(buf + CH * 128 + 4 * i) = g.q[r]; }
    if (tid < 256) *(LAS f32x4*)(buf + 2 * CH * 128 + 4 * tid) = g.v;
    else if (tid < 320) buf[2 * CH * 128 + CH * 32 + (tid - 256)] = g.e;
}
__device__ __forceinline__ void gdn_block(const Ctx& F, int vb) {
    const int bh = vb >> 2, qt = vb & 3, b = bh >> 3, h = bh & 7, colL = F.wave * 4 + (F.lane >> 4), rg = F.lane & 15;
    const size_t base = (size_t)b * SEQ;
    const float* GK = (const float*)(F.ws + WS_GK) + base * 1024 + h * 128; const float* GQ = (const float*)(F.ws + WS_GQ) + base * 1024 + h * 128;
    const float* GV = (const float*)(F.ws + WS_GV) + base * 1024 + h * 128 + qt * 32;
    const float* GEG = (const float*)(F.ws + WS_GEG) + base * 8 + h; const float* GBE = (const float*)(F.ws + WS_GBE) + base * 8 + h;
    float* op = (float*)(F.ws + WS_GO) + base * 1024 + h * 128 + qt * 32 + colL;
    LAS float* lb = (LAS float*)F.lds;
    float S[8] = {0.f, 0.f, 0.f, 0.f, 0.f, 0.f, 0.f, 0.f};
    const bool wr = rg == 0;
    GStage g;
    gdn_gload(g, GK, GQ, GV, GEG, GBE, 0, F.tid); gdn_gstore(g, lb, F.tid);
    __syncthreads();
    for (int c = 0; c < SEQ / CH; ++c) {
        const LAS float* buf = lb + (c & 1) * G_BUF;
        if (c + 1 < SEQ / CH) gdn_gload(g, GK, GQ, GV, GEG, GBE, (c + 1) * CH, F.tid);
        GStep A, B;
        gdn_lds(A, buf, 0, rg, colL);
#pragma unroll 2
        for (int s = 0; s < CH; s += 2) {
            gdn_lds(B, buf, s + 1, rg, colL);
            gdn_step(A, S, op, c * CH + s, wr);
            gdn_lds(A, buf, (s + 2 < CH) ? s + 2 : s, rg, colL);
            gdn_step(B, S, op, c * CH + s + 1, wr);
        }
        if (c + 1 < SEQ / CH) gdn_gstore(g, lb + ((c + 1) & 1) * G_BUF, F.tid);
        __syncthreads();
    }
}

struct RStep { f32x4 w, n, a, k, r; float v; };
constexpr int R_BUF = CH * (5 * 64 + 32);
__device__ __forceinline__ void rwkv_lds(RStep& s, const LAS float* buf, int st, int cq, int rowL) {
    s.w = *(const LAS f32x4*)(buf + st * 64 + 4 * cq); s.n = *(const LAS f32x4*)(buf + CH * 64 + st * 64 + 4 * cq); s.a = *(const LAS f32x4*)(buf + 2 * CH * 64 + st * 64 + 4 * cq);
    s.k = *(const LAS f32x4*)(buf + 3 * CH * 64 + st * 64 + 4 * cq); s.r = *(const LAS f32x4*)(buf + 4 * CH * 64 + st * 64 + 4 * cq); s.v = buf[5 * CH * 64 + st * 32 + rowL];
}
__device__ __forceinline__ void rwkv_step(const RStep& s, f32x4& S, float* op, int t, bool wr) {
    float sa = (S.x * s.n.x + S.y * s.n.y) + (S.z * s.n.z + S.w * s.n.w);
    sa = allred16(sa);
    S = S * s.w + sa * s.a + s.v * s.k;
    float y = (S.x * s.r.x + S.y * s.r.y) + (S.z * s.r.z + S.w * s.r.w);
    y = allred16(y);
    if (wr) op[(size_t)t * 1024] = y;
}
struct RStage { f32x4 x[5], v; };
__device__ __forceinline__ void rwkv_gload(RStage& g, const float* const (&src)[5], const float* RV, int t0, int tid) {
    const int st = tid >> 4, f4 = tid & 15;
#pragma unroll
    for (int q = 0; q < 5; ++q) g.x[q] = *(const f32x4*)(src[q] + (size_t)(t0 + st) * 1024 + 4 * f4);
    if (tid < 256) g.v = *(const f32x4*)(RV + (size_t)(t0 + (tid >> 3)) * 1024 + 4 * (tid & 7));
}
__device__ __forceinline__ void rwkv_gstore(const RStage& g, LAS float* buf, int tid) {
#pragma unroll
    for (int q = 0; q < 5; ++q) *(LAS f32x4*)(buf + q * CH * 64 + 4 * tid) = g.x[q];
    if (tid < 256) *(LAS f32x4*)(buf + 5 * CH * 64 + 4 * tid) = g.v;
}
__device__ __forceinline__ void rwkv_block(const Ctx& F, int vb) {
    const int bh = vb >> 1, hf = vb & 1, b = bh >> 4, h = bh & 15, rowL = F.wave * 4 + (F.lane >> 4), cq = F.lane & 15;
    const size_t base = (size_t)b * SEQ * 1024 + h * 64;
    const float* const src[5] = {(const float*)(F.ws + WS_RW) + base, (const float*)(F.ws + WS_RKK) + base, (const float*)(F.ws + WS_RKA) + base, (const float*)(F.ws + WS_RK) + base, (const float*)(F.ws + WS_RR) + base};
    const float* RV = (const float*)(F.ws + WS_RV) + base + hf * 32;
    float* op = (float*)(F.ws + WS_RY) + base + hf * 32 + rowL;
    LAS float* lb = (LAS float*)F.lds;
    f32x4 S = {0.f, 0.f, 0.f, 0.f};
    const bool wr = cq == 0;
    RStage g;
    rwkv_gload(g, src, RV, 0, F.tid); rwkv_gstore(g, lb, F.tid);
    __syncthreads();
    for (int c = 0; c < SEQ / CH; ++c) {
        const LAS float* buf = lb + (c & 1) * R_BUF;
        if (c + 1 < SEQ / CH) rwkv_gload(g, src, RV, (c + 1) * CH, F.tid);
        RStep A, B;
        rwkv_lds(A, buf, 0, cq, rowL);
#pragma unroll 2
        for (int s = 0; s < CH; s += 2) {
            rwkv_lds(B, buf, s + 1, cq, rowL);
            rwkv_step(A, S, op, c * CH + s, wr);
            rwkv_lds(A, buf, (s + 2 < CH) ? s + 2 : s, cq, rowL);
            rwkv_step(B, S, op, c * CH + s + 1, wr);
        }
        if (c + 1 < SEQ / CH) rwkv_gstore(g, lb + ((c + 1) & 1) * R_BUF, F.tid);
        __syncthreads();
    }
}

constexpr int S5_ROW = 132, S5_WAVE = 4 * S5_ROW + 64;
__device__ __forceinline__ void s5_block(const Ctx& F, const Args& a, int l, int it) {
    const int b = it >> 6, g = it & 63, p = F.lane, tl = F.lane >> 4, c = F.lane & 15, w = F.wave;
    const bf16* PROJ = (const bf16*)(F.ws + WS_PROJ); bf16* SY = (bf16*)(F.ws + WS_SY);
    LAS float* cl = (LAS float*)F.lds; LAS float* se = cl + 16 * S5_ROW; LAS float* sb = se + 8 * 128 + w * S5_WAVE; LAS float* ub = sb + 4 * S5_ROW;
    const size_t gp = ((size_t)l * 64 + g) * 64 + p;
    const float dt = expf(a.in[19][l * 64 + g]); const float are = a.in[17][gp], aim = a.in[18][gp];
    const float mag = expf(are * dt), abr = mag * cosf(aim * dt), abi = mag * sinf(aim * dt);
    const float den = are * are + aim * aim, cr = ((abr - 1.f) * are + abi * aim) / den, ci = (abi * are - (abr - 1.f) * aim) / den;
    float Bre[16], Bim[16];
#pragma unroll
    for (int q = 0; q < 4; ++q) { const f32x4 br = *(const f32x4*)(a.in[20] + gp * 16 + 4 * q), bi = *(const f32x4*)(a.in[21] + gp * 16 + 4 * q);
#pragma unroll
        for (int e = 0; e < 4; ++e) { Bre[4 * q + e] = cr * br[e] - ci * bi[e]; Bim[4 * q + e] = cr * bi[e] + ci * br[e]; } }
    { const size_t cb = ((size_t)l * 64 + g) * 16 * 64;
      for (int e = F.tid; e < 2048; e += NTHREADS) { const int cc = e >> 7, r = e & 127; cl[cc * S5_ROW + r] = (r < 64 ? a.in[22] : a.in[23])[cb + cc * 64 + (r & 63)]; } }
    const float dsk = a.in[24][l * 1024 + g * 16 + c];
    const int tw = 256 * w;
    const bf16* up = PROJ + ((size_t)b * SEQ + tw) * NINP + C_SU + g * 16;
    float sr = 0.f, si = 0.f;
    {
        bf16 ucur = up[(size_t)tl * NINP + c], unxt = up[(size_t)(4 + tl) * NINP + c];
        for (int t = 0; t < 256; t += 4) {
            ub[F.lane] = bf1(ucur);
            WFENCE();
            const int tn = (t + 8 < 256) ? t + 8 : t;
            const bf16 unn = up[(size_t)(tn + tl) * NINP + c];
#pragma unroll
            for (int j = 0; j < 4; ++j) {
                float br = 0.f, bi = 0.f;
#pragma unroll
                for (int q = 0; q < 4; ++q) { const f32x4 u4 = *(const LAS f32x4*)(ub + j * 16 + 4 * q);
#pragma unroll
                    for (int e = 0; e < 4; ++e) { br += Bre[4 * q + e] * u4[e]; bi += Bim[4 * q + e] * u4[e]; } }
                const float nr = abr * sr - abi * si + br, ni = abr * si + abi * sr + bi; sr = nr; si = ni;
            }
            WFENCE();
            ucur = unxt; unxt = unn;
        }
    }
    se[w * 128 + p] = sr; se[w * 128 + 64 + p] = si;
    __syncthreads();
    {
        float pr = abr, pi = abi;
#pragma unroll
        for (int i = 0; i < 8; ++i) { const float nr = pr * pr - pi * pi, ni = 2.f * pr * pi; pr = nr; pi = ni; }
        sr = 0.f; si = 0.f;
        for (int j = 0; j < w; ++j) { const float er = se[j * 128 + p], ei = se[j * 128 + 64 + p]; const float nr = pr * sr - pi * si + er, ni = pr * si + pi * sr + ei; sr = nr; si = ni; }
    }
    {
        bf16 ucur = up[(size_t)tl * NINP + c], unxt = up[(size_t)(4 + tl) * NINP + c];
        for (int t = 0; t < 256; t += 4) {
            const float uf = bf1(ucur);
            ub[F.lane] = uf;
            WFENCE();
            const int tn = (t + 8 < 256) ? t + 8 : t;
            const bf16 unn = up[(size_t)(tn + tl) * NINP + c];
#pragma unroll
            for (int j = 0; j < 4; ++j) {
                float br = 0.f, bi = 0.f;
#pragma unroll
                for (int q = 0; q < 4; ++q) { const f32x4 u4 = *(const LAS f32x4*)(ub + j * 16 + 4 * q);
#pragma unroll
                    for (int e = 0; e < 4; ++e) { br += Bre[4 * q + e] * u4[e]; bi += Bim[4 * q + e] * u4[e]; } }
                const float nr = abr * sr - abi * si + br, ni = abr * si + abi * sr + bi; sr = nr; si = ni;
                sb[j * S5_ROW + p] = sr; sb[j * S5_ROW + 64 + p] = si;
            }
            WFENCE();
            float y0 = 0.f, y1 = 0.f;
#pragma unroll 2
            for (int q = 0; q < 16; ++q) { const f32x4 xr = *(const LAS f32x4*)(sb + tl * S5_ROW + 4 * q), xi = *(const LAS f32x4*)(sb + tl * S5_ROW + 64 + 4 * q);
                const f32x4 kr = *(const LAS f32x4*)(cl + c * S5_ROW + 4 * q), ki = *(const LAS f32x4*)(cl + c * S5_ROW + 64 + 4 * q);
                y0 += kr.x * xr.x + kr.y * xr.y + kr.z * xr.z + kr.w * xr.w;
                y1 += ki.x * xi.x + ki.y * xi.y + ki.z * xi.z + ki.w * xi.w; }
            WFENCE();
            const float y = (y0 - y1) + dsk * uf;
            SY[((size_t)b * SEQ + tw + t + tl) * 1024 + g * 16 + c] = (bf16)f2bf(gelu_tanh(y));
            ucur = unxt; unxt = unn;
        }
    }
    __syncthreads();
}

__device__ __forceinline__ void scan_phase(const Ctx& F, const Args& a, int l) {
    if (SCM & 4) for (int vb = F.vcu; vb < 256; vb += F.G) s5_block(F, a, l, vb);
    for (int vb = F.vcu; vb < 256; vb += F.G) {
        if (vb < 128) { if (SCM & 1) gdn_block(F, vb); }
        else { if (SCM & 2) rwkv_block(F, vb - 128); }
    }
}

__device__ __forceinline__ void post_phase(const Ctx& F, const Args& a, int l) {
    const bf16* PROJ = (const bf16*)(F.ws + WS_PROJ); bf16* OBR = (bf16*)(F.ws + WS_OBR);
    const float* GO = (const float*)(F.ws + WS_GO); const float* RY = (const float*)(F.ws + WS_RY); const float* RV = (const float*)(F.ws + WS_RV); const float* RBON = (const float*)(F.ws + WS_RBON);
    const int c0 = 16 * F.lane;
    float nw[16], lw[16], lb[16];
#pragma unroll
    for (int e = 0; e < 16; ++e) { nw[e] = a.in[6][l * 128 + (c0 & 127) + e]; lw[e] = a.in[15][l * 1024 + c0 + e]; lb[e] = a.in[16][l * 1024 + c0 + e]; }
    for (int tok = F.gw; tok < TOK; tok += F.NGW) {
        { float o[16];
#pragma unroll
          for (int q = 0; q < 4; ++q) { const f32x4 v = *(const f32x4*)(GO + (size_t)tok * 1024 + c0 + 4 * q); o[4 * q] = v.x; o[4 * q + 1] = v.y; o[4 * q + 2] = v.z; o[4 * q + 3] = v.w; }
          float ss = 0.f;
#pragma unroll
          for (int e = 0; e < 16; ++e) ss += o[e] * o[e];
          ss = allred8(ss);
          const float rs = 1.f / sqrtf(ss * (1.f / 128.f) + 1e-6f);
          float z[16]; { float z0[8], z1[8]; unpack8(*(const u32x4*)(PROJ + (size_t)tok * NINP + C_GZ + c0), z0); unpack8(*(const u32x4*)(PROJ + (size_t)tok * NINP + C_GZ + c0 + 8), z1);
#pragma unroll
              for (int e = 0; e < 8; ++e) { z[e] = z0[e]; z[8 + e] = z1[e]; } }
          float r0[8], r1[8];
#pragma unroll
          for (int e = 0; e < 8; ++e) { r0[e] = o[e] * rs * nw[e] * siluf_(z[e]); r1[e] = o[8 + e] * rs * nw[8 + e] * siluf_(z[8 + e]); }
          *(u32x4*)(OBR + (size_t)tok * 1024 + c0) = pack8(r0); *(u32x4*)(OBR + (size_t)tok * 1024 + c0 + 8) = pack8(r1); }
        { float y[16], v[16];
#pragma unroll
          for (int q = 0; q < 4; ++q) { const f32x4 t = *(const f32x4*)(RY + (size_t)tok * 1024 + c0 + 4 * q); y[4 * q] = t.x; y[4 * q + 1] = t.y; y[4 * q + 2] = t.z; y[4 * q + 3] = t.w;
              const f32x4 w = *(const f32x4*)(RV + (size_t)tok * 1024 + c0 + 4 * q); v[4 * q] = w.x; v[4 * q + 1] = w.y; v[4 * q + 2] = w.z; v[4 * q + 3] = w.w; }
          float s = 0.f;
#pragma unroll
          for (int e = 0; e < 16; ++e) s += y[e];
          s += dppf<0xB1>(s); s += dppf<0x4E>(s);
          const float mean = s * (1.f / 64.f); float q2 = 0.f;
#pragma unroll
          for (int e = 0; e < 16; ++e) { const float d = y[e] - mean; q2 += d * d; }
          q2 += dppf<0xB1>(q2); q2 += dppf<0x4E>(q2);
          const float rs = 1.f / sqrtf(q2 * (1.f / 64.f) + 64e-5f);
          const float bon = RBON[(size_t)tok * 16 + (c0 >> 6)];
          float z[16]; { float z0[8], z1[8]; unpack8(*(const u32x4*)(PROJ + (size_t)tok * NINP + C_RZ + c0), z0); unpack8(*(const u32x4*)(PROJ + (size_t)tok * NINP + C_RZ + c0 + 8), z1);
#pragma unroll
              for (int e = 0; e < 8; ++e) { z[e] = z0[e]; z[8 + e] = z1[e]; } }
          float r0[8], r1[8];
#pragma unroll
          for (int e = 0; e < 8; ++e) { r0[e] = ((y[e] - mean) * rs * lw[e] + lb[e] + bon * v[e]) * siluf_(z[e]); r1[e] = ((y[8 + e] - mean) * rs * lw[8 + e] + lb[8 + e] + bon * v[8 + e]) * siluf_(z[8 + e]); }
          bf16* ob = OBR + (size_t)TOK * 1024 + (size_t)tok * 1024 + c0;
          *(u32x4*)ob = pack8(r0); *(u32x4*)(ob + 8) = pack8(r1); }
    }
}

#ifndef PHM
#define PHM 0xFFFF
#endif
#ifndef REPM
#define REPM 0
#endif
__global__ void __launch_bounds__(NTHREADS, 2) hybrid_fwd(Args a) {
    extern __shared__ __attribute__((aligned(16))) unsigned char lds_raw[];
    Ctx F;
    F.lds = (LAS unsigned char*)lds_raw; F.ws = a.ws;
    F.G = gridDim.x; { const int bx = blockIdx.x; F.vcu = (F.G % 8 == 0) ? (bx % 8) * (F.G / 8) + bx / 8 : bx; }
    F.NGW = F.G * NWAVES;
    cg::grid_group grid = cg::this_grid();
    if (threadIdx.x < 8) ((volatile LAS unsigned*)(F.lds + MISC_OFF))[threadIdx.x] = 0u;
    __syncthreads();
    XcdBarrier bar = xcd_barrier_post((unsigned*)(a.ws + WS_CTL), (volatile LAS unsigned*)(F.lds + MISC_OFF));
    bf16* XN = (bf16*)(a.ws + WS_XN); bf16* PROJ = (bf16*)(a.ws + WS_PROJ);
    int rep = 0;
    for (int ph = a.ph_lo; ph < a.ph_hi; ) {
        { int t_ = threadIdx.x; asm volatile("" : "+v"(t_)); F.tid = t_; F.lane = t_ & 63; F.wave = __builtin_amdgcn_readfirstlane(t_ >> 6); F.gw = F.vcu * NWAVES + F.wave; }
        if (ph == 0) { if (PHM & 1) phase0(F, a);
            if (REPM & 128) { if (!rep) { rep = 1; __syncthreads(); continue; } rep = 0; } }
        else {
            const int l = (ph - 1) / PH_PER_LAYER, k = (ph - 1) % PH_PER_LAYER;
            if (k == 0 && (PHM & 2)) {
                pg8::Gemm g{XN, (const bf16*)(a.ws + WS_WIN) + (size_t)l * NINP * DM, TOK, NINP, DM}; pg8::StaticOrder S; S.init(TOK, NINP, F.G, (int)blockIdx.x);
                pg8::EpiBf16<0> E{PROJ, NINP, nullptr, 0, 0, 1.f};
                pg8::gemm_phase<pg8::EpiBf16<0>, pg8::StaticOrder, true, true>(F.lds, g, S, E);
            } else if (k == 1) { if (PHM & 4) prep_gdn(F, a, l); if (PHM & 8) prep_rwkv(F, a, l); }
            else if (k == 2) { if (PHM & 16) scan_phase(F, a, l); }
            else if (k == 3 && (PHM & 32)) {
                if (PHM & 256) post_phase(F, a, l);
                __syncthreads();
                pg8::Gemm g{(const bf16*)(a.ws + WS_SY), (const bf16*)(a.ws + WS_WGLU) + (size_t)l * 1024 * 1024, TOK, 1024, 1024}; pg8::StaticOrder S; S.init(TOK, 1024, F.G, (int)blockIdx.x);
                pg8::EpiGlu E{(const bf16*)(a.ws + WS_SY), PROJ, a.in[26] + l * 1024, (bf16*)(a.ws + WS_OBR) + (size_t)2 * TOK * 1024};
                pg8::gemm_phase<pg8::EpiGlu, pg8::StaticOrder, true, true>(F.lds, g, S, E);
            } else if (k == 4 && (PHM & 64)) {
                pg8::Gemm g{(const bf16*)(a.ws + WS_OBR), (const bf16*)(a.ws + WS_WBR) + (size_t)l * 3 * DM * 1024, 3 * TOK, 3 * DM, 1024};
                pg8::BranchOrder S; S.base.init(TOK, DM, F.G, (int)blockIdx.x);
                pg8::EpiBranch E{PROJ, a.in[27] + (size_t)l * 3 * DM, (float*)(a.ws + WS_ACCF), (bf16*)(a.ws + WS_MRG)};
                pg8::gemm_phase<pg8::EpiBranch, pg8::BranchOrder, true, true>(F.lds, g, S, E);
            } else if (k == 5 && (PHM & 128)) {
                pg8::Gemm g{(const bf16*)(a.ws + WS_MRG), (const bf16*)(a.ws + WS_WOUT) + (size_t)l * DM * DM, TOK, DM, DM}; pg8::StaticOrder S; S.init(TOK, DM, F.G, (int)blockIdx.x);
                pg8::EpiResid E{l == 0 ? a.in[0] : a.out, a.out};
                pg8::gemm_phase<pg8::EpiResid, pg8::StaticOrder, true, true>(F.lds, g, S, E);
            } else if (k == 6) {
                if (l + 1 < DEPTH) { for (int m = F.gw; m < TOK; m += F.NGW) rms_row(a.out + (size_t)m * DM, a.in[1] + (size_t)(l + 1) * DM, XN + (size_t)m * DM, nullptr, F.lane); }
                else { for (int m = F.gw; m < TOK; m += F.NGW) rms_row(a.out + (size_t)m * DM, a.in[30], nullptr, a.out + (size_t)m * DM, F.lane); }
            }
            if (REPM && !rep && ((REPM >> k) & 1)) { rep = 1; __syncthreads(); continue; }
            rep = 0;
        }
        if (ph + 1 < a.ph_hi) {
            if (ph == 0) { __threadfence(); grid.sync(); __builtin_amdgcn_fence(__ATOMIC_ACQUIRE, "agent"); }
            else xcd_barrier(bar);
            if (REPM & 256) xcd_barrier(bar);
        }
        ++ph;
    }
}

#ifndef MK_MULTI
#define MK_MULTI 0
#endif
extern "C" void kernel_launch(void* const* d_in, const int* in_sizes, int n_in, void* d_out, int out_size, void* d_ws, size_t ws_size, hipStream_t stream) {
    static int grid = 0;
    if (grid == 0) {
        if (n_in != 31 || out_size != TOK * DM || ws_size < WS_END) { fprintf(stderr, "kernel_launch: unexpected shapes (n_in %d out %d ws %zu)\n", n_in, out_size, ws_size); grid = -1; return; }
        int dev = 0, cus = 0, per_cu = 0;
        hipGetDevice(&dev); hipDeviceGetAttribute(&cus, hipDeviceAttributeMultiprocessorCount, dev);
        if (hipFuncSetAttribute((const void*)hybrid_fwd, hipFuncAttributeMaxDynamicSharedMemorySize, LDS_BYTES) != hipSuccess) { fprintf(stderr, "kernel_launch: hipFuncSetAttribute failed\n"); grid = -1; return; }
        if (hipOccupancyMaxActiveBlocksPerMultiprocessor(&per_cu, (const void*)hybrid_fwd, NTHREADS, LDS_BYTES) != hipSuccess || per_cu < 1) per_cu = 1;
        (void)hipGetLastError();
        grid = cus * per_cu;
        fprintf(stderr, "kernel_launch: grid %d (cus %d x %d)\n", grid, cus, per_cu);
    }
    if (grid < 0) return;
    if (hipMemsetAsync((char*)d_ws + WS_CTL, 0, CTL_ZERO_BYTES, stream) != hipSuccess) { fprintf(stderr, "kernel_launch: memset failed\n"); return; }
    Args a{};
    for (int i = 0; i < 31; ++i) a.in[i] = (const float*)d_in[i];
    a.out = (float*)d_out; a.ws = (unsigned char*)d_ws;
#if MK_MULTI
    for (int ph = 0; ph < NPHASES; ++ph) { a.ph_lo = ph; a.ph_hi = ph + 1; hipLaunchKernelGGL(hybrid_fwd, dim3(grid), dim3(NTHREADS), LDS_BYTES, stream, a); }
#else
    a.ph_lo = 0; a.ph_hi = NPHASES;
    void* args[] = {&a};
    const hipError_t e = hipLaunchCooperativeKernel((const void*)hybrid_fwd, dim3(grid), dim3(NTHREADS), args, LDS_BYTES, stream);
    if (e != hipSuccess) fprintf(stderr, "kernel_launch: cooperative launch failed: %s (grid %d)\n", hipGetErrorString(e), grid);
#endif
}
```

```cpp
#include <hip/hip_runtime.h>
#include <hip/hip_cooperative_groups.h>
#include <cstdio>
#include <cstdint>
namespace cg = cooperative_groups;
namespace pg8 {
#define PG8_LAS __attribute__((address_space(3)))
typedef unsigned short bf16_t;
typedef short bf16x8 __attribute__((ext_vector_type(8)));
typedef float f32x4 __attribute__((ext_vector_type(4)));
typedef unsigned u32x4 __attribute__((ext_vector_type(4)));
constexpr int BM = 256, BK = 64, HALF = 128, HTB = HALF * BK * 2  , STAGE_BYTES = 8 * HTB, NXCD = 8, WGM = 8;

__host__ __device__ __forceinline__ int lds_byte(int r, int c) { const int st = (r >> 4) * 2 + (c >> 5), rr = r & 15, cc = c & 31, ob = rr * 64 + cc * 2; return st * 1024 + (ob ^ (((ob >> 9) & 1) << 5)); }
__host__ __device__ __forceinline__ void stage_rc(int b, int& R, int& C) { const int st = b / 1024, sb = b % 1024, swz = sb ^ (((sb >> 9) & 1) << 5); R = (st >> 1) * 16 + swz / 64; C = (st & 1) * 32 + (swz % 64) / 2; }
__host__ __device__ __forceinline__ int perm32(int rho) { const int n = rho >> 4, i = rho & 15; return 8 * (i >> 2) + 4 * n + (i & 3); }

struct Unit { int pm, pn; };
struct Gemm { const bf16_t* A; const bf16_t* Bt; int M, N, K; };

struct StaticOrder {
    int nM, nN, nwg, G, c;
    __host__ __device__ void init(int M, int N, int G_, int c_) { nM = M / BM; nN = N / BM; nwg = nM * nN; G = G_; c = c_; }
    __host__ __device__ bool next(int i, Unit& u) const {
        const long L = (long)i * G + c; if (L >= nwg) return false;
        int wgid = (int)L; { const int q = nwg / NXCD, r = nwg % NXCD, xcd = wgid % NXCD, off = wgid / NXCD; wgid = (xcd < r ? xcd * (q + 1) : r * (q + 1) + (xcd - r) * q) + off; }
        const int nig = WGM * nN, gid = wgid / nig, fm = gid * WGM, gsz = (nM - fm) < WGM ? (nM - fm) : WGM;
        u.pm = fm + ((wgid % nig) % gsz); u.pn = (wgid % nig) / gsz; return true;
    }
    __device__ __forceinline__ void a_ready(const Unit&) const {}
    __device__ __forceinline__ void done(const Unit&) const {}
};

__device__ __forceinline__ unsigned cvt_pk_bf16(float lo, float hi) { unsigned r; asm volatile("v_cvt_pk_bf16_f32 %0, %1, %2" : "=v"(r) : "v"(lo), "v"(hi)); return r; }
typedef float f32x2 __attribute__((ext_vector_type(2)));
__device__ __forceinline__ f32x2 gelu_pk(f32x2 v) {
    const f32x2 av = __builtin_elementwise_abs(v), d = av * 0.2316418882f + 1.0f;
    f32x2 t; t.x = __builtin_amdgcn_rcpf(d.x); t.y = __builtin_amdgcn_rcpf(d.y);
    f32x2 q = t * 0.5307027145f + (-0.7265760135f); q = q * t + 0.7107068705f; q = q * t + (-0.142248368f); q = q * t + 0.127414796f; q = q * t;
    const f32x2 s = (v * v) * (-0.72134752044f);
    f32x2 e; e.x = __builtin_amdgcn_exp2f(s.x); e.y = __builtin_amdgcn_exp2f(s.y);
    const f32x2 m = v * (q * e), r = v - m;
    f32x2 o; o.x = v.x < 0.f ? m.x : r.x; o.y = v.y < 0.f ? m.y : r.y; return o;
}

template <int ACT  > struct EpiBf16 {
    static constexpr bool PERM = true, AFTER_DRAIN = false; static_assert(ACT == 0 || ACT == 1, "EpiBf16: ACT is 0 (none) or 1 (gelu_pk)");
    bf16_t* O; int ldc; const float* bias; int split_cols; size_t split_stride; float scale0;
    __device__ __forceinline__ void operator()(const f32x4 (&acc)[2][2][4][2], const Unit& u, int wr, int wc, int fr, int fq) const {
        const int row0 = u.pm * BM + wr * 64 + fr; int colt = u.pn * BM; bf16_t* base = O;
        float sc = 1.f; if (split_cols) { const int t = colt / split_cols; base += (size_t)t * split_stride; colt -= t * split_cols; if (t == 0) sc = scale0; }
        const int col0 = colt + wc * 32 + 8 * fq, bcol0 = u.pn * BM + wc * 32 + 8 * fq;
        f32x4 bv[2][2];
#pragma unroll
        for (int bj = 0; bj < 2; ++bj)
#pragma unroll
            for (int n = 0; n < 2; ++n) bv[bj][n] = bias ? *(const f32x4*)(bias + bcol0 + bj * HALF + 4 * n) : (f32x4){0.f, 0.f, 0.f, 0.f};
#pragma unroll
        for (int ai = 0; ai < 2; ++ai)
#pragma unroll
            for (int m = 0; m < 4; ++m) { bf16_t* rowp = base + (size_t)(row0 + ai * HALF + m * 16) * ldc + col0;
#pragma unroll
                for (int bj = 0; bj < 2; ++bj) { f32x4 v0 = acc[ai][bj][m][0] + bv[bj][0], v1 = acc[ai][bj][m][1] + bv[bj][1];
                    if (ACT == 1) { f32x2 a = gelu_pk((f32x2){v0[0], v0[1]}), b = gelu_pk((f32x2){v0[2], v0[3]}), c = gelu_pk((f32x2){v1[0], v1[1]}), d = gelu_pk((f32x2){v1[2], v1[3]});
                        v0 = (f32x4){a.x, a.y, b.x, b.y}; v1 = (f32x4){c.x, c.y, d.x, d.y}; }
                    v0 = v0 * sc; v1 = v1 * sc; u32x4 w; w.x = cvt_pk_bf16(v0[0], v0[1]); w.y = cvt_pk_bf16(v0[2], v0[3]); w.z = cvt_pk_bf16(v1[0], v1[1]); w.w = cvt_pk_bf16(v1[2], v1[3]);
                    *(u32x4*)(rowp + bj * HALF) = w; } }
    }
};

template <class Epi, class Sched, bool ALIGN_EPI = false, bool SP2 = false>
__device__ __forceinline__ void gemm_phase(PG8_LAS unsigned char* lds, const Gemm g, const Sched& S, const Epi& E) {
    int tid_ = threadIdx.x; asm volatile("" : "+v"(tid_));
    const int tid = tid_, wid = __builtin_amdgcn_readfirstlane(tid >> 6), lane = tid & 63, wr = wid >> 2, wc = wid & 3, fr = lane & 15, fq = lane >> 4;
    const int K = g.K, nt = K / BK;
    unsigned voffA[2], voffB[2];
#pragma unroll
    for (int i = 0; i < 2; ++i) { int R, C; stage_rc(tid * 16 + i * 8192, R, C); const int Rb = Epi::PERM ? ((R & ~31) + perm32(R & 31)) : R;
        voffA[i] = (unsigned)(R * K + C) * 2u; voffB[i] = (unsigned)(Rb * K + C) * 2u; }
    const size_t kstep = (size_t)(BK * 2);
    const size_t hstep = (size_t)HALF * K * 2;
    const size_t tstep = 2 * hstep;
    const unsigned ldsw = (unsigned)wid * 1024u;
    const int aoff = lds_byte(wr * 64 + fr, fq * 8), boff = lds_byte(wc * 32 + fr, fq * 8);
#define PG8_SA(b, h) (((b) * 2 + (h)) * HTB)
#define PG8_SB(b, h) ((4 + (b) * 2 + (h)) * HTB)
#define PG8_STAGE(bufoff, gbase, voff) do { _Pragma("unroll") for (int _i = 0; _i < 2; ++_i) \
        __builtin_amdgcn_global_load_lds((const unsigned*)((const char*)(gbase) + (voff)[_i]), (PG8_LAS unsigned*)(lds + (bufoff) + ldsw + _i * 8192), 16, 0, 0); } while (0)
#define PG8_LDA(dst, b, h) do { _Pragma("unroll") for (int m = 0; m < 4; ++m) _Pragma("unroll") for (int k = 0; k < 2; ++k) dst[m][k] = *(const PG8_LAS bf16x8*)(lds + PG8_SA(b, h) + aoff + m * 2048 + k * 1024); } while (0)
#define PG8_LDB(dst, b, h) do { _Pragma("unroll") for (int n = 0; n < 2; ++n) _Pragma("unroll") for (int k = 0; k < 2; ++k) dst[n][k] = *(const PG8_LAS bf16x8*)(lds + PG8_SB(b, h) + boff + n * 2048 + k * 1024); } while (0)
#define PG8_MMA(ai, bj, At, Bt) do { __builtin_amdgcn_s_setprio(1); _Pragma("unroll") for (int m = 0; m < 4; ++m) _Pragma("unroll") for (int n = 0; n < 2; ++n) _Pragma("unroll") for (int k = 0; k < 2; ++k) \
        acc[ai][bj][m][n] = __builtin_amdgcn_mfma_f32_16x16x32_bf16(Bt[n][k], At[m][k], acc[ai][bj][m][n], 0, 0, 0); __builtin_amdgcn_s_setprio(0); } while (0)
#define PG8_WAIT_V(n) asm volatile("s_waitcnt vmcnt(" #n ")" ::: "memory")
#define PG8_WAIT_L(n) asm volatile("s_waitcnt lgkmcnt(" #n ")" ::: "memory")
#define PG8_BAR __builtin_amdgcn_s_barrier()
#define PG8_SCHED __builtin_amdgcn_sched_barrier(0)
    Unit cur, nxt; int ui = 0;
    if (!S.next(0, cur)) return;
    f32x4 acc[2][2][4][2];
#pragma unroll
    for (int a = 0; a < 2; ++a)
#pragma unroll
        for (int b = 0; b < 2; ++b)
#pragma unroll
            for (int m = 0; m < 4; ++m)
#pragma unroll
                for (int n = 0; n < 2; ++n) acc[a][b][m][n] = (f32x4){0.f, 0.f, 0.f, 0.f};
    bf16x8 At[4][2], B0[2][2], B1[2][2];
    const char* cA = (const char*)g.A + (size_t)cur.pm * tstep; const char* cB = (const char*)g.Bt + (size_t)cur.pn * tstep;
    S.a_ready(cur);
    if constexpr (SP2) {
        PG8_STAGE(PG8_SB(0, 0), cB, voffB); PG8_STAGE(PG8_SB(0, 1), cB + hstep, voffB); PG8_STAGE(PG8_SA(0, 0), cA, voffA); PG8_STAGE(PG8_SA(0, 1), cA + hstep, voffA);
        if (wr == 1) PG8_BAR;
        PG8_WAIT_V(2); PG8_BAR;
        PG8_STAGE(PG8_SB(1, 0), cB + kstep, voffB); PG8_STAGE(PG8_SA(1, 0), cA + kstep, voffA); PG8_STAGE(PG8_SB(1, 1), cB + hstep + kstep, voffB);
        PG8_WAIT_V(6); PG8_BAR;
    } else {
        PG8_STAGE(PG8_SB(0, 0), cB, voffB); PG8_STAGE(PG8_SA(0, 0), cA, voffA); PG8_STAGE(PG8_SB(0, 1), cB + hstep, voffB); PG8_STAGE(PG8_SA(0, 1), cA + hstep, voffA);
        if (wr == 1) PG8_BAR;
        PG8_WAIT_V(4); PG8_BAR;
        PG8_STAGE(PG8_SB(1, 0), cB + kstep, voffB); PG8_STAGE(PG8_SA(1, 0), cA + kstep, voffA); PG8_STAGE(PG8_SB(1, 1), cB + hstep + kstep, voffB);
        PG8_WAIT_V(6); PG8_BAR;
    }
    for (;;) {
        const bool has_next = S.next(ui + 1, nxt);
        const char* nA = has_next ? (const char*)g.A + (size_t)nxt.pm * tstep : cA; const char* nB = has_next ? (const char*)g.Bt + (size_t)nxt.pn * tstep : cB;
        for (int t = 0; t < nt; t += 2) {
            const bool last = (t == nt - 2);
            const char* a1 = cA + (size_t)(t + 1) * kstep;
            const char* a2 = last ? nA : cA + (size_t)(t + 2) * kstep; const char* b2 = last ? nB : cB + (size_t)(t + 2) * kstep;
            const char* a3 = a2 + kstep; const char* b3 = b2 + kstep;
            if (last && has_next) S.a_ready(nxt);
            if constexpr (SP2) {
            PG8_LDB(B0, 0, 0); PG8_LDB(B1, 0, 1); PG8_SCHED; PG8_LDA(At, 0, 0); PG8_STAGE(PG8_SA(1, 1), a1 + hstep, voffA);
            PG8_WAIT_V(8); PG8_WAIT_L(0); PG8_BAR; PG8_MMA(0, 0, At, B0); PG8_MMA(0, 1, At, B1); PG8_BAR; PG8_SCHED;
            PG8_LDA(At, 0, 1); PG8_STAGE(PG8_SB(0, 0), b2, voffB); PG8_STAGE(PG8_SB(0, 1), b2 + hstep, voffB); PG8_STAGE(PG8_SA(0, 0), a2, voffA);
            PG8_WAIT_V(8); PG8_WAIT_L(0); PG8_BAR; PG8_MMA(1, 0, At, B0); PG8_MMA(1, 1, At, B1); PG8_BAR; PG8_SCHED;
            PG8_LDB(B0, 1, 0); PG8_LDB(B1, 1, 1); PG8_SCHED; PG8_LDA(At, 1, 0); PG8_STAGE(PG8_SA(0, 1), a2 + hstep, voffA);
            PG8_WAIT_V(8); PG8_WAIT_L(0); PG8_BAR; PG8_MMA(0, 0, At, B0); PG8_MMA(0, 1, At, B1); PG8_BAR; PG8_SCHED;
            PG8_LDA(At, 1, 1); PG8_STAGE(PG8_SB(1, 0), b3, voffB); PG8_STAGE(PG8_SB(1, 1), b3 + hstep, voffB); PG8_STAGE(PG8_SA(1, 0), a3, voffA);
            PG8_WAIT_V(8); PG8_WAIT_L(0); PG8_BAR; PG8_MMA(1, 0, At, B0); PG8_MMA(1, 1, At, B1); PG8_BAR; PG8_SCHED;
            } else {
            PG8_LDB(B0, 0, 0); PG8_SCHED; PG8_LDA(At, 0, 0); PG8_STAGE(PG8_SA(1, 1), a1 + hstep, voffA);
            PG8_WAIT_L(8); PG8_BAR; PG8_WAIT_L(0); PG8_MMA(0, 0, At, B0); PG8_BAR; PG8_SCHED;
            PG8_LDB(B1, 0, 1); PG8_STAGE(PG8_SB(0, 0), b2, voffB);
            PG8_BAR; PG8_WAIT_L(0); PG8_MMA(0, 1, At, B1); PG8_BAR;
            PG8_LDA(At, 0, 1); PG8_STAGE(PG8_SA(0, 0), a2, voffA);
            PG8_BAR; PG8_WAIT_L(0); PG8_MMA(1, 0, At, B0); PG8_BAR; PG8_SCHED;
            PG8_STAGE(PG8_SB(0, 1), b2 + hstep, voffB);
            PG8_WAIT_V(6); PG8_BAR; PG8_MMA(1, 1, At, B1); PG8_BAR;
            PG8_LDB(B0, 1, 0); PG8_SCHED; PG8_LDA(At, 1, 0); PG8_STAGE(PG8_SA(0, 1), a2 + hstep, voffA);
            PG8_WAIT_L(8); PG8_BAR; PG8_WAIT_L(0); PG8_MMA(0, 0, At, B0); PG8_BAR; PG8_SCHED;
            PG8_LDB(B1, 1, 1); PG8_STAGE(PG8_SB(1, 0), b3, voffB);
            PG8_BAR; PG8_WAIT_L(0); PG8_MMA(0, 1, At, B1); PG8_BAR;
            PG8_LDA(At, 1, 1); PG8_STAGE(PG8_SA(1, 0), a3, voffA);
            PG8_BAR; PG8_WAIT_L(0); PG8_MMA(1, 0, At, B0); PG8_BAR; PG8_SCHED;
            PG8_STAGE(PG8_SB(1, 1), b3 + hstep, voffB);
            PG8_WAIT_V(6); PG8_BAR; PG8_MMA(1, 1, At, B1); PG8_BAR;
            }
        }
        if constexpr (ALIGN_EPI) { if (wr == 0) PG8_BAR; }
        if constexpr (!Epi::AFTER_DRAIN) { E(acc, cur, wr, wc, fr, fq); S.done(cur); }
        if (!has_next) break;
#pragma unroll
        for (int a = 0; a < 2; ++a)
#pragma unroll
            for (int b = 0; b < 2; ++b)
#pragma unroll
                for (int m = 0; m < 4; ++m)
#pragma unroll
                    for (int n = 0; n < 2; ++n) acc[a][b][m][n] = (f32x4){0.f, 0.f, 0.f, 0.f};
        cur = nxt; cA = nA; cB = nB; ++ui;
        if constexpr (ALIGN_EPI) { if (wr == 1) PG8_BAR; }
    }
    PG8_WAIT_V(0);
    if constexpr (!ALIGN_EPI) { if (wr == 0) PG8_BAR; }
    PG8_BAR;
    if constexpr (Epi::AFTER_DRAIN) { E.fused(acc, cur, wr, wc, fr, fq, lds, wid, lane); S.done(cur); }
#undef PG8_SA
#undef PG8_SB
#undef PG8_STAGE
#undef PG8_LDA
#undef PG8_LDB
#undef PG8_MMA
#undef PG8_WAIT_V
#undef PG8_WAIT_L
#undef PG8_BAR
#undef PG8_SCHED
}
}

#define GAS __attribute__((address_space(1)))
#define LAS __attribute__((address_space(3)))
typedef unsigned short bf16;
typedef unsigned u32x4 __attribute__((ext_vector_type(4)));
typedef unsigned u32x2 __attribute__((ext_vector_type(2)));
typedef float f32x4 __attribute__((ext_vector_type(4)));
typedef float f32x2 __attribute__((ext_vector_type(2)));

constexpr int NBATCH = 4, SEQ = 2048, TOK = NBATCH * SEQ, DM = 2048, DEPTH = 4;
constexpr int NIN = 16592, NINP = 16640;
constexpr int C_GQKV = 0, C_GZ = 3072, C_GB = 4096, C_GA = 4104, C_RF = 4112, C_RZ = 7376, C_SU = 8400, C_SZ = 9424, C_GATE = 10448;
constexpr int NWAVES = 8, NTHREADS = 512;
constexpr int LDS_BYTES = 147456;
constexpr int PH_PER_LAYER = 7, NPHASES = 1 + DEPTH * PH_PER_LAYER;

constexpr size_t MiB = 1u << 20;
constexpr size_t WS_WIN = 0, WS_WGLU = 260 * MiB, WS_WBR = 268 * MiB, WS_WOUT = 316 * MiB, WS_XN = 348 * MiB, WS_PROJ = 380 * MiB;
constexpr size_t WS_GQ = 640 * MiB, WS_GK = 672 * MiB, WS_GV = 704 * MiB, WS_GEG = 736 * MiB, WS_GBE = 737 * MiB, WS_GO = 738 * MiB;
constexpr size_t WS_RR = 770 * MiB, WS_RW = 802 * MiB, WS_RK = 834 * MiB, WS_RV = 866 * MiB, WS_RKK = 898 * MiB, WS_RKA = 930 * MiB, WS_RBON = 962 * MiB, WS_RY = 963 * MiB;
constexpr size_t WS_SY = 995 * MiB, WS_OBR = 1011 * MiB, WS_ACCF = 1059 * MiB, WS_MRG = 1123 * MiB, WS_CTL = 1155 * MiB, WS_END = 1156 * MiB;
constexpr size_t CTL_ZERO_BYTES = 65536;
constexpr int MISC_OFF = 147392;
static_assert((size_t)DEPTH * NINP * DM * 2 == 260 * MiB && (size_t)TOK * NINP * 2 == 260 * MiB, "ws map");

__device__ __forceinline__ unsigned f2bf(float f) { unsigned u = __builtin_bit_cast(unsigned, f); return (u + 0x7fffu + ((u >> 16) & 1u)) >> 16; }
__device__ __forceinline__ unsigned pk2(float lo, float hi) { return f2bf(lo) | (f2bf(hi) << 16); }
__device__ __forceinline__ float bflo(unsigned w) { return __builtin_bit_cast(float, w << 16); }
__device__ __forceinline__ float bfhi(unsigned w) { return __builtin_bit_cast(float, w & 0xffff0000u); }
__device__ __forceinline__ float bf1(bf16 h) { return __builtin_bit_cast(float, (unsigned)h << 16); }
__device__ __forceinline__ float sigmoidf_(float x) { return 1.f / (1.f + __expf(-x)); }
__device__ __forceinline__ float siluf_(float x) { return x / (1.f + __expf(-x)); }
__device__ __forceinline__ float softplusf_(float x) { return x > 20.f ? x : log1pf(expf(x)); }
__device__ __forceinline__ float gelu_tanh(float y) { const float t = 0.7978845608028654f * (y + 0.044715f * y * y * y); const float th = 1.f - 2.f / (1.f + __expf(2.f * t)); return 0.5f * y * (1.f + th); }
template <int CTRL> __device__ __forceinline__ float dppf(float v) { return __builtin_bit_cast(float, __builtin_amdgcn_update_dpp(0, __builtin_bit_cast(int, v), CTRL, 0xF, 0xF, true)); }
__device__ __forceinline__ float allred8(float v) { v += dppf<0xB1>(v); v += dppf<0x4E>(v); v += dppf<0x141>(v); return v; }
__device__ __forceinline__ float allred16(float v) { v = allred8(v); v += dppf<0x140>(v); return v; }
__device__ __forceinline__ float wave_sum(float v) {
#pragma unroll
    for (int o = 1; o < 64; o <<= 1) v += __shfl_xor(v, o);
    return v;
}
__device__ __forceinline__ void unpack8(const u32x4 w, float (&f)[8]) { f[0] = bflo(w.x); f[1] = bfhi(w.x); f[2] = bflo(w.y); f[3] = bfhi(w.y); f[4] = bflo(w.z); f[5] = bfhi(w.z); f[6] = bflo(w.w); f[7] = bfhi(w.w); }
__device__ __forceinline__ u32x4 pack8(const float (&f)[8]) { u32x4 w; w.x = pk2(f[0], f[1]); w.y = pk2(f[2], f[3]); w.z = pk2(f[4], f[5]); w.w = pk2(f[6], f[7]); return w; }

namespace pg8 {
struct EpiGlu {
    static constexpr bool PERM = true, AFTER_DRAIN = false;
    const bf16* Y1; const bf16* PROJ; const float* bias; bf16* O;
    __device__ __forceinline__ void operator()(const f32x4 (&acc)[2][2][4][2], const Unit& u, int wr, int wc, int fr, int fq) const {
        int row0 = u.pm * BM + wr * 64 + fr, col0 = u.pn * BM + wc * 32 + 8 * fq;
        asm volatile("" : "+v"(row0), "+v"(col0));
#pragma unroll
        for (int bj = 0; bj < 2; ++bj) {
            const int col = col0 + bj * HALF;
            const f32x4 b0 = *(const f32x4*)(bias + col), b1 = *(const f32x4*)(bias + col + 4);
#pragma unroll
            for (int ai = 0; ai < 2; ++ai)
#pragma unroll
                for (int m = 0; m < 4; ++m) {
                    const size_t row = (size_t)(row0 + ai * HALF + m * 16);
                    const u32x4 y8 = *(const u32x4*)(Y1 + row * 1024 + col), z8 = *(const u32x4*)(PROJ + row * NINP + C_SZ + col);
                    float y[8], z[8], o[8]; unpack8(y8, y); unpack8(z8, z);
                    const f32x4 v0 = acc[ai][bj][m][0] + b0, v1 = acc[ai][bj][m][1] + b1;
                    const float a[8] = {v0[0], v0[1], v0[2], v0[3], v1[0], v1[1], v1[2], v1[3]};
#pragma unroll
                    for (int e = 0; e < 8; ++e) o[e] = y[e] * sigmoidf_(a[e]) * siluf_(z[e]);
                    *(u32x4*)(O + row * 1024 + col) = pack8(o);
                    asm volatile("" ::: "memory");
                }
        }
    }
};
struct EpiBranch {
    static constexpr bool PERM = true, AFTER_DRAIN = false;
    const bf16* PROJ; const float* gate_b; float* ACCF; bf16* MRG;
    __device__ __forceinline__ void operator()(const f32x4 (&acc)[2][2][4][2], const Unit& u, int wr, int wc, int fr, int fq) const {
        const int br = u.pm >> 5, pm = u.pm & 31, pn = u.pn & 7;
        int row0 = pm * BM + wr * 64 + fr, col0 = pn * BM + wc * 32 + 8 * fq;
        asm volatile("" : "+v"(row0), "+v"(col0));
#pragma unroll
        for (int bj = 0; bj < 2; ++bj) {
            const int col = col0 + bj * HALF;
            const f32x4 g0 = *(const f32x4*)(gate_b + br * DM + col), g1 = *(const f32x4*)(gate_b + br * DM + col + 4);
            const float gb[8] = {g0[0], g0[1], g0[2], g0[3], g1[0], g1[1], g1[2], g1[3]};
#pragma unroll
            for (int ai = 0; ai < 2; ++ai)
#pragma unroll
                for (int m = 0; m < 4; ++m) {
                    const size_t row = (size_t)(row0 + ai * HALF + m * 16);
                    const u32x4 l8 = *(const u32x4*)(PROJ + row * NINP + C_GATE + br * DM + col);
                    float gl[8], o[8]; unpack8(l8, gl);
                    const f32x4 v0 = acc[ai][bj][m][0], v1 = acc[ai][bj][m][1];
                    const float a[8] = {v0[0], v0[1], v0[2], v0[3], v1[0], v1[1], v1[2], v1[3]};
#pragma unroll
                    for (int e = 0; e < 8; ++e) o[e] = sigmoidf_(gl[e] + gb[e]) * a[e];
                    float* ap = ACCF + row * DM + col;
                    if (br > 0) { const f32x4 p0 = *(const f32x4*)ap, p1 = *(const f32x4*)(ap + 4);
                        o[0] += p0[0]; o[1] += p0[1]; o[2] += p0[2]; o[3] += p0[3]; o[4] += p1[0]; o[5] += p1[1]; o[6] += p1[2]; o[7] += p1[3]; }
                    if (br < 2) { *(f32x4*)ap = (f32x4){o[0], o[1], o[2], o[3]}; *(f32x4*)(ap + 4) = (f32x4){o[4], o[5], o[6], o[7]}; }
                    else *(u32x4*)(MRG + row * DM + col) = pack8(o);
                    asm volatile("" ::: "memory");
                }
        }
    }
};
struct EpiResid {
    static constexpr bool PERM = true, AFTER_DRAIN = false;
    const float* base; float* out;
    __device__ __forceinline__ void operator()(const f32x4 (&acc)[2][2][4][2], const Unit& u, int wr, int wc, int fr, int fq) const {
        int row0 = u.pm * BM + wr * 64 + fr, col0 = u.pn * BM + wc * 32 + 8 * fq;
        asm volatile("" : "+v"(row0), "+v"(col0));
#pragma unroll
        for (int ai = 0; ai < 2; ++ai)
#pragma unroll
            for (int m = 0; m < 4; ++m)
#pragma unroll
                for (int bj = 0; bj < 2; ++bj) {
                    const size_t off = (size_t)(row0 + ai * HALF + m * 16) * DM + col0 + bj * HALF;
                    const f32x4 p0 = *(const f32x4*)(base + off), p1 = *(const f32x4*)(base + off + 4);
                    *(f32x4*)(out + off) = p0 + acc[ai][bj][m][0]; *(f32x4*)(out + off + 4) = p1 + acc[ai][bj][m][1];
                }
    }
};
struct BranchOrder {
    StaticOrder base;
    __device__ bool next(int i, Unit& u) const { Unit t; const int r = i / 3, br = i - 3 * r; if (!base.next(r, t)) return false; u.pm = br * 32 + t.pm; u.pn = br * 8 + t.pn; return true; }
    __device__ __forceinline__ void a_ready(const Unit&) const {}
    __device__ __forceinline__ void done(const Unit&) const {}
};
}

#define XB_TMO      128
#define XB_XCNT(j)  (256  + 64 * (j))
#define XB_XSUB(j)  (1280 + 64 * (j))
#define XB_XGEN(j)  (2304 + 64 * (j))
#define XB_TOP      3328
#define XB_TOPGEN   3392
#define XCD_BAR_WORDS 3456
#define XB_SPIN_CAP (1u << 18)

__device__ __forceinline__ unsigned xb_ld(unsigned* p)              { return __hip_atomic_load(p, __ATOMIC_RELAXED, __HIP_MEMORY_SCOPE_AGENT); }
__device__ __forceinline__ unsigned xb_add(unsigned* p, unsigned v) { return __hip_atomic_fetch_add(p, v, __ATOMIC_RELAXED, __HIP_MEMORY_SCOPE_AGENT); }
__device__ __forceinline__ unsigned xb_xcc_id() { return (unsigned)__builtin_amdgcn_s_getreg((3 << 11) | 20) & 0xFu; }
#define XB_SPIN(cond, bar) do { unsigned _sp = 0; while (cond) { __builtin_amdgcn_s_sleep(1); \
    if ((++_sp & 255u) == 0u) { if (xb_ld(&(bar)[XB_TMO])) break; if (_sp > XB_SPIN_CAP) { atomicAdd(&(bar)[XB_TMO], 1u); break; } } } } while (0)

struct XcdBarrier {
    unsigned* bar; unsigned x;
    volatile LAS unsigned* st;
};

__device__ __forceinline__ XcdBarrier xcd_barrier_post(unsigned* bar, volatile LAS unsigned* st) {
    XcdBarrier b; b.bar = bar; b.x = xb_xcc_id(); b.st = st;
    if (threadIdx.x == 0) (void)xb_add(&bar[XB_XCNT(b.x)], 1u);
    return b;
}
__device__ __forceinline__ void xcd_barrier_complete(unsigned* bar, unsigned x, unsigned& nloc, unsigned& nx) {
    const unsigned G = gridDim.x * gridDim.y * gridDim.z;
    unsigned sum, cnt, mine, sp = 0u;
    for (;;) {
        sum = 0u; cnt = 0u; mine = 0u;
#pragma unroll
        for (unsigned j = 0; j < 16; ++j) { const unsigned c = xb_ld(&bar[XB_XCNT(j)]); sum += c; cnt += (c > 0u) ? 1u : 0u; mine = (j == x) ? c : mine; }
        if (sum == G) break;
        __builtin_amdgcn_s_sleep(1);
        if ((++sp & 255u) == 0u) { if (xb_ld(&bar[XB_TMO])) break; if (sp > XB_SPIN_CAP) { atomicAdd(&bar[XB_TMO], 1u); break; } }
    }
    nloc = mine > 0u ? mine : 1u; nx = cnt > 0u ? cnt : 1u;
}

__device__ __forceinline__ void xcd_barrier(const XcdBarrier& b) {
    asm volatile("s_waitcnt vmcnt(0)" ::: "memory");
    __syncthreads();
    if (threadIdx.x == 0) {
        unsigned* bar = b.bar;
        __builtin_amdgcn_s_waitcnt(0);
        unsigned nloc = b.st[0], nx = b.st[1];
        if (nloc == 0u) { xcd_barrier_complete(bar, b.x, nloc, nx); b.st[0] = nloc; b.st[1] = nx; }
        const unsigned old = xb_add(&bar[XB_XSUB(b.x)], 1u);
        const unsigned gen = old / nloc;
        if (old + 1u == (gen + 1u) * nloc) {
            __builtin_amdgcn_fence(__ATOMIC_RELEASE, "agent");
            asm volatile("s_waitcnt vmcnt(0)" ::: "memory");
            const unsigned og = xb_add(&bar[XB_TOP], 1u);
            const unsigned tg = og / nx;
            if (og + 1u == (tg + 1u) * nx) xb_add(&bar[XB_TOPGEN], 1u);
            else XB_SPIN(xb_ld(&bar[XB_TOPGEN]) == tg, bar);
            __builtin_amdgcn_fence(__ATOMIC_ACQUIRE, "agent");
            xb_add(&bar[XB_XGEN(b.x)], 1u);
            asm volatile("s_waitcnt vmcnt(0)" ::: "memory");
        } else {
            XB_SPIN(xb_ld(&bar[XB_XGEN(b.x)]) == gen, bar);
            __builtin_amdgcn_fence(__ATOMIC_ACQUIRE, "agent");
            asm volatile("s_waitcnt vmcnt(0)" ::: "memory");
        }
    }
    __syncthreads();
}

struct Args { const float* in[31]; float* out; unsigned char* ws; int ph_lo, ph_hi; };
struct Ctx { int tid, lane, wave, vcu, G, gw, NGW; LAS unsigned char* lds; unsigned char* ws; };

__device__ __forceinline__ void transpose_item(const float* W, int K, int N, bf16* WT, LAS float* scr, int kb, int nb, int lane) {
    const int k0 = 64 * kb, n0 = 64 * nb, nq = 4 * (lane & 15), kr = lane >> 4; const bool nv = n0 + nq < N;
    f32x4 v[16];
#pragma unroll
    for (int i = 0; i < 16; ++i) v[i] = nv ? *(const f32x4*)(W + (size_t)(k0 + 4 * i + kr) * N + n0 + nq) : (f32x4){0.f, 0.f, 0.f, 0.f};
#pragma unroll
    for (int i = 0; i < 16; ++i) { LAS float* d = scr + (4 * i + kr) * 65 + nq; d[0] = v[i].x; d[1] = v[i].y; d[2] = v[i].z; d[3] = v[i].w; }
    asm volatile("s_waitcnt lgkmcnt(0)" ::: "memory");
    const int c = lane & 7;
#pragma unroll
    for (int j = 0; j < 8; ++j) { const int nn = (lane >> 3) + 8 * j; const LAS float* s = scr + (8 * c) * 65 + nn;
        u32x4 o; o.x = pk2(s[0 * 65], s[1 * 65]); o.y = pk2(s[2 * 65], s[3 * 65]); o.z = pk2(s[4 * 65], s[5 * 65]); o.w = pk2(s[6 * 65], s[7 * 65]);
        *(u32x4*)(WT + (size_t)(n0 + nn) * K + k0 + 8 * c) = o; }
    asm volatile("s_waitcnt lgkmcnt(0)" ::: "memory");
}

__device__ __forceinline__ void rms_row(const float* xrow, const float* w, bf16* obf, float* of32, int lane) {
    f32x4 v[8]; float s = 0.f;
#pragma unroll
    for (int j = 0; j < 8; ++j) { v[j] = *(const f32x4*)(xrow + 4 * lane + 256 * j); s += (v[j].x * v[j].x + v[j].y * v[j].y) + (v[j].z * v[j].z + v[j].w * v[j].w); }
    const float r = 1.f / sqrtf(wave_sum(s) * (1.f / DM) + 1e-6f);
#pragma unroll
    for (int j = 0; j < 8; ++j) { const f32x4 ww = *(const f32x4*)(w + 4 * lane + 256 * j); const f32x4 o = v[j] * r * ww;
        if (obf) { u32x2 p; p.x = pk2(o.x, o.y); p.y = pk2(o.z, o.w); *(u32x2*)(obf + 4 * lane + 256 * j) = p; }
        else *(f32x4*)(of32 + 4 * lane + 256 * j) = o; }
}

__device__ __forceinline__ void phase0(const Ctx& F, const Args& a) {
    LAS float* scr = (LAS float*)(F.lds + F.wave * 16640);
    constexpr int I_IN = 32 * 260, I_GLU = 16 * 16, I_BR = 16 * 32, I_OUT = 32 * 32, IL = I_IN + I_GLU + 3 * I_BR + I_OUT;
    bf16* WIN = (bf16*)(F.ws + WS_WIN); bf16* WGLU = (bf16*)(F.ws + WS_WGLU); bf16* WBR = (bf16*)(F.ws + WS_WBR); bf16* WOUT = (bf16*)(F.ws + WS_WOUT);
    for (int it = F.gw; it < DEPTH * IL; it += F.NGW) {
        const int l = it / IL; int r = it - l * IL;
        if (r < I_IN) { transpose_item(a.in[2] + (size_t)l * DM * NIN, DM, NIN, WIN + (size_t)l * NINP * DM, scr, r / 260, r % 260, F.lane); continue; } r -= I_IN;
        if (r < I_GLU) { transpose_item(a.in[25] + (size_t)l * 1024 * 1024, 1024, 1024, WGLU + (size_t)l * 1024 * 1024, scr, r / 16, r % 16, F.lane); continue; } r -= I_GLU;
        if (r < 3 * I_BR) { const int br = r / I_BR, r2 = r - br * I_BR;
            transpose_item(a.in[28] + (size_t)(l * 3 + br) * 1024 * DM, 1024, DM, WBR + (size_t)(l * 3 + br) * DM * 1024, scr, r2 / 32, r2 % 32, F.lane); continue; } r -= 3 * I_BR;
        transpose_item(a.in[29] + (size_t)l * DM * DM, DM, DM, WOUT + (size_t)l * DM * DM, scr, r / 32, r % 32, F.lane);
    }
    bf16* XN = (bf16*)(F.ws + WS_XN);
    for (int m = F.gw; m < TOK; m += F.NGW) rms_row(a.in[0] + (size_t)m * DM, a.in[1], XN + (size_t)m * DM, nullptr, F.lane);
}

__device__ __forceinline__ void prep_gdn(const Ctx& F, const Args& a, int l) {
    const bf16* PROJ = (const bf16*)(F.ws + WS_PROJ);
    float* GQ = (float*)(F.ws + WS_GQ); float* GK = (float*)(F.ws + WS_GK); float* GV = (float*)(F.ws + WS_GV); float* GEG = (float*)(F.ws + WS_GEG); float* GBE = (float*)(F.ws + WS_GBE);
    const float* cw = a.in[3] + (size_t)l * 4 * 3072;
    for (int it = F.gw; it < 2048; it += F.NGW) {
        const int h = it & 7, ch = (it >> 3) & 63, b = it >> 9;
        const int t0 = ch * 32; const int c = 2 * F.lane;
        float w[3][4][2], hist[3][3][2];
#pragma unroll
        for (int p = 0; p < 3; ++p)
#pragma unroll
            for (int j = 0; j < 4; ++j) { const f32x2 ww = *(const f32x2*)(cw + j * 3072 + p * 1024 + h * 128 + c); w[p][j][0] = ww.x; w[p][j][1] = ww.y; }
#pragma unroll
        for (int p = 0; p < 3; ++p)
#pragma unroll
            for (int j = 0; j < 3; ++j) { const int t = t0 - 3 + j; unsigned x = 0u;
                if (t >= 0) x = *(const unsigned*)(PROJ + (size_t)(b * SEQ + t) * NINP + C_GQKV + p * 1024 + h * 128 + c);
                hist[p][j][0] = bflo(x); hist[p][j][1] = bfhi(x); }
        const float alog = a.in[4][l * 8 + h], dtb = a.in[5][l * 8 + h]; const float aexp = expf(alog);
        for (int tt = 0; tt < 32; ++tt) {
            const size_t tok = (size_t)(b * SEQ + t0 + tt);
            float o[3][2];
#pragma unroll
            for (int p = 0; p < 3; ++p) {
                const unsigned x = *(const unsigned*)(PROJ + tok * NINP + C_GQKV + p * 1024 + h * 128 + c);
                const float x0 = bflo(x), x1 = bfhi(x);
                const float y0 = w[p][0][0] * hist[p][0][0] + w[p][1][0] * hist[p][1][0] + w[p][2][0] * hist[p][2][0] + w[p][3][0] * x0;
                const float y1 = w[p][0][1] * hist[p][0][1] + w[p][1][1] * hist[p][1][1] + w[p][2][1] * hist[p][2][1] + w[p][3][1] * x1;
                hist[p][0][0] = hist[p][1][0]; hist[p][1][0] = hist[p][2][0]; hist[p][2][0] = x0;
                hist[p][0][1] = hist[p][1][1]; hist[p][1][1] = hist[p][2][1]; hist[p][2][1] = x1;
                o[p][0] = siluf_(y0); o[p][1] = siluf_(y1);
            }
            const float sq = wave_sum(o[0][0] * o[0][0] + o[0][1] * o[0][1]), sk = wave_sum(o[1][0] * o[1][0] + o[1][1] * o[1][1]);
            const float rq = 0.08838834764831845f / sqrtf(sq + 1e-6f), rk = 1.f / sqrtf(sk + 1e-6f);
            const size_t off = tok * 1024 + h * 128 + c;
            *(f32x2*)(GQ + off) = (f32x2){o[0][0] * rq, o[0][1] * rq};
            *(f32x2*)(GK + off) = (f32x2){o[1][0] * rk, o[1][1] * rk};
            *(f32x2*)(GV + off) = (f32x2){o[2][0], o[2][1]};
            if (F.lane == 0) {
                const float bl = bf1(PROJ[tok * NINP + C_GB + h]), al = bf1(PROJ[tok * NINP + C_GA + h]);
                GBE[tok * 8 + h] = sigmoidf_(bl);
                GEG[tok * 8 + h] = expf(-aexp * softplusf_(al + dtb));
            }
        }
    }
}

__device__ __forceinline__ float mix2(unsigned c, unsigned p, float mu0, float mu1, float& o1) {
    const float c0 = bflo(c), c1 = bfhi(c), p0 = bflo(p), p1 = bfhi(p);
    o1 = c1 + (p1 - c1) * mu1; return c0 + (p0 - c0) * mu0;
}
__device__ __forceinline__ void prep_rwkv(const Ctx& F, const Args& a, int l) {
    const bf16* PROJ = (const bf16*)(F.ws + WS_PROJ);
    float* RR = (float*)(F.ws + WS_RR); float* RW = (float*)(F.ws + WS_RW); float* RK = (float*)(F.ws + WS_RK); float* RV = (float*)(F.ws + WS_RV);
    float* RKK = (float*)(F.ws + WS_RKK); float* RKA = (float*)(F.ws + WS_RKA); float* RBON = (float*)(F.ws + WS_RBON);
    const float* mu = a.in[7] + (size_t)l * 3264; const float* w0 = a.in[8] + l * 1024; const float* wup = a.in[9] + (size_t)l * 96 * 1024;
    const float* a0 = a.in[10] + l * 1024; const float* aup = a.in[11] + (size_t)l * 96 * 1024; const float* kk_ = a.in[12] + l * 1024; const float* ka_ = a.in[13] + l * 1024; const float* rk_ = a.in[14] + l * 1024;
    LAS float* A1 = (LAS float*)F.lds; LAS float* A2 = A1 + 16 * 96;
    const int j = F.tid, c = 2 * j;
    const f32x2 mur = *(const f32x2*)(mu + c), muk = *(const f32x2*)(mu + 1024 + c), muv = *(const f32x2*)(mu + 2048 + c);
    const f32x2 w0v = *(const f32x2*)(w0 + c), a0v = *(const f32x2*)(a0 + c), kkv = *(const f32x2*)(kk_ + c), kav = *(const f32x2*)(ka_ + c), rkv = *(const f32x2*)(rk_ + c);
    for (int tile = F.vcu; tile < TOK / 16; tile += F.G) {
        __syncthreads();
        for (int e = F.tid; e < 16 * 192; e += NTHREADS) {
            const int tl = e / 192, i = e - tl * 192; const size_t tok = (size_t)tile * 16 + tl;
            const float cur = bf1(PROJ[tok * NINP + C_RF + 3072 + i]);
            const float prv = (tok & (SEQ - 1)) ? bf1(PROJ[(tok - 1) * NINP + C_RF + 3072 + i]) : 0.f;
            const float m = cur + (prv - cur) * mu[3072 + i];
            if (i < 96) A1[tl * 96 + i] = tanhf(m); else A2[tl * 96 + i - 96] = m;
        }
        __syncthreads();
        float accw[16][2], acca[16][2];
#pragma unroll
        for (int tl = 0; tl < 16; ++tl) { accw[tl][0] = 0.f; accw[tl][1] = 0.f; acca[tl][0] = 0.f; acca[tl][1] = 0.f; }
        for (int i = 0; i < 96; i += 4) {
            f32x2 wu[4], au[4];
#pragma unroll
            for (int q = 0; q < 4; ++q) { wu[q] = *(const f32x2*)(wup + (size_t)(i + q) * 1024 + c); au[q] = *(const f32x2*)(aup + (size_t)(i + q) * 1024 + c); }
#pragma unroll
            for (int tl = 0; tl < 16; ++tl) {
                const f32x4 x1 = *(const LAS f32x4*)(A1 + tl * 96 + i), x2 = *(const LAS f32x4*)(A2 + tl * 96 + i);
#pragma unroll
                for (int q = 0; q < 4; ++q) { accw[tl][0] += x1[q] * wu[q].x; accw[tl][1] += x1[q] * wu[q].y; acca[tl][0] += x2[q] * au[q].x; acca[tl][1] += x2[q] * au[q].y; }
            }
        }
#pragma unroll
        for (int tl = 0; tl < 16; ++tl) {
            const size_t tok = (size_t)tile * 16 + tl; const bool hp = (tok & (SEQ - 1)) != 0;
            const bf16* cp = PROJ + tok * NINP + C_RF + c; const bf16* pp = cp - NINP;
            const unsigned cr = *(const unsigned*)cp, ck = *(const unsigned*)(cp + 1024), cv = *(const unsigned*)(cp + 2048);
            const unsigned pr = hp ? *(const unsigned*)pp : 0u, pk = hp ? *(const unsigned*)(pp + 1024) : 0u, pv = hp ? *(const unsigned*)(pp + 2048) : 0u;
            float r1, k1, v1; const float r0 = mix2(cr, pr, mur.x, mur.y, r1), k0 = mix2(ck, pk, muk.x, muk.y, k1), v0 = mix2(cv, pv, muv.x, muv.y, v1);
            const float wp0 = w0v.x + accw[tl][0], wp1 = w0v.y + accw[tl][1];
            const float d0 = expf(-expf(-softplusf_(-wp0) - 0.5f)), d1 = expf(-expf(-softplusf_(-wp1) - 0.5f));
            const float aa0 = sigmoidf_(a0v.x + acca[tl][0]), aa1 = sigmoidf_(a0v.y + acca[tl][1]);
            const float q0 = k0 * kkv.x, q1 = k1 * kkv.y;
            float ss = q0 * q0 + q1 * q1;
#pragma unroll
            for (int o = 1; o < 32; o <<= 1) ss += __shfl_xor(ss, o);
            const float rn = 1.f / sqrtf(ss + 1e-6f); const float n0 = q0 * rn, n1 = q1 * rn;
            const float km0 = k0 * (1.f + (aa0 - 1.f) * kav.x), km1 = k1 * (1.f + (aa1 - 1.f) * kav.y);
            float bo = r0 * km0 * rkv.x + r1 * km1 * rkv.y;
#pragma unroll
            for (int o = 1; o < 32; o <<= 1) bo += __shfl_xor(bo, o);
            const size_t off = tok * 1024 + c;
            *(f32x2*)(RR + off) = (f32x2){r0, r1}; *(f32x2*)(RW + off) = (f32x2){d0, d1}; *(f32x2*)(RK + off) = (f32x2){km0, km1}; *(f32x2*)(RV + off) = (f32x2){v0, v1};
            *(f32x2*)(RKK + off) = (f32x2){-n0, -n1}; *(f32x2*)(RKA + off) = (f32x2){n0 * aa0, n1 * aa1};
            if ((F.lane & 31) == 0) RBON[tok * 16 + (c >> 6)] = bo;
        }
    }
}

#ifndef SCM
#define SCM 7
#endif
#ifndef REPM
#define REPM 0
#endif
constexpr int CH = 32;
#define WFENCE() do { __builtin_amdgcn_fence(__ATOMIC_RELEASE, "wavefront"); __builtin_amdgcn_wave_barrier(); __builtin_amdgcn_fence(__ATOMIC_ACQUIRE, "wavefront"); } while (0)

struct GStep { f32x4 k0, k1, q0, q1; float v, eg, be; };
constexpr int G_BUF = 2 * CH * 128 + CH * 32 + 2 * CH;
__device__ __forceinline__ void gdn_lds(GStep& s, const LAS float* buf, int st, int rg, int colL) {
    s.k0 = *(const LAS f32x4*)(buf + st * 128 + rg * 4); s.k1 = *(const LAS f32x4*)(buf + st * 128 + 64 + rg * 4);
    s.q0 = *(const LAS f32x4*)(buf + CH * 128 + st * 128 + rg * 4); s.q1 = *(const LAS f32x4*)(buf + CH * 128 + st * 128 + 64 + rg * 4);
    s.v = buf[2 * CH * 128 + st * 32 + colL]; s.eg = buf[2 * CH * 128 + CH * 32 + st]; s.be = buf[2 * CH * 128 + CH * 32 + CH + st];
}
__device__ __forceinline__ void gdn_step(const GStep& s, f32x2 (&S)[4], LAS float* ob, bool wr) {
    const f32x2 k01 = s.k0.xy, k23 = s.k0.zw, k45 = s.k1.xy, k67 = s.k1.zw;
    const f32x2 a2 = (k01 * S[0] + k23 * S[1]) + (k45 * S[2] + k67 * S[3]);
    const float ks = allred16(a2.x + a2.y);
    const float cc = s.be * (s.v - s.eg * ks);
    S[0] = S[0] * s.eg + k01 * cc; S[1] = S[1] * s.eg + k23 * cc; S[2] = S[2] * s.eg + k45 * cc; S[3] = S[3] * s.eg + k67 * cc;
    const f32x2 o2 = (s.q0.xy * S[0] + s.q0.zw * S[1]) + (s.q1.xy * S[2] + s.q1.zw * S[3]);
    const float o = allred16(o2.x + o2.y);
    if (wr) *ob = o;
}
struct GStage { f32x4 k[2], q[2], v; float e; };
__device__ __forceinline__ void gdn_gload(GStage& g, const float* GK, const float* GQ, const float* GV, const float* GEG, const float* GBE, int t0, int tid) {
#pragma unroll
    for (int r = 0; r < 2; ++r) { const int i = tid + 512 * r, st = i >> 5, f4 = i & 31; g.k[r] = *(const f32x4*)(GK + (size_t)(t0 + st) * 1024 + 4 * f4); g.q[r] = *(const f32x4*)(GQ + (size_t)(t0 + st) * 1024 + 4 * f4); }
    if (tid < 256) g.v = *(const f32x4*)(GV + (size_t)(t0 + (tid >> 3)) * 1024 + 4 * (tid & 7));
    else if (tid < 288) g.e = GEG[(size_t)(t0 + tid - 256) * 8];
    else if (tid < 320) g.e = GBE[(size_t)(t0 + tid - 288) * 8];
}
__device__ __forceinline__ void gdn_gstore(const GStage& g, LAS float* buf, int tid) {
#pragma unroll
    for (int r = 0; r < 2; ++r) { const int i = tid + 512 * r; *(LAS f32x4*)(buf + 4 * i) = g.k[r]; *(LAS f32x4*)(buf + CH * 128 + 4 * i) = g.q[r]; }
    if (tid < 256) *(LAS f32x4*)(buf + 2 * CH * 128 + 4 * tid) = g.v;
    else if (tid < 320) buf[2 * CH * 128 + CH * 32 + (tid - 256)] = g.e;
}
__device__ __forceinline__ void gdn_block(const Ctx& F, int vb) {
    const int bh = vb >> 2, qt = vb & 3, b = bh >> 3, h = bh & 7, colL = F.wave * 4 + (F.lane >> 4), rg = F.lane & 15;
    const size_t base = (size_t)b * SEQ;
    const float* GK = (const float*)(F.ws + WS_GK) + base * 1024 + h * 128; const float* GQ = (const float*)(F.ws + WS_GQ) + base * 1024 + h * 128;
    const float* GV = (const float*)(F.ws + WS_GV) + base * 1024 + h * 128 + qt * 32;
    const float* GEG = (const float*)(F.ws + WS_GEG) + base * 8 + h; const float* GBE = (const float*)(F.ws + WS_GBE) + base * 8 + h;
    float* GO = (float*)(F.ws + WS_GO) + base * 1024 + h * 128 + qt * 32;
    LAS float* lb = (LAS float*)F.lds; LAS float* obase = lb + 2 * G_BUF;
    f32x2 S[4] = {{0.f, 0.f}, {0.f, 0.f}, {0.f, 0.f}, {0.f, 0.f}};
    const bool wr = rg == 0;
    GStage g;
    gdn_gload(g, GK, GQ, GV, GEG, GBE, 0, F.tid); gdn_gstore(g, lb, F.tid);
    __syncthreads();
    for (int c = 0; c < SEQ / CH; ++c) {
        const LAS float* buf = lb + (c & 1) * G_BUF; LAS float* ob = obase + (c & 1) * (CH * 32) + colL;
        if (c + 1 < SEQ / CH) gdn_gload(g, GK, GQ, GV, GEG, GBE, (c + 1) * CH, F.tid);
        GStep R0, R1, R2, R3;
        gdn_lds(R0, buf, 0, rg, colL); gdn_lds(R1, buf, 1, rg, colL);
#pragma unroll 1
        for (int s = 0; s < CH; s += 4) {
            gdn_lds(R2, buf, s + 2, rg, colL); gdn_step(R0, S, ob + s * 32, wr);
            gdn_lds(R3, buf, s + 3, rg, colL); gdn_step(R1, S, ob + (s + 1) * 32, wr);
            gdn_lds(R0, buf, (s + 4) & (CH - 1), rg, colL); gdn_step(R2, S, ob + (s + 2) * 32, wr);
            gdn_lds(R1, buf, (s + 5) & (CH - 1), rg, colL); gdn_step(R3, S, ob + (s + 3) * 32, wr);
        }
        if (c + 1 < SEQ / CH) gdn_gstore(g, lb + ((c + 1) & 1) * G_BUF, F.tid);
        __syncthreads();
        if (F.tid < 256) *(f32x4*)(GO + (size_t)(c * CH + (F.tid >> 3)) * 1024 + 4 * (F.tid & 7)) = *(const LAS f32x4*)(obase + (c & 1) * (CH * 32) + 4 * F.tid);
    }
}

struct RStep { f32x4 w, n, a, k, r; float v; };
constexpr int R_BUF = CH * (5 * 64 + 32);
__device__ __forceinline__ void rwkv_lds(RStep& s, const LAS float* buf, int st, int cq, int rowL) {
    s.w = *(const LAS f32x4*)(buf + st * 64 + 4 * cq); s.n = *(const LAS f32x4*)(buf + CH * 64 + st * 64 + 4 * cq); s.a = *(const LAS f32x4*)(buf + 2 * CH * 64 + st * 64 + 4 * cq);
    s.k = *(const LAS f32x4*)(buf + 3 * CH * 64 + st * 64 + 4 * cq); s.r = *(const LAS f32x4*)(buf + 4 * CH * 64 + st * 64 + 4 * cq); s.v = buf[5 * CH * 64 + st * 32 + rowL];
}
__device__ __forceinline__ void rwkv_step(const RStep& s, f32x4& S, LAS float* ob, bool wr) {
    float sa = (S.x * s.n.x + S.y * s.n.y) + (S.z * s.n.z + S.w * s.n.w);
    sa = allred16(sa);
    S = S * s.w + sa * s.a + s.v * s.k;
    float y = (S.x * s.r.x + S.y * s.r.y) + (S.z * s.r.z + S.w * s.r.w);
    y = allred16(y);
    if (wr) *ob = y;
}
struct RStage { f32x4 x[5], v; };
__device__ __forceinline__ void rwkv_gload(RStage& g, const float* const (&src)[5], const float* RV, int t0, int tid) {
    const int st = tid >> 4, f4 = tid & 15;
#pragma unroll
    for (int q = 0; q < 5; ++q) g.x[q] = *(const f32x4*)(src[q] + (size_t)(t0 + st) * 1024 + 4 * f4);
    if (tid < 256) g.v = *(const f32x4*)(RV + (size_t)(t0 + (tid >> 3)) * 1024 + 4 * (tid & 7));
}
__device__ __forceinline__ void rwkv_gstore(const RStage& g, LAS float* buf, int tid) {
#pragma unroll
    for (int q = 0; q < 5; ++q) *(LAS f32x4*)(buf + q * CH * 64 + 4 * tid) = g.x[q];
    if (tid < 256) *(LAS f32x4*)(buf + 5 * CH * 64 + 4 * tid) = g.v;
}
__device__ __forceinline__ void rwkv_block(const Ctx& F, int vb) {
    const int bh = vb >> 1, hf = vb & 1, b = bh >> 4, h = bh & 15, rowL = F.wave * 4 + (F.lane >> 4), cq = F.lane & 15;
    const size_t base = (size_t)b * SEQ * 1024 + h * 64;
    const float* const src[5] = {(const float*)(F.ws + WS_RW) + base, (const float*)(F.ws + WS_RKK) + base, (const float*)(F.ws + WS_RKA) + base, (const float*)(F.ws + WS_RK) + base, (const float*)(F.ws + WS_RR) + base};
    const float* RV = (const float*)(F.ws + WS_RV) + base + hf * 32;
    float* RY = (float*)(F.ws + WS_RY) + base + hf * 32;
    LAS float* lb = (LAS float*)F.lds; LAS float* obase = lb + 2 * R_BUF;
    f32x4 S = {0.f, 0.f, 0.f, 0.f};
    const bool wr = cq == 0;
    RStage g;
    rwkv_gload(g, src, RV, 0, F.tid); rwkv_gstore(g, lb, F.tid);
    __syncthreads();
    for (int c = 0; c < SEQ / CH; ++c) {
        const LAS float* buf = lb + (c & 1) * R_BUF; LAS float* ob = obase + (c & 1) * (CH * 32) + rowL;
        if (c + 1 < SEQ / CH) rwkv_gload(g, src, RV, (c + 1) * CH, F.tid);
        RStep R0, R1, R2, R3;
        rwkv_lds(R0, buf, 0, cq, rowL); rwkv_lds(R1, buf, 1, cq, rowL);
#pragma unroll 1
        for (int s = 0; s < CH; s += 4) {
            rwkv_lds(R2, buf, s + 2, cq, rowL); rwkv_step(R0, S, ob + s * 32, wr);
            rwkv_lds(R3, buf, s + 3, cq, rowL); rwkv_step(R1, S, ob + (s + 1) * 32, wr);
            rwkv_lds(R0, buf, (s + 4) & (CH - 1), cq, rowL); rwkv_step(R2, S, ob + (s + 2) * 32, wr);
            rwkv_lds(R1, buf, (s + 5) & (CH - 1), cq, rowL); rwkv_step(R3, S, ob + (s + 3) * 32, wr);
        }
        if (c + 1 < SEQ / CH) rwkv_gstore(g, lb + ((c + 1) & 1) * R_BUF, F.tid);
        __syncthreads();
        if (F.tid < 256) *(f32x4*)(RY + (size_t)(c * CH + (F.tid >> 3)) * 1024 + 4 * (F.tid & 7)) = *(const LAS f32x4*)(obase + (c & 1) * (CH * 32) + 4 * F.tid);
    }
}

constexpr int S5_ROW = 132, S5_WAVE = 4 * S5_ROW + 64;
__device__ __forceinline__ void s5_block(const Ctx& F, const Args& a, int l, int it) {
    const int b = it >> 6, g = it & 63, p = F.lane, tl = F.lane >> 4, c = F.lane & 15, w = F.wave;
    const bf16* PROJ = (const bf16*)(F.ws + WS_PROJ); bf16* SY = (bf16*)(F.ws + WS_SY);
    LAS float* cl = (LAS float*)F.lds; LAS float* se = cl + 16 * S5_ROW; LAS float* sb = se + 8 * 128 + w * S5_WAVE; LAS float* ub = sb + 4 * S5_ROW;
    const size_t gp = ((size_t)l * 64 + g) * 64 + p;
    const float dt = expf(a.in[19][l * 64 + g]); const float are = a.in[17][gp], aim = a.in[18][gp];
    const float mag = expf(are * dt), abr = mag * cosf(aim * dt), abi = mag * sinf(aim * dt);
    const float den = are * are + aim * aim, cr = ((abr - 1.f) * are + abi * aim) / den, ci = (abi * are - (abr - 1.f) * aim) / den;
    float Bre[16], Bim[16];
#pragma unroll
    for (int q = 0; q < 4; ++q) { const f32x4 br = *(const f32x4*)(a.in[20] + gp * 16 + 4 * q), bi = *(const f32x4*)(a.in[21] + gp * 16 + 4 * q);
#pragma unroll
        for (int e = 0; e < 4; ++e) { Bre[4 * q + e] = cr * br[e] - ci * bi[e]; Bim[4 * q + e] = cr * bi[e] + ci * br[e]; } }
    { const size_t cb = ((size_t)l * 64 + g) * 16 * 64;
      for (int e = F.tid; e < 2048; e += NTHREADS) { const int cc = e >> 7, r = e & 127; cl[cc * S5_ROW + r] = (r < 64 ? a.in[22] : a.in[23])[cb + cc * 64 + (r & 63)]; } }
    const float dsk = a.in[24][l * 1024 + g * 16 + c];
    const int tw = 256 * w;
    const bf16* up = PROJ + ((size_t)b * SEQ + tw) * NINP + C_SU + g * 16;
    float sr = 0.f, si = 0.f;
    {
        bf16 ucur = up[(size_t)tl * NINP + c], unxt = up[(size_t)(4 + tl) * NINP + c];
        for (int t = 0; t < 256; t += 4) {
            ub[F.lane] = bf1(ucur);
            WFENCE();
            const int tn = (t + 8 < 256) ? t + 8 : t;
            const bf16 unn = up[(size_t)(tn + tl) * NINP + c];
#pragma unroll
            for (int j = 0; j < 4; ++j) {
                float br = 0.f, bi = 0.f;
#pragma unroll
                for (int q = 0; q < 4; ++q) { const f32x4 u4 = *(const LAS f32x4*)(ub + j * 16 + 4 * q);
#pragma unroll
                    for (int e = 0; e < 4; ++e) { br += Bre[4 * q + e] * u4[e]; bi += Bim[4 * q + e] * u4[e]; } }
                const float nr = abr * sr - abi * si + br, ni = abr * si + abi * sr + bi; sr = nr; si = ni;
            }
            WFENCE();
            ucur = unxt; unxt = unn;
        }
    }
    se[w * 128 + p] = sr; se[w * 128 + 64 + p] = si;
    __syncthreads();
    {
        float pr = abr, pi = abi;
#pragma unroll
        for (int i = 0; i < 8; ++i) { const float nr = pr * pr - pi * pi, ni = 2.f * pr * pi; pr = nr; pi = ni; }
        sr = 0.f; si = 0.f;
        for (int j = 0; j < w; ++j) { const float er = se[j * 128 + p], ei = se[j * 128 + 64 + p]; const float nr = pr * sr - pi * si + er, ni = pr * si + pi * sr + ei; sr = nr; si = ni; }
    }
    {
        bf16 ucur = up[(size_t)tl * NINP + c], unxt = up[(size_t)(4 + tl) * NINP + c];
        for (int t = 0; t < 256; t += 4) {
            const float uf = bf1(ucur);
            ub[F.lane] = uf;
            WFENCE();
            const int tn = (t + 8 < 256) ? t + 8 : t;
            const bf16 unn = up[(size_t)(tn + tl) * NINP + c];
#pragma unroll
            for (int j = 0; j < 4; ++j) {
                float br = 0.f, bi = 0.f;
#pragma unroll
                for (int q = 0; q < 4; ++q) { const f32x4 u4 = *(const LAS f32x4*)(ub + j * 16 + 4 * q);
#pragma unroll
                    for (int e = 0; e < 4; ++e) { br += Bre[4 * q + e] * u4[e]; bi += Bim[4 * q + e] * u4[e]; } }
                const float nr = abr * sr - abi * si + br, ni = abr * si + abi * sr + bi; sr = nr; si = ni;
                sb[j * S5_ROW + p] = sr; sb[j * S5_ROW + 64 + p] = si;
            }
            WFENCE();
            float y0 = 0.f, y1 = 0.f;
#pragma unroll 2
            for (int q = 0; q < 16; ++q) { const f32x4 xr = *(const LAS f32x4*)(sb + tl * S5_ROW + 4 * q), xi = *(const LAS f32x4*)(sb + tl * S5_ROW + 64 + 4 * q);
                const f32x4 kr = *(const LAS f32x4*)(cl + c * S5_ROW + 4 * q), ki = *(const LAS f32x4*)(cl + c * S5_ROW + 64 + 4 * q);
                y0 += kr.x * xr.x + kr.y * xr.y + kr.z * xr.z + kr.w * xr.w;
                y1 += ki.x * xi.x + ki.y * xi.y + ki.z * xi.z + ki.w * xi.w; }
            WFENCE();
            const float y = (y0 - y1) + dsk * uf;
            SY[((size_t)b * SEQ + tw + t + tl) * 1024 + g * 16 + c] = (bf16)f2bf(gelu_tanh(y));
            ucur = unxt; unxt = unn;
        }
    }
    __syncthreads();
}

__device__ __forceinline__ void scan_phase(const Ctx& F, const Args& a, int l) {
    for (int r5 = 0; r5 < 1 + ((REPM >> 9) & 1); ++r5) for (int vb = F.vcu; vb < 256; vb += F.G) s5_block(F, a, l, vb);
    for (int rg_ = 0; rg_ < 1 + ((REPM >> 10) & 1); ++rg_) for (int vb = F.vcu; vb < 256; vb += F.G) {
        if (vb < 128) { gdn_block(F, vb); if (REPM & 2048) gdn_block(F, vb); }
        else { rwkv_block(F, vb - 128); if (REPM & 4096) rwkv_block(F, vb - 128); }
    }
}

__device__ __forceinline__ void post_phase(const Ctx& F, const Args& a, int l) {
    const bf16* PROJ = (const bf16*)(F.ws + WS_PROJ); bf16* OBR = (bf16*)(F.ws + WS_OBR);
    const float* GO = (const float*)(F.ws + WS_GO); const float* RY = (const float*)(F.ws + WS_RY); const float* RV = (const float*)(F.ws + WS_RV); const float* RBON = (const float*)(F.ws + WS_RBON);
    const int c0 = 16 * F.lane;
    float nw[16], lw[16], lb[16];
#pragma unroll
    for (int e = 0; e < 16; ++e) { nw[e] = a.in[6][l * 128 + (c0 & 127) + e]; lw[e] = a.in[15][l * 1024 + c0 + e]; lb[e] = a.in[16][l * 1024 + c0 + e]; }
    for (int tok = F.gw; tok < TOK; tok += F.NGW) {
        { float o[16];
#pragma unroll
          for (int q = 0; q < 4; ++q) { const f32x4 v = *(const f32x4*)(GO + (size_t)tok * 1024 + c0 + 4 * q); o[4 * q] = v.x; o[4 * q + 1] = v.y; o[4 * q + 2] = v.z; o[4 * q + 3] = v.w; }
          float ss = 0.f;
#pragma unroll
          for (int e = 0; e < 16; ++e) ss += o[e] * o[e];
          ss = allred8(ss);
          const float rs = 1.f / sqrtf(ss * (1.f / 128.f) + 1e-6f);
          float z[16]; { float z0[8], z1[8]; unpack8(*(const u32x4*)(PROJ + (size_t)tok * NINP + C_GZ + c0), z0); unpack8(*(const u32x4*)(PROJ + (size_t)tok * NINP + C_GZ + c0 + 8), z1);
#pragma unroll
              for (int e = 0; e < 8; ++e) { z[e] = z0[e]; z[8 + e] = z1[e]; } }
          float r0[8], r1[8];
#pragma unroll
          for (int e = 0; e < 8; ++e) { r0[e] = o[e] * rs * nw[e] * siluf_(z[e]); r1[e] = o[8 + e] * rs * nw[8 + e] * siluf_(z[8 + e]); }
          *(u32x4*)(OBR + (size_t)tok * 1024 + c0) = pack8(r0); *(u32x4*)(OBR + (size_t)tok * 1024 + c0 + 8) = pack8(r1); }
        { float y[16], v[16];
#pragma unroll
          for (int q = 0; q < 4; ++q) { const f32x4 t = *(const f32x4*)(RY + (size_t)tok * 1024 + c0 + 4 * q); y[4 * q] = t.x; y[4 * q + 1] = t.y; y[4 * q + 2] = t.z; y[4 * q + 3] = t.w;
              const f32x4 w = *(const f32x4*)(RV + (size_t)tok * 1024 + c0 + 4 * q); v[4 * q] = w.x; v[4 * q + 1] = w.y; v[4 * q + 2] = w.z; v[4 * q + 3] = w.w; }
          float s = 0.f;
#pragma unroll
          for (int e = 0; e < 16; ++e) s += y[e];
          s += dppf<0xB1>(s); s += dppf<0x4E>(s);
          const float mean = s * (1.f / 64.f); float q2 = 0.f;
#pragma unroll
          for (int e = 0; e < 16; ++e) { const float d = y[e] - mean; q2 += d * d; }
          q2 += dppf<0xB1>(q2); q2 += dppf<0x4E>(q2);
          const float rs = 1.f / sqrtf(q2 * (1.f / 64.f) + 64e-5f);
          const float bon = RBON[(size_t)tok * 16 + (c0 >> 6)];
          float z[16]; { float z0[8], z1[8]; unpack8(*(const u32x4*)(PROJ + (size_t)tok * NINP + C_RZ + c0), z0); unpack8(*(const u32x4*)(PROJ + (size_t)tok * NINP + C_RZ + c0 + 8), z1);
#pragma unroll
              for (int e = 0; e < 8; ++e) { z[e] = z0[e]; z[8 + e] = z1[e]; } }
          float r0[8], r1[8];
#pragma unroll
          for (int e = 0; e < 8; ++e) { r0[e] = ((y[e] - mean) * rs * lw[e] + lb[e] + bon * v[e]) * siluf_(z[e]); r1[e] = ((y[8 + e] - mean) * rs * lw[8 + e] + lb[8 + e] + bon * v[8 + e]) * siluf_(z[8 + e]); }
          bf16* ob = OBR + (size_t)TOK * 1024 + (size_t)tok * 1024 + c0;
          *(u32x4*)ob = pack8(r0); *(u32x4*)(ob + 8) = pack8(r1); }
    }
}

#ifndef PHM
#define PHM 0xFFFF
#endif
#ifndef REPM
#define REPM 0
#endif
__global__ void __launch_bounds__(NTHREADS, 2) hybrid_fwd(Args a) {
    extern __shared__ __attribute__((aligned(16))) unsigned char lds_raw[];
    Ctx F;
    F.lds = (LAS unsigned char*)lds_raw; F.ws = a.ws;
    F.G = gridDim.x; { const int bx = blockIdx.x; F.vcu = (F.G % 8 == 0) ? (bx % 8) * (F.G / 8) + bx / 8 : bx; }
    F.NGW = F.G * NWAVES;
    cg::grid_group grid = cg::this_grid();
    if (threadIdx.x < 8) ((volatile LAS unsigned*)(F.lds + MISC_OFF))[threadIdx.x] = 0u;
    __syncthreads();
    XcdBarrier bar = xcd_barrier_post((unsigned*)(a.ws + WS_CTL), (volatile LAS unsigned*)(F.lds + MISC_OFF));
    bf16* XN = (bf16*)(a.ws + WS_XN); bf16* PROJ = (bf16*)(a.ws + WS_PROJ);
    int rep = 0;
    for (int ph = a.ph_lo; ph < a.ph_hi; ) {
        { int t_ = threadIdx.x; asm volatile("" : "+v"(t_)); F.tid = t_; F.lane = t_ & 63; F.wave = __builtin_amdgcn_readfirstlane(t_ >> 6); F.gw = F.vcu * NWAVES + F.wave; }
        if (ph == 0) { if (PHM & 1) phase0(F, a);
            if (REPM & 128) { if (!rep) { rep = 1; __syncthreads(); continue; } rep = 0; } }
        else {
            const int l = (ph - 1) / PH_PER_LAYER, k = (ph - 1) % PH_PER_LAYER;
            if (k == 0 && (PHM & 2)) {
                pg8::Gemm g{XN, (const bf16*)(a.ws + WS_WIN) + (size_t)l * NINP * DM, TOK, NINP, DM}; pg8::StaticOrder S; S.init(TOK, NINP, F.G, (int)blockIdx.x);
                pg8::EpiBf16<0> E{PROJ, NINP, nullptr, 0, 0, 1.f};
                pg8::gemm_phase<pg8::EpiBf16<0>, pg8::StaticOrder, true, true>(F.lds, g, S, E);
            } else if (k == 1) { if (PHM & 4) prep_gdn(F, a, l); if (PHM & 8) prep_rwkv(F, a, l); }
            else if (k == 2) { if (PHM & 16) scan_phase(F, a, l); }
            else if (k == 3 && (PHM & 32)) {
                if (PHM & 256) post_phase(F, a, l);
                __syncthreads();
                pg8::Gemm g{(const bf16*)(a.ws + WS_SY), (const bf16*)(a.ws + WS_WGLU) + (size_t)l * 1024 * 1024, TOK, 1024, 1024}; pg8::StaticOrder S; S.init(TOK, 1024, F.G, (int)blockIdx.x);
                pg8::EpiGlu E{(const bf16*)(a.ws + WS_SY), PROJ, a.in[26] + l * 1024, (bf16*)(a.ws + WS_OBR) + (size_t)2 * TOK * 1024};
                pg8::gemm_phase<pg8::EpiGlu, pg8::StaticOrder, true, true>(F.lds, g, S, E);
            } else if (k == 4 && (PHM & 64)) {
                pg8::Gemm g{(const bf16*)(a.ws + WS_OBR), (const bf16*)(a.ws + WS_WBR) + (size_t)l * 3 * DM * 1024, 3 * TOK, 3 * DM, 1024};
                pg8::BranchOrder S; S.base.init(TOK, DM, F.G, (int)blockIdx.x);
                pg8::EpiBranch E{PROJ, a.in[27] + (size_t)l * 3 * DM, (float*)(a.ws + WS_ACCF), (bf16*)(a.ws + WS_MRG)};
                pg8::gemm_phase<pg8::EpiBranch, pg8::BranchOrder, true, true>(F.lds, g, S, E);
            } else if (k == 5 && (PHM & 128)) {
                pg8::Gemm g{(const bf16*)(a.ws + WS_MRG), (const bf16*)(a.ws + WS_WOUT) + (size_t)l * DM * DM, TOK, DM, DM}; pg8::StaticOrder S; S.init(TOK, DM, F.G, (int)blockIdx.x);
                pg8::EpiResid E{l == 0 ? a.in[0] : a.out, a.out};
                pg8::gemm_phase<pg8::EpiResid, pg8::StaticOrder, true, true>(F.lds, g, S, E);
            } else if (k == 6) {
                if (l + 1 < DEPTH) { for (int m = F.gw; m < TOK; m += F.NGW) rms_row(a.out + (size_t)m * DM, a.in[1] + (size_t)(l + 1) * DM, XN + (size_t)m * DM, nullptr, F.lane); }
                else { for (int m = F.gw; m < TOK; m += F.NGW) rms_row(a.out + (size_t)m * DM, a.in[30], nullptr, a.out + (size_t)m * DM, F.lane); }
            }
            if (REPM && !rep && ((REPM >> k) & 1)) { rep = 1; __syncthreads(); continue; }
            rep = 0;
        }
        if (ph + 1 < a.ph_hi) {
            if (ph == 0) { __threadfence(); grid.sync(); __builtin_amdgcn_fence(__ATOMIC_ACQUIRE, "agent"); }
            else xcd_barrier(bar);
            if (REPM & 256) xcd_barrier(bar);
        }
        ++ph;
    }
}

#ifndef MK_MULTI
#define MK_MULTI 0
#endif
extern "C" void kernel_launch(void* const* d_in, const int* in_sizes, int n_in, void* d_out, int out_size, void* d_ws, size_t ws_size, hipStream_t stream) {
    static int grid = 0;
    if (grid == 0) {
        if (n_in != 31 || out_size != TOK * DM || ws_size < WS_END) { fprintf(stderr, "kernel_launch: unexpected shapes (n_in %d out %d ws %zu)\n", n_in, out_size, ws_size); grid = -1; return; }
        int dev = 0, cus = 0, per_cu = 0;
        hipGetDevice(&dev); hipDeviceGetAttribute(&cus, hipDeviceAttributeMultiprocessorCount, dev);
        if (hipFuncSetAttribute((const void*)hybrid_fwd, hipFuncAttributeMaxDynamicSharedMemorySize, LDS_BYTES) != hipSuccess) { fprintf(stderr, "kernel_launch: hipFuncSetAttribute failed\n"); grid = -1; return; }
        if (hipOccupancyMaxActiveBlocksPerMultiprocessor(&per_cu, (const void*)hybrid_fwd, NTHREADS, LDS_BYTES) != hipSuccess || per_cu < 1) per_cu = 1;
        (void)hipGetLastError();
        grid = cus * per_cu;
        fprintf(stderr, "kernel_launch: grid %d (cus %d x %d)\n", grid, cus, per_cu);
    }
    if (grid < 0) return;
    if (hipMemsetAsync((char*)d_ws + WS_CTL, 0, CTL_ZERO_BYTES, stream) != hipSuccess) { fprintf(stderr, "kernel_launch: memset failed\n"); return; }
    Args a{};
    for (int i = 0; i < 31; ++i) a.in[i] = (const float*)d_in[i];
    a.out = (float*)d_out; a.ws = (unsigned char*)d_ws;
#if MK_MULTI
    for (int ph = 0; ph < NPHASES; ++ph) { a.ph_lo = ph; a.ph_hi = ph + 1; hipLaunchKernelGGL(hybrid_fwd, dim3(grid), dim3(NTHREADS), LDS_BYTES, stream, a); }
#else
    a.ph_lo = 0; a.ph_hi = NPHASES;
    void* args[] = {&a};
    const hipError_t e = hipLaunchCooperativeKernel((const void*)hybrid_fwd, dim3(grid), dim3(NTHREADS), args, LDS_BYTES, stream);
    if (e != hipSuccess) fprintf(stderr, "kernel_launch: cooperative launch failed: %s (grid %d)\n", hipGetErrorString(e), grid);
#endif
}
```

```cpp
#include <hip/hip_runtime.h>
#include <hip/hip_cooperative_groups.h>
#include <cstdio>
#include <cstdint>
namespace cg = cooperative_groups;
namespace pg8 {
#define PG8_LAS __attribute__((address_space(3)))
typedef unsigned short bf16_t;
typedef short bf16x8 __attribute__((ext_vector_type(8)));
typedef float f32x4 __attribute__((ext_vector_type(4)));
typedef unsigned u32x4 __attribute__((ext_vector_type(4)));
constexpr int BM = 256, BK = 64, HALF = 128, HTB = HALF * BK * 2  , STAGE_BYTES = 8 * HTB, NXCD = 8, WGM = 8;

__host__ __device__ __forceinline__ int lds_byte(int r, int c) { const int st = (r >> 4) * 2 + (c >> 5), rr = r & 15, cc = c & 31, ob = rr * 64 + cc * 2; return st * 1024 + (ob ^ (((ob >> 9) & 1) << 5)); }
__host__ __device__ __forceinline__ void stage_rc(int b, int& R, int& C) { const int st = b / 1024, sb = b % 1024, swz = sb ^ (((sb >> 9) & 1) << 5); R = (st >> 1) * 16 + swz / 64; C = (st & 1) * 32 + (swz % 64) / 2; }
__host__ __device__ __forceinline__ int perm32(int rho) { const int n = rho >> 4, i = rho & 15; return 8 * (i >> 2) + 4 * n + (i & 3); }

struct Unit { int pm, pn; };
struct Gemm { const bf16_t* A; const bf16_t* Bt; int M, N, K; };

struct StaticOrder {
    int nM, nN, nwg, G, c;
    __host__ __device__ void init(int M, int N, int G_, int c_) { nM = M / BM; nN = N / BM; nwg = nM * nN; G = G_; c = c_; }
    __host__ __device__ bool next(int i, Unit& u) const {
        const long L = (long)i * G + c; if (L >= nwg) return false;
        int wgid = (int)L; { const int q = nwg / NXCD, r = nwg % NXCD, xcd = wgid % NXCD, off = wgid / NXCD; wgid = (xcd < r ? xcd * (q + 1) : r * (q + 1) + (xcd - r) * q) + off; }
        const int nig = WGM * nN, gid = wgid / nig, fm = gid * WGM, gsz = (nM - fm) < WGM ? (nM - fm) : WGM;
        u.pm = fm + ((wgid % nig) % gsz); u.pn = (wgid % nig) / gsz; return true;
    }
    __device__ __forceinline__ void a_ready(const Unit&) const {}
    __device__ __forceinline__ void done(const Unit&) const {}
};

__device__ __forceinline__ unsigned cvt_pk_bf16(float lo, float hi) { unsigned r; asm volatile("v_cvt_pk_bf16_f32 %0, %1, %2" : "=v"(r) : "v"(lo), "v"(hi)); return r; }
typedef float f32x2 __attribute__((ext_vector_type(2)));
__device__ __forceinline__ f32x2 gelu_pk(f32x2 v) {
    const f32x2 av = __builtin_elementwise_abs(v), d = av * 0.2316418882f + 1.0f;
    f32x2 t; t.x = __builtin_amdgcn_rcpf(d.x); t.y = __builtin_amdgcn_rcpf(d.y);
    f32x2 q = t * 0.5307027145f + (-0.7265760135f); q = q * t + 0.7107068705f; q = q * t + (-0.142248368f); q = q * t + 0.127414796f; q = q * t;
    const f32x2 s = (v * v) * (-0.72134752044f);
    f32x2 e; e.x = __builtin_amdgcn_exp2f(s.x); e.y = __builtin_amdgcn_exp2f(s.y);
    const f32x2 m = v * (q * e), r = v - m;
    f32x2 o; o.x = v.x < 0.f ? m.x : r.x; o.y = v.y < 0.f ? m.y : r.y; return o;
}

template <int ACT  > struct EpiBf16 {
    static constexpr bool PERM = true, AFTER_DRAIN = false; static_assert(ACT == 0 || ACT == 1, "EpiBf16: ACT is 0 (none) or 1 (gelu_pk)");
    bf16_t* O; int ldc; const float* bias; int split_cols; size_t split_stride; float scale0;
    __device__ __forceinline__ void operator()(const f32x4 (&acc)[2][2][4][2], const Unit& u, int wr, int wc, int fr, int fq) const {
        const int row0 = u.pm * BM + wr * 64 + fr; int colt = u.pn * BM; bf16_t* base = O;
        float sc = 1.f; if (split_cols) { const int t = colt / split_cols; base += (size_t)t * split_stride; colt -= t * split_cols; if (t == 0) sc = scale0; }
        const int col0 = colt + wc * 32 + 8 * fq, bcol0 = u.pn * BM + wc * 32 + 8 * fq;
        f32x4 bv[2][2];
#pragma unroll
        for (int bj = 0; bj < 2; ++bj)
#pragma unroll
            for (int n = 0; n < 2; ++n) bv[bj][n] = bias ? *(const f32x4*)(bias + bcol0 + bj * HALF + 4 * n) : (f32x4){0.f, 0.f, 0.f, 0.f};
#pragma unroll
        for (int ai = 0; ai < 2; ++ai)
#pragma unroll
            for (int m = 0; m < 4; ++m) { bf16_t* rowp = base + (size_t)(row0 + ai * HALF + m * 16) * ldc + col0;
#pragma unroll
                for (int bj = 0; bj < 2; ++bj) { f32x4 v0 = acc[ai][bj][m][0] + bv[bj][0], v1 = acc[ai][bj][m][1] + bv[bj][1];
                    if (ACT == 1) { f32x2 a = gelu_pk((f32x2){v0[0], v0[1]}), b = gelu_pk((f32x2){v0[2], v0[3]}), c = gelu_pk((f32x2){v1[0], v1[1]}), d = gelu_pk((f32x2){v1[2], v1[3]});
                        v0 = (f32x4){a.x, a.y, b.x, b.y}; v1 = (f32x4){c.x, c.y, d.x, d.y}; }
                    v0 = v0 * sc; v1 = v1 * sc; u32x4 w; w.x = cvt_pk_bf16(v0[0], v0[1]); w.y = cvt_pk_bf16(v0[2], v0[3]); w.z = cvt_pk_bf16(v1[0], v1[1]); w.w = cvt_pk_bf16(v1[2], v1[3]);
                    *(u32x4*)(rowp + bj * HALF) = w; } }
    }
};

template <class Epi, class Sched, bool ALIGN_EPI = false, bool SP2 = false>
__device__ __forceinline__ void gemm_phase(PG8_LAS unsigned char* lds, const Gemm g, const Sched& S, const Epi& E) {
    int tid_ = threadIdx.x; asm volatile("" : "+v"(tid_));
    const int tid = tid_, wid = __builtin_amdgcn_readfirstlane(tid >> 6), lane = tid & 63, wr = wid >> 2, wc = wid & 3, fr = lane & 15, fq = lane >> 4;
    const int K = g.K, nt = K / BK;
    unsigned voffA[2], voffB[2];
#pragma unroll
    for (int i = 0; i < 2; ++i) { int R, C; stage_rc(tid * 16 + i * 8192, R, C); const int Rb = Epi::PERM ? ((R & ~31) + perm32(R & 31)) : R;
        voffA[i] = (unsigned)(R * K + C) * 2u; voffB[i] = (unsigned)(Rb * K + C) * 2u; }
    const size_t kstep = (size_t)(BK * 2);
    const size_t hstep = (size_t)HALF * K * 2;
    const size_t tstep = 2 * hstep;
    const unsigned ldsw = (unsigned)wid * 1024u;
    const int aoff = lds_byte(wr * 64 + fr, fq * 8), boff = lds_byte(wc * 32 + fr, fq * 8);
#define PG8_SA(b, h) (((b) * 2 + (h)) * HTB)
#define PG8_SB(b, h) ((4 + (b) * 2 + (h)) * HTB)
#define PG8_STAGE(bufoff, gbase, voff) do { _Pragma("unroll") for (int _i = 0; _i < 2; ++_i) \
        __builtin_amdgcn_global_load_lds((const unsigned*)((const char*)(gbase) + (voff)[_i]), (PG8_LAS unsigned*)(lds + (bufoff) + ldsw + _i * 8192), 16, 0, 0); } while (0)
#define PG8_LDA(dst, b, h) do { _Pragma("unroll") for (int m = 0; m < 4; ++m) _Pragma("unroll") for (int k = 0; k < 2; ++k) dst[m][k] = *(const PG8_LAS bf16x8*)(lds + PG8_SA(b, h) + aoff + m * 2048 + k * 1024); } while (0)
#define PG8_LDB(dst, b, h) do { _Pragma("unroll") for (int n = 0; n < 2; ++n) _Pragma("unroll") for (int k = 0; k < 2; ++k) dst[n][k] = *(const PG8_LAS bf16x8*)(lds + PG8_SB(b, h) + boff + n * 2048 + k * 1024); } while (0)
#define PG8_MMA(ai, bj, At, Bt) do { __builtin_amdgcn_s_setprio(1); _Pragma("unroll") for (int m = 0; m < 4; ++m) _Pragma("unroll") for (int n = 0; n < 2; ++n) _Pragma("unroll") for (int k = 0; k < 2; ++k) \
        acc[ai][bj][m][n] = __builtin_amdgcn_mfma_f32_16x16x32_bf16(Bt[n][k], At[m][k], acc[ai][bj][m][n], 0, 0, 0); __builtin_amdgcn_s_setprio(0); } while (0)
#define PG8_WAIT_V(n) asm volatile("s_waitcnt vmcnt(" #n ")" ::: "memory")
#define PG8_WAIT_L(n) asm volatile("s_waitcnt lgkmcnt(" #n ")" ::: "memory")
#define PG8_BAR __builtin_amdgcn_s_barrier()
#define PG8_SCHED __builtin_amdgcn_sched_barrier(0)
    Unit cur, nxt; int ui = 0;
    if (!S.next(0, cur)) return;
    f32x4 acc[2][2][4][2];
#pragma unroll
    for (int a = 0; a < 2; ++a)
#pragma unroll
        for (int b = 0; b < 2; ++b)
#pragma unroll
            for (int m = 0; m < 4; ++m)
#pragma unroll
                for (int n = 0; n < 2; ++n) acc[a][b][m][n] = (f32x4){0.f, 0.f, 0.f, 0.f};
    bf16x8 At[4][2], B0[2][2], B1[2][2];
    const char* cA = (const char*)g.A + (size_t)cur.pm * tstep; const char* cB = (const char*)g.Bt + (size_t)cur.pn * tstep;
    S.a_ready(cur);
    if constexpr (SP2) {
        PG8_STAGE(PG8_SB(0, 0), cB, voffB); PG8_STAGE(PG8_SB(0, 1), cB + hstep, voffB); PG8_STAGE(PG8_SA(0, 0), cA, voffA); PG8_STAGE(PG8_SA(0, 1), cA + hstep, voffA);
        if (wr == 1) PG8_BAR;
        PG8_WAIT_V(2); PG8_BAR;
        PG8_STAGE(PG8_SB(1, 0), cB + kstep, voffB); PG8_STAGE(PG8_SA(1, 0), cA + kstep, voffA); PG8_STAGE(PG8_SB(1, 1), cB + hstep + kstep, voffB);
        PG8_WAIT_V(6); PG8_BAR;
    } else {
        PG8_STAGE(PG8_SB(0, 0), cB, voffB); PG8_STAGE(PG8_SA(0, 0), cA, voffA); PG8_STAGE(PG8_SB(0, 1), cB + hstep, voffB); PG8_STAGE(PG8_SA(0, 1), cA + hstep, voffA);
        if (wr == 1) PG8_BAR;
        PG8_WAIT_V(4); PG8_BAR;
        PG8_STAGE(PG8_SB(1, 0), cB + kstep, voffB); PG8_STAGE(PG8_SA(1, 0), cA + kstep, voffA); PG8_STAGE(PG8_SB(1, 1), cB + hstep + kstep, voffB);
        PG8_WAIT_V(6); PG8_BAR;
    }
    for (;;) {
        const bool has_next = S.next(ui + 1, nxt);
        const char* nA = has_next ? (const char*)g.A + (size_t)nxt.pm * tstep : cA; const char* nB = has_next ? (const char*)g.Bt + (size_t)nxt.pn * tstep : cB;
        for (int t = 0; t < nt; t += 2) {
            const bool last = (t == nt - 2);
            const char* a1 = cA + (size_t)(t + 1) * kstep;
            const char* a2 = last ? nA : cA + (size_t)(t + 2) * kstep; const char* b2 = last ? nB : cB + (size_t)(t + 2) * kstep;
            const char* a3 = a2 + kstep; const char* b3 = b2 + kstep;
            if (last && has_next) S.a_ready(nxt);
            if constexpr (SP2) {
            PG8_LDB(B0, 0, 0); PG8_LDB(B1, 0, 1); PG8_SCHED; PG8_LDA(At, 0, 0); PG8_STAGE(PG8_SA(1, 1), a1 + hstep, voffA);
            PG8_WAIT_V(8); PG8_WAIT_L(0); PG8_BAR; PG8_MMA(0, 0, At, B0); PG8_MMA(0, 1, At, B1); PG8_BAR; PG8_SCHED;
            PG8_LDA(At, 0, 1); PG8_STAGE(PG8_SB(0, 0), b2, voffB); PG8_STAGE(PG8_SB(0, 1), b2 + hstep, voffB); PG8_STAGE(PG8_SA(0, 0), a2, voffA);
            PG8_WAIT_V(8); PG8_WAIT_L(0); PG8_BAR; PG8_MMA(1, 0, At, B0); PG8_MMA(1, 1, At, B1); PG8_BAR; PG8_SCHED;
            PG8_LDB(B0, 1, 0); PG8_LDB(B1, 1, 1); PG8_SCHED; PG8_LDA(At, 1, 0); PG8_STAGE(PG8_SA(0, 1), a2 + hstep, voffA);
            PG8_WAIT_V(8); PG8_WAIT_L(0); PG8_BAR; PG8_MMA(0, 0, At, B0); PG8_MMA(0, 1, At, B1); PG8_BAR; PG8_SCHED;
            PG8_LDA(At, 1, 1); PG8_STAGE(PG8_SB(1, 0), b3, voffB); PG8_STAGE(PG8_SB(1, 1), b3 + hstep, voffB); PG8_STAGE(PG8_SA(1, 0), a3, voffA);
            PG8_WAIT_V(8); PG8_WAIT_L(0); PG8_BAR; PG8_MMA(1, 0, At, B0); PG8_MMA(1, 1, At, B1); PG8_BAR; PG8_SCHED;
            } else {
            PG8_LDB(B0, 0, 0); PG8_SCHED; PG8_LDA(At, 0, 0); PG8_STAGE(PG8_SA(1, 1), a1 + hstep, voffA);
            PG8_WAIT_L(8); PG8_BAR; PG8_WAIT_L(0); PG8_MMA(0, 0, At, B0); PG8_BAR; PG8_SCHED;
            PG8_LDB(B1, 0, 1); PG8_STAGE(PG8_SB(0, 0), b2, voffB);
            PG8_BAR; PG8_WAIT_L(0); PG8_MMA(0, 1, At, B1); PG8_BAR;
            PG8_LDA(At, 0, 1); PG8_STAGE(PG8_SA(0, 0), a2, voffA);
            PG8_BAR; PG8_WAIT_L(0); PG8_MMA(1, 0, At, B0); PG8_BAR; PG8_SCHED;
            PG8_STAGE(PG8_SB(0, 1), b2 + hstep, voffB);
            PG8_WAIT_V(6); PG8_BAR; PG8_MMA(1, 1, At, B1); PG8_BAR;
            PG8_LDB(B0, 1, 0); PG8_SCHED; PG8_LDA(At, 1, 0); PG8_STAGE(PG8_SA(0, 1), a2 + hstep, voffA);
            PG8_WAIT_L(8); PG8_BAR; PG8_WAIT_L(0); PG8_MMA(0, 0, At, B0); PG8_BAR; PG8_SCHED;
            PG8_LDB(B1, 1, 1); PG8_STAGE(PG8_SB(1, 0), b3, voffB);
            PG8_BAR; PG8_WAIT_L(0); PG8_MMA(0, 1, At, B1); PG8_BAR;
            PG8_LDA(At, 1, 1); PG8_STAGE(PG8_SA(1, 0), a3, voffA);
            PG8_BAR; PG8_WAIT_L(0); PG8_MMA(1, 0, At, B0); PG8_BAR; PG8_SCHED;
            PG8_STAGE(PG8_SB(1, 1), b3 + hstep, voffB);
            PG8_WAIT_V(6); PG8_BAR; PG8_MMA(1, 1, At, B1); PG8_BAR;
            }
        }
        if constexpr (ALIGN_EPI) { if (wr == 0) PG8_BAR; }
        if constexpr (!Epi::AFTER_DRAIN) { E(acc, cur, wr, wc, fr, fq); S.done(cur); }
        if (!has_next) break;
#pragma unroll
        for (int a = 0; a < 2; ++a)
#pragma unroll
            for (int b = 0; b < 2; ++b)
#pragma unroll
                for (int m = 0; m < 4; ++m)
#pragma unroll
                    for (int n = 0; n < 2; ++n) acc[a][b][m][n] = (f32x4){0.f, 0.f, 0.f, 0.f};
        cur = nxt; cA = nA; cB = nB; ++ui;
        if constexpr (ALIGN_EPI) { if (wr == 1) PG8_BAR; }
    }
    PG8_WAIT_V(0);
    if constexpr (!ALIGN_EPI) { if (wr == 0) PG8_BAR; }
    PG8_BAR;
    if constexpr (Epi::AFTER_DRAIN) { E.fused(acc, cur, wr, wc, fr, fq, lds, wid, lane); S.done(cur); }
#undef PG8_SA
#undef PG8_SB
#undef PG8_STAGE
#undef PG8_LDA
#undef PG8_LDB
#undef PG8_MMA
#undef PG8_WAIT_V
#undef PG8_WAIT_L
#undef PG8_BAR
#undef PG8_SCHED
}
}

#define GAS __attribute__((address_space(1)))
#define LAS __attribute__((address_space(3)))
typedef unsigned short bf16;
typedef unsigned u32x4 __attribute__((ext_vector_type(4)));
typedef unsigned u32x2 __attribute__((ext_vector_type(2)));
typedef float f32x4 __attribute__((ext_vector_type(4)));
typedef float f32x2 __attribute__((ext_vector_type(2)));

constexpr int NBATCH = 4, SEQ = 2048, TOK = NBATCH * SEQ, DM = 2048, DEPTH = 4;
constexpr int NIN = 16592, NINP = 16640;
constexpr int C_GQKV = 0, C_GZ = 3072, C_GB = 4096, C_GA = 4104, C_RF = 4112, C_RZ = 7376, C_SU = 8400, C_SZ = 9424, C_GATE = 10448;
constexpr int NWAVES = 8, NTHREADS = 512;
constexpr int LDS_BYTES = 147456;
constexpr int PH_PER_LAYER = 7, NPHASES = 1 + DEPTH * PH_PER_LAYER;

constexpr size_t MiB = 1u << 20;
constexpr size_t WS_WIN = 0, WS_WGLU = 260 * MiB, WS_WBR = 268 * MiB, WS_WOUT = 316 * MiB, WS_XN = 348 * MiB, WS_PROJ = 380 * MiB;
constexpr size_t WS_GQ = 640 * MiB, WS_GK = 672 * MiB, WS_GV = 704 * MiB, WS_GEG = 736 * MiB, WS_GBE = 737 * MiB, WS_GO = 738 * MiB;
constexpr size_t WS_RR = 770 * MiB, WS_RW = 802 * MiB, WS_RK = 834 * MiB, WS_RV = 866 * MiB, WS_RKK = 898 * MiB, WS_RKA = 930 * MiB, WS_RBON = 962 * MiB, WS_RY = 963 * MiB;
constexpr size_t WS_SY = 995 * MiB, WS_OBR = 1011 * MiB, WS_ACCF = 1059 * MiB, WS_MRG = 1123 * MiB, WS_CTL = 1155 * MiB, WS_END = 1156 * MiB;
constexpr size_t CTL_ZERO_BYTES = 65536;
constexpr int MISC_OFF = 147392;
static_assert((size_t)DEPTH * NINP * DM * 2 == 260 * MiB && (size_t)TOK * NINP * 2 == 260 * MiB, "ws map");

__device__ __forceinline__ unsigned f2bf(float f) { unsigned u = __builtin_bit_cast(unsigned, f); return (u + 0x7fffu + ((u >> 16) & 1u)) >> 16; }
__device__ __forceinline__ unsigned pk2(float lo, float hi) { return f2bf(lo) | (f2bf(hi) << 16); }
__device__ __forceinline__ float bflo(unsigned w) { return __builtin_bit_cast(float, w << 16); }
__device__ __forceinline__ float bfhi(unsigned w) { return __builtin_bit_cast(float, w & 0xffff0000u); }
__device__ __forceinline__ float bf1(bf16 h) { return __builtin_bit_cast(float, (unsigned)h << 16); }
__device__ __forceinline__ float sigmoidf_(float x) { return 1.f / (1.f + __expf(-x)); }
__device__ __forceinline__ float siluf_(float x) { return x / (1.f + __expf(-x)); }
__device__ __forceinline__ float softplusf_(float x) { return x > 20.f ? x : log1pf(expf(x)); }
__device__ __forceinline__ float gelu_tanh(float y) { const float t = 0.7978845608028654f * (y + 0.044715f * y * y * y); const float th = 1.f - 2.f / (1.f + __expf(2.f * t)); return 0.5f * y * (1.f + th); }
template <int CTRL> __device__ __forceinline__ float dppf(float v) { return __builtin_bit_cast(float, __builtin_amdgcn_update_dpp(0, __builtin_bit_cast(int, v), CTRL, 0xF, 0xF, true)); }
__device__ __forceinline__ float allred8(float v) { v += dppf<0xB1>(v); v += dppf<0x4E>(v); v += dppf<0x141>(v); return v; }
__device__ __forceinline__ float allred16(float v) { v = allred8(v); v += dppf<0x140>(v); return v; }
__device__ __forceinline__ float wave_sum(float v) {
#pragma unroll
    for (int o = 1; o < 64; o <<= 1) v += __shfl_xor(v, o);
    return v;
}
__device__ __forceinline__ void unpack8(const u32x4 w, float (&f)[8]) { f[0] = bflo(w.x); f[1] = bfhi(w.x); f[2] = bflo(w.y); f[3] = bfhi(w.y); f[4] = bflo(w.z); f[5] = bfhi(w.z); f[6] = bflo(w.w); f[7] = bfhi(w.w); }
__device__ __forceinline__ u32x4 pack8(const float (&f)[8]) { u32x4 w; w.x = pk2(f[0], f[1]); w.y = pk2(f[2], f[3]); w.z = pk2(f[4], f[5]); w.w = pk2(f[6], f[7]); return w; }

namespace pg8 {
struct EpiGlu {
    static constexpr bool PERM = true, AFTER_DRAIN = false;
    const bf16* Y1; const bf16* PROJ; const float* bias; bf16* O;
    __device__ __forceinline__ void operator()(const f32x4 (&acc)[2][2][4][2], const Unit& u, int wr, int wc, int fr, int fq) const {
        int row0 = u.pm * BM + wr * 64 + fr, col0 = u.pn * BM + wc * 32 + 8 * fq;
        asm volatile("" : "+v"(row0), "+v"(col0));
#pragma unroll
        for (int bj = 0; bj < 2; ++bj) {
            const int col = col0 + bj * HALF;
            const f32x4 b0 = *(const f32x4*)(bias + col), b1 = *(const f32x4*)(bias + col + 4);
#pragma unroll
            for (int ai = 0; ai < 2; ++ai)
#pragma unroll
                for (int m = 0; m < 4; ++m) {
                    const size_t row = (size_t)(row0 + ai * HALF + m * 16);
                    const u32x4 y8 = *(const u32x4*)(Y1 + row * 1024 + col), z8 = *(const u32x4*)(PROJ + row * NINP + C_SZ + col);
                    float y[8], z[8], o[8]; unpack8(y8, y); unpack8(z8, z);
                    const f32x4 v0 = acc[ai][bj][m][0] + b0, v1 = acc[ai][bj][m][1] + b1;
                    const float a[8] = {v0[0], v0[1], v0[2], v0[3], v1[0], v1[1], v1[2], v1[3]};
#pragma unroll
                    for (int e = 0; e < 8; ++e) o[e] = y[e] * sigmoidf_(a[e]) * siluf_(z[e]);
                    *(u32x4*)(O + row * 1024 + col) = pack8(o);
                    asm volatile("" ::: "memory");
                }
        }
    }
};
struct EpiBranch {
    static constexpr bool PERM = true, AFTER_DRAIN = false;
    const bf16* PROJ; const float* gate_b; float* ACCF; bf16* MRG;
    __device__ __forceinline__ void operator()(const f32x4 (&acc)[2][2][4][2], const Unit& u, int wr, int wc, int fr, int fq) const {
        const int br = u.pm >> 5, pm = u.pm & 31, pn = u.pn & 7;
        int row0 = pm * BM + wr * 64 + fr, col0 = pn * BM + wc * 32 + 8 * fq;
        asm volatile("" : "+v"(row0), "+v"(col0));
#pragma unroll
        for (int bj = 0; bj < 2; ++bj) {
            const int col = col0 + bj * HALF;
            const f32x4 g0 = *(const f32x4*)(gate_b + br * DM + col), g1 = *(const f32x4*)(gate_b + br * DM + col + 4);
            const float gb[8] = {g0[0], g0[1], g0[2], g0[3], g1[0], g1[1], g1[2], g1[3]};
#pragma unroll
            for (int ai = 0; ai < 2; ++ai)
#pragma unroll
                for (int m = 0; m < 4; ++m) {
                    const size_t row = (size_t)(row0 + ai * HALF + m * 16);
                    const u32x4 l8 = *(const u32x4*)(PROJ + row * NINP + C_GATE + br * DM + col);
                    float gl[8], o[8]; unpack8(l8, gl);
                    const f32x4 v0 = acc[ai][bj][m][0], v1 = acc[ai][bj][m][1];
                    const float a[8] = {v0[0], v0[1], v0[2], v0[3], v1[0], v1[1], v1[2], v1[3]};
#pragma unroll
                    for (int e = 0; e < 8; ++e) o[e] = sigmoidf_(gl[e] + gb[e]) * a[e];
                    float* ap = ACCF + row * DM + col;
                    if (br > 0) { const f32x4 p0 = *(const f32x4*)ap, p1 = *(const f32x4*)(ap + 4);
                        o[0] += p0[0]; o[1] += p0[1]; o[2] += p0[2]; o[3] += p0[3]; o[4] += p1[0]; o[5] += p1[1]; o[6] += p1[2]; o[7] += p1[3]; }
                    if (br < 2) { *(f32x4*)ap = (f32x4){o[0], o[1], o[2], o[3]}; *(f32x4*)(ap + 4) = (f32x4){o[4], o[5], o[6], o[7]}; }
                    else *(u32x4*)(MRG + row * DM + col) = pack8(o);
                    asm volatile("" ::: "memory");
                }
        }
    }
};
struct EpiResid {
    static constexpr bool PERM = true, AFTER_DRAIN = false;
    const float* base; float* out;
    __device__ __forceinline__ void operator()(const f32x4 (&acc)[2][2][4][2], const Unit& u, int wr, int wc, int fr, int fq) const {
        int row0 = u.pm * BM + wr * 64 + fr, col0 = u.pn * BM + wc * 32 + 8 * fq;
        asm volatile("" : "+v"(row0), "+v"(col0));
#pragma unroll
        for (int ai = 0; ai < 2; ++ai)
#pragma unroll
            for (int m = 0; m < 4; ++m)
#pragma unroll
                for (int bj = 0; bj < 2; ++bj) {
                    const size_t off = (size_t)(row0 + ai * HALF + m * 16) * DM + col0 + bj * HALF;
                    const f32x4 p0 = *(const f32x4*)(base + off), p1 = *(const f32x4*)(base + off + 4);
                    *(f32x4*)(out + off) = p0 + acc[ai][bj][m][0]; *(f32x4*)(out + off + 4) = p1 + acc[ai][bj][m][1];
                }
    }
};
struct BranchOrder {
    StaticOrder base;
    __device__ bool next(int i, Unit& u) const { Unit t; const int r = i / 3, br = i - 3 * r; if (!base.next(r, t)) return false; u.pm = br * 32 + t.pm; u.pn = br * 8 + t.pn; return true; }
    __device__ __forceinline__ void a_ready(const Unit&) const {}
    __device__ __forceinline__ void done(const Unit&) const {}
};
}

#define XB_TMO      128
#define XB_XCNT(j)  (256  + 64 * (j))
#define XB_XSUB(j)  (1280 + 64 * (j))
#define XB_XGEN(j)  (2304 + 64 * (j))
#define XB_TOP      3328
#define XB_TOPGEN   3392
#define XCD_BAR_WORDS 3456
#define XB_SPIN_CAP (1u << 18)

__device__ __forceinline__ unsigned xb_ld(unsigned* p)              { return __hip_atomic_load(p, __ATOMIC_RELAXED, __HIP_MEMORY_SCOPE_AGENT); }
__device__ __forceinline__ unsigned xb_add(unsigned* p, unsigned v) { return __hip_atomic_fetch_add(p, v, __ATOMIC_RELAXED, __HIP_MEMORY_SCOPE_AGENT); }
__device__ __forceinline__ unsigned xb_xcc_id() { return (unsigned)__builtin_amdgcn_s_getreg((3 << 11) | 20) & 0xFu; }
#define XB_SPIN(cond, bar) do { unsigned _sp = 0; while (cond) { __builtin_amdgcn_s_sleep(1); \
    if ((++_sp & 255u) == 0u) { if (xb_ld(&(bar)[XB_TMO])) break; if (_sp > XB_SPIN_CAP) { atomicAdd(&(bar)[XB_TMO], 1u); break; } } } } while (0)

struct XcdBarrier {
    unsigned* bar; unsigned x;
    volatile LAS unsigned* st;
};

__device__ __forceinline__ XcdBarrier xcd_barrier_post(unsigned* bar, volatile LAS unsigned* st) {
    XcdBarrier b; b.bar = bar; b.x = xb_xcc_id(); b.st = st;
    if (threadIdx.x == 0) (void)xb_add(&bar[XB_XCNT(b.x)], 1u);
    return b;
}
__device__ __forceinline__ void xcd_barrier_complete(unsigned* bar, unsigned x, unsigned& nloc, unsigned& nx) {
    const unsigned G = gridDim.x * gridDim.y * gridDim.z;
    unsigned sum, cnt, mine, sp = 0u;
    for (;;) {
        sum = 0u; cnt = 0u; mine = 0u;
#pragma unroll
        for (unsigned j = 0; j < 16; ++j) { const unsigned c = xb_ld(&bar[XB_XCNT(j)]); sum += c; cnt += (c > 0u) ? 1u : 0u; mine = (j == x) ? c : mine; }
        if (sum == G) break;
        __builtin_amdgcn_s_sleep(1);
        if ((++sp & 255u) == 0u) { if (xb_ld(&bar[XB_TMO])) break; if (sp > XB_SPIN_CAP) { atomicAdd(&bar[XB_TMO], 1u); break; } }
    }
    nloc = mine > 0u ? mine : 1u; nx = cnt > 0u ? cnt : 1u;
}

__device__ __forceinline__ void xcd_barrier(const XcdBarrier& b) {
    asm volatile("s_waitcnt vmcnt(0)" ::: "memory");
    __syncthreads();
    if (threadIdx.x == 0) {
        unsigned* bar = b.bar;
        __builtin_amdgcn_s_waitcnt(0);
        unsigned nloc = b.st[0], nx = b.st[1];
        if (nloc == 0u) { xcd_barrier_complete(bar, b.x, nloc, nx); b.st[0] = nloc; b.st[1] = nx; }
        const unsigned old = xb_add(&bar[XB_XSUB(b.x)], 1u);
        const unsigned gen = old / nloc;
        if (old + 1u == (gen + 1u) * nloc) {
            __builtin_amdgcn_fence(__ATOMIC_RELEASE, "agent");
            asm volatile("s_waitcnt vmcnt(0)" ::: "memory");
            const unsigned og = xb_add(&bar[XB_TOP], 1u);
            const unsigned tg = og / nx;
            if (og + 1u == (tg + 1u) * nx) xb_add(&bar[XB_TOPGEN], 1u);
            else XB_SPIN(xb_ld(&bar[XB_TOPGEN]) == tg, bar);
            __builtin_amdgcn_fence(__ATOMIC_ACQUIRE, "agent");
            xb_add(&bar[XB_XGEN(b.x)], 1u);
            asm volatile("s_waitcnt vmcnt(0)" ::: "memory");
        } else {
            XB_SPIN(xb_ld(&bar[XB_XGEN(b.x)]) == gen, bar);
            __builtin_amdgcn_fence(__ATOMIC_ACQUIRE, "agent");
            asm volatile("s_waitcnt vmcnt(0)" ::: "memory");
        }
    }
    __syncthreads();
}

struct Args { const float* in[31]; float* out; unsigned char* ws; int ph_lo, ph_hi; };
struct Ctx { int tid, lane, wave, vcu, G, gw, NGW; LAS unsigned char* lds; unsigned char* ws; };

__device__ __forceinline__ void transpose_item(const float* W, int K, int N, bf16* WT, LAS float* scr, int kb, int nb, int lane) {
    const int k0 = 64 * kb, n0 = 64 * nb, nq = 4 * (lane & 15), kr = lane >> 4; const bool nv = n0 + nq < N;
    f32x4 v[16];
#pragma unroll
    for (int i = 0; i < 16; ++i) v[i] = nv ? *(const f32x4*)(W + (size_t)(k0 + 4 * i + kr) * N + n0 + nq) : (f32x4){0.f, 0.f, 0.f, 0.f};
#pragma unroll
    for (int i = 0; i < 16; ++i) { LAS float* d = scr + (4 * i + kr) * 65 + nq; d[0] = v[i].x; d[1] = v[i].y; d[2] = v[i].z; d[3] = v[i].w; }
    asm volatile("s_waitcnt lgkmcnt(0)" ::: "memory");
    const int c = lane & 7;
#pragma unroll
    for (int j = 0; j < 8; ++j) { const int nn = (lane >> 3) + 8 * j; const LAS float* s = scr + (8 * c) * 65 + nn;
        u32x4 o; o.x = pk2(s[0 * 65], s[1 * 65]); o.y = pk2(s[2 * 65], s[3 * 65]); o.z = pk2(s[4 * 65], s[5 * 65]); o.w = pk2(s[6 * 65], s[7 * 65]);
        *(u32x4*)(WT + (size_t)(n0 + nn) * K + k0 + 8 * c) = o; }
    asm volatile("s_waitcnt lgkmcnt(0)" ::: "memory");
}

__device__ __forceinline__ void rms_row(const float* xrow, const float* w, bf16* obf, float* of32, int lane) {
    f32x4 v[8]; float s = 0.f;
#pragma unroll
    for (int j = 0; j < 8; ++j) { v[j] = *(const f32x4*)(xrow + 4 * lane + 256 * j); s += (v[j].x * v[j].x + v[j].y * v[j].y) + (v[j].z * v[j].z + v[j].w * v[j].w); }
    const float r = 1.f / sqrtf(wave_sum(s) * (1.f / DM) + 1e-6f);
#pragma unroll
    for (int j = 0; j < 8; ++j) { const f32x4 ww = *(const f32x4*)(w + 4 * lane + 256 * j); const f32x4 o = v[j] * r * ww;
        if (obf) { u32x2 p; p.x = pk2(o.x, o.y); p.y = pk2(o.z, o.w); *(u32x2*)(obf + 4 * lane + 256 * j) = p; }
        else *(f32x4*)(of32 + 4 * lane + 256 * j) = o; }
}

__device__ __forceinline__ void phase0(const Ctx& F, const Args& a) {
    LAS float* scr = (LAS float*)(F.lds + F.wave * 16640);
    constexpr int I_IN = 32 * 260, I_GLU = 16 * 16, I_BR = 16 * 32, I_OUT = 32 * 32, IL = I_IN + I_GLU + 3 * I_BR + I_OUT;
    bf16* WIN = (bf16*)(F.ws + WS_WIN); bf16* WGLU = (bf16*)(F.ws + WS_WGLU); bf16* WBR = (bf16*)(F.ws + WS_WBR); bf16* WOUT = (bf16*)(F.ws + WS_WOUT);
    for (int it = F.gw; it < DEPTH * IL; it += F.NGW) {
        const int l = it / IL; int r = it - l * IL;
        if (r < I_IN) { transpose_item(a.in[2] + (size_t)l * DM * NIN, DM, NIN, WIN + (size_t)l * NINP * DM, scr, r / 260, r % 260, F.lane); continue; } r -= I_IN;
        if (r < I_GLU) { transpose_item(a.in[25] + (size_t)l * 1024 * 1024, 1024, 1024, WGLU + (size_t)l * 1024 * 1024, scr, r / 16, r % 16, F.lane); continue; } r -= I_GLU;
        if (r < 3 * I_BR) { const int br = r / I_BR, r2 = r - br * I_BR;
            transpose_item(a.in[28] + (size_t)(l * 3 + br) * 1024 * DM, 1024, DM, WBR + (size_t)(l * 3 + br) * DM * 1024, scr, r2 / 32, r2 % 32, F.lane); continue; } r -= 3 * I_BR;
        transpose_item(a.in[29] + (size_t)l * DM * DM, DM, DM, WOUT + (size_t)l * DM * DM, scr, r / 32, r % 32, F.lane);
    }
    bf16* XN = (bf16*)(F.ws + WS_XN);
    for (int m = F.gw; m < TOK; m += F.NGW) rms_row(a.in[0] + (size_t)m * DM, a.in[1], XN + (size_t)m * DM, nullptr, F.lane);
}

__device__ __forceinline__ void prep_gdn(const Ctx& F, const Args& a, int l) {
    const bf16* PROJ = (const bf16*)(F.ws + WS_PROJ);
    float* GQ = (float*)(F.ws + WS_GQ); float* GK = (float*)(F.ws + WS_GK); float* GV = (float*)(F.ws + WS_GV); float* GEG = (float*)(F.ws + WS_GEG); float* GBE = (float*)(F.ws + WS_GBE);
    const float* cw = a.in[3] + (size_t)l * 4 * 3072;
    for (int it = F.gw; it < 2048; it += F.NGW) {
        const int h = it & 7, ch = (it >> 3) & 63, b = it >> 9;
        const int t0 = ch * 32; const int c = 2 * F.lane;
        float w[3][4][2], hist[3][3][2];
#pragma unroll
        for (int p = 0; p < 3; ++p)
#pragma unroll
            for (int j = 0; j < 4; ++j) { const f32x2 ww = *(const f32x2*)(cw + j * 3072 + p * 1024 + h * 128 + c); w[p][j][0] = ww.x; w[p][j][1] = ww.y; }
#pragma unroll
        for (int p = 0; p < 3; ++p)
#pragma unroll
            for (int j = 0; j < 3; ++j) { const int t = t0 - 3 + j; unsigned x = 0u;
                if (t >= 0) x = *(const unsigned*)(PROJ + (size_t)(b * SEQ + t) * NINP + C_GQKV + p * 1024 + h * 128 + c);
                hist[p][j][0] = bflo(x); hist[p][j][1] = bfhi(x); }
        const float alog = a.in[4][l * 8 + h], dtb = a.in[5][l * 8 + h]; const float aexp = expf(alog);
        for (int tt = 0; tt < 32; ++tt) {
            const size_t tok = (size_t)(b * SEQ + t0 + tt);
            float o[3][2];
#pragma unroll
            for (int p = 0; p < 3; ++p) {
                const unsigned x = *(const unsigned*)(PROJ + tok * NINP + C_GQKV + p * 1024 + h * 128 + c);
                const float x0 = bflo(x), x1 = bfhi(x);
                const float y0 = w[p][0][0] * hist[p][0][0] + w[p][1][0] * hist[p][1][0] + w[p][2][0] * hist[p][2][0] + w[p][3][0] * x0;
                const float y1 = w[p][0][1] * hist[p][0][1] + w[p][1][1] * hist[p][1][1] + w[p][2][1] * hist[p][2][1] + w[p][3][1] * x1;
                hist[p][0][0] = hist[p][1][0]; hist[p][1][0] = hist[p][2][0]; hist[p][2][0] = x0;
                hist[p][0][1] = hist[p][1][1]; hist[p][1][1] = hist[p][2][1]; hist[p][2][1] = x1;
                o[p][0] = siluf_(y0); o[p][1] = siluf_(y1);
            }
            const float sq = wave_sum(o[0][0] * o[0][0] + o[0][1] * o[0][1]), sk = wave_sum(o[1][0] * o[1][0] + o[1][1] * o[1][1]);
            const float rq = 0.08838834764831845f / sqrtf(sq + 1e-6f), rk = 1.f / sqrtf(sk + 1e-6f);
            const size_t off = tok * 1024 + h * 128 + c;
            *(f32x2*)(GQ + off) = (f32x2){o[0][0] * rq, o[0][1] * rq};
            *(f32x2*)(GK + off) = (f32x2){o[1][0] * rk, o[1][1] * rk};
            *(f32x2*)(GV + off) = (f32x2){o[2][0], o[2][1]};
            if (F.lane == 0) {
                const float bl = bf1(PROJ[tok * NINP + C_GB + h]), al = bf1(PROJ[tok * NINP + C_GA + h]);
                GBE[tok * 8 + h] = sigmoidf_(bl);
                GEG[tok * 8 + h] = expf(-aexp * softplusf_(al + dtb));
            }
        }
    }
}

__device__ __forceinline__ float mix2(unsigned c, unsigned p, float mu0, float mu1, float& o1) {
    const float c0 = bflo(c), c1 = bfhi(c), p0 = bflo(p), p1 = bfhi(p);
    o1 = c1 + (p1 - c1) * mu1; return c0 + (p0 - c0) * mu0;
}
__device__ __forceinline__ void prep_rwkv(const Ctx& F, const Args& a, int l) {
    const bf16* PROJ = (const bf16*)(F.ws + WS_PROJ);
    float* RR = (float*)(F.ws + WS_RR); float* RW = (float*)(F.ws + WS_RW); float* RK = (float*)(F.ws + WS_RK); float* RV = (float*)(F.ws + WS_RV);
    float* RKK = (float*)(F.ws + WS_RKK); float* RKA = (float*)(F.ws + WS_RKA); float* RBON = (float*)(F.ws + WS_RBON);
    const float* mu = a.in[7] + (size_t)l * 3264; const float* w0 = a.in[8] + l * 1024; const float* wup = a.in[9] + (size_t)l * 96 * 1024;
    const float* a0 = a.in[10] + l * 1024; const float* aup = a.in[11] + (size_t)l * 96 * 1024; const float* kk_ = a.in[12] + l * 1024; const float* ka_ = a.in[13] + l * 1024; const float* rk_ = a.in[14] + l * 1024;
    LAS float* A1 = (LAS float*)F.lds; LAS float* A2 = A1 + 16 * 96;
    const int j = F.tid, c = 2 * j;
    const f32x2 mur = *(const f32x2*)(mu + c), muk = *(const f32x2*)(mu + 1024 + c), muv = *(const f32x2*)(mu + 2048 + c);
    const f32x2 w0v = *(const f32x2*)(w0 + c), a0v = *(const f32x2*)(a0 + c), kkv = *(const f32x2*)(kk_ + c), kav = *(const f32x2*)(ka_ + c), rkv = *(const f32x2*)(rk_ + c);
    for (int tile = F.vcu; tile < TOK / 16; tile += F.G) {
        __syncthreads();
        for (int e = F.tid; e < 16 * 192; e += NTHREADS) {
            const int tl = e / 192, i = e - tl * 192; const size_t tok = (size_t)tile * 16 + tl;
            const float cur = bf1(PROJ[tok * NINP + C_RF + 3072 + i]);
            const float prv = (tok & (SEQ - 1)) ? bf1(PROJ[(tok - 1) * NINP + C_RF + 3072 + i]) : 0.f;
            const float m = cur + (prv - cur) * mu[3072 + i];
            if (i < 96) A1[tl * 96 + i] = tanhf(m); else A2[tl * 96 + i - 96] = m;
        }
        __syncthreads();
        float accw[16][2], acca[16][2];
#pragma unroll
        for (int tl = 0; tl < 16; ++tl) { accw[tl][0] = 0.f; accw[tl][1] = 0.f; acca[tl][0] = 0.f; acca[tl][1] = 0.f; }
        for (int i = 0; i < 96; i += 4) {
            f32x2 wu[4], au[4];
#pragma unroll
            for (int q = 0; q < 4; ++q) { wu[q] = *(const f32x2*)(wup + (size_t)(i + q) * 1024 + c); au[q] = *(const f32x2*)(aup + (size_t)(i + q) * 1024 + c); }
#pragma unroll
            for (int tl = 0; tl < 16; ++tl) {
                const f32x4 x1 = *(const LAS f32x4*)(A1 + tl * 96 + i), x2 = *(const LAS f32x4*)(A2 + tl * 96 + i);
#pragma unroll
                for (int q = 0; q < 4; ++q) { accw[tl][0] += x1[q] * wu[q].x; accw[tl][1] += x1[q] * wu[q].y; acca[tl][0] += x2[q] * au[q].x; acca[tl][1] += x2[q] * au[q].y; }
            }
        }
#pragma unroll
        for (int tl = 0; tl < 16; ++tl) {
            const size_t tok = (size_t)tile * 16 + tl; const bool hp = (tok & (SEQ - 1)) != 0;
            const bf16* cp = PROJ + tok * NINP + C_RF + c; const bf16* pp = cp - NINP;
            const unsigned cr = *(const unsigned*)cp, ck = *(const unsigned*)(cp + 1024), cv = *(const unsigned*)(cp + 2048);
            const unsigned pr = hp ? *(const unsigned*)pp : 0u, pk = hp ? *(const unsigned*)(pp + 1024) : 0u, pv = hp ? *(const unsigned*)(pp + 2048) : 0u;
            float r1, k1, v1; const float r0 = mix2(cr, pr, mur.x, mur.y, r1), k0 = mix2(ck, pk, muk.x, muk.y, k1), v0 = mix2(cv, pv, muv.x, muv.y, v1);
            const float wp0 = w0v.x + accw[tl][0], wp1 = w0v.y + accw[tl][1];
            const float d0 = expf(-expf(-softplusf_(-wp0) - 0.5f)), d1 = expf(-expf(-softplusf_(-wp1) - 0.5f));
            const float aa0 = sigmoidf_(a0v.x + acca[tl][0]), aa1 = sigmoidf_(a0v.y + acca[tl][1]);
            const float q0 = k0 * kkv.x, q1 = k1 * kkv.y;
            float ss = q0 * q0 + q1 * q1;
#pragma unroll
            for (int o = 1; o < 32; o <<= 1) ss += __shfl_xor(ss, o);
            const float rn = 1.f / sqrtf(ss + 1e-6f); const float n0 = q0 * rn, n1 = q1 * rn;
            const float km0 = k0 * (1.f + (aa0 - 1.f) * kav.x), km1 = k1 * (1.f + (aa1 - 1.f) * kav.y);
            float bo = r0 * km0 * rkv.x + r1 * km1 * rkv.y;
#pragma unroll
            for (int o = 1; o < 32; o <<= 1) bo += __shfl_xor(bo, o);
            const size_t off = tok * 1024 + c;
            *(f32x2*)(RR + off) = (f32x2){r0, r1}; *(f32x2*)(RW + off) = (f32x2){d0, d1}; *(f32x2*)(RK + off) = (f32x2){km0, km1}; *(f32x2*)(RV + off) = (f32x2){v0, v1};
            *(f32x2*)(RKK + off) = (f32x2){-n0, -n1}; *(f32x2*)(RKA + off) = (f32x2){n0 * aa0, n1 * aa1};
            if ((F.lane & 31) == 0) RBON[tok * 16 + (c >> 6)] = bo;
        }
    }
}

#ifndef SCM
#define SCM 7
#endif
#ifndef REPM
#define REPM 0
#endif
constexpr int CH = 32;
#define WFENCE() do { __builtin_amdgcn_fence(__ATOMIC_RELEASE, "wavefront"); __builtin_amdgcn_wave_barrier(); __builtin_amdgcn_fence(__ATOMIC_ACQUIRE, "wavefront"); } while (0)

struct GStep { f32x4 k0, k1, q0, q1; float v, eg, be; };
constexpr int G_BUF = 2 * CH * 128 + CH * 32 + 2 * CH;
__device__ __forceinline__ void gdn_lds(GStep& s, const LAS float* buf, int st, int rg, int colL) {
    s.k0 = *(const LAS f32x4*)(buf + st * 128 + rg * 4); s.k1 = *(const LAS f32x4*)(buf + st * 128 + 64 + rg * 4);
    s.q0 = *(const LAS f32x4*)(buf + CH * 128 + st * 128 + rg * 4); s.q1 = *(const LAS f32x4*)(buf + CH * 128 + st * 128 + 64 + rg * 4);
    s.v = buf[2 * CH * 128 + st * 32 + colL]; s.eg = buf[2 * CH * 128 + CH * 32 + st]; s.be = buf[2 * CH * 128 + CH * 32 + CH + st];
}
__device__ __forceinline__ void gdn_step(const GStep& s, f32x2 (&S)[4], LAS float* ob, bool wr) {
    const f32x2 k01 = s.k0.xy, k23 = s.k0.zw, k45 = s.k1.xy, k67 = s.k1.zw;
    const f32x2 a2 = (k01 * S[0] + k23 * S[1]) + (k45 * S[2] + k67 * S[3]);
    const float ks = allred16(a2.x + a2.y);
    const float cc = s.be * (s.v - s.eg * ks);
    S[0] = S[0] * s.eg + k01 * cc; S[1] = S[1] * s.eg + k23 * cc; S[2] = S[2] * s.eg + k45 * cc; S[3] = S[3] * s.eg + k67 * cc;
    const f32x2 o2 = (s.q0.xy * S[0] + s.q0.zw * S[1]) + (s.q1.xy * S[2] + s.q1.zw * S[3]);
    const float o = allred16(o2.x + o2.y);
    if (wr) *ob = o;
}
struct GStage { f32x4 k[2], q[2], v; float e; };
__device__ __forceinline__ void gdn_gload(GStage& g, const float* GK, const float* GQ, const float* GV, const float* GEG, const float* GBE, int t0, int tid) {
#pragma unroll
    for (int r = 0; r < 2; ++r) { const int i = tid + 512 * r, st = i >> 5, f4 = i & 31; g.k[r] = *(const f32x4*)(GK + (size_t)(t0 + st) * 1024 + 4 * f4); g.q[r] = *(const f32x4*)(GQ + (size_t)(t0 + st) * 1024 + 4 * f4); }
    if (tid < 256) g.v = *(const f32x4*)(GV + (size_t)(t0 + (tid >> 3)) * 1024 + 4 * (tid & 7));
    else if (tid < 288) g.e = GEG[(size_t)(t0 + tid - 256) * 8];
    else if (tid < 320) g.e = GBE[(size_t)(t0 + tid - 288) * 8];
}
__device__ __forceinline__ void gdn_gstore(const GStage& g, LAS float* buf, int tid) {
#pragma unroll
    for (int r = 0; r < 2; ++r) { const int i = tid + 512 * r; *(LAS f32x4*)(buf + 4 * i) = g.k[r]; *(LAS f32x4*)(buf + CH * 128 + 4 * i) = g.q[r]; }
    if (tid < 256) *(LAS f32x4*)(buf + 2 * CH * 128 + 4 * tid) = g.v;
    else if (tid < 320) buf[2 * CH * 128 + CH * 32 + (tid - 256)] = g.e;
}
__device__ __forceinline__ void gdn_block(const Ctx& F, int vb) {
    const int bh = vb >> 2, qt = vb & 3, b = bh >> 3, h = bh & 7, colL = F.wave * 4 + (F.lane >> 4), rg = F.lane & 15;
    const size_t base = (size_t)b * SEQ;
    const float* GK = (const float*)(F.ws + WS_GK) + base * 1024 + h * 128; const float* GQ = (const float*)(F.ws + WS_GQ) + base * 1024 + h * 128;
    const float* GV = (const float*)(F.ws + WS_GV) + base * 1024 + h * 128 + qt * 32;
    const float* GEG = (const float*)(F.ws + WS_GEG) + base * 8 + h; const float* GBE = (const float*)(F.ws + WS_GBE) + base * 8 + h;
    float* GO = (float*)(F.ws + WS_GO) + base * 1024 + h * 128 + qt * 32;
    LAS float* lb = (LAS float*)F.lds; LAS float* obase = lb + 2 * G_BUF;
    f32x2 S[4] = {{0.f, 0.f}, {0.f, 0.f}, {0.f, 0.f}, {0.f, 0.f}};
    const bool wr = rg == 0;
    GStage g;
    gdn_gload(g, GK, GQ, GV, GEG, GBE, 0, F.tid); gdn_gstore(g, lb, F.tid);
    __syncthreads();
    for (int c = 0; c < SEQ / CH; ++c) {
        const LAS float* buf = lb + (c & 1) * G_BUF; LAS float* ob = obase + (c & 1) * (CH * 32) + colL;
        if (c + 1 < SEQ / CH) gdn_gload(g, GK, GQ, GV, GEG, GBE, (c + 1) * CH, F.tid);
        GStep R0, R1, R2, R3;
        gdn_lds(R0, buf, 0, rg, colL); gdn_lds(R1, buf, 1, rg, colL);
#pragma unroll 1
        for (int s = 0; s < CH; s += 4) {
            gdn_lds(R2, buf, s + 2, rg, colL); gdn_step(R0, S, ob + s * 32, wr);
            gdn_lds(R3, buf, s + 3, rg, colL); gdn_step(R1, S, ob + (s + 1) * 32, wr);
            gdn_lds(R0, buf, (s + 4) & (CH - 1), rg, colL); gdn_step(R2, S, ob + (s + 2) * 32, wr);
            gdn_lds(R1, buf, (s + 5) & (CH - 1), rg, colL); gdn_step(R3, S, ob + (s + 3) * 32, wr);
        }
        if (c + 1 < SEQ / CH) gdn_gstore(g, lb + ((c + 1) & 1) * G_BUF, F.tid);
        __syncthreads();
        if (F.tid < 256) *(f32x4*)(GO + (size_t)(c * CH + (F.tid >> 3)) * 1024 + 4 * (F.tid & 7)) = *(const LAS f32x4*)(obase + (c & 1) * (CH * 32) + 4 * F.tid);
    }
}

struct RStep { f32x4 w, n, a, k, r; float v; };
constexpr int R_BUF = CH * (5 * 64 + 32);
__device__ __forceinline__ void rwkv_lds(RStep& s, const LAS float* buf, int st, int cq, int rowL) {
    s.w = *(const LAS f32x4*)(buf + st * 64 + 4 * cq); s.n = *(const LAS f32x4*)(buf + CH * 64 + st * 64 + 4 * cq); s.a = *(const LAS f32x4*)(buf + 2 * CH * 64 + st * 64 + 4 * cq);
    s.k = *(const LAS f32x4*)(buf + 3 * CH * 64 + st * 64 + 4 * cq); s.r = *(const LAS f32x4*)(buf + 4 * CH * 64 + st * 64 + 4 * cq); s.v = buf[5 * CH * 64 + st * 32 + rowL];
}
__device__ __forceinline__ void rwkv_step(const RStep& s, f32x4& S, LAS float* ob, bool wr) {
    float sa = (S.x * s.n.x + S.y * s.n.y) + (S.z * s.n.z + S.w * s.n.w);
    sa = allred16(sa);
    S = S * s.w + sa * s.a + s.v * s.k;
    float y = (S.x * s.r.x + S.y * s.r.y) + (S.z * s.r.z + S.w * s.r.w);
    y = allred16(y);
    if (wr) *ob = y;
}
struct RStage { f32x4 x[5], v; };
__device__ __forceinline__ void rwkv_gload(RStage& g, const float* const (&src)[5], const float* RV, int t0, int tid) {
    const int st = tid >> 4, f4 = tid & 15;
#pragma unroll
    for (int q = 0; q < 5; ++q) g.x[q] = *(const f32x4*)(src[q] + (size_t)(t0 + st) * 1024 + 4 * f4);
    if (tid < 256) g.v = *(const f32x4*)(RV + (size_t)(t0 + (tid >> 3)) * 1024 + 4 * (tid & 7));
}
__device__ __forceinline__ void rwkv_gstore(const RStage& g, LAS float* buf, int tid) {
#pragma unroll
    for (int q = 0; q < 5; ++q) *(LAS f32x4*)(buf + q * CH * 64 + 4 * tid) = g.x[q];
    if (tid < 256) *(LAS f32x4*)(buf + 5 * CH * 64 + 4 * tid) = g.v;
}
__device__ __forceinline__ void rwkv_block(const Ctx& F, int vb) {
    const int bh = vb >> 1, hf = vb & 1, b = bh >> 4, h = bh & 15, rowL = F.wave * 4 + (F.lane >> 4), cq = F.lane & 15;
    const size_t base = (size_t)b * SEQ * 1024 + h * 64;
    const float* const src[5] = {(const float*)(F.ws + WS_RW) + base, (const float*)(F.ws + WS_RKK) + base, (const float*)(F.ws + WS_RKA) + base, (const float*)(F.ws + WS_RK) + base, (const float*)(F.ws + WS_RR) + base};
    const float* RV = (const float*)(F.ws + WS_RV) + base + hf * 32;
    float* RY = (float*)(F.ws + WS_RY) + base + hf * 32;
    LAS float* lb = (LAS float*)F.lds; LAS float* obase = lb + 2 * R_BUF;
    f32x4 S = {0.f, 0.f, 0.f, 0.f};
    const bool wr = cq == 0;
    RStage g;
    rwkv_gload(g, src, RV, 0, F.tid); rwkv_gstore(g, lb, F.tid);
    __syncthreads();
    for (int c = 0; c < SEQ / CH; ++c) {
        const LAS float* buf = lb + (c & 1) * R_BUF; LAS float* ob = obase + (c & 1) * (CH * 32) + rowL;
        if (c + 1 < SEQ / CH) rwkv_gload(g, src, RV, (c + 1) * CH, F.tid);
        RStep R0, R1, R2, R3;
        rwkv_lds(R0, buf, 0, cq, rowL); rwkv_lds(R1, buf, 1, cq, rowL);
#pragma unroll 1
        for (int s = 0; s < CH; s += 4) {
            rwkv_lds(R2, buf, s + 2, cq, rowL); rwkv_step(R0, S, ob + s * 32, wr);
            rwkv_lds(R3, buf, s + 3, cq, rowL); rwkv_step(R1, S, ob + (s + 1) * 32, wr);
            rwkv_lds(R0, buf, (s + 4) & (CH - 1), cq, rowL); rwkv_step(R2, S, ob + (s + 2) * 32, wr);
            rwkv_lds(R1, buf, (s + 5) & (CH - 1), cq, rowL); rwkv_step(R3, S, ob + (s + 3) * 32, wr);
        }
        if (c + 1 < SEQ / CH) rwkv_gstore(g, lb + ((c + 1) & 1) * R_BUF, F.tid);
        __syncthreads();
        if (F.tid < 256) *(f32x4*)(RY + (size_t)(c * CH + (F.tid >> 3)) * 1024 + 4 * (F.tid & 7)) = *(const LAS f32x4*)(obase + (c & 1) * (CH * 32) + 4 * F.tid);
    }
}

typedef short bf16x8_t __attribute__((ext_vector_type(8)));
constexpr int S5_SROW = 136;
constexpr int S5_WAVE_B = 16 * S5_SROW * 2 + 1024;
__device__ __forceinline__ void s5_block(const Ctx& F, const Args& a, int l, int it) {
    const int b = it >> 6, g = it & 63, p = F.lane, tl = F.lane >> 4, c = F.lane & 15, w = F.wave;
    const bf16* PROJ = (const bf16*)(F.ws + WS_PROJ); bf16* SY = (bf16*)(F.ws + WS_SY);
    LAS float* se = (LAS float*)F.lds;
    LAS unsigned char* wb = F.lds + 4096 + w * S5_WAVE_B;
    LAS bf16* sbuf = (LAS bf16*)wb; LAS float* uall = (LAS float*)(wb + 16 * S5_SROW * 2);
    const size_t gp = ((size_t)l * 64 + g) * 64 + p;
    const float dt = expf(a.in[19][l * 64 + g]); const float are = a.in[17][gp], aim = a.in[18][gp];
    const float mag = expf(are * dt), abr = mag * cosf(aim * dt), abi = mag * sinf(aim * dt);
    const float den = are * are + aim * aim, cr = ((abr - 1.f) * are + abi * aim) / den, ci = (abi * are - (abr - 1.f) * aim) / den;
    float Bre[16], Bim[16];
#pragma unroll
    for (int q = 0; q < 4; ++q) { const f32x4 br = *(const f32x4*)(a.in[20] + gp * 16 + 4 * q), bi = *(const f32x4*)(a.in[21] + gp * 16 + 4 * q);
#pragma unroll
        for (int e = 0; e < 4; ++e) { Bre[4 * q + e] = cr * br[e] - ci * bi[e]; Bim[4 * q + e] = cr * bi[e] + ci * br[e]; } }
    bf16x8_t Cf[4];
    { const size_t cb = (((size_t)l * 64 + g) * 16 + c) * 64;
#pragma unroll
      for (int m = 0; m < 4; ++m) { const int k0 = 32 * m + 8 * tl; const float* src = (k0 < 64 ? a.in[22] + cb + k0 : a.in[23] + cb + (k0 - 64)); const float sg = k0 < 64 ? 1.f : -1.f;
          const f32x4 x0 = *(const f32x4*)src, x1 = *(const f32x4*)(src + 4);
          u32x4 pk; pk.x = pk2(sg * x0.x, sg * x0.y); pk.y = pk2(sg * x0.z, sg * x0.w); pk.z = pk2(sg * x1.x, sg * x1.y); pk.w = pk2(sg * x1.z, sg * x1.w);
          Cf[m] = __builtin_bit_cast(bf16x8_t, pk); } }
    const float dsk = a.in[24][l * 1024 + g * 16 + c];
    const int tw = 256 * w;
    const bf16* up = PROJ + ((size_t)b * SEQ + tw) * NINP + C_SU + g * 16;
    float sr = 0.f, si = 0.f;
    {
        bf16 ucur = up[(size_t)tl * NINP + c], unxt = up[(size_t)(4 + tl) * NINP + c];
        for (int t = 0; t < 256; t += 4) {
            uall[F.lane] = bf1(ucur);
            WFENCE();
            const int tn = (t + 8 < 256) ? t + 8 : t;
            const bf16 unn = up[(size_t)(tn + tl) * NINP + c];
#pragma unroll
            for (int j = 0; j < 4; ++j) {
                float br = 0.f, bi = 0.f;
#pragma unroll
                for (int q = 0; q < 4; ++q) { const f32x4 u4 = *(const LAS f32x4*)(uall + j * 16 + 4 * q);
#pragma unroll
                    for (int e = 0; e < 4; ++e) { br += Bre[4 * q + e] * u4[e]; bi += Bim[4 * q + e] * u4[e]; } }
                const float nr = abr * sr - abi * si + br, ni = abr * si + abi * sr + bi; sr = nr; si = ni;
            }
            WFENCE();
            ucur = unxt; unxt = unn;
        }
    }
    se[w * 128 + p] = sr; se[w * 128 + 64 + p] = si;
    __syncthreads();
    {
        float pr = abr, pi = abi;
#pragma unroll
        for (int i = 0; i < 8; ++i) { const float nr = pr * pr - pi * pi, ni = 2.f * pr * pi; pr = nr; pi = ni; }
        sr = 0.f; si = 0.f;
        for (int j = 0; j < w; ++j) { const float er = se[j * 128 + p], ei = se[j * 128 + 64 + p]; const float nr = pr * sr - pi * si + er, ni = pr * si + pi * sr + ei; sr = nr; si = ni; }
    }
    {
        bf16 ucur = up[(size_t)tl * NINP + c], unxt = up[(size_t)(4 + tl) * NINP + c];
        for (int t = 0; t < 256; t += 16) {
#pragma unroll
            for (int sub = 0; sub < 4; ++sub) {
                uall[sub * 64 + F.lane] = bf1(ucur);
                WFENCE();
                const int tn = (t + 4 * sub + 8 < 256) ? t + 4 * sub + 8 : t + 4 * sub;
                const bf16 unn = up[(size_t)(tn + tl) * NINP + c];
#pragma unroll
                for (int j = 0; j < 4; ++j) {
                    float br = 0.f, bi = 0.f;
#pragma unroll
                    for (int q = 0; q < 4; ++q) { const f32x4 u4 = *(const LAS f32x4*)(uall + sub * 64 + j * 16 + 4 * q);
#pragma unroll
                        for (int e = 0; e < 4; ++e) { br += Bre[4 * q + e] * u4[e]; bi += Bim[4 * q + e] * u4[e]; } }
                    const float nr = abr * sr - abi * si + br, ni = abr * si + abi * sr + bi; sr = nr; si = ni;
                    sbuf[(sub * 4 + j) * S5_SROW + p] = (bf16)f2bf(sr); sbuf[(sub * 4 + j) * S5_SROW + 64 + p] = (bf16)f2bf(si);
                }
                ucur = unxt; unxt = unn;
            }
            WFENCE();
            f32x4 acc = {0.f, 0.f, 0.f, 0.f};
#pragma unroll
            for (int m = 0; m < 4; ++m) { const bf16x8_t af = *(const LAS bf16x8_t*)(sbuf + c * S5_SROW + 32 * m + 8 * tl);
                acc = __builtin_amdgcn_mfma_f32_16x16x32_bf16(af, Cf[m], acc, 0, 0, 0); }
#pragma unroll
            for (int r = 0; r < 4; ++r) { const int st = 4 * tl + r; const float y = acc[r] + dsk * uall[st * 16 + c];
                SY[((size_t)b * SEQ + tw + t + st) * 1024 + g * 16 + c] = (bf16)f2bf(gelu_tanh(y)); }
            WFENCE();
        }
    }
    __syncthreads();
}

__device__ __forceinline__ void scan_phase(const Ctx& F, const Args& a, int l) {
    for (int r5 = 0; r5 < 1 + ((REPM >> 9) & 1); ++r5) for (int vb = F.vcu; vb < 256; vb += F.G) s5_block(F, a, l, vb);
    for (int rg_ = 0; rg_ < 1 + ((REPM >> 10) & 1); ++rg_) for (int vb = F.vcu; vb < 256; vb += F.G) {
        if (vb < 128) { gdn_block(F, vb); if (REPM & 2048) gdn_block(F, vb); }
        else { rwkv_block(F, vb - 128); if (REPM & 4096) rwkv_block(F, vb - 128); }
    }
}

__device__ __forceinline__ void post_phase(const Ctx& F, const Args& a, int l) {
    const bf16* PROJ = (const bf16*)(F.ws + WS_PROJ); bf16* OBR = (bf16*)(F.ws + WS_OBR);
    const float* GO = (const float*)(F.ws + WS_GO); const float* RY = (const float*)(F.ws + WS_RY); const float* RV = (const float*)(F.ws + WS_RV); const float* RBON = (const float*)(F.ws + WS_RBON);
    const int c0 = 16 * F.lane;
    float nw[16], lw[16], lb[16];
#pragma unroll
    for (int e = 0; e < 16; ++e) { nw[e] = a.in[6][l * 128 + (c0 & 127) + e]; lw[e] = a.in[15][l * 1024 + c0 + e]; lb[e] = a.in[16][l * 1024 + c0 + e]; }
    for (int tok = F.gw; tok < TOK; tok += F.NGW) {
        { float o[16];
#pragma unroll
          for (int q = 0; q < 4; ++q) { const f32x4 v = *(const f32x4*)(GO + (size_t)tok * 1024 + c0 + 4 * q); o[4 * q] = v.x; o[4 * q + 1] = v.y; o[4 * q + 2] = v.z; o[4 * q + 3] = v.w; }
          float ss = 0.f;
#pragma unroll
          for (int e = 0; e < 16; ++e) ss += o[e] * o[e];
          ss = allred8(ss);
          const float rs = 1.f / sqrtf(ss * (1.f / 128.f) + 1e-6f);
          float z[16]; { float z0[8], z1[8]; unpack8(*(const u32x4*)(PROJ + (size_t)tok * NINP + C_GZ + c0), z0); unpack8(*(const u32x4*)(PROJ + (size_t)tok * NINP + C_GZ + c0 + 8), z1);
#pragma unroll
              for (int e = 0; e < 8; ++e) { z[e] = z0[e]; z[8 + e] = z1[e]; } }
          float r0[8], r1[8];
#pragma unroll
          for (int e = 0; e < 8; ++e) { r0[e] = o[e] * rs * nw[e] * siluf_(z[e]); r1[e] = o[8 + e] * rs * nw[8 + e] * siluf_(z[8 + e]); }
          *(u32x4*)(OBR + (size_t)tok * 1024 + c0) = pack8(r0); *(u32x4*)(OBR + (size_t)tok * 1024 + c0 + 8) = pack8(r1); }
        { float y[16], v[16];
#pragma unroll
          for (int q = 0; q < 4; ++q) { const f32x4 t = *(const f32x4*)(RY + (size_t)tok * 1024 + c0 + 4 * q); y[4 * q] = t.x; y[4 * q + 1] = t.y; y[4 * q + 2] = t.z; y[4 * q + 3] = t.w;
              const f32x4 w = *(const f32x4*)(RV + (size_t)tok * 1024 + c0 + 4 * q); v[4 * q] = w.x; v[4 * q + 1] = w.y; v[4 * q + 2] = w.z; v[4 * q + 3] = w.w; }
          float s = 0.f;
#pragma unroll
          for (int e = 0; e < 16; ++e) s += y[e];
          s += dppf<0xB1>(s); s += dppf<0x4E>(s);
          const float mean = s * (1.f / 64.f); float q2 = 0.f;
#pragma unroll
          for (int e = 0; e < 16; ++e) { const float d = y[e] - mean; q2 += d * d; }
          q2 += dppf<0xB1>(q2); q2 += dppf<0x4E>(q2);
          const float rs = 1.f / sqrtf(q2 * (1.f / 64.f) + 64e-5f);
          const float bon = RBON[(size_t)tok * 16 + (c0 >> 6)];
          float z[16]; { float z0[8], z1[8]; unpack8(*(const u32x4*)(PROJ + (size_t)tok * NINP + C_RZ + c0), z0); unpack8(*(const u32x4*)(PROJ + (size_t)tok * NINP + C_RZ + c0 + 8), z1);
#pragma unroll
              for (int e = 0; e < 8; ++e) { z[e] = z0[e]; z[8 + e] = z1[e]; } }
          float r0[8], r1[8];
#pragma unroll
          for (int e = 0; e < 8; ++e) { r0[e] = ((y[e] - mean) * rs * lw[e] + lb[e] + bon * v[e]) * siluf_(z[e]); r1[e] = ((y[8 + e] - mean) * rs * lw[8 + e] + lb[8 + e] + bon * v[8 + e]) * siluf_(z[8 + e]); }
          bf16* ob = OBR + (size_t)TOK * 1024 + (size_t)tok * 1024 + c0;
          *(u32x4*)ob = pack8(r0); *(u32x4*)(ob + 8) = pack8(r1); }
    }
}

#ifndef PHM
#define PHM 0xFFFF
#endif
#ifndef REPM
#define REPM 0
#endif
__global__ void __launch_bounds__(NTHREADS, 2) hybrid_fwd(Args a) {
    extern __shared__ __attribute__((aligned(16))) unsigned char lds_raw[];
    Ctx F;
    F.lds = (LAS unsigned char*)lds_raw; F.ws = a.ws;
    F.G = gridDim.x; { const int bx = blockIdx.x; F.vcu = (F.G % 8 == 0) ? (bx % 8) * (F.G / 8) + bx / 8 : bx; }
    F.NGW = F.G * NWAVES;
    cg::grid_group grid = cg::this_grid();
    if (threadIdx.x < 8) ((volatile LAS unsigned*)(F.lds + MISC_OFF))[threadIdx.x] = 0u;
    __syncthreads();
    XcdBarrier bar = xcd_barrier_post((unsigned*)(a.ws + WS_CTL), (volatile LAS unsigned*)(F.lds + MISC_OFF));
    bf16* XN = (bf16*)(a.ws + WS_XN); bf16* PROJ = (bf16*)(a.ws + WS_PROJ);
    int rep = 0;
    for (int ph = a.ph_lo; ph < a.ph_hi; ) {
        { int t_ = threadIdx.x; asm volatile("" : "+v"(t_)); F.tid = t_; F.lane = t_ & 63; F.wave = __builtin_amdgcn_readfirstlane(t_ >> 6); F.gw = F.vcu * NWAVES + F.wave; }
        if (ph == 0) { if (PHM & 1) phase0(F, a);
            if (REPM & 128) { if (!rep) { rep = 1; __syncthreads(); continue; } rep = 0; } }
        else {
            const int l = (ph - 1) / PH_PER_LAYER, k = (ph - 1) % PH_PER_LAYER;
            if (k == 0 && (PHM & 2)) {
                pg8::Gemm g{XN, (const bf16*)(a.ws + WS_WIN) + (size_t)l * NINP * DM, TOK, NINP, DM}; pg8::StaticOrder S; S.init(TOK, NINP, F.G, (int)blockIdx.x);
                pg8::EpiBf16<0> E{PROJ, NINP, nullptr, 0, 0, 1.f};
                pg8::gemm_phase<pg8::EpiBf16<0>, pg8::StaticOrder, true, true>(F.lds, g, S, E);
            } else if (k == 1) { prep_gdn(F, a, l); if (REPM & 8192) prep_gdn(F, a, l); prep_rwkv(F, a, l); if (REPM & 16384) prep_rwkv(F, a, l); }
            else if (k == 2) { if (PHM & 16) scan_phase(F, a, l); }
            else if (k == 3 && (PHM & 32)) {
                if (PHM & 256) post_phase(F, a, l);
                __syncthreads();
                pg8::Gemm g{(const bf16*)(a.ws + WS_SY), (const bf16*)(a.ws + WS_WGLU) + (size_t)l * 1024 * 1024, TOK, 1024, 1024}; pg8::StaticOrder S; S.init(TOK, 1024, F.G, (int)blockIdx.x);
                pg8::EpiGlu E{(const bf16*)(a.ws + WS_SY), PROJ, a.in[26] + l * 1024, (bf16*)(a.ws + WS_OBR) + (size_t)2 * TOK * 1024};
                pg8::gemm_phase<pg8::EpiGlu, pg8::StaticOrder, true, true>(F.lds, g, S, E);
            } else if (k == 4 && (PHM & 64)) {
                pg8::Gemm g{(const bf16*)(a.ws + WS_OBR), (const bf16*)(a.ws + WS_WBR) + (size_t)l * 3 * DM * 1024, 3 * TOK, 3 * DM, 1024};
                pg8::BranchOrder S; S.base.init(TOK, DM, F.G, (int)blockIdx.x);
                pg8::EpiBranch E{PROJ, a.in[27] + (size_t)l * 3 * DM, (float*)(a.ws + WS_ACCF), (bf16*)(a.ws + WS_MRG)};
                pg8::gemm_phase<pg8::EpiBranch, pg8::BranchOrder, true, true>(F.lds, g, S, E);
            } else if (k == 5 && (PHM & 128)) {
                pg8::Gemm g{(const bf16*)(a.ws + WS_MRG), (const bf16*)(a.ws + WS_WOUT) + (size_t)l * DM * DM, TOK, DM, DM}; pg8::StaticOrder S; S.init(TOK, DM, F.G, (int)blockIdx.x);
                pg8::EpiResid E{l == 0 ? a.in[0] : a.out, a.out};
                pg8::gemm_phase<pg8::EpiResid, pg8::StaticOrder, true, true>(F.lds, g, S, E);
            } else if (k == 6) {
                if (l + 1 < DEPTH) { for (int m = F.gw; m < TOK; m += F.NGW) rms_row(a.out + (size_t)m * DM, a.in[1] + (size_t)(l + 1) * DM, XN + (size_t)m * DM, nullptr, F.lane); }
                else { for (int m = F.gw; m < TOK; m += F.NGW) rms_row(a.out + (size_t)m * DM, a.in[30], nullptr, a.out + (size_t)m * DM, F.lane); }
            }
            if (REPM && !rep && ((REPM >> k) & 1)) { rep = 1; __syncthreads(); continue; }
            rep = 0;
        }
        if (ph + 1 < a.ph_hi) {
            if (ph == 0) { __threadfence(); grid.sync(); __builtin_amdgcn_fence(__ATOMIC_ACQUIRE, "agent"); }
            else xcd_barrier(bar);
            if (REPM & 256) xcd_barrier(bar);
        }
        ++ph;
    }
}

#ifndef MK_MULTI
#define MK_MULTI 0
#endif
extern "C" void kernel_launch(void* const* d_in, const int* in_sizes, int n_in, void* d_out, int out_size, void* d_ws, size_t ws_size, hipStream_t stream) {
    static int grid = 0;
    if (grid == 0) {
        if (n_in != 31 || out_size != TOK * DM || ws_size < WS_END) { fprintf(stderr, "kernel_launch: unexpected shapes (n_in %d out %d ws %zu)\n", n_in, out_size, ws_size); grid = -1; return; }
        int dev = 0, cus = 0, per_cu = 0;
        hipGetDevice(&dev); hipDeviceGetAttribute(&cus, hipDeviceAttributeMultiprocessorCount, dev);
        if (hipFuncSetAttribute((const void*)hybrid_fwd, hipFuncAttributeMaxDynamicSharedMemorySize, LDS_BYTES) != hipSuccess) { fprintf(stderr, "kernel_launch: hipFuncSetAttribute failed\n"); grid = -1; return; }
        if (hipOccupancyMaxActiveBlocksPerMultiprocessor(&per_cu, (const void*)hybrid_fwd, NTHREADS, LDS_BYTES) != hipSuccess || per_cu < 1) per_cu = 1;
        (void)hipGetLastError();
        grid = cus * per_cu;
        fprintf(stderr, "kernel_launch: grid %d (cus %d x %d)\n", grid, cus, per_cu);
    }
    if (grid < 0) return;
    if (hipMemsetAsync((char*)d_ws + WS_CTL, 0, CTL_ZERO_BYTES, stream) != hipSuccess) { fprintf(stderr, "kernel_launch: memset failed\n"); return; }
    Args a{};
    for (int i = 0; i < 31; ++i) a.in[i] = (const float*)d_in[i];
    a.out = (float*)d_out; a.ws = (unsigned char*)d_ws;
#if MK_MULTI
    for (int ph = 0; ph < NPHASES; ++ph) { a.ph_lo = ph; a.ph_hi = ph + 1; hipLaunchKernelGGL(hybrid_fwd, dim3(grid), dim3(NTHREADS), LDS_BYTES, stream, a); }
#else
    a.ph_lo = 0; a.ph_hi = NPHASES;
    void* args[] = {&a};
    const hipError_t e = hipLaunchCooperativeKernel((const void*)hybrid_fwd, dim3(grid), dim3(NTHREADS), args, LDS_BYTES, stream);
    if (e != hipSuccess) fprintf(stderr, "kernel_launch: cooperative launch failed: %s (grid %d)\n", hipGetErrorString(e), grid);
#endif
}
```

```cpp
#include <hip/hip_runtime.h>
#include <hip/hip_cooperative_groups.h>
#include <cstdio>
#include <cstdint>
namespace cg = cooperative_groups;
namespace pg8 {
#define PG8_LAS __attribute__((address_space(3)))
typedef unsigned short bf16_t;
typedef short bf16x8 __attribute__((ext_vector_type(8)));
typedef float f32x4 __attribute__((ext_vector_type(4)));
typedef unsigned u32x4 __attribute__((ext_vector_type(4)));
constexpr int BM = 256, BK = 64, HALF = 128, HTB = HALF * BK * 2  , STAGE_BYTES = 8 * HTB, NXCD = 8, WGM = 8;

__host__ __device__ __forceinline__ int lds_byte(int r, int c) { const int st = (r >> 4) * 2 + (c >> 5), rr = r & 15, cc = c & 31, ob = rr * 64 + cc * 2; return st * 1024 + (ob ^ (((ob >> 9) & 1) << 5)); }
__host__ __device__ __forceinline__ void stage_rc(int b, int& R, int& C) { const int st = b / 1024, sb = b % 1024, swz = sb ^ (((sb >> 9) & 1) << 5); R = (st >> 1) * 16 + swz / 64; C = (st & 1) * 32 + (swz % 64) / 2; }
__host__ __device__ __forceinline__ int perm32(int rho) { const int n = rho >> 4, i = rho & 15; return 8 * (i >> 2) + 4 * n + (i & 3); }

struct Unit { int pm, pn; };
struct Gemm { const bf16_t* A; const bf16_t* Bt; int M, N, K; };

struct StaticOrder {
    int nM, nN, nwg, G, c;
    __host__ __device__ void init(int M, int N, int G_, int c_) { nM = M / BM; nN = N / BM; nwg = nM * nN; G = G_; c = c_; }
    __host__ __device__ bool next(int i, Unit& u) const {
        const long L = (long)i * G + c; if (L >= nwg) return false;
        int wgid = (int)L; { const int q = nwg / NXCD, r = nwg % NXCD, xcd = wgid % NXCD, off = wgid / NXCD; wgid = (xcd < r ? xcd * (q + 1) : r * (q + 1) + (xcd - r) * q) + off; }
        const int nig = WGM * nN, gid = wgid / nig, fm = gid * WGM, gsz = (nM - fm) < WGM ? (nM - fm) : WGM;
        u.pm = fm + ((wgid % nig) % gsz); u.pn = (wgid % nig) / gsz; return true;
    }
    __device__ __forceinline__ void a_ready(const Unit&) const {}
    __device__ __forceinline__ void done(const Unit&) const {}
};

__device__ __forceinline__ unsigned cvt_pk_bf16(float lo, float hi) { unsigned r; asm volatile("v_cvt_pk_bf16_f32 %0, %1, %2" : "=v"(r) : "v"(lo), "v"(hi)); return r; }
typedef float f32x2 __attribute__((ext_vector_type(2)));
__device__ __forceinline__ f32x2 gelu_pk(f32x2 v) {
    const f32x2 av = __builtin_elementwise_abs(v), d = av * 0.2316418882f + 1.0f;
    f32x2 t; t.x = __builtin_amdgcn_rcpf(d.x); t.y = __builtin_amdgcn_rcpf(d.y);
    f32x2 q = t * 0.5307027145f + (-0.7265760135f); q = q * t + 0.7107068705f; q = q * t + (-0.142248368f); q = q * t + 0.127414796f; q = q * t;
    const f32x2 s = (v * v) * (-0.72134752044f);
    f32x2 e; e.x = __builtin_amdgcn_exp2f(s.x); e.y = __builtin_amdgcn_exp2f(s.y);
    const f32x2 m = v * (q * e), r = v - m;
    f32x2 o; o.x = v.x < 0.f ? m.x : r.x; o.y = v.y < 0.f ? m.y : r.y; return o;
}

template <int ACT  > struct EpiBf16 {
    static constexpr bool PERM = true, AFTER_DRAIN = false; static_assert(ACT == 0 || ACT == 1, "EpiBf16: ACT is 0 (none) or 1 (gelu_pk)");
    bf16_t* O; int ldc; const float* bias; int split_cols; size_t split_stride; float scale0;
    __device__ __forceinline__ void operator()(const f32x4 (&acc)[2][2][4][2], const Unit& u, int wr, int wc, int fr, int fq) const {
        const int row0 = u.pm * BM + wr * 64 + fr; int colt = u.pn * BM; bf16_t* base = O;
        float sc = 1.f; if (split_cols) { const int t = colt / split_cols; base += (size_t)t * split_stride; colt -= t * split_cols; if (t == 0) sc = scale0; }
        const int col0 = colt + wc * 32 + 8 * fq, bcol0 = u.pn * BM + wc * 32 + 8 * fq;
        f32x4 bv[2][2];
#pragma unroll
        for (int bj = 0; bj < 2; ++bj)
#pragma unroll
            for (int n = 0; n < 2; ++n) bv[bj][n] = bias ? *(const f32x4*)(bias + bcol0 + bj * HALF + 4 * n) : (f32x4){0.f, 0.f, 0.f, 0.f};
#pragma unroll
        for (int ai = 0; ai < 2; ++ai)
#pragma unroll
            for (int m = 0; m < 4; ++m) { bf16_t* rowp = base + (size_t)(row0 + ai * HALF + m * 16) * ldc + col0;
#pragma unroll
                for (int bj = 0; bj < 2; ++bj) { f32x4 v0 = acc[ai][bj][m][0] + bv[bj][0], v1 = acc[ai][bj][m][1] + bv[bj][1];
                    if (ACT == 1) { f32x2 a = gelu_pk((f32x2){v0[0], v0[1]}), b = gelu_pk((f32x2){v0[2], v0[3]}), c = gelu_pk((f32x2){v1[0], v1[1]}), d = gelu_pk((f32x2){v1[2], v1[3]});
                        v0 = (f32x4){a.x, a.y, b.x, b.y}; v1 = (f32x4){c.x, c.y, d.x, d.y}; }
                    v0 = v0 * sc; v1 = v1 * sc; u32x4 w; w.x = cvt_pk_bf16(v0[0], v0[1]); w.y = cvt_pk_bf16(v0[2], v0[3]); w.z = cvt_pk_bf16(v1[0], v1[1]); w.w = cvt_pk_bf16(v1[2], v1[3]);
                    *(u32x4*)(rowp + bj * HALF) = w; } }
    }
};

template <class Epi, class Sched, bool ALIGN_EPI = false, bool SP2 = false>
__device__ __forceinline__ void gemm_phase(PG8_LAS unsigned char* lds, const Gemm g, const Sched& S, const Epi& E) {
    int tid_ = threadIdx.x; asm volatile("" : "+v"(tid_));
    const int tid = tid_, wid = __builtin_amdgcn_readfirstlane(tid >> 6), lane = tid & 63, wr = wid >> 2, wc = wid & 3, fr = lane & 15, fq = lane >> 4;
    const int K = g.K, nt = K / BK;
    unsigned voffA[2], voffB[2];
#pragma unroll
    for (int i = 0; i < 2; ++i) { int R, C; stage_rc(tid * 16 + i * 8192, R, C); const int Rb = Epi::PERM ? ((R & ~31) + perm32(R & 31)) : R;
        voffA[i] = (unsigned)(R * K + C) * 2u; voffB[i] = (unsigned)(Rb * K + C) * 2u; }
    const size_t kstep = (size_t)(BK * 2);
    const size_t hstep = (size_t)HALF * K * 2;
    const size_t tstep = 2 * hstep;
    const unsigned ldsw = (unsigned)wid * 1024u;
    const int aoff = lds_byte(wr * 64 + fr, fq * 8), boff = lds_byte(wc * 32 + fr, fq * 8);
#define PG8_SA(b, h) (((b) * 2 + (h)) * HTB)
#define PG8_SB(b, h) ((4 + (b) * 2 + (h)) * HTB)
#define PG8_STAGE(bufoff, gbase, voff) do { _Pragma("unroll") for (int _i = 0; _i < 2; ++_i) \
        __builtin_amdgcn_global_load_lds((const unsigned*)((const char*)(gbase) + (voff)[_i]), (PG8_LAS unsigned*)(lds + (bufoff) + ldsw + _i * 8192), 16, 0, 0); } while (0)
#define PG8_LDA(dst, b, h) do { _Pragma("unroll") for (int m = 0; m < 4; ++m) _Pragma("unroll") for (int k = 0; k < 2; ++k) dst[m][k] = *(const PG8_LAS bf16x8*)(lds + PG8_SA(b, h) + aoff + m * 2048 + k * 1024); } while (0)
#define PG8_LDB(dst, b, h) do { _Pragma("unroll") for (int n = 0; n < 2; ++n) _Pragma("unroll") for (int k = 0; k < 2; ++k) dst[n][k] = *(const PG8_LAS bf16x8*)(lds + PG8_SB(b, h) + boff + n * 2048 + k * 1024); } while (0)
#define PG8_MMA(ai, bj, At, Bt) do { __builtin_amdgcn_s_setprio(1); _Pragma("unroll") for (int m = 0; m < 4; ++m) _Pragma("unroll") for (int n = 0; n < 2; ++n) _Pragma("unroll") for (int k = 0; k < 2; ++k) \
        acc[ai][bj][m][n] = __builtin_amdgcn_mfma_f32_16x16x32_bf16(Bt[n][k], At[m][k], acc[ai][bj][m][n], 0, 0, 0); __builtin_amdgcn_s_setprio(0); } while (0)
#define PG8_WAIT_V(n) asm volatile("s_waitcnt vmcnt(" #n ")" ::: "memory")
#define PG8_WAIT_L(n) asm volatile("s_waitcnt lgkmcnt(" #n ")" ::: "memory")
#define PG8_BAR __builtin_amdgcn_s_barrier()
#define PG8_SCHED __builtin_amdgcn_sched_barrier(0)
    Unit cur, nxt; int ui = 0;
    if (!S.next(0, cur)) return;
    f32x4 acc[2][2][4][2];
#pragma unroll
    for (int a = 0; a < 2; ++a)
#pragma unroll
        for (int b = 0; b < 2; ++b)
#pragma unroll
            for (int m = 0; m < 4; ++m)
#pragma unroll
                for (int n = 0; n < 2; ++n) acc[a][b][m][n] = (f32x4){0.f, 0.f, 0.f, 0.f};
    bf16x8 At[4][2], B0[2][2], B1[2][2];
    const char* cA = (const char*)g.A + (size_t)cur.pm * tstep; const char* cB = (const char*)g.Bt + (size_t)cur.pn * tstep;
    S.a_ready(cur);
    if constexpr (SP2) {
        PG8_STAGE(PG8_SB(0, 0), cB, voffB); PG8_STAGE(PG8_SB(0, 1), cB + hstep, voffB); PG8_STAGE(PG8_SA(0, 0), cA, voffA); PG8_STAGE(PG8_SA(0, 1), cA + hstep, voffA);
        if (wr == 1) PG8_BAR;
        PG8_WAIT_V(2); PG8_BAR;
        PG8_STAGE(PG8_SB(1, 0), cB + kstep, voffB); PG8_STAGE(PG8_SA(1, 0), cA + kstep, voffA); PG8_STAGE(PG8_SB(1, 1), cB + hstep + kstep, voffB);
        PG8_WAIT_V(6); PG8_BAR;
    } else {
        PG8_STAGE(PG8_SB(0, 0), cB, voffB); PG8_STAGE(PG8_SA(0, 0), cA, voffA); PG8_STAGE(PG8_SB(0, 1), cB + hstep, voffB); PG8_STAGE(PG8_SA(0, 1), cA + hstep, voffA);
        if (wr == 1) PG8_BAR;
        PG8_WAIT_V(4); PG8_BAR;
        PG8_STAGE(PG8_SB(1, 0), cB + kstep, voffB); PG8_STAGE(PG8_SA(1, 0), cA + kstep, voffA); PG8_STAGE(PG8_SB(1, 1), cB + hstep + kstep, voffB);
        PG8_WAIT_V(6); PG8_BAR;
    }
    for (;;) {
        const bool has_next = S.next(ui + 1, nxt);
        const char* nA = has_next ? (const char*)g.A + (size_t)nxt.pm * tstep : cA; const char* nB = has_next ? (const char*)g.Bt + (size_t)nxt.pn * tstep : cB;
        for (int t = 0; t < nt; t += 2) {
            const bool last = (t == nt - 2);
            const char* a1 = cA + (size_t)(t + 1) * kstep;
            const char* a2 = last ? nA : cA + (size_t)(t + 2) * kstep; const char* b2 = last ? nB : cB + (size_t)(t + 2) * kstep;
            const char* a3 = a2 + kstep; const char* b3 = b2 + kstep;
            if (last && has_next) S.a_ready(nxt);
            if constexpr (SP2) {
            PG8_LDB(B0, 0, 0); PG8_LDB(B1, 0, 1); PG8_SCHED; PG8_LDA(At, 0, 0); PG8_STAGE(PG8_SA(1, 1), a1 + hstep, voffA);
            PG8_WAIT_V(8); PG8_WAIT_L(0); PG8_BAR; PG8_MMA(0, 0, At, B0); PG8_MMA(0, 1, At, B1); PG8_BAR; PG8_SCHED;
            PG8_LDA(At, 0, 1); PG8_STAGE(PG8_SB(0, 0), b2, voffB); PG8_STAGE(PG8_SB(0, 1), b2 + hstep, voffB); PG8_STAGE(PG8_SA(0, 0), a2, voffA);
            PG8_WAIT_V(8); PG8_WAIT_L(0); PG8_BAR; PG8_MMA(1, 0, At, B0); PG8_MMA(1, 1, At, B1); PG8_BAR; PG8_SCHED;
            PG8_LDB(B0, 1, 0); PG8_LDB(B1, 1, 1); PG8_SCHED; PG8_LDA(At, 1, 0); PG8_STAGE(PG8_SA(0, 1), a2 + hstep, voffA);
            PG8_WAIT_V(8); PG8_WAIT_L(0); PG8_BAR; PG8_MMA(0, 0, At, B0); PG8_MMA(0, 1, At, B1); PG8_BAR; PG8_SCHED;
            PG8_LDA(At, 1, 1); PG8_STAGE(PG8_SB(1, 0), b3, voffB); PG8_STAGE(PG8_SB(1, 1), b3 + hstep, voffB); PG8_STAGE(PG8_SA(1, 0), a3, voffA);
            PG8_WAIT_V(8); PG8_WAIT_L(0); PG8_BAR; PG8_MMA(1, 0, At, B0); PG8_MMA(1, 1, At, B1); PG8_BAR; PG8_SCHED;
            } else {
            PG8_LDB(B0, 0, 0); PG8_SCHED; PG8_LDA(At, 0, 0); PG8_STAGE(PG8_SA(1, 1), a1 + hstep, voffA);
            PG8_WAIT_L(8); PG8_BAR; PG8_WAIT_L(0); PG8_MMA(0, 0, At, B0); PG8_BAR; PG8_SCHED;
            PG8_LDB(B1, 0, 1); PG8_STAGE(PG8_SB(0, 0), b2, voffB);
            PG8_BAR; PG8_WAIT_L(0); PG8_MMA(0, 1, At, B1); PG8_BAR;
            PG8_LDA(At, 0, 1); PG8_STAGE(PG8_SA(0, 0), a2, voffA);
            PG8_BAR; PG8_WAIT_L(0); PG8_MMA(1, 0, At, B0); PG8_BAR; PG8_SCHED;
            PG8_STAGE(PG8_SB(0, 1), b2 + hstep, voffB);
            PG8_WAIT_V(6); PG8_BAR; PG8_MMA(1, 1, At, B1); PG8_BAR;
            PG8_LDB(B0, 1, 0); PG8_SCHED; PG8_LDA(At, 1, 0); PG8_STAGE(PG8_SA(0, 1), a2 + hstep, voffA);
            PG8_WAIT_L(8); PG8_BAR; PG8_WAIT_L(0); PG8_MMA(0, 0, At, B0); PG8_BAR; PG8_SCHED;
            PG8_LDB(B1, 1, 1); PG8_STAGE(PG8_SB(1, 0), b3, voffB);
            PG8_BAR; PG8_WAIT_L(0); PG8_MMA(0, 1, At, B1); PG8_BAR;
            PG8_LDA(At, 1, 1); PG8_STAGE(PG8_SA(1, 0), a3, voffA);
            PG8_BAR; PG8_WAIT_L(0); PG8_MMA(1, 0, At, B0); PG8_BAR; PG8_SCHED;
            PG8_STAGE(PG8_SB(1, 1), b3 + hstep, voffB);
            PG8_WAIT_V(6); PG8_BAR; PG8_MMA(1, 1, At, B1); PG8_BAR;
            }
        }
        if constexpr (ALIGN_EPI) { if (wr == 0) PG8_BAR; }
        if constexpr (!Epi::AFTER_DRAIN) { E(acc, cur, wr, wc, fr, fq); S.done(cur); }
        if (!has_next) break;
#pragma unroll
        for (int a = 0; a < 2; ++a)
#pragma unroll
            for (int b = 0; b < 2; ++b)
#pragma unroll
                for (int m = 0; m < 4; ++m)
#pragma unroll
                    for (int n = 0; n < 2; ++n) acc[a][b][m][n] = (f32x4){0.f, 0.f, 0.f, 0.f};
        cur = nxt; cA = nA; cB = nB; ++ui;
        if constexpr (ALIGN_EPI) { if (wr == 1) PG8_BAR; }
    }
    PG8_WAIT_V(0);
    if constexpr (!ALIGN_EPI) { if (wr == 0) PG8_BAR; }
    PG8_BAR;
    if constexpr (Epi::AFTER_DRAIN) { E.fused(acc, cur, wr, wc, fr, fq, lds, wid, lane); S.done(cur); }
#undef PG8_SA
#undef PG8_SB
#undef PG8_STAGE
#undef PG8_LDA
#undef PG8_LDB
#undef PG8_MMA
#undef PG8_WAIT_V
#undef PG8_WAIT_L
#undef PG8_BAR
#undef PG8_SCHED
}
}

#define GAS __attribute__((address_space(1)))
#define LAS __attribute__((address_space(3)))
typedef unsigned short bf16;
typedef unsigned u32x4 __attribute__((ext_vector_type(4)));
typedef unsigned u32x2 __attribute__((ext_vector_type(2)));
typedef float f32x4 __attribute__((ext_vector_type(4)));
typedef float f32x2 __attribute__((ext_vector_type(2)));

constexpr int NBATCH = 4, SEQ = 2048, TOK = NBATCH * SEQ, DM = 2048, DEPTH = 4;
constexpr int NIN = 16592, NINP = 16640;
constexpr int C_GQKV = 0, C_GZ = 3072, C_GB = 4096, C_GA = 4104, C_RF = 4112, C_RZ = 7376, C_SU = 8400, C_SZ = 9424, C_GATE = 10448;
constexpr int NWAVES = 8, NTHREADS = 512;
constexpr int LDS_BYTES = 147456;
constexpr int PH_PER_LAYER = 6, NPHASES = 2 + DEPTH * PH_PER_LAYER;

constexpr size_t MiB = 1u << 20;
constexpr size_t WS_WIN = 0, WS_WGLU = 260 * MiB, WS_WBR = 268 * MiB, WS_WOUT = 316 * MiB, WS_XN = 348 * MiB, WS_PROJ = 380 * MiB;
constexpr size_t WS_GQ = 640 * MiB, WS_GK = 672 * MiB, WS_GV = 704 * MiB, WS_GEG = 736 * MiB, WS_GBE = 737 * MiB, WS_GO = 738 * MiB;
constexpr size_t WS_RR = 770 * MiB, WS_RW = 802 * MiB, WS_RK = 834 * MiB, WS_RV = 866 * MiB, WS_RKK = 898 * MiB, WS_RKA = 930 * MiB, WS_RBON = 962 * MiB, WS_RY = 963 * MiB;
constexpr size_t WS_SY = 995 * MiB, WS_OBR = 1011 * MiB, WS_ACCF = 1059 * MiB, WS_MRG = 1123 * MiB, WS_CTL = 1155 * MiB, WS_END = 1156 * MiB;
constexpr size_t CTL_SS = 65536, CTL_ZERO_BYTES = CTL_SS + (size_t)DEPTH * TOK * 8;
constexpr int MISC_OFF = 147392;
static_assert((size_t)DEPTH * NINP * DM * 2 == 260 * MiB && (size_t)TOK * NINP * 2 == 260 * MiB, "ws map");

__device__ __forceinline__ unsigned f2bf(float f) { unsigned u = __builtin_bit_cast(unsigned, f); return (u + 0x7fffu + ((u >> 16) & 1u)) >> 16; }
__device__ __forceinline__ unsigned pk2(float lo, float hi) { return f2bf(lo) | (f2bf(hi) << 16); }
__device__ __forceinline__ float bflo(unsigned w) { return __builtin_bit_cast(float, w << 16); }
__device__ __forceinline__ float bfhi(unsigned w) { return __builtin_bit_cast(float, w & 0xffff0000u); }
__device__ __forceinline__ float bf1(bf16 h) { return __builtin_bit_cast(float, (unsigned)h << 16); }
__device__ __forceinline__ float sigmoidf_(float x) { return 1.f / (1.f + __expf(-x)); }
__device__ __forceinline__ float siluf_(float x) { return x / (1.f + __expf(-x)); }
__device__ __forceinline__ float softplusf_(float x) { return x > 20.f ? x : log1pf(expf(x)); }
__device__ __forceinline__ float gelu_tanh(float y) { const float t = 0.7978845608028654f * (y + 0.044715f * y * y * y); const float th = 1.f - 2.f / (1.f + __expf(2.f * t)); return 0.5f * y * (1.f + th); }
template <int CTRL> __device__ __forceinline__ float dppf(float v) { return __builtin_bit_cast(float, __builtin_amdgcn_update_dpp(0, __builtin_bit_cast(int, v), CTRL, 0xF, 0xF, true)); }
__device__ __forceinline__ float allred8(float v) { v += dppf<0xB1>(v); v += dppf<0x4E>(v); v += dppf<0x141>(v); return v; }
__device__ __forceinline__ float allred16(float v) { v = allred8(v); v += dppf<0x140>(v); return v; }
__device__ __forceinline__ float wave_sum(float v) {
#pragma unroll
    for (int o = 1; o < 64; o <<= 1) v += __shfl_xor(v, o);
    return v;
}
__device__ __forceinline__ void unpack8(const u32x4 w, float (&f)[8]) { f[0] = bflo(w.x); f[1] = bfhi(w.x); f[2] = bflo(w.y); f[3] = bfhi(w.y); f[4] = bflo(w.z); f[5] = bfhi(w.z); f[6] = bflo(w.w); f[7] = bfhi(w.w); }
__device__ __forceinline__ u32x4 pack8(const float (&f)[8]) { u32x4 w; w.x = pk2(f[0], f[1]); w.y = pk2(f[2], f[3]); w.z = pk2(f[4], f[5]); w.w = pk2(f[6], f[7]); return w; }

namespace pg8 {
struct EpiGlu {
    static constexpr bool PERM = true, AFTER_DRAIN = false;
    const bf16* Y1; const bf16* PROJ; const float* bias; bf16* O;
    __device__ __forceinline__ void operator()(const f32x4 (&acc)[2][2][4][2], const Unit& u, int wr, int wc, int fr, int fq) const {
        int row0 = u.pm * BM + wr * 64 + fr, col0 = u.pn * BM + wc * 32 + 8 * fq;
        asm volatile("" : "+v"(row0), "+v"(col0));
#pragma unroll
        for (int bj = 0; bj < 2; ++bj) {
            const int col = col0 + bj * HALF;
            const f32x4 b0 = *(const f32x4*)(bias + col), b1 = *(const f32x4*)(bias + col + 4);
#pragma unroll
            for (int ai = 0; ai < 2; ++ai)
#pragma unroll
                for (int m = 0; m < 4; ++m) {
                    const size_t row = (size_t)(row0 + ai * HALF + m * 16);
                    const u32x4 y8 = *(const u32x4*)(Y1 + row * 1024 + col), z8 = *(const u32x4*)(PROJ + row * NINP + C_SZ + col);
                    float y[8], z[8], o[8]; unpack8(y8, y); unpack8(z8, z);
                    const f32x4 v0 = acc[ai][bj][m][0] + b0, v1 = acc[ai][bj][m][1] + b1;
                    const float a[8] = {v0[0], v0[1], v0[2], v0[3], v1[0], v1[1], v1[2], v1[3]};
#pragma unroll
                    for (int e = 0; e < 8; ++e) o[e] = y[e] * sigmoidf_(a[e]) * siluf_(z[e]);
                    *(u32x4*)(O + row * 1024 + col) = pack8(o);
                    asm volatile("" ::: "memory");
                }
        }
    }
};
struct EpiBranch {
    static constexpr bool PERM = true, AFTER_DRAIN = false;
    const bf16* PROJ; const float* gate_b; float* ACCF; bf16* MRG;
    __device__ __forceinline__ void operator()(const f32x4 (&acc)[2][2][4][2], const Unit& u, int wr, int wc, int fr, int fq) const {
        const int br = u.pm >> 5, pm = u.pm & 31, pn = u.pn & 7;
        int row0 = pm * BM + wr * 64 + fr, col0 = pn * BM + wc * 32 + 8 * fq;
        asm volatile("" : "+v"(row0), "+v"(col0));
#pragma unroll
        for (int bj = 0; bj < 2; ++bj) {
            const int col = col0 + bj * HALF;
            const f32x4 g0 = *(const f32x4*)(gate_b + br * DM + col), g1 = *(const f32x4*)(gate_b + br * DM + col + 4);
            const float gb[8] = {g0[0], g0[1], g0[2], g0[3], g1[0], g1[1], g1[2], g1[3]};
#pragma unroll
            for (int ai = 0; ai < 2; ++ai)
#pragma unroll
                for (int m = 0; m < 4; ++m) {
                    const size_t row = (size_t)(row0 + ai * HALF + m * 16);
                    const u32x4 l8 = *(const u32x4*)(PROJ + row * NINP + C_GATE + br * DM + col);
                    float gl[8], o[8]; unpack8(l8, gl);
                    const f32x4 v0 = acc[ai][bj][m][0], v1 = acc[ai][bj][m][1];
                    const float a[8] = {v0[0], v0[1], v0[2], v0[3], v1[0], v1[1], v1[2], v1[3]};
#pragma unroll
                    for (int e = 0; e < 8; ++e) o[e] = sigmoidf_(gl[e] + gb[e]) * a[e];
                    float* ap = ACCF + row * DM + col;
                    if (br > 0) { const f32x4 p0 = *(const f32x4*)ap, p1 = *(const f32x4*)(ap + 4);
                        o[0] += p0[0]; o[1] += p0[1]; o[2] += p0[2]; o[3] += p0[3]; o[4] += p1[0]; o[5] += p1[1]; o[6] += p1[2]; o[7] += p1[3]; }
                    if (br < 2) { *(f32x4*)ap = (f32x4){o[0], o[1], o[2], o[3]}; *(f32x4*)(ap + 4) = (f32x4){o[4], o[5], o[6], o[7]}; }
                    else *(u32x4*)(MRG + row * DM + col) = pack8(o);
                    asm volatile("" ::: "memory");
                }
        }
    }
};
struct EpiResid {
    static constexpr bool PERM = true, AFTER_DRAIN = false;
    const float* base; float* out; bf16* xn; const float* nw; unsigned long long* ss;
    __device__ __forceinline__ void operator()(const f32x4 (&acc)[2][2][4][2], const Unit& u, int wr, int wc, int fr, int fq) const {
        int row0 = u.pm * BM + wr * 64 + fr, col0 = u.pn * BM + wc * 32 + 8 * fq;
        asm volatile("" : "+v"(row0), "+v"(col0));
#pragma unroll
        for (int ai = 0; ai < 2; ++ai)
#pragma unroll
            for (int m = 0; m < 4; ++m) {
                const int row = row0 + ai * HALF + m * 16; float sq = 0.f;
#pragma unroll
                for (int bj = 0; bj < 2; ++bj) {
                    const size_t off = (size_t)row * DM + col0 + bj * HALF;
                    const f32x4 o0 = *(const f32x4*)(base + off) + acc[ai][bj][m][0], o1 = *(const f32x4*)(base + off + 4) + acc[ai][bj][m][1];
                    *(f32x4*)(out + off) = o0; *(f32x4*)(out + off + 4) = o1;
                    if (xn) { const f32x4 w0 = *(const f32x4*)(nw + col0 + bj * HALF), w1 = *(const f32x4*)(nw + col0 + bj * HALF + 4);
                        sq += (o0.x * o0.x + o0.y * o0.y) + (o0.z * o0.z + o0.w * o0.w) + (o1.x * o1.x + o1.y * o1.y) + (o1.z * o1.z + o1.w * o1.w);
                        u32x4 p; p.x = pk2(o0.x * w0.x, o0.y * w0.y); p.y = pk2(o0.z * w0.z, o0.w * w0.w); p.z = pk2(o1.x * w1.x, o1.y * w1.y); p.w = pk2(o1.z * w1.z, o1.w * w1.w);
                        *(u32x4*)(xn + off) = p; }
                }
                if (xn) { sq += __shfl_xor(sq, 16); sq += __shfl_xor(sq, 32); if (fq == 0) atomicAdd(ss + row, (unsigned long long)(sq * 65536.f + 0.5f)); }
                asm volatile("" ::: "memory");
            }
    }
};
struct EpiBf16Rs {
    static constexpr bool PERM = true, AFTER_DRAIN = false;
    bf16* O; int ldc; const unsigned long long* ss;
    __device__ __forceinline__ void operator()(const f32x4 (&acc)[2][2][4][2], const Unit& u, int wr, int wc, int fr, int fq) const {
        int row0 = u.pm * BM + wr * 64 + fr, col0 = u.pn * BM + wc * 32 + 8 * fq;
        asm volatile("" : "+v"(row0), "+v"(col0));
#pragma unroll
        for (int ai = 0; ai < 2; ++ai)
#pragma unroll
            for (int m = 0; m < 4; ++m) { const int row = row0 + ai * HALF + m * 16; const float rs = 1.f / sqrtf((float)ss[row] * (1.f / (65536.f * DM)) + 1e-6f);
                bf16* rowp = O + (size_t)row * ldc + col0;
#pragma unroll
                for (int bj = 0; bj < 2; ++bj) { const f32x4 v0 = acc[ai][bj][m][0] * rs, v1 = acc[ai][bj][m][1] * rs;
                    u32x4 w; w.x = cvt_pk_bf16(v0[0], v0[1]); w.y = cvt_pk_bf16(v0[2], v0[3]); w.z = cvt_pk_bf16(v1[0], v1[1]); w.w = cvt_pk_bf16(v1[2], v1[3]);
                    *(u32x4*)(rowp + bj * HALF) = w; } }
    }
};
struct BranchOrder {
    StaticOrder base;
    __device__ bool next(int i, Unit& u) const { Unit t; const int r = i / 3, br = i - 3 * r; if (!base.next(r, t)) return false; u.pm = br * 32 + t.pm; u.pn = br * 8 + t.pn; return true; }
    __device__ __forceinline__ void a_ready(const Unit&) const {}
    __device__ __forceinline__ void done(const Unit&) const {}
};
}

#define XB_TMO      128
#define XB_XCNT(j)  (256  + 64 * (j))
#define XB_XSUB(j)  (1280 + 64 * (j))
#define XB_XGEN(j)  (2304 + 64 * (j))
#define XB_TOP      3328
#define XB_TOPGEN   3392
#define XCD_BAR_WORDS 3456
#define XB_SPIN_CAP (1u << 18)

__device__ __forceinline__ unsigned xb_ld(unsigned* p)              { return __hip_atomic_load(p, __ATOMIC_RELAXED, __HIP_MEMORY_SCOPE_AGENT); }
__device__ __forceinline__ unsigned xb_add(unsigned* p, unsigned v) { return __hip_atomic_fetch_add(p, v, __ATOMIC_RELAXED, __HIP_MEMORY_SCOPE_AGENT); }
__device__ __forceinline__ unsigned xb_xcc_id() { return (unsigned)__builtin_amdgcn_s_getreg((3 << 11) | 20) & 0xFu; }
#define XB_SPIN(cond, bar) do { unsigned _sp = 0; while (cond) { __builtin_amdgcn_s_sleep(1); \
    if ((++_sp & 255u) == 0u) { if (xb_ld(&(bar)[XB_TMO])) break; if (_sp > XB_SPIN_CAP) { atomicAdd(&(bar)[XB_TMO], 1u); break; } } } } while (0)

struct XcdBarrier {
    unsigned* bar; unsigned x;
    volatile LAS unsigned* st;
};

__device__ __forceinline__ XcdBarrier xcd_barrier_post(unsigned* bar, volatile LAS unsigned* st) {
    XcdBarrier b; b.bar = bar; b.x = xb_xcc_id(); b.st = st;
    if (threadIdx.x == 0) (void)xb_add(&bar[XB_XCNT(b.x)], 1u);
    return b;
}
__device__ __forceinline__ void xcd_barrier_complete(unsigned* bar, unsigned x, unsigned& nloc, unsigned& nx) {
    const unsigned G = gridDim.x * gridDim.y * gridDim.z;
    unsigned sum, cnt, mine, sp = 0u;
    for (;;) {
        sum = 0u; cnt = 0u; mine = 0u;
#pragma unroll
        for (unsigned j = 0; j < 16; ++j) { const unsigned c = xb_ld(&bar[XB_XCNT(j)]); sum += c; cnt += (c > 0u) ? 1u : 0u; mine = (j == x) ? c : mine; }
        if (sum == G) break;
        __builtin_amdgcn_s_sleep(1);
        if ((++sp & 255u) == 0u) { if (xb_ld(&bar[XB_TMO])) break; if (sp > XB_SPIN_CAP) { atomicAdd(&bar[XB_TMO], 1u); break; } }
    }
    nloc = mine > 0u ? mine : 1u; nx = cnt > 0u ? cnt : 1u;
}

__device__ __forceinline__ void xcd_barrier(const XcdBarrier& b) {
    asm volatile("s_waitcnt vmcnt(0)" ::: "memory");
    __syncthreads();
    if (threadIdx.x == 0) {
        unsigned* bar = b.bar;
        __builtin_amdgcn_s_waitcnt(0);
        unsigned nloc = b.st[0], nx = b.st[1];
        if (nloc == 0u) { xcd_barrier_complete(bar, b.x, nloc, nx); b.st[0] = nloc; b.st[1] = nx; }
        const unsigned old = xb_add(&bar[XB_XSUB(b.x)], 1u);
        const unsigned gen = old / nloc;
        if (old + 1u == (gen + 1u) * nloc) {
            __builtin_amdgcn_fence(__ATOMIC_RELEASE, "agent");
            asm volatile("s_waitcnt vmcnt(0)" ::: "memory");
            const unsigned og = xb_add(&bar[XB_TOP], 1u);
            const unsigned tg = og / nx;
            if (og + 1u == (tg + 1u) * nx) xb_add(&bar[XB_TOPGEN], 1u);
            else XB_SPIN(xb_ld(&bar[XB_TOPGEN]) == tg, bar);
            __builtin_amdgcn_fence(__ATOMIC_ACQUIRE, "agent");
            xb_add(&bar[XB_XGEN(b.x)], 1u);
            asm volatile("s_waitcnt vmcnt(0)" ::: "memory");
        } else {
            XB_SPIN(xb_ld(&bar[XB_XGEN(b.x)]) == gen, bar);
            __builtin_amdgcn_fence(__ATOMIC_ACQUIRE, "agent");
            asm volatile("s_waitcnt vmcnt(0)" ::: "memory");
        }
    }
    __syncthreads();
}

struct Args { const float* in[31]; float* out; unsigned char* ws; int ph_lo, ph_hi; };
struct Ctx { int tid, lane, wave, vcu, G, gw, NGW; LAS unsigned char* lds; unsigned char* ws; };

__device__ __forceinline__ void transpose_item(const float* W, int K, int N, bf16* WT, LAS float* scr, int kb, int nb, int lane) {
    const int k0 = 64 * kb, n0 = 64 * nb, nq = 4 * (lane & 15), kr = lane >> 4; const bool nv = n0 + nq < N;
    f32x4 v[16];
#pragma unroll
    for (int i = 0; i < 16; ++i) v[i] = nv ? *(const f32x4*)(W + (size_t)(k0 + 4 * i + kr) * N + n0 + nq) : (f32x4){0.f, 0.f, 0.f, 0.f};
#pragma unroll
    for (int i = 0; i < 16; ++i) { LAS float* d = scr + (4 * i + kr) * 65 + nq; d[0] = v[i].x; d[1] = v[i].y; d[2] = v[i].z; d[3] = v[i].w; }
    asm volatile("s_waitcnt lgkmcnt(0)" ::: "memory");
    const int c = lane & 7;
#pragma unroll
    for (int j = 0; j < 8; ++j) { const int nn = (lane >> 3) + 8 * j; const LAS float* s = scr + (8 * c) * 65 + nn;
        u32x4 o; o.x = pk2(s[0 * 65], s[1 * 65]); o.y = pk2(s[2 * 65], s[3 * 65]); o.z = pk2(s[4 * 65], s[5 * 65]); o.w = pk2(s[6 * 65], s[7 * 65]);
        *(u32x4*)(WT + (size_t)(n0 + nn) * K + k0 + 8 * c) = o; }
    asm volatile("s_waitcnt lgkmcnt(0)" ::: "memory");
}

__device__ __forceinline__ void rms_row(const float* xrow, const float* w, bf16* obf, unsigned long long* ss, float* of32, int lane) {
    f32x4 v[8]; float s = 0.f;
#pragma unroll
    for (int j = 0; j < 8; ++j) { v[j] = *(const f32x4*)(xrow + 4 * lane + 256 * j); s += (v[j].x * v[j].x + v[j].y * v[j].y) + (v[j].z * v[j].z + v[j].w * v[j].w); }
    s = wave_sum(s);
    const float r = obf ? 1.f : 1.f / sqrtf(s * (1.f / DM) + 1e-6f);
#pragma unroll
    for (int j = 0; j < 8; ++j) { const f32x4 ww = *(const f32x4*)(w + 4 * lane + 256 * j); const f32x4 o = v[j] * r * ww;
        if (obf) { u32x2 p; p.x = pk2(o.x, o.y); p.y = pk2(o.z, o.w); *(u32x2*)(obf + 4 * lane + 256 * j) = p; }
        else *(f32x4*)(of32 + 4 * lane + 256 * j) = o; }
    if (obf && lane == 0) *ss = (unsigned long long)(s * 65536.f + 0.5f);
}

__device__ __forceinline__ void phase0(const Ctx& F, const Args& a) {
    LAS float* scr = (LAS float*)(F.lds + F.wave * 16640);
    constexpr int I_IN = 32 * 260, I_GLU = 16 * 16, I_BR = 16 * 32, I_OUT = 32 * 32, IL = I_IN + I_GLU + 3 * I_BR + I_OUT;
    bf16* WIN = (bf16*)(F.ws + WS_WIN); bf16* WGLU = (bf16*)(F.ws + WS_WGLU); bf16* WBR = (bf16*)(F.ws + WS_WBR); bf16* WOUT = (bf16*)(F.ws + WS_WOUT);
    for (int it = F.gw; it < DEPTH * IL; it += F.NGW) {
        const int l = it / IL; int r = it - l * IL;
        if (r < I_IN) { transpose_item(a.in[2] + (size_t)l * DM * NIN, DM, NIN, WIN + (size_t)l * NINP * DM, scr, r / 260, r % 260, F.lane); continue; } r -= I_IN;
        if (r < I_GLU) { transpose_item(a.in[25] + (size_t)l * 1024 * 1024, 1024, 1024, WGLU + (size_t)l * 1024 * 1024, scr, r / 16, r % 16, F.lane); continue; } r -= I_GLU;
        if (r < 3 * I_BR) { const int br = r / I_BR, r2 = r - br * I_BR;
            transpose_item(a.in[28] + (size_t)(l * 3 + br) * 1024 * DM, 1024, DM, WBR + (size_t)(l * 3 + br) * DM * 1024, scr, r2 / 32, r2 % 32, F.lane); continue; } r -= 3 * I_BR;
        transpose_item(a.in[29] + (size_t)l * DM * DM, DM, DM, WOUT + (size_t)l * DM * DM, scr, r / 32, r % 32, F.lane);
    }
    bf16* XN = (bf16*)(F.ws + WS_XN);
    unsigned long long* SS0 = (unsigned long long*)(F.ws + WS_CTL + CTL_SS);
    for (int m = F.gw; m < TOK; m += F.NGW) rms_row(a.in[0] + (size_t)m * DM, a.in[1], XN + (size_t)m * DM, SS0 + m, nullptr, F.lane);
}

__device__ __forceinline__ void prep_gdn(const Ctx& F, const Args& a, int l) {
    const bf16* PROJ = (const bf16*)(F.ws + WS_PROJ);
    float* GQ = (float*)(F.ws + WS_GQ); float* GK = (float*)(F.ws + WS_GK); float* GV = (float*)(F.ws + WS_GV); float* GEG = (float*)(F.ws + WS_GEG); float* GBE = (float*)(F.ws + WS_GBE);
    const float* cw = a.in[3] + (size_t)l * 4 * 3072;
    for (int it = F.gw; it < 2048; it += F.NGW) {
        const int h = it & 7, ch = (it >> 3) & 63, b = it >> 9;
        const int t0 = ch * 32; const int c = 2 * F.lane;
        float w[3][4][2], hist[3][3][2];
#pragma unroll
        for (int p = 0; p < 3; ++p)
#pragma unroll
            for (int j = 0; j < 4; ++j) { const f32x2 ww = *(const f32x2*)(cw + j * 3072 + p * 1024 + h * 128 + c); w[p][j][0] = ww.x; w[p][j][1] = ww.y; }
#pragma unroll
        for (int p = 0; p < 3; ++p)
#pragma unroll
            for (int j = 0; j < 3; ++j) { const int t = t0 - 3 + j; unsigned x = 0u;
                if (t >= 0) x = *(const unsigned*)(PROJ + (size_t)(b * SEQ + t) * NINP + C_GQKV + p * 1024 + h * 128 + c);
                hist[p][j][0] = bflo(x); hist[p][j][1] = bfhi(x); }
        const float alog = a.in[4][l * 8 + h], dtb = a.in[5][l * 8 + h]; const float aexp = expf(alog);
        for (int tt = 0; tt < 32; ++tt) {
            const size_t tok = (size_t)(b * SEQ + t0 + tt);
            float o[3][2];
#pragma unroll
            for (int p = 0; p < 3; ++p) {
                const unsigned x = *(const unsigned*)(PROJ + tok * NINP + C_GQKV + p * 1024 + h * 128 + c);
                const float x0 = bflo(x), x1 = bfhi(x);
                const float y0 = w[p][0][0] * hist[p][0][0] + w[p][1][0] * hist[p][1][0] + w[p][2][0] * hist[p][2][0] + w[p][3][0] * x0;
                const float y1 = w[p][0][1] * hist[p][0][1] + w[p][1][1] * hist[p][1][1] + w[p][2][1] * hist[p][2][1] + w[p][3][1] * x1;
                hist[p][0][0] = hist[p][1][0]; hist[p][1][0] = hist[p][2][0]; hist[p][2][0] = x0;
                hist[p][0][1] = hist[p][1][1]; hist[p][1][1] = hist[p][2][1]; hist[p][2][1] = x1;
                o[p][0] = siluf_(y0); o[p][1] = siluf_(y1);
            }
            const float sq = wave_sum(o[0][0] * o[0][0] + o[0][1] * o[0][1]), sk = wave_sum(o[1][0] * o[1][0] + o[1][1] * o[1][1]);
            const float rq = 0.08838834764831845f / sqrtf(sq + 1e-6f), rk = 1.f / sqrtf(sk + 1e-6f);
            const size_t off = tok * 1024 + h * 128 + c;
            *(f32x2*)(GQ + off) = (f32x2){o[0][0] * rq, o[0][1] * rq};
            *(f32x2*)(GK + off) = (f32x2){o[1][0] * rk, o[1][1] * rk};
            *(f32x2*)(GV + off) = (f32x2){o[2][0], o[2][1]};
            if (F.lane == 0) {
                const float bl = bf1(PROJ[tok * NINP + C_GB + h]), al = bf1(PROJ[tok * NINP + C_GA + h]);
                GBE[tok * 8 + h] = sigmoidf_(bl);
                GEG[tok * 8 + h] = expf(-aexp * softplusf_(al + dtb));
            }
        }
    }
}

__device__ __forceinline__ float mix2(unsigned c, unsigned p, float mu0, float mu1, float& o1) {
    const float c0 = bflo(c), c1 = bfhi(c), p0 = bflo(p), p1 = bfhi(p);
    o1 = c1 + (p1 - c1) * mu1; return c0 + (p0 - c0) * mu0;
}
__device__ __forceinline__ void prep_rwkv(const Ctx& F, const Args& a, int l) {
    const bf16* PROJ = (const bf16*)(F.ws + WS_PROJ);
    float* RR = (float*)(F.ws + WS_RR); float* RW = (float*)(F.ws + WS_RW); float* RK = (float*)(F.ws + WS_RK); float* RV = (float*)(F.ws + WS_RV);
    float* RKK = (float*)(F.ws + WS_RKK); float* RKA = (float*)(F.ws + WS_RKA); float* RBON = (float*)(F.ws + WS_RBON);
    const float* mu = a.in[7] + (size_t)l * 3264; const float* w0 = a.in[8] + l * 1024; const float* wup = a.in[9] + (size_t)l * 96 * 1024;
    const float* a0 = a.in[10] + l * 1024; const float* aup = a.in[11] + (size_t)l * 96 * 1024; const float* kk_ = a.in[12] + l * 1024; const float* ka_ = a.in[13] + l * 1024; const float* rk_ = a.in[14] + l * 1024;
    LAS float* A1 = (LAS float*)F.lds; LAS float* A2 = A1 + 16 * 96;
    const int j = F.tid, c = 2 * j;
    const f32x2 mur = *(const f32x2*)(mu + c), muk = *(const f32x2*)(mu + 1024 + c), muv = *(const f32x2*)(mu + 2048 + c);
    const f32x2 w0v = *(const f32x2*)(w0 + c), a0v = *(const f32x2*)(a0 + c), kkv = *(const f32x2*)(kk_ + c), kav = *(const f32x2*)(ka_ + c), rkv = *(const f32x2*)(rk_ + c);
    for (int tile = F.vcu; tile < TOK / 16; tile += F.G) {
        __syncthreads();
        for (int e = F.tid; e < 16 * 192; e += NTHREADS) {
            const int tl = e / 192, i = e - tl * 192; const size_t tok = (size_t)tile * 16 + tl;
            const float cur = bf1(PROJ[tok * NINP + C_RF + 3072 + i]);
            const float prv = (tok & (SEQ - 1)) ? bf1(PROJ[(tok - 1) * NINP + C_RF + 3072 + i]) : 0.f;
            const float m = cur + (prv - cur) * mu[3072 + i];
            if (i < 96) A1[tl * 96 + i] = tanhf(m); else A2[tl * 96 + i - 96] = m;
        }
        __syncthreads();
        float accw[16][2], acca[16][2];
#pragma unroll
        for (int tl = 0; tl < 16; ++tl) { accw[tl][0] = 0.f; accw[tl][1] = 0.f; acca[tl][0] = 0.f; acca[tl][1] = 0.f; }
        for (int i = 0; i < 96; i += 4) {
            f32x2 wu[4], au[4];
#pragma unroll
            for (int q = 0; q < 4; ++q) { wu[q] = *(const f32x2*)(wup + (size_t)(i + q) * 1024 + c); au[q] = *(const f32x2*)(aup + (size_t)(i + q) * 1024 + c); }
#pragma unroll
            for (int tl = 0; tl < 16; ++tl) {
                const f32x4 x1 = *(const LAS f32x4*)(A1 + tl * 96 + i), x2 = *(const LAS f32x4*)(A2 + tl * 96 + i);
#pragma unroll
                for (int q = 0; q < 4; ++q) { accw[tl][0] += x1[q] * wu[q].x; accw[tl][1] += x1[q] * wu[q].y; acca[tl][0] += x2[q] * au[q].x; acca[tl][1] += x2[q] * au[q].y; }
            }
        }
#pragma unroll
        for (int tl = 0; tl < 16; ++tl) {
            const size_t tok = (size_t)tile * 16 + tl; const bool hp = (tok & (SEQ - 1)) != 0;
            const bf16* cp = PROJ + tok * NINP + C_RF + c; const bf16* pp = cp - NINP;
            const unsigned cr = *(const unsigned*)cp, ck = *(const unsigned*)(cp + 1024), cv = *(const unsigned*)(cp + 2048);
            const unsigned pr = hp ? *(const unsigned*)pp : 0u, pk = hp ? *(const unsigned*)(pp + 1024) : 0u, pv = hp ? *(const unsigned*)(pp + 2048) : 0u;
            float r1, k1, v1; const float r0 = mix2(cr, pr, mur.x, mur.y, r1), k0 = mix2(ck, pk, muk.x, muk.y, k1), v0 = mix2(cv, pv, muv.x, muv.y, v1);
            const float wp0 = w0v.x + accw[tl][0], wp1 = w0v.y + accw[tl][1];
            const float d0 = expf(-expf(-softplusf_(-wp0) - 0.5f)), d1 = expf(-expf(-softplusf_(-wp1) - 0.5f));
            const float aa0 = sigmoidf_(a0v.x + acca[tl][0]), aa1 = sigmoidf_(a0v.y + acca[tl][1]);
            const float q0 = k0 * kkv.x, q1 = k1 * kkv.y;
            float ss = q0 * q0 + q1 * q1;
#pragma unroll
            for (int o = 1; o < 32; o <<= 1) ss += __shfl_xor(ss, o);
            const float rn = 1.f / sqrtf(ss + 1e-6f); const float n0 = q0 * rn, n1 = q1 * rn;
            const float km0 = k0 * (1.f + (aa0 - 1.f) * kav.x), km1 = k1 * (1.f + (aa1 - 1.f) * kav.y);
            float bo = r0 * km0 * rkv.x + r1 * km1 * rkv.y;
#pragma unroll
            for (int o = 1; o < 32; o <<= 1) bo += __shfl_xor(bo, o);
            const size_t off = tok * 1024 + c;
            *(f32x2*)(RR + off) = (f32x2){r0, r1}; *(f32x2*)(RW + off) = (f32x2){d0, d1}; *(f32x2*)(RK + off) = (f32x2){km0, km1}; *(f32x2*)(RV + off) = (f32x2){v0, v1};
            *(f32x2*)(RKK + off) = (f32x2){-n0, -n1}; *(f32x2*)(RKA + off) = (f32x2){n0 * aa0, n1 * aa1};
            if ((F.lane & 31) == 0) RBON[tok * 16 + (c >> 6)] = bo;
        }
    }
}

#ifndef SCM
#define SCM 7
#endif
#ifndef REPM
#define REPM 0
#endif
constexpr int CH = 32;
#define WFENCE() do { __builtin_amdgcn_fence(__ATOMIC_RELEASE, "wavefront"); __builtin_amdgcn_wave_barrier(); __builtin_amdgcn_fence(__ATOMIC_ACQUIRE, "wavefront"); } while (0)

struct GStep { f32x4 k0, k1, q0, q1; float v, eg, be; };
constexpr int G_BUF = 2 * CH * 128 + CH * 32 + 2 * CH;
__device__ __forceinline__ void gdn_lds(GStep& s, const LAS float* buf, int st, int rg, int colL) {
    s.k0 = *(const LAS f32x4*)(buf + st * 128 + rg * 4); s.k1 = *(const LAS f32x4*)(buf + st * 128 + 64 + rg * 4);
    s.q0 = *(const LAS f32x4*)(buf + CH * 128 + st * 128 + rg * 4); s.q1 = *(const LAS f32x4*)(buf + CH * 128 + st * 128 + 64 + rg * 4);
    s.v = buf[2 * CH * 128 + st * 32 + colL]; s.eg = buf[2 * CH * 128 + CH * 32 + st]; s.be = buf[2 * CH * 128 + CH * 32 + CH + st];
}
__device__ __forceinline__ void gdn_step(const GStep& s, f32x2 (&S)[4], LAS float* ob, bool wr) {
    const f32x2 k01 = s.k0.xy, k23 = s.k0.zw, k45 = s.k1.xy, k67 = s.k1.zw;
    const f32x2 a2 = (k01 * S[0] + k23 * S[1]) + (k45 * S[2] + k67 * S[3]);
    const float ks = allred16(a2.x + a2.y);
    const float cc = s.be * (s.v - s.eg * ks);
    S[0] = S[0] * s.eg + k01 * cc; S[1] = S[1] * s.eg + k23 * cc; S[2] = S[2] * s.eg + k45 * cc; S[3] = S[3] * s.eg + k67 * cc;
    const f32x2 o2 = (s.q0.xy * S[0] + s.q0.zw * S[1]) + (s.q1.xy * S[2] + s.q1.zw * S[3]);
    const float o = allred16(o2.x + o2.y);
    if (wr) *ob = o;
}
struct GStage { f32x4 k[2], q[2], v; float e; };
__device__ __forceinline__ void gdn_gload(GStage& g, const float* GK, const float* GQ, const float* GV, const float* GEG, const float* GBE, int t0, int tid) {
#pragma unroll
    for (int r = 0; r < 2; ++r) { const int i = tid + 512 * r, st = i >> 5, f4 = i & 31; g.k[r] = *(const f32x4*)(GK + (size_t)(t0 + st) * 1024 + 4 * f4); g.q[r] = *(const f32x4*)(GQ + (size_t)(t0 + st) * 1024 + 4 * f4); }
    if (tid < 256) g.v = *(const f32x4*)(GV + (size_t)(t0 + (tid >> 3)) * 1024 + 4 * (tid & 7));
    else if (tid < 288) g.e = GEG[(size_t)(t0 + tid - 256) * 8];
    else if (tid < 320) g.e = GBE[(size_t)(t0 + tid - 288) * 8];
}
__device__ __forceinline__ void gdn_gstore(const GStage& g, LAS float* buf, int tid) {
#pragma unroll
    for (int r = 0; r < 2; ++r) { const int i = tid + 512 * r; *(LAS f32x4*)(buf + 4 * i) = g.k[r]; *(LAS f32x4*)(buf + CH * 128 + 4 * i) = g.q[r]; }
    if (tid < 256) *(LAS f32x4*)(buf + 2 * CH * 128 + 4 * tid) = g.v;
    else if (tid < 320) buf[2 * CH * 128 + CH * 32 + (tid - 256)] = g.e;
}
__device__ __forceinline__ void gdn_block(const Ctx& F, int vb) {
    const int bh = vb >> 2, qt = vb & 3, b = bh >> 3, h = bh & 7, colL = F.wave * 4 + (F.lane >> 4), rg = F.lane & 15;
    const size_t base = (size_t)b * SEQ;
    const float* GK = (const float*)(F.ws + WS_GK) + base * 1024 + h * 128; const float* GQ = (const float*)(F.ws + WS_GQ) + base * 1024 + h * 128;
    const float* GV = (const float*)(F.ws + WS_GV) + base * 1024 + h * 128 + qt * 32;
    const float* GEG = (const float*)(F.ws + WS_GEG) + base * 8 + h; const float* GBE = (const float*)(F.ws + WS_GBE) + base * 8 + h;
    float* GO = (float*)(F.ws + WS_GO) + base * 1024 + h * 128 + qt * 32;
    LAS float* lb = (LAS float*)F.lds; LAS float* obase = lb + 2 * G_BUF;
    f32x2 S[4] = {{0.f, 0.f}, {0.f, 0.f}, {0.f, 0.f}, {0.f, 0.f}};
    const bool wr = rg == 0;
    GStage g;
    gdn_gload(g, GK, GQ, GV, GEG, GBE, 0, F.tid); gdn_gstore(g, lb, F.tid);
    __syncthreads();
    for (int c = 0; c < SEQ / CH; ++c) {
        const LAS float* buf = lb + (c & 1) * G_BUF; LAS float* ob = obase + (c & 1) * (CH * 32) + colL;
        if (c + 1 < SEQ / CH) gdn_gload(g, GK, GQ, GV, GEG, GBE, (c + 1) * CH, F.tid);
        GStep R0, R1, R2, R3;
        gdn_lds(R0, buf, 0, rg, colL); gdn_lds(R1, buf, 1, rg, colL);
#pragma unroll 1
        for (int s = 0; s < CH; s += 4) {
            gdn_lds(R2, buf, s + 2, rg, colL); gdn_step(R0, S, ob + s * 32, wr);
            gdn_lds(R3, buf, s + 3, rg, colL); gdn_step(R1, S, ob + (s + 1) * 32, wr);
            gdn_lds(R0, buf, (s + 4) & (CH - 1), rg, colL); gdn_step(R2, S, ob + (s + 2) * 32, wr);
            gdn_lds(R1, buf, (s + 5) & (CH - 1), rg, colL); gdn_step(R3, S, ob + (s + 3) * 32, wr);
        }
        if (c + 1 < SEQ / CH) gdn_gstore(g, lb + ((c + 1) & 1) * G_BUF, F.tid);
        __syncthreads();
        if (F.tid < 256) *(f32x4*)(GO + (size_t)(c * CH + (F.tid >> 3)) * 1024 + 4 * (F.tid & 7)) = *(const LAS f32x4*)(obase + (c & 1) * (CH * 32) + 4 * F.tid);
    }
}

struct RStep { f32x4 w, n, a, k, r; float v; };
constexpr int R_BUF = CH * (5 * 64 + 32);
__device__ __forceinline__ void rwkv_lds(RStep& s, const LAS float* buf, int st, int cq, int rowL) {
    s.w = *(const LAS f32x4*)(buf + st * 64 + 4 * cq); s.n = *(const LAS f32x4*)(buf + CH * 64 + st * 64 + 4 * cq); s.a = *(const LAS f32x4*)(buf + 2 * CH * 64 + st * 64 + 4 * cq);
    s.k = *(const LAS f32x4*)(buf + 3 * CH * 64 + st * 64 + 4 * cq); s.r = *(const LAS f32x4*)(buf + 4 * CH * 64 + st * 64 + 4 * cq); s.v = buf[5 * CH * 64 + st * 32 + rowL];
}
__device__ __forceinline__ void rwkv_step(const RStep& s, f32x4& S, LAS float* ob, bool wr) {
    float sa = (S.x * s.n.x + S.y * s.n.y) + (S.z * s.n.z + S.w * s.n.w);
    sa = allred16(sa);
    S = S * s.w + sa * s.a + s.v * s.k;
    float y = (S.x * s.r.x + S.y * s.r.y) + (S.z * s.r.z + S.w * s.r.w);
    y = allred16(y);
    if (wr) *ob = y;
}
struct RStage { f32x4 x[5], v; };
__device__ __forceinline__ void rwkv_gload(RStage& g, const float* const (&src)[5], const float* RV, int t0, int tid) {
    const int st = tid >> 4, f4 = tid & 15;
#pragma unroll
    for (int q = 0; q < 5; ++q) g.x[q] = *(const f32x4*)(src[q] + (size_t)(t0 + st) * 1024 + 4 * f4);
    if (tid < 256) g.v = *(const f32x4*)(RV + (size_t)(t0 + (tid >> 3)) * 1024 + 4 * (tid & 7));
}
__device__ __forceinline__ void rwkv_gstore(const RStage& g, LAS float* buf, int tid) {
#pragma unroll
    for (int q = 0; q < 5; ++q) *(LAS f32x4*)(buf + q * CH * 64 + 4 * tid) = g.x[q];
    if (tid < 256) *(LAS f32x4*)(buf + 5 * CH * 64 + 4 * tid) = g.v;
}
__device__ __forceinline__ void rwkv_block(const Ctx& F, int vb) {
    const int bh = vb >> 1, hf = vb & 1, b = bh >> 4, h = bh & 15, rowL = F.wave * 4 + (F.lane >> 4), cq = F.lane & 15;
    const size_t base = (size_t)b * SEQ * 1024 + h * 64;
    const float* const src[5] = {(const float*)(F.ws + WS_RW) + base, (const float*)(F.ws + WS_RKK) + base, (const float*)(F.ws + WS_RKA) + base, (const float*)(F.ws + WS_RK) + base, (const float*)(F.ws + WS_RR) + base};
    const float* RV = (const float*)(F.ws + WS_RV) + base + hf * 32;
    float* RY = (float*)(F.ws + WS_RY) + base + hf * 32;
    LAS float* lb = (LAS float*)F.lds; LAS float* obase = lb + 2 * R_BUF;
    f32x4 S = {0.f, 0.f, 0.f, 0.f};
    const bool wr = cq == 0;
    RStage g;
    rwkv_gload(g, src, RV, 0, F.tid); rwkv_gstore(g, lb, F.tid);
    __syncthreads();
    for (int c = 0; c < SEQ / CH; ++c) {
        const LAS float* buf = lb + (c & 1) * R_BUF; LAS float* ob = obase + (c & 1) * (CH * 32) + rowL;
        if (c + 1 < SEQ / CH) rwkv_gload(g, src, RV, (c + 1) * CH, F.tid);
        RStep R0, R1, R2, R3;
        rwkv_lds(R0, buf, 0, cq, rowL); rwkv_lds(R1, buf, 1, cq, rowL);
#pragma unroll 1
        for (int s = 0; s < CH; s += 4) {
            rwkv_lds(R2, buf, s + 2, cq, rowL); rwkv_step(R0, S, ob + s * 32, wr);
            rwkv_lds(R3, buf, s + 3, cq, rowL); rwkv_step(R1, S, ob + (s + 1) * 32, wr);
            rwkv_lds(R0, buf, (s + 4) & (CH - 1), cq, rowL); rwkv_step(R2, S, ob + (s + 2) * 32, wr);
            rwkv_lds(R1, buf, (s + 5) & (CH - 1), cq, rowL); rwkv_step(R3, S, ob + (s + 3) * 32, wr);
        }
        if (c + 1 < SEQ / CH) rwkv_gstore(g, lb + ((c + 1) & 1) * R_BUF, F.tid);
        __syncthreads();
        if (F.tid < 256) *(f32x4*)(RY + (size_t)(c * CH + (F.tid >> 3)) * 1024 + 4 * (F.tid & 7)) = *(const LAS f32x4*)(obase + (c & 1) * (CH * 32) + 4 * F.tid);
    }
}

typedef short bf16x8_t __attribute__((ext_vector_type(8)));
constexpr int S5_SROW = 136;
constexpr int S5_WAVE_B = 16 * S5_SROW * 2 + 1024;
__device__ __forceinline__ void s5_block(const Ctx& F, const Args& a, int l, int it) {
    const int b = it >> 6, g = it & 63, p = F.lane, tl = F.lane >> 4, c = F.lane & 15, w = F.wave;
    const bf16* PROJ = (const bf16*)(F.ws + WS_PROJ); bf16* SY = (bf16*)(F.ws + WS_SY);
    LAS float* se = (LAS float*)F.lds;
    LAS unsigned char* wb = F.lds + 4096 + w * S5_WAVE_B;
    LAS bf16* sbuf = (LAS bf16*)wb; LAS float* uall = (LAS float*)(wb + 16 * S5_SROW * 2);
    const size_t gp = ((size_t)l * 64 + g) * 64 + p;
    const float dt = expf(a.in[19][l * 64 + g]); const float are = a.in[17][gp], aim = a.in[18][gp];
    const float mag = expf(are * dt), abr = mag * cosf(aim * dt), abi = mag * sinf(aim * dt);
    const float den = are * are + aim * aim, cr = ((abr - 1.f) * are + abi * aim) / den, ci = (abi * are - (abr - 1.f) * aim) / den;
    float Bre[16], Bim[16];
#pragma unroll
    for (int q = 0; q < 4; ++q) { const f32x4 br = *(const f32x4*)(a.in[20] + gp * 16 + 4 * q), bi = *(const f32x4*)(a.in[21] + gp * 16 + 4 * q);
#pragma unroll
        for (int e = 0; e < 4; ++e) { Bre[4 * q + e] = cr * br[e] - ci * bi[e]; Bim[4 * q + e] = cr * bi[e] + ci * br[e]; } }
    bf16x8_t Cf[4];
    { const size_t cb = (((size_t)l * 64 + g) * 16 + c) * 64;
#pragma unroll
      for (int m = 0; m < 4; ++m) { const int k0 = 32 * m + 8 * tl; const float* src = (k0 < 64 ? a.in[22] + cb + k0 : a.in[23] + cb + (k0 - 64)); const float sg = k0 < 64 ? 1.f : -1.f;
          const f32x4 x0 = *(const f32x4*)src, x1 = *(const f32x4*)(src + 4);
          u32x4 pk; pk.x = pk2(sg * x0.x, sg * x0.y); pk.y = pk2(sg * x0.z, sg * x0.w); pk.z = pk2(sg * x1.x, sg * x1.y); pk.w = pk2(sg * x1.z, sg * x1.w);
          Cf[m] = __builtin_bit_cast(bf16x8_t, pk); } }
    const float dsk = a.in[24][l * 1024 + g * 16 + c];
    const int tw = 256 * w;
    const bf16* up = PROJ + ((size_t)b * SEQ + tw) * NINP + C_SU + g * 16;
    float sr = 0.f, si = 0.f;
    {
        bf16 ucur = up[(size_t)tl * NINP + c], unxt = up[(size_t)(4 + tl) * NINP + c];
        for (int t = 0; t < 256; t += 4) {
            uall[F.lane] = bf1(ucur);
            WFENCE();
            const int tn = (t + 8 < 256) ? t + 8 : t;
            const bf16 unn = up[(size_t)(tn + tl) * NINP + c];
#pragma unroll
            for (int j = 0; j < 4; ++j) {
                float br = 0.f, bi = 0.f;
#pragma unroll
                for (int q = 0; q < 4; ++q) { const f32x4 u4 = *(const LAS f32x4*)(uall + j * 16 + 4 * q);
#pragma unroll
                    for (int e = 0; e < 4; ++e) { br += Bre[4 * q + e] * u4[e]; bi += Bim[4 * q + e] * u4[e]; } }
                const float nr = abr * sr - abi * si + br, ni = abr * si + abi * sr + bi; sr = nr; si = ni;
            }
            WFENCE();
            ucur = unxt; unxt = unn;
        }
    }
    se[w * 128 + p] = sr; se[w * 128 + 64 + p] = si;
    __syncthreads();
    {
        float pr = abr, pi = abi;
#pragma unroll
        for (int i = 0; i < 8; ++i) { const float nr = pr * pr - pi * pi, ni = 2.f * pr * pi; pr = nr; pi = ni; }
        sr = 0.f; si = 0.f;
        for (int j = 0; j < w; ++j) { const float er = se[j * 128 + p], ei = se[j * 128 + 64 + p]; const float nr = pr * sr - pi * si + er, ni = pr * si + pi * sr + ei; sr = nr; si = ni; }
    }
    {
        bf16 ucur = up[(size_t)tl * NINP + c], unxt = up[(size_t)(4 + tl) * NINP + c];
        for (int t = 0; t < 256; t += 16) {
#pragma unroll
            for (int sub = 0; sub < 4; ++sub) {
                uall[sub * 64 + F.lane] = bf1(ucur);
                WFENCE();
                const int tn = (t + 4 * sub + 8 < 256) ? t + 4 * sub + 8 : t + 4 * sub;
                const bf16 unn = up[(size_t)(tn + tl) * NINP + c];
#pragma unroll
                for (int j = 0; j < 4; ++j) {
                    float br = 0.f, bi = 0.f;
#pragma unroll
                    for (int q = 0; q < 4; ++q) { const f32x4 u4 = *(const LAS f32x4*)(uall + sub * 64 + j * 16 + 4 * q);
#pragma unroll
                        for (int e = 0; e < 4; ++e) { br += Bre[4 * q + e] * u4[e]; bi += Bim[4 * q + e] * u4[e]; } }
                    const float nr = abr * sr - abi * si + br, ni = abr * si + abi * sr + bi; sr = nr; si = ni;
                    sbuf[(sub * 4 + j) * S5_SROW + p] = (bf16)f2bf(sr); sbuf[(sub * 4 + j) * S5_SROW + 64 + p] = (bf16)f2bf(si);
                }
                ucur = unxt; unxt = unn;
            }
            WFENCE();
            f32x4 acc = {0.f, 0.f, 0.f, 0.f};
#pragma unroll
            for (int m = 0; m < 4; ++m) { const bf16x8_t af = *(const LAS bf16x8_t*)(sbuf + c * S5_SROW + 32 * m + 8 * tl);
                acc = __builtin_amdgcn_mfma_f32_16x16x32_bf16(af, Cf[m], acc, 0, 0, 0); }
#pragma unroll
            for (int r = 0; r < 4; ++r) { const int st = 4 * tl + r; const float y = acc[r] + dsk * uall[st * 16 + c];
                SY[((size_t)b * SEQ + tw + t + st) * 1024 + g * 16 + c] = (bf16)f2bf(gelu_tanh(y)); }
            WFENCE();
        }
    }
    __syncthreads();
}

__device__ __forceinline__ void scan_phase(const Ctx& F, const Args& a, int l) {
    for (int r5 = 0; r5 < 1 + ((REPM >> 9) & 1); ++r5) for (int vb = F.vcu; vb < 256; vb += F.G) s5_block(F, a, l, vb);
    for (int rg_ = 0; rg_ < 1 + ((REPM >> 10) & 1); ++rg_) for (int vb = F.vcu; vb < 256; vb += F.G) {
        if (vb < 128) { gdn_block(F, vb); if (REPM & 2048) gdn_block(F, vb); }
        else { rwkv_block(F, vb - 128); if (REPM & 4096) rwkv_block(F, vb - 128); }
    }
}

__device__ __forceinline__ void post_phase(const Ctx& F, const Args& a, int l, int gw, int ngw) {
    const bf16* PROJ = (const bf16*)(F.ws + WS_PROJ); bf16* OBR = (bf16*)(F.ws + WS_OBR);
    const float* GO = (const float*)(F.ws + WS_GO); const float* RY = (const float*)(F.ws + WS_RY); const float* RV = (const float*)(F.ws + WS_RV); const float* RBON = (const float*)(F.ws + WS_RBON);
    const int c0 = 16 * F.lane;
    float nw[16], lw[16], lb[16];
#pragma unroll
    for (int e = 0; e < 16; ++e) { nw[e] = a.in[6][l * 128 + (c0 & 127) + e]; lw[e] = a.in[15][l * 1024 + c0 + e]; lb[e] = a.in[16][l * 1024 + c0 + e]; }
    for (int tok = gw; tok < TOK; tok += ngw) {
        { float o[16];
#pragma unroll
          for (int q = 0; q < 4; ++q) { const f32x4 v = *(const f32x4*)(GO + (size_t)tok * 1024 + c0 + 4 * q); o[4 * q] = v.x; o[4 * q + 1] = v.y; o[4 * q + 2] = v.z; o[4 * q + 3] = v.w; }
          float ss = 0.f;
#pragma unroll
          for (int e = 0; e < 16; ++e) ss += o[e] * o[e];
          ss = allred8(ss);
          const float rs = 1.f / sqrtf(ss * (1.f / 128.f) + 1e-6f);
          float z[16]; { float z0[8], z1[8]; unpack8(*(const u32x4*)(PROJ + (size_t)tok * NINP + C_GZ + c0), z0); unpack8(*(const u32x4*)(PROJ + (size_t)tok * NINP + C_GZ + c0 + 8), z1);
#pragma unroll
              for (int e = 0; e < 8; ++e) { z[e] = z0[e]; z[8 + e] = z1[e]; } }
          float r0[8], r1[8];
#pragma unroll
          for (int e = 0; e < 8; ++e) { r0[e] = o[e] * rs * nw[e] * siluf_(z[e]); r1[e] = o[8 + e] * rs * nw[8 + e] * siluf_(z[8 + e]); }
          *(u32x4*)(OBR + (size_t)tok * 1024 + c0) = pack8(r0); *(u32x4*)(OBR + (size_t)tok * 1024 + c0 + 8) = pack8(r1); }
        { float y[16], v[16];
#pragma unroll
          for (int q = 0; q < 4; ++q) { const f32x4 t = *(const f32x4*)(RY + (size_t)tok * 1024 + c0 + 4 * q); y[4 * q] = t.x; y[4 * q + 1] = t.y; y[4 * q + 2] = t.z; y[4 * q + 3] = t.w;
              const f32x4 w = *(const f32x4*)(RV + (size_t)tok * 1024 + c0 + 4 * q); v[4 * q] = w.x; v[4 * q + 1] = w.y; v[4 * q + 2] = w.z; v[4 * q + 3] = w.w; }
          float s = 0.f;
#pragma unroll
          for (int e = 0; e < 16; ++e) s += y[e];
          s += dppf<0xB1>(s); s += dppf<0x4E>(s);
          const float mean = s * (1.f / 64.f); float q2 = 0.f;
#pragma unroll
          for (int e = 0; e < 16; ++e) { const float d = y[e] - mean; q2 += d * d; }
          q2 += dppf<0xB1>(q2); q2 += dppf<0x4E>(q2);
          const float rs = 1.f / sqrtf(q2 * (1.f / 64.f) + 64e-5f);
          const float bon = RBON[(size_t)tok * 16 + (c0 >> 6)];
          float z[16]; { float z0[8], z1[8]; unpack8(*(const u32x4*)(PROJ + (size_t)tok * NINP + C_RZ + c0), z0); unpack8(*(const u32x4*)(PROJ + (size_t)tok * NINP + C_RZ + c0 + 8), z1);
#pragma unroll
              for (int e = 0; e < 8; ++e) { z[e] = z0[e]; z[8 + e] = z1[e]; } }
          float r0[8], r1[8];
#pragma unroll
          for (int e = 0; e < 8; ++e) { r0[e] = ((y[e] - mean) * rs * lw[e] + lb[e] + bon * v[e]) * siluf_(z[e]); r1[e] = ((y[8 + e] - mean) * rs * lw[8 + e] + lb[8 + e] + bon * v[8 + e]) * siluf_(z[8 + e]); }
          bf16* ob = OBR + (size_t)TOK * 1024 + (size_t)tok * 1024 + c0;
          *(u32x4*)ob = pack8(r0); *(u32x4*)(ob + 8) = pack8(r1); }
    }
}

#ifndef PHM
#define PHM 0xFFFF
#endif
#ifndef REPM
#define REPM 0
#endif
__global__ void __launch_bounds__(NTHREADS, 2) hybrid_fwd(Args a) {
    extern __shared__ __attribute__((aligned(16))) unsigned char lds_raw[];
    Ctx F;
    F.lds = (LAS unsigned char*)lds_raw; F.ws = a.ws;
    F.G = gridDim.x; { const int bx = blockIdx.x; F.vcu = (F.G % 8 == 0) ? (bx % 8) * (F.G / 8) + bx / 8 : bx; }
    F.NGW = F.G * NWAVES;
    cg::grid_group grid = cg::this_grid();
    if (threadIdx.x < 8) ((volatile LAS unsigned*)(F.lds + MISC_OFF))[threadIdx.x] = 0u;
    __syncthreads();
    grid.sync();
    XcdBarrier bar = xcd_barrier_post((unsigned*)(a.ws + WS_CTL), (volatile LAS unsigned*)(F.lds + MISC_OFF));
    bf16* XN = (bf16*)(a.ws + WS_XN); bf16* PROJ = (bf16*)(a.ws + WS_PROJ);
    int rep = 0;
    for (int ph = a.ph_lo; ph < a.ph_hi; ) {
        { int t_ = threadIdx.x; asm volatile("" : "+v"(t_)); F.tid = t_; F.lane = t_ & 63; F.wave = __builtin_amdgcn_readfirstlane(t_ >> 6); F.gw = F.vcu * NWAVES + F.wave; }
        if (ph == NPHASES - 1) { for (int m = F.gw; m < TOK; m += F.NGW) rms_row(a.out + (size_t)m * DM, a.in[30], nullptr, nullptr, a.out + (size_t)m * DM, F.lane); }
        else if (ph == 0) { if (PHM & 1) phase0(F, a);
            if (REPM & 128) { if (!rep) { rep = 1; __syncthreads(); continue; } rep = 0; } }
        else {
            const int l = (ph - 1) / PH_PER_LAYER, k = (ph - 1) % PH_PER_LAYER;
            if (k == 0 && (PHM & 2)) {
                pg8::Gemm g{XN, (const bf16*)(a.ws + WS_WIN) + (size_t)l * NINP * DM, TOK, NINP, DM}; pg8::StaticOrder S; S.init(TOK, NINP, F.G, (int)blockIdx.x);
                pg8::EpiBf16Rs E{PROJ, NINP, (const unsigned long long*)(a.ws + WS_CTL + CTL_SS) + (size_t)l * TOK};
                pg8::gemm_phase<pg8::EpiBf16Rs, pg8::StaticOrder, true, true>(F.lds, g, S, E);
            } else if (k == 1) { prep_gdn(F, a, l); if (REPM & 8192) prep_gdn(F, a, l); prep_rwkv(F, a, l); if (REPM & 16384) prep_rwkv(F, a, l); }
            else if (k == 2) { if (PHM & 16) scan_phase(F, a, l); }
            else if (k == 3 && (PHM & 32)) {
                const bool split = F.G >= 192;
                if (!split) { post_phase(F, a, l, F.gw, F.NGW); __syncthreads(); }
                if (!split || (int)blockIdx.x < 128) {
                    pg8::Gemm g{(const bf16*)(a.ws + WS_SY), (const bf16*)(a.ws + WS_WGLU) + (size_t)l * 1024 * 1024, TOK, 1024, 1024}; pg8::StaticOrder S; S.init(TOK, 1024, F.G, (int)blockIdx.x);
                    pg8::EpiGlu E{(const bf16*)(a.ws + WS_SY), PROJ, a.in[26] + l * 1024, (bf16*)(a.ws + WS_OBR) + (size_t)2 * TOK * 1024};
                    pg8::gemm_phase<pg8::EpiGlu, pg8::StaticOrder, true, true>(F.lds, g, S, E);
                } else post_phase(F, a, l, ((int)blockIdx.x - 128) * NWAVES + F.wave, (F.G - 128) * NWAVES);
            } else if (k == 4 && (PHM & 64)) {
                pg8::Gemm g{(const bf16*)(a.ws + WS_OBR), (const bf16*)(a.ws + WS_WBR) + (size_t)l * 3 * DM * 1024, 3 * TOK, 3 * DM, 1024};
                pg8::BranchOrder S; S.base.init(TOK, DM, F.G, (int)blockIdx.x);
                pg8::EpiBranch E{PROJ, a.in[27] + (size_t)l * 3 * DM, (float*)(a.ws + WS_ACCF), (bf16*)(a.ws + WS_MRG)};
                pg8::gemm_phase<pg8::EpiBranch, pg8::BranchOrder, true, true>(F.lds, g, S, E);
            } else if (k == 5 && (PHM & 128)) {
                pg8::Gemm g{(const bf16*)(a.ws + WS_MRG), (const bf16*)(a.ws + WS_WOUT) + (size_t)l * DM * DM, TOK, DM, DM}; pg8::StaticOrder S; S.init(TOK, DM, F.G, (int)blockIdx.x);
                pg8::EpiResid E{l == 0 ? a.in[0] : a.out, a.out, l + 1 < DEPTH ? XN : nullptr, a.in[1] + (size_t)(l + 1 < DEPTH ? l + 1 : 0) * DM, (unsigned long long*)(a.ws + WS_CTL + CTL_SS) + (size_t)(l + 1 < DEPTH ? l + 1 : 0) * TOK};
                pg8::gemm_phase<pg8::EpiResid, pg8::StaticOrder, true, true>(F.lds, g, S, E);
            }
            if (REPM && !rep && ((REPM >> k) & 1)) { rep = 1; __syncthreads(); continue; }
            rep = 0;
        }
        if (ph + 1 < a.ph_hi) {
            xcd_barrier(bar);
            if (REPM & 256) xcd_barrier(bar);
        }
        ++ph;
    }
}

#ifndef MK_MULTI
#define MK_MULTI 0
#endif
extern "C" void kernel_launch(void* const* d_in, const int* in_sizes, int n_in, void* d_out, int out_size, void* d_ws, size_t ws_size, hipStream_t stream) {
    static int grid = 0;
    if (grid == 0) {
        if (n_in != 31 || out_size != TOK * DM || ws_size < WS_END) { fprintf(stderr, "kernel_launch: unexpected shapes (n_in %d out %d ws %zu)\n", n_in, out_size, ws_size); grid = -1; return; }
        int dev = 0, cus = 0, per_cu = 0;
        hipGetDevice(&dev); hipDeviceGetAttribute(&cus, hipDeviceAttributeMultiprocessorCount, dev);
        if (hipFuncSetAttribute((const void*)hybrid_fwd, hipFuncAttributeMaxDynamicSharedMemorySize, LDS_BYTES) != hipSuccess) { fprintf(stderr, "kernel_launch: hipFuncSetAttribute failed\n"); grid = -1; return; }
        if (hipOccupancyMaxActiveBlocksPerMultiprocessor(&per_cu, (const void*)hybrid_fwd, NTHREADS, LDS_BYTES) != hipSuccess || per_cu < 1) per_cu = 1;
        (void)hipGetLastError();
        grid = cus * per_cu;
        fprintf(stderr, "kernel_launch: grid %d (cus %d x %d)\n", grid, cus, per_cu);
    }
    if (grid < 0) return;
    if (hipMemsetAsync((char*)d_ws + WS_CTL, 0, CTL_ZERO_BYTES, stream) != hipSuccess) { fprintf(stderr, "kernel_launch: memset failed\n"); return; }
    Args a{};
    for (int i = 0; i < 31; ++i) a.in[i] = (const float*)d_in[i];
    a.out = (float*)d_out; a.ws = (unsigned char*)d_ws;
#if MK_MULTI
    for (int ph = 0; ph < NPHASES; ++ph) { a.ph_lo = ph; a.ph_hi = ph + 1; hipLaunchKernelGGL(hybrid_fwd, dim3(grid), dim3(NTHREADS), LDS_BYTES, stream, a); }
#else
    a.ph_lo = 0; a.ph_hi = NPHASES;
    void* args[] = {&a};
    const hipError_t e = hipLaunchCooperativeKernel((const void*)hybrid_fwd, dim3(grid), dim3(NTHREADS), args, LDS_BYTES, stream);
    if (e != hipSuccess) fprintf(stderr, "kernel_launch: cooperative launch failed: %s (grid %d)\n", hipGetErrorString(e), grid);
#endif
}
```

```cpp
#include <hip/hip_runtime.h>
#include <hip/hip_cooperative_groups.h>
#include <cstdio>
#include <cstdint>
namespace cg = cooperative_groups;
namespace pg8 {
#define PG8_LAS __attribute__((address_space(3)))
typedef unsigned short bf16_t;
typedef short bf16x8 __attribute__((ext_vector_type(8)));
typedef float f32x4 __attribute__((ext_vector_type(4)));
typedef unsigned u32x4 __attribute__((ext_vector_type(4)));
constexpr int BM = 256, BK = 64, HALF = 128, HTB = HALF * BK * 2  , STAGE_BYTES = 8 * HTB, NXCD = 8, WGM = 8;

__host__ __device__ __forceinline__ int lds_byte(int r, int c) { const int st = (r >> 4) * 2 + (c >> 5), rr = r & 15, cc = c & 31, ob = rr * 64 + cc * 2; return st * 1024 + (ob ^ (((ob >> 9) & 1) << 5)); }
__host__ __device__ __forceinline__ void stage_rc(int b, int& R, int& C) { const int st = b / 1024, sb = b % 1024, swz = sb ^ (((sb >> 9) & 1) << 5); R = (st >> 1) * 16 + swz / 64; C = (st & 1) * 32 + (swz % 64) / 2; }
__host__ __device__ __forceinline__ int perm32(int rho) { const int n = rho >> 4, i = rho & 15; return 8 * (i >> 2) + 4 * n + (i & 3); }

struct Unit { int pm, pn; };
struct Gemm { const bf16_t* A; const bf16_t* Bt; int M, N, K; };

struct StaticOrder {
    int nM, nN, nwg, G, c;
    __host__ __device__ void init(int M, int N, int G_, int c_) { nM = M / BM; nN = N / BM; nwg = nM * nN; G = G_; c = c_; }
    __host__ __device__ bool next(int i, Unit& u) const {
        const long L = (long)i * G + c; if (L >= nwg) return false;
        int wgid = (int)L; { const int q = nwg / NXCD, r = nwg % NXCD, xcd = wgid % NXCD, off = wgid / NXCD; wgid = (xcd < r ? xcd * (q + 1) : r * (q + 1) + (xcd - r) * q) + off; }
        const int nig = WGM * nN, gid = wgid / nig, fm = gid * WGM, gsz = (nM - fm) < WGM ? (nM - fm) : WGM;
        u.pm = fm + ((wgid % nig) % gsz); u.pn = (wgid % nig) / gsz; return true;
    }
    __device__ __forceinline__ void a_ready(const Unit&) const {}
    __device__ __forceinline__ void done(const Unit&) const {}
};

__device__ __forceinline__ unsigned cvt_pk_bf16(float lo, float hi) { unsigned r; asm volatile("v_cvt_pk_bf16_f32 %0, %1, %2" : "=v"(r) : "v"(lo), "v"(hi)); return r; }
typedef float f32x2 __attribute__((ext_vector_type(2)));
__device__ __forceinline__ f32x2 gelu_pk(f32x2 v) {
    const f32x2 av = __builtin_elementwise_abs(v), d = av * 0.2316418882f + 1.0f;
    f32x2 t; t.x = __builtin_amdgcn_rcpf(d.x); t.y = __builtin_amdgcn_rcpf(d.y);
    f32x2 q = t * 0.5307027145f + (-0.7265760135f); q = q * t + 0.7107068705f; q = q * t + (-0.142248368f); q = q * t + 0.127414796f; q = q * t;
    const f32x2 s = (v * v) * (-0.72134752044f);
    f32x2 e; e.x = __builtin_amdgcn_exp2f(s.x); e.y = __builtin_amdgcn_exp2f(s.y);
    const f32x2 m = v * (q * e), r = v - m;
    f32x2 o; o.x = v.x < 0.f ? m.x : r.x; o.y = v.y < 0.f ? m.y : r.y; return o;
}

template <int ACT  > struct EpiBf16 {
    static constexpr bool PERM = true, AFTER_DRAIN = false; static_assert(ACT == 0 || ACT == 1, "EpiBf16: ACT is 0 (none) or 1 (gelu_pk)");
    bf16_t* O; int ldc; const float* bias; int split_cols; size_t split_stride; float scale0;
    __device__ __forceinline__ void operator()(const f32x4 (&acc)[2][2][4][2], const Unit& u, int wr, int wc, int fr, int fq) const {
        const int row0 = u.pm * BM + wr * 64 + fr; int colt = u.pn * BM; bf16_t* base = O;
        float sc = 1.f; if (split_cols) { const int t = colt / split_cols; base += (size_t)t * split_stride; colt -= t * split_cols; if (t == 0) sc = scale0; }
        const int col0 = colt + wc * 32 + 8 * fq, bcol0 = u.pn * BM + wc * 32 + 8 * fq;
        f32x4 bv[2][2];
#pragma unroll
        for (int bj = 0; bj < 2; ++bj)
#pragma unroll
            for (int n = 0; n < 2; ++n) bv[bj][n] = bias ? *(const f32x4*)(bias + bcol0 + bj * HALF + 4 * n) : (f32x4){0.f, 0.f, 0.f, 0.f};
#pragma unroll
        for (int ai = 0; ai < 2; ++ai)
#pragma unroll
            for (int m = 0; m < 4; ++m) { bf16_t* rowp = base + (size_t)(row0 + ai * HALF + m * 16) * ldc + col0;
#pragma unroll
                for (int bj = 0; bj < 2; ++bj) { f32x4 v0 = acc[ai][bj][m][0] + bv[bj][0], v1 = acc[ai][bj][m][1] + bv[bj][1];
                    if (ACT == 1) { f32x2 a = gelu_pk((f32x2){v0[0], v0[1]}), b = gelu_pk((f32x2){v0[2], v0[3]}), c = gelu_pk((f32x2){v1[0], v1[1]}), d = gelu_pk((f32x2){v1[2], v1[3]});
                        v0 = (f32x4){a.x, a.y, b.x, b.y}; v1 = (f32x4){c.x, c.y, d.x, d.y}; }
                    v0 = v0 * sc; v1 = v1 * sc; u32x4 w; w.x = cvt_pk_bf16(v0[0], v0[1]); w.y = cvt_pk_bf16(v0[2], v0[3]); w.z = cvt_pk_bf16(v1[0], v1[1]); w.w = cvt_pk_bf16(v1[2], v1[3]);
                    *(u32x4*)(rowp + bj * HALF) = w; } }
    }
};

template <class Epi, class Sched, bool ALIGN_EPI = false, bool SP2 = false>
__device__ __forceinline__ void gemm_phase(PG8_LAS unsigned char* lds, const Gemm g, const Sched& S, const Epi& E) {
    int tid_ = threadIdx.x; asm volatile("" : "+v"(tid_));
    const int tid = tid_, wid = __builtin_amdgcn_readfirstlane(tid >> 6), lane = tid & 63, wr = wid >> 2, wc = wid & 3, fr = lane & 15, fq = lane >> 4;
    const int K = g.K, nt = K / BK;
    unsigned voffA[2], voffB[2];
#pragma unroll
    for (int i = 0; i < 2; ++i) { int R, C; stage_rc(tid * 16 + i * 8192, R, C); const int Rb = Epi::PERM ? ((R & ~31) + perm32(R & 31)) : R;
        voffA[i] = (unsigned)(R * K + C) * 2u; voffB[i] = (unsigned)(Rb * K + C) * 2u; }
    const size_t kstep = (size_t)(BK * 2);
    const size_t hstep = (size_t)HALF * K * 2;
    const size_t tstep = 2 * hstep;
    const unsigned ldsw = (unsigned)wid * 1024u;
    const int aoff = lds_byte(wr * 64 + fr, fq * 8), boff = lds_byte(wc * 32 + fr, fq * 8);
#define PG8_SA(b, h) (((b) * 2 + (h)) * HTB)
#define PG8_SB(b, h) ((4 + (b) * 2 + (h)) * HTB)
#define PG8_STAGE(bufoff, gbase, voff) do { _Pragma("unroll") for (int _i = 0; _i < 2; ++_i) \
        __builtin_amdgcn_global_load_lds((const unsigned*)((const char*)(gbase) + (voff)[_i]), (PG8_LAS unsigned*)(lds + (bufoff) + ldsw + _i * 8192), 16, 0, 0); } while (0)
#define PG8_LDA(dst, b, h) do { _Pragma("unroll") for (int m = 0; m < 4; ++m) _Pragma("unroll") for (int k = 0; k < 2; ++k) dst[m][k] = *(const PG8_LAS bf16x8*)(lds + PG8_SA(b, h) + aoff + m * 2048 + k * 1024); } while (0)
#define PG8_LDB(dst, b, h) do { _Pragma("unroll") for (int n = 0; n < 2; ++n) _Pragma("unroll") for (int k = 0; k < 2; ++k) dst[n][k] = *(const PG8_LAS bf16x8*)(lds + PG8_SB(b, h) + boff + n * 2048 + k * 1024); } while (0)
#define PG8_MMA(ai, bj, At, Bt) do { __builtin_amdgcn_s_setprio(1); _Pragma("unroll") for (int m = 0; m < 4; ++m) _Pragma("unroll") for (int n = 0; n < 2; ++n) _Pragma("unroll") for (int k = 0; k < 2; ++k) \
        acc[ai][bj][m][n] = __builtin_amdgcn_mfma_f32_16x16x32_bf16(Bt[n][k], At[m][k], acc[ai][bj][m][n], 0, 0, 0); __builtin_amdgcn_s_setprio(0); } while (0)
#define PG8_WAIT_V(n) asm volatile("s_waitcnt vmcnt(" #n ")" ::: "memory")
#define PG8_WAIT_L(n) asm volatile("s_waitcnt lgkmcnt(" #n ")" ::: "memory")
#define PG8_BAR __builtin_amdgcn_s_barrier()
#define PG8_SCHED __builtin_amdgcn_sched_barrier(0)
    Unit cur, nxt; int ui = 0;
    if (!S.next(0, cur)) return;
    f32x4 acc[2][2][4][2];
#pragma unroll
    for (int a = 0; a < 2; ++a)
#pragma unroll
        for (int b = 0; b < 2; ++b)
#pragma unroll
            for (int m = 0; m < 4; ++m)
#pragma unroll
                for (int n = 0; n < 2; ++n) acc[a][b][m][n] = (f32x4){0.f, 0.f, 0.f, 0.f};
    bf16x8 At[4][2], B0[2][2], B1[2][2];
    const char* cA = (const char*)g.A + (size_t)cur.pm * tstep; const char* cB = (const char*)g.Bt + (size_t)cur.pn * tstep;
    S.a_ready(cur);
    if constexpr (SP2) {
        PG8_STAGE(PG8_SB(0, 0), cB, voffB); PG8_STAGE(PG8_SB(0, 1), cB + hstep, voffB); PG8_STAGE(PG8_SA(0, 0), cA, voffA); PG8_STAGE(PG8_SA(0, 1), cA + hstep, voffA);
        if (wr == 1) PG8_BAR;
        PG8_WAIT_V(2); PG8_BAR;
        PG8_STAGE(PG8_SB(1, 0), cB + kstep, voffB); PG8_STAGE(PG8_SA(1, 0), cA + kstep, voffA); PG8_STAGE(PG8_SB(1, 1), cB + hstep + kstep, voffB);
        PG8_WAIT_V(6); PG8_BAR;
    } else {
        PG8_STAGE(PG8_SB(0, 0), cB, voffB); PG8_STAGE(PG8_SA(0, 0), cA, voffA); PG8_STAGE(PG8_SB(0, 1), cB + hstep, voffB); PG8_STAGE(PG8_SA(0, 1), cA + hstep, voffA);
        if (wr == 1) PG8_BAR;
        PG8_WAIT_V(4); PG8_BAR;
        PG8_STAGE(PG8_SB(1, 0), cB + kstep, voffB); PG8_STAGE(PG8_SA(1, 0), cA + kstep, voffA); PG8_STAGE(PG8_SB(1, 1), cB + hstep + kstep, voffB);
        PG8_WAIT_V(6); PG8_BAR;
    }
    for (;;) {
        const bool has_next = S.next(ui + 1, nxt);
        const char* nA = has_next ? (const char*)g.A + (size_t)nxt.pm * tstep : cA; const char* nB = has_next ? (const char*)g.Bt + (size_t)nxt.pn * tstep : cB;
        for (int t = 0; t < nt; t += 2) {
            const bool last = (t == nt - 2);
            const char* a1 = cA + (size_t)(t + 1) * kstep;
            const char* a2 = last ? nA : cA + (size_t)(t + 2) * kstep; const char* b2 = last ? nB : cB + (size_t)(t + 2) * kstep;
            const char* a3 = a2 + kstep; const char* b3 = b2 + kstep;
            if (last && has_next) S.a_ready(nxt);
            if constexpr (SP2) {
            PG8_LDB(B0, 0, 0); PG8_LDB(B1, 0, 1); PG8_SCHED; PG8_LDA(At, 0, 0); PG8_STAGE(PG8_SA(1, 1), a1 + hstep, voffA);
            PG8_WAIT_V(8); PG8_WAIT_L(0); PG8_BAR; PG8_MMA(0, 0, At, B0); PG8_MMA(0, 1, At, B1); PG8_BAR; PG8_SCHED;
            PG8_LDA(At, 0, 1); PG8_STAGE(PG8_SB(0, 0), b2, voffB); PG8_STAGE(PG8_SB(0, 1), b2 + hstep, voffB); PG8_STAGE(PG8_SA(0, 0), a2, voffA);
            PG8_WAIT_V(8); PG8_WAIT_L(0); PG8_BAR; PG8_MMA(1, 0, At, B0); PG8_MMA(1, 1, At, B1); PG8_BAR; PG8_SCHED;
            PG8_LDB(B0, 1, 0); PG8_LDB(B1, 1, 1); PG8_SCHED; PG8_LDA(At, 1, 0); PG8_STAGE(PG8_SA(0, 1), a2 + hstep, voffA);
            PG8_WAIT_V(8); PG8_WAIT_L(0); PG8_BAR; PG8_MMA(0, 0, At, B0); PG8_MMA(0, 1, At, B1); PG8_BAR; PG8_SCHED;
            PG8_LDA(At, 1, 1); PG8_STAGE(PG8_SB(1, 0), b3, voffB); PG8_STAGE(PG8_SB(1, 1), b3 + hstep, voffB); PG8_STAGE(PG8_SA(1, 0), a3, voffA);
            PG8_WAIT_V(8); PG8_WAIT_L(0); PG8_BAR; PG8_MMA(1, 0, At, B0); PG8_MMA(1, 1, At, B1); PG8_BAR; PG8_SCHED;
            } else {
            PG8_LDB(B0, 0, 0); PG8_SCHED; PG8_LDA(At, 0, 0); PG8_STAGE(PG8_SA(1, 1), a1 + hstep, voffA);
            PG8_WAIT_L(8); PG8_BAR; PG8_WAIT_L(0); PG8_MMA(0, 0, At, B0); PG8_BAR; PG8_SCHED;
            PG8_LDB(B1, 0, 1); PG8_STAGE(PG8_SB(0, 0), b2, voffB);
            PG8_BAR; PG8_WAIT_L(0); PG8_MMA(0, 1, At, B1); PG8_BAR;
            PG8_LDA(At, 0, 1); PG8_STAGE(PG8_SA(0, 0), a2, voffA);
            PG8_BAR; PG8_WAIT_L(0); PG8_MMA(1, 0, At, B0); PG8_BAR; PG8_SCHED;
            PG8_STAGE(PG8_SB(0, 1), b2 + hstep, voffB);
            PG8_WAIT_V(6); PG8_BAR; PG8_MMA(1, 1, At, B1); PG8_BAR;
            PG8_LDB(B0, 1, 0); PG8_SCHED; PG8_LDA(At, 1, 0); PG8_STAGE(PG8_SA(0, 1), a2 + hstep, voffA);
            PG8_WAIT_L(8); PG8_BAR; PG8_WAIT_L(0); PG8_MMA(0, 0, At, B0); PG8_BAR; PG8_SCHED;
            PG8_LDB(B1, 1, 1); PG8_STAGE(PG8_SB(1, 0), b3, voffB);
            PG8_BAR; PG8_WAIT_L(0); PG8_MMA(0, 1, At, B1); PG8_BAR;
            PG8_LDA(At, 1, 1); PG8_STAGE(PG8_SA(1, 0), a3, voffA);
            PG8_BAR; PG8_WAIT_L(0); PG8_MMA(1, 0, At, B0); PG8_BAR; PG8_SCHED;
            PG8_STAGE(PG8_SB(1, 1), b3 + hstep, voffB);
            PG8_WAIT_V(6); PG8_BAR; PG8_MMA(1, 1, At, B1); PG8_BAR;
            }
        }
        if constexpr (ALIGN_EPI) { if (wr == 0) PG8_BAR; }
        if constexpr (!Epi::AFTER_DRAIN) { E(acc, cur, wr, wc, fr, fq); S.done(cur); }
        if (!has_next) break;
#pragma unroll
        for (int a = 0; a < 2; ++a)
#pragma unroll
            for (int b = 0; b < 2; ++b)
#pragma unroll
                for (int m = 0; m < 4; ++m)
#pragma unroll
                    for (int n = 0; n < 2; ++n) acc[a][b][m][n] = (f32x4){0.f, 0.f, 0.f, 0.f};
        cur = nxt; cA = nA; cB = nB; ++ui;
        if constexpr (ALIGN_EPI) { if (wr == 1) PG8_BAR; }
    }
    PG8_WAIT_V(0);
    if constexpr (!ALIGN_EPI) { if (wr == 0) PG8_BAR; }
    PG8_BAR;
    if constexpr (Epi::AFTER_DRAIN) { E.fused(acc, cur, wr, wc, fr, fq, lds, wid, lane); S.done(cur); }
#undef PG8_SA
#undef PG8_SB
#undef PG8_STAGE
#undef PG8_LDA
#undef PG8_LDB
#undef PG8_MMA
#undef PG8_WAIT_V
#undef PG8_WAIT_L
#undef PG8_BAR
#undef PG8_SCHED
}
}

#define GAS __attribute__((address_space(1)))
#define LAS __attribute__((address_space(3)))
typedef unsigned short bf16;
typedef unsigned u32x4 __attribute__((ext_vector_type(4)));
typedef unsigned u32x2 __attribute__((ext_vector_type(2)));
typedef float f32x4 __attribute__((ext_vector_type(4)));
typedef float f32x2 __attribute__((ext_vector_type(2)));

constexpr int NBATCH = 4, SEQ = 2048, TOK = NBATCH * SEQ, DM = 2048, DEPTH = 4;
constexpr int NIN = 16592, NINP = 16640;
constexpr int C_GQKV = 0, C_GZ = 3072, C_GB = 4096, C_GA = 4104, C_RF = 4112, C_RZ = 7376, C_SU = 8400, C_SZ = 9424, C_GATE = 10448;
constexpr int NWAVES = 8, NTHREADS = 512;
constexpr int LDS_BYTES = 147456;
constexpr int PH_PER_LAYER = 6, NPHASES = 2 + DEPTH * PH_PER_LAYER;

constexpr size_t MiB = 1u << 20;
constexpr size_t WS_WIN = 0, WS_WGLU = 260 * MiB, WS_WBR = 268 * MiB, WS_WOUT = 316 * MiB, WS_XN = 348 * MiB, WS_PROJ = 380 * MiB;
constexpr size_t WS_GQ = 640 * MiB, WS_GK = 672 * MiB, WS_GV = 704 * MiB, WS_GEG = 736 * MiB, WS_GBE = 737 * MiB, WS_GO = 738 * MiB;
constexpr size_t WS_RR = 770 * MiB, WS_RW = 802 * MiB, WS_RK = 834 * MiB, WS_RV = 866 * MiB, WS_RKK = 898 * MiB, WS_RKA = 930 * MiB, WS_RBON = 962 * MiB, WS_RY = 963 * MiB;
constexpr size_t WS_SY = 995 * MiB, WS_OBR = 1011 * MiB, WS_ACCF = 1059 * MiB, WS_MRG = 1123 * MiB, WS_CTL = 1155 * MiB, WS_END = 1156 * MiB;
constexpr size_t CTL_SS = 65536, CTL_ZERO_BYTES = CTL_SS + (size_t)DEPTH * TOK * 8;
constexpr int MISC_OFF = 147392;
static_assert((size_t)DEPTH * NINP * DM * 2 == 260 * MiB && (size_t)TOK * NINP * 2 == 260 * MiB, "ws map");

__device__ __forceinline__ unsigned f2bf(float f) { unsigned u = __builtin_bit_cast(unsigned, f); return (u + 0x7fffu + ((u >> 16) & 1u)) >> 16; }
__device__ __forceinline__ unsigned pk2(float lo, float hi) { return f2bf(lo) | (f2bf(hi) << 16); }
__device__ __forceinline__ float bflo(unsigned w) { return __builtin_bit_cast(float, w << 16); }
__device__ __forceinline__ float bfhi(unsigned w) { return __builtin_bit_cast(float, w & 0xffff0000u); }
__device__ __forceinline__ float bf1(bf16 h) { return __builtin_bit_cast(float, (unsigned)h << 16); }
__device__ __forceinline__ float sigmoidf_(float x) { return 1.f / (1.f + __expf(-x)); }
__device__ __forceinline__ float siluf_(float x) { return x / (1.f + __expf(-x)); }
__device__ __forceinline__ float softplusf_(float x) { return x > 20.f ? x : log1pf(expf(x)); }
__device__ __forceinline__ float gelu_tanh(float y) { const float t = 0.7978845608028654f * (y + 0.044715f * y * y * y); const float th = 1.f - 2.f / (1.f + __expf(2.f * t)); return 0.5f * y * (1.f + th); }
template <int CTRL> __device__ __forceinline__ float dppf(float v) { return __builtin_bit_cast(float, __builtin_amdgcn_update_dpp(0, __builtin_bit_cast(int, v), CTRL, 0xF, 0xF, true)); }
__device__ __forceinline__ float allred8(float v) { v += dppf<0xB1>(v); v += dppf<0x4E>(v); v += dppf<0x141>(v); return v; }
__device__ __forceinline__ float allred16(float v) { v = allred8(v); v += dppf<0x140>(v); return v; }
__device__ __forceinline__ float wave_sum(float v) {
#pragma unroll
    for (int o = 1; o < 64; o <<= 1) v += __shfl_xor(v, o);
    return v;
}
__device__ __forceinline__ void unpack8(const u32x4 w, float (&f)[8]) { f[0] = bflo(w.x); f[1] = bfhi(w.x); f[2] = bflo(w.y); f[3] = bfhi(w.y); f[4] = bflo(w.z); f[5] = bfhi(w.z); f[6] = bflo(w.w); f[7] = bfhi(w.w); }
__device__ __forceinline__ u32x4 pack8(const float (&f)[8]) { u32x4 w; w.x = pk2(f[0], f[1]); w.y = pk2(f[2], f[3]); w.z = pk2(f[4], f[5]); w.w = pk2(f[6], f[7]); return w; }

namespace pg8 {
struct EpiGlu {
    static constexpr bool PERM = true, AFTER_DRAIN = false;
    const bf16* Y1; const bf16* PROJ; const float* bias; bf16* O;
    __device__ __forceinline__ void operator()(const f32x4 (&acc)[2][2][4][2], const Unit& u, int wr, int wc, int fr, int fq) const {
        int row0 = u.pm * BM + wr * 64 + fr, col0 = u.pn * BM + wc * 32 + 8 * fq;
        asm volatile("" : "+v"(row0), "+v"(col0));
#pragma unroll
        for (int bj = 0; bj < 2; ++bj) {
            const int col = col0 + bj * HALF;
            const f32x4 b0 = *(const f32x4*)(bias + col), b1 = *(const f32x4*)(bias + col + 4);
#pragma unroll
            for (int ai = 0; ai < 2; ++ai)
#pragma unroll
                for (int m = 0; m < 4; ++m) {
                    const size_t row = (size_t)(row0 + ai * HALF + m * 16);
                    const u32x4 y8 = *(const u32x4*)(Y1 + row * 1024 + col), z8 = *(const u32x4*)(PROJ + row * NINP + C_SZ + col);
                    float y[8], z[8], o[8]; unpack8(y8, y); unpack8(z8, z);
                    const f32x4 v0 = acc[ai][bj][m][0] + b0, v1 = acc[ai][bj][m][1] + b1;
                    const float a[8] = {v0[0], v0[1], v0[2], v0[3], v1[0], v1[1], v1[2], v1[3]};
#pragma unroll
                    for (int e = 0; e < 8; ++e) o[e] = y[e] * sigmoidf_(a[e]) * siluf_(z[e]);
                    *(u32x4*)(O + row * 1024 + col) = pack8(o);
                    asm volatile("" ::: "memory");
                }
        }
    }
};
struct EpiBranch {
    static constexpr bool PERM = true, AFTER_DRAIN = false;
    const bf16* PROJ; const float* gate_b; bf16* ACC; bf16* MRG;
    __device__ __forceinline__ void operator()(const f32x4 (&acc)[2][2][4][2], const Unit& u, int wr, int wc, int fr, int fq) const {
        const int br = u.pm >> 5, pm = u.pm & 31, pn = u.pn & 7;
        int row0 = pm * BM + wr * 64 + fr, col0 = pn * BM + wc * 32 + 8 * fq;
        asm volatile("" : "+v"(row0), "+v"(col0));
        bf16* dst = br < 2 ? ACC : MRG;
#pragma unroll
        for (int bj = 0; bj < 2; ++bj) {
            const int col = col0 + bj * HALF;
            const f32x4 g0 = *(const f32x4*)(gate_b + br * DM + col), g1 = *(const f32x4*)(gate_b + br * DM + col + 4);
            const float gb[8] = {g0[0], g0[1], g0[2], g0[3], g1[0], g1[1], g1[2], g1[3]};
#pragma unroll
            for (int ai = 0; ai < 2; ++ai)
#pragma unroll
                for (int m = 0; m < 4; ++m) {
                    const size_t row = (size_t)(row0 + ai * HALF + m * 16);
                    const u32x4 l8 = *(const u32x4*)(PROJ + row * NINP + C_GATE + br * DM + col);
                    float gl[8], o[8]; unpack8(l8, gl);
                    const f32x4 v0 = acc[ai][bj][m][0], v1 = acc[ai][bj][m][1];
                    const float a[8] = {v0[0], v0[1], v0[2], v0[3], v1[0], v1[1], v1[2], v1[3]};
#pragma unroll
                    for (int e = 0; e < 8; ++e) o[e] = sigmoidf_(gl[e] + gb[e]) * a[e];
                    if (br > 0) { float p[8]; unpack8(*(const u32x4*)(ACC + row * DM + col), p);
#pragma unroll
                        for (int e = 0; e < 8; ++e) o[e] += p[e]; }
                    *(u32x4*)(dst + row * DM + col) = pack8(o);
                    asm volatile("" ::: "memory");
                }
        }
    }
};
struct EpiResid {
    static constexpr bool PERM = true, AFTER_DRAIN = false;
    const float* base; float* out; bf16* xn; const float* nw; unsigned long long* ss;
    __device__ __forceinline__ void operator()(const f32x4 (&acc)[2][2][4][2], const Unit& u, int wr, int wc, int fr, int fq) const {
        int row0 = u.pm * BM + wr * 64 + fr, col0 = u.pn * BM + wc * 32 + 8 * fq;
        asm volatile("" : "+v"(row0), "+v"(col0));
#pragma unroll
        for (int ai = 0; ai < 2; ++ai)
#pragma unroll
            for (int m = 0; m < 4; ++m) {
                const int row = row0 + ai * HALF + m * 16; float sq = 0.f;
#pragma unroll
                for (int bj = 0; bj < 2; ++bj) {
                    const size_t off = (size_t)row * DM + col0 + bj * HALF;
                    const f32x4 o0 = *(const f32x4*)(base + off) + acc[ai][bj][m][0], o1 = *(const f32x4*)(base + off + 4) + acc[ai][bj][m][1];
                    *(f32x4*)(out + off) = o0; *(f32x4*)(out + off + 4) = o1;
                    if (xn) { const f32x4 w0 = *(const f32x4*)(nw + col0 + bj * HALF), w1 = *(const f32x4*)(nw + col0 + bj * HALF + 4);
                        sq += (o0.x * o0.x + o0.y * o0.y) + (o0.z * o0.z + o0.w * o0.w) + (o1.x * o1.x + o1.y * o1.y) + (o1.z * o1.z + o1.w * o1.w);
                        u32x4 p; p.x = pk2(o0.x * w0.x, o0.y * w0.y); p.y = pk2(o0.z * w0.z, o0.w * w0.w); p.z = pk2(o1.x * w1.x, o1.y * w1.y); p.w = pk2(o1.z * w1.z, o1.w * w1.w);
                        *(u32x4*)(xn + off) = p; }
                }
                if (xn) { sq += __shfl_xor(sq, 16); sq += __shfl_xor(sq, 32); if (fq == 0) atomicAdd(ss + row, (unsigned long long)(sq * 65536.f + 0.5f)); }
                asm volatile("" ::: "memory");
            }
    }
};
struct EpiBf16Rs {
    static constexpr bool PERM = true, AFTER_DRAIN = false;
    bf16* O; int ldc; const unsigned long long* ss;
    __device__ __forceinline__ void operator()(const f32x4 (&acc)[2][2][4][2], const Unit& u, int wr, int wc, int fr, int fq) const {
        int row0 = u.pm * BM + wr * 64 + fr, col0 = u.pn * BM + wc * 32 + 8 * fq;
        asm volatile("" : "+v"(row0), "+v"(col0));
#pragma unroll
        for (int ai = 0; ai < 2; ++ai)
#pragma unroll
            for (int m = 0; m < 4; ++m) { const int row = row0 + ai * HALF + m * 16; const float rs = 1.f / sqrtf((float)ss[row] * (1.f / (65536.f * DM)) + 1e-6f);
                bf16* rowp = O + (size_t)row * ldc + col0;
#pragma unroll
                for (int bj = 0; bj < 2; ++bj) { const f32x4 v0 = acc[ai][bj][m][0] * rs, v1 = acc[ai][bj][m][1] * rs;
                    u32x4 w; w.x = cvt_pk_bf16(v0[0], v0[1]); w.y = cvt_pk_bf16(v0[2], v0[3]); w.z = cvt_pk_bf16(v1[0], v1[1]); w.w = cvt_pk_bf16(v1[2], v1[3]);
                    *(u32x4*)(rowp + bj * HALF) = w; } }
    }
};
struct BranchOrder {
    StaticOrder base;
    __device__ bool next(int i, Unit& u) const { Unit t; const int r = i / 3, br = i - 3 * r; if (!base.next(r, t)) return false; u.pm = br * 32 + t.pm; u.pn = br * 8 + t.pn; return true; }
    __device__ __forceinline__ void a_ready(const Unit&) const {}
    __device__ __forceinline__ void done(const Unit&) const {}
};
}

#define XB_TMO      128
#define XB_XCNT(j)  (256  + 64 * (j))
#define XB_XSUB(j)  (1280 + 64 * (j))
#define XB_XGEN(j)  (2304 + 64 * (j))
#define XB_TOP      3328
#define XB_TOPGEN   3392
#define XCD_BAR_WORDS 3456
#define XB_SPIN_CAP (1u << 18)

__device__ __forceinline__ unsigned xb_ld(unsigned* p)              { return __hip_atomic_load(p, __ATOMIC_RELAXED, __HIP_MEMORY_SCOPE_AGENT); }
__device__ __forceinline__ unsigned xb_add(unsigned* p, unsigned v) { return __hip_atomic_fetch_add(p, v, __ATOMIC_RELAXED, __HIP_MEMORY_SCOPE_AGENT); }
__device__ __forceinline__ unsigned xb_xcc_id() { return (unsigned)__builtin_amdgcn_s_getreg((3 << 11) | 20) & 0xFu; }
#define XB_SPIN(cond, bar) do { unsigned _sp = 0; while (cond) { __builtin_amdgcn_s_sleep(1); \
    if ((++_sp & 255u) == 0u) { if (xb_ld(&(bar)[XB_TMO])) break; if (_sp > XB_SPIN_CAP) { atomicAdd(&(bar)[XB_TMO], 1u); break; } } } } while (0)

struct XcdBarrier {
    unsigned* bar; unsigned x;
    volatile LAS unsigned* st;
};

__device__ __forceinline__ XcdBarrier xcd_barrier_post(unsigned* bar, volatile LAS unsigned* st) {
    XcdBarrier b; b.bar = bar; b.x = xb_xcc_id(); b.st = st;
    if (threadIdx.x == 0) (void)xb_add(&bar[XB_XCNT(b.x)], 1u);
    return b;
}
__device__ __forceinline__ void xcd_barrier_complete(unsigned* bar, unsigned x, unsigned& nloc, unsigned& nx) {
    const unsigned G = gridDim.x * gridDim.y * gridDim.z;
    unsigned sum, cnt, mine, sp = 0u;
    for (;;) {
        sum = 0u; cnt = 0u; mine = 0u;
#pragma unroll
        for (unsigned j = 0; j < 16; ++j) { const unsigned c = xb_ld(&bar[XB_XCNT(j)]); sum += c; cnt += (c > 0u) ? 1u : 0u; mine = (j == x) ? c : mine; }
        if (sum == G) break;
        __builtin_amdgcn_s_sleep(1);
        if ((++sp & 255u) == 0u) { if (xb_ld(&bar[XB_TMO])) break; if (sp > XB_SPIN_CAP) { atomicAdd(&bar[XB_TMO], 1u); break; } }
    }
    nloc = mine > 0u ? mine : 1u; nx = cnt > 0u ? cnt : 1u;
}

__device__ __forceinline__ void xcd_barrier(const XcdBarrier& b) {
    asm volatile("s_waitcnt vmcnt(0)" ::: "memory");
    __syncthreads();
    if (threadIdx.x == 0) {
        unsigned* bar = b.bar;
        __builtin_amdgcn_s_waitcnt(0);
        unsigned nloc = b.st[0], nx = b.st[1];
        if (nloc == 0u) { xcd_barrier_complete(bar, b.x, nloc, nx); b.st[0] = nloc; b.st[1] = nx; }
        const unsigned old = xb_add(&bar[XB_XSUB(b.x)], 1u);
        const unsigned gen = old / nloc;
        if (old + 1u == (gen + 1u) * nloc) {
            __builtin_amdgcn_fence(__ATOMIC_RELEASE, "agent");
            asm volatile("s_waitcnt vmcnt(0)" ::: "memory");
            const unsigned og = xb_add(&bar[XB_TOP], 1u);
            const unsigned tg = og / nx;
            if (og + 1u == (tg + 1u) * nx) xb_add(&bar[XB_TOPGEN], 1u);
            else XB_SPIN(xb_ld(&bar[XB_TOPGEN]) == tg, bar);
            __builtin_amdgcn_fence(__ATOMIC_ACQUIRE, "agent");
            xb_add(&bar[XB_XGEN(b.x)], 1u);
            asm volatile("s_waitcnt vmcnt(0)" ::: "memory");
        } else {
            XB_SPIN(xb_ld(&bar[XB_XGEN(b.x)]) == gen, bar);
            __builtin_amdgcn_fence(__ATOMIC_ACQUIRE, "agent");
            asm volatile("s_waitcnt vmcnt(0)" ::: "memory");
        }
    }
    __syncthreads();
}

struct Args { const float* in[31]; float* out; unsigned char* ws; int ph_lo, ph_hi; };
struct Ctx { int tid, lane, wave, vcu, G, gw, NGW; LAS unsigned char* lds; unsigned char* ws; };

__device__ __forceinline__ void transpose_item(const float* W, int K, int N, bf16* WT, LAS float* scr, int kb, int nb, int lane) {
    const int k0 = 64 * kb, n0 = 64 * nb, nq = 4 * (lane & 15), kr = lane >> 4; const bool nv = n0 + nq < N;
    f32x4 v[16];
#pragma unroll
    for (int i = 0; i < 16; ++i) v[i] = nv ? *(const f32x4*)(W + (size_t)(k0 + 4 * i + kr) * N + n0 + nq) : (f32x4){0.f, 0.f, 0.f, 0.f};
#pragma unroll
    for (int i = 0; i < 16; ++i) { LAS float* d = scr + (4 * i + kr) * 65 + nq; d[0] = v[i].x; d[1] = v[i].y; d[2] = v[i].z; d[3] = v[i].w; }
    asm volatile("s_waitcnt lgkmcnt(0)" ::: "memory");
    const int c = lane & 7;
#pragma unroll
    for (int j = 0; j < 8; ++j) { const int nn = (lane >> 3) + 8 * j; const LAS float* s = scr + (8 * c) * 65 + nn;
        u32x4 o; o.x = pk2(s[0 * 65], s[1 * 65]); o.y = pk2(s[2 * 65], s[3 * 65]); o.z = pk2(s[4 * 65], s[5 * 65]); o.w = pk2(s[6 * 65], s[7 * 65]);
        *(u32x4*)(WT + (size_t)(n0 + nn) * K + k0 + 8 * c) = o; }
    asm volatile("s_waitcnt lgkmcnt(0)" ::: "memory");
}

__device__ __forceinline__ void rms_row(const float* xrow, const float* w, bf16* obf, unsigned long long* ss, float* of32, int lane) {
    f32x4 v[8]; float s = 0.f;
#pragma unroll
    for (int j = 0; j < 8; ++j) { v[j] = *(const f32x4*)(xrow + 4 * lane + 256 * j); s += (v[j].x * v[j].x + v[j].y * v[j].y) + (v[j].z * v[j].z + v[j].w * v[j].w); }
    s = wave_sum(s);
    const float r = obf ? 1.f : 1.f / sqrtf(s * (1.f / DM) + 1e-6f);
#pragma unroll
    for (int j = 0; j < 8; ++j) { const f32x4 ww = *(const f32x4*)(w + 4 * lane + 256 * j); const f32x4 o = v[j] * r * ww;
        if (obf) { u32x2 p; p.x = pk2(o.x, o.y); p.y = pk2(o.z, o.w); *(u32x2*)(obf + 4 * lane + 256 * j) = p; }
        else *(f32x4*)(of32 + 4 * lane + 256 * j) = o; }
    if (obf && lane == 0) *ss = (unsigned long long)(s * 65536.f + 0.5f);
}

__device__ __forceinline__ void phase0(const Ctx& F, const Args& a) {
    LAS float* scr = (LAS float*)(F.lds + F.wave * 16640);
    constexpr int I_IN = 32 * 260, I_GLU = 16 * 16, I_BR = 16 * 32, I_OUT = 32 * 32, IL = I_IN + I_GLU + 3 * I_BR + I_OUT;
    bf16* WIN = (bf16*)(F.ws + WS_WIN); bf16* WGLU = (bf16*)(F.ws + WS_WGLU); bf16* WBR = (bf16*)(F.ws + WS_WBR); bf16* WOUT = (bf16*)(F.ws + WS_WOUT);
    for (int it = F.gw; it < DEPTH * IL; it += F.NGW) {
        const int l = it / IL; int r = it - l * IL;
        if (r < I_IN) { transpose_item(a.in[2] + (size_t)l * DM * NIN, DM, NIN, WIN + (size_t)l * NINP * DM, scr, r / 260, r % 260, F.lane); continue; } r -= I_IN;
        if (r < I_GLU) { transpose_item(a.in[25] + (size_t)l * 1024 * 1024, 1024, 1024, WGLU + (size_t)l * 1024 * 1024, scr, r / 16, r % 16, F.lane); continue; } r -= I_GLU;
        if (r < 3 * I_BR) { const int br = r / I_BR, r2 = r - br * I_BR;
            transpose_item(a.in[28] + (size_t)(l * 3 + br) * 1024 * DM, 1024, DM, WBR + (size_t)(l * 3 + br) * DM * 1024, scr, r2 / 32, r2 % 32, F.lane); continue; } r -= 3 * I_BR;
        transpose_item(a.in[29] + (size_t)l * DM * DM, DM, DM, WOUT + (size_t)l * DM * DM, scr, r / 32, r % 32, F.lane);
    }
    bf16* XN = (bf16*)(F.ws + WS_XN);
    unsigned long long* SS0 = (unsigned long long*)(F.ws + WS_CTL + CTL_SS);
    for (int m = F.gw; m < TOK; m += F.NGW) rms_row(a.in[0] + (size_t)m * DM, a.in[1], XN + (size_t)m * DM, SS0 + m, nullptr, F.lane);
}

__device__ __forceinline__ void prep_gdn(const Ctx& F, const Args& a, int l) {
    const bf16* PROJ = (const bf16*)(F.ws + WS_PROJ);
    float* GQ = (float*)(F.ws + WS_GQ); float* GK = (float*)(F.ws + WS_GK); float* GV = (float*)(F.ws + WS_GV); float* GEG = (float*)(F.ws + WS_GEG); float* GBE = (float*)(F.ws + WS_GBE);
    const float* cw = a.in[3] + (size_t)l * 4 * 3072;
    for (int it = F.gw; it < 2048; it += F.NGW) {
        const int h = it & 7, ch = (it >> 3) & 63, b = it >> 9;
        const int t0 = ch * 32; const int c = 2 * F.lane;
        float w[3][4][2], hist[3][3][2];
#pragma unroll
        for (int p = 0; p < 3; ++p)
#pragma unroll
            for (int j = 0; j < 4; ++j) { const f32x2 ww = *(const f32x2*)(cw + j * 3072 + p * 1024 + h * 128 + c); w[p][j][0] = ww.x; w[p][j][1] = ww.y; }
#pragma unroll
        for (int p = 0; p < 3; ++p)
#pragma unroll
            for (int j = 0; j < 3; ++j) { const int t = t0 - 3 + j; unsigned x = 0u;
                if (t >= 0) x = *(const unsigned*)(PROJ + (size_t)(b * SEQ + t) * NINP + C_GQKV + p * 1024 + h * 128 + c);
                hist[p][j][0] = bflo(x); hist[p][j][1] = bfhi(x); }
        const float alog = a.in[4][l * 8 + h], dtb = a.in[5][l * 8 + h]; const float aexp = expf(alog);
        for (int tt = 0; tt < 32; ++tt) {
            const size_t tok = (size_t)(b * SEQ + t0 + tt);
            float o[3][2];
#pragma unroll
            for (int p = 0; p < 3; ++p) {
                const unsigned x = *(const unsigned*)(PROJ + tok * NINP + C_GQKV + p * 1024 + h * 128 + c);
                const float x0 = bflo(x), x1 = bfhi(x);
                const float y0 = w[p][0][0] * hist[p][0][0] + w[p][1][0] * hist[p][1][0] + w[p][2][0] * hist[p][2][0] + w[p][3][0] * x0;
                const float y1 = w[p][0][1] * hist[p][0][1] + w[p][1][1] * hist[p][1][1] + w[p][2][1] * hist[p][2][1] + w[p][3][1] * x1;
                hist[p][0][0] = hist[p][1][0]; hist[p][1][0] = hist[p][2][0]; hist[p][2][0] = x0;
                hist[p][0][1] = hist[p][1][1]; hist[p][1][1] = hist[p][2][1]; hist[p][2][1] = x1;
                o[p][0] = siluf_(y0); o[p][1] = siluf_(y1);
            }
            const float sq = wave_sum(o[0][0] * o[0][0] + o[0][1] * o[0][1]), sk = wave_sum(o[1][0] * o[1][0] + o[1][1] * o[1][1]);
            const float rq = 0.08838834764831845f / sqrtf(sq + 1e-6f), rk = 1.f / sqrtf(sk + 1e-6f);
            const size_t off = tok * 1024 + h * 128 + c;
            *(unsigned*)((bf16*)GQ + off) = pk2(o[0][0] * rq, o[0][1] * rq);
            *(unsigned*)((bf16*)GK + off) = pk2(o[1][0] * rk, o[1][1] * rk);
            *(unsigned*)((bf16*)GV + off) = pk2(o[2][0], o[2][1]);
            if (F.lane == 0) {
                const float bl = bf1(PROJ[tok * NINP + C_GB + h]), al = bf1(PROJ[tok * NINP + C_GA + h]);
                GBE[tok * 8 + h] = sigmoidf_(bl);
                GEG[tok * 8 + h] = expf(-aexp * softplusf_(al + dtb));
            }
        }
    }
}

__device__ __forceinline__ float mix2(unsigned c, unsigned p, float mu0, float mu1, float& o1) {
    const float c0 = bflo(c), c1 = bfhi(c), p0 = bflo(p), p1 = bfhi(p);
    o1 = c1 + (p1 - c1) * mu1; return c0 + (p0 - c0) * mu0;
}
__device__ __forceinline__ void prep_rwkv(const Ctx& F, const Args& a, int l) {
    const bf16* PROJ = (const bf16*)(F.ws + WS_PROJ);
    float* RR = (float*)(F.ws + WS_RR); float* RW = (float*)(F.ws + WS_RW); float* RK = (float*)(F.ws + WS_RK); float* RV = (float*)(F.ws + WS_RV);
    float* RKK = (float*)(F.ws + WS_RKK); float* RKA = (float*)(F.ws + WS_RKA); float* RBON = (float*)(F.ws + WS_RBON);
    const float* mu = a.in[7] + (size_t)l * 3264; const float* w0 = a.in[8] + l * 1024; const float* wup = a.in[9] + (size_t)l * 96 * 1024;
    const float* a0 = a.in[10] + l * 1024; const float* aup = a.in[11] + (size_t)l * 96 * 1024; const float* kk_ = a.in[12] + l * 1024; const float* ka_ = a.in[13] + l * 1024; const float* rk_ = a.in[14] + l * 1024;
    LAS float* A1 = (LAS float*)F.lds; LAS float* A2 = A1 + 16 * 96;
    const int j = F.tid, c = 2 * j;
    const f32x2 mur = *(const f32x2*)(mu + c), muk = *(const f32x2*)(mu + 1024 + c), muv = *(const f32x2*)(mu + 2048 + c);
    const f32x2 w0v = *(const f32x2*)(w0 + c), a0v = *(const f32x2*)(a0 + c), kkv = *(const f32x2*)(kk_ + c), kav = *(const f32x2*)(ka_ + c), rkv = *(const f32x2*)(rk_ + c);
    for (int tile = F.vcu; tile < TOK / 16; tile += F.G) {
        __syncthreads();
        for (int e = F.tid; e < 16 * 192; e += NTHREADS) {
            const int tl = e / 192, i = e - tl * 192; const size_t tok = (size_t)tile * 16 + tl;
            const float cur = bf1(PROJ[tok * NINP + C_RF + 3072 + i]);
            const float prv = (tok & (SEQ - 1)) ? bf1(PROJ[(tok - 1) * NINP + C_RF + 3072 + i]) : 0.f;
            const float m = cur + (prv - cur) * mu[3072 + i];
            if (i < 96) A1[tl * 96 + i] = tanhf(m); else A2[tl * 96 + i - 96] = m;
        }
        __syncthreads();
        float accw[16][2], acca[16][2];
#pragma unroll
        for (int tl = 0; tl < 16; ++tl) { accw[tl][0] = 0.f; accw[tl][1] = 0.f; acca[tl][0] = 0.f; acca[tl][1] = 0.f; }
        for (int i = 0; i < 96; i += 4) {
            f32x2 wu[4], au[4];
#pragma unroll
            for (int q = 0; q < 4; ++q) { wu[q] = *(const f32x2*)(wup + (size_t)(i + q) * 1024 + c); au[q] = *(const f32x2*)(aup + (size_t)(i + q) * 1024 + c); }
#pragma unroll
            for (int tl = 0; tl < 16; ++tl) {
                const f32x4 x1 = *(const LAS f32x4*)(A1 + tl * 96 + i), x2 = *(const LAS f32x4*)(A2 + tl * 96 + i);
#pragma unroll
                for (int q = 0; q < 4; ++q) { accw[tl][0] += x1[q] * wu[q].x; accw[tl][1] += x1[q] * wu[q].y; acca[tl][0] += x2[q] * au[q].x; acca[tl][1] += x2[q] * au[q].y; }
            }
        }
#pragma unroll
        for (int tl = 0; tl < 16; ++tl) {
            const size_t tok = (size_t)tile * 16 + tl; const bool hp = (tok & (SEQ - 1)) != 0;
            const bf16* cp = PROJ + tok * NINP + C_RF + c; const bf16* pp = cp - NINP;
            const unsigned cr = *(const unsigned*)cp, ck = *(const unsigned*)(cp + 1024), cv = *(const unsigned*)(cp + 2048);
            const unsigned pr = hp ? *(const unsigned*)pp : 0u, pk = hp ? *(const unsigned*)(pp + 1024) : 0u, pv = hp ? *(const unsigned*)(pp + 2048) : 0u;
            float r1, k1, v1; const float r0 = mix2(cr, pr, mur.x, mur.y, r1), k0 = mix2(ck, pk, muk.x, muk.y, k1), v0 = mix2(cv, pv, muv.x, muv.y, v1);
            const float wp0 = w0v.x + accw[tl][0], wp1 = w0v.y + accw[tl][1];
            const float d0 = expf(-expf(-softplusf_(-wp0) - 0.5f)), d1 = expf(-expf(-softplusf_(-wp1) - 0.5f));
            const float aa0 = sigmoidf_(a0v.x + acca[tl][0]), aa1 = sigmoidf_(a0v.y + acca[tl][1]);
            const float q0 = k0 * kkv.x, q1 = k1 * kkv.y;
            float ss = q0 * q0 + q1 * q1;
#pragma unroll
            for (int o = 1; o < 32; o <<= 1) ss += __shfl_xor(ss, o);
            const float rn = 1.f / sqrtf(ss + 1e-6f); const float n0 = q0 * rn, n1 = q1 * rn;
            const float km0 = k0 * (1.f + (aa0 - 1.f) * kav.x), km1 = k1 * (1.f + (aa1 - 1.f) * kav.y);
            float bo = r0 * km0 * rkv.x + r1 * km1 * rkv.y;
#pragma unroll
            for (int o = 1; o < 32; o <<= 1) bo += __shfl_xor(bo, o);
            const size_t off = tok * 1024 + c;
            *(unsigned*)((bf16*)RR + off) = pk2(r0, r1); *(f32x2*)(RW + off) = (f32x2){d0, d1}; *(unsigned*)((bf16*)RK + off) = pk2(km0, km1); *(unsigned*)((bf16*)RV + off) = pk2(v0, v1);
            *(f32x2*)(RKK + off) = (f32x2){-n0, -n1}; *(unsigned*)((bf16*)RKA + off) = pk2(n0 * aa0, n1 * aa1);
            if ((F.lane & 31) == 0) RBON[tok * 16 + (c >> 6)] = bo;
        }
    }
}

#ifndef SCM
#define SCM 7
#endif
#ifndef REPM
#define REPM 0
#endif
constexpr int CH = 32;
#define WFENCE() do { __builtin_amdgcn_fence(__ATOMIC_RELEASE, "wavefront"); __builtin_amdgcn_wave_barrier(); __builtin_amdgcn_fence(__ATOMIC_ACQUIRE, "wavefront"); } while (0)

struct GStep { f32x4 k0, k1, q0, q1; float v, eg, be; };
constexpr int G_BUF = 2 * CH * 128 + CH * 32 + 2 * CH;
__device__ __forceinline__ void gdn_lds(GStep& s, const LAS float* buf, int st, int rg, int colL) {
    s.k0 = *(const LAS f32x4*)(buf + st * 128 + rg * 4); s.k1 = *(const LAS f32x4*)(buf + st * 128 + 64 + rg * 4);
    s.q0 = *(const LAS f32x4*)(buf + CH * 128 + st * 128 + rg * 4); s.q1 = *(const LAS f32x4*)(buf + CH * 128 + st * 128 + 64 + rg * 4);
    s.v = buf[2 * CH * 128 + st * 32 + colL]; s.eg = buf[2 * CH * 128 + CH * 32 + st]; s.be = buf[2 * CH * 128 + CH * 32 + CH + st];
}
__device__ __forceinline__ void gdn_step(const GStep& s, f32x2 (&S)[4], LAS float* ob, bool wr) {
    const f32x2 k01 = s.k0.xy, k23 = s.k0.zw, k45 = s.k1.xy, k67 = s.k1.zw;
    const f32x2 a2 = (k01 * S[0] + k23 * S[1]) + (k45 * S[2] + k67 * S[3]);
    const float ks = allred16(a2.x + a2.y);
    const float cc = s.be * (s.v - s.eg * ks);
    S[0] = S[0] * s.eg + k01 * cc; S[1] = S[1] * s.eg + k23 * cc; S[2] = S[2] * s.eg + k45 * cc; S[3] = S[3] * s.eg + k67 * cc;
    const f32x2 o2 = (s.q0.xy * S[0] + s.q0.zw * S[1]) + (s.q1.xy * S[2] + s.q1.zw * S[3]);
    const float o = allred16(o2.x + o2.y);
    if (wr) *ob = o;
}
struct GStage { u32x4 k, q, v; float e; };
__device__ __forceinline__ void gdn_gload(GStage& g, const bf16* GK, const bf16* GQ, const bf16* GV, const float* GEG, const float* GBE, int t0, int tid) {
    { const int st = tid >> 4, f8 = tid & 15; g.k = *(const u32x4*)(GK + (size_t)(t0 + st) * 1024 + 8 * f8); g.q = *(const u32x4*)(GQ + (size_t)(t0 + st) * 1024 + 8 * f8); }
    { const int i = tid & 127; g.v = *(const u32x4*)(GV + (size_t)(t0 + (i >> 2)) * 1024 + 8 * (i & 3)); }
    { const int i = tid & 63; const float* p = (i < 32 ? GEG : GBE); g.e = p[(size_t)(t0 + (i & 31)) * 8]; }
}
__device__ __forceinline__ void st8(LAS float* d, const u32x4 w) { float f[8]; unpack8(w, f); *(LAS f32x4*)d = (f32x4){f[0], f[1], f[2], f[3]}; *(LAS f32x4*)(d + 4) = (f32x4){f[4], f[5], f[6], f[7]}; }
__device__ __forceinline__ void gdn_gstore(const GStage& g, LAS float* buf, int tid) {
    st8(buf + 8 * tid, g.k); st8(buf + CH * 128 + 8 * tid, g.q);
    if (tid < 128) st8(buf + 2 * CH * 128 + 8 * tid, g.v);
    else if (tid >= 256 && tid < 320) buf[2 * CH * 128 + CH * 32 + (tid - 256)] = g.e;
}
__device__ __forceinline__ void gdn_block(const Ctx& F, int vb) {
    const int bh = vb >> 2, qt = vb & 3, b = bh >> 3, h = bh & 7, colL = F.wave * 4 + (F.lane >> 4), rg = F.lane & 15;
    const size_t base = (size_t)b * SEQ;
    const bf16* GK = (const bf16*)(F.ws + WS_GK) + base * 1024 + h * 128; const bf16* GQ = (const bf16*)(F.ws + WS_GQ) + base * 1024 + h * 128;
    const bf16* GV = (const bf16*)(F.ws + WS_GV) + base * 1024 + h * 128 + qt * 32;
    const float* GEG = (const float*)(F.ws + WS_GEG) + base * 8 + h; const float* GBE = (const float*)(F.ws + WS_GBE) + base * 8 + h;
    float* GO = (float*)(F.ws + WS_GO) + base * 1024 + h * 128 + qt * 32;
    LAS float* lb = (LAS float*)F.lds; LAS float* obase = lb + 2 * G_BUF;
    f32x2 S[4] = {{0.f, 0.f}, {0.f, 0.f}, {0.f, 0.f}, {0.f, 0.f}};
    const bool wr = rg == 0;
    GStage g;
    gdn_gload(g, GK, GQ, GV, GEG, GBE, 0, F.tid); gdn_gstore(g, lb, F.tid);
    __syncthreads();
    for (int c = 0; c < SEQ / CH; ++c) {
        const LAS float* buf = lb + (c & 1) * G_BUF; LAS float* ob = obase + (c & 1) * (CH * 32) + colL;
        if (c + 1 < SEQ / CH) gdn_gload(g, GK, GQ, GV, GEG, GBE, (c + 1) * CH, F.tid);
        GStep R0, R1, R2, R3;
        gdn_lds(R0, buf, 0, rg, colL); gdn_lds(R1, buf, 1, rg, colL);
#pragma unroll 1
        for (int s = 0; s < CH; s += 4) {
            gdn_lds(R2, buf, s + 2, rg, colL); gdn_step(R0, S, ob + s * 32, wr);
            gdn_lds(R3, buf, s + 3, rg, colL); gdn_step(R1, S, ob + (s + 1) * 32, wr);
            gdn_lds(R0, buf, (s + 4) & (CH - 1), rg, colL); gdn_step(R2, S, ob + (s + 2) * 32, wr);
            gdn_lds(R1, buf, (s + 5) & (CH - 1), rg, colL); gdn_step(R3, S, ob + (s + 3) * 32, wr);
        }
        if (c + 1 < SEQ / CH) gdn_gstore(g, lb + ((c + 1) & 1) * G_BUF, F.tid);
        __syncthreads();
        if (F.tid < 256) *(f32x4*)(GO + (size_t)(c * CH + (F.tid >> 3)) * 1024 + 4 * (F.tid & 7)) = *(const LAS f32x4*)(obase + (c & 1) * (CH * 32) + 4 * F.tid);
    }
}

struct RStep { f32x4 w, n, a, k, r; float v; };
constexpr int R_BUF = CH * (5 * 64 + 32);
__device__ __forceinline__ void rwkv_lds(RStep& s, const LAS float* buf, int st, int cq, int rowL) {
    s.w = *(const LAS f32x4*)(buf + st * 64 + 4 * cq); s.n = *(const LAS f32x4*)(buf + CH * 64 + st * 64 + 4 * cq); s.a = *(const LAS f32x4*)(buf + 2 * CH * 64 + st * 64 + 4 * cq);
    s.k = *(const LAS f32x4*)(buf + 3 * CH * 64 + st * 64 + 4 * cq); s.r = *(const LAS f32x4*)(buf + 4 * CH * 64 + st * 64 + 4 * cq); s.v = buf[5 * CH * 64 + st * 32 + rowL];
}
__device__ __forceinline__ void rwkv_step(const RStep& s, f32x4& S, LAS float* ob, bool wr) {
    float sa = (S.x * s.n.x + S.y * s.n.y) + (S.z * s.n.z + S.w * s.n.w);
    sa = allred16(sa);
    S = S * s.w + sa * s.a + s.v * s.k;
    float y = (S.x * s.r.x + S.y * s.r.y) + (S.z * s.r.z + S.w * s.r.w);
    y = allred16(y);
    if (wr) *ob = y;
}
struct RStage { f32x4 x[2]; u32x4 y[3], v; };
__device__ __forceinline__ void rwkv_gload(RStage& g, const float* RW, const float* RN, const bf16* RA, const bf16* RKp, const bf16* RRp, const bf16* RV, int t0, int tid) {
    { const int st = tid >> 4, f4 = tid & 15; g.x[0] = *(const f32x4*)(RW + (size_t)(t0 + st) * 1024 + 4 * f4); g.x[1] = *(const f32x4*)(RN + (size_t)(t0 + st) * 1024 + 4 * f4); }
    { const int i = tid & 255; const size_t o = (size_t)(t0 + (i >> 3)) * 1024 + 8 * (i & 7); g.y[0] = *(const u32x4*)(RA + o); g.y[1] = *(const u32x4*)(RKp + o); g.y[2] = *(const u32x4*)(RRp + o); }
    { const int i = tid & 127; g.v = *(const u32x4*)(RV + (size_t)(t0 + (i >> 2)) * 1024 + 8 * (i & 3)); }
}
__device__ __forceinline__ void rwkv_gstore(const RStage& g, LAS float* buf, int tid) {
    *(LAS f32x4*)(buf + 4 * tid) = g.x[0]; *(LAS f32x4*)(buf + CH * 64 + 4 * tid) = g.x[1];
    if (tid < 256) { st8(buf + 2 * CH * 64 + 8 * tid, g.y[0]); st8(buf + 3 * CH * 64 + 8 * tid, g.y[1]); st8(buf + 4 * CH * 64 + 8 * tid, g.y[2]); }
    else if (tid < 384) st8(buf + 5 * CH * 64 + 8 * (tid - 256), g.v);
}
__device__ __forceinline__ void rwkv_block(const Ctx& F, int vb) {
    const int bh = vb >> 1, hf = vb & 1, b = bh >> 4, h = bh & 15, rowL = F.wave * 4 + (F.lane >> 4), cq = F.lane & 15;
    const size_t base = (size_t)b * SEQ * 1024 + h * 64;
    const float* RW = (const float*)(F.ws + WS_RW) + base; const float* RN = (const float*)(F.ws + WS_RKK) + base;
    const bf16* RA = (const bf16*)(F.ws + WS_RKA) + base; const bf16* RKp = (const bf16*)(F.ws + WS_RK) + base; const bf16* RRp = (const bf16*)(F.ws + WS_RR) + base;
    const bf16* RV = (const bf16*)(F.ws + WS_RV) + base + hf * 32;
    float* RY = (float*)(F.ws + WS_RY) + base + hf * 32;
    LAS float* lb = (LAS float*)F.lds; LAS float* obase = lb + 2 * R_BUF;
    f32x4 S = {0.f, 0.f, 0.f, 0.f};
    const bool wr = cq == 0;
    RStage g;
    rwkv_gload(g, RW, RN, RA, RKp, RRp, RV, 0, F.tid); rwkv_gstore(g, lb, F.tid);
    __syncthreads();
    for (int c = 0; c < SEQ / CH; ++c) {
        const LAS float* buf = lb + (c & 1) * R_BUF; LAS float* ob = obase + (c & 1) * (CH * 32) + rowL;
        if (c + 1 < SEQ / CH) rwkv_gload(g, RW, RN, RA, RKp, RRp, RV, (c + 1) * CH, F.tid);
        RStep R0, R1, R2, R3;
        rwkv_lds(R0, buf, 0, cq, rowL); rwkv_lds(R1, buf, 1, cq, rowL);
#pragma unroll 1
        for (int s = 0; s < CH; s += 4) {
            rwkv_lds(R2, buf, s + 2, cq, rowL); rwkv_step(R0, S, ob + s * 32, wr);
            rwkv_lds(R3, buf, s + 3, cq, rowL); rwkv_step(R1, S, ob + (s + 1) * 32, wr);
            rwkv_lds(R0, buf, (s + 4) & (CH - 1), cq, rowL); rwkv_step(R2, S, ob + (s + 2) * 32, wr);
            rwkv_lds(R1, buf, (s + 5) & (CH - 1), cq, rowL); rwkv_step(R3, S, ob + (s + 3) * 32, wr);
        }
        if (c + 1 < SEQ / CH) rwkv_gstore(g, lb + ((c + 1) & 1) * R_BUF, F.tid);
        __syncthreads();
        if (F.tid < 256) *(f32x4*)(RY + (size_t)(c * CH + (F.tid >> 3)) * 1024 + 4 * (F.tid & 7)) = *(const LAS f32x4*)(obase + (c & 1) * (CH * 32) + 4 * F.tid);
    }
}

typedef short bf16x8_t __attribute__((ext_vector_type(8)));
constexpr int S5_SROW = 136;
constexpr int S5_WAVE_B = 16 * S5_SROW * 2 + 1024;
__device__ __forceinline__ void s5_block(const Ctx& F, const Args& a, int l, int it) {
    const int b = it >> 6, g = it & 63, p = F.lane, tl = F.lane >> 4, c = F.lane & 15, w = F.wave;
    const bf16* PROJ = (const bf16*)(F.ws + WS_PROJ); bf16* SY = (bf16*)(F.ws + WS_SY);
    LAS float* se = (LAS float*)F.lds;
    LAS unsigned char* wb = F.lds + 4096 + w * S5_WAVE_B;
    LAS bf16* sbuf = (LAS bf16*)wb; LAS float* uall = (LAS float*)(wb + 16 * S5_SROW * 2);
    const size_t gp = ((size_t)l * 64 + g) * 64 + p;
    const float dt = expf(a.in[19][l * 64 + g]); const float are = a.in[17][gp], aim = a.in[18][gp];
    const float mag = expf(are * dt), abr = mag * cosf(aim * dt), abi = mag * sinf(aim * dt);
    const float den = are * are + aim * aim, cr = ((abr - 1.f) * are + abi * aim) / den, ci = (abi * are - (abr - 1.f) * aim) / den;
    float Bre[16], Bim[16];
#pragma unroll
    for (int q = 0; q < 4; ++q) { const f32x4 br = *(const f32x4*)(a.in[20] + gp * 16 + 4 * q), bi = *(const f32x4*)(a.in[21] + gp * 16 + 4 * q);
#pragma unroll
        for (int e = 0; e < 4; ++e) { Bre[4 * q + e] = cr * br[e] - ci * bi[e]; Bim[4 * q + e] = cr * bi[e] + ci * br[e]; } }
    bf16x8_t Cf[4];
    { const size_t cb = (((size_t)l * 64 + g) * 16 + c) * 64;
#pragma unroll
      for (int m = 0; m < 4; ++m) { const int k0 = 32 * m + 8 * tl; const float* src = (k0 < 64 ? a.in[22] + cb + k0 : a.in[23] + cb + (k0 - 64)); const float sg = k0 < 64 ? 1.f : -1.f;
          const f32x4 x0 = *(const f32x4*)src, x1 = *(const f32x4*)(src + 4);
          u32x4 pk; pk.x = pk2(sg * x0.x, sg * x0.y); pk.y = pk2(sg * x0.z, sg * x0.w); pk.z = pk2(sg * x1.x, sg * x1.y); pk.w = pk2(sg * x1.z, sg * x1.w);
          Cf[m] = __builtin_bit_cast(bf16x8_t, pk); } }
    const float dsk = a.in[24][l * 1024 + g * 16 + c];
    const int tw = 256 * w;
    const bf16* up = PROJ + ((size_t)b * SEQ + tw) * NINP + C_SU + g * 16;
    float sr = 0.f, si = 0.f;
    {
        bf16 ucur = up[(size_t)tl * NINP + c], unxt = up[(size_t)(4 + tl) * NINP + c];
        for (int t = 0; t < 256; t += 4) {
            uall[F.lane] = bf1(ucur);
            WFENCE();
            const int tn = (t + 8 < 256) ? t + 8 : t;
            const bf16 unn = up[(size_t)(tn + tl) * NINP + c];
#pragma unroll
            for (int j = 0; j < 4; ++j) {
                float br = 0.f, bi = 0.f;
#pragma unroll
                for (int q = 0; q < 4; ++q) { const f32x4 u4 = *(const LAS f32x4*)(uall + j * 16 + 4 * q);
#pragma unroll
                    for (int e = 0; e < 4; ++e) { br += Bre[4 * q + e] * u4[e]; bi += Bim[4 * q + e] * u4[e]; } }
                const float nr = abr * sr - abi * si + br, ni = abr * si + abi * sr + bi; sr = nr; si = ni;
            }
            WFENCE();
            ucur = unxt; unxt = unn;
        }
    }
    se[w * 128 + p] = sr; se[w * 128 + 64 + p] = si;
    __syncthreads();
    {
        float pr = abr, pi = abi;
#pragma unroll
        for (int i = 0; i < 8; ++i) { const float nr = pr * pr - pi * pi, ni = 2.f * pr * pi; pr = nr; pi = ni; }
        sr = 0.f; si = 0.f;
        for (int j = 0; j < w; ++j) { const float er = se[j * 128 + p], ei = se[j * 128 + 64 + p]; const float nr = pr * sr - pi * si + er, ni = pr * si + pi * sr + ei; sr = nr; si = ni; }
    }
    {
        bf16 ucur = up[(size_t)tl * NINP + c], unxt = up[(size_t)(4 + tl) * NINP + c];
        for (int t = 0; t < 256; t += 16) {
#pragma unroll
            for (int sub = 0; sub < 4; ++sub) {
                uall[sub * 64 + F.lane] = bf1(ucur);
                WFENCE();
                const int tn = (t + 4 * sub + 8 < 256) ? t + 4 * sub + 8 : t + 4 * sub;
                const bf16 unn = up[(size_t)(tn + tl) * NINP + c];
#pragma unroll
                for (int j = 0; j < 4; ++j) {
                    float br = 0.f, bi = 0.f;
#pragma unroll
                    for (int q = 0; q < 4; ++q) { const f32x4 u4 = *(const LAS f32x4*)(uall + sub * 64 + j * 16 + 4 * q);
#pragma unroll
                        for (int e = 0; e < 4; ++e) { br += Bre[4 * q + e] * u4[e]; bi += Bim[4 * q + e] * u4[e]; } }
                    const float nr = abr * sr - abi * si + br, ni = abr * si + abi * sr + bi; sr = nr; si = ni;
                    sbuf[(sub * 4 + j) * S5_SROW + p] = (bf16)f2bf(sr); sbuf[(sub * 4 + j) * S5_SROW + 64 + p] = (bf16)f2bf(si);
                }
                ucur = unxt; unxt = unn;
            }
            WFENCE();
            f32x4 acc = {0.f, 0.f, 0.f, 0.f};
#pragma unroll
            for (int m = 0; m < 4; ++m) { const bf16x8_t af = *(const LAS bf16x8_t*)(sbuf + c * S5_SROW + 32 * m + 8 * tl);
                acc = __builtin_amdgcn_mfma_f32_16x16x32_bf16(af, Cf[m], acc, 0, 0, 0); }
#pragma unroll
            for (int r = 0; r < 4; ++r) { const int st = 4 * tl + r; const float y = acc[r] + dsk * uall[st * 16 + c];
                SY[((size_t)b * SEQ + tw + t + st) * 1024 + g * 16 + c] = (bf16)f2bf(gelu_tanh(y)); }
            WFENCE();
        }
    }
    __syncthreads();
}

__device__ __forceinline__ void scan_phase(const Ctx& F, const Args& a, int l) {
    for (int r5 = 0; r5 < 1 + ((REPM >> 9) & 1); ++r5) for (int vb = F.vcu; vb < 256; vb += F.G) s5_block(F, a, l, vb);
    for (int rg_ = 0; rg_ < 1 + ((REPM >> 10) & 1); ++rg_) for (int vb = F.vcu; vb < 256; vb += F.G) {
        if (vb < 128) { gdn_block(F, vb); if (REPM & 2048) gdn_block(F, vb); }
        else { rwkv_block(F, vb - 128); if (REPM & 4096) rwkv_block(F, vb - 128); }
    }
}

__device__ __forceinline__ void post_phase(const Ctx& F, const Args& a, int l, int gw, int ngw) {
    const bf16* PROJ = (const bf16*)(F.ws + WS_PROJ); bf16* OBR = (bf16*)(F.ws + WS_OBR);
    const float* GO = (const float*)(F.ws + WS_GO); const float* RY = (const float*)(F.ws + WS_RY); const float* RV = (const float*)(F.ws + WS_RV); const float* RBON = (const float*)(F.ws + WS_RBON);
    const int c0 = 16 * F.lane;
    float nw[16], lw[16], lb[16];
#pragma unroll
    for (int e = 0; e < 16; ++e) { nw[e] = a.in[6][l * 128 + (c0 & 127) + e]; lw[e] = a.in[15][l * 1024 + c0 + e]; lb[e] = a.in[16][l * 1024 + c0 + e]; }
    for (int tok = gw; tok < TOK; tok += ngw) {
        { float o[16];
#pragma unroll
          for (int q = 0; q < 4; ++q) { const f32x4 v = *(const f32x4*)(GO + (size_t)tok * 1024 + c0 + 4 * q); o[4 * q] = v.x; o[4 * q + 1] = v.y; o[4 * q + 2] = v.z; o[4 * q + 3] = v.w; }
          float ss = 0.f;
#pragma unroll
          for (int e = 0; e < 16; ++e) ss += o[e] * o[e];
          ss = allred8(ss);
          const float rs = 1.f / sqrtf(ss * (1.f / 128.f) + 1e-6f);
          float z[16]; { float z0[8], z1[8]; unpack8(*(const u32x4*)(PROJ + (size_t)tok * NINP + C_GZ + c0), z0); unpack8(*(const u32x4*)(PROJ + (size_t)tok * NINP + C_GZ + c0 + 8), z1);
#pragma unroll
              for (int e = 0; e < 8; ++e) { z[e] = z0[e]; z[8 + e] = z1[e]; } }
          float r0[8], r1[8];
#pragma unroll
          for (int e = 0; e < 8; ++e) { r0[e] = o[e] * rs * nw[e] * siluf_(z[e]); r1[e] = o[8 + e] * rs * nw[8 + e] * siluf_(z[8 + e]); }
          *(u32x4*)(OBR + (size_t)tok * 1024 + c0) = pack8(r0); *(u32x4*)(OBR + (size_t)tok * 1024 + c0 + 8) = pack8(r1); }
        { float y[16], v[16];
#pragma unroll
          for (int q = 0; q < 4; ++q) { const f32x4 t = *(const f32x4*)(RY + (size_t)tok * 1024 + c0 + 4 * q); y[4 * q] = t.x; y[4 * q + 1] = t.y; y[4 * q + 2] = t.z; y[4 * q + 3] = t.w;
          }
          { float va[8], vb[8]; unpack8(*(const u32x4*)((const bf16*)RV + (size_t)tok * 1024 + c0), va); unpack8(*(const u32x4*)((const bf16*)RV + (size_t)tok * 1024 + c0 + 8), vb);
#pragma unroll
              for (int e = 0; e < 8; ++e) { v[e] = va[e]; v[8 + e] = vb[e]; } }
          float s = 0.f;
#pragma unroll
          for (int e = 0; e < 16; ++e) s += y[e];
          s += dppf<0xB1>(s); s += dppf<0x4E>(s);
          const float mean = s * (1.f / 64.f); float q2 = 0.f;
#pragma unroll
          for (int e = 0; e < 16; ++e) { const float d = y[e] - mean; q2 += d * d; }
          q2 += dppf<0xB1>(q2); q2 += dppf<0x4E>(q2);
          const float rs = 1.f / sqrtf(q2 * (1.f / 64.f) + 64e-5f);
          const float bon = RBON[(size_t)tok * 16 + (c0 >> 6)];
          float z[16]; { float z0[8], z1[8]; unpack8(*(const u32x4*)(PROJ + (size_t)tok * NINP + C_RZ + c0), z0); unpack8(*(const u32x4*)(PROJ + (size_t)tok * NINP + C_RZ + c0 + 8), z1);
#pragma unroll
              for (int e = 0; e < 8; ++e) { z[e] = z0[e]; z[8 + e] = z1[e]; } }
          float r0[8], r1[8];
#pragma unroll
          for (int e = 0; e < 8; ++e) { r0[e] = ((y[e] - mean) * rs * lw[e] + lb[e] + bon * v[e]) * siluf_(z[e]); r1[e] = ((y[8 + e] - mean) * rs * lw[8 + e] + lb[8 + e] + bon * v[8 + e]) * siluf_(z[8 + e]); }
          bf16* ob = OBR + (size_t)TOK * 1024 + (size_t)tok * 1024 + c0;
          *(u32x4*)ob = pack8(r0); *(u32x4*)(ob + 8) = pack8(r1); }
    }
}

#ifndef PHM
#define PHM 0xFFFF
#endif
#ifndef REPM
#define REPM 0
#endif
__global__ void __launch_bounds__(NTHREADS, 2) hybrid_fwd(Args a) {
    extern __shared__ __attribute__((aligned(16))) unsigned char lds_raw[];
    Ctx F;
    F.lds = (LAS unsigned char*)lds_raw; F.ws = a.ws;
    F.G = gridDim.x; { const int bx = blockIdx.x; F.vcu = (F.G % 8 == 0) ? (bx % 8) * (F.G / 8) + bx / 8 : bx; }
    F.NGW = F.G * NWAVES;
    cg::grid_group grid = cg::this_grid();
    if (threadIdx.x < 8) ((volatile LAS unsigned*)(F.lds + MISC_OFF))[threadIdx.x] = 0u;
    __syncthreads();
    grid.sync();
    XcdBarrier bar = xcd_barrier_post((unsigned*)(a.ws + WS_CTL), (volatile LAS unsigned*)(F.lds + MISC_OFF));
    bf16* XN = (bf16*)(a.ws + WS_XN); bf16* PROJ = (bf16*)(a.ws + WS_PROJ);
    int rep = 0;
    for (int ph = a.ph_lo; ph < a.ph_hi; ) {
        { int t_ = threadIdx.x; asm volatile("" : "+v"(t_)); F.tid = t_; F.lane = t_ & 63; F.wave = __builtin_amdgcn_readfirstlane(t_ >> 6); F.gw = F.vcu * NWAVES + F.wave; }
        if (ph == NPHASES - 1) { for (int m = F.gw; m < TOK; m += F.NGW) rms_row(a.out + (size_t)m * DM, a.in[30], nullptr, nullptr, a.out + (size_t)m * DM, F.lane); }
        else if (ph == 0) { if (PHM & 1) phase0(F, a);
            if (REPM & 128) { if (!rep) { rep = 1; __syncthreads(); continue; } rep = 0; } }
        else {
            const int l = (ph - 1) / PH_PER_LAYER, k = (ph - 1) % PH_PER_LAYER;
            if (k == 0 && (PHM & 2)) {
                pg8::Gemm g{XN, (const bf16*)(a.ws + WS_WIN) + (size_t)l * NINP * DM, TOK, NINP, DM}; pg8::StaticOrder S; S.init(TOK, NINP, F.G, (int)blockIdx.x);
                pg8::EpiBf16Rs E{PROJ, NINP, (const unsigned long long*)(a.ws + WS_CTL + CTL_SS) + (size_t)l * TOK};
                pg8::gemm_phase<pg8::EpiBf16Rs, pg8::StaticOrder, true, true>(F.lds, g, S, E);
            } else if (k == 1) { prep_gdn(F, a, l); if (REPM & 8192) prep_gdn(F, a, l); prep_rwkv(F, a, l); if (REPM & 16384) prep_rwkv(F, a, l); }
            else if (k == 2) { if (PHM & 16) scan_phase(F, a, l); }
            else if (k == 3 && (PHM & 32)) {
                const bool split = F.G >= 192;
                if (!split) { post_phase(F, a, l, F.gw, F.NGW); __syncthreads(); }
                if (!split || (int)blockIdx.x < 128) {
                    pg8::Gemm g{(const bf16*)(a.ws + WS_SY), (const bf16*)(a.ws + WS_WGLU) + (size_t)l * 1024 * 1024, TOK, 1024, 1024}; pg8::StaticOrder S; S.init(TOK, 1024, F.G, (int)blockIdx.x);
                    pg8::EpiGlu E{(const bf16*)(a.ws + WS_SY), PROJ, a.in[26] + l * 1024, (bf16*)(a.ws + WS_OBR) + (size_t)2 * TOK * 1024};
                    pg8::gemm_phase<pg8::EpiGlu, pg8::StaticOrder, true, true>(F.lds, g, S, E);
                } else post_phase(F, a, l, ((int)blockIdx.x - 128) * NWAVES + F.wave, (F.G - 128) * NWAVES);
            } else if (k == 4 && (PHM & 64)) {
                pg8::Gemm g{(const bf16*)(a.ws + WS_OBR), (const bf16*)(a.ws + WS_WBR) + (size_t)l * 3 * DM * 1024, 3 * TOK, 3 * DM, 1024};
                pg8::BranchOrder S; S.base.init(TOK, DM, F.G, (int)blockIdx.x);
                pg8::EpiBranch E{PROJ, a.in[27] + (size_t)l * 3 * DM, (bf16*)(a.ws + WS_ACCF), (bf16*)(a.ws + WS_MRG)};
                pg8::gemm_phase<pg8::EpiBranch, pg8::BranchOrder, true, true>(F.lds, g, S, E);
            } else if (k == 5 && (PHM & 128)) {
                pg8::Gemm g{(const bf16*)(a.ws + WS_MRG), (const bf16*)(a.ws + WS_WOUT) + (size_t)l * DM * DM, TOK, DM, DM}; pg8::StaticOrder S; S.init(TOK, DM, F.G, (int)blockIdx.x);
                pg8::EpiResid E{l == 0 ? a.in[0] : a.out, a.out, l + 1 < DEPTH ? XN : nullptr, a.in[1] + (size_t)(l + 1 < DEPTH ? l + 1 : 0) * DM, (unsigned long long*)(a.ws + WS_CTL + CTL_SS) + (size_t)(l + 1 < DEPTH ? l + 1 : 0) * TOK};
                pg8::gemm_phase<pg8::EpiResid, pg8::StaticOrder, true, true>(F.lds, g, S, E);
            }
            if (REPM && !rep && ((REPM >> k) & 1)) { rep = 1; __syncthreads(); continue; }
            rep = 0;
        }
        if (ph + 1 < a.ph_hi) {
            xcd_barrier(bar);
            if (REPM & 256) xcd_barrier(bar);
        }
        ++ph;
    }
}

#ifndef MK_MULTI
#define MK_MULTI 0
#endif
extern "C" void kernel_launch(void* const* d_in, const int* in_sizes, int n_in, void* d_out, int out_size, void* d_ws, size_t ws_size, hipStream_t stream) {
    static int grid = 0;
    if (grid == 0) {
        if (n_in != 31 || out_size != TOK * DM || ws_size < WS_END) { fprintf(stderr, "kernel_launch: unexpected shapes (n_in %d out %d ws %zu)\n", n_in, out_size, ws_size); grid = -1; return; }
        int dev = 0, cus = 0, per_cu = 0;
        hipGetDevice(&dev); hipDeviceGetAttribute(&cus, hipDeviceAttributeMultiprocessorCount, dev);
        if (hipFuncSetAttribute((const void*)hybrid_fwd, hipFuncAttributeMaxDynamicSharedMemorySize, LDS_BYTES) != hipSuccess) { fprintf(stderr, "kernel_launch: hipFuncSetAttribute failed\n"); grid = -1; return; }
        if (hipOccupancyMaxActiveBlocksPerMultiprocessor(&per_cu, (const void*)hybrid_fwd, NTHREADS, LDS_BYTES) != hipSuccess || per_cu < 1) per_cu = 1;
        (void)hipGetLastError();
        grid = cus * per_cu;
        fprintf(stderr, "kernel_launch: grid %d (cus %d x %d)\n", grid, cus, per_cu);
    }
    if (grid < 0) return;
    if (hipMemsetAsync((char*)d_ws + WS_CTL, 0, CTL_ZERO_BYTES, stream) != hipSuccess) { fprintf(stderr, "kernel_launch: memset failed\n"); return; }
    Args a{};
    for (int i = 0; i < 31; ++i) a.in[i] = (const float*)d_in[i];
    a.out = (float*)d_out; a.ws = (unsigned char*)d_ws;
#if MK_MULTI
    for (int ph = 0; ph < NPHASES; ++ph) { a.ph_lo = ph; a.ph_hi = ph + 1; hipLaunchKernelGGL(hybrid_fwd, dim3(grid), dim3(NTHREADS), LDS_BYTES, stream, a); }
#else
    a.ph_lo = 0; a.ph_hi = NPHASES;
    void* args[] = {&a};
    const hipError_t e = hipLaunchCooperativeKernel((const void*)hybrid_fwd, dim3(grid), dim3(NTHREADS), args, LDS_BYTES, stream);
    if (e != hipSuccess) fprintf(stderr, "kernel_launch: cooperative launch failed: %s (grid %d)\n", hipGetErrorString(e), grid);
#endif
}
```

```cpp
#include <hip/hip_runtime.h>
#include <hip/hip_cooperative_groups.h>
#include <cstdio>
#include <cstdint>
namespace cg = cooperative_groups;
namespace pg8 {
#define PG8_LAS __attribute__((address_space(3)))
typedef unsigned short bf16_t;
typedef short bf16x8 __attribute__((ext_vector_type(8)));
typedef float f32x4 __attribute__((ext_vector_type(4)));
typedef unsigned u32x4 __attribute__((ext_vector_type(4)));
constexpr int BM = 256, BK = 64, HALF = 128, HTB = HALF * BK * 2  , STAGE_BYTES = 8 * HTB, NXCD = 8, WGM = 8;

__host__ __device__ __forceinline__ int lds_byte(int r, int c) { const int st = (r >> 4) * 2 + (c >> 5), rr = r & 15, cc = c & 31, ob = rr * 64 + cc * 2; return st * 1024 + (ob ^ (((ob >> 9) & 1) << 5)); }
__host__ __device__ __forceinline__ void stage_rc(int b, int& R, int& C) { const int st = b / 1024, sb = b % 1024, swz = sb ^ (((sb >> 9) & 1) << 5); R = (st >> 1) * 16 + swz / 64; C = (st & 1) * 32 + (swz % 64) / 2; }
__host__ __device__ __forceinline__ int perm32(int rho) { const int n = rho >> 4, i = rho & 15; return 8 * (i >> 2) + 4 * n + (i & 3); }

struct Unit { int pm, pn; };
struct Gemm { const bf16_t* A; const bf16_t* Bt; int M, N, K; };

struct StaticOrder {
    int nM, nN, nwg, G, c;
    __host__ __device__ void init(int M, int N, int G_, int c_) { nM = M / BM; nN = N / BM; nwg = nM * nN; G = G_; c = c_; }
    __host__ __device__ bool next(int i, Unit& u) const {
        const long L = (long)i * G + c; if (L >= nwg) return false;
        int wgid = (int)L; { const int q = nwg / NXCD, r = nwg % NXCD, xcd = wgid % NXCD, off = wgid / NXCD; wgid = (xcd < r ? xcd * (q + 1) : r * (q + 1) + (xcd - r) * q) + off; }
        const int nig = WGM * nN, gid = wgid / nig, fm = gid * WGM, gsz = (nM - fm) < WGM ? (nM - fm) : WGM;
        u.pm = fm + ((wgid % nig) % gsz); u.pn = (wgid % nig) / gsz; return true;
    }
    __device__ __forceinline__ void a_ready(const Unit&) const {}
    __device__ __forceinline__ void done(const Unit&) const {}
};

__device__ __forceinline__ unsigned cvt_pk_bf16(float lo, float hi) { unsigned r; asm volatile("v_cvt_pk_bf16_f32 %0, %1, %2" : "=v"(r) : "v"(lo), "v"(hi)); return r; }
typedef float f32x2 __attribute__((ext_vector_type(2)));
__device__ __forceinline__ f32x2 gelu_pk(f32x2 v) {
    const f32x2 av = __builtin_elementwise_abs(v), d = av * 0.2316418882f + 1.0f;
    f32x2 t; t.x = __builtin_amdgcn_rcpf(d.x); t.y = __builtin_amdgcn_rcpf(d.y);
    f32x2 q = t * 0.5307027145f + (-0.7265760135f); q = q * t + 0.7107068705f; q = q * t + (-0.142248368f); q = q * t + 0.127414796f; q = q * t;
    const f32x2 s = (v * v) * (-0.72134752044f);
    f32x2 e; e.x = __builtin_amdgcn_exp2f(s.x); e.y = __builtin_amdgcn_exp2f(s.y);
    const f32x2 m = v * (q * e), r = v - m;
    f32x2 o; o.x = v.x < 0.f ? m.x : r.x; o.y = v.y < 0.f ? m.y : r.y; return o;
}

template <int ACT  > struct EpiBf16 {
    static constexpr bool PERM = true, AFTER_DRAIN = false; static_assert(ACT == 0 || ACT == 1, "EpiBf16: ACT is 0 (none) or 1 (gelu_pk)");
    bf16_t* O; int ldc; const float* bias; int split_cols; size_t split_stride; float scale0;
    __device__ __forceinline__ void operator()(const f32x4 (&acc)[2][2][4][2], const Unit& u, int wr, int wc, int fr, int fq) const {
        const int row0 = u.pm * BM + wr * 64 + fr; int colt = u.pn * BM; bf16_t* base = O;
        float sc = 1.f; if (split_cols) { const int t = colt / split_cols; base += (size_t)t * split_stride; colt -= t * split_cols; if (t == 0) sc = scale0; }
        const int col0 = colt + wc * 32 + 8 * fq, bcol0 = u.pn * BM + wc * 32 + 8 * fq;
        f32x4 bv[2][2];
#pragma unroll
        for (int bj = 0; bj < 2; ++bj)
#pragma unroll
            for (int n = 0; n < 2; ++n) bv[bj][n] = bias ? *(const f32x4*)(bias + bcol0 + bj * HALF + 4 * n) : (f32x4){0.f, 0.f, 0.f, 0.f};
#pragma unroll
        for (int ai = 0; ai < 2; ++ai)
#pragma unroll
            for (int m = 0; m < 4; ++m) { bf16_t* rowp = base + (size_t)(row0 + ai * HALF + m * 16) * ldc + col0;
#pragma unroll
                for (int bj = 0; bj < 2; ++bj) { f32x4 v0 = acc[ai][bj][m][0] + bv[bj][0], v1 = acc[ai][bj][m][1] + bv[bj][1];
                    if (ACT == 1) { f32x2 a = gelu_pk((f32x2){v0[0], v0[1]}), b = gelu_pk((f32x2){v0[2], v0[3]}), c = gelu_pk((f32x2){v1[0], v1[1]}), d = gelu_pk((f32x2){v1[2], v1[3]});
                        v0 = (f32x4){a.x, a.y, b.x, b.y}; v1 = (f32x4){c.x, c.y, d.x, d.y}; }
                    v0 = v0 * sc; v1 = v1 * sc; u32x4 w; w.x = cvt_pk_bf16(v0[0], v0[1]); w.y = cvt_pk_bf16(v0[2], v0[3]); w.z = cvt_pk_bf16(v1[0], v1[1]); w.w = cvt_pk_bf16(v1[2], v1[3]);
                    *(u32x4*)(rowp + bj * HALF) = w; } }
    }
};

template <class Epi, class Sched, bool ALIGN_EPI = false, bool SP2 = false>
__device__ __forceinline__ void gemm_phase(PG8_LAS unsigned char* lds, const Gemm g, const Sched& S, const Epi& E) {
    int tid_ = threadIdx.x; asm volatile("" : "+v"(tid_));
    const int tid = tid_, wid = __builtin_amdgcn_readfirstlane(tid >> 6), lane = tid & 63, wr = wid >> 2, wc = wid & 3, fr = lane & 15, fq = lane >> 4;
    const int K = g.K, nt = K / BK;
    unsigned voffA[2], voffB[2];
#pragma unroll
    for (int i = 0; i < 2; ++i) { int R, C; stage_rc(tid * 16 + i * 8192, R, C); const int Rb = Epi::PERM ? ((R & ~31) + perm32(R & 31)) : R;
        voffA[i] = (unsigned)(R * K + C) * 2u; voffB[i] = (unsigned)(Rb * K + C) * 2u; }
    const size_t kstep = (size_t)(BK * 2);
    const size_t hstep = (size_t)HALF * K * 2;
    const size_t tstep = 2 * hstep;
    const unsigned ldsw = (unsigned)wid * 1024u;
    const int aoff = lds_byte(wr * 64 + fr, fq * 8), boff = lds_byte(wc * 32 + fr, fq * 8);
#define PG8_SA(b, h) (((b) * 2 + (h)) * HTB)
#define PG8_SB(b, h) ((4 + (b) * 2 + (h)) * HTB)
#define PG8_STAGE(bufoff, gbase, voff) do { _Pragma("unroll") for (int _i = 0; _i < 2; ++_i) \
        __builtin_amdgcn_global_load_lds((const unsigned*)((const char*)(gbase) + (voff)[_i]), (PG8_LAS unsigned*)(lds + (bufoff) + ldsw + _i * 8192), 16, 0, 0); } while (0)
#define PG8_LDA(dst, b, h) do { _Pragma("unroll") for (int m = 0; m < 4; ++m) _Pragma("unroll") for (int k = 0; k < 2; ++k) dst[m][k] = *(const PG8_LAS bf16x8*)(lds + PG8_SA(b, h) + aoff + m * 2048 + k * 1024); } while (0)
#define PG8_LDB(dst, b, h) do { _Pragma("unroll") for (int n = 0; n < 2; ++n) _Pragma("unroll") for (int k = 0; k < 2; ++k) dst[n][k] = *(const PG8_LAS bf16x8*)(lds + PG8_SB(b, h) + boff + n * 2048 + k * 1024); } while (0)
#define PG8_MMA(ai, bj, At, Bt) do { __builtin_amdgcn_s_setprio(1); _Pragma("unroll") for (int m = 0; m < 4; ++m) _Pragma("unroll") for (int n = 0; n < 2; ++n) _Pragma("unroll") for (int k = 0; k < 2; ++k) \
        acc[ai][bj][m][n] = __builtin_amdgcn_mfma_f32_16x16x32_bf16(Bt[n][k], At[m][k], acc[ai][bj][m][n], 0, 0, 0); __builtin_amdgcn_s_setprio(0); } while (0)
#define PG8_WAIT_V(n) asm volatile("s_waitcnt vmcnt(" #n ")" ::: "memory")
#define PG8_WAIT_L(n) asm volatile("s_waitcnt lgkmcnt(" #n ")" ::: "memory")
#define PG8_BAR __builtin_amdgcn_s_barrier()
#define PG8_SCHED __builtin_amdgcn_sched_barrier(0)
    Unit cur, nxt; int ui = 0;
    if (!S.next(0, cur)) return;
    f32x4 acc[2][2][4][2];
#pragma unroll
    for (int a = 0; a < 2; ++a)
#pragma unroll
        for (int b = 0; b < 2; ++b)
#pragma unroll
            for (int m = 0; m < 4; ++m)
#pragma unroll
                for (int n = 0; n < 2; ++n) acc[a][b][m][n] = (f32x4){0.f, 0.f, 0.f, 0.f};
    bf16x8 At[4][2], B0[2][2], B1[2][2];
    const char* cA = (const char*)g.A + (size_t)cur.pm * tstep; const char* cB = (const char*)g.Bt + (size_t)cur.pn * tstep;
    S.a_ready(cur);
    if constexpr (SP2) {
        PG8_STAGE(PG8_SB(0, 0), cB, voffB); PG8_STAGE(PG8_SB(0, 1), cB + hstep, voffB); PG8_STAGE(PG8_SA(0, 0), cA, voffA); PG8_STAGE(PG8_SA(0, 1), cA + hstep, voffA);
        if (wr == 1) PG8_BAR;
        PG8_WAIT_V(2); PG8_BAR;
        PG8_STAGE(PG8_SB(1, 0), cB + kstep, voffB); PG8_STAGE(PG8_SA(1, 0), cA + kstep, voffA); PG8_STAGE(PG8_SB(1, 1), cB + hstep + kstep, voffB);
        PG8_WAIT_V(6); PG8_BAR;
    } else {
        PG8_STAGE(PG8_SB(0, 0), cB, voffB); PG8_STAGE(PG8_SA(0, 0), cA, voffA); PG8_STAGE(PG8_SB(0, 1), cB + hstep, voffB); PG8_STAGE(PG8_SA(0, 1), cA + hstep, voffA);
        if (wr == 1) PG8_BAR;
        PG8_WAIT_V(4); PG8_BAR;
        PG8_STAGE(PG8_SB(1, 0), cB + kstep, voffB); PG8_STAGE(PG8_SA(1, 0), cA + kstep, voffA); PG8_STAGE(PG8_SB(1, 1), cB + hstep + kstep, voffB);
        PG8_WAIT_V(6); PG8_BAR;
    }
    for (;;) {
        const bool has_next = S.next(ui + 1, nxt);
        const char* nA = has_next ? (const char*)g.A + (size_t)nxt.pm * tstep : cA; const char* nB = has_next ? (const char*)g.Bt + (size_t)nxt.pn * tstep : cB;
        for (int t = 0; t < nt; t += 2) {
            const bool last = (t == nt - 2);
            const char* a1 = cA + (size_t)(t + 1) * kstep;
            const char* a2 = last ? nA : cA + (size_t)(t + 2) * kstep; const char* b2 = last ? nB : cB + (size_t)(t + 2) * kstep;
            const char* a3 = a2 + kstep; const char* b3 = b2 + kstep;
            if (last && has_next) S.a_ready(nxt);
            if constexpr (SP2) {
            PG8_LDB(B0, 0, 0); PG8_LDB(B1, 0, 1); PG8_SCHED; PG8_LDA(At, 0, 0); PG8_STAGE(PG8_SA(1, 1), a1 + hstep, voffA);
            PG8_WAIT_V(8); PG8_WAIT_L(0); PG8_BAR; PG8_MMA(0, 0, At, B0); PG8_MMA(0, 1, At, B1); PG8_BAR; PG8_SCHED;
            PG8_LDA(At, 0, 1); PG8_STAGE(PG8_SB(0, 0), b2, voffB); PG8_STAGE(PG8_SB(0, 1), b2 + hstep, voffB); PG8_STAGE(PG8_SA(0, 0), a2, voffA);
            PG8_WAIT_V(8); PG8_WAIT_L(0); PG8_BAR; PG8_MMA(1, 0, At, B0); PG8_MMA(1, 1, At, B1); PG8_BAR; PG8_SCHED;
            PG8_LDB(B0, 1, 0); PG8_LDB(B1, 1, 1); PG8_SCHED; PG8_LDA(At, 1, 0); PG8_STAGE(PG8_SA(0, 1), a2 + hstep, voffA);
            PG8_WAIT_V(8); PG8_WAIT_L(0); PG8_BAR; PG8_MMA(0, 0, At, B0); PG8_MMA(0, 1, At, B1); PG8_BAR; PG8_SCHED;
            PG8_LDA(At, 1, 1); PG8_STAGE(PG8_SB(1, 0), b3, voffB); PG8_STAGE(PG8_SB(1, 1), b3 + hstep, voffB); PG8_STAGE(PG8_SA(1, 0), a3, voffA);
            PG8_WAIT_V(8); PG8_WAIT_L(0); PG8_BAR; PG8_MMA(1, 0, At, B0); PG8_MMA(1, 1, At, B1); PG8_BAR; PG8_SCHED;
            } else {
            PG8_LDB(B0, 0, 0); PG8_SCHED; PG8_LDA(At, 0, 0); PG8_STAGE(PG8_SA(1, 1), a1 + hstep, voffA);
            PG8_WAIT_L(8); PG8_BAR; PG8_WAIT_L(0); PG8_MMA(0, 0, At, B0); PG8_BAR; PG8_SCHED;
            PG8_LDB(B1, 0, 1); PG8_STAGE(PG8_SB(0, 0), b2, voffB);
            PG8_BAR; PG8_WAIT_L(0); PG8_MMA(0, 1, At, B1); PG8_BAR;
            PG8_LDA(At, 0, 1); PG8_STAGE(PG8_SA(0, 0), a2, voffA);
            PG8_BAR; PG8_WAIT_L(0); PG8_MMA(1, 0, At, B0); PG8_BAR; PG8_SCHED;
            PG8_STAGE(PG8_SB(0, 1), b2 + hstep, voffB);
            PG8_WAIT_V(6); PG8_BAR; PG8_MMA(1, 1, At, B1); PG8_BAR;
            PG8_LDB(B0, 1, 0); PG8_SCHED; PG8_LDA(At, 1, 0); PG8_STAGE(PG8_SA(0, 1), a2 + hstep, voffA);
            PG8_WAIT_L(8); PG8_BAR; PG8_WAIT_L(0); PG8_MMA(0, 0, At, B0); PG8_BAR; PG8_SCHED;
            PG8_LDB(B1, 1, 1); PG8_STAGE(PG8_SB(1, 0), b3, voffB);
            PG8_BAR; PG8_WAIT_L(0); PG8_MMA(0, 1, At, B1); PG8_BAR;
            PG8_LDA(At, 1, 1); PG8_STAGE(PG8_SA(1, 0), a3, voffA);
            PG8_BAR; PG8_WAIT_L(0); PG8_MMA(1, 0, At, B0); PG8_BAR; PG8_SCHED;
            PG8_STAGE(PG8_SB(1, 1), b3 + hstep, voffB);
            PG8_WAIT_V(6); PG8_BAR; PG8_MMA(1, 1, At, B1); PG8_BAR;
            }
        }
        if constexpr (ALIGN_EPI) { if (wr == 0) PG8_BAR; }
        if constexpr (!Epi::AFTER_DRAIN) { E(acc, cur, wr, wc, fr, fq); S.done(cur); }
        if (!has_next) break;
#pragma unroll
        for (int a = 0; a < 2; ++a)
#pragma unroll
            for (int b = 0; b < 2; ++b)
#pragma unroll
                for (int m = 0; m < 4; ++m)
#pragma unroll
                    for (int n = 0; n < 2; ++n) acc[a][b][m][n] = (f32x4){0.f, 0.f, 0.f, 0.f};
        cur = nxt; cA = nA; cB = nB; ++ui;
        if constexpr (ALIGN_EPI) { if (wr == 1) PG8_BAR; }
    }
    PG8_WAIT_V(0);
    if constexpr (!ALIGN_EPI) { if (wr == 0) PG8_BAR; }
    PG8_BAR;
    if constexpr (Epi::AFTER_DRAIN) { E.fused(acc, cur, wr, wc, fr, fq, lds, wid, lane); S.done(cur); }
#undef PG8_SA
#undef PG8_SB
#undef PG8_STAGE
#undef PG8_LDA
#undef PG8_LDB
#undef PG8_MMA
#undef PG8_WAIT_V
#undef PG8_WAIT_L
#undef PG8_BAR
#undef PG8_SCHED
}
}

#define GAS __attribute__((address_space(1)))
#define LAS __attribute__((address_space(3)))
typedef unsigned short bf16;
typedef unsigned u32x4 __attribute__((ext_vector_type(4)));
typedef unsigned u32x2 __attribute__((ext_vector_type(2)));
typedef float f32x4 __attribute__((ext_vector_type(4)));
typedef float f32x2 __attribute__((ext_vector_type(2)));
typedef short bf16x8_t __attribute__((ext_vector_type(8)));

constexpr int NBATCH = 4, SEQ = 2048, TOK = NBATCH * SEQ, DM = 2048, DEPTH = 4;
constexpr int NIN = 16592, NINP = 16640;
constexpr int C_GQKV = 0, C_GZ = 3072, C_GB = 4096, C_GA = 4104, C_RF = 4112, C_RZ = 7376, C_SU = 8400, C_SZ = 9424, C_GATE = 10448;
constexpr int NWAVES = 8, NTHREADS = 512;
constexpr int LDS_BYTES = 147456;
constexpr int PH_PER_LAYER = 6, NPHASES = 2 + DEPTH * PH_PER_LAYER;

constexpr size_t MiB = 1u << 20;
constexpr size_t WS_WIN = 0, WS_WGLU = 260 * MiB, WS_WBR = 268 * MiB, WS_WOUT = 316 * MiB, WS_XN = 348 * MiB, WS_PROJ = 380 * MiB;
constexpr size_t WS_GQ = 640 * MiB, WS_GK = 672 * MiB, WS_GV = 704 * MiB, WS_GEG = 736 * MiB, WS_GBE = 737 * MiB, WS_GO = 738 * MiB;
constexpr size_t WS_RR = 770 * MiB, WS_RW = 802 * MiB, WS_RK = 834 * MiB, WS_RV = 866 * MiB, WS_RKK = 898 * MiB, WS_RKA = 930 * MiB, WS_RBON = 962 * MiB, WS_RY = 963 * MiB;
constexpr size_t WS_SY = 995 * MiB, WS_OBR = 1011 * MiB, WS_ACCF = 1059 * MiB, WS_MRG = 1123 * MiB, WS_CTL = 1155 * MiB, WS_LORA = 1156 * MiB, WS_END = 1158 * MiB;
constexpr size_t CTL_SS = 65536, CTL_ZERO_BYTES = CTL_SS + (size_t)DEPTH * TOK * 8;
constexpr int MISC_OFF = 147392;
static_assert((size_t)DEPTH * NINP * DM * 2 == 260 * MiB && (size_t)TOK * NINP * 2 == 260 * MiB, "ws map");

__device__ __forceinline__ unsigned f2bf(float f) { unsigned u = __builtin_bit_cast(unsigned, f); return (u + 0x7fffu + ((u >> 16) & 1u)) >> 16; }
__device__ __forceinline__ unsigned pk2(float lo, float hi) { return f2bf(lo) | (f2bf(hi) << 16); }
__device__ __forceinline__ float bflo(unsigned w) { return __builtin_bit_cast(float, w << 16); }
__device__ __forceinline__ float bfhi(unsigned w) { return __builtin_bit_cast(float, w & 0xffff0000u); }
__device__ __forceinline__ float bf1(bf16 h) { return __builtin_bit_cast(float, (unsigned)h << 16); }
__device__ __forceinline__ float sigmoidf_(float x) { return 1.f / (1.f + __expf(-x)); }
__device__ __forceinline__ float siluf_(float x) { return x / (1.f + __expf(-x)); }
__device__ __forceinline__ float softplusf_(float x) { return x > 20.f ? x : log1pf(expf(x)); }
__device__ __forceinline__ float gelu_tanh(float y) { const float t = 0.7978845608028654f * (y + 0.044715f * y * y * y); const float th = 1.f - 2.f / (1.f + __expf(2.f * t)); return 0.5f * y * (1.f + th); }
template <int CTRL> __device__ __forceinline__ float dppf(float v) { return __builtin_bit_cast(float, __builtin_amdgcn_update_dpp(0, __builtin_bit_cast(int, v), CTRL, 0xF, 0xF, true)); }
__device__ __forceinline__ float allred8(float v) { v += dppf<0xB1>(v); v += dppf<0x4E>(v); v += dppf<0x141>(v); return v; }
__device__ __forceinline__ float allred16(float v) { v = allred8(v); v += dppf<0x140>(v); return v; }
__device__ __forceinline__ float wave_sum(float v) {
#pragma unroll
    for (int o = 1; o < 64; o <<= 1) v += __shfl_xor(v, o);
    return v;
}
__device__ __forceinline__ void unpack8(const u32x4 w, float (&f)[8]) { f[0] = bflo(w.x); f[1] = bfhi(w.x); f[2] = bflo(w.y); f[3] = bfhi(w.y); f[4] = bflo(w.z); f[5] = bfhi(w.z); f[6] = bflo(w.w); f[7] = bfhi(w.w); }
__device__ __forceinline__ u32x4 pack8(const float (&f)[8]) { u32x4 w; w.x = pk2(f[0], f[1]); w.y = pk2(f[2], f[3]); w.z = pk2(f[4], f[5]); w.w = pk2(f[6], f[7]); return w; }

namespace pg8 {
struct EpiGlu {
    static constexpr bool PERM = true, AFTER_DRAIN = false;
    const bf16* Y1; const bf16* PROJ; const float* bias; bf16* O;
    __device__ __forceinline__ void operator()(const f32x4 (&acc)[2][2][4][2], const Unit& u, int wr, int wc, int fr, int fq) const {
        int row0 = u.pm * BM + wr * 64 + fr, col0 = u.pn * BM + wc * 32 + 8 * fq;
        asm volatile("" : "+v"(row0), "+v"(col0));
#pragma unroll
        for (int bj = 0; bj < 2; ++bj) {
            const int col = col0 + bj * HALF;
            const f32x4 b0 = *(const f32x4*)(bias + col), b1 = *(const f32x4*)(bias + col + 4);
#pragma unroll
            for (int ai = 0; ai < 2; ++ai)
#pragma unroll
                for (int m = 0; m < 4; ++m) {
                    const size_t row = (size_t)(row0 + ai * HALF + m * 16);
                    const u32x4 y8 = *(const u32x4*)(Y1 + row * 1024 + col), z8 = *(const u32x4*)(PROJ + row * NINP + C_SZ + col);
                    float y[8], z[8], o[8]; unpack8(y8, y); unpack8(z8, z);
                    const f32x4 v0 = acc[ai][bj][m][0] + b0, v1 = acc[ai][bj][m][1] + b1;
                    const float a[8] = {v0[0], v0[1], v0[2], v0[3], v1[0], v1[1], v1[2], v1[3]};
#pragma unroll
                    for (int e = 0; e < 8; ++e) o[e] = y[e] * sigmoidf_(a[e]) * siluf_(z[e]);
                    *(u32x4*)(O + row * 1024 + col) = pack8(o);
                    asm volatile("" ::: "memory");
                }
        }
    }
};
struct EpiBranch {
    static constexpr bool PERM = true, AFTER_DRAIN = false;
    const bf16* PROJ; const float* gate_b; bf16* ACC; bf16* MRG;
    __device__ __forceinline__ void operator()(const f32x4 (&acc)[2][2][4][2], const Unit& u, int wr, int wc, int fr, int fq) const {
        const int br = u.pm >> 5, pm = u.pm & 31, pn = u.pn & 7;
        int row0 = pm * BM + wr * 64 + fr, col0 = pn * BM + wc * 32 + 8 * fq;
        asm volatile("" : "+v"(row0), "+v"(col0));
        bf16* dst = br < 2 ? ACC : MRG;
#pragma unroll
        for (int bj = 0; bj < 2; ++bj) {
            const int col = col0 + bj * HALF;
            const f32x4 g0 = *(const f32x4*)(gate_b + br * DM + col), g1 = *(const f32x4*)(gate_b + br * DM + col + 4);
            const float gb[8] = {g0[0], g0[1], g0[2], g0[3], g1[0], g1[1], g1[2], g1[3]};
#pragma unroll
            for (int ai = 0; ai < 2; ++ai)
#pragma unroll
                for (int m = 0; m < 4; ++m) {
                    const size_t row = (size_t)(row0 + ai * HALF + m * 16);
                    const u32x4 l8 = *(const u32x4*)(PROJ + row * NINP + C_GATE + br * DM + col);
                    float gl[8], o[8]; unpack8(l8, gl);
                    const f32x4 v0 = acc[ai][bj][m][0], v1 = acc[ai][bj][m][1];
                    const float a[8] = {v0[0], v0[1], v0[2], v0[3], v1[0], v1[1], v1[2], v1[3]};
#pragma unroll
                    for (int e = 0; e < 8; ++e) o[e] = sigmoidf_(gl[e] + gb[e]) * a[e];
                    if (br > 0) { float p[8]; unpack8(*(const u32x4*)(ACC + row * DM + col), p);
#pragma unroll
                        for (int e = 0; e < 8; ++e) o[e] += p[e]; }
                    *(u32x4*)(dst + row * DM + col) = pack8(o);
                    asm volatile("" ::: "memory");
                }
        }
    }
};
struct EpiResid {
    static constexpr bool PERM = true, AFTER_DRAIN = false;
    const float* base; float* out; bf16* xn; const float* nw; unsigned long long* ss;
    __device__ __forceinline__ void operator()(const f32x4 (&acc)[2][2][4][2], const Unit& u, int wr, int wc, int fr, int fq) const {
        int row0 = u.pm * BM + wr * 64 + fr, col0 = u.pn * BM + wc * 32 + 8 * fq;
        asm volatile("" : "+v"(row0), "+v"(col0));
#pragma unroll
        for (int ai = 0; ai < 2; ++ai)
#pragma unroll
            for (int m = 0; m < 4; ++m) {
                const int row = row0 + ai * HALF + m * 16; float sq = 0.f;
#pragma unroll
                for (int bj = 0; bj < 2; ++bj) {
                    const size_t off = (size_t)row * DM + col0 + bj * HALF;
                    const f32x4 o0 = *(const f32x4*)(base + off) + acc[ai][bj][m][0], o1 = *(const f32x4*)(base + off + 4) + acc[ai][bj][m][1];
                    *(f32x4*)(out + off) = o0; *(f32x4*)(out + off + 4) = o1;
                    if (xn) { const f32x4 w0 = *(const f32x4*)(nw + col0 + bj * HALF), w1 = *(const f32x4*)(nw + col0 + bj * HALF + 4);
                        sq += (o0.x * o0.x + o0.y * o0.y) + (o0.z * o0.z + o0.w * o0.w) + (o1.x * o1.x + o1.y * o1.y) + (o1.z * o1.z + o1.w * o1.w);
                        u32x4 p; p.x = pk2(o0.x * w0.x, o0.y * w0.y); p.y = pk2(o0.z * w0.z, o0.w * w0.w); p.z = pk2(o1.x * w1.x, o1.y * w1.y); p.w = pk2(o1.z * w1.z, o1.w * w1.w);
                        *(u32x4*)(xn + off) = p; }
                }
                if (xn) { sq += __shfl_xor(sq, 16); sq += __shfl_xor(sq, 32); if (fq == 0) atomicAdd(ss + row, (unsigned long long)(sq * 65536.f + 0.5f)); }
                asm volatile("" ::: "memory");
            }
    }
};
struct EpiBf16Rs {
    static constexpr bool PERM = true, AFTER_DRAIN = false;
    bf16* O; int ldc; const unsigned long long* ss;
    __device__ __forceinline__ void operator()(const f32x4 (&acc)[2][2][4][2], const Unit& u, int wr, int wc, int fr, int fq) const {
        int row0 = u.pm * BM + wr * 64 + fr, col0 = u.pn * BM + wc * 32 + 8 * fq;
        asm volatile("" : "+v"(row0), "+v"(col0));
#pragma unroll
        for (int ai = 0; ai < 2; ++ai)
#pragma unroll
            for (int m = 0; m < 4; ++m) { const int row = row0 + ai * HALF + m * 16; const float rs = 1.f / sqrtf((float)ss[row] * (1.f / (65536.f * DM)) + 1e-6f);
                bf16* rowp = O + (size_t)row * ldc + col0;
#pragma unroll
                for (int bj = 0; bj < 2; ++bj) { const f32x4 v0 = acc[ai][bj][m][0] * rs, v1 = acc[ai][bj][m][1] * rs;
                    u32x4 w; w.x = cvt_pk_bf16(v0[0], v0[1]); w.y = cvt_pk_bf16(v0[2], v0[3]); w.z = cvt_pk_bf16(v1[0], v1[1]); w.w = cvt_pk_bf16(v1[2], v1[3]);
                    *(u32x4*)(rowp + bj * HALF) = w; } }
    }
};
struct BranchOrder {
    StaticOrder base;
    __device__ bool next(int i, Unit& u) const { Unit t; const int r = i / 3, br = i - 3 * r; if (!base.next(r, t)) return false; u.pm = br * 32 + t.pm; u.pn = br * 8 + t.pn; return true; }
    __device__ __forceinline__ void a_ready(const Unit&) const {}
    __device__ __forceinline__ void done(const Unit&) const {}
};
}

#define XB_TMO      128
#define XB_XCNT(j)  (256  + 64 * (j))
#define XB_XSUB(j)  (1280 + 64 * (j))
#define XB_XGEN(j)  (2304 + 64 * (j))
#define XB_TOP      3328
#define XB_TOPGEN   3392
#define XCD_BAR_WORDS 3456
#define XB_SPIN_CAP (1u << 18)

__device__ __forceinline__ unsigned xb_ld(unsigned* p)              { return __hip_atomic_load(p, __ATOMIC_RELAXED, __HIP_MEMORY_SCOPE_AGENT); }
__device__ __forceinline__ unsigned xb_add(unsigned* p, unsigned v) { return __hip_atomic_fetch_add(p, v, __ATOMIC_RELAXED, __HIP_MEMORY_SCOPE_AGENT); }
__device__ __forceinline__ unsigned xb_xcc_id() { return (unsigned)__builtin_amdgcn_s_getreg((3 << 11) | 20) & 0xFu; }
#define XB_SPIN(cond, bar) do { unsigned _sp = 0; while (cond) { __builtin_amdgcn_s_sleep(1); \
    if ((++_sp & 255u) == 0u) { if (xb_ld(&(bar)[XB_TMO])) break; if (_sp > XB_SPIN_CAP) { atomicAdd(&(bar)[XB_TMO], 1u); break; } } } } while (0)

struct XcdBarrier {
    unsigned* bar; unsigned x;
    volatile LAS unsigned* st;
};

__device__ __forceinline__ XcdBarrier xcd_barrier_post(unsigned* bar, volatile LAS unsigned* st) {
    XcdBarrier b; b.bar = bar; b.x = xb_xcc_id(); b.st = st;
    if (threadIdx.x == 0) (void)xb_add(&bar[XB_XCNT(b.x)], 1u);
    return b;
}
__device__ __forceinline__ void xcd_barrier_complete(unsigned* bar, unsigned x, unsigned& nloc, unsigned& nx) {
    const unsigned G = gridDim.x * gridDim.y * gridDim.z;
    unsigned sum, cnt, mine, sp = 0u;
    for (;;) {
        sum = 0u; cnt = 0u; mine = 0u;
#pragma unroll
        for (unsigned j = 0; j < 16; ++j) { const unsigned c = xb_ld(&bar[XB_XCNT(j)]); sum += c; cnt += (c > 0u) ? 1u : 0u; mine = (j == x) ? c : mine; }
        if (sum == G) break;
        __builtin_amdgcn_s_sleep(1);
        if ((++sp & 255u) == 0u) { if (xb_ld(&bar[XB_TMO])) break; if (sp > XB_SPIN_CAP) { atomicAdd(&bar[XB_TMO], 1u); break; } }
    }
    nloc = mine > 0u ? mine : 1u; nx = cnt > 0u ? cnt : 1u;
}

__device__ __forceinline__ void xcd_barrier(const XcdBarrier& b) {
    asm volatile("s_waitcnt vmcnt(0)" ::: "memory");
    __syncthreads();
    if (threadIdx.x == 0) {
        unsigned* bar = b.bar;
        __builtin_amdgcn_s_waitcnt(0);
        unsigned nloc = b.st[0], nx = b.st[1];
        if (nloc == 0u) { xcd_barrier_complete(bar, b.x, nloc, nx); b.st[0] = nloc; b.st[1] = nx; }
        const unsigned old = xb_add(&bar[XB_XSUB(b.x)], 1u);
        const unsigned gen = old / nloc;
        if (old + 1u == (gen + 1u) * nloc) {
            __builtin_amdgcn_fence(__ATOMIC_RELEASE, "agent");
            asm volatile("s_waitcnt vmcnt(0)" ::: "memory");
            const unsigned og = xb_add(&bar[XB_TOP], 1u);
            const unsigned tg = og / nx;
            if (og + 1u == (tg + 1u) * nx) xb_add(&bar[XB_TOPGEN], 1u);
            else XB_SPIN(xb_ld(&bar[XB_TOPGEN]) == tg, bar);
            __builtin_amdgcn_fence(__ATOMIC_ACQUIRE, "agent");
            xb_add(&bar[XB_XGEN(b.x)], 1u);
            asm volatile("s_waitcnt vmcnt(0)" ::: "memory");
        } else {
            XB_SPIN(xb_ld(&bar[XB_XGEN(b.x)]) == gen, bar);
            __builtin_amdgcn_fence(__ATOMIC_ACQUIRE, "agent");
            asm volatile("s_waitcnt vmcnt(0)" ::: "memory");
        }
    }
    __syncthreads();
}

struct Args { const float* in[31]; float* out; unsigned char* ws; int ph_lo, ph_hi; };
struct Ctx { int tid, lane, wave, vcu, G, gw, NGW; LAS unsigned char* lds; unsigned char* ws; };

__device__ __forceinline__ void transpose_item(const float* W, int K, int N, bf16* WT, LAS float* scr, int kb, int nb, int lane) {
    const int k0 = 64 * kb, n0 = 64 * nb, nq = 4 * (lane & 15), kr = lane >> 4; const bool nv = n0 + nq < N;
    f32x4 v[16];
#pragma unroll
    for (int i = 0; i < 16; ++i) v[i] = nv ? *(const f32x4*)(W + (size_t)(k0 + 4 * i + kr) * N + n0 + nq) : (f32x4){0.f, 0.f, 0.f, 0.f};
#pragma unroll
    for (int i = 0; i < 16; ++i) { LAS float* d = scr + (4 * i + kr) * 65 + nq; d[0] = v[i].x; d[1] = v[i].y; d[2] = v[i].z; d[3] = v[i].w; }
    asm volatile("s_waitcnt lgkmcnt(0)" ::: "memory");
    const int c = lane & 7;
#pragma unroll
    for (int j = 0; j < 8; ++j) { const int nn = (lane >> 3) + 8 * j; const LAS float* s = scr + (8 * c) * 65 + nn;
        u32x4 o; o.x = pk2(s[0 * 65], s[1 * 65]); o.y = pk2(s[2 * 65], s[3 * 65]); o.z = pk2(s[4 * 65], s[5 * 65]); o.w = pk2(s[6 * 65], s[7 * 65]);
        *(u32x4*)(WT + (size_t)(n0 + nn) * K + k0 + 8 * c) = o; }
    asm volatile("s_waitcnt lgkmcnt(0)" ::: "memory");
}

__device__ __forceinline__ void rms_row(const float* xrow, const float* w, bf16* obf, unsigned long long* ss, float* of32, int lane) {
    f32x4 v[8]; float s = 0.f;
#pragma unroll
    for (int j = 0; j < 8; ++j) { v[j] = *(const f32x4*)(xrow + 4 * lane + 256 * j); s += (v[j].x * v[j].x + v[j].y * v[j].y) + (v[j].z * v[j].z + v[j].w * v[j].w); }
    s = wave_sum(s);
    const float r = obf ? 1.f : 1.f / sqrtf(s * (1.f / DM) + 1e-6f);
#pragma unroll
    for (int j = 0; j < 8; ++j) { const f32x4 ww = *(const f32x4*)(w + 4 * lane + 256 * j); const f32x4 o = v[j] * r * ww;
        if (obf) { u32x2 p; p.x = pk2(o.x, o.y); p.y = pk2(o.z, o.w); *(u32x2*)(obf + 4 * lane + 256 * j) = p; }
        else *(f32x4*)(of32 + 4 * lane + 256 * j) = o; }
    if (obf && lane == 0) *ss = (unsigned long long)(s * 65536.f + 0.5f);
}

__device__ __forceinline__ void phase0(const Ctx& F, const Args& a) {
    LAS float* scr = (LAS float*)(F.lds + F.wave * 16640);
    constexpr int I_IN = 32 * 260, I_GLU = 16 * 16, I_BR = 16 * 32, I_OUT = 32 * 32, IL = I_IN + I_GLU + 3 * I_BR + I_OUT;
    bf16* WIN = (bf16*)(F.ws + WS_WIN); bf16* WGLU = (bf16*)(F.ws + WS_WGLU); bf16* WBR = (bf16*)(F.ws + WS_WBR); bf16* WOUT = (bf16*)(F.ws + WS_WOUT);
    for (int it = F.gw; it < DEPTH * IL; it += F.NGW) {
        const int l = it / IL; int r = it - l * IL;
        if (r < I_IN) { transpose_item(a.in[2] + (size_t)l * DM * NIN, DM, NIN, WIN + (size_t)l * NINP * DM, scr, r / 260, r % 260, F.lane); continue; } r -= I_IN;
        if (r < I_GLU) { transpose_item(a.in[25] + (size_t)l * 1024 * 1024, 1024, 1024, WGLU + (size_t)l * 1024 * 1024, scr, r / 16, r % 16, F.lane); continue; } r -= I_GLU;
        if (r < 3 * I_BR) { const int br = r / I_BR, r2 = r - br * I_BR;
            transpose_item(a.in[28] + (size_t)(l * 3 + br) * 1024 * DM, 1024, DM, WBR + (size_t)(l * 3 + br) * DM * 1024, scr, r2 / 32, r2 % 32, F.lane); continue; } r -= 3 * I_BR;
        transpose_item(a.in[29] + (size_t)l * DM * DM, DM, DM, WOUT + (size_t)l * DM * DM, scr, r / 32, r % 32, F.lane);
    }
    bf16* XN = (bf16*)(F.ws + WS_XN);
    {
        bf16* LT = (bf16*)(F.ws + WS_LORA);
        for (int it = F.gw * 64 + F.lane; it < DEPTH * 2 * 1024 * 12; it += F.NGW * 64) {
            const int kg = it % 12, n = (it / 12) & 1023, lw = it / (12 * 1024), l = lw >> 1, which = lw & 1;
            const float* src = (which ? a.in[11] : a.in[9]) + (size_t)l * 96 * 1024 + (size_t)(8 * kg) * 1024 + n;
            u32x4 o; o.x = pk2(src[0], src[1024]); o.y = pk2(src[2048], src[3072]); o.z = pk2(src[4096], src[5120]); o.w = pk2(src[6144], src[7168]);
            *(u32x4*)(LT + ((size_t)lw * 1024 + n) * 96 + 8 * kg) = o;
        }
    }
    unsigned long long* SS0 = (unsigned long long*)(F.ws + WS_CTL + CTL_SS);
    for (int m = F.gw; m < TOK; m += F.NGW) rms_row(a.in[0] + (size_t)m * DM, a.in[1], XN + (size_t)m * DM, SS0 + m, nullptr, F.lane);
}

__device__ __forceinline__ void prep_gdn(const Ctx& F, const Args& a, int l) {
    const bf16* PROJ = (const bf16*)(F.ws + WS_PROJ);
    float* GQ = (float*)(F.ws + WS_GQ); float* GK = (float*)(F.ws + WS_GK); float* GV = (float*)(F.ws + WS_GV); float* GEG = (float*)(F.ws + WS_GEG); float* GBE = (float*)(F.ws + WS_GBE);
    const float* cw = a.in[3] + (size_t)l * 4 * 3072;
    for (int it = F.gw; it < 2048; it += F.NGW) {
        const int h = it & 7, ch = (it >> 3) & 63, b = it >> 9;
        const int t0 = ch * 32; const int c = 2 * F.lane;
        float w[3][4][2], hist[3][3][2];
#pragma unroll
        for (int p = 0; p < 3; ++p)
#pragma unroll
            for (int j = 0; j < 4; ++j) { const f32x2 ww = *(const f32x2*)(cw + j * 3072 + p * 1024 + h * 128 + c); w[p][j][0] = ww.x; w[p][j][1] = ww.y; }
#pragma unroll
        for (int p = 0; p < 3; ++p)
#pragma unroll
            for (int j = 0; j < 3; ++j) { const int t = t0 - 3 + j; unsigned x = 0u;
                if (t >= 0) x = *(const unsigned*)(PROJ + (size_t)(b * SEQ + t) * NINP + C_GQKV + p * 1024 + h * 128 + c);
                hist[p][j][0] = bflo(x); hist[p][j][1] = bfhi(x); }
        const float alog = a.in[4][l * 8 + h], dtb = a.in[5][l * 8 + h]; const float aexp = expf(alog);
        for (int tt = 0; tt < 32; ++tt) {
            const size_t tok = (size_t)(b * SEQ + t0 + tt);
            float o[3][2];
#pragma unroll
            for (int p = 0; p < 3; ++p) {
                const unsigned x = *(const unsigned*)(PROJ + tok * NINP + C_GQKV + p * 1024 + h * 128 + c);
                const float x0 = bflo(x), x1 = bfhi(x);
                const float y0 = w[p][0][0] * hist[p][0][0] + w[p][1][0] * hist[p][1][0] + w[p][2][0] * hist[p][2][0] + w[p][3][0] * x0;
                const float y1 = w[p][0][1] * hist[p][0][1] + w[p][1][1] * hist[p][1][1] + w[p][2][1] * hist[p][2][1] + w[p][3][1] * x1;
                hist[p][0][0] = hist[p][1][0]; hist[p][1][0] = hist[p][2][0]; hist[p][2][0] = x0;
                hist[p][0][1] = hist[p][1][1]; hist[p][1][1] = hist[p][2][1]; hist[p][2][1] = x1;
                o[p][0] = siluf_(y0); o[p][1] = siluf_(y1);
            }
            const float sq = wave_sum(o[0][0] * o[0][0] + o[0][1] * o[0][1]), sk = wave_sum(o[1][0] * o[1][0] + o[1][1] * o[1][1]);
            const float rq = 0.08838834764831845f / sqrtf(sq + 1e-6f), rk = 1.f / sqrtf(sk + 1e-6f);
            const size_t off = tok * 1024 + h * 128 + c;
            *(unsigned*)((bf16*)GQ + off) = pk2(o[0][0] * rq, o[0][1] * rq);
            *(unsigned*)((bf16*)GK + off) = pk2(o[1][0] * rk, o[1][1] * rk);
            *(unsigned*)((bf16*)GV + off) = pk2(o[2][0], o[2][1]);
            if (F.lane == 0) {
                const float bl = bf1(PROJ[tok * NINP + C_GB + h]), al = bf1(PROJ[tok * NINP + C_GA + h]);
                GBE[tok * 8 + h] = sigmoidf_(bl);
                GEG[tok * 8 + h] = expf(-aexp * softplusf_(al + dtb));
            }
        }
    }
}

__device__ __forceinline__ float mix2(unsigned c, unsigned p, float mu0, float mu1, float& o1) {
    const float c0 = bflo(c), c1 = bfhi(c), p0 = bflo(p), p1 = bfhi(p);
    o1 = c1 + (p1 - c1) * mu1; return c0 + (p0 - c0) * mu0;
}
__device__ __forceinline__ void prep_rwkv(const Ctx& F, const Args& a, int l) {
    const bf16* PROJ = (const bf16*)(F.ws + WS_PROJ);
    float* RR = (float*)(F.ws + WS_RR); float* RW = (float*)(F.ws + WS_RW); float* RK = (float*)(F.ws + WS_RK); float* RV = (float*)(F.ws + WS_RV);
    float* RKK = (float*)(F.ws + WS_RKK); float* RKA = (float*)(F.ws + WS_RKA); float* RBON = (float*)(F.ws + WS_RBON);
    const float* mu = a.in[7] + (size_t)l * 3264; const float* w0 = a.in[8] + l * 1024; const float* wup = a.in[9] + (size_t)l * 96 * 1024;
    const float* a0 = a.in[10] + l * 1024; const float* aup = a.in[11] + (size_t)l * 96 * 1024; const float* kk_ = a.in[12] + l * 1024; const float* ka_ = a.in[13] + l * 1024; const float* rk_ = a.in[14] + l * 1024;
    constexpr int AROW = 104;
    LAS bf16* A1 = (LAS bf16*)F.lds; LAS bf16* A2 = A1 + 16 * AROW;
    LAS float* LW = (LAS float*)(F.lds + 8192); LAS float* LA = LW + 16 * 1024;
    const bf16* LTw = (const bf16*)(F.ws + WS_LORA) + (size_t)(2 * l) * 1024 * 96; const bf16* LTa = LTw + 1024 * 96;
    const int j = F.tid, c = 2 * j;
    const f32x2 mur = *(const f32x2*)(mu + c), muk = *(const f32x2*)(mu + 1024 + c), muv = *(const f32x2*)(mu + 2048 + c);
    const f32x2 w0v = *(const f32x2*)(w0 + c), a0v = *(const f32x2*)(a0 + c), kkv = *(const f32x2*)(kk_ + c), kav = *(const f32x2*)(ka_ + c), rkv = *(const f32x2*)(rk_ + c);
    for (int tile = F.vcu; tile < TOK / 16; tile += F.G) {
        __syncthreads();
        for (int e = F.tid; e < 16 * 192; e += NTHREADS) {
            const int tl = e / 192, i = e - tl * 192; const size_t tok = (size_t)tile * 16 + tl;
            const float cur = bf1(PROJ[tok * NINP + C_RF + 3072 + i]);
            const float prv = (tok & (SEQ - 1)) ? bf1(PROJ[(tok - 1) * NINP + C_RF + 3072 + i]) : 0.f;
            const float m = cur + (prv - cur) * mu[3072 + i];
            if (i < 96) A1[tl * AROW + i] = (bf16)f2bf(tanhf(m)); else A2[tl * AROW + i - 96] = (bf16)f2bf(m);
        }
        __syncthreads();
        {
            const int row = F.lane & 15, quad = F.lane >> 4;
            bf16x8_t fw[3], fa[3];
#pragma unroll
            for (int ks = 0; ks < 3; ++ks) { fw[ks] = *(const LAS bf16x8_t*)(A1 + row * AROW + 32 * ks + 8 * quad); fa[ks] = *(const LAS bf16x8_t*)(A2 + row * AROW + 32 * ks + 8 * quad); }
#pragma unroll 2
            for (int nt = 0; nt < 8; ++nt) {
                const int n = 128 * F.wave + 16 * nt + row;
                f32x4 aw = {0.f, 0.f, 0.f, 0.f}, aa = {0.f, 0.f, 0.f, 0.f};
#pragma unroll
                for (int ks = 0; ks < 3; ++ks) {
                    const bf16x8_t bw = *(const bf16x8_t*)(LTw + (size_t)n * 96 + 32 * ks + 8 * quad), ba = *(const bf16x8_t*)(LTa + (size_t)n * 96 + 32 * ks + 8 * quad);
                    aw = __builtin_amdgcn_mfma_f32_16x16x32_bf16(fw[ks], bw, aw, 0, 0, 0); aa = __builtin_amdgcn_mfma_f32_16x16x32_bf16(fa[ks], ba, aa, 0, 0, 0);
                }
#pragma unroll
                for (int r = 0; r < 4; ++r) { LW[(4 * quad + r) * 1024 + n] = aw[r]; LA[(4 * quad + r) * 1024 + n] = aa[r]; }
            }
        }
        __syncthreads();
#pragma unroll
        for (int tl = 0; tl < 16; ++tl) {
            const size_t tok = (size_t)tile * 16 + tl; const bool hp = (tok & (SEQ - 1)) != 0;
            const bf16* cp = PROJ + tok * NINP + C_RF + c; const bf16* pp = cp - NINP;
            const unsigned cr = *(const unsigned*)cp, ck = *(const unsigned*)(cp + 1024), cv = *(const unsigned*)(cp + 2048);
            const unsigned pr = hp ? *(const unsigned*)pp : 0u, pk = hp ? *(const unsigned*)(pp + 1024) : 0u, pv = hp ? *(const unsigned*)(pp + 2048) : 0u;
            float r1, k1, v1; const float r0 = mix2(cr, pr, mur.x, mur.y, r1), k0 = mix2(ck, pk, muk.x, muk.y, k1), v0 = mix2(cv, pv, muv.x, muv.y, v1);
            const f32x2 lw = *(const LAS f32x2*)(LW + tl * 1024 + c), la = *(const LAS f32x2*)(LA + tl * 1024 + c);
            const float wp0 = w0v.x + lw.x, wp1 = w0v.y + lw.y;
            const float d0 = expf(-expf(-softplusf_(-wp0) - 0.5f)), d1 = expf(-expf(-softplusf_(-wp1) - 0.5f));
            const float aa0 = sigmoidf_(a0v.x + la.x), aa1 = sigmoidf_(a0v.y + la.y);
            const float q0 = k0 * kkv.x, q1 = k1 * kkv.y;
            float ss = q0 * q0 + q1 * q1;
#pragma unroll
            for (int o = 1; o < 32; o <<= 1) ss += __shfl_xor(ss, o);
            const float rn = 1.f / sqrtf(ss + 1e-6f); const float n0 = q0 * rn, n1 = q1 * rn;
            const float km0 = k0 * (1.f + (aa0 - 1.f) * kav.x), km1 = k1 * (1.f + (aa1 - 1.f) * kav.y);
            float bo = r0 * km0 * rkv.x + r1 * km1 * rkv.y;
#pragma unroll
            for (int o = 1; o < 32; o <<= 1) bo += __shfl_xor(bo, o);
            const size_t off = tok * 1024 + c;
            *(unsigned*)((bf16*)RR + off) = pk2(r0, r1); *(f32x2*)(RW + off) = (f32x2){d0, d1}; *(unsigned*)((bf16*)RK + off) = pk2(km0, km1); *(unsigned*)((bf16*)RV + off) = pk2(v0, v1);
            *(f32x2*)(RKK + off) = (f32x2){-n0, -n1}; *(unsigned*)((bf16*)RKA + off) = pk2(n0 * aa0, n1 * aa1);
            if ((F.lane & 31) == 0) RBON[tok * 16 + (c >> 6)] = bo;
        }
    }
}

#ifndef SCM
#define SCM 7
#endif
#ifndef REPM
#define REPM 0
#endif
constexpr int CH = 32;
#define WFENCE() do { __builtin_amdgcn_fence(__ATOMIC_RELEASE, "wavefront"); __builtin_amdgcn_wave_barrier(); __builtin_amdgcn_fence(__ATOMIC_ACQUIRE, "wavefront"); } while (0)

struct GStep { f32x4 k0, k1, q0, q1; float v, eg, be; };
constexpr int G_BUF = 2 * CH * 128 + CH * 32 + 2 * CH;
__device__ __forceinline__ void gdn_lds(GStep& s, const LAS float* buf, int st, int rg, int colL) {
    s.k0 = *(const LAS f32x4*)(buf + st * 128 + rg * 4); s.k1 = *(const LAS f32x4*)(buf + st * 128 + 64 + rg * 4);
    s.q0 = *(const LAS f32x4*)(buf + CH * 128 + st * 128 + rg * 4); s.q1 = *(const LAS f32x4*)(buf + CH * 128 + st * 128 + 64 + rg * 4);
    s.v = buf[2 * CH * 128 + st * 32 + colL]; s.eg = buf[2 * CH * 128 + CH * 32 + st]; s.be = buf[2 * CH * 128 + CH * 32 + CH + st];
}
__device__ __forceinline__ void gdn_step(const GStep& s, f32x2 (&S)[4], LAS float* ob, bool wr) {
    const f32x2 k01 = s.k0.xy, k23 = s.k0.zw, k45 = s.k1.xy, k67 = s.k1.zw;
    const f32x2 a2 = (k01 * S[0] + k23 * S[1]) + (k45 * S[2] + k67 * S[3]);
    const float ks = allred16(a2.x + a2.y);
    const float cc = s.be * (s.v - s.eg * ks);
    S[0] = S[0] * s.eg + k01 * cc; S[1] = S[1] * s.eg + k23 * cc; S[2] = S[2] * s.eg + k45 * cc; S[3] = S[3] * s.eg + k67 * cc;
    const f32x2 o2 = (s.q0.xy * S[0] + s.q0.zw * S[1]) + (s.q1.xy * S[2] + s.q1.zw * S[3]);
    const float o = allred16(o2.x + o2.y);
    if (wr) *ob = o;
}
struct GStage { u32x4 k, q, v; float e; };
__device__ __forceinline__ void gdn_gload(GStage& g, const bf16* GK, const bf16* GQ, const bf16* GV, const float* GEG, const float* GBE, int t0, int tid) {
    { const int st = tid >> 4, f8 = tid & 15; g.k = *(const u32x4*)(GK + (size_t)(t0 + st) * 1024 + 8 * f8); g.q = *(const u32x4*)(GQ + (size_t)(t0 + st) * 1024 + 8 * f8); }
    { const int i = tid & 127; g.v = *(const u32x4*)(GV + (size_t)(t0 + (i >> 2)) * 1024 + 8 * (i & 3)); }
    { const int i = tid & 63; const float* p = (i < 32 ? GEG : GBE); g.e = p[(size_t)(t0 + (i & 31)) * 8]; }
}
__device__ __forceinline__ void st8(LAS float* d, const u32x4 w) { float f[8]; unpack8(w, f); *(LAS f32x4*)d = (f32x4){f[0], f[1], f[2], f[3]}; *(LAS f32x4*)(d + 4) = (f32x4){f[4], f[5], f[6], f[7]}; }
__device__ __forceinline__ void gdn_gstore(const GStage& g, LAS float* buf, int tid) {
    st8(buf + 8 * tid, g.k); st8(buf + CH * 128 + 8 * tid, g.q);
    if (tid < 128) st8(buf + 2 * CH * 128 + 8 * tid, g.v);
    else if (tid >= 256 && tid < 320) buf[2 * CH * 128 + CH * 32 + (tid - 256)] = g.e;
}
__device__ __forceinline__ void gdn_block(const Ctx& F, int vb) {
    const int bh = vb >> 2, qt = vb & 3, b = bh >> 3, h = bh & 7, colL = F.wave * 4 + (F.lane >> 4), rg = F.lane & 15;
    const size_t base = (size_t)b * SEQ;
    const bf16* GK = (const bf16*)(F.ws + WS_GK) + base * 1024 + h * 128; const bf16* GQ = (const bf16*)(F.ws + WS_GQ) + base * 1024 + h * 128;
    const bf16* GV = (const bf16*)(F.ws + WS_GV) + base * 1024 + h * 128 + qt * 32;
    const float* GEG = (const float*)(F.ws + WS_GEG) + base * 8 + h; const float* GBE = (const float*)(F.ws + WS_GBE) + base * 8 + h;
    float* GO = (float*)(F.ws + WS_GO) + base * 1024 + h * 128 + qt * 32;
    LAS float* lb = (LAS float*)F.lds; LAS float* obase = lb + 2 * G_BUF;
    f32x2 S[4] = {{0.f, 0.f}, {0.f, 0.f}, {0.f, 0.f}, {0.f, 0.f}};
    const bool wr = rg == 0;
    GStage g;
    gdn_gload(g, GK, GQ, GV, GEG, GBE, 0, F.tid); gdn_gstore(g, lb, F.tid);
    __syncthreads();
    for (int c = 0; c < SEQ / CH; ++c) {
        const LAS float* buf = lb + (c & 1) * G_BUF; LAS float* ob = obase + (c & 1) * (CH * 32) + colL;
        if (c + 1 < SEQ / CH) gdn_gload(g, GK, GQ, GV, GEG, GBE, (c + 1) * CH, F.tid);
        GStep R0, R1, R2, R3;
        gdn_lds(R0, buf, 0, rg, colL); gdn_lds(R1, buf, 1, rg, colL);
#pragma unroll 1
        for (int s = 0; s < CH; s += 4) {
            gdn_lds(R2, buf, s + 2, rg, colL); gdn_step(R0, S, ob + s * 32, wr);
            gdn_lds(R3, buf, s + 3, rg, colL); gdn_step(R1, S, ob + (s + 1) * 32, wr);
            gdn_lds(R0, buf, (s + 4) & (CH - 1), rg, colL); gdn_step(R2, S, ob + (s + 2) * 32, wr);
            gdn_lds(R1, buf, (s + 5) & (CH - 1), rg, colL); gdn_step(R3, S, ob + (s + 3) * 32, wr);
        }
        if (c + 1 < SEQ / CH) gdn_gstore(g, lb + ((c + 1) & 1) * G_BUF, F.tid);
        __syncthreads();
        if (F.tid < 256) *(f32x4*)(GO + (size_t)(c * CH + (F.tid >> 3)) * 1024 + 4 * (F.tid & 7)) = *(const LAS f32x4*)(obase + (c & 1) * (CH * 32) + 4 * F.tid);
    }
}

struct RStep { f32x4 w, n, a, k, r; float v; };
constexpr int R_BUF = CH * (5 * 64 + 32);
__device__ __forceinline__ void rwkv_lds(RStep& s, const LAS float* buf, int st, int cq, int rowL) {
    s.w = *(const LAS f32x4*)(buf + st * 64 + 4 * cq); s.n = *(const LAS f32x4*)(buf + CH * 64 + st * 64 + 4 * cq); s.a = *(const LAS f32x4*)(buf + 2 * CH * 64 + st * 64 + 4 * cq);
    s.k = *(const LAS f32x4*)(buf + 3 * CH * 64 + st * 64 + 4 * cq); s.r = *(const LAS f32x4*)(buf + 4 * CH * 64 + st * 64 + 4 * cq); s.v = buf[5 * CH * 64 + st * 32 + rowL];
}
__device__ __forceinline__ void rwkv_step(const RStep& s, f32x4& S, LAS float* ob, bool wr) {
    float sa = (S.x * s.n.x + S.y * s.n.y) + (S.z * s.n.z + S.w * s.n.w);
    sa = allred16(sa);
    S = S * s.w + sa * s.a + s.v * s.k;
    float y = (S.x * s.r.x + S.y * s.r.y) + (S.z * s.r.z + S.w * s.r.w);
    y = allred16(y);
    if (wr) *ob = y;
}
struct RStage { f32x4 x[2]; u32x4 y[3], v; };
__device__ __forceinline__ void rwkv_gload(RStage& g, const float* RW, const float* RN, const bf16* RA, const bf16* RKp, const bf16* RRp, const bf16* RV, int t0, int tid) {
    { const int st = tid >> 4, f4 = tid & 15; g.x[0] = *(const f32x4*)(RW + (size_t)(t0 + st) * 1024 + 4 * f4); g.x[1] = *(const f32x4*)(RN + (size_t)(t0 + st) * 1024 + 4 * f4); }
    { const int i = tid & 255; const size_t o = (size_t)(t0 + (i >> 3)) * 1024 + 8 * (i & 7); g.y[0] = *(const u32x4*)(RA + o); g.y[1] = *(const u32x4*)(RKp + o); g.y[2] = *(const u32x4*)(RRp + o); }
    { const int i = tid & 127; g.v = *(const u32x4*)(RV + (size_t)(t0 + (i >> 2)) * 1024 + 8 * (i & 3)); }
}
__device__ __forceinline__ void rwkv_gstore(const RStage& g, LAS float* buf, int tid) {
    *(LAS f32x4*)(buf + 4 * tid) = g.x[0]; *(LAS f32x4*)(buf + CH * 64 + 4 * tid) = g.x[1];
    if (tid < 256) { st8(buf + 2 * CH * 64 + 8 * tid, g.y[0]); st8(buf + 3 * CH * 64 + 8 * tid, g.y[1]); st8(buf + 4 * CH * 64 + 8 * tid, g.y[2]); }
    else if (tid < 384) st8(buf + 5 * CH * 64 + 8 * (tid - 256), g.v);
}
__device__ __forceinline__ void rwkv_block(const Ctx& F, int vb) {
    const int bh = vb >> 1, hf = vb & 1, b = bh >> 4, h = bh & 15, rowL = F.wave * 4 + (F.lane >> 4), cq = F.lane & 15;
    const size_t base = (size_t)b * SEQ * 1024 + h * 64;
    const float* RW = (const float*)(F.ws + WS_RW) + base; const float* RN = (const float*)(F.ws + WS_RKK) + base;
    const bf16* RA = (const bf16*)(F.ws + WS_RKA) + base; const bf16* RKp = (const bf16*)(F.ws + WS_RK) + base; const bf16* RRp = (const bf16*)(F.ws + WS_RR) + base;
    const bf16* RV = (const bf16*)(F.ws + WS_RV) + base + hf * 32;
    float* RY = (float*)(F.ws + WS_RY) + base + hf * 32;
    LAS float* lb = (LAS float*)F.lds; LAS float* obase = lb + 2 * R_BUF;
    f32x4 S = {0.f, 0.f, 0.f, 0.f};
    const bool wr = cq == 0;
    RStage g;
    rwkv_gload(g, RW, RN, RA, RKp, RRp, RV, 0, F.tid); rwkv_gstore(g, lb, F.tid);
    __syncthreads();
    for (int c = 0; c < SEQ / CH; ++c) {
        const LAS float* buf = lb + (c & 1) * R_BUF; LAS float* ob = obase + (c & 1) * (CH * 32) + rowL;
        if (c + 1 < SEQ / CH) rwkv_gload(g, RW, RN, RA, RKp, RRp, RV, (c + 1) * CH, F.tid);
        RStep R0, R1, R2, R3;
        rwkv_lds(R0, buf, 0, cq, rowL); rwkv_lds(R1, buf, 1, cq, rowL);
#pragma unroll 1
        for (int s = 0; s < CH; s += 4) {
            rwkv_lds(R2, buf, s + 2, cq, rowL); rwkv_step(R0, S, ob + s * 32, wr);
            rwkv_lds(R3, buf, s + 3, cq, rowL); rwkv_step(R1, S, ob + (s + 1) * 32, wr);
            rwkv_lds(R0, buf, (s + 4) & (CH - 1), cq, rowL); rwkv_step(R2, S, ob + (s + 2) * 32, wr);
            rwkv_lds(R1, buf, (s + 5) & (CH - 1), cq, rowL); rwkv_step(R3, S, ob + (s + 3) * 32, wr);
        }
        if (c + 1 < SEQ / CH) rwkv_gstore(g, lb + ((c + 1) & 1) * R_BUF, F.tid);
        __syncthreads();
        if (F.tid < 256) *(f32x4*)(RY + (size_t)(c * CH + (F.tid >> 3)) * 1024 + 4 * (F.tid & 7)) = *(const LAS f32x4*)(obase + (c & 1) * (CH * 32) + 4 * F.tid);
    }
}

constexpr int S5_SROW = 136;
constexpr int S5_WAVE_B = 16 * S5_SROW * 2 + 1024;
__device__ __forceinline__ void s5_block(const Ctx& F, const Args& a, int l, int it) {
    const int b = it >> 6, g = it & 63, p = F.lane, tl = F.lane >> 4, c = F.lane & 15, w = F.wave;
    const bf16* PROJ = (const bf16*)(F.ws + WS_PROJ); bf16* SY = (bf16*)(F.ws + WS_SY);
    LAS float* se = (LAS float*)F.lds;
    LAS unsigned char* wb = F.lds + 4096 + w * S5_WAVE_B;
    LAS bf16* sbuf = (LAS bf16*)wb; LAS float* uall = (LAS float*)(wb + 16 * S5_SROW * 2);
    const size_t gp = ((size_t)l * 64 + g) * 64 + p;
    const float dt = expf(a.in[19][l * 64 + g]); const float are = a.in[17][gp], aim = a.in[18][gp];
    const float mag = expf(are * dt), abr = mag * cosf(aim * dt), abi = mag * sinf(aim * dt);
    const float den = are * are + aim * aim, cr = ((abr - 1.f) * are + abi * aim) / den, ci = (abi * are - (abr - 1.f) * aim) / den;
    float Bre[16], Bim[16];
#pragma unroll
    for (int q = 0; q < 4; ++q) { const f32x4 br = *(const f32x4*)(a.in[20] + gp * 16 + 4 * q), bi = *(const f32x4*)(a.in[21] + gp * 16 + 4 * q);
#pragma unroll
        for (int e = 0; e < 4; ++e) { Bre[4 * q + e] = cr * br[e] - ci * bi[e]; Bim[4 * q + e] = cr * bi[e] + ci * br[e]; } }
    bf16x8_t Cf[4];
    { const size_t cb = (((size_t)l * 64 + g) * 16 + c) * 64;
#pragma unroll
      for (int m = 0; m < 4; ++m) { const int k0 = 32 * m + 8 * tl; const float* src = (k0 < 64 ? a.in[22] + cb + k0 : a.in[23] + cb + (k0 - 64)); const float sg = k0 < 64 ? 1.f : -1.f;
          const f32x4 x0 = *(const f32x4*)src, x1 = *(const f32x4*)(src + 4);
          u32x4 pk; pk.x = pk2(sg * x0.x, sg * x0.y); pk.y = pk2(sg * x0.z, sg * x0.w); pk.z = pk2(sg * x1.x, sg * x1.y); pk.w = pk2(sg * x1.z, sg * x1.w);
          Cf[m] = __builtin_bit_cast(bf16x8_t, pk); } }
    const float dsk = a.in[24][l * 1024 + g * 16 + c];
    const int tw = 256 * w;
    const bf16* up = PROJ + ((size_t)b * SEQ + tw) * NINP + C_SU + g * 16;
    float sr = 0.f, si = 0.f;
    {
        bf16 ucur = up[(size_t)tl * NINP + c], unxt = up[(size_t)(4 + tl) * NINP + c];
        for (int t = 0; t < 256; t += 4) {
            uall[F.lane] = bf1(ucur);
            WFENCE();
            const int tn = (t + 8 < 256) ? t + 8 : t;
            const bf16 unn = up[(size_t)(tn + tl) * NINP + c];
#pragma unroll
            for (int j = 0; j < 4; ++j) {
                float br = 0.f, bi = 0.f;
#pragma unroll
                for (int q = 0; q < 4; ++q) { const f32x4 u4 = *(const LAS f32x4*)(uall + j * 16 + 4 * q);
#pragma unroll
                    for (int e = 0; e < 4; ++e) { br += Bre[4 * q + e] * u4[e]; bi += Bim[4 * q + e] * u4[e]; } }
                const float nr = abr * sr - abi * si + br, ni = abr * si + abi * sr + bi; sr = nr; si = ni;
            }
            WFENCE();
            ucur = unxt; unxt = unn;
        }
    }
    se[w * 128 + p] = sr; se[w * 128 + 64 + p] = si;
    __syncthreads();
    {
        float pr = abr, pi = abi;
#pragma unroll
        for (int i = 0; i < 8; ++i) { const float nr = pr * pr - pi * pi, ni = 2.f * pr * pi; pr = nr; pi = ni; }
        sr = 0.f; si = 0.f;
        for (int j = 0; j < w; ++j) { const float er = se[j * 128 + p], ei = se[j * 128 + 64 + p]; const float nr = pr * sr - pi * si + er, ni = pr * si + pi * sr + ei; sr = nr; si = ni; }
    }
    {
        bf16 ucur = up[(size_t)tl * NINP + c], unxt = up[(size_t)(4 + tl) * NINP + c];
        for (int t = 0; t < 256; t += 16) {
#pragma unroll
            for (int sub = 0; sub < 4; ++sub) {
                uall[sub * 64 + F.lane] = bf1(ucur);
                WFENCE();
                const int tn = (t + 4 * sub + 8 < 256) ? t + 4 * sub + 8 : t + 4 * sub;
                const bf16 unn = up[(size_t)(tn + tl) * NINP + c];
#pragma unroll
                for (int j = 0; j < 4; ++j) {
                    float br = 0.f, bi = 0.f;
#pragma unroll
                    for (int q = 0; q < 4; ++q) { const f32x4 u4 = *(const LAS f32x4*)(uall + sub * 64 + j * 16 + 4 * q);
#pragma unroll
                        for (int e = 0; e < 4; ++e) { br += Bre[4 * q + e] * u4[e]; bi += Bim[4 * q + e] * u4[e]; } }
                    const float nr = abr * sr - abi * si + br, ni = abr * si + abi * sr + bi; sr = nr; si = ni;
                    sbuf[(sub * 4 + j) * S5_SROW + p] = (bf16)f2bf(sr); sbuf[(sub * 4 + j) * S5_SROW + 64 + p] = (bf16)f2bf(si);
                }
                ucur = unxt; unxt = unn;
            }
            WFENCE();
            f32x4 acc = {0.f, 0.f, 0.f, 0.f};
#pragma unroll
            for (int m = 0; m < 4; ++m) { const bf16x8_t af = *(const LAS bf16x8_t*)(sbuf + c * S5_SROW + 32 * m + 8 * tl);
                acc = __builtin_amdgcn_mfma_f32_16x16x32_bf16(af, Cf[m], acc, 0, 0, 0); }
#pragma unroll
            for (int r = 0; r < 4; ++r) { const int st = 4 * tl + r; const float y = acc[r] + dsk * uall[st * 16 + c];
                SY[((size_t)b * SEQ + tw + t + st) * 1024 + g * 16 + c] = (bf16)f2bf(gelu_tanh(y)); }
            WFENCE();
        }
    }
    __syncthreads();
}

__device__ __forceinline__ void scan_phase(const Ctx& F, const Args& a, int l) {
    for (int r5 = 0; r5 < 1 + ((REPM >> 9) & 1); ++r5) for (int vb = F.vcu; vb < 256; vb += F.G) s5_block(F, a, l, vb);
    for (int rg_ = 0; rg_ < 1 + ((REPM >> 10) & 1); ++rg_) for (int vb = F.vcu; vb < 256; vb += F.G) {
        if (vb < 128) { gdn_block(F, vb); if (REPM & 2048) gdn_block(F, vb); }
        else { rwkv_block(F, vb - 128); if (REPM & 4096) rwkv_block(F, vb - 128); }
    }
}

__device__ __forceinline__ void post_phase(const Ctx& F, const Args& a, int l, int gw, int ngw) {
    const bf16* PROJ = (const bf16*)(F.ws + WS_PROJ); bf16* OBR = (bf16*)(F.ws + WS_OBR);
    const float* GO = (const float*)(F.ws + WS_GO); const float* RY = (const float*)(F.ws + WS_RY); const float* RV = (const float*)(F.ws + WS_RV); const float* RBON = (const float*)(F.ws + WS_RBON);
    const int c0 = 16 * F.lane;
    float nw[16], lw[16], lb[16];
#pragma unroll
    for (int e = 0; e < 16; ++e) { nw[e] = a.in[6][l * 128 + (c0 & 127) + e]; lw[e] = a.in[15][l * 1024 + c0 + e]; lb[e] = a.in[16][l * 1024 + c0 + e]; }
    for (int tok = gw; tok < TOK; tok += ngw) {
        { float o[16];
#pragma unroll
          for (int q = 0; q < 4; ++q) { const f32x4 v = *(const f32x4*)(GO + (size_t)tok * 1024 + c0 + 4 * q); o[4 * q] = v.x; o[4 * q + 1] = v.y; o[4 * q + 2] = v.z; o[4 * q + 3] = v.w; }
          float ss = 0.f;
#pragma unroll
          for (int e = 0; e < 16; ++e) ss += o[e] * o[e];
          ss = allred8(ss);
          const float rs = 1.f / sqrtf(ss * (1.f / 128.f) + 1e-6f);
          float z[16]; { float z0[8], z1[8]; unpack8(*(const u32x4*)(PROJ + (size_t)tok * NINP + C_GZ + c0), z0); unpack8(*(const u32x4*)(PROJ + (size_t)tok * NINP + C_GZ + c0 + 8), z1);
#pragma unroll
              for (int e = 0; e < 8; ++e) { z[e] = z0[e]; z[8 + e] = z1[e]; } }
          float r0[8], r1[8];
#pragma unroll
          for (int e = 0; e < 8; ++e) { r0[e] = o[e] * rs * nw[e] * siluf_(z[e]); r1[e] = o[8 + e] * rs * nw[8 + e] * siluf_(z[8 + e]); }
          *(u32x4*)(OBR + (size_t)tok * 1024 + c0) = pack8(r0); *(u32x4*)(OBR + (size_t)tok * 1024 + c0 + 8) = pack8(r1); }
        { float y[16], v[16];
#pragma unroll
          for (int q = 0; q < 4; ++q) { const f32x4 t = *(const f32x4*)(RY + (size_t)tok * 1024 + c0 + 4 * q); y[4 * q] = t.x; y[4 * q + 1] = t.y; y[4 * q + 2] = t.z; y[4 * q + 3] = t.w;
          }
          { float va[8], vb[8]; unpack8(*(const u32x4*)((const bf16*)RV + (size_t)tok * 1024 + c0), va); unpack8(*(const u32x4*)((const bf16*)RV + (size_t)tok * 1024 + c0 + 8), vb);
#pragma unroll
              for (int e = 0; e < 8; ++e) { v[e] = va[e]; v[8 + e] = vb[e]; } }
          float s = 0.f;
#pragma unroll
          for (int e = 0; e < 16; ++e) s += y[e];
          s += dppf<0xB1>(s); s += dppf<0x4E>(s);
          const float mean = s * (1.f / 64.f); float q2 = 0.f;
#pragma unroll
          for (int e = 0; e < 16; ++e) { const float d = y[e] - mean; q2 += d * d; }
          q2 += dppf<0xB1>(q2); q2 += dppf<0x4E>(q2);
          const float rs = 1.f / sqrtf(q2 * (1.f / 64.f) + 64e-5f);
          const float bon = RBON[(size_t)tok * 16 + (c0 >> 6)];
          float z[16]; { float z0[8], z1[8]; unpack8(*(const u32x4*)(PROJ + (size_t)tok * NINP + C_RZ + c0), z0); unpack8(*(const u32x4*)(PROJ + (size_t)tok * NINP + C_RZ + c0 + 8), z1);
#pragma unroll
              for (int e = 0; e < 8; ++e) { z[e] = z0[e]; z[8 + e] = z1[e]; } }
          float r0[8], r1[8];
#pragma unroll
          for (int e = 0; e < 8; ++e) { r0[e] = ((y[e] - mean) * rs * lw[e] + lb[e] + bon * v[e]) * siluf_(z[e]); r1[e] = ((y[8 + e] - mean) * rs * lw[8 + e] + lb[8 + e] + bon * v[8 + e]) * siluf_(z[8 + e]); }
          bf16* ob = OBR + (size_t)TOK * 1024 + (size_t)tok * 1024 + c0;
          *(u32x4*)ob = pack8(r0); *(u32x4*)(ob + 8) = pack8(r1); }
    }
}

#ifndef PHM
#define PHM 0xFFFF
#endif
#ifndef REPM
#define REPM 0
#endif
__global__ void __launch_bounds__(NTHREADS, 2) hybrid_fwd(Args a) {
    extern __shared__ __attribute__((aligned(16))) unsigned char lds_raw[];
    Ctx F;
    F.lds = (LAS unsigned char*)lds_raw; F.ws = a.ws;
    F.G = gridDim.x; { const int bx = blockIdx.x; F.vcu = (F.G % 8 == 0) ? (bx % 8) * (F.G / 8) + bx / 8 : bx; }
    F.NGW = F.G * NWAVES;
    cg::grid_group grid = cg::this_grid();
    if (threadIdx.x < 8) ((volatile LAS unsigned*)(F.lds + MISC_OFF))[threadIdx.x] = 0u;
    __syncthreads();
    grid.sync();
    XcdBarrier bar = xcd_barrier_post((unsigned*)(a.ws + WS_CTL), (volatile LAS unsigned*)(F.lds + MISC_OFF));
    bf16* XN = (bf16*)(a.ws + WS_XN); bf16* PROJ = (bf16*)(a.ws + WS_PROJ);
    int rep = 0;
    for (int ph = a.ph_lo; ph < a.ph_hi; ) {
        { int t_ = threadIdx.x; asm volatile("" : "+v"(t_)); F.tid = t_; F.lane = t_ & 63; F.wave = __builtin_amdgcn_readfirstlane(t_ >> 6); F.gw = F.vcu * NWAVES + F.wave; }
        if (ph == NPHASES - 1) { for (int m = F.gw; m < TOK; m += F.NGW) rms_row(a.out + (size_t)m * DM, a.in[30], nullptr, nullptr, a.out + (size_t)m * DM, F.lane); }
        else if (ph == 0) { if (PHM & 1) phase0(F, a);
            if (REPM & 128) { if (!rep) { rep = 1; __syncthreads(); continue; } rep = 0; } }
        else {
            const int l = (ph - 1) / PH_PER_LAYER, k = (ph - 1) % PH_PER_LAYER;
            if (k == 0 && (PHM & 2)) {
                pg8::Gemm g{XN, (const bf16*)(a.ws + WS_WIN) + (size_t)l * NINP * DM, TOK, NINP, DM}; pg8::StaticOrder S; S.init(TOK, NINP, F.G, (int)blockIdx.x);
                pg8::EpiBf16Rs E{PROJ, NINP, (const unsigned long long*)(a.ws + WS_CTL + CTL_SS) + (size_t)l * TOK};
                pg8::gemm_phase<pg8::EpiBf16Rs, pg8::StaticOrder, true, true>(F.lds, g, S, E);
            } else if (k == 1) { prep_gdn(F, a, l); if (REPM & 8192) prep_gdn(F, a, l); prep_rwkv(F, a, l); if (REPM & 16384) prep_rwkv(F, a, l); }
            else if (k == 2) { if (PHM & 16) scan_phase(F, a, l); }
            else if (k == 3 && (PHM & 32)) {
                const bool split = F.G >= 192;
                if (!split) { post_phase(F, a, l, F.gw, F.NGW); __syncthreads(); }
                if (!split || (int)blockIdx.x < 128) {
                    pg8::Gemm g{(const bf16*)(a.ws + WS_SY), (const bf16*)(a.ws + WS_WGLU) + (size_t)l * 1024 * 1024, TOK, 1024, 1024}; pg8::StaticOrder S; S.init(TOK, 1024, F.G, (int)blockIdx.x);
                    pg8::EpiGlu E{(const bf16*)(a.ws + WS_SY), PROJ, a.in[26] + l * 1024, (bf16*)(a.ws + WS_OBR) + (size_t)2 * TOK * 1024};
                    pg8::gemm_phase<pg8::EpiGlu, pg8::StaticOrder, true, true>(F.lds, g, S, E);
                } else post_phase(F, a, l, ((int)blockIdx.x - 128) * NWAVES + F.wave, (F.G - 128) * NWAVES);
            } else if (k == 4 && (PHM & 64)) {
                pg8::Gemm g{(const bf16*)(a.ws + WS_OBR), (const bf16*)(a.ws + WS_WBR) + (size_t)l * 3 * DM * 1024, 3 * TOK, 3 * DM, 1024};
                pg8::BranchOrder S; S.base.init(TOK, DM, F.G, (int)blockIdx.x);
                pg8::EpiBranch E{PROJ, a.in[27] + (size_t)l * 3 * DM, (bf16*)(a.ws + WS_ACCF), (bf16*)(a.ws + WS_MRG)};
                pg8::gemm_phase<pg8::EpiBranch, pg8::BranchOrder, true, true>(F.lds, g, S, E);
            } else if (k == 5 && (PHM & 128)) {
                pg8::Gemm g{(const bf16*)(a.ws + WS_MRG), (const bf16*)(a.ws + WS_WOUT) + (size_t)l * DM * DM, TOK, DM, DM}; pg8::StaticOrder S; S.init(TOK, DM, F.G, (int)blockIdx.x);
                pg8::EpiResid E{l == 0 ? a.in[0] : a.out, a.out, l + 1 < DEPTH ? XN : nullptr, a.in[1] + (size_t)(l + 1 < DEPTH ? l + 1 : 0) * DM, (unsigned long long*)(a.ws + WS_CTL + CTL_SS) + (size_t)(l + 1 < DEPTH ? l + 1 : 0) * TOK};
                pg8::gemm_phase<pg8::EpiResid, pg8::StaticOrder, true, true>(F.lds, g, S, E);
            }
            if (REPM && !rep && ((REPM >> k) & 1)) { rep = 1; __syncthreads(); continue; }
            rep = 0;
        }
        if (ph + 1 < a.ph_hi) {
            xcd_barrier(bar);
            if (REPM & 256) xcd_barrier(bar);
        }
        ++ph;
    }
}

#ifndef MK_MULTI
#define MK_MULTI 0
#endif
extern "C" void kernel_launch(void* const* d_in, const int* in_sizes, int n_in, void* d_out, int out_size, void* d_ws, size_t ws_size, hipStream_t stream) {
    static int grid = 0;
    if (grid == 0) {
        if (n_in != 31 || out_size != TOK * DM || ws_size < WS_END) { fprintf(stderr, "kernel_launch: unexpected shapes (n_in %d out %d ws %zu)\n", n_in, out_size, ws_size); grid = -1; return; }
        int dev = 0, cus = 0, per_cu = 0;
        hipGetDevice(&dev); hipDeviceGetAttribute(&cus, hipDeviceAttributeMultiprocessorCount, dev);
        if (hipFuncSetAttribute((const void*)hybrid_fwd, hipFuncAttributeMaxDynamicSharedMemorySize, LDS_BYTES) != hipSuccess) { fprintf(stderr, "kernel_launch: hipFuncSetAttribute failed\n"); grid = -1; return; }
        if (hipOccupancyMaxActiveBlocksPerMultiprocessor(&per_cu, (const void*)hybrid_fwd, NTHREADS, LDS_BYTES) != hipSuccess || per_cu < 1) per_cu = 1;
        (void)hipGetLastError();
        grid = cus * per_cu;
        fprintf(stderr, "kernel_launch: grid %d (cus %d x %d)\n", grid, cus, per_cu);
    }
    if (grid < 0) return;
    if (hipMemsetAsync((char*)d_ws + WS_CTL, 0, CTL_ZERO_BYTES, stream) != hipSuccess) { fprintf(stderr, "kernel_launch: memset failed\n"); return; }
    Args a{};
    for (int i = 0; i < 31; ++i) a.in[i] = (const float*)d_in[i];
    a.out = (float*)d_out; a.ws = (unsigned char*)d_ws;
#if MK_MULTI
    for (int ph = 0; ph < NPHASES; ++ph) { a.ph_lo = ph; a.ph_hi = ph + 1; hipLaunchKernelGGL(hybrid_fwd, dim3(grid), dim3(NTHREADS), LDS_BYTES, stream, a); }
#else
    a.ph_lo = 0; a.ph_hi = NPHASES;
    void* args[] = {&a};
    const hipError_t e = hipLaunchCooperativeKernel((const void*)hybrid_fwd, dim3(grid), dim3(NTHREADS), args, LDS_BYTES, stream);
    if (e != hipSuccess) fprintf(stderr, "kernel_launch: cooperative launch failed: %s (grid %d)\n", hipGetErrorString(e), grid);
#endif
}
```

```cpp
#include <hip/hip_runtime.h>
#include <hip/hip_cooperative_groups.h>
#include <cstdio>
#include <cstdint>
namespace cg = cooperative_groups;
namespace pg8 {
#define PG8_LAS __attribute__((address_space(3)))
typedef unsigned short bf16_t;
typedef short bf16x8 __attribute__((ext_vector_type(8)));
typedef float f32x4 __attribute__((ext_vector_type(4)));
typedef unsigned u32x4 __attribute__((ext_vector_type(4)));
constexpr int BM = 256, BK = 64, HALF = 128, HTB = HALF * BK * 2  , STAGE_BYTES = 8 * HTB, NXCD = 8, WGM = 8;

__host__ __device__ __forceinline__ int lds_byte(int r, int c) { const int st = (r >> 4) * 2 + (c >> 5), rr = r & 15, cc = c & 31, ob = rr * 64 + cc * 2; return st * 1024 + (ob ^ (((ob >> 9) & 1) << 5)); }
__host__ __device__ __forceinline__ void stage_rc(int b, int& R, int& C) { const int st = b / 1024, sb = b % 1024, swz = sb ^ (((sb >> 9) & 1) << 5); R = (st >> 1) * 16 + swz / 64; C = (st & 1) * 32 + (swz % 64) / 2; }
__host__ __device__ __forceinline__ int perm32(int rho) { const int n = rho >> 4, i = rho & 15; return 8 * (i >> 2) + 4 * n + (i & 3); }

struct Unit { int pm, pn; };
struct Gemm { const bf16_t* A; const bf16_t* Bt; int M, N, K, ld; };

struct StaticOrder {
    int nM, nN, nwg, G, c;
    __host__ __device__ void init(int M, int N, int G_, int c_) { nM = M / BM; nN = N / BM; nwg = nM * nN; G = G_; c = c_; }
    __host__ __device__ bool next(int i, Unit& u) const {
        const long L = (long)i * G + c; if (L >= nwg) return false;
        int wgid = (int)L; { const int q = nwg / NXCD, r = nwg % NXCD, xcd = wgid % NXCD, off = wgid / NXCD; wgid = (xcd < r ? xcd * (q + 1) : r * (q + 1) + (xcd - r) * q) + off; }
        const int nig = WGM * nN, gid = wgid / nig, fm = gid * WGM, gsz = (nM - fm) < WGM ? (nM - fm) : WGM;
        u.pm = fm + ((wgid % nig) % gsz); u.pn = (wgid % nig) / gsz; return true;
    }
    __device__ __forceinline__ void a_ready(const Unit&) const {}
    __device__ __forceinline__ void done(const Unit&) const {}
};

__device__ __forceinline__ unsigned cvt_pk_bf16(float lo, float hi) { unsigned r; asm volatile("v_cvt_pk_bf16_f32 %0, %1, %2" : "=v"(r) : "v"(lo), "v"(hi)); return r; }
typedef float f32x2 __attribute__((ext_vector_type(2)));
__device__ __forceinline__ f32x2 gelu_pk(f32x2 v) {
    const f32x2 av = __builtin_elementwise_abs(v), d = av * 0.2316418882f + 1.0f;
    f32x2 t; t.x = __builtin_amdgcn_rcpf(d.x); t.y = __builtin_amdgcn_rcpf(d.y);
    f32x2 q = t * 0.5307027145f + (-0.7265760135f); q = q * t + 0.7107068705f; q = q * t + (-0.142248368f); q = q * t + 0.127414796f; q = q * t;
    const f32x2 s = (v * v) * (-0.72134752044f);
    f32x2 e; e.x = __builtin_amdgcn_exp2f(s.x); e.y = __builtin_amdgcn_exp2f(s.y);
    const f32x2 m = v * (q * e), r = v - m;
    f32x2 o; o.x = v.x < 0.f ? m.x : r.x; o.y = v.y < 0.f ? m.y : r.y; return o;
}

template <int ACT  > struct EpiBf16 {
    static constexpr bool PERM = true, AFTER_DRAIN = false; static_assert(ACT == 0 || ACT == 1, "EpiBf16: ACT is 0 (none) or 1 (gelu_pk)");
    bf16_t* O; int ldc; const float* bias; int split_cols; size_t split_stride; float scale0;
    __device__ __forceinline__ void operator()(const f32x4 (&acc)[2][2][4][2], const Unit& u, int wr, int wc, int fr, int fq) const {
        const int row0 = u.pm * BM + wr * 64 + fr; int colt = u.pn * BM; bf16_t* base = O;
        float sc = 1.f; if (split_cols) { const int t = colt / split_cols; base += (size_t)t * split_stride; colt -= t * split_cols; if (t == 0) sc = scale0; }
        const int col0 = colt + wc * 32 + 8 * fq, bcol0 = u.pn * BM + wc * 32 + 8 * fq;
        f32x4 bv[2][2];
#pragma unroll
        for (int bj = 0; bj < 2; ++bj)
#pragma unroll
            for (int n = 0; n < 2; ++n) bv[bj][n] = bias ? *(const f32x4*)(bias + bcol0 + bj * HALF + 4 * n) : (f32x4){0.f, 0.f, 0.f, 0.f};
#pragma unroll
        for (int ai = 0; ai < 2; ++ai)
#pragma unroll
            for (int m = 0; m < 4; ++m) { bf16_t* rowp = base + (size_t)(row0 + ai * HALF + m * 16) * ldc + col0;
#pragma unroll
                for (int bj = 0; bj < 2; ++bj) { f32x4 v0 = acc[ai][bj][m][0] + bv[bj][0], v1 = acc[ai][bj][m][1] + bv[bj][1];
                    if (ACT == 1) { f32x2 a = gelu_pk((f32x2){v0[0], v0[1]}), b = gelu_pk((f32x2){v0[2], v0[3]}), c = gelu_pk((f32x2){v1[0], v1[1]}), d = gelu_pk((f32x2){v1[2], v1[3]});
                        v0 = (f32x4){a.x, a.y, b.x, b.y}; v1 = (f32x4){c.x, c.y, d.x, d.y}; }
                    v0 = v0 * sc; v1 = v1 * sc; u32x4 w; w.x = cvt_pk_bf16(v0[0], v0[1]); w.y = cvt_pk_bf16(v0[2], v0[3]); w.z = cvt_pk_bf16(v1[0], v1[1]); w.w = cvt_pk_bf16(v1[2], v1[3]);
                    *(u32x4*)(rowp + bj * HALF) = w; } }
    }
};

template <class Epi, class Sched, bool ALIGN_EPI = false, bool SP2 = false>
__device__ __forceinline__ void gemm_phase(PG8_LAS unsigned char* lds, const Gemm g, const Sched& S, const Epi& E) {
    int tid_ = threadIdx.x; asm volatile("" : "+v"(tid_));
    const int tid = tid_, wid = __builtin_amdgcn_readfirstlane(tid >> 6), lane = tid & 63, wr = wid >> 2, wc = wid & 3, fr = lane & 15, fq = lane >> 4;
    const int K = g.K, nt = K / BK, LD = g.ld ? g.ld : g.K;
    unsigned voffA[2], voffB[2];
#pragma unroll
    for (int i = 0; i < 2; ++i) { int R, C; stage_rc(tid * 16 + i * 8192, R, C); const int Rb = Epi::PERM ? ((R & ~31) + perm32(R & 31)) : R;
        voffA[i] = (unsigned)(R * LD + C) * 2u; voffB[i] = (unsigned)(Rb * LD + C) * 2u; }
    const size_t kstep = (size_t)(BK * 2);
    const size_t hstep = (size_t)HALF * LD * 2;
    const size_t tstep = 2 * hstep;
    const unsigned ldsw = (unsigned)wid * 1024u;
    const int aoff = lds_byte(wr * 64 + fr, fq * 8), boff = lds_byte(wc * 32 + fr, fq * 8);
#define PG8_SA(b, h) (((b) * 2 + (h)) * HTB)
#define PG8_SB(b, h) ((4 + (b) * 2 + (h)) * HTB)
#define PG8_STAGE(bufoff, gbase, voff) do { _Pragma("unroll") for (int _i = 0; _i < 2; ++_i) \
        __builtin_amdgcn_global_load_lds((const unsigned*)((const char*)(gbase) + (voff)[_i]), (PG8_LAS unsigned*)(lds + (bufoff) + ldsw + _i * 8192), 16, 0, 0); } while (0)
#define PG8_LDA(dst, b, h) do { _Pragma("unroll") for (int m = 0; m < 4; ++m) _Pragma("unroll") for (int k = 0; k < 2; ++k) dst[m][k] = *(const PG8_LAS bf16x8*)(lds + PG8_SA(b, h) + aoff + m * 2048 + k * 1024); } while (0)
#define PG8_LDB(dst, b, h) do { _Pragma("unroll") for (int n = 0; n < 2; ++n) _Pragma("unroll") for (int k = 0; k < 2; ++k) dst[n][k] = *(const PG8_LAS bf16x8*)(lds + PG8_SB(b, h) + boff + n * 2048 + k * 1024); } while (0)
#define PG8_MMA(ai, bj, At, Bt) do { __builtin_amdgcn_s_setprio(1); _Pragma("unroll") for (int m = 0; m < 4; ++m) _Pragma("unroll") for (int n = 0; n < 2; ++n) _Pragma("unroll") for (int k = 0; k < 2; ++k) \
        acc[ai][bj][m][n] = __builtin_amdgcn_mfma_f32_16x16x32_bf16(Bt[n][k], At[m][k], acc[ai][bj][m][n], 0, 0, 0); __builtin_amdgcn_s_setprio(0); } while (0)
#define PG8_WAIT_V(n) asm volatile("s_waitcnt vmcnt(" #n ")" ::: "memory")
#define PG8_WAIT_L(n) asm volatile("s_waitcnt lgkmcnt(" #n ")" ::: "memory")
#define PG8_BAR __builtin_amdgcn_s_barrier()
#define PG8_SCHED __builtin_amdgcn_sched_barrier(0)
    Unit cur, nxt; int ui = 0;
    if (!S.next(0, cur)) return;
    f32x4 acc[2][2][4][2];
#pragma unroll
    for (int a = 0; a < 2; ++a)
#pragma unroll
        for (int b = 0; b < 2; ++b)
#pragma unroll
            for (int m = 0; m < 4; ++m)
#pragma unroll
                for (int n = 0; n < 2; ++n) acc[a][b][m][n] = (f32x4){0.f, 0.f, 0.f, 0.f};
    bf16x8 At[4][2], B0[2][2], B1[2][2];
    const char* cA = (const char*)g.A + (size_t)cur.pm * tstep; const char* cB = (const char*)g.Bt + (size_t)cur.pn * tstep;
    S.a_ready(cur);
    if constexpr (SP2) {
        PG8_STAGE(PG8_SB(0, 0), cB, voffB); PG8_STAGE(PG8_SB(0, 1), cB + hstep, voffB); PG8_STAGE(PG8_SA(0, 0), cA, voffA); PG8_STAGE(PG8_SA(0, 1), cA + hstep, voffA);
        if (wr == 1) PG8_BAR;
        PG8_WAIT_V(2); PG8_BAR;
        PG8_STAGE(PG8_SB(1, 0), cB + kstep, voffB); PG8_STAGE(PG8_SA(1, 0), cA + kstep, voffA); PG8_STAGE(PG8_SB(1, 1), cB + hstep + kstep, voffB);
        PG8_WAIT_V(6); PG8_BAR;
    } else {
        PG8_STAGE(PG8_SB(0, 0), cB, voffB); PG8_STAGE(PG8_SA(0, 0), cA, voffA); PG8_STAGE(PG8_SB(0, 1), cB + hstep, voffB); PG8_STAGE(PG8_SA(0, 1), cA + hstep, voffA);
        if (wr == 1) PG8_BAR;
        PG8_WAIT_V(4); PG8_BAR;
        PG8_STAGE(PG8_SB(1, 0), cB + kstep, voffB); PG8_STAGE(PG8_SA(1, 0), cA + kstep, voffA); PG8_STAGE(PG8_SB(1, 1), cB + hstep + kstep, voffB);
        PG8_WAIT_V(6); PG8_BAR;
    }
    for (;;) {
        const bool has_next = S.next(ui + 1, nxt);
        const char* nA = has_next ? (const char*)g.A + (size_t)nxt.pm * tstep : cA; const char* nB = has_next ? (const char*)g.Bt + (size_t)nxt.pn * tstep : cB;
        for (int t = 0; t < nt; t += 2) {
            const bool last = (t == nt - 2);
            const char* a1 = cA + (size_t)(t + 1) * kstep;
            const char* a2 = last ? nA : cA + (size_t)(t + 2) * kstep; const char* b2 = last ? nB : cB + (size_t)(t + 2) * kstep;
            const char* a3 = a2 + kstep; const char* b3 = b2 + kstep;
            if (last && has_next) S.a_ready(nxt);
            if constexpr (SP2) {
            PG8_LDB(B0, 0, 0); PG8_LDB(B1, 0, 1); PG8_SCHED; PG8_LDA(At, 0, 0); PG8_STAGE(PG8_SA(1, 1), a1 + hstep, voffA);
            PG8_WAIT_V(8); PG8_WAIT_L(0); PG8_BAR; PG8_MMA(0, 0, At, B0); PG8_MMA(0, 1, At, B1); PG8_BAR; PG8_SCHED;
            PG8_LDA(At, 0, 1); PG8_STAGE(PG8_SB(0, 0), b2, voffB); PG8_STAGE(PG8_SB(0, 1), b2 + hstep, voffB); PG8_STAGE(PG8_SA(0, 0), a2, voffA);
            PG8_WAIT_V(8); PG8_WAIT_L(0); PG8_BAR; PG8_MMA(1, 0, At, B0); PG8_MMA(1, 1, At, B1); PG8_BAR; PG8_SCHED;
            PG8_LDB(B0, 1, 0); PG8_LDB(B1, 1, 1); PG8_SCHED; PG8_LDA(At, 1, 0); PG8_STAGE(PG8_SA(0, 1), a2 + hstep, voffA);
            PG8_WAIT_V(8); PG8_WAIT_L(0); PG8_BAR; PG8_MMA(0, 0, At, B0); PG8_MMA(0, 1, At, B1); PG8_BAR; PG8_SCHED;
            PG8_LDA(At, 1, 1); PG8_STAGE(PG8_SB(1, 0), b3, voffB); PG8_STAGE(PG8_SB(1, 1), b3 + hstep, voffB); PG8_STAGE(PG8_SA(1, 0), a3, voffA);
            PG8_WAIT_V(8); PG8_WAIT_L(0); PG8_BAR; PG8_MMA(1, 0, At, B0); PG8_MMA(1, 1, At, B1); PG8_BAR; PG8_SCHED;
            } else {
            PG8_LDB(B0, 0, 0); PG8_SCHED; PG8_LDA(At, 0, 0); PG8_STAGE(PG8_SA(1, 1), a1 + hstep, voffA);
            PG8_WAIT_L(8); PG8_BAR; PG8_WAIT_L(0); PG8_MMA(0, 0, At, B0); PG8_BAR; PG8_SCHED;
            PG8_LDB(B1, 0, 1); PG8_STAGE(PG8_SB(0, 0), b2, voffB);
            PG8_BAR; PG8_WAIT_L(0); PG8_MMA(0, 1, At, B1); PG8_BAR;
            PG8_LDA(At, 0, 1); PG8_STAGE(PG8_SA(0, 0), a2, voffA);
            PG8_BAR; PG8_WAIT_L(0); PG8_MMA(1, 0, At, B0); PG8_BAR; PG8_SCHED;
            PG8_STAGE(PG8_SB(0, 1), b2 + hstep, voffB);
            PG8_WAIT_V(6); PG8_BAR; PG8_MMA(1, 1, At, B1); PG8_BAR;
            PG8_LDB(B0, 1, 0); PG8_SCHED; PG8_LDA(At, 1, 0); PG8_STAGE(PG8_SA(0, 1), a2 + hstep, voffA);
            PG8_WAIT_L(8); PG8_BAR; PG8_WAIT_L(0); PG8_MMA(0, 0, At, B0); PG8_BAR; PG8_SCHED;
            PG8_LDB(B1, 1, 1); PG8_STAGE(PG8_SB(1, 0), b3, voffB);
            PG8_BAR; PG8_WAIT_L(0); PG8_MMA(0, 1, At, B1); PG8_BAR;
            PG8_LDA(At, 1, 1); PG8_STAGE(PG8_SA(1, 0), a3, voffA);
            PG8_BAR; PG8_WAIT_L(0); PG8_MMA(1, 0, At, B0); PG8_BAR; PG8_SCHED;
            PG8_STAGE(PG8_SB(1, 1), b3 + hstep, voffB);
            PG8_WAIT_V(6); PG8_BAR; PG8_MMA(1, 1, At, B1); PG8_BAR;
            }
        }
        if constexpr (ALIGN_EPI) { if (wr == 0) PG8_BAR; }
        if constexpr (!Epi::AFTER_DRAIN) { E(acc, cur, wr, wc, fr, fq); S.done(cur); }
        if (!has_next) break;
#pragma unroll
        for (int a = 0; a < 2; ++a)
#pragma unroll
            for (int b = 0; b < 2; ++b)
#pragma unroll
                for (int m = 0; m < 4; ++m)
#pragma unroll
                    for (int n = 0; n < 2; ++n) acc[a][b][m][n] = (f32x4){0.f, 0.f, 0.f, 0.f};
        cur = nxt; cA = nA; cB = nB; ++ui;
        if constexpr (ALIGN_EPI) { if (wr == 1) PG8_BAR; }
    }
    PG8_WAIT_V(0);
    if constexpr (!ALIGN_EPI) { if (wr == 0) PG8_BAR; }
    PG8_BAR;
    if constexpr (Epi::AFTER_DRAIN) { E.fused(acc, cur, wr, wc, fr, fq, lds, wid, lane); S.done(cur); }
#undef PG8_SA
#undef PG8_SB
#undef PG8_STAGE
#undef PG8_LDA
#undef PG8_LDB
#undef PG8_MMA
#undef PG8_WAIT_V
#undef PG8_WAIT_L
#undef PG8_BAR
#undef PG8_SCHED
}
}

#define GAS __attribute__((address_space(1)))
#define LAS __attribute__((address_space(3)))
typedef unsigned short bf16;
typedef unsigned u32x4 __attribute__((ext_vector_type(4)));
typedef unsigned u32x2 __attribute__((ext_vector_type(2)));
typedef float f32x4 __attribute__((ext_vector_type(4)));
typedef float f32x2 __attribute__((ext_vector_type(2)));
typedef short bf16x8_t __attribute__((ext_vector_type(8)));

constexpr int NBATCH = 4, SEQ = 2048, TOK = NBATCH * SEQ, DM = 2048, DEPTH = 4;
constexpr int NIN = 16592, NINP = 16640;
constexpr int C_GQKV = 0, C_GZ = 3072, C_GB = 4096, C_GA = 4104, C_RF = 4112, C_RZ = 7376, C_SU = 8400, C_SZ = 9424, C_GATE = 10448;
constexpr int NWAVES = 8, NTHREADS = 512;
constexpr int LDS_BYTES = 147456;
constexpr int PH_PER_LAYER = 6, NPHASES = 2 + DEPTH * PH_PER_LAYER;

constexpr size_t MiB = 1u << 20;
constexpr size_t WS_WIN = 0, WS_WGLU = 260 * MiB, WS_WBR = 268 * MiB, WS_WOUT = 316 * MiB, WS_XN = 348 * MiB, WS_PROJ = 380 * MiB;
constexpr size_t WS_GQ = 640 * MiB, WS_GK = 672 * MiB, WS_GV = 704 * MiB, WS_GEG = 736 * MiB, WS_GBE = 737 * MiB, WS_GO = 738 * MiB;
constexpr size_t WS_RR = 770 * MiB, WS_RW = 802 * MiB, WS_RK = 834 * MiB, WS_RV = 866 * MiB, WS_RKK = 898 * MiB, WS_RKA = 930 * MiB, WS_RBON = 962 * MiB, WS_RY = 963 * MiB;
constexpr size_t WS_SY = 995 * MiB, WS_OBR = 1011 * MiB, WS_ACCF = 1059 * MiB, WS_MRG = 1123 * MiB, WS_CTL = 1155 * MiB, WS_LORA = 1156 * MiB, WS_END = 1158 * MiB;
constexpr size_t CTL_SS = 65536, CTL_ZERO_BYTES = CTL_SS + (size_t)DEPTH * TOK * 8;
constexpr int MISC_OFF = 147392;
static_assert((size_t)DEPTH * NINP * DM * 2 == 260 * MiB && (size_t)TOK * NINP * 2 == 260 * MiB, "ws map");

__device__ __forceinline__ unsigned f2bf(float f) { unsigned u = __builtin_bit_cast(unsigned, f); return (u + 0x7fffu + ((u >> 16) & 1u)) >> 16; }
__device__ __forceinline__ unsigned pk2(float lo, float hi) { return f2bf(lo) | (f2bf(hi) << 16); }
__device__ __forceinline__ float bflo(unsigned w) { return __builtin_bit_cast(float, w << 16); }
__device__ __forceinline__ float bfhi(unsigned w) { return __builtin_bit_cast(float, w & 0xffff0000u); }
__device__ __forceinline__ float bf1(bf16 h) { return __builtin_bit_cast(float, (unsigned)h << 16); }
__device__ __forceinline__ float sigmoidf_(float x) { return 1.f / (1.f + __expf(-x)); }
__device__ __forceinline__ float siluf_(float x) { return x / (1.f + __expf(-x)); }
__device__ __forceinline__ float softplusf_(float x) { return x > 20.f ? x : log1pf(expf(x)); }
__device__ __forceinline__ float gelu_tanh(float y) { const float t = 0.7978845608028654f * (y + 0.044715f * y * y * y); const float th = 1.f - 2.f / (1.f + __expf(2.f * t)); return 0.5f * y * (1.f + th); }
template <int CTRL> __device__ __forceinline__ float dppf(float v) { return __builtin_bit_cast(float, __builtin_amdgcn_update_dpp(0, __builtin_bit_cast(int, v), CTRL, 0xF, 0xF, true)); }
__device__ __forceinline__ float allred8(float v) { v += dppf<0xB1>(v); v += dppf<0x4E>(v); v += dppf<0x141>(v); return v; }
__device__ __forceinline__ float allred16(float v) { v = allred8(v); v += dppf<0x140>(v); return v; }
__device__ __forceinline__ float wave_sum(float v) {
#pragma unroll
    for (int o = 1; o < 64; o <<= 1) v += __shfl_xor(v, o);
    return v;
}
__device__ __forceinline__ void unpack8(const u32x4 w, float (&f)[8]) { f[0] = bflo(w.x); f[1] = bfhi(w.x); f[2] = bflo(w.y); f[3] = bfhi(w.y); f[4] = bflo(w.z); f[5] = bfhi(w.z); f[6] = bflo(w.w); f[7] = bfhi(w.w); }
__device__ __forceinline__ u32x4 pack8(const float (&f)[8]) { u32x4 w; w.x = pk2(f[0], f[1]); w.y = pk2(f[2], f[3]); w.z = pk2(f[4], f[5]); w.w = pk2(f[6], f[7]); return w; }

namespace pg8 {
struct EpiGlu {
    static constexpr bool PERM = true, AFTER_DRAIN = false;
    const bf16* Y1; const bf16* PROJ; const float* bias; bf16* O;
    __device__ __forceinline__ void operator()(const f32x4 (&acc)[2][2][4][2], const Unit& u, int wr, int wc, int fr, int fq) const {
        int row0 = u.pm * BM + wr * 64 + fr, col0 = u.pn * BM + wc * 32 + 8 * fq;
        asm volatile("" : "+v"(row0), "+v"(col0));
#pragma unroll
        for (int bj = 0; bj < 2; ++bj) {
            const int col = col0 + bj * HALF;
            const f32x4 b0 = *(const f32x4*)(bias + col), b1 = *(const f32x4*)(bias + col + 4);
#pragma unroll
            for (int ai = 0; ai < 2; ++ai)
#pragma unroll
                for (int m = 0; m < 4; ++m) {
                    const size_t row = (size_t)(row0 + ai * HALF + m * 16);
                    const u32x4 y8 = *(const u32x4*)(Y1 + row * 1024 + col), z8 = *(const u32x4*)(PROJ + row * NINP + C_SZ + col);
                    float y[8], z[8], o[8]; unpack8(y8, y); unpack8(z8, z);
                    const f32x4 v0 = acc[ai][bj][m][0] + b0, v1 = acc[ai][bj][m][1] + b1;
                    const float a[8] = {v0[0], v0[1], v0[2], v0[3], v1[0], v1[1], v1[2], v1[3]};
#pragma unroll
                    for (int e = 0; e < 8; ++e) o[e] = y[e] * sigmoidf_(a[e]) * siluf_(z[e]);
                    *(u32x4*)(O + row * 1024 + col) = pack8(o);
                    asm volatile("" ::: "memory");
                }
        }
    }
};
struct EpiBranch {
    static constexpr bool PERM = true, AFTER_DRAIN = false;
    const bf16* PROJ; const float* gate_b; bf16* ACC; bf16* MRG;
    __device__ __forceinline__ void operator()(const f32x4 (&acc)[2][2][4][2], const Unit& u, int wr, int wc, int fr, int fq) const {
        const int br = u.pm >> 5, pm = u.pm & 31, pn = u.pn & 7;
        int row0 = pm * BM + wr * 64 + fr, col0 = pn * BM + wc * 32 + 8 * fq;
        asm volatile("" : "+v"(row0), "+v"(col0));
        bf16* dst = br < 2 ? ACC : MRG;
#pragma unroll
        for (int bj = 0; bj < 2; ++bj) {
            const int col = col0 + bj * HALF;
            const f32x4 g0 = *(const f32x4*)(gate_b + br * DM + col), g1 = *(const f32x4*)(gate_b + br * DM + col + 4);
            const float gb[8] = {g0[0], g0[1], g0[2], g0[3], g1[0], g1[1], g1[2], g1[3]};
#pragma unroll
            for (int ai = 0; ai < 2; ++ai)
#pragma unroll
                for (int m = 0; m < 4; ++m) {
                    const size_t row = (size_t)(row0 + ai * HALF + m * 16);
                    const u32x4 l8 = *(const u32x4*)(PROJ + row * NINP + C_GATE + br * DM + col);
                    float gl[8], o[8]; unpack8(l8, gl);
                    const f32x4 v0 = acc[ai][bj][m][0], v1 = acc[ai][bj][m][1];
                    const float a[8] = {v0[0], v0[1], v0[2], v0[3], v1[0], v1[1], v1[2], v1[3]};
#pragma unroll
                    for (int e = 0; e < 8; ++e) o[e] = sigmoidf_(gl[e] + gb[e]) * a[e];
                    if (br > 0) { float p[8]; unpack8(*(const u32x4*)(ACC + row * DM + col), p);
#pragma unroll
                        for (int e = 0; e < 8; ++e) o[e] += p[e]; }
                    *(u32x4*)(dst + row * DM + col) = pack8(o);
                    asm volatile("" ::: "memory");
                }
        }
    }
};
struct EpiResid {
    static constexpr bool PERM = true, AFTER_DRAIN = false;
    const float* base; float* out; bf16* xn; const float* nw; unsigned long long* ss;
    __device__ __forceinline__ void operator()(const f32x4 (&acc)[2][2][4][2], const Unit& u, int wr, int wc, int fr, int fq) const {
        int row0 = u.pm * BM + wr * 64 + fr, col0 = u.pn * BM + wc * 32 + 8 * fq;
        asm volatile("" : "+v"(row0), "+v"(col0));
#pragma unroll
        for (int ai = 0; ai < 2; ++ai)
#pragma unroll
            for (int m = 0; m < 4; ++m) {
                const int row = row0 + ai * HALF + m * 16; float sq = 0.f;
#pragma unroll
                for (int bj = 0; bj < 2; ++bj) {
                    const size_t off = (size_t)row * DM + col0 + bj * HALF;
                    const f32x4 o0 = *(const f32x4*)(base + off) + acc[ai][bj][m][0], o1 = *(const f32x4*)(base + off + 4) + acc[ai][bj][m][1];
                    *(f32x4*)(out + off) = o0; *(f32x4*)(out + off + 4) = o1;
                    if (xn) { const f32x4 w0 = *(const f32x4*)(nw + col0 + bj * HALF), w1 = *(const f32x4*)(nw + col0 + bj * HALF + 4);
                        sq += (o0.x * o0.x + o0.y * o0.y) + (o0.z * o0.z + o0.w * o0.w) + (o1.x * o1.x + o1.y * o1.y) + (o1.z * o1.z + o1.w * o1.w);
                        u32x4 p; p.x = pk2(o0.x * w0.x, o0.y * w0.y); p.y = pk2(o0.z * w0.z, o0.w * w0.w); p.z = pk2(o1.x * w1.x, o1.y * w1.y); p.w = pk2(o1.z * w1.z, o1.w * w1.w);
                        *(u32x4*)(xn + off) = p; }
                }
                if (xn) { sq += __shfl_xor(sq, 16); sq += __shfl_xor(sq, 32); if (fq == 0) atomicAdd(ss + row, (unsigned long long)(sq * 65536.f + 0.5f)); }
                asm volatile("" ::: "memory");
            }
    }
};
struct EpiBf16Rs {
    static constexpr bool PERM = true, AFTER_DRAIN = false;
    bf16* O; int ldc; const unsigned long long* ss;
    __device__ __forceinline__ void operator()(const f32x4 (&acc)[2][2][4][2], const Unit& u, int wr, int wc, int fr, int fq) const {
        int row0 = u.pm * BM + wr * 64 + fr, col0 = u.pn * BM + wc * 32 + 8 * fq;
        asm volatile("" : "+v"(row0), "+v"(col0));
#pragma unroll
        for (int ai = 0; ai < 2; ++ai)
#pragma unroll
            for (int m = 0; m < 4; ++m) { const int row = row0 + ai * HALF + m * 16; const float rs = 1.f / sqrtf((float)ss[row] * (1.f / (65536.f * DM)) + 1e-6f);
                bf16* rowp = O + (size_t)row * ldc + col0;
#pragma unroll
                for (int bj = 0; bj < 2; ++bj) { const f32x4 v0 = acc[ai][bj][m][0] * rs, v1 = acc[ai][bj][m][1] * rs;
                    u32x4 w; w.x = cvt_pk_bf16(v0[0], v0[1]); w.y = cvt_pk_bf16(v0[2], v0[3]); w.z = cvt_pk_bf16(v1[0], v1[1]); w.w = cvt_pk_bf16(v1[2], v1[3]);
                    *(u32x4*)(rowp + bj * HALF) = w; } }
    }
};
struct BranchOrder {
    StaticOrder base;
    __device__ bool next(int i, Unit& u) const { Unit t; const int r = i / 3, br = i - 3 * r; if (!base.next(r, t)) return false; u.pm = br * 32 + t.pm; u.pn = br * 8 + t.pn; return true; }
    __device__ __forceinline__ void a_ready(const Unit&) const {}
    __device__ __forceinline__ void done(const Unit&) const {}
};
}

#define XB_TMO      128
#define XB_XCNT(j)  (256  + 64 * (j))
#define XB_XSUB(j)  (1280 + 64 * (j))
#define XB_XGEN(j)  (2304 + 64 * (j))
#define XB_TOP      3328
#define XB_TOPGEN   3392
#define XCD_BAR_WORDS 3456
#define XB_SPIN_CAP (1u << 18)

__device__ __forceinline__ unsigned xb_ld(unsigned* p)              { return __hip_atomic_load(p, __ATOMIC_RELAXED, __HIP_MEMORY_SCOPE_AGENT); }
__device__ __forceinline__ unsigned xb_add(unsigned* p, unsigned v) { return __hip_atomic_fetch_add(p, v, __ATOMIC_RELAXED, __HIP_MEMORY_SCOPE_AGENT); }
__device__ __forceinline__ unsigned xb_xcc_id() { return (unsigned)__builtin_amdgcn_s_getreg((3 << 11) | 20) & 0xFu; }
#define XB_SPIN(cond, bar) do { unsigned _sp = 0; while (cond) { __builtin_amdgcn_s_sleep(1); \
    if ((++_sp & 255u) == 0u) { if (xb_ld(&(bar)[XB_TMO])) break; if (_sp > XB_SPIN_CAP) { atomicAdd(&(bar)[XB_TMO], 1u); break; } } } } while (0)

struct XcdBarrier {
    unsigned* bar; unsigned x;
    volatile LAS unsigned* st;
};

__device__ __forceinline__ XcdBarrier xcd_barrier_post(unsigned* bar, volatile LAS unsigned* st) {
    XcdBarrier b; b.bar = bar; b.x = xb_xcc_id(); b.st = st;
    if (threadIdx.x == 0) (void)xb_add(&bar[XB_XCNT(b.x)], 1u);
    return b;
}
__device__ __forceinline__ void xcd_barrier_complete(unsigned* bar, unsigned x, unsigned& nloc, unsigned& nx) {
    const unsigned G = gridDim.x * gridDim.y * gridDim.z;
    unsigned sum, cnt, mine, sp = 0u;
    for (;;) {
        sum = 0u; cnt = 0u; mine = 0u;
#pragma unroll
        for (unsigned j = 0; j < 16; ++j) { const unsigned c = xb_ld(&bar[XB_XCNT(j)]); sum += c; cnt += (c > 0u) ? 1u : 0u; mine = (j == x) ? c : mine; }
        if (sum == G) break;
        __builtin_amdgcn_s_sleep(1);
        if ((++sp & 255u) == 0u) { if (xb_ld(&bar[XB_TMO])) break; if (sp > XB_SPIN_CAP) { atomicAdd(&bar[XB_TMO], 1u); break; } }
    }
    nloc = mine > 0u ? mine : 1u; nx = cnt > 0u ? cnt : 1u;
}

__device__ __forceinline__ void xcd_barrier(const XcdBarrier& b) {
    asm volatile("s_waitcnt vmcnt(0)" ::: "memory");
    __syncthreads();
    if (threadIdx.x == 0) {
        unsigned* bar = b.bar;
        __builtin_amdgcn_s_waitcnt(0);
        unsigned nloc = b.st[0], nx = b.st[1];
        if (nloc == 0u) { xcd_barrier_complete(bar, b.x, nloc, nx); b.st[0] = nloc; b.st[1] = nx; }
        const unsigned old = xb_add(&bar[XB_XSUB(b.x)], 1u);
        const unsigned gen = old / nloc;
        if (old + 1u == (gen + 1u) * nloc) {
            __builtin_amdgcn_fence(__ATOMIC_RELEASE, "agent");
            asm volatile("s_waitcnt vmcnt(0)" ::: "memory");
            const unsigned og = xb_add(&bar[XB_TOP], 1u);
            const unsigned tg = og / nx;
            if (og + 1u == (tg + 1u) * nx) xb_add(&bar[XB_TOPGEN], 1u);
            else XB_SPIN(xb_ld(&bar[XB_TOPGEN]) == tg, bar);
            __builtin_amdgcn_fence(__ATOMIC_ACQUIRE, "agent");
            xb_add(&bar[XB_XGEN(b.x)], 1u);
            asm volatile("s_waitcnt vmcnt(0)" ::: "memory");
        } else {
            XB_SPIN(xb_ld(&bar[XB_XGEN(b.x)]) == gen, bar);
            __builtin_amdgcn_fence(__ATOMIC_ACQUIRE, "agent");
            asm volatile("s_waitcnt vmcnt(0)" ::: "memory");
        }
    }
    __syncthreads();
}

struct Args { const float* in[31]; float* out; unsigned char* ws; int ph_lo, ph_hi; };
struct Ctx { int tid, lane, wave, vcu, G, gw, NGW; LAS unsigned char* lds; unsigned char* ws; };

__device__ __forceinline__ void transpose_item(const float* W, int K, int N, bf16* WT, LAS float* scr, int kb, int nb, int lane) {
    const int k0 = 64 * kb, n0 = 64 * nb, nq = 4 * (lane & 15), kr = lane >> 4; const bool nv = n0 + nq < N;
    f32x4 v[16];
#pragma unroll
    for (int i = 0; i < 16; ++i) v[i] = nv ? *(const f32x4*)(W + (size_t)(k0 + 4 * i + kr) * N + n0 + nq) : (f32x4){0.f, 0.f, 0.f, 0.f};
#pragma unroll
    for (int i = 0; i < 16; ++i) { LAS float* d = scr + (4 * i + kr) * 65 + nq; d[0] = v[i].x; d[1] = v[i].y; d[2] = v[i].z; d[3] = v[i].w; }
    asm volatile("s_waitcnt lgkmcnt(0)" ::: "memory");
    const int c = lane & 7;
#pragma unroll
    for (int j = 0; j < 8; ++j) { const int nn = (lane >> 3) + 8 * j; const LAS float* s = scr + (8 * c) * 65 + nn;
        u32x4 o; o.x = pk2(s[0 * 65], s[1 * 65]); o.y = pk2(s[2 * 65], s[3 * 65]); o.z = pk2(s[4 * 65], s[5 * 65]); o.w = pk2(s[6 * 65], s[7 * 65]);
        *(u32x4*)(WT + (size_t)(n0 + nn) * K + k0 + 8 * c) = o; }
    asm volatile("s_waitcnt lgkmcnt(0)" ::: "memory");
}

__device__ __forceinline__ void rms_row(const float* xrow, const float* w, bf16* obf, unsigned long long* ss, float* of32, int lane) {
    f32x4 v[8]; float s = 0.f;
#pragma unroll
    for (int j = 0; j < 8; ++j) { v[j] = *(const f32x4*)(xrow + 4 * lane + 256 * j); s += (v[j].x * v[j].x + v[j].y * v[j].y) + (v[j].z * v[j].z + v[j].w * v[j].w); }
    s = wave_sum(s);
    const float r = obf ? 1.f : 1.f / sqrtf(s * (1.f / DM) + 1e-6f);
#pragma unroll
    for (int j = 0; j < 8; ++j) { const f32x4 ww = *(const f32x4*)(w + 4 * lane + 256 * j); const f32x4 o = v[j] * r * ww;
        if (obf) { u32x2 p; p.x = pk2(o.x, o.y); p.y = pk2(o.z, o.w); *(u32x2*)(obf + 4 * lane + 256 * j) = p; }
        else *(f32x4*)(of32 + 4 * lane + 256 * j) = o; }
    if (obf && lane == 0) *ss = (unsigned long long)(s * 65536.f + 0.5f);
}

__device__ __forceinline__ void phase0(const Ctx& F, const Args& a) {
    LAS float* scr = (LAS float*)(F.lds + F.wave * 16640);
    constexpr int I_IN = 32 * 260, I_GLU = 16 * 16, I_BR = 16 * 32, I_OUT = 32 * 32, IL = I_IN + I_GLU + 3 * I_BR + I_OUT;
    bf16* WIN = (bf16*)(F.ws + WS_WIN); bf16* WGLU = (bf16*)(F.ws + WS_WGLU); bf16* WBR = (bf16*)(F.ws + WS_WBR); bf16* WOUT = (bf16*)(F.ws + WS_WOUT);
    for (int it = F.gw; it < DEPTH * IL; it += F.NGW) {
        const int l = it / IL; int r = it - l * IL;
        if (r < I_IN) { transpose_item(a.in[2] + (size_t)l * DM * NIN, DM, NIN, WIN + (size_t)l * NINP * DM, scr, r / 260, r % 260, F.lane); continue; } r -= I_IN;
        if (r < I_GLU) { transpose_item(a.in[25] + (size_t)l * 1024 * 1024, 1024, 1024, WGLU + (size_t)l * 1024 * 1024, scr, r / 16, r % 16, F.lane); continue; } r -= I_GLU;
        if (r < 3 * I_BR) { const int br = r / I_BR, r2 = r - br * I_BR;
            transpose_item(a.in[28] + (size_t)(l * 3 + br) * 1024 * DM, 1024, DM, WBR + (size_t)(l * 3 + br) * DM * 1024, scr, r2 / 32, r2 % 32, F.lane); continue; } r -= 3 * I_BR;
        transpose_item(a.in[29] + (size_t)l * DM * DM, DM, DM, WOUT + (size_t)l * DM * DM, scr, r / 32, r % 32, F.lane);
    }
    bf16* XN = (bf16*)(F.ws + WS_XN);
    {
        bf16* LT = (bf16*)(F.ws + WS_LORA);
        for (int it = F.gw * 64 + F.lane; it < DEPTH * 2 * 1024 * 12; it += F.NGW * 64) {
            const int kg = it % 12, n = (it / 12) & 1023, lw = it / (12 * 1024), l = lw >> 1, which = lw & 1;
            const float* src = (which ? a.in[11] : a.in[9]) + (size_t)l * 96 * 1024 + (size_t)(8 * kg) * 1024 + n;
            u32x4 o; o.x = pk2(src[0], src[1024]); o.y = pk2(src[2048], src[3072]); o.z = pk2(src[4096], src[5120]); o.w = pk2(src[6144], src[7168]);
            *(u32x4*)(LT + ((size_t)lw * 1024 + n) * 96 + 8 * kg) = o;
        }
    }
    unsigned long long* SS0 = (unsigned long long*)(F.ws + WS_CTL + CTL_SS);
    for (int m = F.gw; m < TOK; m += F.NGW) rms_row(a.in[0] + (size_t)m * DM, a.in[1], XN + (size_t)m * DM, SS0 + m, nullptr, F.lane);
}

__device__ __forceinline__ void prep_gdn(const Ctx& F, const Args& a, int l) {
    const bf16* PROJ = (const bf16*)(F.ws + WS_PROJ);
    float* GQ = (float*)(F.ws + WS_GQ); float* GK = (float*)(F.ws + WS_GK); float* GV = (float*)(F.ws + WS_GV); float* GEG = (float*)(F.ws + WS_GEG); float* GBE = (float*)(F.ws + WS_GBE);
    const float* cw = a.in[3] + (size_t)l * 4 * 3072;
    for (int it = F.gw; it < 2048; it += F.NGW) {
        const int h = it & 7, ch = (it >> 3) & 63, b = it >> 9;
        const int t0 = ch * 32; const int c = 2 * F.lane;
        float w[3][4][2], hist[3][3][2];
#pragma unroll
        for (int p = 0; p < 3; ++p)
#pragma unroll
            for (int j = 0; j < 4; ++j) { const f32x2 ww = *(const f32x2*)(cw + j * 3072 + p * 1024 + h * 128 + c); w[p][j][0] = ww.x; w[p][j][1] = ww.y; }
#pragma unroll
        for (int p = 0; p < 3; ++p)
#pragma unroll
            for (int j = 0; j < 3; ++j) { const int t = t0 - 3 + j; unsigned x = 0u;
                if (t >= 0) x = *(const unsigned*)(PROJ + (size_t)(b * SEQ + t) * NINP + C_GQKV + p * 1024 + h * 128 + c);
                hist[p][j][0] = bflo(x); hist[p][j][1] = bfhi(x); }
        const float alog = a.in[4][l * 8 + h], dtb = a.in[5][l * 8 + h]; const float aexp = expf(alog);
        unsigned raw[3][32];
#pragma unroll
        for (int tt = 0; tt < 32; ++tt)
#pragma unroll
            for (int p = 0; p < 3; ++p) raw[p][tt] = *(const unsigned*)(PROJ + (size_t)(b * SEQ + t0 + tt) * NINP + C_GQKV + p * 1024 + h * 128 + c);
#pragma unroll
        for (int tt = 0; tt < 32; ++tt) {
            const size_t tok = (size_t)(b * SEQ + t0 + tt);
            float o[3][2];
#pragma unroll
            for (int p = 0; p < 3; ++p) {
                const unsigned x = raw[p][tt];
                const float x0 = bflo(x), x1 = bfhi(x);
                const float y0 = w[p][0][0] * hist[p][0][0] + w[p][1][0] * hist[p][1][0] + w[p][2][0] * hist[p][2][0] + w[p][3][0] * x0;
                const float y1 = w[p][0][1] * hist[p][0][1] + w[p][1][1] * hist[p][1][1] + w[p][2][1] * hist[p][2][1] + w[p][3][1] * x1;
                hist[p][0][0] = hist[p][1][0]; hist[p][1][0] = hist[p][2][0]; hist[p][2][0] = x0;
                hist[p][0][1] = hist[p][1][1]; hist[p][1][1] = hist[p][2][1]; hist[p][2][1] = x1;
                o[p][0] = siluf_(y0); o[p][1] = siluf_(y1);
            }
            const float sq = wave_sum(o[0][0] * o[0][0] + o[0][1] * o[0][1]), sk = wave_sum(o[1][0] * o[1][0] + o[1][1] * o[1][1]);
            const float rq = 0.08838834764831845f / sqrtf(sq + 1e-6f), rk = 1.f / sqrtf(sk + 1e-6f);
            const size_t off = tok * 1024 + h * 128 + c;
            *(unsigned*)((bf16*)GQ + off) = pk2(o[0][0] * rq, o[0][1] * rq);
            *(unsigned*)((bf16*)GK + off) = pk2(o[1][0] * rk, o[1][1] * rk);
            *(unsigned*)((bf16*)GV + off) = pk2(o[2][0], o[2][1]);
            if (F.lane == 0) {
                const float bl = bf1(PROJ[tok * NINP + C_GB + h]), al = bf1(PROJ[tok * NINP + C_GA + h]);
                GBE[tok * 8 + h] = sigmoidf_(bl);
                GEG[tok * 8 + h] = expf(-aexp * softplusf_(al + dtb));
            }
        }
    }
}

__device__ __forceinline__ float mix2(unsigned c, unsigned p, float mu0, float mu1, float& o1) {
    const float c0 = bflo(c), c1 = bfhi(c), p0 = bflo(p), p1 = bfhi(p);
    o1 = c1 + (p1 - c1) * mu1; return c0 + (p0 - c0) * mu0;
}
__device__ __forceinline__ void prep_rwkv(const Ctx& F, const Args& a, int l) {
    const bf16* PROJ = (const bf16*)(F.ws + WS_PROJ);
    float* RR = (float*)(F.ws + WS_RR); float* RW = (float*)(F.ws + WS_RW); float* RK = (float*)(F.ws + WS_RK); float* RV = (float*)(F.ws + WS_RV);
    float* RKK = (float*)(F.ws + WS_RKK); float* RKA = (float*)(F.ws + WS_RKA); float* RBON = (float*)(F.ws + WS_RBON);
    const float* mu = a.in[7] + (size_t)l * 3264; const float* w0 = a.in[8] + l * 1024; const float* wup = a.in[9] + (size_t)l * 96 * 1024;
    const float* a0 = a.in[10] + l * 1024; const float* aup = a.in[11] + (size_t)l * 96 * 1024; const float* kk_ = a.in[12] + l * 1024; const float* ka_ = a.in[13] + l * 1024; const float* rk_ = a.in[14] + l * 1024;
    constexpr int AROW = 104;
    LAS bf16* A1 = (LAS bf16*)F.lds; LAS bf16* A2 = A1 + 16 * AROW;
    LAS float* LW = (LAS float*)(F.lds + 8192); LAS float* LA = LW + 16 * 1024;
    const bf16* LTw = (const bf16*)(F.ws + WS_LORA) + (size_t)(2 * l) * 1024 * 96; const bf16* LTa = LTw + 1024 * 96;
    const int j = F.tid, c = 2 * j;
    const f32x2 mur = *(const f32x2*)(mu + c), muk = *(const f32x2*)(mu + 1024 + c), muv = *(const f32x2*)(mu + 2048 + c);
    const f32x2 w0v = *(const f32x2*)(w0 + c), a0v = *(const f32x2*)(a0 + c), kkv = *(const f32x2*)(kk_ + c), kav = *(const f32x2*)(ka_ + c), rkv = *(const f32x2*)(rk_ + c);
    for (int tile = F.vcu; tile < TOK / 16; tile += F.G) {
        __syncthreads();
        for (int e = F.tid; e < 16 * 192; e += NTHREADS) {
            const int tl = e / 192, i = e - tl * 192; const size_t tok = (size_t)tile * 16 + tl;
            const float cur = bf1(PROJ[tok * NINP + C_RF + 3072 + i]);
            const float prv = (tok & (SEQ - 1)) ? bf1(PROJ[(tok - 1) * NINP + C_RF + 3072 + i]) : 0.f;
            const float m = cur + (prv - cur) * mu[3072 + i];
            if (i < 96) A1[tl * AROW + i] = (bf16)f2bf(tanhf(m)); else A2[tl * AROW + i - 96] = (bf16)f2bf(m);
        }
        __syncthreads();
        {
            const int row = F.lane & 15, quad = F.lane >> 4;
            bf16x8_t fw[3], fa[3];
#pragma unroll
            for (int ks = 0; ks < 3; ++ks) { fw[ks] = *(const LAS bf16x8_t*)(A1 + row * AROW + 32 * ks + 8 * quad); fa[ks] = *(const LAS bf16x8_t*)(A2 + row * AROW + 32 * ks + 8 * quad); }
#pragma unroll 2
            for (int nt = 0; nt < 8; ++nt) {
                const int n = 128 * F.wave + 16 * nt + row;
                f32x4 aw = {0.f, 0.f, 0.f, 0.f}, aa = {0.f, 0.f, 0.f, 0.f};
#pragma unroll
                for (int ks = 0; ks < 3; ++ks) {
                    const bf16x8_t bw = *(const bf16x8_t*)(LTw + (size_t)n * 96 + 32 * ks + 8 * quad), ba = *(const bf16x8_t*)(LTa + (size_t)n * 96 + 32 * ks + 8 * quad);
                    aw = __builtin_amdgcn_mfma_f32_16x16x32_bf16(fw[ks], bw, aw, 0, 0, 0); aa = __builtin_amdgcn_mfma_f32_16x16x32_bf16(fa[ks], ba, aa, 0, 0, 0);
                }
#pragma unroll
                for (int r = 0; r < 4; ++r) { LW[(4 * quad + r) * 1024 + n] = aw[r]; LA[(4 * quad + r) * 1024 + n] = aa[r]; }
            }
        }
        __syncthreads();
        unsigned rw[17][3];
#pragma unroll
        for (int tl = 0; tl < 17; ++tl) { const size_t tok = (size_t)tile * 16 + tl - 1; const bool ok = tl > 0 || ((tok + 1) & (SEQ - 1)) != 0;
            const bf16* cp = PROJ + tok * NINP + C_RF + c;
#pragma unroll
            for (int q = 0; q < 3; ++q) rw[tl][q] = ok ? *(const unsigned*)(cp + 1024 * q) : 0u; }
#pragma unroll
        for (int tl = 0; tl < 16; ++tl) {
            const size_t tok = (size_t)tile * 16 + tl; const bool hp = (tok & (SEQ - 1)) != 0;
            const unsigned cr = rw[tl + 1][0], ck = rw[tl + 1][1], cv = rw[tl + 1][2];
            const unsigned pr = hp ? rw[tl][0] : 0u, pk = hp ? rw[tl][1] : 0u, pv = hp ? rw[tl][2] : 0u;
            float r1, k1, v1; const float r0 = mix2(cr, pr, mur.x, mur.y, r1), k0 = mix2(ck, pk, muk.x, muk.y, k1), v0 = mix2(cv, pv, muv.x, muv.y, v1);
            const f32x2 lw = *(const LAS f32x2*)(LW + tl * 1024 + c), la = *(const LAS f32x2*)(LA + tl * 1024 + c);
            const float wp0 = w0v.x + lw.x, wp1 = w0v.y + lw.y;
            const float d0 = expf(-expf(-softplusf_(-wp0) - 0.5f)), d1 = expf(-expf(-softplusf_(-wp1) - 0.5f));
            const float aa0 = sigmoidf_(a0v.x + la.x), aa1 = sigmoidf_(a0v.y + la.y);
            const float q0 = k0 * kkv.x, q1 = k1 * kkv.y;
            float ss = q0 * q0 + q1 * q1;
#pragma unroll
            for (int o = 1; o < 32; o <<= 1) ss += __shfl_xor(ss, o);
            const float rn = 1.f / sqrtf(ss + 1e-6f); const float n0 = q0 * rn, n1 = q1 * rn;
            const float km0 = k0 * (1.f + (aa0 - 1.f) * kav.x), km1 = k1 * (1.f + (aa1 - 1.f) * kav.y);
            float bo = r0 * km0 * rkv.x + r1 * km1 * rkv.y;
#pragma unroll
            for (int o = 1; o < 32; o <<= 1) bo += __shfl_xor(bo, o);
            const size_t off = tok * 1024 + c;
            *(unsigned*)((bf16*)RR + off) = pk2(r0, r1); *(f32x2*)(RW + off) = (f32x2){d0, d1}; *(unsigned*)((bf16*)RK + off) = pk2(km0, km1); *(unsigned*)((bf16*)RV + off) = pk2(v0, v1);
            *(f32x2*)(RKK + off) = (f32x2){-n0, -n1}; *(unsigned*)((bf16*)RKA + off) = pk2(n0 * aa0, n1 * aa1);
            if ((F.lane & 31) == 0) RBON[tok * 16 + (c >> 6)] = bo;
        }
    }
}

#ifndef SCM
#define SCM 7
#endif
#ifndef REPM
#define REPM 0
#endif
constexpr int CH = 32;
#define WFENCE() do { __builtin_amdgcn_fence(__ATOMIC_RELEASE, "wavefront"); __builtin_amdgcn_wave_barrier(); __builtin_amdgcn_fence(__ATOMIC_ACQUIRE, "wavefront"); } while (0)

struct GStep { f32x4 k0, k1, q0, q1; float v, eg, be; };
constexpr int G_BUF = 2 * CH * 128 + CH * 32 + 2 * CH;
__device__ __forceinline__ void gdn_lds(GStep& s, const LAS float* buf, int st, int rg, int colL) {
    s.k0 = *(const LAS f32x4*)(buf + st * 128 + rg * 4); s.k1 = *(const LAS f32x4*)(buf + st * 128 + 64 + rg * 4);
    s.q0 = *(const LAS f32x4*)(buf + CH * 128 + st * 128 + rg * 4); s.q1 = *(const LAS f32x4*)(buf + CH * 128 + st * 128 + 64 + rg * 4);
    s.v = buf[2 * CH * 128 + st * 32 + colL]; s.eg = buf[2 * CH * 128 + CH * 32 + st]; s.be = buf[2 * CH * 128 + CH * 32 + CH + st];
}
__device__ __forceinline__ void gdn_step(const GStep& s, f32x2 (&S)[4], LAS float* ob, bool wr) {
    const f32x2 k01 = s.k0.xy, k23 = s.k0.zw, k45 = s.k1.xy, k67 = s.k1.zw;
    const f32x2 a2 = (k01 * S[0] + k23 * S[1]) + (k45 * S[2] + k67 * S[3]);
    const float ks = allred16(a2.x + a2.y);
    const float cc = s.be * (s.v - s.eg * ks);
    S[0] = S[0] * s.eg + k01 * cc; S[1] = S[1] * s.eg + k23 * cc; S[2] = S[2] * s.eg + k45 * cc; S[3] = S[3] * s.eg + k67 * cc;
    const f32x2 o2 = (s.q0.xy * S[0] + s.q0.zw * S[1]) + (s.q1.xy * S[2] + s.q1.zw * S[3]);
    const float o = allred16(o2.x + o2.y);
    if (wr) *ob = o;
}
struct GStage { u32x4 k, q, v; float e; };
__device__ __forceinline__ void gdn_gload(GStage& g, const bf16* GK, const bf16* GQ, const bf16* GV, const float* GEG, const float* GBE, int t0, int tid) {
    { const int st = tid >> 4, f8 = tid & 15; g.k = *(const u32x4*)(GK + (size_t)(t0 + st) * 1024 + 8 * f8); g.q = *(const u32x4*)(GQ + (size_t)(t0 + st) * 1024 + 8 * f8); }
    { const int i = tid & 127; g.v = *(const u32x4*)(GV + (size_t)(t0 + (i >> 2)) * 1024 + 8 * (i & 3)); }
    { const int i = tid & 63; const float* p = (i < 32 ? GEG : GBE); g.e = p[(size_t)(t0 + (i & 31)) * 8]; }
}
__device__ __forceinline__ void st8(LAS float* d, const u32x4 w) { float f[8]; unpack8(w, f); *(LAS f32x4*)d = (f32x4){f[0], f[1], f[2], f[3]}; *(LAS f32x4*)(d + 4) = (f32x4){f[4], f[5], f[6], f[7]}; }
__device__ __forceinline__ void gdn_gstore(const GStage& g, LAS float* buf, int tid) {
    st8(buf + 8 * tid, g.k); st8(buf + CH * 128 + 8 * tid, g.q);
    if (tid < 128) st8(buf + 2 * CH * 128 + 8 * tid, g.v);
    else if (tid >= 256 && tid < 320) buf[2 * CH * 128 + CH * 32 + (tid - 256)] = g.e;
}
__device__ __forceinline__ void gdn_block(const Ctx& F, int vb) {
    const int bh = vb >> 2, qt = vb & 3, b = bh >> 3, h = bh & 7, colL = F.wave * 4 + (F.lane >> 4), rg = F.lane & 15;
    const size_t base = (size_t)b * SEQ;
    const bf16* GK = (const bf16*)(F.ws + WS_GK) + base * 1024 + h * 128; const bf16* GQ = (const bf16*)(F.ws + WS_GQ) + base * 1024 + h * 128;
    const bf16* GV = (const bf16*)(F.ws + WS_GV) + base * 1024 + h * 128 + qt * 32;
    const float* GEG = (const float*)(F.ws + WS_GEG) + base * 8 + h; const float* GBE = (const float*)(F.ws + WS_GBE) + base * 8 + h;
    float* GO = (float*)(F.ws + WS_GO) + base * 1024 + h * 128 + qt * 32;
    LAS float* lb = (LAS float*)F.lds; LAS float* obase = lb + 2 * G_BUF;
    f32x2 S[4] = {{0.f, 0.f}, {0.f, 0.f}, {0.f, 0.f}, {0.f, 0.f}};
    const bool wr = rg == 0;
    GStage g;
    gdn_gload(g, GK, GQ, GV, GEG, GBE, 0, F.tid); gdn_gstore(g, lb, F.tid);
    __syncthreads();
    for (int c = 0; c < SEQ / CH; ++c) {
        const LAS float* buf = lb + (c & 1) * G_BUF; LAS float* ob = obase + (c & 1) * (CH * 32) + colL;
        if (c + 1 < SEQ / CH) gdn_gload(g, GK, GQ, GV, GEG, GBE, (c + 1) * CH, F.tid);
        GStep R0, R1, R2, R3;
        gdn_lds(R0, buf, 0, rg, colL); gdn_lds(R1, buf, 1, rg, colL);
#pragma unroll 1
        for (int s = 0; s < CH; s += 4) {
            gdn_lds(R2, buf, s + 2, rg, colL); gdn_step(R0, S, ob + s * 32, wr);
            gdn_lds(R3, buf, s + 3, rg, colL); gdn_step(R1, S, ob + (s + 1) * 32, wr);
            gdn_lds(R0, buf, (s + 4) & (CH - 1), rg, colL); gdn_step(R2, S, ob + (s + 2) * 32, wr);
            gdn_lds(R1, buf, (s + 5) & (CH - 1), rg, colL); gdn_step(R3, S, ob + (s + 3) * 32, wr);
        }
        if (c + 1 < SEQ / CH) gdn_gstore(g, lb + ((c + 1) & 1) * G_BUF, F.tid);
        __syncthreads();
        if (F.tid < 256) *(f32x4*)(GO + (size_t)(c * CH + (F.tid >> 3)) * 1024 + 4 * (F.tid & 7)) = *(const LAS f32x4*)(obase + (c & 1) * (CH * 32) + 4 * F.tid);
    }
}

struct RStep { f32x4 w, n, a, k, r; float v; };
constexpr int R_BUF = CH * (5 * 64 + 32);
__device__ __forceinline__ void rwkv_lds(RStep& s, const LAS float* buf, int st, int cq, int rowL) {
    s.w = *(const LAS f32x4*)(buf + st * 64 + 4 * cq); s.n = *(const LAS f32x4*)(buf + CH * 64 + st * 64 + 4 * cq); s.a = *(const LAS f32x4*)(buf + 2 * CH * 64 + st * 64 + 4 * cq);
    s.k = *(const LAS f32x4*)(buf + 3 * CH * 64 + st * 64 + 4 * cq); s.r = *(const LAS f32x4*)(buf + 4 * CH * 64 + st * 64 + 4 * cq); s.v = buf[5 * CH * 64 + st * 32 + rowL];
}
__device__ __forceinline__ void rwkv_step(const RStep& s, f32x4& S, LAS float* ob, bool wr) {
    float sa = (S.x * s.n.x + S.y * s.n.y) + (S.z * s.n.z + S.w * s.n.w);
    sa = allred16(sa);
    S = S * s.w + sa * s.a + s.v * s.k;
    float y = (S.x * s.r.x + S.y * s.r.y) + (S.z * s.r.z + S.w * s.r.w);
    y = allred16(y);
    if (wr) *ob = y;
}
struct RStage { f32x4 x[2]; u32x4 y[3], v; };
__device__ __forceinline__ void rwkv_gload(RStage& g, const float* RW, const float* RN, const bf16* RA, const bf16* RKp, const bf16* RRp, const bf16* RV, int t0, int tid) {
    { const int st = tid >> 4, f4 = tid & 15; g.x[0] = *(const f32x4*)(RW + (size_t)(t0 + st) * 1024 + 4 * f4); g.x[1] = *(const f32x4*)(RN + (size_t)(t0 + st) * 1024 + 4 * f4); }
    { const int i = tid & 255; const size_t o = (size_t)(t0 + (i >> 3)) * 1024 + 8 * (i & 7); g.y[0] = *(const u32x4*)(RA + o); g.y[1] = *(const u32x4*)(RKp + o); g.y[2] = *(const u32x4*)(RRp + o); }
    { const int i = tid & 127; g.v = *(const u32x4*)(RV + (size_t)(t0 + (i >> 2)) * 1024 + 8 * (i & 3)); }
}
__device__ __forceinline__ void rwkv_gstore(const RStage& g, LAS float* buf, int tid) {
    *(LAS f32x4*)(buf + 4 * tid) = g.x[0]; *(LAS f32x4*)(buf + CH * 64 + 4 * tid) = g.x[1];
    if (tid < 256) { st8(buf + 2 * CH * 64 + 8 * tid, g.y[0]); st8(buf + 3 * CH * 64 + 8 * tid, g.y[1]); st8(buf + 4 * CH * 64 + 8 * tid, g.y[2]); }
    else if (tid < 384) st8(buf + 5 * CH * 64 + 8 * (tid - 256), g.v);
}
__device__ __forceinline__ void rwkv_block(const Ctx& F, int vb) {
    const int bh = vb >> 1, hf = vb & 1, b = bh >> 4, h = bh & 15, rowL = F.wave * 4 + (F.lane >> 4), cq = F.lane & 15;
    const size_t base = (size_t)b * SEQ * 1024 + h * 64;
    const float* RW = (const float*)(F.ws + WS_RW) + base; const float* RN = (const float*)(F.ws + WS_RKK) + base;
    const bf16* RA = (const bf16*)(F.ws + WS_RKA) + base; const bf16* RKp = (const bf16*)(F.ws + WS_RK) + base; const bf16* RRp = (const bf16*)(F.ws + WS_RR) + base;
    const bf16* RV = (const bf16*)(F.ws + WS_RV) + base + hf * 32;
    float* RY = (float*)(F.ws + WS_RY) + base + hf * 32;
    LAS float* lb = (LAS float*)F.lds; LAS float* obase = lb + 2 * R_BUF;
    f32x4 S = {0.f, 0.f, 0.f, 0.f};
    const bool wr = cq == 0;
    RStage g;
    rwkv_gload(g, RW, RN, RA, RKp, RRp, RV, 0, F.tid); rwkv_gstore(g, lb, F.tid);
    __syncthreads();
    for (int c = 0; c < SEQ / CH; ++c) {
        const LAS float* buf = lb + (c & 1) * R_BUF; LAS float* ob = obase + (c & 1) * (CH * 32) + rowL;
        if (c + 1 < SEQ / CH) rwkv_gload(g, RW, RN, RA, RKp, RRp, RV, (c + 1) * CH, F.tid);
        RStep R0, R1, R2, R3;
        rwkv_lds(R0, buf, 0, cq, rowL); rwkv_lds(R1, buf, 1, cq, rowL);
#pragma unroll 1
        for (int s = 0; s < CH; s += 4) {
            rwkv_lds(R2, buf, s + 2, cq, rowL); rwkv_step(R0, S, ob + s * 32, wr);
            rwkv_lds(R3, buf, s + 3, cq, rowL); rwkv_step(R1, S, ob + (s + 1) * 32, wr);
            rwkv_lds(R0, buf, (s + 4) & (CH - 1), cq, rowL); rwkv_step(R2, S, ob + (s + 2) * 32, wr);
            rwkv_lds(R1, buf, (s + 5) & (CH - 1), cq, rowL); rwkv_step(R3, S, ob + (s + 3) * 32, wr);
        }
        if (c + 1 < SEQ / CH) rwkv_gstore(g, lb + ((c + 1) & 1) * R_BUF, F.tid);
        __syncthreads();
        if (F.tid < 256) *(f32x4*)(RY + (size_t)(c * CH + (F.tid >> 3)) * 1024 + 4 * (F.tid & 7)) = *(const LAS f32x4*)(obase + (c & 1) * (CH * 32) + 4 * F.tid);
    }
}

constexpr int S5_SROW = 136;
constexpr int S5_WAVE_B = 16 * S5_SROW * 2 + 1024;
__device__ __forceinline__ void s5_block(const Ctx& F, const Args& a, int l, int it) {
    const int b = it >> 6, g = it & 63, p = F.lane, tl = F.lane >> 4, c = F.lane & 15, w = F.wave;
    const bf16* PROJ = (const bf16*)(F.ws + WS_PROJ); bf16* SY = (bf16*)(F.ws + WS_SY);
    LAS float* se = (LAS float*)F.lds;
    LAS unsigned char* wb = F.lds + 4096 + w * S5_WAVE_B;
    LAS bf16* sbuf = (LAS bf16*)wb; LAS float* uall = (LAS float*)(wb + 16 * S5_SROW * 2);
    const size_t gp = ((size_t)l * 64 + g) * 64 + p;
    const float dt = expf(a.in[19][l * 64 + g]); const float are = a.in[17][gp], aim = a.in[18][gp];
    const float mag = expf(are * dt), abr = mag * cosf(aim * dt), abi = mag * sinf(aim * dt);
    const float den = are * are + aim * aim, cr = ((abr - 1.f) * are + abi * aim) / den, ci = (abi * are - (abr - 1.f) * aim) / den;
    float Bre[16], Bim[16];
#pragma unroll
    for (int q = 0; q < 4; ++q) { const f32x4 br = *(const f32x4*)(a.in[20] + gp * 16 + 4 * q), bi = *(const f32x4*)(a.in[21] + gp * 16 + 4 * q);
#pragma unroll
        for (int e = 0; e < 4; ++e) { Bre[4 * q + e] = cr * br[e] - ci * bi[e]; Bim[4 * q + e] = cr * bi[e] + ci * br[e]; } }
    bf16x8_t Cf[4];
    { const size_t cb = (((size_t)l * 64 + g) * 16 + c) * 64;
#pragma unroll
      for (int m = 0; m < 4; ++m) { const int k0 = 32 * m + 8 * tl; const float* src = (k0 < 64 ? a.in[22] + cb + k0 : a.in[23] + cb + (k0 - 64)); const float sg = k0 < 64 ? 1.f : -1.f;
          const f32x4 x0 = *(const f32x4*)src, x1 = *(const f32x4*)(src + 4);
          u32x4 pk; pk.x = pk2(sg * x0.x, sg * x0.y); pk.y = pk2(sg * x0.z, sg * x0.w); pk.z = pk2(sg * x1.x, sg * x1.y); pk.w = pk2(sg * x1.z, sg * x1.w);
          Cf[m] = __builtin_bit_cast(bf16x8_t, pk); } }
    const float dsk = a.in[24][l * 1024 + g * 16 + c];
    const int tw = 256 * w;
    const bf16* up = PROJ + ((size_t)b * SEQ + tw) * NINP + C_SU + g * 16;
    float sr = 0.f, si = 0.f;
    {
        bf16 ucur = up[(size_t)tl * NINP + c], unxt = up[(size_t)(4 + tl) * NINP + c];
        for (int t = 0; t < 256; t += 4) {
            uall[F.lane] = bf1(ucur);
            WFENCE();
            const int tn = (t + 8 < 256) ? t + 8 : t;
            const bf16 unn = up[(size_t)(tn + tl) * NINP + c];
#pragma unroll
            for (int j = 0; j < 4; ++j) {
                float br = 0.f, bi = 0.f;
#pragma unroll
                for (int q = 0; q < 4; ++q) { const f32x4 u4 = *(const LAS f32x4*)(uall + j * 16 + 4 * q);
#pragma unroll
                    for (int e = 0; e < 4; ++e) { br += Bre[4 * q + e] * u4[e]; bi += Bim[4 * q + e] * u4[e]; } }
                const float nr = abr * sr - abi * si + br, ni = abr * si + abi * sr + bi; sr = nr; si = ni;
            }
            WFENCE();
            ucur = unxt; unxt = unn;
        }
    }
    se[w * 128 + p] = sr; se[w * 128 + 64 + p] = si;
    __syncthreads();
    {
        float pr = abr, pi = abi;
#pragma unroll
        for (int i = 0; i < 8; ++i) { const float nr = pr * pr - pi * pi, ni = 2.f * pr * pi; pr = nr; pi = ni; }
        sr = 0.f; si = 0.f;
        for (int j = 0; j < w; ++j) { const float er = se[j * 128 + p], ei = se[j * 128 + 64 + p]; const float nr = pr * sr - pi * si + er, ni = pr * si + pi * sr + ei; sr = nr; si = ni; }
    }
    {
        bf16 ucur = up[(size_t)tl * NINP + c], unxt = up[(size_t)(4 + tl) * NINP + c];
        for (int t = 0; t < 256; t += 16) {
#pragma unroll
            for (int sub = 0; sub < 4; ++sub) {
                uall[sub * 64 + F.lane] = bf1(ucur);
                WFENCE();
                const int tn = (t + 4 * sub + 8 < 256) ? t + 4 * sub + 8 : t + 4 * sub;
                const bf16 unn = up[(size_t)(tn + tl) * NINP + c];
#pragma unroll
                for (int j = 0; j < 4; ++j) {
                    float br = 0.f, bi = 0.f;
#pragma unroll
                    for (int q = 0; q < 4; ++q) { const f32x4 u4 = *(const LAS f32x4*)(uall + sub * 64 + j * 16 + 4 * q);
#pragma unroll
                        for (int e = 0; e < 4; ++e) { br += Bre[4 * q + e] * u4[e]; bi += Bim[4 * q + e] * u4[e]; } }
                    const float nr = abr * sr - abi * si + br, ni = abr * si + abi * sr + bi; sr = nr; si = ni;
                    sbuf[(sub * 4 + j) * S5_SROW + p] = (bf16)f2bf(sr); sbuf[(sub * 4 + j) * S5_SROW + 64 + p] = (bf16)f2bf(si);
                }
                ucur = unxt; unxt = unn;
            }
            WFENCE();
            f32x4 acc = {0.f, 0.f, 0.f, 0.f};
#pragma unroll
            for (int m = 0; m < 4; ++m) { const bf16x8_t af = *(const LAS bf16x8_t*)(sbuf + c * S5_SROW + 32 * m + 8 * tl);
                acc = __builtin_amdgcn_mfma_f32_16x16x32_bf16(af, Cf[m], acc, 0, 0, 0); }
#pragma unroll
            for (int r = 0; r < 4; ++r) { const int st = 4 * tl + r; const float y = acc[r] + dsk * uall[st * 16 + c];
                SY[((size_t)b * SEQ + tw + t + st) * 1024 + g * 16 + c] = (bf16)f2bf(gelu_tanh(y)); }
            WFENCE();
        }
    }
    __syncthreads();
}

__device__ __forceinline__ void scan_phase(const Ctx& F, const Args& a, int l) {
    for (int r5 = 0; r5 < 1 + ((REPM >> 9) & 1); ++r5) for (int vb = F.vcu; vb < 256; vb += F.G) s5_block(F, a, l, vb);
    for (int rg_ = 0; rg_ < 1 + ((REPM >> 10) & 1); ++rg_) for (int vb = F.vcu; vb < 256; vb += F.G) {
        if (vb < 128) { gdn_block(F, vb); if (REPM & 2048) gdn_block(F, vb); }
        else { rwkv_block(F, vb - 128); if (REPM & 4096) rwkv_block(F, vb - 128); }
    }
}

__device__ __forceinline__ void post_phase(const Ctx& F, const Args& a, int l, int gw, int ngw) {
    const bf16* PROJ = (const bf16*)(F.ws + WS_PROJ); bf16* OBR = (bf16*)(F.ws + WS_OBR);
    const float* GO = (const float*)(F.ws + WS_GO); const float* RY = (const float*)(F.ws + WS_RY); const float* RV = (const float*)(F.ws + WS_RV); const float* RBON = (const float*)(F.ws + WS_RBON);
    const int c0 = 16 * F.lane;
    float nw[16], lw[16], lb[16];
#pragma unroll
    for (int e = 0; e < 16; ++e) { nw[e] = a.in[6][l * 128 + (c0 & 127) + e]; lw[e] = a.in[15][l * 1024 + c0 + e]; lb[e] = a.in[16][l * 1024 + c0 + e]; }
    for (int tok = gw; tok < TOK; tok += ngw) {
        { float o[16];
#pragma unroll
          for (int q = 0; q < 4; ++q) { const f32x4 v = *(const f32x4*)(GO + (size_t)tok * 1024 + c0 + 4 * q); o[4 * q] = v.x; o[4 * q + 1] = v.y; o[4 * q + 2] = v.z; o[4 * q + 3] = v.w; }
          float ss = 0.f;
#pragma unroll
          for (int e = 0; e < 16; ++e) ss += o[e] * o[e];
          ss = allred8(ss);
          const float rs = 1.f / sqrtf(ss * (1.f / 128.f) + 1e-6f);
          float z[16]; { float z0[8], z1[8]; unpack8(*(const u32x4*)(PROJ + (size_t)tok * NINP + C_GZ + c0), z0); unpack8(*(const u32x4*)(PROJ + (size_t)tok * NINP + C_GZ + c0 + 8), z1);
#pragma unroll
              for (int e = 0; e < 8; ++e) { z[e] = z0[e]; z[8 + e] = z1[e]; } }
          float r0[8], r1[8];
#pragma unroll
          for (int e = 0; e < 8; ++e) { r0[e] = o[e] * rs * nw[e] * siluf_(z[e]); r1[e] = o[8 + e] * rs * nw[8 + e] * siluf_(z[8 + e]); }
          *(u32x4*)(OBR + (size_t)tok * 1024 + c0) = pack8(r0); *(u32x4*)(OBR + (size_t)tok * 1024 + c0 + 8) = pack8(r1); }
        { float y[16], v[16];
#pragma unroll
          for (int q = 0; q < 4; ++q) { const f32x4 t = *(const f32x4*)(RY + (size_t)tok * 1024 + c0 + 4 * q); y[4 * q] = t.x; y[4 * q + 1] = t.y; y[4 * q + 2] = t.z; y[4 * q + 3] = t.w;
          }
          { float va[8], vb[8]; unpack8(*(const u32x4*)((const bf16*)RV + (size_t)tok * 1024 + c0), va); unpack8(*(const u32x4*)((const bf16*)RV + (size_t)tok * 1024 + c0 + 8), vb);
#pragma unroll
              for (int e = 0; e < 8; ++e) { v[e] = va[e]; v[8 + e] = vb[e]; } }
          float s = 0.f;
#pragma unroll
          for (int e = 0; e < 16; ++e) s += y[e];
          s += dppf<0xB1>(s); s += dppf<0x4E>(s);
          const float mean = s * (1.f / 64.f); float q2 = 0.f;
#pragma unroll
          for (int e = 0; e < 16; ++e) { const float d = y[e] - mean; q2 += d * d; }
          q2 += dppf<0xB1>(q2); q2 += dppf<0x4E>(q2);
          const float rs = 1.f / sqrtf(q2 * (1.f / 64.f) + 64e-5f);
          const float bon = RBON[(size_t)tok * 16 + (c0 >> 6)];
          float z[16]; { float z0[8], z1[8]; unpack8(*(const u32x4*)(PROJ + (size_t)tok * NINP + C_RZ + c0), z0); unpack8(*(const u32x4*)(PROJ + (size_t)tok * NINP + C_RZ + c0 + 8), z1);
#pragma unroll
              for (int e = 0; e < 8; ++e) { z[e] = z0[e]; z[8 + e] = z1[e]; } }
          float r0[8], r1[8];
#pragma unroll
          for (int e = 0; e < 8; ++e) { r0[e] = ((y[e] - mean) * rs * lw[e] + lb[e] + bon * v[e]) * siluf_(z[e]); r1[e] = ((y[8 + e] - mean) * rs * lw[8 + e] + lb[8 + e] + bon * v[8 + e]) * siluf_(z[8 + e]); }
          bf16* ob = OBR + (size_t)TOK * 1024 + (size_t)tok * 1024 + c0;
          *(u32x4*)ob = pack8(r0); *(u32x4*)(ob + 8) = pack8(r1); }
    }
}

#ifndef PHM
#define PHM 0xFFFF
#endif
#ifndef REPM
#define REPM 0
#endif
__global__ void __launch_bounds__(NTHREADS, 2) hybrid_fwd(Args a) {
    extern __shared__ __attribute__((aligned(16))) unsigned char lds_raw[];
    Ctx F;
    F.lds = (LAS unsigned char*)lds_raw; F.ws = a.ws;
    F.G = gridDim.x; { const int bx = blockIdx.x; F.vcu = (F.G % 8 == 0) ? (bx % 8) * (F.G / 8) + bx / 8 : bx; }
    F.NGW = F.G * NWAVES;
    cg::grid_group grid = cg::this_grid();
    if (threadIdx.x < 8) ((volatile LAS unsigned*)(F.lds + MISC_OFF))[threadIdx.x] = 0u;
    __syncthreads();
    grid.sync();
    XcdBarrier bar = xcd_barrier_post((unsigned*)(a.ws + WS_CTL), (volatile LAS unsigned*)(F.lds + MISC_OFF));
    bf16* XN = (bf16*)(a.ws + WS_XN); bf16* PROJ = (bf16*)(a.ws + WS_PROJ);
    int rep = 0;
    for (int ph = a.ph_lo; ph < a.ph_hi; ) {
        { int t_ = threadIdx.x; asm volatile("" : "+v"(t_)); F.tid = t_; F.lane = t_ & 63; F.wave = __builtin_amdgcn_readfirstlane(t_ >> 6); F.gw = F.vcu * NWAVES + F.wave; }
        if (ph == NPHASES - 1) { for (int m = F.gw; m < TOK; m += F.NGW) rms_row(a.out + (size_t)m * DM, a.in[30], nullptr, nullptr, a.out + (size_t)m * DM, F.lane); }
        else if (ph == 0) { if (PHM & 1) phase0(F, a);
            if (REPM & 128) { if (!rep) { rep = 1; __syncthreads(); continue; } rep = 0; } }
        else {
            const int l = (ph - 1) / PH_PER_LAYER, k = (ph - 1) % PH_PER_LAYER;
            if (k == 0 && (PHM & 2)) {
                pg8::Gemm g{XN, (const bf16*)(a.ws + WS_WIN) + (size_t)l * NINP * DM, TOK, NINP, DM}; pg8::StaticOrder S; S.init(TOK, NINP, F.G, (int)blockIdx.x);
                pg8::EpiBf16Rs E{PROJ, NINP, (const unsigned long long*)(a.ws + WS_CTL + CTL_SS) + (size_t)l * TOK};
                pg8::gemm_phase<pg8::EpiBf16Rs, pg8::StaticOrder, true, true>(F.lds, g, S, E);
            } else if (k == 1) { prep_gdn(F, a, l); if (REPM & 8192) prep_gdn(F, a, l); prep_rwkv(F, a, l); if (REPM & 16384) prep_rwkv(F, a, l); }
            else if (k == 2) { if (PHM & 16) scan_phase(F, a, l); }
            else if (k == 3 && (PHM & 32)) {
                const bool split = F.G >= 192;
                if (!split) { post_phase(F, a, l, F.gw, F.NGW); __syncthreads(); }
                if (!split || (int)blockIdx.x < 128) {
                    pg8::Gemm g{(const bf16*)(a.ws + WS_SY), (const bf16*)(a.ws + WS_WGLU) + (size_t)l * 1024 * 1024, TOK, 1024, 1024}; pg8::StaticOrder S; S.init(TOK, 1024, F.G, (int)blockIdx.x);
                    pg8::EpiGlu E{(const bf16*)(a.ws + WS_SY), PROJ, a.in[26] + l * 1024, (bf16*)(a.ws + WS_OBR) + (size_t)2 * TOK * 1024};
                    pg8::gemm_phase<pg8::EpiGlu, pg8::StaticOrder, true, true>(F.lds, g, S, E);
                } else post_phase(F, a, l, ((int)blockIdx.x - 128) * NWAVES + F.wave, (F.G - 128) * NWAVES);
            } else if (k == 4 && (PHM & 64)) {
                pg8::Gemm g{(const bf16*)(a.ws + WS_OBR), (const bf16*)(a.ws + WS_WBR) + (size_t)l * 3 * DM * 1024, 3 * TOK, 3 * DM, 1024};
                pg8::BranchOrder S; S.base.init(TOK, DM, F.G, (int)blockIdx.x);
                pg8::EpiBranch E{PROJ, a.in[27] + (size_t)l * 3 * DM, (bf16*)(a.ws + WS_ACCF), (bf16*)(a.ws + WS_MRG)};
                pg8::gemm_phase<pg8::EpiBranch, pg8::BranchOrder, true, true>(F.lds, g, S, E);
            } else if (k == 5 && (PHM & 128)) {
                pg8::Gemm g{(const bf16*)(a.ws + WS_MRG), (const bf16*)(a.ws + WS_WOUT) + (size_t)l * DM * DM, TOK, DM, DM}; pg8::StaticOrder S; S.init(TOK, DM, F.G, (int)blockIdx.x);
                pg8::EpiResid E{l == 0 ? a.in[0] : a.out, a.out, l + 1 < DEPTH ? XN : nullptr, a.in[1] + (size_t)(l + 1 < DEPTH ? l + 1 : 0) * DM, (unsigned long long*)(a.ws + WS_CTL + CTL_SS) + (size_t)(l + 1 < DEPTH ? l + 1 : 0) * TOK};
                pg8::gemm_phase<pg8::EpiResid, pg8::StaticOrder, true, true>(F.lds, g, S, E);
            }
            if (REPM && !rep && ((REPM >> k) & 1)) { rep = 1; __syncthreads(); continue; }
            rep = 0;
        }
        if (ph + 1 < a.ph_hi) {
            xcd_barrier(bar);
            if (REPM & 256) xcd_barrier(bar);
        }
        ++ph;
    }
}

#ifndef MK_MULTI
#define MK_MULTI 0
#endif
extern "C" void kernel_launch(void* const* d_in, const int* in_sizes, int n_in, void* d_out, int out_size, void* d_ws, size_t ws_size, hipStream_t stream) {
    static int grid = 0;
    if (grid == 0) {
        if (n_in != 31 || out_size != TOK * DM || ws_size < WS_END) { fprintf(stderr, "kernel_launch: unexpected shapes (n_in %d out %d ws %zu)\n", n_in, out_size, ws_size); grid = -1; return; }
        int dev = 0, cus = 0, per_cu = 0;
        hipGetDevice(&dev); hipDeviceGetAttribute(&cus, hipDeviceAttributeMultiprocessorCount, dev);
        if (hipFuncSetAttribute((const void*)hybrid_fwd, hipFuncAttributeMaxDynamicSharedMemorySize, LDS_BYTES) != hipSuccess) { fprintf(stderr, "kernel_launch: hipFuncSetAttribute failed\n"); grid = -1; return; }
        if (hipOccupancyMaxActiveBlocksPerMultiprocessor(&per_cu, (const void*)hybrid_fwd, NTHREADS, LDS_BYTES) != hipSuccess || per_cu < 1) per_cu = 1;
        (void)hipGetLastError();
        grid = cus * per_cu;
        fprintf(stderr, "kernel_launch: grid %d (cus %d x %d)\n", grid, cus, per_cu);
    }
    if (grid < 0) return;
    if (hipMemsetAsync((char*)d_ws + WS_CTL, 0, CTL_ZERO_BYTES, stream) != hipSuccess) { fprintf(stderr, "kernel_launch: memset failed\n"); return; }
    Args a{};
    for (int i = 0; i < 31; ++i) a.in[i] = (const float*)d_in[i];
    a.out = (float*)d_out; a.ws = (unsigned char*)d_ws;
#if MK_MULTI
    for (int ph = 0; ph < NPHASES; ++ph) { a.ph_lo = ph; a.ph_hi = ph + 1; hipLaunchKernelGGL(hybrid_fwd, dim3(grid), dim3(NTHREADS), LDS_BYTES, stream, a); }
#else
    a.ph_lo = 0; a.ph_hi = NPHASES;
    void* args[] = {&a};
    const hipError_t e = hipLaunchCooperativeKernel((const void*)hybrid_fwd, dim3(grid), dim3(NTHREADS), args, LDS_BYTES, stream);
    if (e != hipSuccess) fprintf(stderr, "kernel_launch: cooperative launch failed: %s (grid %d)\n", hipGetErrorString(e), grid);
#endif
}
```

```cpp
#include <hip/hip_runtime.h>
#include <hip/hip_cooperative_groups.h>
#include <cstdio>
#include <cstdint>
namespace cg = cooperative_groups;
namespace pg8 {
#define PG8_LAS __attribute__((address_space(3)))
typedef unsigned short bf16_t;
typedef short bf16x8 __attribute__((ext_vector_type(8)));
typedef float f32x4 __attribute__((ext_vector_type(4)));
typedef unsigned u32x4 __attribute__((ext_vector_type(4)));
constexpr int BM = 256, BK = 64, HALF = 128, HTB = HALF * BK * 2  , STAGE_BYTES = 8 * HTB, NXCD = 8, WGM = 8;

__host__ __device__ __forceinline__ int lds_byte(int r, int c) { const int st = (r >> 4) * 2 + (c >> 5), rr = r & 15, cc = c & 31, ob = rr * 64 + cc * 2; return st * 1024 + (ob ^ (((ob >> 9) & 1) << 5)); }
__host__ __device__ __forceinline__ void stage_rc(int b, int& R, int& C) { const int st = b / 1024, sb = b % 1024, swz = sb ^ (((sb >> 9) & 1) << 5); R = (st >> 1) * 16 + swz / 64; C = (st & 1) * 32 + (swz % 64) / 2; }
__host__ __device__ __forceinline__ int perm32(int rho) { const int n = rho >> 4, i = rho & 15; return 8 * (i >> 2) + 4 * n + (i & 3); }

struct Unit { int pm, pn; };
struct Gemm { const bf16_t* A; const bf16_t* Bt; int M, N, K, ld; };

struct StaticOrder {
    int nM, nN, nwg, G, c;
    __host__ __device__ void init(int M, int N, int G_, int c_) { nM = M / BM; nN = N / BM; nwg = nM * nN; G = G_; c = c_; }
    __host__ __device__ bool next(int i, Unit& u) const {
        const long L = (long)i * G + c; if (L >= nwg) return false;
        int wgid = (int)L; { const int q = nwg / NXCD, r = nwg % NXCD, xcd = wgid % NXCD, off = wgid / NXCD; wgid = (xcd < r ? xcd * (q + 1) : r * (q + 1) + (xcd - r) * q) + off; }
        const int nig = WGM * nN, gid = wgid / nig, fm = gid * WGM, gsz = (nM - fm) < WGM ? (nM - fm) : WGM;
        u.pm = fm + ((wgid % nig) % gsz); u.pn = (wgid % nig) / gsz; return true;
    }
    __device__ __forceinline__ void a_ready(const Unit&) const {}
    __device__ __forceinline__ void done(const Unit&) const {}
};

__device__ __forceinline__ unsigned cvt_pk_bf16(float lo, float hi) { unsigned r; asm volatile("v_cvt_pk_bf16_f32 %0, %1, %2" : "=v"(r) : "v"(lo), "v"(hi)); return r; }
typedef float f32x2 __attribute__((ext_vector_type(2)));
__device__ __forceinline__ f32x2 gelu_pk(f32x2 v) {
    const f32x2 av = __builtin_elementwise_abs(v), d = av * 0.2316418882f + 1.0f;
    f32x2 t; t.x = __builtin_amdgcn_rcpf(d.x); t.y = __builtin_amdgcn_rcpf(d.y);
    f32x2 q = t * 0.5307027145f + (-0.7265760135f); q = q * t + 0.7107068705f; q = q * t + (-0.142248368f); q = q * t + 0.127414796f; q = q * t;
    const f32x2 s = (v * v) * (-0.72134752044f);
    f32x2 e; e.x = __builtin_amdgcn_exp2f(s.x); e.y = __builtin_amdgcn_exp2f(s.y);
    const f32x2 m = v * (q * e), r = v - m;
    f32x2 o; o.x = v.x < 0.f ? m.x : r.x; o.y = v.y < 0.f ? m.y : r.y; return o;
}

template <int ACT  > struct EpiBf16 {
    static constexpr bool PERM = true, AFTER_DRAIN = false; static_assert(ACT == 0 || ACT == 1, "EpiBf16: ACT is 0 (none) or 1 (gelu_pk)");
    bf16_t* O; int ldc; const float* bias; int split_cols; size_t split_stride; float scale0;
    __device__ __forceinline__ void operator()(const f32x4 (&acc)[2][2][4][2], const Unit& u, int wr, int wc, int fr, int fq) const {
        const int row0 = u.pm * BM + wr * 64 + fr; int colt = u.pn * BM; bf16_t* base = O;
        float sc = 1.f; if (split_cols) { const int t = colt / split_cols; base += (size_t)t * split_stride; colt -= t * split_cols; if (t == 0) sc = scale0; }
        const int col0 = colt + wc * 32 + 8 * fq, bcol0 = u.pn * BM + wc * 32 + 8 * fq;
        f32x4 bv[2][2];
#pragma unroll
        for (int bj = 0; bj < 2; ++bj)
#pragma unroll
            for (int n = 0; n < 2; ++n) bv[bj][n] = bias ? *(const f32x4*)(bias + bcol0 + bj * HALF + 4 * n) : (f32x4){0.f, 0.f, 0.f, 0.f};
#pragma unroll
        for (int ai = 0; ai < 2; ++ai)
#pragma unroll
            for (int m = 0; m < 4; ++m) { bf16_t* rowp = base + (size_t)(row0 + ai * HALF + m * 16) * ldc + col0;
#pragma unroll
                for (int bj = 0; bj < 2; ++bj) { f32x4 v0 = acc[ai][bj][m][0] + bv[bj][0], v1 = acc[ai][bj][m][1] + bv[bj][1];
                    if (ACT == 1) { f32x2 a = gelu_pk((f32x2){v0[0], v0[1]}), b = gelu_pk((f32x2){v0[2], v0[3]}), c = gelu_pk((f32x2){v1[0], v1[1]}), d = gelu_pk((f32x2){v1[2], v1[3]});
                        v0 = (f32x4){a.x, a.y, b.x, b.y}; v1 = (f32x4){c.x, c.y, d.x, d.y}; }
                    v0 = v0 * sc; v1 = v1 * sc; u32x4 w; w.x = cvt_pk_bf16(v0[0], v0[1]); w.y = cvt_pk_bf16(v0[2], v0[3]); w.z = cvt_pk_bf16(v1[0], v1[1]); w.w = cvt_pk_bf16(v1[2], v1[3]);
                    *(u32x4*)(rowp + bj * HALF) = w; } }
    }
};

template <class Epi, class Sched, bool ALIGN_EPI = false, bool SP2 = false>
__device__ __forceinline__ void gemm_phase(PG8_LAS unsigned char* lds, const Gemm g, const Sched& S, const Epi& E) {
    int tid_ = threadIdx.x; asm volatile("" : "+v"(tid_));
    const int tid = tid_, wid = __builtin_amdgcn_readfirstlane(tid >> 6), lane = tid & 63, wr = wid >> 2, wc = wid & 3, fr = lane & 15, fq = lane >> 4;
    const int K = g.K, nt = K / BK, LD = g.ld ? g.ld : g.K;
    unsigned voffA[2], voffB[2];
#pragma unroll
    for (int i = 0; i < 2; ++i) { int R, C; stage_rc(tid * 16 + i * 8192, R, C); const int Rb = Epi::PERM ? ((R & ~31) + perm32(R & 31)) : R;
        voffA[i] = (unsigned)(R * LD + C) * 2u; voffB[i] = (unsigned)(Rb * LD + C) * 2u; }
    const size_t kstep = (size_t)(BK * 2);
    const size_t hstep = (size_t)HALF * LD * 2;
    const size_t tstep = 2 * hstep;
    const unsigned ldsw = (unsigned)wid * 1024u;
    const int aoff = lds_byte(wr * 64 + fr, fq * 8), boff = lds_byte(wc * 32 + fr, fq * 8);
#define PG8_SA(b, h) (((b) * 2 + (h)) * HTB)
#define PG8_SB(b, h) ((4 + (b) * 2 + (h)) * HTB)
#define PG8_STAGE(bufoff, gbase, voff) do { _Pragma("unroll") for (int _i = 0; _i < 2; ++_i) \
        __builtin_amdgcn_global_load_lds((const unsigned*)((const char*)(gbase) + (voff)[_i]), (PG8_LAS unsigned*)(lds + (bufoff) + ldsw + _i * 8192), 16, 0, 0); } while (0)
#define PG8_LDA(dst, b, h) do { _Pragma("unroll") for (int m = 0; m < 4; ++m) _Pragma("unroll") for (int k = 0; k < 2; ++k) dst[m][k] = *(const PG8_LAS bf16x8*)(lds + PG8_SA(b, h) + aoff + m * 2048 + k * 1024); } while (0)
#define PG8_LDB(dst, b, h) do { _Pragma("unroll") for (int n = 0; n < 2; ++n) _Pragma("unroll") for (int k = 0; k < 2; ++k) dst[n][k] = *(const PG8_LAS bf16x8*)(lds + PG8_SB(b, h) + boff + n * 2048 + k * 1024); } while (0)
#define PG8_MMA(ai, bj, At, Bt) do { __builtin_amdgcn_s_setprio(1); _Pragma("unroll") for (int m = 0; m < 4; ++m) _Pragma("unroll") for (int n = 0; n < 2; ++n) _Pragma("unroll") for (int k = 0; k < 2; ++k) \
        acc[ai][bj][m][n] = __builtin_amdgcn_mfma_f32_16x16x32_bf16(Bt[n][k], At[m][k], acc[ai][bj][m][n], 0, 0, 0); __builtin_amdgcn_s_setprio(0); } while (0)
#define PG8_WAIT_V(n) asm volatile("s_waitcnt vmcnt(" #n ")" ::: "memory")
#define PG8_WAIT_L(n) asm volatile("s_waitcnt lgkmcnt(" #n ")" ::: "memory")
#define PG8_BAR __builtin_amdgcn_s_barrier()
#define PG8_SCHED __builtin_amdgcn_sched_barrier(0)
    Unit cur, nxt; int ui = 0;
    if (!S.next(0, cur)) return;
    f32x4 acc[2][2][4][2];
#pragma unroll
    for (int a = 0; a < 2; ++a)
#pragma unroll
        for (int b = 0; b < 2; ++b)
#pragma unroll
            for (int m = 0; m < 4; ++m)
#pragma unroll
                for (int n = 0; n < 2; ++n) acc[a][b][m][n] = (f32x4){0.f, 0.f, 0.f, 0.f};
    bf16x8 At[4][2], B0[2][2], B1[2][2];
    const char* cA = (const char*)g.A + (size_t)cur.pm * tstep; const char* cB = (const char*)g.Bt + (size_t)cur.pn * tstep;
    S.a_ready(cur);
    if constexpr (SP2) {
        PG8_STAGE(PG8_SB(0, 0), cB, voffB); PG8_STAGE(PG8_SB(0, 1), cB + hstep, voffB); PG8_STAGE(PG8_SA(0, 0), cA, voffA); PG8_STAGE(PG8_SA(0, 1), cA + hstep, voffA);
        if (wr == 1) PG8_BAR;
        PG8_WAIT_V(2); PG8_BAR;
        PG8_STAGE(PG8_SB(1, 0), cB + kstep, voffB); PG8_STAGE(PG8_SA(1, 0), cA + kstep, voffA); PG8_STAGE(PG8_SB(1, 1), cB + hstep + kstep, voffB);
        PG8_WAIT_V(6); PG8_BAR;
    } else {
        PG8_STAGE(PG8_SB(0, 0), cB, voffB); PG8_STAGE(PG8_SA(0, 0), cA, voffA); PG8_STAGE(PG8_SB(0, 1), cB + hstep, voffB); PG8_STAGE(PG8_SA(0, 1), cA + hstep, voffA);
        if (wr == 1) PG8_BAR;
        PG8_WAIT_V(4); PG8_BAR;
        PG8_STAGE(PG8_SB(1, 0), cB + kstep, voffB); PG8_STAGE(PG8_SA(1, 0), cA + kstep, voffA); PG8_STAGE(PG8_SB(1, 1), cB + hstep + kstep, voffB);
        PG8_WAIT_V(6); PG8_BAR;
    }
    for (;;) {
        const bool has_next = S.next(ui + 1, nxt);
        const char* nA = has_next ? (const char*)g.A + (size_t)nxt.pm * tstep : cA; const char* nB = has_next ? (const char*)g.Bt + (size_t)nxt.pn * tstep : cB;
        for (int t = 0; t < nt; t += 2) {
            const bool last = (t == nt - 2);
            const char* a1 = cA + (size_t)(t + 1) * kstep;
            const char* a2 = last ? nA : cA + (size_t)(t + 2) * kstep; const char* b2 = last ? nB : cB + (size_t)(t + 2) * kstep;
            const char* a3 = a2 + kstep; const char* b3 = b2 + kstep;
            if (last && has_next) S.a_ready(nxt);
            if constexpr (SP2) {
            PG8_LDB(B0, 0, 0); PG8_LDB(B1, 0, 1); PG8_SCHED; PG8_LDA(At, 0, 0); PG8_STAGE(PG8_SA(1, 1), a1 + hstep, voffA);
            PG8_WAIT_V(8); PG8_WAIT_L(0); PG8_BAR; PG8_MMA(0, 0, At, B0); PG8_MMA(0, 1, At, B1); PG8_BAR; PG8_SCHED;
            PG8_LDA(At, 0, 1); PG8_STAGE(PG8_SB(0, 0), b2, voffB); PG8_STAGE(PG8_SB(0, 1), b2 + hstep, voffB); PG8_STAGE(PG8_SA(0, 0), a2, voffA);
            PG8_WAIT_V(8); PG8_WAIT_L(0); PG8_BAR; PG8_MMA(1, 0, At, B0); PG8_MMA(1, 1, At, B1); PG8_BAR; PG8_SCHED;
            PG8_LDB(B0, 1, 0); PG8_LDB(B1, 1, 1); PG8_SCHED; PG8_LDA(At, 1, 0); PG8_STAGE(PG8_SA(0, 1), a2 + hstep, voffA);
            PG8_WAIT_V(8); PG8_WAIT_L(0); PG8_BAR; PG8_MMA(0, 0, At, B0); PG8_MMA(0, 1, At, B1); PG8_BAR; PG8_SCHED;
            PG8_LDA(At, 1, 1); PG8_STAGE(PG8_SB(1, 0), b3, voffB); PG8_STAGE(PG8_SB(1, 1), b3 + hstep, voffB); PG8_STAGE(PG8_SA(1, 0), a3, voffA);
            PG8_WAIT_V(8); PG8_WAIT_L(0); PG8_BAR; PG8_MMA(1, 0, At, B0); PG8_MMA(1, 1, At, B1); PG8_BAR; PG8_SCHED;
            } else {
            PG8_LDB(B0, 0, 0); PG8_SCHED; PG8_LDA(At, 0, 0); PG8_STAGE(PG8_SA(1, 1), a1 + hstep, voffA);
            PG8_WAIT_L(8); PG8_BAR; PG8_WAIT_L(0); PG8_MMA(0, 0, At, B0); PG8_BAR; PG8_SCHED;
            PG8_LDB(B1, 0, 1); PG8_STAGE(PG8_SB(0, 0), b2, voffB);
            PG8_BAR; PG8_WAIT_L(0); PG8_MMA(0, 1, At, B1); PG8_BAR;
            PG8_LDA(At, 0, 1); PG8_STAGE(PG8_SA(0, 0), a2, voffA);
            PG8_BAR; PG8_WAIT_L(0); PG8_MMA(1, 0, At, B0); PG8_BAR; PG8_SCHED;
            PG8_STAGE(PG8_SB(0, 1), b2 + hstep, voffB);
            PG8_WAIT_V(6); PG8_BAR; PG8_MMA(1, 1, At, B1); PG8_BAR;
            PG8_LDB(B0, 1, 0); PG8_SCHED; PG8_LDA(At, 1, 0); PG8_STAGE(PG8_SA(0, 1), a2 + hstep, voffA);
            PG8_WAIT_L(8); PG8_BAR; PG8_WAIT_L(0); PG8_MMA(0, 0, At, B0); PG8_BAR; PG8_SCHED;
            PG8_LDB(B1, 1, 1); PG8_STAGE(PG8_SB(1, 0), b3, voffB);
            PG8_BAR; PG8_WAIT_L(0); PG8_MMA(0, 1, At, B1); PG8_BAR;
            PG8_LDA(At, 1, 1); PG8_STAGE(PG8_SA(1, 0), a3, voffA);
            PG8_BAR; PG8_WAIT_L(0); PG8_MMA(1, 0, At, B0); PG8_BAR; PG8_SCHED;
            PG8_STAGE(PG8_SB(1, 1), b3 + hstep, voffB);
            PG8_WAIT_V(6); PG8_BAR; PG8_MMA(1, 1, At, B1); PG8_BAR;
            }
        }
        if constexpr (ALIGN_EPI) { if (wr == 0) PG8_BAR; }
        if constexpr (!Epi::AFTER_DRAIN) { E(acc, cur, wr, wc, fr, fq); S.done(cur); }
        if (!has_next) break;
#pragma unroll
        for (int a = 0; a < 2; ++a)
#pragma unroll
            for (int b = 0; b < 2; ++b)
#pragma unroll
                for (int m = 0; m < 4; ++m)
#pragma unroll
                    for (int n = 0; n < 2; ++n) acc[a][b][m][n] = (f32x4){0.f, 0.f, 0.f, 0.f};
        cur = nxt; cA = nA; cB = nB; ++ui;
        if constexpr (ALIGN_EPI) { if (wr == 1) PG8_BAR; }
    }
    PG8_WAIT_V(0);
    if constexpr (!ALIGN_EPI) { if (wr == 0) PG8_BAR; }
    PG8_BAR;
    if constexpr (Epi::AFTER_DRAIN) { E.fused(acc, cur, wr, wc, fr, fq, lds, wid, lane); S.done(cur); }
#undef PG8_SA
#undef PG8_SB
#undef PG8_STAGE
#undef PG8_LDA
#undef PG8_LDB
#undef PG8_MMA
#undef PG8_WAIT_V
#undef PG8_WAIT_L
#undef PG8_BAR
#undef PG8_SCHED
}
}

#define GAS __attribute__((address_space(1)))
#define LAS __attribute__((address_space(3)))
typedef unsigned short bf16;
typedef unsigned u32x4 __attribute__((ext_vector_type(4)));
typedef unsigned u32x2 __attribute__((ext_vector_type(2)));
typedef float f32x4 __attribute__((ext_vector_type(4)));
typedef float f32x2 __attribute__((ext_vector_type(2)));
typedef short bf16x8_t __attribute__((ext_vector_type(8)));

constexpr int NBATCH = 4, SEQ = 2048, TOK = NBATCH * SEQ, DM = 2048, DEPTH = 4;
constexpr int NIN = 16592, NINP = 16640;
constexpr int C_GQKV = 0, C_GZ = 3072, C_GB = 4096, C_GA = 4104, C_RF = 4112, C_RZ = 7376, C_SU = 8400, C_SZ = 9424, C_GATE = 10448;
constexpr int NWAVES = 8, NTHREADS = 512;
constexpr int LDS_BYTES = 147456;
constexpr int PH_PER_LAYER = 6, NPHASES = 2 + DEPTH * PH_PER_LAYER;

constexpr size_t MiB = 1u << 20;
constexpr size_t WS_WIN = 0, WS_WGLU = 260 * MiB, WS_WBR = 268 * MiB, WS_WOUT = 316 * MiB, WS_XN = 348 * MiB, WS_PROJ = 380 * MiB;
constexpr size_t WS_GQ = 640 * MiB, WS_GK = 672 * MiB, WS_GV = 704 * MiB, WS_GEG = 736 * MiB, WS_GBE = 737 * MiB, WS_GO = 738 * MiB;
constexpr size_t WS_RR = 770 * MiB, WS_RW = 802 * MiB, WS_RK = 834 * MiB, WS_RV = 866 * MiB, WS_RKK = 898 * MiB, WS_RKA = 930 * MiB, WS_RBON = 962 * MiB, WS_RY = 963 * MiB;
constexpr size_t WS_SY = 995 * MiB, WS_OBR = 1011 * MiB, WS_ACCF = 1059 * MiB, WS_MRG = 1123 * MiB, WS_CTL = 1155 * MiB, WS_LORA = 1156 * MiB, WS_END = 1158 * MiB;
constexpr size_t CTL_SS = 65536, CTL_ZERO_BYTES = CTL_SS + (size_t)DEPTH * TOK * 8;
constexpr int MISC_OFF = 147392;
static_assert((size_t)DEPTH * NINP * DM * 2 == 260 * MiB && (size_t)TOK * NINP * 2 == 260 * MiB, "ws map");

__device__ __forceinline__ unsigned f2bf(float f) { unsigned u = __builtin_bit_cast(unsigned, f); return (u + 0x7fffu + ((u >> 16) & 1u)) >> 16; }
__device__ __forceinline__ unsigned pk2(float lo, float hi) { return f2bf(lo) | (f2bf(hi) << 16); }
__device__ __forceinline__ float bflo(unsigned w) { return __builtin_bit_cast(float, w << 16); }
__device__ __forceinline__ float bfhi(unsigned w) { return __builtin_bit_cast(float, w & 0xffff0000u); }
__device__ __forceinline__ float bf1(bf16 h) { return __builtin_bit_cast(float, (unsigned)h << 16); }
__device__ __forceinline__ float sigmoidf_(float x) { return __builtin_amdgcn_rcpf(1.f + __expf(-x)); }
__device__ __forceinline__ float siluf_(float x) { return x * __builtin_amdgcn_rcpf(1.f + __expf(-x)); }
__device__ __forceinline__ float softplusf_(float x) { return x > 20.f ? x : log1pf(expf(x)); }
__device__ __forceinline__ float gelu_tanh(float y) { const float t = 0.7978845608028654f * (y + 0.044715f * y * y * y); const float th = 1.f - 2.f * __builtin_amdgcn_rcpf(1.f + __expf(2.f * t)); return 0.5f * y * (1.f + th); }
template <int CTRL> __device__ __forceinline__ float dppf(float v) { return __builtin_bit_cast(float, __builtin_amdgcn_update_dpp(0, __builtin_bit_cast(int, v), CTRL, 0xF, 0xF, true)); }
__device__ __forceinline__ float allred8(float v) { v += dppf<0xB1>(v); v += dppf<0x4E>(v); v += dppf<0x141>(v); return v; }
__device__ __forceinline__ float allred16(float v) { v = allred8(v); v += dppf<0x140>(v); return v; }
__device__ __forceinline__ float wave_sum(float v) {
#pragma unroll
    for (int o = 1; o < 64; o <<= 1) v += __shfl_xor(v, o);
    return v;
}
__device__ __forceinline__ void unpack8(const u32x4 w, float (&f)[8]) { f[0] = bflo(w.x); f[1] = bfhi(w.x); f[2] = bflo(w.y); f[3] = bfhi(w.y); f[4] = bflo(w.z); f[5] = bfhi(w.z); f[6] = bflo(w.w); f[7] = bfhi(w.w); }
__device__ __forceinline__ u32x4 pack8(const float (&f)[8]) { u32x4 w; w.x = pk2(f[0], f[1]); w.y = pk2(f[2], f[3]); w.z = pk2(f[4], f[5]); w.w = pk2(f[6], f[7]); return w; }

namespace pg8 {
struct EpiGlu {
    static constexpr bool PERM = true, AFTER_DRAIN = false;
    const bf16* Y1; const bf16* PROJ; const float* bias; bf16* O;
    __device__ __forceinline__ void operator()(const f32x4 (&acc)[2][2][4][2], const Unit& u, int wr, int wc, int fr, int fq) const {
        int row0 = u.pm * BM + wr * 64 + fr, col0 = u.pn * BM + wc * 32 + 8 * fq;
        asm volatile("" : "+v"(row0), "+v"(col0));
#pragma unroll
        for (int bj = 0; bj < 2; ++bj) {
            const int col = col0 + bj * HALF;
            const f32x4 b0 = *(const f32x4*)(bias + col), b1 = *(const f32x4*)(bias + col + 4);
#pragma unroll
            for (int ai = 0; ai < 2; ++ai)
#pragma unroll
                for (int m = 0; m < 4; ++m) {
                    const size_t row = (size_t)(row0 + ai * HALF + m * 16);
                    const u32x4 y8 = *(const u32x4*)(Y1 + row * 1024 + col), z8 = *(const u32x4*)(PROJ + row * NINP + C_SZ + col);
                    float y[8], z[8], o[8]; unpack8(y8, y); unpack8(z8, z);
                    const f32x4 v0 = acc[ai][bj][m][0] + b0, v1 = acc[ai][bj][m][1] + b1;
                    const float a[8] = {v0[0], v0[1], v0[2], v0[3], v1[0], v1[1], v1[2], v1[3]};
#pragma unroll
                    for (int e = 0; e < 8; ++e) o[e] = y[e] * sigmoidf_(a[e]) * siluf_(z[e]);
                    *(u32x4*)(O + row * 1024 + col) = pack8(o);
                    asm volatile("" ::: "memory");
                }
        }
    }
};
struct EpiBranch {
    static constexpr bool PERM = true, AFTER_DRAIN = false;
    const bf16* PROJ; const float* gate_b; bf16* ACC; bf16* MRG;
    __device__ __forceinline__ void operator()(const f32x4 (&acc)[2][2][4][2], const Unit& u, int wr, int wc, int fr, int fq) const {
        const int br = u.pm >> 5, pm = u.pm & 31, pn = u.pn & 7;
        int row0 = pm * BM + wr * 64 + fr, col0 = pn * BM + wc * 32 + 8 * fq;
        asm volatile("" : "+v"(row0), "+v"(col0));
        bf16* dst = br < 2 ? ACC : MRG;
#pragma unroll
        for (int bj = 0; bj < 2; ++bj) {
            const int col = col0 + bj * HALF;
            const f32x4 g0 = *(const f32x4*)(gate_b + br * DM + col), g1 = *(const f32x4*)(gate_b + br * DM + col + 4);
            const float gb[8] = {g0[0], g0[1], g0[2], g0[3], g1[0], g1[1], g1[2], g1[3]};
#pragma unroll
            for (int ai = 0; ai < 2; ++ai)
#pragma unroll
                for (int m = 0; m < 4; ++m) {
                    const size_t row = (size_t)(row0 + ai * HALF + m * 16);
                    const u32x4 l8 = *(const u32x4*)(PROJ + row * NINP + C_GATE + br * DM + col);
                    float gl[8], o[8]; unpack8(l8, gl);
                    const f32x4 v0 = acc[ai][bj][m][0], v1 = acc[ai][bj][m][1];
                    const float a[8] = {v0[0], v0[1], v0[2], v0[3], v1[0], v1[1], v1[2], v1[3]};
#pragma unroll
                    for (int e = 0; e < 8; ++e) o[e] = sigmoidf_(gl[e] + gb[e]) * a[e];
                    if (br > 0) { float p[8]; unpack8(*(const u32x4*)(ACC + row * DM + col), p);
#pragma unroll
                        for (int e = 0; e < 8; ++e) o[e] += p[e]; }
                    *(u32x4*)(dst + row * DM + col) = pack8(o);
                    asm volatile("" ::: "memory");
                }
        }
    }
};
struct EpiResid {
    static constexpr bool PERM = true, AFTER_DRAIN = false;
    const float* base; float* out; bf16* xn; const float* nw; unsigned long long* ss;
    __device__ __forceinline__ void operator()(const f32x4 (&acc)[2][2][4][2], const Unit& u, int wr, int wc, int fr, int fq) const {
        int row0 = u.pm * BM + wr * 64 + fr, col0 = u.pn * BM + wc * 32 + 8 * fq;
        asm volatile("" : "+v"(row0), "+v"(col0));
#pragma unroll
        for (int ai = 0; ai < 2; ++ai)
#pragma unroll
            for (int m = 0; m < 4; ++m) {
                const int row = row0 + ai * HALF + m * 16; float sq = 0.f;
#pragma unroll
                for (int bj = 0; bj < 2; ++bj) {
                    const size_t off = (size_t)row * DM + col0 + bj * HALF;
                    const f32x4 o0 = *(const f32x4*)(base + off) + acc[ai][bj][m][0], o1 = *(const f32x4*)(base + off + 4) + acc[ai][bj][m][1];
                    *(f32x4*)(out + off) = o0; *(f32x4*)(out + off + 4) = o1;
                    if (xn) { const f32x4 w0 = *(const f32x4*)(nw + col0 + bj * HALF), w1 = *(const f32x4*)(nw + col0 + bj * HALF + 4);
                        sq += (o0.x * o0.x + o0.y * o0.y) + (o0.z * o0.z + o0.w * o0.w) + (o1.x * o1.x + o1.y * o1.y) + (o1.z * o1.z + o1.w * o1.w);
                        u32x4 p; p.x = pk2(o0.x * w0.x, o0.y * w0.y); p.y = pk2(o0.z * w0.z, o0.w * w0.w); p.z = pk2(o1.x * w1.x, o1.y * w1.y); p.w = pk2(o1.z * w1.z, o1.w * w1.w);
                        *(u32x4*)(xn + off) = p; }
                }
                if (xn) { sq += __shfl_xor(sq, 16); sq += __shfl_xor(sq, 32); if (fq == 0) atomicAdd(ss + row, (unsigned long long)(sq * 65536.f + 0.5f)); }
                asm volatile("" ::: "memory");
            }
    }
};
struct EpiBf16Rs {
    static constexpr bool PERM = true, AFTER_DRAIN = false;
    bf16* O; int ldc; const unsigned long long* ss;
    __device__ __forceinline__ void operator()(const f32x4 (&acc)[2][2][4][2], const Unit& u, int wr, int wc, int fr, int fq) const {
        int row0 = u.pm * BM + wr * 64 + fr, col0 = u.pn * BM + wc * 32 + 8 * fq;
        asm volatile("" : "+v"(row0), "+v"(col0));
#pragma unroll
        for (int ai = 0; ai < 2; ++ai)
#pragma unroll
            for (int m = 0; m < 4; ++m) { const int row = row0 + ai * HALF + m * 16; const float rs = 1.f / sqrtf((float)ss[row] * (1.f / (65536.f * DM)) + 1e-6f);
                bf16* rowp = O + (size_t)row * ldc + col0;
#pragma unroll
                for (int bj = 0; bj < 2; ++bj) { const f32x4 v0 = acc[ai][bj][m][0] * rs, v1 = acc[ai][bj][m][1] * rs;
                    u32x4 w; w.x = cvt_pk_bf16(v0[0], v0[1]); w.y = cvt_pk_bf16(v0[2], v0[3]); w.z = cvt_pk_bf16(v1[0], v1[1]); w.w = cvt_pk_bf16(v1[2], v1[3]);
                    *(u32x4*)(rowp + bj * HALF) = w; } }
    }
};
struct BranchOrder {
    StaticOrder base;
    __device__ bool next(int i, Unit& u) const { Unit t; const int r = i / 3, br = i - 3 * r; if (!base.next(r, t)) return false; u.pm = br * 32 + t.pm; u.pn = br * 8 + t.pn; return true; }
    __device__ __forceinline__ void a_ready(const Unit&) const {}
    __device__ __forceinline__ void done(const Unit&) const {}
};
}

#define XB_TMO      128
#define XB_XCNT(j)  (256  + 64 * (j))
#define XB_XSUB(j)  (1280 + 64 * (j))
#define XB_XGEN(j)  (2304 + 64 * (j))
#define XB_TOP      3328
#define XB_TOPGEN   3392
#define XCD_BAR_WORDS 3456
#define XB_SPIN_CAP (1u << 18)

__device__ __forceinline__ unsigned xb_ld(unsigned* p)              { return __hip_atomic_load(p, __ATOMIC_RELAXED, __HIP_MEMORY_SCOPE_AGENT); }
__device__ __forceinline__ unsigned xb_add(unsigned* p, unsigned v) { return __hip_atomic_fetch_add(p, v, __ATOMIC_RELAXED, __HIP_MEMORY_SCOPE_AGENT); }
__device__ __forceinline__ unsigned xb_xcc_id() { return (unsigned)__builtin_amdgcn_s_getreg((3 << 11) | 20) & 0xFu; }
#define XB_SPIN(cond, bar) do { unsigned _sp = 0; while (cond) { __builtin_amdgcn_s_sleep(1); \
    if ((++_sp & 255u) == 0u) { if (xb_ld(&(bar)[XB_TMO])) break; if (_sp > XB_SPIN_CAP) { atomicAdd(&(bar)[XB_TMO], 1u); break; } } } } while (0)

struct XcdBarrier {
    unsigned* bar; unsigned x;
    volatile LAS unsigned* st;
};

__device__ __forceinline__ XcdBarrier xcd_barrier_post(unsigned* bar, volatile LAS unsigned* st) {
    XcdBarrier b; b.bar = bar; b.x = xb_xcc_id(); b.st = st;
    if (threadIdx.x == 0) (void)xb_add(&bar[XB_XCNT(b.x)], 1u);
    return b;
}
__device__ __forceinline__ void xcd_barrier_complete(unsigned* bar, unsigned x, unsigned& nloc, unsigned& nx) {
    const unsigned G = gridDim.x * gridDim.y * gridDim.z;
    unsigned sum, cnt, mine, sp = 0u;
    for (;;) {
        sum = 0u; cnt = 0u; mine = 0u;
#pragma unroll
        for (unsigned j = 0; j < 16; ++j) { const unsigned c = xb_ld(&bar[XB_XCNT(j)]); sum += c; cnt += (c > 0u) ? 1u : 0u; mine = (j == x) ? c : mine; }
        if (sum == G) break;
        __builtin_amdgcn_s_sleep(1);
        if ((++sp & 255u) == 0u) { if (xb_ld(&bar[XB_TMO])) break; if (sp > XB_SPIN_CAP) { atomicAdd(&bar[XB_TMO], 1u); break; } }
    }
    nloc = mine > 0u ? mine : 1u; nx = cnt > 0u ? cnt : 1u;
}

__device__ __forceinline__ void xcd_barrier(const XcdBarrier& b) {
    asm volatile("s_waitcnt vmcnt(0)" ::: "memory");
    __syncthreads();
    if (threadIdx.x == 0) {
        unsigned* bar = b.bar;
        __builtin_amdgcn_s_waitcnt(0);
        unsigned nloc = b.st[0], nx = b.st[1];
        if (nloc == 0u) { xcd_barrier_complete(bar, b.x, nloc, nx); b.st[0] = nloc; b.st[1] = nx; }
        const unsigned old = xb_add(&bar[XB_XSUB(b.x)], 1u);
        const unsigned gen = old / nloc;
        if (old + 1u == (gen + 1u) * nloc) {
            __builtin_amdgcn_fence(__ATOMIC_RELEASE, "agent");
            asm volatile("s_waitcnt vmcnt(0)" ::: "memory");
            const unsigned og = xb_add(&bar[XB_TOP], 1u);
            const unsigned tg = og / nx;
            if (og + 1u == (tg + 1u) * nx) xb_add(&bar[XB_TOPGEN], 1u);
            else XB_SPIN(xb_ld(&bar[XB_TOPGEN]) == tg, bar);
            __builtin_amdgcn_fence(__ATOMIC_ACQUIRE, "agent");
            xb_add(&bar[XB_XGEN(b.x)], 1u);
            asm volatile("s_waitcnt vmcnt(0)" ::: "memory");
        } else {
            XB_SPIN(xb_ld(&bar[XB_XGEN(b.x)]) == gen, bar);
            __builtin_amdgcn_fence(__ATOMIC_ACQUIRE, "agent");
            asm volatile("s_waitcnt vmcnt(0)" ::: "memory");
        }
    }
    __syncthreads();
}

struct Args { const float* in[31]; float* out; unsigned char* ws; int ph_lo, ph_hi; };
struct Ctx { int tid, lane, wave, vcu, G, gw, NGW; LAS unsigned char* lds; unsigned char* ws; };

__device__ __forceinline__ void transpose_item(const float* W, int K, int N, bf16* WT, LAS float* scr, int kb, int nb, int lane) {
    const int k0 = 64 * kb, n0 = 64 * nb, nq = 4 * (lane & 15), kr = lane >> 4; const bool nv = n0 + nq < N;
    f32x4 v[16];
#pragma unroll
    for (int i = 0; i < 16; ++i) v[i] = nv ? *(const f32x4*)(W + (size_t)(k0 + 4 * i + kr) * N + n0 + nq) : (f32x4){0.f, 0.f, 0.f, 0.f};
#pragma unroll
    for (int i = 0; i < 16; ++i) { LAS float* d = scr + (4 * i + kr) * 65 + nq; d[0] = v[i].x; d[1] = v[i].y; d[2] = v[i].z; d[3] = v[i].w; }
    asm volatile("s_waitcnt lgkmcnt(0)" ::: "memory");
    const int c = lane & 7;
#pragma unroll
    for (int j = 0; j < 8; ++j) { const int nn = (lane >> 3) + 8 * j; const LAS float* s = scr + (8 * c) * 65 + nn;
        u32x4 o; o.x = pk2(s[0 * 65], s[1 * 65]); o.y = pk2(s[2 * 65], s[3 * 65]); o.z = pk2(s[4 * 65], s[5 * 65]); o.w = pk2(s[6 * 65], s[7 * 65]);
        *(u32x4*)(WT + (size_t)(n0 + nn) * K + k0 + 8 * c) = o; }
    asm volatile("s_waitcnt lgkmcnt(0)" ::: "memory");
}

__device__ __forceinline__ void rms_row(const float* xrow, const float* w, bf16* obf, unsigned long long* ss, float* of32, int lane) {
    f32x4 v[8]; float s = 0.f;
#pragma unroll
    for (int j = 0; j < 8; ++j) { v[j] = *(const f32x4*)(xrow + 4 * lane + 256 * j); s += (v[j].x * v[j].x + v[j].y * v[j].y) + (v[j].z * v[j].z + v[j].w * v[j].w); }
    s = wave_sum(s);
    const float r = obf ? 1.f : 1.f / sqrtf(s * (1.f / DM) + 1e-6f);
#pragma unroll
    for (int j = 0; j < 8; ++j) { const f32x4 ww = *(const f32x4*)(w + 4 * lane + 256 * j); const f32x4 o = v[j] * r * ww;
        if (obf) { u32x2 p; p.x = pk2(o.x, o.y); p.y = pk2(o.z, o.w); *(u32x2*)(obf + 4 * lane + 256 * j) = p; }
        else *(f32x4*)(of32 + 4 * lane + 256 * j) = o; }
    if (obf && lane == 0) *ss = (unsigned long long)(s * 65536.f + 0.5f);
}

__device__ __forceinline__ void phase0(const Ctx& F, const Args& a) {
    LAS float* scr = (LAS float*)(F.lds + F.wave * 16640);
    constexpr int I_IN = 32 * 260, I_GLU = 16 * 16, I_BR = 16 * 32, I_OUT = 32 * 32, IL = I_IN + I_GLU + 3 * I_BR + I_OUT;
    bf16* WIN = (bf16*)(F.ws + WS_WIN); bf16* WGLU = (bf16*)(F.ws + WS_WGLU); bf16* WBR = (bf16*)(F.ws + WS_WBR); bf16* WOUT = (bf16*)(F.ws + WS_WOUT);
    for (int it = F.gw; it < DEPTH * IL; it += F.NGW) {
        const int l = it / IL; int r = it - l * IL;
        if (r < I_IN) { transpose_item(a.in[2] + (size_t)l * DM * NIN, DM, NIN, WIN + (size_t)l * NINP * DM, scr, r / 260, r % 260, F.lane); continue; } r -= I_IN;
        if (r < I_GLU) { transpose_item(a.in[25] + (size_t)l * 1024 * 1024, 1024, 1024, WGLU + (size_t)l * 1024 * 1024, scr, r / 16, r % 16, F.lane); continue; } r -= I_GLU;
        if (r < 3 * I_BR) { const int br = r / I_BR, r2 = r - br * I_BR;
            transpose_item(a.in[28] + (size_t)(l * 3 + br) * 1024 * DM, 1024, DM, WBR + (size_t)(l * 3 + br) * DM * 1024, scr, r2 / 32, r2 % 32, F.lane); continue; } r -= 3 * I_BR;
        transpose_item(a.in[29] + (size_t)l * DM * DM, DM, DM, WOUT + (size_t)l * DM * DM, scr, r / 32, r % 32, F.lane);
    }
    bf16* XN = (bf16*)(F.ws + WS_XN);
    {
        bf16* LT = (bf16*)(F.ws + WS_LORA);
        for (int it = F.gw * 64 + F.lane; it < DEPTH * 2 * 1024 * 12; it += F.NGW * 64) {
            const int kg = it % 12, n = (it / 12) & 1023, lw = it / (12 * 1024), l = lw >> 1, which = lw & 1;
            const float* src = (which ? a.in[11] : a.in[9]) + (size_t)l * 96 * 1024 + (size_t)(8 * kg) * 1024 + n;
            u32x4 o; o.x = pk2(src[0], src[1024]); o.y = pk2(src[2048], src[3072]); o.z = pk2(src[4096], src[5120]); o.w = pk2(src[6144], src[7168]);
            *(u32x4*)(LT + ((size_t)lw * 1024 + n) * 96 + 8 * kg) = o;
        }
    }
    unsigned long long* SS0 = (unsigned long long*)(F.ws + WS_CTL + CTL_SS);
    for (int m = F.gw; m < TOK; m += F.NGW) rms_row(a.in[0] + (size_t)m * DM, a.in[1], XN + (size_t)m * DM, SS0 + m, nullptr, F.lane);
}

__device__ __forceinline__ void prep_gdn(const Ctx& F, const Args& a, int l) {
    const bf16* PROJ = (const bf16*)(F.ws + WS_PROJ);
    float* GQ = (float*)(F.ws + WS_GQ); float* GK = (float*)(F.ws + WS_GK); float* GV = (float*)(F.ws + WS_GV); float* GEG = (float*)(F.ws + WS_GEG); float* GBE = (float*)(F.ws + WS_GBE);
    const float* cw = a.in[3] + (size_t)l * 4 * 3072;
    for (int it = F.gw; it < 2048; it += F.NGW) {
        const int h = it & 7, ch = (it >> 3) & 63, b = it >> 9;
        const int t0 = ch * 32; const int c = 2 * F.lane;
        float w[3][4][2], hist[3][3][2];
#pragma unroll
        for (int p = 0; p < 3; ++p)
#pragma unroll
            for (int j = 0; j < 4; ++j) { const f32x2 ww = *(const f32x2*)(cw + j * 3072 + p * 1024 + h * 128 + c); w[p][j][0] = ww.x; w[p][j][1] = ww.y; }
#pragma unroll
        for (int p = 0; p < 3; ++p)
#pragma unroll
            for (int j = 0; j < 3; ++j) { const int t = t0 - 3 + j; unsigned x = 0u;
                if (t >= 0) x = *(const unsigned*)(PROJ + (size_t)(b * SEQ + t) * NINP + C_GQKV + p * 1024 + h * 128 + c);
                hist[p][j][0] = bflo(x); hist[p][j][1] = bfhi(x); }
        const float alog = a.in[4][l * 8 + h], dtb = a.in[5][l * 8 + h]; const float aexp = expf(alog);
        unsigned raw[3][32];
#pragma unroll
        for (int tt = 0; tt < 32; ++tt)
#pragma unroll
            for (int p = 0; p < 3; ++p) raw[p][tt] = *(const unsigned*)(PROJ + (size_t)(b * SEQ + t0 + tt) * NINP + C_GQKV + p * 1024 + h * 128 + c);
#pragma unroll
        for (int tt = 0; tt < 32; ++tt) {
            const size_t tok = (size_t)(b * SEQ + t0 + tt);
            float o[3][2];
#pragma unroll
            for (int p = 0; p < 3; ++p) {
                const unsigned x = raw[p][tt];
                const float x0 = bflo(x), x1 = bfhi(x);
                const float y0 = w[p][0][0] * hist[p][0][0] + w[p][1][0] * hist[p][1][0] + w[p][2][0] * hist[p][2][0] + w[p][3][0] * x0;
                const float y1 = w[p][0][1] * hist[p][0][1] + w[p][1][1] * hist[p][1][1] + w[p][2][1] * hist[p][2][1] + w[p][3][1] * x1;
                hist[p][0][0] = hist[p][1][0]; hist[p][1][0] = hist[p][2][0]; hist[p][2][0] = x0;
                hist[p][0][1] = hist[p][1][1]; hist[p][1][1] = hist[p][2][1]; hist[p][2][1] = x1;
                o[p][0] = siluf_(y0); o[p][1] = siluf_(y1);
            }
            const float sq = wave_sum(o[0][0] * o[0][0] + o[0][1] * o[0][1]), sk = wave_sum(o[1][0] * o[1][0] + o[1][1] * o[1][1]);
            const float rq = 0.08838834764831845f * rsqrtf(sq + 1e-6f), rk = rsqrtf(sk + 1e-6f);
            const size_t off = tok * 1024 + h * 128 + c;
            *(unsigned*)((bf16*)GQ + off) = pk2(o[0][0] * rq, o[0][1] * rq);
            *(unsigned*)((bf16*)GK + off) = pk2(o[1][0] * rk, o[1][1] * rk);
            *(unsigned*)((bf16*)GV + off) = pk2(o[2][0], o[2][1]);
            if (F.lane == 0) {
                const float bl = bf1(PROJ[tok * NINP + C_GB + h]), al = bf1(PROJ[tok * NINP + C_GA + h]);
                GBE[tok * 8 + h] = sigmoidf_(bl);
                GEG[tok * 8 + h] = expf(-aexp * softplusf_(al + dtb));
            }
        }
    }
}

__device__ __forceinline__ float mix2(unsigned c, unsigned p, float mu0, float mu1, float& o1) {
    const float c0 = bflo(c), c1 = bfhi(c), p0 = bflo(p), p1 = bfhi(p);
    o1 = c1 + (p1 - c1) * mu1; return c0 + (p0 - c0) * mu0;
}
__device__ __forceinline__ void prep_rwkv(const Ctx& F, const Args& a, int l) {
    const bf16* PROJ = (const bf16*)(F.ws + WS_PROJ);
    float* RR = (float*)(F.ws + WS_RR); float* RW = (float*)(F.ws + WS_RW); float* RK = (float*)(F.ws + WS_RK); float* RV = (float*)(F.ws + WS_RV);
    float* RKK = (float*)(F.ws + WS_RKK); float* RKA = (float*)(F.ws + WS_RKA); float* RBON = (float*)(F.ws + WS_RBON);
    const float* mu = a.in[7] + (size_t)l * 3264; const float* w0 = a.in[8] + l * 1024; const float* wup = a.in[9] + (size_t)l * 96 * 1024;
    const float* a0 = a.in[10] + l * 1024; const float* aup = a.in[11] + (size_t)l * 96 * 1024; const float* kk_ = a.in[12] + l * 1024; const float* ka_ = a.in[13] + l * 1024; const float* rk_ = a.in[14] + l * 1024;
    constexpr int AROW = 104;
    LAS bf16* A1 = (LAS bf16*)F.lds; LAS bf16* A2 = A1 + 16 * AROW;
    LAS float* LW = (LAS float*)(F.lds + 8192); LAS float* LA = LW + 16 * 1024;
    const bf16* LTw = (const bf16*)(F.ws + WS_LORA) + (size_t)(2 * l) * 1024 * 96; const bf16* LTa = LTw + 1024 * 96;
    const int j = F.tid, c = 2 * j;
    const f32x2 mur = *(const f32x2*)(mu + c), muk = *(const f32x2*)(mu + 1024 + c), muv = *(const f32x2*)(mu + 2048 + c);
    const f32x2 w0v = *(const f32x2*)(w0 + c), a0v = *(const f32x2*)(a0 + c), kkv = *(const f32x2*)(kk_ + c), kav = *(const f32x2*)(ka_ + c), rkv = *(const f32x2*)(rk_ + c);
    for (int tile = F.vcu; tile < TOK / 16; tile += F.G) {
        __syncthreads();
        for (int e = F.tid; e < 16 * 192; e += NTHREADS) {
            const int tl = e / 192, i = e - tl * 192; const size_t tok = (size_t)tile * 16 + tl;
            const float cur = bf1(PROJ[tok * NINP + C_RF + 3072 + i]);
            const float prv = (tok & (SEQ - 1)) ? bf1(PROJ[(tok - 1) * NINP + C_RF + 3072 + i]) : 0.f;
            const float m = cur + (prv - cur) * mu[3072 + i];
            if (i < 96) A1[tl * AROW + i] = (bf16)f2bf(tanhf(m)); else A2[tl * AROW + i - 96] = (bf16)f2bf(m);
        }
        __syncthreads();
        {
            const int row = F.lane & 15, quad = F.lane >> 4;
            bf16x8_t fw[3], fa[3];
#pragma unroll
            for (int ks = 0; ks < 3; ++ks) { fw[ks] = *(const LAS bf16x8_t*)(A1 + row * AROW + 32 * ks + 8 * quad); fa[ks] = *(const LAS bf16x8_t*)(A2 + row * AROW + 32 * ks + 8 * quad); }
#pragma unroll 2
            for (int nt = 0; nt < 8; ++nt) {
                const int n = 128 * F.wave + 16 * nt + row;
                f32x4 aw = {0.f, 0.f, 0.f, 0.f}, aa = {0.f, 0.f, 0.f, 0.f};
#pragma unroll
                for (int ks = 0; ks < 3; ++ks) {
                    const bf16x8_t bw = *(const bf16x8_t*)(LTw + (size_t)n * 96 + 32 * ks + 8 * quad), ba = *(const bf16x8_t*)(LTa + (size_t)n * 96 + 32 * ks + 8 * quad);
                    aw = __builtin_amdgcn_mfma_f32_16x16x32_bf16(fw[ks], bw, aw, 0, 0, 0); aa = __builtin_amdgcn_mfma_f32_16x16x32_bf16(fa[ks], ba, aa, 0, 0, 0);
                }
#pragma unroll
                for (int r = 0; r < 4; ++r) { LW[(4 * quad + r) * 1024 + n] = aw[r]; LA[(4 * quad + r) * 1024 + n] = aa[r]; }
            }
        }
        __syncthreads();
        unsigned rw[17][3];
#pragma unroll
        for (int tl = 0; tl < 17; ++tl) { const size_t tok = (size_t)tile * 16 + tl - 1; const bool ok = tl > 0 || ((tok + 1) & (SEQ - 1)) != 0;
            const bf16* cp = PROJ + tok * NINP + C_RF + c;
#pragma unroll
            for (int q = 0; q < 3; ++q) rw[tl][q] = ok ? *(const unsigned*)(cp + 1024 * q) : 0u; }
#pragma unroll
        for (int tl = 0; tl < 16; ++tl) {
            const size_t tok = (size_t)tile * 16 + tl; const bool hp = (tok & (SEQ - 1)) != 0;
            const unsigned cr = rw[tl + 1][0], ck = rw[tl + 1][1], cv = rw[tl + 1][2];
            const unsigned pr = hp ? rw[tl][0] : 0u, pk = hp ? rw[tl][1] : 0u, pv = hp ? rw[tl][2] : 0u;
            float r1, k1, v1; const float r0 = mix2(cr, pr, mur.x, mur.y, r1), k0 = mix2(ck, pk, muk.x, muk.y, k1), v0 = mix2(cv, pv, muv.x, muv.y, v1);
            const f32x2 lw = *(const LAS f32x2*)(LW + tl * 1024 + c), la = *(const LAS f32x2*)(LA + tl * 1024 + c);
            const float wp0 = w0v.x + lw.x, wp1 = w0v.y + lw.y;
            const float d0 = __expf(-0.6065306597126334f * sigmoidf_(wp0)), d1 = __expf(-0.6065306597126334f * sigmoidf_(wp1));
            const float aa0 = sigmoidf_(a0v.x + la.x), aa1 = sigmoidf_(a0v.y + la.y);
            const float q0 = k0 * kkv.x, q1 = k1 * kkv.y;
            float ss = q0 * q0 + q1 * q1;
#pragma unroll
            for (int o = 1; o < 32; o <<= 1) ss += __shfl_xor(ss, o);
            const float rn = rsqrtf(ss + 1e-6f); const float n0 = q0 * rn, n1 = q1 * rn;
            const float km0 = k0 * (1.f + (aa0 - 1.f) * kav.x), km1 = k1 * (1.f + (aa1 - 1.f) * kav.y);
            float bo = r0 * km0 * rkv.x + r1 * km1 * rkv.y;
#pragma unroll
            for (int o = 1; o < 32; o <<= 1) bo += __shfl_xor(bo, o);
            const size_t off = tok * 1024 + c;
            *(unsigned*)((bf16*)RR + off) = pk2(r0, r1); *(f32x2*)(RW + off) = (f32x2){d0, d1}; *(unsigned*)((bf16*)RK + off) = pk2(km0, km1); *(unsigned*)((bf16*)RV + off) = pk2(v0, v1);
            *(f32x2*)(RKK + off) = (f32x2){-n0, -n1}; *(unsigned*)((bf16*)RKA + off) = pk2(n0 * aa0, n1 * aa1);
            if ((F.lane & 31) == 0) RBON[tok * 16 + (c >> 6)] = bo;
        }
    }
}

#ifndef SCM
#define SCM 7
#endif
#ifndef REPM
#define REPM 0
#endif
constexpr int CH = 32;
#define WFENCE() do { __builtin_amdgcn_fence(__ATOMIC_RELEASE, "wavefront"); __builtin_amdgcn_wave_barrier(); __builtin_amdgcn_fence(__ATOMIC_ACQUIRE, "wavefront"); } while (0)

struct GStep { f32x4 k0, k1, q0, q1; float v, eg, be; };
constexpr int G_BUF = 2 * CH * 128 + CH * 32 + 2 * CH;
__device__ __forceinline__ void gdn_lds(GStep& s, const LAS float* buf, int st, int rg, int colL) {
    s.k0 = *(const LAS f32x4*)(buf + st * 128 + rg * 4); s.k1 = *(const LAS f32x4*)(buf + st * 128 + 64 + rg * 4);
    s.q0 = *(const LAS f32x4*)(buf + CH * 128 + st * 128 + rg * 4); s.q1 = *(const LAS f32x4*)(buf + CH * 128 + st * 128 + 64 + rg * 4);
    s.v = buf[2 * CH * 128 + st * 32 + colL]; s.eg = buf[2 * CH * 128 + CH * 32 + st]; s.be = buf[2 * CH * 128 + CH * 32 + CH + st];
}
__device__ __forceinline__ void gdn_step(const GStep& s, f32x2 (&S)[4], LAS float* ob, bool wr) {
    const f32x2 k01 = s.k0.xy, k23 = s.k0.zw, k45 = s.k1.xy, k67 = s.k1.zw;
    const f32x2 a2 = (k01 * S[0] + k23 * S[1]) + (k45 * S[2] + k67 * S[3]);
    const float ks = allred16(a2.x + a2.y);
    const float cc = s.be * (s.v - s.eg * ks);
    S[0] = S[0] * s.eg + k01 * cc; S[1] = S[1] * s.eg + k23 * cc; S[2] = S[2] * s.eg + k45 * cc; S[3] = S[3] * s.eg + k67 * cc;
    const f32x2 o2 = (s.q0.xy * S[0] + s.q0.zw * S[1]) + (s.q1.xy * S[2] + s.q1.zw * S[3]);
    const float o = allred16(o2.x + o2.y);
    if (wr) *ob = o;
}
struct GStage { u32x4 k, q, v; float e; };
__device__ __forceinline__ void gdn_gload(GStage& g, const bf16* GK, const bf16* GQ, const bf16* GV, const float* GEG, const float* GBE, int t0, int tid) {
    { const int st = tid >> 4, f8 = tid & 15; g.k = *(const u32x4*)(GK + (size_t)(t0 + st) * 1024 + 8 * f8); g.q = *(const u32x4*)(GQ + (size_t)(t0 + st) * 1024 + 8 * f8); }
    { const int i = tid & 127; g.v = *(const u32x4*)(GV + (size_t)(t0 + (i >> 2)) * 1024 + 8 * (i & 3)); }
    { const int i = tid & 63; const float* p = (i < 32 ? GEG : GBE); g.e = p[(size_t)(t0 + (i & 31)) * 8]; }
}
__device__ __forceinline__ void st8(LAS float* d, const u32x4 w) { float f[8]; unpack8(w, f); *(LAS f32x4*)d = (f32x4){f[0], f[1], f[2], f[3]}; *(LAS f32x4*)(d + 4) = (f32x4){f[4], f[5], f[6], f[7]}; }
__device__ __forceinline__ void gdn_gstore(const GStage& g, LAS float* buf, int tid) {
    st8(buf + 8 * tid, g.k); st8(buf + CH * 128 + 8 * tid, g.q);
    if (tid < 128) st8(buf + 2 * CH * 128 + 8 * tid, g.v);
    else if (tid >= 256 && tid < 320) buf[2 * CH * 128 + CH * 32 + (tid - 256)] = g.e;
}
__device__ __forceinline__ void gdn_block(const Ctx& F, int vb) {
    const int bh = vb >> 2, qt = vb & 3, b = bh >> 3, h = bh & 7, colL = F.wave * 4 + (F.lane >> 4), rg = F.lane & 15;
    const size_t base = (size_t)b * SEQ;
    const bf16* GK = (const bf16*)(F.ws + WS_GK) + base * 1024 + h * 128; const bf16* GQ = (const bf16*)(F.ws + WS_GQ) + base * 1024 + h * 128;
    const bf16* GV = (const bf16*)(F.ws + WS_GV) + base * 1024 + h * 128 + qt * 32;
    const float* GEG = (const float*)(F.ws + WS_GEG) + base * 8 + h; const float* GBE = (const float*)(F.ws + WS_GBE) + base * 8 + h;
    float* GO = (float*)(F.ws + WS_GO) + base * 1024 + h * 128 + qt * 32;
    LAS float* lb = (LAS float*)F.lds; LAS float* obase = lb + 2 * G_BUF;
    f32x2 S[4] = {{0.f, 0.f}, {0.f, 0.f}, {0.f, 0.f}, {0.f, 0.f}};
    const bool wr = rg == 0;
    GStage g;
    gdn_gload(g, GK, GQ, GV, GEG, GBE, 0, F.tid); gdn_gstore(g, lb, F.tid);
    __syncthreads();
    for (int c = 0; c < SEQ / CH; ++c) {
        const LAS float* buf = lb + (c & 1) * G_BUF; LAS float* ob = obase + (c & 1) * (CH * 32) + colL;
        if (c + 1 < SEQ / CH) gdn_gload(g, GK, GQ, GV, GEG, GBE, (c + 1) * CH, F.tid);
        GStep R0, R1, R2, R3;
        gdn_lds(R0, buf, 0, rg, colL); gdn_lds(R1, buf, 1, rg, colL);
#pragma unroll 1
        for (int s = 0; s < CH; s += 4) {
            gdn_lds(R2, buf, s + 2, rg, colL); gdn_step(R0, S, ob + s * 32, wr);
            gdn_lds(R3, buf, s + 3, rg, colL); gdn_step(R1, S, ob + (s + 1) * 32, wr);
            gdn_lds(R0, buf, (s + 4) & (CH - 1), rg, colL); gdn_step(R2, S, ob + (s + 2) * 32, wr);
            gdn_lds(R1, buf, (s + 5) & (CH - 1), rg, colL); gdn_step(R3, S, ob + (s + 3) * 32, wr);
        }
        if (c + 1 < SEQ / CH) gdn_gstore(g, lb + ((c + 1) & 1) * G_BUF, F.tid);
        __syncthreads();
        if (F.tid < 256) *(f32x4*)(GO + (size_t)(c * CH + (F.tid >> 3)) * 1024 + 4 * (F.tid & 7)) = *(const LAS f32x4*)(obase + (c & 1) * (CH * 32) + 4 * F.tid);
    }
}

struct RStep { f32x4 w, n, a, k, r; float v; };
constexpr int R_BUF = CH * (5 * 64 + 32);
__device__ __forceinline__ void rwkv_lds(RStep& s, const LAS float* buf, int st, int cq, int rowL) {
    s.w = *(const LAS f32x4*)(buf + st * 64 + 4 * cq); s.n = *(const LAS f32x4*)(buf + CH * 64 + st * 64 + 4 * cq); s.a = *(const LAS f32x4*)(buf + 2 * CH * 64 + st * 64 + 4 * cq);
    s.k = *(const LAS f32x4*)(buf + 3 * CH * 64 + st * 64 + 4 * cq); s.r = *(const LAS f32x4*)(buf + 4 * CH * 64 + st * 64 + 4 * cq); s.v = buf[5 * CH * 64 + st * 32 + rowL];
}
__device__ __forceinline__ void rwkv_step(const RStep& s, f32x4& S, LAS float* ob, bool wr) {
    float sa = (S.x * s.n.x + S.y * s.n.y) + (S.z * s.n.z + S.w * s.n.w);
    sa = allred16(sa);
    S = S * s.w + sa * s.a + s.v * s.k;
    float y = (S.x * s.r.x + S.y * s.r.y) + (S.z * s.r.z + S.w * s.r.w);
    y = allred16(y);
    if (wr) *ob = y;
}
struct RStage { f32x4 x[2]; u32x4 y[3], v; };
__device__ __forceinline__ void rwkv_gload(RStage& g, const float* RW, const float* RN, const bf16* RA, const bf16* RKp, const bf16* RRp, const bf16* RV, int t0, int tid) {
    { const int st = tid >> 4, f4 = tid & 15; g.x[0] = *(const f32x4*)(RW + (size_t)(t0 + st) * 1024 + 4 * f4); g.x[1] = *(const f32x4*)(RN + (size_t)(t0 + st) * 1024 + 4 * f4); }
    { const int i = tid & 255; const size_t o = (size_t)(t0 + (i >> 3)) * 1024 + 8 * (i & 7); g.y[0] = *(const u32x4*)(RA + o); g.y[1] = *(const u32x4*)(RKp + o); g.y[2] = *(const u32x4*)(RRp + o); }
    { const int i = tid & 127; g.v = *(const u32x4*)(RV + (size_t)(t0 + (i >> 2)) * 1024 + 8 * (i & 3)); }
}
__device__ __forceinline__ void rwkv_gstore(const RStage& g, LAS float* buf, int tid) {
    *(LAS f32x4*)(buf + 4 * tid) = g.x[0]; *(LAS f32x4*)(buf + CH * 64 + 4 * tid) = g.x[1];
    if (tid < 256) { st8(buf + 2 * CH * 64 + 8 * tid, g.y[0]); st8(buf + 3 * CH * 64 + 8 * tid, g.y[1]); st8(buf + 4 * CH * 64 + 8 * tid, g.y[2]); }
    else if (tid < 384) st8(buf + 5 * CH * 64 + 8 * (tid - 256), g.v);
}
__device__ __forceinline__ void rwkv_block(const Ctx& F, int vb) {
    const int bh = vb >> 1, hf = vb & 1, b = bh >> 4, h = bh & 15, rowL = F.wave * 4 + (F.lane >> 4), cq = F.lane & 15;
    const size_t base = (size_t)b * SEQ * 1024 + h * 64;
    const float* RW = (const float*)(F.ws + WS_RW) + base; const float* RN = (const float*)(F.ws + WS_RKK) + base;
    const bf16* RA = (const bf16*)(F.ws + WS_RKA) + base; const bf16* RKp = (const bf16*)(F.ws + WS_RK) + base; const bf16* RRp = (const bf16*)(F.ws + WS_RR) + base;
    const bf16* RV = (const bf16*)(F.ws + WS_RV) + base + hf * 32;
    float* RY = (float*)(F.ws + WS_RY) + base + hf * 32;
    LAS float* lb = (LAS float*)F.lds; LAS float* obase = lb + 2 * R_BUF;
    f32x4 S = {0.f, 0.f, 0.f, 0.f};
    const bool wr = cq == 0;
    RStage g;
    rwkv_gload(g, RW, RN, RA, RKp, RRp, RV, 0, F.tid); rwkv_gstore(g, lb, F.tid);
    __syncthreads();
    for (int c = 0; c < SEQ / CH; ++c) {
        const LAS float* buf = lb + (c & 1) * R_BUF; LAS float* ob = obase + (c & 1) * (CH * 32) + rowL;
        if (c + 1 < SEQ / CH) rwkv_gload(g, RW, RN, RA, RKp, RRp, RV, (c + 1) * CH, F.tid);
        RStep R0, R1, R2, R3;
        rwkv_lds(R0, buf, 0, cq, rowL); rwkv_lds(R1, buf, 1, cq, rowL);
#pragma unroll 1
        for (int s = 0; s < CH; s += 4) {
            rwkv_lds(R2, buf, s + 2, cq, rowL); rwkv_step(R0, S, ob + s * 32, wr);
            rwkv_lds(R3, buf, s + 3, cq, rowL); rwkv_step(R1, S, ob + (s + 1) * 32, wr);
            rwkv_lds(R0, buf, (s + 4) & (CH - 1), cq, rowL); rwkv_step(R2, S, ob + (s + 2) * 32, wr);
            rwkv_lds(R1, buf, (s + 5) & (CH - 1), cq, rowL); rwkv_step(R3, S, ob + (s + 3) * 32, wr);
        }
        if (c + 1 < SEQ / CH) rwkv_gstore(g, lb + ((c + 1) & 1) * R_BUF, F.tid);
        __syncthreads();
        if (F.tid < 256) *(f32x4*)(RY + (size_t)(c * CH + (F.tid >> 3)) * 1024 + 4 * (F.tid & 7)) = *(const LAS f32x4*)(obase + (c & 1) * (CH * 32) + 4 * F.tid);
    }
}

constexpr int S5_SROW = 136;
constexpr int S5_WAVE_B = 16 * S5_SROW * 2 + 1024;
__device__ __forceinline__ void s5_block(const Ctx& F, const Args& a, int l, int it) {
    const int b = it >> 6, g = it & 63, p = F.lane, tl = F.lane >> 4, c = F.lane & 15, w = F.wave;
    const bf16* PROJ = (const bf16*)(F.ws + WS_PROJ); bf16* SY = (bf16*)(F.ws + WS_SY);
    LAS float* se = (LAS float*)F.lds;
    LAS unsigned char* wb = F.lds + 4096 + w * S5_WAVE_B;
    LAS bf16* sbuf = (LAS bf16*)wb; LAS float* uall = (LAS float*)(wb + 16 * S5_SROW * 2);
    const size_t gp = ((size_t)l * 64 + g) * 64 + p;
    const float dt = expf(a.in[19][l * 64 + g]); const float are = a.in[17][gp], aim = a.in[18][gp];
    const float mag = expf(are * dt), abr = mag * cosf(aim * dt), abi = mag * sinf(aim * dt);
    const float den = are * are + aim * aim, cr = ((abr - 1.f) * are + abi * aim) / den, ci = (abi * are - (abr - 1.f) * aim) / den;
    float Bre[16], Bim[16];
#pragma unroll
    for (int q = 0; q < 4; ++q) { const f32x4 br = *(const f32x4*)(a.in[20] + gp * 16 + 4 * q), bi = *(const f32x4*)(a.in[21] + gp * 16 + 4 * q);
#pragma unroll
        for (int e = 0; e < 4; ++e) { Bre[4 * q + e] = cr * br[e] - ci * bi[e]; Bim[4 * q + e] = cr * bi[e] + ci * br[e]; } }
    bf16x8_t Cf[4];
    { const size_t cb = (((size_t)l * 64 + g) * 16 + c) * 64;
#pragma unroll
      for (int m = 0; m < 4; ++m) { const int k0 = 32 * m + 8 * tl; const float* src = (k0 < 64 ? a.in[22] + cb + k0 : a.in[23] + cb + (k0 - 64)); const float sg = k0 < 64 ? 1.f : -1.f;
          const f32x4 x0 = *(const f32x4*)src, x1 = *(const f32x4*)(src + 4);
          u32x4 pk; pk.x = pk2(sg * x0.x, sg * x0.y); pk.y = pk2(sg * x0.z, sg * x0.w); pk.z = pk2(sg * x1.x, sg * x1.y); pk.w = pk2(sg * x1.z, sg * x1.w);
          Cf[m] = __builtin_bit_cast(bf16x8_t, pk); } }
    const float dsk = a.in[24][l * 1024 + g * 16 + c];
    const int tw = 256 * w;
    const bf16* up = PROJ + ((size_t)b * SEQ + tw) * NINP + C_SU + g * 16;
    float sr = 0.f, si = 0.f;
    {
        bf16 ucur = up[(size_t)tl * NINP + c], unxt = up[(size_t)(4 + tl) * NINP + c];
        for (int t = 0; t < 256; t += 4) {
            uall[F.lane] = bf1(ucur);
            WFENCE();
            const int tn = (t + 8 < 256) ? t + 8 : t;
            const bf16 unn = up[(size_t)(tn + tl) * NINP + c];
#pragma unroll
            for (int j = 0; j < 4; ++j) {
                float br = 0.f, bi = 0.f;
#pragma unroll
                for (int q = 0; q < 4; ++q) { const f32x4 u4 = *(const LAS f32x4*)(uall + j * 16 + 4 * q);
#pragma unroll
                    for (int e = 0; e < 4; ++e) { br += Bre[4 * q + e] * u4[e]; bi += Bim[4 * q + e] * u4[e]; } }
                const float nr = abr * sr - abi * si + br, ni = abr * si + abi * sr + bi; sr = nr; si = ni;
            }
            WFENCE();
            ucur = unxt; unxt = unn;
        }
    }
    se[w * 128 + p] = sr; se[w * 128 + 64 + p] = si;
    __syncthreads();
    {
        float pr = abr, pi = abi;
#pragma unroll
        for (int i = 0; i < 8; ++i) { const float nr = pr * pr - pi * pi, ni = 2.f * pr * pi; pr = nr; pi = ni; }
        sr = 0.f; si = 0.f;
        for (int j = 0; j < w; ++j) { const float er = se[j * 128 + p], ei = se[j * 128 + 64 + p]; const float nr = pr * sr - pi * si + er, ni = pr * si + pi * sr + ei; sr = nr; si = ni; }
    }
    {
        bf16 ucur = up[(size_t)tl * NINP + c], unxt = up[(size_t)(4 + tl) * NINP + c];
        for (int t = 0; t < 256; t += 16) {
#pragma unroll
            for (int sub = 0; sub < 4; ++sub) {
                uall[sub * 64 + F.lane] = bf1(ucur);
                WFENCE();
                const int tn = (t + 4 * sub + 8 < 256) ? t + 4 * sub + 8 : t + 4 * sub;
                const bf16 unn = up[(size_t)(tn + tl) * NINP + c];
#pragma unroll
                for (int j = 0; j < 4; ++j) {
                    float br = 0.f, bi = 0.f;
#pragma unroll
                    for (int q = 0; q < 4; ++q) { const f32x4 u4 = *(const LAS f32x4*)(uall + sub * 64 + j * 16 + 4 * q);
#pragma unroll
                        for (int e = 0; e < 4; ++e) { br += Bre[4 * q + e] * u4[e]; bi += Bim[4 * q + e] * u4[e]; } }
                    const float nr = abr * sr - abi * si + br, ni = abr * si + abi * sr + bi; sr = nr; si = ni;
                    sbuf[(sub * 4 + j) * S5_SROW + p] = (bf16)f2bf(sr); sbuf[(sub * 4 + j) * S5_SROW + 64 + p] = (bf16)f2bf(si);
                }
                ucur = unxt; unxt = unn;
            }
            WFENCE();
            f32x4 acc = {0.f, 0.f, 0.f, 0.f};
#pragma unroll
            for (int m = 0; m < 4; ++m) { const bf16x8_t af = *(const LAS bf16x8_t*)(sbuf + c * S5_SROW + 32 * m + 8 * tl);
                acc = __builtin_amdgcn_mfma_f32_16x16x32_bf16(af, Cf[m], acc, 0, 0, 0); }
#pragma unroll
            for (int r = 0; r < 4; ++r) { const int st = 4 * tl + r; const float y = acc[r] + dsk * uall[st * 16 + c];
                SY[((size_t)b * SEQ + tw + t + st) * 1024 + g * 16 + c] = (bf16)f2bf(gelu_tanh(y)); }
            WFENCE();
        }
    }
    __syncthreads();
}

__device__ __forceinline__ void scan_phase(const Ctx& F, const Args& a, int l) {
    for (int r5 = 0; r5 < 1 + ((REPM >> 9) & 1); ++r5) for (int vb = F.vcu; vb < 256; vb += F.G) s5_block(F, a, l, vb);
    for (int rg_ = 0; rg_ < 1 + ((REPM >> 10) & 1); ++rg_) for (int vb = F.vcu; vb < 256; vb += F.G) {
        if (vb < 128) { gdn_block(F, vb); if (REPM & 2048) gdn_block(F, vb); }
        else { rwkv_block(F, vb - 128); if (REPM & 4096) rwkv_block(F, vb - 128); }
    }
}

__device__ __forceinline__ void post_phase(const Ctx& F, const Args& a, int l, int gw, int ngw) {
    const bf16* PROJ = (const bf16*)(F.ws + WS_PROJ); bf16* OBR = (bf16*)(F.ws + WS_OBR);
    const float* GO = (const float*)(F.ws + WS_GO); const float* RY = (const float*)(F.ws + WS_RY); const float* RV = (const float*)(F.ws + WS_RV); const float* RBON = (const float*)(F.ws + WS_RBON);
    const int c0 = 16 * F.lane;
    float nw[16], lw[16], lb[16];
#pragma unroll
    for (int e = 0; e < 16; ++e) { nw[e] = a.in[6][l * 128 + (c0 & 127) + e]; lw[e] = a.in[15][l * 1024 + c0 + e]; lb[e] = a.in[16][l * 1024 + c0 + e]; }
    for (int tok = gw; tok < TOK; tok += ngw) {
        { float o[16];
#pragma unroll
          for (int q = 0; q < 4; ++q) { const f32x4 v = *(const f32x4*)(GO + (size_t)tok * 1024 + c0 + 4 * q); o[4 * q] = v.x; o[4 * q + 1] = v.y; o[4 * q + 2] = v.z; o[4 * q + 3] = v.w; }
          float ss = 0.f;
#pragma unroll
          for (int e = 0; e < 16; ++e) ss += o[e] * o[e];
          ss = allred8(ss);
          const float rs = rsqrtf(ss * (1.f / 128.f) + 1e-6f);
          float z[16]; { float z0[8], z1[8]; unpack8(*(const u32x4*)(PROJ + (size_t)tok * NINP + C_GZ + c0), z0); unpack8(*(const u32x4*)(PROJ + (size_t)tok * NINP + C_GZ + c0 + 8), z1);
#pragma unroll
              for (int e = 0; e < 8; ++e) { z[e] = z0[e]; z[8 + e] = z1[e]; } }
          float r0[8], r1[8];
#pragma unroll
          for (int e = 0; e < 8; ++e) { r0[e] = o[e] * rs * nw[e] * siluf_(z[e]); r1[e] = o[8 + e] * rs * nw[8 + e] * siluf_(z[8 + e]); }
          *(u32x4*)(OBR + (size_t)tok * 1024 + c0) = pack8(r0); *(u32x4*)(OBR + (size_t)tok * 1024 + c0 + 8) = pack8(r1); }
        { float y[16], v[16];
#pragma unroll
          for (int q = 0; q < 4; ++q) { const f32x4 t = *(const f32x4*)(RY + (size_t)tok * 1024 + c0 + 4 * q); y[4 * q] = t.x; y[4 * q + 1] = t.y; y[4 * q + 2] = t.z; y[4 * q + 3] = t.w;
          }
          { float va[8], vb[8]; unpack8(*(const u32x4*)((const bf16*)RV + (size_t)tok * 1024 + c0), va); unpack8(*(const u32x4*)((const bf16*)RV + (size_t)tok * 1024 + c0 + 8), vb);
#pragma unroll
              for (int e = 0; e < 8; ++e) { v[e] = va[e]; v[8 + e] = vb[e]; } }
          float s = 0.f;
#pragma unroll
          for (int e = 0; e < 16; ++e) s += y[e];
          s += dppf<0xB1>(s); s += dppf<0x4E>(s);
          const float mean = s * (1.f / 64.f); float q2 = 0.f;
#pragma unroll
          for (int e = 0; e < 16; ++e) { const float d = y[e] - mean; q2 += d * d; }
          q2 += dppf<0xB1>(q2); q2 += dppf<0x4E>(q2);
          const float rs = rsqrtf(q2 * (1.f / 64.f) + 64e-5f);
          const float bon = RBON[(size_t)tok * 16 + (c0 >> 6)];
          float z[16]; { float z0[8], z1[8]; unpack8(*(const u32x4*)(PROJ + (size_t)tok * NINP + C_RZ + c0), z0); unpack8(*(const u32x4*)(PROJ + (size_t)tok * NINP + C_RZ + c0 + 8), z1);
#pragma unroll
              for (int e = 0; e < 8; ++e) { z[e] = z0[e]; z[8 + e] = z1[e]; } }
          float r0[8], r1[8];
#pragma unroll
          for (int e = 0; e < 8; ++e) { r0[e] = ((y[e] - mean) * rs * lw[e] + lb[e] + bon * v[e]) * siluf_(z[e]); r1[e] = ((y[8 + e] - mean) * rs * lw[8 + e] + lb[8 + e] + bon * v[8 + e]) * siluf_(z[8 + e]); }
          bf16* ob = OBR + (size_t)TOK * 1024 + (size_t)tok * 1024 + c0;
          *(u32x4*)ob = pack8(r0); *(u32x4*)(ob + 8) = pack8(r1); }
    }
}

#ifndef PHM
#define PHM 0xFFFF
#endif
#ifndef REPM
#define REPM 0
#endif
__global__ void __launch_bounds__(NTHREADS, 2) hybrid_fwd(Args a) {
    extern __shared__ __attribute__((aligned(16))) unsigned char lds_raw[];
    Ctx F;
    F.lds = (LAS unsigned char*)lds_raw; F.ws = a.ws;
    F.G = gridDim.x; { const int bx = blockIdx.x; F.vcu = (F.G % 8 == 0) ? (bx % 8) * (F.G / 8) + bx / 8 : bx; }
    F.NGW = F.G * NWAVES;
    cg::grid_group grid = cg::this_grid();
    if (threadIdx.x < 8) ((volatile LAS unsigned*)(F.lds + MISC_OFF))[threadIdx.x] = 0u;
    __syncthreads();
    grid.sync();
    XcdBarrier bar = xcd_barrier_post((unsigned*)(a.ws + WS_CTL), (volatile LAS unsigned*)(F.lds + MISC_OFF));
    bf16* XN = (bf16*)(a.ws + WS_XN); bf16* PROJ = (bf16*)(a.ws + WS_PROJ);
    int rep = 0;
    for (int ph = a.ph_lo; ph < a.ph_hi; ) {
        { int t_ = threadIdx.x; asm volatile("" : "+v"(t_)); F.tid = t_; F.lane = t_ & 63; F.wave = __builtin_amdgcn_readfirstlane(t_ >> 6); F.gw = F.vcu * NWAVES + F.wave; }
        if (ph == NPHASES - 1) { for (int m = F.gw; m < TOK; m += F.NGW) rms_row(a.out + (size_t)m * DM, a.in[30], nullptr, nullptr, a.out + (size_t)m * DM, F.lane); }
        else if (ph == 0) { if (PHM & 1) phase0(F, a);
            if (REPM & 128) { if (!rep) { rep = 1; __syncthreads(); continue; } rep = 0; } }
        else {
            const int l = (ph - 1) / PH_PER_LAYER, k = (ph - 1) % PH_PER_LAYER;
            if (k == 0 && (PHM & 2)) {
                pg8::Gemm g{XN, (const bf16*)(a.ws + WS_WIN) + (size_t)l * NINP * DM, TOK, NINP, DM}; pg8::StaticOrder S; S.init(TOK, NINP, F.G, (int)blockIdx.x);
                pg8::EpiBf16Rs E{PROJ, NINP, (const unsigned long long*)(a.ws + WS_CTL + CTL_SS) + (size_t)l * TOK};
                pg8::gemm_phase<pg8::EpiBf16Rs, pg8::StaticOrder, true, true>(F.lds, g, S, E);
            } else if (k == 1) { prep_gdn(F, a, l); if (REPM & 8192) prep_gdn(F, a, l); prep_rwkv(F, a, l); if (REPM & 16384) prep_rwkv(F, a, l); }
            else if (k == 2) { if (PHM & 16) scan_phase(F, a, l); }
            else if (k == 3 && (PHM & 32)) {
                const bool split = F.G >= 192;
                if (!split) { post_phase(F, a, l, F.gw, F.NGW); __syncthreads(); }
                if (!split || (int)blockIdx.x < 128) {
                    pg8::Gemm g{(const bf16*)(a.ws + WS_SY), (const bf16*)(a.ws + WS_WGLU) + (size_t)l * 1024 * 1024, TOK, 1024, 1024}; pg8::StaticOrder S; S.init(TOK, 1024, F.G, (int)blockIdx.x);
                    pg8::EpiGlu E{(const bf16*)(a.ws + WS_SY), PROJ, a.in[26] + l * 1024, (bf16*)(a.ws + WS_OBR) + (size_t)2 * TOK * 1024};
                    pg8::gemm_phase<pg8::EpiGlu, pg8::StaticOrder, true, true>(F.lds, g, S, E);
                } else post_phase(F, a, l, ((int)blockIdx.x - 128) * NWAVES + F.wave, (F.G - 128) * NWAVES);
            } else if (k == 4 && (PHM & 64)) {
                pg8::Gemm g{(const bf16*)(a.ws + WS_OBR), (const bf16*)(a.ws + WS_WBR) + (size_t)l * 3 * DM * 1024, 3 * TOK, 3 * DM, 1024};
                pg8::BranchOrder S; S.base.init(TOK, DM, F.G, (int)blockIdx.x);
                pg8::EpiBranch E{PROJ, a.in[27] + (size_t)l * 3 * DM, (bf16*)(a.ws + WS_ACCF), (bf16*)(a.ws + WS_MRG)};
                pg8::gemm_phase<pg8::EpiBranch, pg8::BranchOrder, true, true>(F.lds, g, S, E);
            } else if (k == 5 && (PHM & 128)) {
                pg8::Gemm g{(const bf16*)(a.ws + WS_MRG), (const bf16*)(a.ws + WS_WOUT) + (size_t)l * DM * DM, TOK, DM, DM}; pg8::StaticOrder S; S.init(TOK, DM, F.G, (int)blockIdx.x);
                pg8::EpiResid E{l == 0 ? a.in[0] : a.out, a.out, l + 1 < DEPTH ? XN : nullptr, a.in[1] + (size_t)(l + 1 < DEPTH ? l + 1 : 0) * DM, (unsigned long long*)(a.ws + WS_CTL + CTL_SS) + (size_t)(l + 1 < DEPTH ? l + 1 : 0) * TOK};
                pg8::gemm_phase<pg8::EpiResid, pg8::StaticOrder, true, true>(F.lds, g, S, E);
            }
            if (REPM && !rep && ((REPM >> k) & 1)) { rep = 1; __syncthreads(); continue; }
            rep = 0;
        }
        if (ph + 1 < a.ph_hi) {
            xcd_barrier(bar);
            if (REPM & 256) xcd_barrier(bar);
        }
        ++ph;
    }
}

#ifndef MK_MULTI
#define MK_MULTI 0
#endif
extern "C" void kernel_launch(void* const* d_in, const int* in_sizes, int n_in, void* d_out, int out_size, void* d_ws, size_t ws_size, hipStream_t stream) {
    static int grid = 0;
    if (grid == 0) {
        if (n_in != 31 || out_size != TOK * DM || ws_size < WS_END) { fprintf(stderr, "kernel_launch: unexpected shapes (n_in %d out %d ws %zu)\n", n_in, out_size, ws_size); grid = -1; return; }
        int dev = 0, cus = 0, per_cu = 0;
        hipGetDevice(&dev); hipDeviceGetAttribute(&cus, hipDeviceAttributeMultiprocessorCount, dev);
        if (hipFuncSetAttribute((const void*)hybrid_fwd, hipFuncAttributeMaxDynamicSharedMemorySize, LDS_BYTES) != hipSuccess) { fprintf(stderr, "kernel_launch: hipFuncSetAttribute failed\n"); grid = -1; return; }
        if (hipOccupancyMaxActiveBlocksPerMultiprocessor(&per_cu, (const void*)hybrid_fwd, NTHREADS, LDS_BYTES) != hipSuccess || per_cu < 1) per_cu = 1;
        (void)hipGetLastError();
        grid = cus * per_cu;
        fprintf(stderr, "kernel_launch: grid %d (cus %d x %d)\n", grid, cus, per_cu);
    }
    if (grid < 0) return;
    if (hipMemsetAsync((char*)d_ws + WS_CTL, 0, CTL_ZERO_BYTES, stream) != hipSuccess) { fprintf(stderr, "kernel_launch: memset failed\n"); return; }
    Args a{};
    for (int i = 0; i < 31; ++i) a.in[i] = (const float*)d_in[i];
    a.out = (float*)d_out; a.ws = (unsigned char*)d_ws;
#if MK_MULTI
    for (int ph = 0; ph < NPHASES; ++ph) { a.ph_lo = ph; a.ph_hi = ph + 1; hipLaunchKernelGGL(hybrid_fwd, dim3(grid), dim3(NTHREADS), LDS_BYTES, stream, a); }
#else
    a.ph_lo = 0; a.ph_hi = NPHASES;
    void* args[] = {&a};
    const hipError_t e = hipLaunchCooperativeKernel((const void*)hybrid_fwd, dim3(grid), dim3(NTHREADS), args, LDS_BYTES, stream);
    if (e != hipSuccess) fprintf(stderr, "kernel_launch: cooperative launch failed: %s (grid %d)\n", hipGetErrorString(e), grid);
#endif
}
```

```cpp
#include <hip/hip_runtime.h>
#include <hip/hip_cooperative_groups.h>
#include <cstdio>
#include <cstdint>
namespace cg = cooperative_groups;
namespace pg8 {
#define PG8_LAS __attribute__((address_space(3)))
typedef unsigned short bf16_t;
typedef short bf16x8 __attribute__((ext_vector_type(8)));
typedef float f32x4 __attribute__((ext_vector_type(4)));
typedef unsigned u32x4 __attribute__((ext_vector_type(4)));
constexpr int BM = 256, BK = 64, HALF = 128, HTB = HALF * BK * 2  , STAGE_BYTES = 8 * HTB, NXCD = 8, WGM = 8;

__host__ __device__ __forceinline__ int lds_byte(int r, int c) { const int st = (r >> 4) * 2 + (c >> 5), rr = r & 15, cc = c & 31, ob = rr * 64 + cc * 2; return st * 1024 + (ob ^ (((ob >> 9) & 1) << 5)); }
__host__ __device__ __forceinline__ void stage_rc(int b, int& R, int& C) { const int st = b / 1024, sb = b % 1024, swz = sb ^ (((sb >> 9) & 1) << 5); R = (st >> 1) * 16 + swz / 64; C = (st & 1) * 32 + (swz % 64) / 2; }
__host__ __device__ __forceinline__ int perm32(int rho) { const int n = rho >> 4, i = rho & 15; return 8 * (i >> 2) + 4 * n + (i & 3); }

struct Unit { int pm, pn; };
struct Gemm { const bf16_t* A; const bf16_t* Bt; int M, N, K, ld; };

struct StaticOrder {
    int nM, nN, nwg, G, c;
    __host__ __device__ void init(int M, int N, int G_, int c_) { nM = M / BM; nN = N / BM; nwg = nM * nN; G = G_; c = c_; }
    __host__ __device__ bool next(int i, Unit& u) const {
        const long L = (long)i * G + c; if (L >= nwg) return false;
        int wgid = (int)L; { const int q = nwg / NXCD, r = nwg % NXCD, xcd = wgid % NXCD, off = wgid / NXCD; wgid = (xcd < r ? xcd * (q + 1) : r * (q + 1) + (xcd - r) * q) + off; }
        const int nig = WGM * nN, gid = wgid / nig, fm = gid * WGM, gsz = (nM - fm) < WGM ? (nM - fm) : WGM;
        u.pm = fm + ((wgid % nig) % gsz); u.pn = (wgid % nig) / gsz; return true;
    }
    __device__ __forceinline__ void a_ready(const Unit&) const {}
    __device__ __forceinline__ void done(const Unit&) const {}
};

__device__ __forceinline__ unsigned cvt_pk_bf16(float lo, float hi) { unsigned r; asm volatile("v_cvt_pk_bf16_f32 %0, %1, %2" : "=v"(r) : "v"(lo), "v"(hi)); return r; }
typedef float f32x2 __attribute__((ext_vector_type(2)));
__device__ __forceinline__ f32x2 gelu_pk(f32x2 v) {
    const f32x2 av = __builtin_elementwise_abs(v), d = av * 0.2316418882f + 1.0f;
    f32x2 t; t.x = __builtin_amdgcn_rcpf(d.x); t.y = __builtin_amdgcn_rcpf(d.y);
    f32x2 q = t * 0.5307027145f + (-0.7265760135f); q = q * t + 0.7107068705f; q = q * t + (-0.142248368f); q = q * t + 0.127414796f; q = q * t;
    const f32x2 s = (v * v) * (-0.72134752044f);
    f32x2 e; e.x = __builtin_amdgcn_exp2f(s.x); e.y = __builtin_amdgcn_exp2f(s.y);
    const f32x2 m = v * (q * e), r = v - m;
    f32x2 o; o.x = v.x < 0.f ? m.x : r.x; o.y = v.y < 0.f ? m.y : r.y; return o;
}

template <int ACT  > struct EpiBf16 {
    static constexpr bool PERM = true, AFTER_DRAIN = false; static_assert(ACT == 0 || ACT == 1, "EpiBf16: ACT is 0 (none) or 1 (gelu_pk)");
    bf16_t* O; int ldc; const float* bias; int split_cols; size_t split_stride; float scale0;
    __device__ __forceinline__ void operator()(const f32x4 (&acc)[2][2][4][2], const Unit& u, int wr, int wc, int fr, int fq) const {
        const int row0 = u.pm * BM + wr * 64 + fr; int colt = u.pn * BM; bf16_t* base = O;
        float sc = 1.f; if (split_cols) { const int t = colt / split_cols; base += (size_t)t * split_stride; colt -= t * split_cols; if (t == 0) sc = scale0; }
        const int col0 = colt + wc * 32 + 8 * fq, bcol0 = u.pn * BM + wc * 32 + 8 * fq;
        f32x4 bv[2][2];
#pragma unroll
        for (int bj = 0; bj < 2; ++bj)
#pragma unroll
            for (int n = 0; n < 2; ++n) bv[bj][n] = bias ? *(const f32x4*)(bias + bcol0 + bj * HALF + 4 * n) : (f32x4){0.f, 0.f, 0.f, 0.f};
#pragma unroll
        for (int ai = 0; ai < 2; ++ai)
#pragma unroll
            for (int m = 0; m < 4; ++m) { bf16_t* rowp = base + (size_t)(row0 + ai * HALF + m * 16) * ldc + col0;
#pragma unroll
                for (int bj = 0; bj < 2; ++bj) { f32x4 v0 = acc[ai][bj][m][0] + bv[bj][0], v1 = acc[ai][bj][m][1] + bv[bj][1];
                    if (ACT == 1) { f32x2 a = gelu_pk((f32x2){v0[0], v0[1]}), b = gelu_pk((f32x2){v0[2], v0[3]}), c = gelu_pk((f32x2){v1[0], v1[1]}), d = gelu_pk((f32x2){v1[2], v1[3]});
                        v0 = (f32x4){a.x, a.y, b.x, b.y}; v1 = (f32x4){c.x, c.y, d.x, d.y}; }
                    v0 = v0 * sc; v1 = v1 * sc; u32x4 w; w.x = cvt_pk_bf16(v0[0], v0[1]); w.y = cvt_pk_bf16(v0[2], v0[3]); w.z = cvt_pk_bf16(v1[0], v1[1]); w.w = cvt_pk_bf16(v1[2], v1[3]);
                    *(u32x4*)(rowp + bj * HALF) = w; } }
    }
};

template <class Epi, class Sched, bool ALIGN_EPI = false, bool SP2 = false>
__device__ __forceinline__ void gemm_phase(PG8_LAS unsigned char* lds, const Gemm g, const Sched& S, const Epi& E) {
    int tid_ = threadIdx.x; asm volatile("" : "+v"(tid_));
    const int tid = tid_, wid = __builtin_amdgcn_readfirstlane(tid >> 6), lane = tid & 63, wr = wid >> 2, wc = wid & 3, fr = lane & 15, fq = lane >> 4;
    const int K = g.K, nt = K / BK, LD = g.ld ? g.ld : g.K;
    unsigned voffA[2], voffB[2];
#pragma unroll
    for (int i = 0; i < 2; ++i) { int R, C; stage_rc(tid * 16 + i * 8192, R, C); const int Rb = Epi::PERM ? ((R & ~31) + perm32(R & 31)) : R;
        voffA[i] = (unsigned)(R * LD + C) * 2u; voffB[i] = (unsigned)(Rb * LD + C) * 2u; }
    const size_t kstep = (size_t)(BK * 2);
    const size_t hstep = (size_t)HALF * LD * 2;
    const size_t tstep = 2 * hstep;
    const unsigned ldsw = (unsigned)wid * 1024u;
    const int aoff = lds_byte(wr * 64 + fr, fq * 8), boff = lds_byte(wc * 32 + fr, fq * 8);
#define PG8_SA(b, h) (((b) * 2 + (h)) * HTB)
#define PG8_SB(b, h) ((4 + (b) * 2 + (h)) * HTB)
#define PG8_STAGE(bufoff, gbase, voff) do { _Pragma("unroll") for (int _i = 0; _i < 2; ++_i) \
        __builtin_amdgcn_global_load_lds((const unsigned*)((const char*)(gbase) + (voff)[_i]), (PG8_LAS unsigned*)(lds + (bufoff) + ldsw + _i * 8192), 16, 0, 0); } while (0)
#define PG8_LDA(dst, b, h) do { _Pragma("unroll") for (int m = 0; m < 4; ++m) _Pragma("unroll") for (int k = 0; k < 2; ++k) dst[m][k] = *(const PG8_LAS bf16x8*)(lds + PG8_SA(b, h) + aoff + m * 2048 + k * 1024); } while (0)
#define PG8_LDB(dst, b, h) do { _Pragma("unroll") for (int n = 0; n < 2; ++n) _Pragma("unroll") for (int k = 0; k < 2; ++k) dst[n][k] = *(const PG8_LAS bf16x8*)(lds + PG8_SB(b, h) + boff + n * 2048 + k * 1024); } while (0)
#define PG8_MMA(ai, bj, At, Bt) do { __builtin_amdgcn_s_setprio(1); _Pragma("unroll") for (int m = 0; m < 4; ++m) _Pragma("unroll") for (int n = 0; n < 2; ++n) _Pragma("unroll") for (int k = 0; k < 2; ++k) \
        acc[ai][bj][m][n] = __builtin_amdgcn_mfma_f32_16x16x32_bf16(Bt[n][k], At[m][k], acc[ai][bj][m][n], 0, 0, 0); __builtin_amdgcn_s_setprio(0); } while (0)
#define PG8_WAIT_V(n) asm volatile("s_waitcnt vmcnt(" #n ")" ::: "memory")
#define PG8_WAIT_L(n) asm volatile("s_waitcnt lgkmcnt(" #n ")" ::: "memory")
#define PG8_BAR __builtin_amdgcn_s_barrier()
#define PG8_SCHED __builtin_amdgcn_sched_barrier(0)
    Unit cur, nxt; int ui = 0;
    if (!S.next(0, cur)) return;
    f32x4 acc[2][2][4][2];
#pragma unroll
    for (int a = 0; a < 2; ++a)
#pragma unroll
        for (int b = 0; b < 2; ++b)
#pragma unroll
            for (int m = 0; m < 4; ++m)
#pragma unroll
                for (int n = 0; n < 2; ++n) acc[a][b][m][n] = (f32x4){0.f, 0.f, 0.f, 0.f};
    bf16x8 At[4][2], B0[2][2], B1[2][2];
    const char* cA = (const char*)g.A + (size_t)cur.pm * tstep; const char* cB = (const char*)g.Bt + (size_t)cur.pn * tstep;
    S.a_ready(cur);
    if constexpr (SP2) {
        PG8_STAGE(PG8_SB(0, 0), cB, voffB); PG8_STAGE(PG8_SB(0, 1), cB + hstep, voffB); PG8_STAGE(PG8_SA(0, 0), cA, voffA); PG8_STAGE(PG8_SA(0, 1), cA + hstep, voffA);
        if (wr == 1) PG8_BAR;
        PG8_WAIT_V(2); PG8_BAR;
        PG8_STAGE(PG8_SB(1, 0), cB + kstep, voffB); PG8_STAGE(PG8_SA(1, 0), cA + kstep, voffA); PG8_STAGE(PG8_SB(1, 1), cB + hstep + kstep, voffB);
        PG8_WAIT_V(6); PG8_BAR;
    } else {
        PG8_STAGE(PG8_SB(0, 0), cB, voffB); PG8_STAGE(PG8_SA(0, 0), cA, voffA); PG8_STAGE(PG8_SB(0, 1), cB + hstep, voffB); PG8_STAGE(PG8_SA(0, 1), cA + hstep, voffA);
        if (wr == 1) PG8_BAR;
        PG8_WAIT_V(4); PG8_BAR;
        PG8_STAGE(PG8_SB(1, 0), cB + kstep, voffB); PG8_STAGE(PG8_SA(1, 0), cA + kstep, voffA); PG8_STAGE(PG8_SB(1, 1), cB + hstep + kstep, voffB);
        PG8_WAIT_V(6); PG8_BAR;
    }
    for (;;) {
        const bool has_next = S.next(ui + 1, nxt);
        const char* nA = has_next ? (const char*)g.A + (size_t)nxt.pm * tstep : cA; const char* nB = has_next ? (const char*)g.Bt + (size_t)nxt.pn * tstep : cB;
        for (int t = 0; t < nt; t += 2) {
            const bool last = (t == nt - 2);
            const char* a1 = cA + (size_t)(t + 1) * kstep;
            const char* a2 = last ? nA : cA + (size_t)(t + 2) * kstep; const char* b2 = last ? nB : cB + (size_t)(t + 2) * kstep;
            const char* a3 = a2 + kstep; const char* b3 = b2 + kstep;
            if (last && has_next) S.a_ready(nxt);
            if constexpr (SP2) {
            PG8_LDB(B0, 0, 0); PG8_LDB(B1, 0, 1); PG8_SCHED; PG8_LDA(At, 0, 0); PG8_STAGE(PG8_SA(1, 1), a1 + hstep, voffA);
            PG8_WAIT_V(8); PG8_WAIT_L(0); PG8_BAR; PG8_MMA(0, 0, At, B0); PG8_MMA(0, 1, At, B1); PG8_BAR; PG8_SCHED;
            PG8_LDA(At, 0, 1); PG8_STAGE(PG8_SB(0, 0), b2, voffB); PG8_STAGE(PG8_SB(0, 1), b2 + hstep, voffB); PG8_STAGE(PG8_SA(0, 0), a2, voffA);
            PG8_WAIT_V(8); PG8_WAIT_L(0); PG8_BAR; PG8_MMA(1, 0, At, B0); PG8_MMA(1, 1, At, B1); PG8_BAR; PG8_SCHED;
            PG8_LDB(B0, 1, 0); PG8_LDB(B1, 1, 1); PG8_SCHED; PG8_LDA(At, 1, 0); PG8_STAGE(PG8_SA(0, 1), a2 + hstep, voffA);
            PG8_WAIT_V(8); PG8_WAIT_L(0); PG8_BAR; PG8_MMA(0, 0, At, B0); PG8_MMA(0, 1, At, B1); PG8_BAR; PG8_SCHED;
            PG8_LDA(At, 1, 1); PG8_STAGE(PG8_SB(1, 0), b3, voffB); PG8_STAGE(PG8_SB(1, 1), b3 + hstep, voffB); PG8_STAGE(PG8_SA(1, 0), a3, voffA);
            PG8_WAIT_V(8); PG8_WAIT_L(0); PG8_BAR; PG8_MMA(1, 0, At, B0); PG8_MMA(1, 1, At, B1); PG8_BAR; PG8_SCHED;
            } else {
            PG8_LDB(B0, 0, 0); PG8_SCHED; PG8_LDA(At, 0, 0); PG8_STAGE(PG8_SA(1, 1), a1 + hstep, voffA);
            PG8_WAIT_L(8); PG8_BAR; PG8_WAIT_L(0); PG8_MMA(0, 0, At, B0); PG8_BAR; PG8_SCHED;
            PG8_LDB(B1, 0, 1); PG8_STAGE(PG8_SB(0, 0), b2, voffB);
            PG8_BAR; PG8_WAIT_L(0); PG8_MMA(0, 1, At, B1); PG8_BAR;
            PG8_LDA(At, 0, 1); PG8_STAGE(PG8_SA(0, 0), a2, voffA);
            PG8_BAR; PG8_WAIT_L(0); PG8_MMA(1, 0, At, B0); PG8_BAR; PG8_SCHED;
            PG8_STAGE(PG8_SB(0, 1), b2 + hstep, voffB);
            PG8_WAIT_V(6); PG8_BAR; PG8_MMA(1, 1, At, B1); PG8_BAR;
            PG8_LDB(B0, 1, 0); PG8_SCHED; PG8_LDA(At, 1, 0); PG8_STAGE(PG8_SA(0, 1), a2 + hstep, voffA);
            PG8_WAIT_L(8); PG8_BAR; PG8_WAIT_L(0); PG8_MMA(0, 0, At, B0); PG8_BAR; PG8_SCHED;
            PG8_LDB(B1, 1, 1); PG8_STAGE(PG8_SB(1, 0), b3, voffB);
            PG8_BAR; PG8_WAIT_L(0); PG8_MMA(0, 1, At, B1); PG8_BAR;
            PG8_LDA(At, 1, 1); PG8_STAGE(PG8_SA(1, 0), a3, voffA);
            PG8_BAR; PG8_WAIT_L(0); PG8_MMA(1, 0, At, B0); PG8_BAR; PG8_SCHED;
            PG8_STAGE(PG8_SB(1, 1), b3 + hstep, voffB);
            PG8_WAIT_V(6); PG8_BAR; PG8_MMA(1, 1, At, B1); PG8_BAR;
            }
        }
        if constexpr (ALIGN_EPI) { if (wr == 0) PG8_BAR; }
        if constexpr (!Epi::AFTER_DRAIN) { E(acc, cur, wr, wc, fr, fq); S.done(cur); }
        if (!has_next) break;
#pragma unroll
        for (int a = 0; a < 2; ++a)
#pragma unroll
            for (int b = 0; b < 2; ++b)
#pragma unroll
                for (int m = 0; m < 4; ++m)
#pragma unroll
                    for (int n = 0; n < 2; ++n) acc[a][b][m][n] = (f32x4){0.f, 0.f, 0.f, 0.f};
        cur = nxt; cA = nA; cB = nB; ++ui;
        if constexpr (ALIGN_EPI) { if (wr == 1) PG8_BAR; }
    }
    PG8_WAIT_V(0);
    if constexpr (!ALIGN_EPI) { if (wr == 0) PG8_BAR; }
    PG8_BAR;
    if constexpr (Epi::AFTER_DRAIN) { E.fused(acc, cur, wr, wc, fr, fq, lds, wid, lane); S.done(cur); }
#undef PG8_SA
#undef PG8_SB
#undef PG8_STAGE
#undef PG8_LDA
#undef PG8_LDB
#undef PG8_MMA
#undef PG8_WAIT_V
#undef PG8_WAIT_L
#undef PG8_BAR
#undef PG8_SCHED
}
}

#define GAS __attribute__((address_space(1)))
#define LAS __attribute__((address_space(3)))
typedef unsigned short bf16;
typedef unsigned u32x4 __attribute__((ext_vector_type(4)));
typedef unsigned u32x2 __attribute__((ext_vector_type(2)));
typedef float f32x4 __attribute__((ext_vector_type(4)));
typedef float f32x2 __attribute__((ext_vector_type(2)));
typedef short bf16x8_t __attribute__((ext_vector_type(8)));

constexpr int NBATCH = 4, SEQ = 2048, TOK = NBATCH * SEQ, DM = 2048, DEPTH = 4;
constexpr int NIN = 16592, NINP = 16640;
constexpr int C_GQKV = 0, C_GZ = 3072, C_GB = 4096, C_GA = 4104, C_RF = 4112, C_RZ = 7376, C_SU = 8400, C_SZ = 9424, C_GATE = 10448;
constexpr int NWAVES = 8, NTHREADS = 512;
constexpr int LDS_BYTES = 147456;
constexpr int PH_PER_LAYER = 6, NPHASES = 2 + DEPTH * PH_PER_LAYER;

constexpr size_t MiB = 1u << 20;
constexpr size_t WS_WIN = 0, WS_WGLU = 260 * MiB, WS_WBR = 268 * MiB, WS_WOUT = 316 * MiB, WS_XN = 348 * MiB, WS_PROJ = 380 * MiB;
constexpr size_t WS_GQ = 640 * MiB, WS_GK = 672 * MiB, WS_GV = 704 * MiB, WS_GEG = 736 * MiB, WS_GBE = 737 * MiB, WS_GO = 738 * MiB;
constexpr size_t WS_RR = 770 * MiB, WS_RW = 802 * MiB, WS_RK = 834 * MiB, WS_RV = 866 * MiB, WS_RKK = 898 * MiB, WS_RKA = 930 * MiB, WS_RBON = 962 * MiB, WS_RY = 963 * MiB;
constexpr size_t WS_SY = 995 * MiB, WS_OBR = 1011 * MiB, WS_ACCF = 1059 * MiB, WS_MRG = 1123 * MiB, WS_CTL = 1155 * MiB, WS_LORA = 1156 * MiB, WS_END = 1158 * MiB;
constexpr size_t CTL_SS = 65536, CTL_ZERO_BYTES = CTL_SS + (size_t)DEPTH * TOK * 8;
constexpr int MISC_OFF = 147392;
static_assert((size_t)DEPTH * NINP * DM * 2 == 260 * MiB && (size_t)TOK * NINP * 2 == 260 * MiB, "ws map");

__device__ __forceinline__ unsigned f2bf(float f) { unsigned u = __builtin_bit_cast(unsigned, f); return (u + 0x7fffu + ((u >> 16) & 1u)) >> 16; }
__device__ __forceinline__ unsigned pk2(float lo, float hi) { unsigned r; asm("v_cvt_pk_bf16_f32 %0, %1, %2" : "=v"(r) : "v"(lo), "v"(hi)); return r; }
__device__ __forceinline__ float bflo(unsigned w) { return __builtin_bit_cast(float, w << 16); }
__device__ __forceinline__ float bfhi(unsigned w) { return __builtin_bit_cast(float, w & 0xffff0000u); }
__device__ __forceinline__ float bf1(bf16 h) { return __builtin_bit_cast(float, (unsigned)h << 16); }
__device__ __forceinline__ float sigmoidf_(float x) { return __builtin_amdgcn_rcpf(1.f + __expf(-x)); }
__device__ __forceinline__ float siluf_(float x) { return x * __builtin_amdgcn_rcpf(1.f + __expf(-x)); }
__device__ __forceinline__ float softplusf_(float x) { return x > 20.f ? x : log1pf(expf(x)); }
__device__ __forceinline__ float gelu_tanh(float y) { const float t = 0.7978845608028654f * (y + 0.044715f * y * y * y); const float th = 1.f - 2.f * __builtin_amdgcn_rcpf(1.f + __expf(2.f * t)); return 0.5f * y * (1.f + th); }
template <int CTRL> __device__ __forceinline__ float dppf(float v) { return __builtin_bit_cast(float, __builtin_amdgcn_update_dpp(0, __builtin_bit_cast(int, v), CTRL, 0xF, 0xF, true)); }
__device__ __forceinline__ float allred8(float v) { v += dppf<0xB1>(v); v += dppf<0x4E>(v); v += dppf<0x141>(v); return v; }
__device__ __forceinline__ float allred16(float v) { v = allred8(v); v += dppf<0x140>(v); return v; }
__device__ __forceinline__ float wave_sum(float v) {
#pragma unroll
    for (int o = 1; o < 64; o <<= 1) v += __shfl_xor(v, o);
    return v;
}
__device__ __forceinline__ void unpack8(const u32x4 w, float (&f)[8]) { f[0] = bflo(w.x); f[1] = bfhi(w.x); f[2] = bflo(w.y); f[3] = bfhi(w.y); f[4] = bflo(w.z); f[5] = bfhi(w.z); f[6] = bflo(w.w); f[7] = bfhi(w.w); }
__device__ __forceinline__ u32x4 pack8(const float (&f)[8]) { u32x4 w; w.x = pk2(f[0], f[1]); w.y = pk2(f[2], f[3]); w.z = pk2(f[4], f[5]); w.w = pk2(f[6], f[7]); return w; }

namespace pg8 {
struct EpiGlu {
    static constexpr bool PERM = true, AFTER_DRAIN = false;
    const bf16* Y1; const bf16* PROJ; const float* bias; bf16* O;
    __device__ __forceinline__ void operator()(const f32x4 (&acc)[2][2][4][2], const Unit& u, int wr, int wc, int fr, int fq) const {
        int row0 = u.pm * BM + wr * 64 + fr, col0 = u.pn * BM + wc * 32 + 8 * fq;
        asm volatile("" : "+v"(row0), "+v"(col0));
        f32x4 bb[2][2];
#pragma unroll
        for (int bj = 0; bj < 2; ++bj) { bb[bj][0] = *(const f32x4*)(bias + col0 + bj * HALF); bb[bj][1] = *(const f32x4*)(bias + col0 + bj * HALF + 4); }
        u32x4 yc = *(const u32x4*)(Y1 + (size_t)row0 * 1024 + col0), zc = *(const u32x4*)(PROJ + (size_t)row0 * NINP + C_SZ + col0);
#pragma unroll
        for (int it = 0; it < 16; ++it) {
            const int bj = it >> 3, ai = (it >> 2) & 1, m = it & 3;
            const size_t row = (size_t)(row0 + ai * HALF + m * 16); const int col = col0 + bj * HALF;
            u32x4 yn = yc, zn = zc;
            if (it + 1 < 16) { const int nb = (it + 1) >> 3, na = ((it + 1) >> 2) & 1, nm = (it + 1) & 3; const size_t nrow = (size_t)(row0 + na * HALF + nm * 16); const int ncol = col0 + nb * HALF;
                yn = *(const u32x4*)(Y1 + nrow * 1024 + ncol); zn = *(const u32x4*)(PROJ + nrow * NINP + C_SZ + ncol); }
            float y[8], z[8], o[8]; unpack8(yc, y); unpack8(zc, z);
            const f32x4 v0 = acc[ai][bj][m][0] + bb[bj][0], v1 = acc[ai][bj][m][1] + bb[bj][1];
            const float a[8] = {v0[0], v0[1], v0[2], v0[3], v1[0], v1[1], v1[2], v1[3]};
#pragma unroll
            for (int e = 0; e < 8; ++e) o[e] = y[e] * sigmoidf_(a[e]) * siluf_(z[e]);
            *(u32x4*)(O + row * 1024 + col) = pack8(o);
            yc = yn; zc = zn;
            asm volatile("" ::: "memory");
        }
    }
};
struct EpiBranch {
    static constexpr bool PERM = true, AFTER_DRAIN = false;
    const bf16* PROJ; const float* gate_b; bf16* ACC; bf16* MRG;
    __device__ __forceinline__ void operator()(const f32x4 (&acc)[2][2][4][2], const Unit& u, int wr, int wc, int fr, int fq) const {
        const int br = u.pm >> 5, pm = u.pm & 31, pn = u.pn & 7;
        int row0 = pm * BM + wr * 64 + fr, col0 = pn * BM + wc * 32 + 8 * fq;
        asm volatile("" : "+v"(row0), "+v"(col0));
        bf16* dst = br < 2 ? ACC : MRG;
        const bf16* gl = PROJ + C_GATE + br * DM;
        f32x4 gb[2][2];
#pragma unroll
        for (int bj = 0; bj < 2; ++bj) { gb[bj][0] = *(const f32x4*)(gate_b + br * DM + col0 + bj * HALF); gb[bj][1] = *(const f32x4*)(gate_b + br * DM + col0 + bj * HALF + 4); }
        const u32x4 zero = {0u, 0u, 0u, 0u};
        u32x4 lc = *(const u32x4*)(gl + (size_t)row0 * NINP + col0), pc = br > 0 ? *(const u32x4*)(ACC + (size_t)row0 * DM + col0) : zero;
#pragma unroll
        for (int it = 0; it < 16; ++it) {
            const int bj = it >> 3, ai = (it >> 2) & 1, m = it & 3;
            const size_t row = (size_t)(row0 + ai * HALF + m * 16); const int col = col0 + bj * HALF;
            u32x4 ln = lc, pn_ = pc;
            if (it + 1 < 16) { const int nb = (it + 1) >> 3, na = ((it + 1) >> 2) & 1, nm = (it + 1) & 3; const size_t nrow = (size_t)(row0 + na * HALF + nm * 16); const int ncol = col0 + nb * HALF;
                ln = *(const u32x4*)(gl + nrow * NINP + ncol); pn_ = br > 0 ? *(const u32x4*)(ACC + nrow * DM + ncol) : zero; }
            float g[8], p[8], o[8]; unpack8(lc, g); unpack8(pc, p);
            const f32x4 v0 = acc[ai][bj][m][0], v1 = acc[ai][bj][m][1];
            const float a[8] = {v0[0], v0[1], v0[2], v0[3], v1[0], v1[1], v1[2], v1[3]};
            const float gbv[8] = {gb[bj][0][0], gb[bj][0][1], gb[bj][0][2], gb[bj][0][3], gb[bj][1][0], gb[bj][1][1], gb[bj][1][2], gb[bj][1][3]};
#pragma unroll
            for (int e = 0; e < 8; ++e) o[e] = sigmoidf_(g[e] + gbv[e]) * a[e] + p[e];
            *(u32x4*)(dst + row * DM + col) = pack8(o);
            lc = ln; pc = pn_;
            asm volatile("" ::: "memory");
        }
    }
};
struct EpiResid {
    static constexpr bool PERM = true, AFTER_DRAIN = false;
    const float* base; float* out; bf16* xn; const float* nw; unsigned long long* ss;
    __device__ __forceinline__ void operator()(const f32x4 (&acc)[2][2][4][2], const Unit& u, int wr, int wc, int fr, int fq) const {
        int row0 = u.pm * BM + wr * 64 + fr, col0 = u.pn * BM + wc * 32 + 8 * fq;
        asm volatile("" : "+v"(row0), "+v"(col0));
        f32x4 ww[2][2];
#pragma unroll
        for (int bj = 0; bj < 2; ++bj) { ww[bj][0] = *(const f32x4*)(nw + col0 + bj * HALF); ww[bj][1] = *(const f32x4*)(nw + col0 + bj * HALF + 4); }
        f32x4 bc[2][2];
#pragma unroll
        for (int bj = 0; bj < 2; ++bj) { const size_t off = (size_t)row0 * DM + col0 + bj * HALF; bc[bj][0] = *(const f32x4*)(base + off); bc[bj][1] = *(const f32x4*)(base + off + 4); }
#pragma unroll
        for (int it = 0; it < 8; ++it) {
            const int ai = it >> 2, m = it & 3; const int row = row0 + ai * HALF + m * 16;
            f32x4 bn[2][2];
#pragma unroll
            for (int bj = 0; bj < 2; ++bj) { bn[bj][0] = bc[bj][0]; bn[bj][1] = bc[bj][1]; }
            if (it + 1 < 8) { const int nrow = row0 + ((it + 1) >> 2) * HALF + ((it + 1) & 3) * 16;
#pragma unroll
                for (int bj = 0; bj < 2; ++bj) { const size_t off = (size_t)nrow * DM + col0 + bj * HALF; bn[bj][0] = *(const f32x4*)(base + off); bn[bj][1] = *(const f32x4*)(base + off + 4); } }
            float sq = 0.f;
#pragma unroll
            for (int bj = 0; bj < 2; ++bj) {
                const size_t off = (size_t)row * DM + col0 + bj * HALF;
                const f32x4 o0 = bc[bj][0] + acc[ai][bj][m][0], o1 = bc[bj][1] + acc[ai][bj][m][1];
                *(f32x4*)(out + off) = o0; *(f32x4*)(out + off + 4) = o1;
                if (xn) { const f32x4 w0 = ww[bj][0], w1 = ww[bj][1];
                    sq += (o0.x * o0.x + o0.y * o0.y) + (o0.z * o0.z + o0.w * o0.w) + (o1.x * o1.x + o1.y * o1.y) + (o1.z * o1.z + o1.w * o1.w);
                    u32x4 p; p.x = pk2(o0.x * w0.x, o0.y * w0.y); p.y = pk2(o0.z * w0.z, o0.w * w0.w); p.z = pk2(o1.x * w1.x, o1.y * w1.y); p.w = pk2(o1.z * w1.z, o1.w * w1.w);
                    *(u32x4*)(xn + off) = p; }
            }
            if (xn) { sq += __shfl_xor(sq, 16); sq += __shfl_xor(sq, 32); if (fq == 0) atomicAdd(ss + row, (unsigned long long)(sq * 65536.f + 0.5f)); }
#pragma unroll
            for (int bj = 0; bj < 2; ++bj) { bc[bj][0] = bn[bj][0]; bc[bj][1] = bn[bj][1]; }
            asm volatile("" ::: "memory");
        }
    }
};
struct EpiBf16Rs {
    static constexpr bool PERM = true, AFTER_DRAIN = false;
    bf16* O; int ldc; const unsigned long long* ss;
    __device__ __forceinline__ void operator()(const f32x4 (&acc)[2][2][4][2], const Unit& u, int wr, int wc, int fr, int fq) const {
        int row0 = u.pm * BM + wr * 64 + fr, col0 = u.pn * BM + wc * 32 + 8 * fq;
        asm volatile("" : "+v"(row0), "+v"(col0));
#pragma unroll
        for (int ai = 0; ai < 2; ++ai)
#pragma unroll
            for (int m = 0; m < 4; ++m) { const int row = row0 + ai * HALF + m * 16; const float rs = 1.f / sqrtf((float)ss[row] * (1.f / (65536.f * DM)) + 1e-6f);
                bf16* rowp = O + (size_t)row * ldc + col0;
#pragma unroll
                for (int bj = 0; bj < 2; ++bj) { const f32x4 v0 = acc[ai][bj][m][0] * rs, v1 = acc[ai][bj][m][1] * rs;
                    u32x4 w; w.x = cvt_pk_bf16(v0[0], v0[1]); w.y = cvt_pk_bf16(v0[2], v0[3]); w.z = cvt_pk_bf16(v1[0], v1[1]); w.w = cvt_pk_bf16(v1[2], v1[3]);
                    *(u32x4*)(rowp + bj * HALF) = w; } }
    }
};
struct BranchOrder {
    StaticOrder base;
    __device__ bool next(int i, Unit& u) const { Unit t; const int r = i / 3, br = i - 3 * r; if (!base.next(r, t)) return false; u.pm = br * 32 + t.pm; u.pn = br * 8 + t.pn; return true; }
    __device__ __forceinline__ void a_ready(const Unit&) const {}
    __device__ __forceinline__ void done(const Unit&) const {}
};
}

#define XB_TMO      128
#define XB_XCNT(j)  (256  + 64 * (j))
#define XB_XSUB(j)  (1280 + 64 * (j))
#define XB_XGEN(j)  (2304 + 64 * (j))
#define XB_TOP      3328
#define XB_TOPGEN   3392
#define XCD_BAR_WORDS 3456
#define XB_SPIN_CAP (1u << 18)

__device__ __forceinline__ unsigned xb_ld(unsigned* p)              { return __hip_atomic_load(p, __ATOMIC_RELAXED, __HIP_MEMORY_SCOPE_AGENT); }
__device__ __forceinline__ unsigned xb_add(unsigned* p, unsigned v) { return __hip_atomic_fetch_add(p, v, __ATOMIC_RELAXED, __HIP_MEMORY_SCOPE_AGENT); }
__device__ __forceinline__ unsigned xb_xcc_id() { return (unsigned)__builtin_amdgcn_s_getreg((3 << 11) | 20) & 0xFu; }
#define XB_SPIN(cond, bar) do { unsigned _sp = 0; while (cond) { __builtin_amdgcn_s_sleep(1); \
    if ((++_sp & 255u) == 0u) { if (xb_ld(&(bar)[XB_TMO])) break; if (_sp > XB_SPIN_CAP) { atomicAdd(&(bar)[XB_TMO], 1u); break; } } } } while (0)

struct XcdBarrier {
    unsigned* bar; unsigned x;
    volatile LAS unsigned* st;
};

__device__ __forceinline__ XcdBarrier xcd_barrier_post(unsigned* bar, volatile LAS unsigned* st) {
    XcdBarrier b; b.bar = bar; b.x = xb_xcc_id(); b.st = st;
    if (threadIdx.x == 0) (void)xb_add(&bar[XB_XCNT(b.x)], 1u);
    return b;
}
__device__ __forceinline__ void xcd_barrier_complete(unsigned* bar, unsigned x, unsigned& nloc, unsigned& nx) {
    const unsigned G = gridDim.x * gridDim.y * gridDim.z;
    unsigned sum, cnt, mine, sp = 0u;
    for (;;) {
        sum = 0u; cnt = 0u; mine = 0u;
#pragma unroll
        for (unsigned j = 0; j < 16; ++j) { const unsigned c = xb_ld(&bar[XB_XCNT(j)]); sum += c; cnt += (c > 0u) ? 1u : 0u; mine = (j == x) ? c : mine; }
        if (sum == G) break;
        __builtin_amdgcn_s_sleep(1);
        if ((++sp & 255u) == 0u) { if (xb_ld(&bar[XB_TMO])) break; if (sp > XB_SPIN_CAP) { atomicAdd(&bar[XB_TMO], 1u); break; } }
    }
    nloc = mine > 0u ? mine : 1u; nx = cnt > 0u ? cnt : 1u;
}

__device__ __forceinline__ void xcd_barrier(const XcdBarrier& b) {
    asm volatile("s_waitcnt vmcnt(0)" ::: "memory");
    __syncthreads();
    if (threadIdx.x == 0) {
        unsigned* bar = b.bar;
        __builtin_amdgcn_s_waitcnt(0);
        unsigned nloc = b.st[0], nx = b.st[1];
        if (nloc == 0u) { xcd_barrier_complete(bar, b.x, nloc, nx); b.st[0] = nloc; b.st[1] = nx; }
        const unsigned old = xb_add(&bar[XB_XSUB(b.x)], 1u);
        const unsigned gen = old / nloc;
        if (old + 1u == (gen + 1u) * nloc) {
            __builtin_amdgcn_fence(__ATOMIC_RELEASE, "agent");
            asm volatile("s_waitcnt vmcnt(0)" ::: "memory");
            const unsigned og = xb_add(&bar[XB_TOP], 1u);
            const unsigned tg = og / nx;
            if (og + 1u == (tg + 1u) * nx) xb_add(&bar[XB_TOPGEN], 1u);
            else XB_SPIN(xb_ld(&bar[XB_TOPGEN]) == tg, bar);
            __builtin_amdgcn_fence(__ATOMIC_ACQUIRE, "agent");
            xb_add(&bar[XB_XGEN(b.x)], 1u);
            asm volatile("s_waitcnt vmcnt(0)" ::: "memory");
        } else {
            XB_SPIN(xb_ld(&bar[XB_XGEN(b.x)]) == gen, bar);
            __builtin_amdgcn_fence(__ATOMIC_ACQUIRE, "agent");
            asm volatile("s_waitcnt vmcnt(0)" ::: "memory");
        }
    }
    __syncthreads();
}

struct Args { const float* in[31]; float* out; unsigned char* ws; int ph_lo, ph_hi; };
struct Ctx { int tid, lane, wave, vcu, G, gw, NGW; LAS unsigned char* lds; unsigned char* ws; };

__device__ __forceinline__ void transpose_item(const float* W, int K, int N, bf16* WT, LAS float* scr, int kb, int nb, int lane) {
    const int k0 = 64 * kb, n0 = 64 * nb, nq = 4 * (lane & 15), kr = lane >> 4; const bool nv = n0 + nq < N;
    f32x4 v[16];
#pragma unroll
    for (int i = 0; i < 16; ++i) v[i] = nv ? *(const f32x4*)(W + (size_t)(k0 + 4 * i + kr) * N + n0 + nq) : (f32x4){0.f, 0.f, 0.f, 0.f};
#pragma unroll
    for (int i = 0; i < 16; ++i) { LAS float* d = scr + (4 * i + kr) * 65 + nq; d[0] = v[i].x; d[1] = v[i].y; d[2] = v[i].z; d[3] = v[i].w; }
    asm volatile("s_waitcnt lgkmcnt(0)" ::: "memory");
    const int c = lane & 7;
#pragma unroll
    for (int j = 0; j < 8; ++j) { const int nn = (lane >> 3) + 8 * j; const LAS float* s = scr + (8 * c) * 65 + nn;
        u32x4 o; o.x = pk2(s[0 * 65], s[1 * 65]); o.y = pk2(s[2 * 65], s[3 * 65]); o.z = pk2(s[4 * 65], s[5 * 65]); o.w = pk2(s[6 * 65], s[7 * 65]);
        *(u32x4*)(WT + (size_t)(n0 + nn) * K + k0 + 8 * c) = o; }
    asm volatile("s_waitcnt lgkmcnt(0)" ::: "memory");
}

__device__ __forceinline__ void rms_row(const float* xrow, const float* w, bf16* obf, unsigned long long* ss, float* of32, int lane) {
    f32x4 v[8]; float s = 0.f;
#pragma unroll
    for (int j = 0; j < 8; ++j) { v[j] = *(const f32x4*)(xrow + 4 * lane + 256 * j); s += (v[j].x * v[j].x + v[j].y * v[j].y) + (v[j].z * v[j].z + v[j].w * v[j].w); }
    s = wave_sum(s);
    const float r = obf ? 1.f : 1.f / sqrtf(s * (1.f / DM) + 1e-6f);
#pragma unroll
    for (int j = 0; j < 8; ++j) { const f32x4 ww = *(const f32x4*)(w + 4 * lane + 256 * j); const f32x4 o = v[j] * r * ww;
        if (obf) { u32x2 p; p.x = pk2(o.x, o.y); p.y = pk2(o.z, o.w); *(u32x2*)(obf + 4 * lane + 256 * j) = p; }
        else *(f32x4*)(of32 + 4 * lane + 256 * j) = o; }
    if (obf && lane == 0) *ss = (unsigned long long)(s * 65536.f + 0.5f);
}

__device__ __forceinline__ void phase0(const Ctx& F, const Args& a) {
    LAS float* scr = (LAS float*)(F.lds + F.wave * 16640);
    constexpr int I_IN = 32 * 260, I_GLU = 16 * 16, I_BR = 16 * 32, I_OUT = 32 * 32, IL = I_IN + I_GLU + 3 * I_BR + I_OUT;
    bf16* WIN = (bf16*)(F.ws + WS_WIN); bf16* WGLU = (bf16*)(F.ws + WS_WGLU); bf16* WBR = (bf16*)(F.ws + WS_WBR); bf16* WOUT = (bf16*)(F.ws + WS_WOUT);
    for (int it = F.gw; it < DEPTH * IL; it += F.NGW) {
        const int l = it / IL; int r = it - l * IL;
        if (r < I_IN) { transpose_item(a.in[2] + (size_t)l * DM * NIN, DM, NIN, WIN + (size_t)l * NINP * DM, scr, r / 260, r % 260, F.lane); continue; } r -= I_IN;
        if (r < I_GLU) { transpose_item(a.in[25] + (size_t)l * 1024 * 1024, 1024, 1024, WGLU + (size_t)l * 1024 * 1024, scr, r / 16, r % 16, F.lane); continue; } r -= I_GLU;
        if (r < 3 * I_BR) { const int br = r / I_BR, r2 = r - br * I_BR;
            transpose_item(a.in[28] + (size_t)(l * 3 + br) * 1024 * DM, 1024, DM, WBR + (size_t)(l * 3 + br) * DM * 1024, scr, r2 / 32, r2 % 32, F.lane); continue; } r -= 3 * I_BR;
        transpose_item(a.in[29] + (size_t)l * DM * DM, DM, DM, WOUT + (size_t)l * DM * DM, scr, r / 32, r % 32, F.lane);
    }
    bf16* XN = (bf16*)(F.ws + WS_XN);
    {
        bf16* LT = (bf16*)(F.ws + WS_LORA);
        for (int it = F.gw * 64 + F.lane; it < DEPTH * 2 * 1024 * 12; it += F.NGW * 64) {
            const int kg = it % 12, n = (it / 12) & 1023, lw = it / (12 * 1024), l = lw >> 1, which = lw & 1;
            const float* src = (which ? a.in[11] : a.in[9]) + (size_t)l * 96 * 1024 + (size_t)(8 * kg) * 1024 + n;
            u32x4 o; o.x = pk2(src[0], src[1024]); o.y = pk2(src[2048], src[3072]); o.z = pk2(src[4096], src[5120]); o.w = pk2(src[6144], src[7168]);
            *(u32x4*)(LT + ((size_t)lw * 1024 + n) * 96 + 8 * kg) = o;
        }
    }
    unsigned long long* SS0 = (unsigned long long*)(F.ws + WS_CTL + CTL_SS);
    for (int m = F.gw; m < TOK; m += F.NGW) rms_row(a.in[0] + (size_t)m * DM, a.in[1], XN + (size_t)m * DM, SS0 + m, nullptr, F.lane);
}

__device__ __forceinline__ void prep_gdn(const Ctx& F, const Args& a, int l) {
    const bf16* PROJ = (const bf16*)(F.ws + WS_PROJ);
    float* GQ = (float*)(F.ws + WS_GQ); float* GK = (float*)(F.ws + WS_GK); float* GV = (float*)(F.ws + WS_GV); float* GEG = (float*)(F.ws + WS_GEG); float* GBE = (float*)(F.ws + WS_GBE);
    const float* cw = a.in[3] + (size_t)l * 4 * 3072;
    for (int it = F.gw; it < 2048; it += F.NGW) {
        const int h = it & 7, ch = (it >> 3) & 63, b = it >> 9;
        const int t0 = ch * 32; const int c = 2 * F.lane;
        float w[3][4][2], hist[3][3][2];
#pragma unroll
        for (int p = 0; p < 3; ++p)
#pragma unroll
            for (int j = 0; j < 4; ++j) { const f32x2 ww = *(const f32x2*)(cw + j * 3072 + p * 1024 + h * 128 + c); w[p][j][0] = ww.x; w[p][j][1] = ww.y; }
#pragma unroll
        for (int p = 0; p < 3; ++p)
#pragma unroll
            for (int j = 0; j < 3; ++j) { const int t = t0 - 3 + j; unsigned x = 0u;
                if (t >= 0) x = *(const unsigned*)(PROJ + (size_t)(b * SEQ + t) * NINP + C_GQKV + p * 1024 + h * 128 + c);
                hist[p][j][0] = bflo(x); hist[p][j][1] = bfhi(x); }
        const float alog = a.in[4][l * 8 + h], dtb = a.in[5][l * 8 + h]; const float aexp = expf(alog);
        unsigned raw[3][32];
#pragma unroll
        for (int tt = 0; tt < 32; ++tt)
#pragma unroll
            for (int p = 0; p < 3; ++p) raw[p][tt] = *(const unsigned*)(PROJ + (size_t)(b * SEQ + t0 + tt) * NINP + C_GQKV + p * 1024 + h * 128 + c);
#pragma unroll
        for (int tt = 0; tt < 32; ++tt) {
            const size_t tok = (size_t)(b * SEQ + t0 + tt);
            float o[3][2];
#pragma unroll
            for (int p = 0; p < 3; ++p) {
                const unsigned x = raw[p][tt];
                const float x0 = bflo(x), x1 = bfhi(x);
                const float y0 = w[p][0][0] * hist[p][0][0] + w[p][1][0] * hist[p][1][0] + w[p][2][0] * hist[p][2][0] + w[p][3][0] * x0;
                const float y1 = w[p][0][1] * hist[p][0][1] + w[p][1][1] * hist[p][1][1] + w[p][2][1] * hist[p][2][1] + w[p][3][1] * x1;
                hist[p][0][0] = hist[p][1][0]; hist[p][1][0] = hist[p][2][0]; hist[p][2][0] = x0;
                hist[p][0][1] = hist[p][1][1]; hist[p][1][1] = hist[p][2][1]; hist[p][2][1] = x1;
                o[p][0] = siluf_(y0); o[p][1] = siluf_(y1);
            }
            const float sq = wave_sum(o[0][0] * o[0][0] + o[0][1] * o[0][1]), sk = wave_sum(o[1][0] * o[1][0] + o[1][1] * o[1][1]);
            const float rq = 0.08838834764831845f * rsqrtf(sq + 1e-6f), rk = rsqrtf(sk + 1e-6f);
            const size_t off = tok * 1024 + h * 128 + c;
            *(unsigned*)((bf16*)GQ + off) = pk2(o[0][0] * rq, o[0][1] * rq);
            *(unsigned*)((bf16*)GK + off) = pk2(o[1][0] * rk, o[1][1] * rk);
            *(unsigned*)((bf16*)GV + off) = pk2(o[2][0], o[2][1]);
            if (F.lane == 0) {
                const float bl = bf1(PROJ[tok * NINP + C_GB + h]), al = bf1(PROJ[tok * NINP + C_GA + h]);
                GBE[tok * 8 + h] = sigmoidf_(bl);
                GEG[tok * 8 + h] = expf(-aexp * softplusf_(al + dtb));
            }
        }
    }
}

__device__ __forceinline__ float mix2(unsigned c, unsigned p, float mu0, float mu1, float& o1) {
    const float c0 = bflo(c), c1 = bfhi(c), p0 = bflo(p), p1 = bfhi(p);
    o1 = c1 + (p1 - c1) * mu1; return c0 + (p0 - c0) * mu0;
}
__device__ __forceinline__ void prep_rwkv(const Ctx& F, const Args& a, int l) {
    const bf16* PROJ = (const bf16*)(F.ws + WS_PROJ);
    float* RR = (float*)(F.ws + WS_RR); float* RW = (float*)(F.ws + WS_RW); float* RK = (float*)(F.ws + WS_RK); float* RV = (float*)(F.ws + WS_RV);
    float* RKK = (float*)(F.ws + WS_RKK); float* RKA = (float*)(F.ws + WS_RKA); float* RBON = (float*)(F.ws + WS_RBON);
    const float* mu = a.in[7] + (size_t)l * 3264; const float* w0 = a.in[8] + l * 1024; const float* wup = a.in[9] + (size_t)l * 96 * 1024;
    const float* a0 = a.in[10] + l * 1024; const float* aup = a.in[11] + (size_t)l * 96 * 1024; const float* kk_ = a.in[12] + l * 1024; const float* ka_ = a.in[13] + l * 1024; const float* rk_ = a.in[14] + l * 1024;
    constexpr int AROW = 104;
    LAS bf16* A1 = (LAS bf16*)F.lds; LAS bf16* A2 = A1 + 16 * AROW;
    LAS float* LW = (LAS float*)(F.lds + 8192); LAS float* LA = LW + 16 * 1024;
    const bf16* LTw = (const bf16*)(F.ws + WS_LORA) + (size_t)(2 * l) * 1024 * 96; const bf16* LTa = LTw + 1024 * 96;
    const int j = F.tid, c = 2 * j;
    const f32x2 mur = *(const f32x2*)(mu + c), muk = *(const f32x2*)(mu + 1024 + c), muv = *(const f32x2*)(mu + 2048 + c);
    const f32x2 w0v = *(const f32x2*)(w0 + c), a0v = *(const f32x2*)(a0 + c), kkv = *(const f32x2*)(kk_ + c), kav = *(const f32x2*)(ka_ + c), rkv = *(const f32x2*)(rk_ + c);
    for (int tile = F.vcu; tile < TOK / 16; tile += F.G) {
        __syncthreads();
        for (int e = F.tid; e < 16 * 192; e += NTHREADS) {
            const int tl = e / 192, i = e - tl * 192; const size_t tok = (size_t)tile * 16 + tl;
            const float cur = bf1(PROJ[tok * NINP + C_RF + 3072 + i]);
            const float prv = (tok & (SEQ - 1)) ? bf1(PROJ[(tok - 1) * NINP + C_RF + 3072 + i]) : 0.f;
            const float m = cur + (prv - cur) * mu[3072 + i];
            if (i < 96) A1[tl * AROW + i] = (bf16)f2bf(tanhf(m)); else A2[tl * AROW + i - 96] = (bf16)f2bf(m);
        }
        __syncthreads();
        {
            const int row = F.lane & 15, quad = F.lane >> 4;
            bf16x8_t fw[3], fa[3];
#pragma unroll
            for (int ks = 0; ks < 3; ++ks) { fw[ks] = *(const LAS bf16x8_t*)(A1 + row * AROW + 32 * ks + 8 * quad); fa[ks] = *(const LAS bf16x8_t*)(A2 + row * AROW + 32 * ks + 8 * quad); }
#pragma unroll 2
            for (int nt = 0; nt < 8; ++nt) {
                const int n = 128 * F.wave + 16 * nt + row;
                f32x4 aw = {0.f, 0.f, 0.f, 0.f}, aa = {0.f, 0.f, 0.f, 0.f};
#pragma unroll
                for (int ks = 0; ks < 3; ++ks) {
                    const bf16x8_t bw = *(const bf16x8_t*)(LTw + (size_t)n * 96 + 32 * ks + 8 * quad), ba = *(const bf16x8_t*)(LTa + (size_t)n * 96 + 32 * ks + 8 * quad);
                    aw = __builtin_amdgcn_mfma_f32_16x16x32_bf16(fw[ks], bw, aw, 0, 0, 0); aa = __builtin_amdgcn_mfma_f32_16x16x32_bf16(fa[ks], ba, aa, 0, 0, 0);
                    asm volatile("" :: "v"(bw), "v"(ba));
                }
#pragma unroll
                for (int r = 0; r < 4; ++r) { LW[(4 * quad + r) * 1024 + n] = aw[r]; LA[(4 * quad + r) * 1024 + n] = aa[r]; }
            }
        }
        __syncthreads();
        unsigned rw[17][3];
#pragma unroll
        for (int tl = 0; tl < 17; ++tl) { const size_t tok = (size_t)tile * 16 + tl - 1; const bool ok = tl > 0 || ((tok + 1) & (SEQ - 1)) != 0;
            const bf16* cp = PROJ + tok * NINP + C_RF + c;
#pragma unroll
            for (int q = 0; q < 3; ++q) rw[tl][q] = ok ? *(const unsigned*)(cp + 1024 * q) : 0u; }
#pragma unroll
        for (int tl = 0; tl < 16; ++tl) {
            const size_t tok = (size_t)tile * 16 + tl; const bool hp = (tok & (SEQ - 1)) != 0;
            const unsigned cr = rw[tl + 1][0], ck = rw[tl + 1][1], cv = rw[tl + 1][2];
            const unsigned pr = hp ? rw[tl][0] : 0u, pk = hp ? rw[tl][1] : 0u, pv = hp ? rw[tl][2] : 0u;
            float r1, k1, v1; const float r0 = mix2(cr, pr, mur.x, mur.y, r1), k0 = mix2(ck, pk, muk.x, muk.y, k1), v0 = mix2(cv, pv, muv.x, muv.y, v1);
            const f32x2 lw = *(const LAS f32x2*)(LW + tl * 1024 + c), la = *(const LAS f32x2*)(LA + tl * 1024 + c);
            const float wp0 = w0v.x + lw.x, wp1 = w0v.y + lw.y;
            const float d0 = __expf(-0.6065306597126334f * sigmoidf_(wp0)), d1 = __expf(-0.6065306597126334f * sigmoidf_(wp1));
            const float aa0 = sigmoidf_(a0v.x + la.x), aa1 = sigmoidf_(a0v.y + la.y);
            const float q0 = k0 * kkv.x, q1 = k1 * kkv.y;
            float ss = q0 * q0 + q1 * q1;
#pragma unroll
            for (int o = 1; o < 32; o <<= 1) ss += __shfl_xor(ss, o);
            const float rn = rsqrtf(ss + 1e-6f); const float n0 = q0 * rn, n1 = q1 * rn;
            const float km0 = k0 * (1.f + (aa0 - 1.f) * kav.x), km1 = k1 * (1.f + (aa1 - 1.f) * kav.y);
            float bo = r0 * km0 * rkv.x + r1 * km1 * rkv.y;
#pragma unroll
            for (int o = 1; o < 32; o <<= 1) bo += __shfl_xor(bo, o);
            const size_t off = tok * 1024 + c;
            *(unsigned*)((bf16*)RR + off) = pk2(r0, r1); *(f32x2*)(RW + off) = (f32x2){d0, d1}; *(unsigned*)((bf16*)RK + off) = pk2(km0, km1); *(unsigned*)((bf16*)RV + off) = pk2(v0, v1);
            *(f32x2*)(RKK + off) = (f32x2){-n0, -n1}; *(unsigned*)((bf16*)RKA + off) = pk2(n0 * aa0, n1 * aa1);
            if ((F.lane & 31) == 0) RBON[tok * 16 + (c >> 6)] = bo;
        }
    }
}

#ifndef SCM
#define SCM 7
#endif
#ifndef REPM
#define REPM 0
#endif
constexpr int CH = 32;
#define WFENCE() do { __builtin_amdgcn_fence(__ATOMIC_RELEASE, "wavefront"); asm volatile("s_waitcnt lgkmcnt(0)" ::: "memory"); __builtin_amdgcn_wave_barrier(); __builtin_amdgcn_fence(__ATOMIC_ACQUIRE, "wavefront"); } while (0)

struct GStep { f32x4 k0, k1, q0, q1; float v, eg, be; };
constexpr int G_BUF = 2 * CH * 128 + CH * 32 + 2 * CH;
__device__ __forceinline__ void gdn_lds(GStep& s, const LAS float* buf, int st, int rg, int colL) {
    s.k0 = *(const LAS f32x4*)(buf + st * 128 + rg * 4); s.k1 = *(const LAS f32x4*)(buf + st * 128 + 64 + rg * 4);
    s.q0 = *(const LAS f32x4*)(buf + CH * 128 + st * 128 + rg * 4); s.q1 = *(const LAS f32x4*)(buf + CH * 128 + st * 128 + 64 + rg * 4);
    s.v = buf[2 * CH * 128 + st * 32 + colL]; s.eg = buf[2 * CH * 128 + CH * 32 + st]; s.be = buf[2 * CH * 128 + CH * 32 + CH + st];
}
__device__ __forceinline__ void gdn_step(const GStep& s, f32x2 (&S)[4], LAS float* ob, bool wr) {
    const f32x2 k01 = s.k0.xy, k23 = s.k0.zw, k45 = s.k1.xy, k67 = s.k1.zw;
    const f32x2 a2 = (k01 * S[0] + k23 * S[1]) + (k45 * S[2] + k67 * S[3]);
    const float ks = allred16(a2.x + a2.y);
    const float cc = s.be * (s.v - s.eg * ks);
    S[0] = S[0] * s.eg + k01 * cc; S[1] = S[1] * s.eg + k23 * cc; S[2] = S[2] * s.eg + k45 * cc; S[3] = S[3] * s.eg + k67 * cc;
    const f32x2 o2 = (s.q0.xy * S[0] + s.q0.zw * S[1]) + (s.q1.xy * S[2] + s.q1.zw * S[3]);
    const float o = allred16(o2.x + o2.y);
    if (wr) *ob = o;
}
struct GStage { u32x4 k, q, v; float e; };
__device__ __forceinline__ void gdn_gload(GStage& g, const bf16* GK, const bf16* GQ, const bf16* GV, const float* GEG, const float* GBE, int t0, int tid) {
    { const int st = tid >> 4, f8 = tid & 15; g.k = *(const u32x4*)(GK + (size_t)(t0 + st) * 1024 + 8 * f8); g.q = *(const u32x4*)(GQ + (size_t)(t0 + st) * 1024 + 8 * f8); }
    { const int i = tid & 127; g.v = *(const u32x4*)(GV + (size_t)(t0 + (i >> 2)) * 1024 + 8 * (i & 3)); }
    { const int i = tid & 63; const float* p = (i < 32 ? GEG : GBE); g.e = p[(size_t)(t0 + (i & 31)) * 8]; }
}
__device__ __forceinline__ void st8(LAS float* d, const u32x4 w) { float f[8]; unpack8(w, f); *(LAS f32x4*)d = (f32x4){f[0], f[1], f[2], f[3]}; *(LAS f32x4*)(d + 4) = (f32x4){f[4], f[5], f[6], f[7]}; }
__device__ __forceinline__ void gdn_gstore(const GStage& g, LAS float* buf, int tid) {
    st8(buf + 8 * tid, g.k); st8(buf + CH * 128 + 8 * tid, g.q);
    if (tid < 128) st8(buf + 2 * CH * 128 + 8 * tid, g.v);
    else if (tid >= 256 && tid < 320) buf[2 * CH * 128 + CH * 32 + (tid - 256)] = g.e;
}
__device__ __forceinline__ void gdn_block(const Ctx& F, int vb) {
    const int bh = vb >> 2, qt = vb & 3, b = bh >> 3, h = bh & 7, colL = F.wave * 4 + (F.lane >> 4), rg = F.lane & 15;
    const size_t base = (size_t)b * SEQ;
    const bf16* GK = (const bf16*)(F.ws + WS_GK) + base * 1024 + h * 128; const bf16* GQ = (const bf16*)(F.ws + WS_GQ) + base * 1024 + h * 128;
    const bf16* GV = (const bf16*)(F.ws + WS_GV) + base * 1024 + h * 128 + qt * 32;
    const float* GEG = (const float*)(F.ws + WS_GEG) + base * 8 + h; const float* GBE = (const float*)(F.ws + WS_GBE) + base * 8 + h;
    float* GO = (float*)(F.ws + WS_GO) + base * 1024 + h * 128 + qt * 32;
    LAS float* lb = (LAS float*)F.lds; LAS float* obase = lb + 2 * G_BUF;
    f32x2 S[4] = {{0.f, 0.f}, {0.f, 0.f}, {0.f, 0.f}, {0.f, 0.f}};
    const bool wr = rg == 0;
    GStage g;
    gdn_gload(g, GK, GQ, GV, GEG, GBE, 0, F.tid); gdn_gstore(g, lb, F.tid);
    __syncthreads();
    for (int c = 0; c < SEQ / CH; ++c) {
        const LAS float* buf = lb + (c & 1) * G_BUF; LAS float* ob = obase + (c & 1) * (CH * 32) + colL;
        if (c + 1 < SEQ / CH) gdn_gload(g, GK, GQ, GV, GEG, GBE, (c + 1) * CH, F.tid);
        GStep R0, R1, R2, R3;
        gdn_lds(R0, buf, 0, rg, colL); gdn_lds(R1, buf, 1, rg, colL);
#pragma unroll 1
        for (int s = 0; s < CH; s += 4) {
            gdn_lds(R2, buf, s + 2, rg, colL); gdn_step(R0, S, ob + s * 32, wr);
            gdn_lds(R3, buf, s + 3, rg, colL); gdn_step(R1, S, ob + (s + 1) * 32, wr);
            gdn_lds(R0, buf, (s + 4) & (CH - 1), rg, colL); gdn_step(R2, S, ob + (s + 2) * 32, wr);
            gdn_lds(R1, buf, (s + 5) & (CH - 1), rg, colL); gdn_step(R3, S, ob + (s + 3) * 32, wr);
        }
        if (c + 1 < SEQ / CH) gdn_gstore(g, lb + ((c + 1) & 1) * G_BUF, F.tid);
        __syncthreads();
        if (F.tid < 256) *(f32x4*)(GO + (size_t)(c * CH + (F.tid >> 3)) * 1024 + 4 * (F.tid & 7)) = *(const LAS f32x4*)(obase + (c & 1) * (CH * 32) + 4 * F.tid);
    }
}

struct RStep { f32x4 w, n, a, k, r; float v; };
constexpr int R_BUF = CH * (5 * 64 + 32);
__device__ __forceinline__ void rwkv_lds(RStep& s, const LAS float* buf, int st, int cq, int rowL) {
    s.w = *(const LAS f32x4*)(buf + st * 64 + 4 * cq); s.n = *(const LAS f32x4*)(buf + CH * 64 + st * 64 + 4 * cq); s.a = *(const LAS f32x4*)(buf + 2 * CH * 64 + st * 64 + 4 * cq);
    s.k = *(const LAS f32x4*)(buf + 3 * CH * 64 + st * 64 + 4 * cq); s.r = *(const LAS f32x4*)(buf + 4 * CH * 64 + st * 64 + 4 * cq); s.v = buf[5 * CH * 64 + st * 32 + rowL];
}
__device__ __forceinline__ void rwkv_step(const RStep& s, f32x4& S, LAS float* ob, bool wr) {
    float sa = (S.x * s.n.x + S.y * s.n.y) + (S.z * s.n.z + S.w * s.n.w);
    sa = allred16(sa);
    S = S * s.w + sa * s.a + s.v * s.k;
    float y = (S.x * s.r.x + S.y * s.r.y) + (S.z * s.r.z + S.w * s.r.w);
    y = allred16(y);
    if (wr) *ob = y;
}
struct RStage { f32x4 x[2]; u32x4 y[3], v; };
__device__ __forceinline__ void rwkv_gload(RStage& g, const float* RW, const float* RN, const bf16* RA, const bf16* RKp, const bf16* RRp, const bf16* RV, int t0, int tid) {
    { const int st = tid >> 4, f4 = tid & 15; g.x[0] = *(const f32x4*)(RW + (size_t)(t0 + st) * 1024 + 4 * f4); g.x[1] = *(const f32x4*)(RN + (size_t)(t0 + st) * 1024 + 4 * f4); }
    { const int i = tid & 255; const size_t o = (size_t)(t0 + (i >> 3)) * 1024 + 8 * (i & 7); g.y[0] = *(const u32x4*)(RA + o); g.y[1] = *(const u32x4*)(RKp + o); g.y[2] = *(const u32x4*)(RRp + o); }
    { const int i = tid & 127; g.v = *(const u32x4*)(RV + (size_t)(t0 + (i >> 2)) * 1024 + 8 * (i & 3)); }
}
__device__ __forceinline__ void rwkv_gstore(const RStage& g, LAS float* buf, int tid) {
    *(LAS f32x4*)(buf + 4 * tid) = g.x[0]; *(LAS f32x4*)(buf + CH * 64 + 4 * tid) = g.x[1];
    if (tid < 256) { st8(buf + 2 * CH * 64 + 8 * tid, g.y[0]); st8(buf + 3 * CH * 64 + 8 * tid, g.y[1]); st8(buf + 4 * CH * 64 + 8 * tid, g.y[2]); }
    else if (tid < 384) st8(buf + 5 * CH * 64 + 8 * (tid - 256), g.v);
}
__device__ __forceinline__ void rwkv_block(const Ctx& F, int vb) {
    const int bh = vb >> 1, hf = vb & 1, b = bh >> 4, h = bh & 15, rowL = F.wave * 4 + (F.lane >> 4), cq = F.lane & 15;
    const size_t base = (size_t)b * SEQ * 1024 + h * 64;
    const float* RW = (const float*)(F.ws + WS_RW) + base; const float* RN = (const float*)(F.ws + WS_RKK) + base;
    const bf16* RA = (const bf16*)(F.ws + WS_RKA) + base; const bf16* RKp = (const bf16*)(F.ws + WS_RK) + base; const bf16* RRp = (const bf16*)(F.ws + WS_RR) + base;
    const bf16* RV = (const bf16*)(F.ws + WS_RV) + base + hf * 32;
    float* RY = (float*)(F.ws + WS_RY) + base + hf * 32;
    LAS float* lb = (LAS float*)F.lds; LAS float* obase = lb + 2 * R_BUF;
    f32x4 S = {0.f, 0.f, 0.f, 0.f};
    const bool wr = cq == 0;
    RStage g;
    rwkv_gload(g, RW, RN, RA, RKp, RRp, RV, 0, F.tid); rwkv_gstore(g, lb, F.tid);
    __syncthreads();
    for (int c = 0; c < SEQ / CH; ++c) {
        const LAS float* buf = lb + (c & 1) * R_BUF; LAS float* ob = obase + (c & 1) * (CH * 32) + rowL;
        if (c + 1 < SEQ / CH) rwkv_gload(g, RW, RN, RA, RKp, RRp, RV, (c + 1) * CH, F.tid);
        RStep R0, R1, R2, R3;
        rwkv_lds(R0, buf, 0, cq, rowL); rwkv_lds(R1, buf, 1, cq, rowL);
#pragma unroll 1
        for (int s = 0; s < CH; s += 4) {
            rwkv_lds(R2, buf, s + 2, cq, rowL); rwkv_step(R0, S, ob + s * 32, wr);
            rwkv_lds(R3, buf, s + 3, cq, rowL); rwkv_step(R1, S, ob + (s + 1) * 32, wr);
            rwkv_lds(R0, buf, (s + 4) & (CH - 1), cq, rowL); rwkv_step(R2, S, ob + (s + 2) * 32, wr);
            rwkv_lds(R1, buf, (s + 5) & (CH - 1), cq, rowL); rwkv_step(R3, S, ob + (s + 3) * 32, wr);
        }
        if (c + 1 < SEQ / CH) rwkv_gstore(g, lb + ((c + 1) & 1) * R_BUF, F.tid);
        __syncthreads();
        if (F.tid < 256) *(f32x4*)(RY + (size_t)(c * CH + (F.tid >> 3)) * 1024 + 4 * (F.tid & 7)) = *(const LAS f32x4*)(obase + (c & 1) * (CH * 32) + 4 * F.tid);
    }
}

constexpr int S5_SROW = 136;
constexpr int S5_BROW = 20;
constexpr int S5_WAVE_B = 16 * S5_SROW * 2 + 1024 + 128 * S5_BROW * 4;
__device__ __forceinline__ void s5_block(const Ctx& F, const Args& a, int l, int it) {
    const int b = it >> 6, g = it & 63, p = F.lane, tl = F.lane >> 4, c = F.lane & 15, w = F.wave;
    const bf16* PROJ = (const bf16*)(F.ws + WS_PROJ); bf16* SY = (bf16*)(F.ws + WS_SY);
    LAS float* se = (LAS float*)F.lds;
    LAS unsigned char* wb = F.lds + 4096 + w * S5_WAVE_B;
    LAS bf16* sbuf = (LAS bf16*)wb; LAS float* uall = (LAS float*)(wb + 16 * S5_SROW * 2); LAS float* BU = uall + 256;
    const float dt = expf(a.in[19][l * 64 + g]);
    float abr, abi;
    {   const size_t gp = ((size_t)l * 64 + g) * 64 + p; const float are = a.in[17][gp], aim = a.in[18][gp]; const float mag = expf(are * dt); abr = mag * cosf(aim * dt); abi = mag * sinf(aim * dt); }
    bf16x8_t Bf[8];
    {   const int hl = tl >> 1, c0 = 8 * (tl & 1);
#pragma unroll
        for (int jj = 0; jj < 4; ++jj) {
            const size_t gp2 = ((size_t)l * 64 + g) * 64 + 16 * jj + c; const float are = a.in[17][gp2], aim = a.in[18][gp2];
            const float mag = expf(are * dt), ar = mag * cosf(aim * dt), ai = mag * sinf(aim * dt);
            const float den = are * are + aim * aim, cr = ((ar - 1.f) * are + ai * aim) / den, ci = (ai * are - (ar - 1.f) * aim) / den;
            const f32x4 r0 = *(const f32x4*)(a.in[20] + gp2 * 16 + c0), r1 = *(const f32x4*)(a.in[20] + gp2 * 16 + c0 + 4), i0 = *(const f32x4*)(a.in[21] + gp2 * 16 + c0), i1 = *(const f32x4*)(a.in[21] + gp2 * 16 + c0 + 4);
            const float br[8] = {r0.x, r0.y, r0.z, r0.w, r1.x, r1.y, r1.z, r1.w}, bi[8] = {i0.x, i0.y, i0.z, i0.w, i1.x, i1.y, i1.z, i1.w};
            float vr[8], vi[8];
#pragma unroll
            for (int e = 0; e < 8; ++e) { const float xr = cr * br[e] - ci * bi[e], xi = cr * bi[e] + ci * br[e];
                const float hr = bflo(pk2(xr, 0.f)), hi = bflo(pk2(xi, 0.f)); vr[e] = hl ? xr - hr : hr; vi[e] = hl ? xi - hi : hi; }
            Bf[jj] = __builtin_bit_cast(bf16x8_t, pack8(vr)); Bf[4 + jj] = __builtin_bit_cast(bf16x8_t, pack8(vi));
        }
    }
    bf16x8_t Cf[4];
    { const size_t cb = (((size_t)l * 64 + g) * 16 + c) * 64;
#pragma unroll
      for (int m = 0; m < 4; ++m) { const int k0 = 32 * m + 8 * tl; const float* src = (k0 < 64 ? a.in[22] + cb + k0 : a.in[23] + cb + (k0 - 64)); const float sg = k0 < 64 ? 1.f : -1.f;
          const f32x4 x0 = *(const f32x4*)src, x1 = *(const f32x4*)(src + 4);
          u32x4 pk; pk.x = pk2(sg * x0.x, sg * x0.y); pk.y = pk2(sg * x0.z, sg * x0.w); pk.z = pk2(sg * x1.x, sg * x1.y); pk.w = pk2(sg * x1.z, sg * x1.w);
          Cf[m] = __builtin_bit_cast(bf16x8_t, pk); } }
    const float dsk = a.in[24][l * 1024 + g * 16 + c];
    const int tw = 256 * w;
    const bf16* up = PROJ + ((size_t)b * SEQ + tw + c) * NINP + C_SU + g * 16 + 8 * (tl & 1);
    float sr = 0.f, si = 0.f;
#define S5_BU(UF) do { const bf16x8_t af_ = __builtin_bit_cast(bf16x8_t, UF); \
        _Pragma("unroll") for (int j = 0; j < 8; ++j) { const f32x4 z_ = {0.f, 0.f, 0.f, 0.f}; const f32x4 d_ = __builtin_amdgcn_mfma_f32_16x16x32_bf16(af_, Bf[j], z_, 0, 0, 0); \
            *(LAS f32x4*)(BU + (16 * j + c) * S5_BROW + 4 * tl) = d_; } asm volatile("" :: "v"(af_)); } while (0)
    {
        u32x4 ucur = *(const u32x4*)up;
        for (int t = 0; t < 256; t += 16) {
            const u32x4 unxt = *(const u32x4*)(up + (size_t)((t + 16 < 256) ? t + 16 : t) * NINP);
            S5_BU(ucur);
            WFENCE();
            float br_[16], bi_[16];
#pragma unroll
            for (int q = 0; q < 4; ++q) { const f32x4 x = *(const LAS f32x4*)(BU + p * S5_BROW + 4 * q), y = *(const LAS f32x4*)(BU + (64 + p) * S5_BROW + 4 * q);
                br_[4 * q] = x.x; br_[4 * q + 1] = x.y; br_[4 * q + 2] = x.z; br_[4 * q + 3] = x.w; bi_[4 * q] = y.x; bi_[4 * q + 1] = y.y; bi_[4 * q + 2] = y.z; bi_[4 * q + 3] = y.w; }
#pragma unroll
            for (int s = 0; s < 16; ++s) { const float nr = abr * sr - abi * si + br_[s], ni = abr * si + abi * sr + bi_[s]; sr = nr; si = ni; }
            WFENCE();
            ucur = unxt;
        }
    }
    se[w * 128 + p] = sr; se[w * 128 + 64 + p] = si;
    __syncthreads();
    {
        float pr = abr, pi = abi;
#pragma unroll
        for (int i = 0; i < 8; ++i) { const float nr = pr * pr - pi * pi, ni = 2.f * pr * pi; pr = nr; pi = ni; }
        sr = 0.f; si = 0.f;
        for (int j = 0; j < w; ++j) { const float er = se[j * 128 + p], ei = se[j * 128 + 64 + p]; const float nr = pr * sr - pi * si + er, ni = pr * si + pi * sr + ei; sr = nr; si = ni; }
    }
    {
        u32x4 ucur = *(const u32x4*)up;
        for (int t = 0; t < 256; t += 16) {
            const u32x4 unxt = *(const u32x4*)(up + (size_t)((t + 16 < 256) ? t + 16 : t) * NINP);
            S5_BU(ucur);
            if (tl < 2) { float uf[8]; unpack8(ucur, uf); *(LAS f32x4*)(uall + c * 16 + 8 * tl) = (f32x4){uf[0], uf[1], uf[2], uf[3]}; *(LAS f32x4*)(uall + c * 16 + 8 * tl + 4) = (f32x4){uf[4], uf[5], uf[6], uf[7]}; }
            WFENCE();
            float br_[16], bi_[16];
#pragma unroll
            for (int q = 0; q < 4; ++q) { const f32x4 x = *(const LAS f32x4*)(BU + p * S5_BROW + 4 * q), y = *(const LAS f32x4*)(BU + (64 + p) * S5_BROW + 4 * q);
                br_[4 * q] = x.x; br_[4 * q + 1] = x.y; br_[4 * q + 2] = x.z; br_[4 * q + 3] = x.w; bi_[4 * q] = y.x; bi_[4 * q + 1] = y.y; bi_[4 * q + 2] = y.z; bi_[4 * q + 3] = y.w; }
#pragma unroll
            for (int s = 0; s < 16; ++s) { const float nr = abr * sr - abi * si + br_[s], ni = abr * si + abi * sr + bi_[s]; sr = nr; si = ni;
                const unsigned pk = pk2(sr, si); sbuf[s * S5_SROW + p] = (bf16)(pk & 0xffffu); sbuf[s * S5_SROW + 64 + p] = (bf16)(pk >> 16); }
            WFENCE();
            f32x4 acc = {0.f, 0.f, 0.f, 0.f};
#pragma unroll
            for (int m = 0; m < 4; ++m) { const bf16x8_t af = *(const LAS bf16x8_t*)(sbuf + c * S5_SROW + 32 * m + 8 * tl);
                acc = __builtin_amdgcn_mfma_f32_16x16x32_bf16(af, Cf[m], acc, 0, 0, 0); asm volatile("" :: "v"(af)); }
#pragma unroll
            for (int r = 0; r < 4; ++r) { const int st = 4 * tl + r; const float y = acc[r] + dsk * uall[st * 16 + c];
                SY[((size_t)b * SEQ + tw + t + st) * 1024 + g * 16 + c] = (bf16)(pk2(gelu_tanh(y), 0.f) & 0xffffu); }
            WFENCE();
            ucur = unxt;
        }
    }
#undef S5_BU
    __syncthreads();
}

__device__ __forceinline__ void scan_phase(const Ctx& F, const Args& a, int l) {
    for (int r5 = 0; r5 < 1 + ((REPM >> 9) & 1); ++r5) for (int vb = F.vcu; vb < 256; vb += F.G) s5_block(F, a, l, vb);
    for (int rg_ = 0; rg_ < 1 + ((REPM >> 10) & 1); ++rg_) for (int vb = F.vcu; vb < 256; vb += F.G) {
        if (vb < 128) { gdn_block(F, vb); if (REPM & 2048) gdn_block(F, vb); }
        else { rwkv_block(F, vb - 128); if (REPM & 4096) rwkv_block(F, vb - 128); }
    }
}

__device__ __forceinline__ void post_phase(const Ctx& F, const Args& a, int l, int gw, int ngw) {
    const bf16* PROJ = (const bf16*)(F.ws + WS_PROJ); bf16* OBR = (bf16*)(F.ws + WS_OBR);
    const float* GO = (const float*)(F.ws + WS_GO); const float* RY = (const float*)(F.ws + WS_RY); const float* RV = (const float*)(F.ws + WS_RV); const float* RBON = (const float*)(F.ws + WS_RBON);
    const int c0 = 16 * F.lane;
    float nw[16], lw[16], lb[16];
#pragma unroll
    for (int e = 0; e < 16; ++e) { nw[e] = a.in[6][l * 128 + (c0 & 127) + e]; lw[e] = a.in[15][l * 1024 + c0 + e]; lb[e] = a.in[16][l * 1024 + c0 + e]; }
    for (int tok = gw; tok < TOK; tok += ngw) {
        { float o[16];
#pragma unroll
          for (int q = 0; q < 4; ++q) { const f32x4 v = *(const f32x4*)(GO + (size_t)tok * 1024 + c0 + 4 * q); o[4 * q] = v.x; o[4 * q + 1] = v.y; o[4 * q + 2] = v.z; o[4 * q + 3] = v.w; }
          float ss = 0.f;
#pragma unroll
          for (int e = 0; e < 16; ++e) ss += o[e] * o[e];
          ss = allred8(ss);
          const float rs = rsqrtf(ss * (1.f / 128.f) + 1e-6f);
          float z[16]; { float z0[8], z1[8]; unpack8(*(const u32x4*)(PROJ + (size_t)tok * NINP + C_GZ + c0), z0); unpack8(*(const u32x4*)(PROJ + (size_t)tok * NINP + C_GZ + c0 + 8), z1);
#pragma unroll
              for (int e = 0; e < 8; ++e) { z[e] = z0[e]; z[8 + e] = z1[e]; } }
          float r0[8], r1[8];
#pragma unroll
          for (int e = 0; e < 8; ++e) { r0[e] = o[e] * rs * nw[e] * siluf_(z[e]); r1[e] = o[8 + e] * rs * nw[8 + e] * siluf_(z[8 + e]); }
          *(u32x4*)(OBR + (size_t)tok * 1024 + c0) = pack8(r0); *(u32x4*)(OBR + (size_t)tok * 1024 + c0 + 8) = pack8(r1); }
        { float y[16], v[16];
#pragma unroll
          for (int q = 0; q < 4; ++q) { const f32x4 t = *(const f32x4*)(RY + (size_t)tok * 1024 + c0 + 4 * q); y[4 * q] = t.x; y[4 * q + 1] = t.y; y[4 * q + 2] = t.z; y[4 * q + 3] = t.w;
          }
          { float va[8], vb[8]; unpack8(*(const u32x4*)((const bf16*)RV + (size_t)tok * 1024 + c0), va); unpack8(*(const u32x4*)((const bf16*)RV + (size_t)tok * 1024 + c0 + 8), vb);
#pragma unroll
              for (int e = 0; e < 8; ++e) { v[e] = va[e]; v[8 + e] = vb[e]; } }
          float s = 0.f;
#pragma unroll
          for (int e = 0; e < 16; ++e) s += y[e];
          s += dppf<0xB1>(s); s += dppf<0x4E>(s);
          const float mean = s * (1.f / 64.f); float q2 = 0.f;
#pragma unroll
          for (int e = 0; e < 16; ++e) { const float d = y[e] - mean; q2 += d * d; }
          q2 += dppf<0xB1>(q2); q2 += dppf<0x4E>(q2);
          const float rs = rsqrtf(q2 * (1.f / 64.f) + 64e-5f);
          const float bon = RBON[(size_t)tok * 16 + (c0 >> 6)];
          float z[16]; { float z0[8], z1[8]; unpack8(*(const u32x4*)(PROJ + (size_t)tok * NINP + C_RZ + c0), z0); unpack8(*(const u32x4*)(PROJ + (size_t)tok * NINP + C_RZ + c0 + 8), z1);
#pragma unroll
              for (int e = 0; e < 8; ++e) { z[e] = z0[e]; z[8 + e] = z1[e]; } }
          float r0[8], r1[8];
#pragma unroll
          for (int e = 0; e < 8; ++e) { r0[e] = ((y[e] - mean) * rs * lw[e] + lb[e] + bon * v[e]) * siluf_(z[e]); r1[e] = ((y[8 + e] - mean) * rs * lw[8 + e] + lb[8 + e] + bon * v[8 + e]) * siluf_(z[8 + e]); }
          bf16* ob = OBR + (size_t)TOK * 1024 + (size_t)tok * 1024 + c0;
          *(u32x4*)ob = pack8(r0); *(u32x4*)(ob + 8) = pack8(r1); }
    }
}

#ifndef PHM
#define PHM 0xFFFF
#endif
#ifndef REPM
#define REPM 0
#endif
__global__ void __launch_bounds__(NTHREADS, 2) hybrid_fwd(Args a) {
    extern __shared__ __attribute__((aligned(16))) unsigned char lds_raw[];
    Ctx F;
    F.lds = (LAS unsigned char*)lds_raw; F.ws = a.ws;
    F.G = gridDim.x; { const int bx = blockIdx.x; F.vcu = (F.G % 8 == 0) ? (bx % 8) * (F.G / 8) + bx / 8 : bx; }
    F.NGW = F.G * NWAVES;
    cg::grid_group grid = cg::this_grid();
    if (threadIdx.x < 8) ((volatile LAS unsigned*)(F.lds + MISC_OFF))[threadIdx.x] = 0u;
    __syncthreads();
    grid.sync();
    XcdBarrier bar = xcd_barrier_post((unsigned*)(a.ws + WS_CTL), (volatile LAS unsigned*)(F.lds + MISC_OFF));
    bf16* XN = (bf16*)(a.ws + WS_XN); bf16* PROJ = (bf16*)(a.ws + WS_PROJ);
    int rep = 0;
    for (int ph = a.ph_lo; ph < a.ph_hi; ) {
        { int t_ = threadIdx.x; asm volatile("" : "+v"(t_)); F.tid = t_; F.lane = t_ & 63; F.wave = __builtin_amdgcn_readfirstlane(t_ >> 6); F.gw = F.vcu * NWAVES + F.wave; }
        if (ph == NPHASES - 1) { for (int m = F.gw; m < TOK; m += F.NGW) rms_row(a.out + (size_t)m * DM, a.in[30], nullptr, nullptr, a.out + (size_t)m * DM, F.lane); }
        else if (ph == 0) { if (PHM & 1) phase0(F, a);
            if (REPM & 128) { if (!rep) { rep = 1; __syncthreads(); continue; } rep = 0; } }
        else {
            const int l = (ph - 1) / PH_PER_LAYER, k = (ph - 1) % PH_PER_LAYER;
            if (k == 0 && (PHM & 2)) {
                pg8::Gemm g{XN, (const bf16*)(a.ws + WS_WIN) + (size_t)l * NINP * DM, TOK, NINP, DM}; pg8::StaticOrder S; S.init(TOK, NINP, F.G, (int)blockIdx.x);
                pg8::EpiBf16Rs E{PROJ, NINP, (const unsigned long long*)(a.ws + WS_CTL + CTL_SS) + (size_t)l * TOK};
                pg8::gemm_phase<pg8::EpiBf16Rs, pg8::StaticOrder, true, true>(F.lds, g, S, E);
            } else if (k == 1) { prep_gdn(F, a, l); if (REPM & 8192) prep_gdn(F, a, l); prep_rwkv(F, a, l); if (REPM & 16384) prep_rwkv(F, a, l); }
            else if (k == 2) { if (PHM & 16) scan_phase(F, a, l); }
            else if (k == 3 && (PHM & 32)) {
                const bool split = F.G >= 192;
                if (!split) { post_phase(F, a, l, F.gw, F.NGW); __syncthreads(); }
                if (!split || (int)blockIdx.x < 128) {
                    pg8::Gemm g{(const bf16*)(a.ws + WS_SY), (const bf16*)(a.ws + WS_WGLU) + (size_t)l * 1024 * 1024, TOK, 1024, 1024}; pg8::StaticOrder S; S.init(TOK, 1024, F.G, (int)blockIdx.x);
                    pg8::EpiGlu E{(const bf16*)(a.ws + WS_SY), PROJ, a.in[26] + l * 1024, (bf16*)(a.ws + WS_OBR) + (size_t)2 * TOK * 1024};
                    pg8::gemm_phase<pg8::EpiGlu, pg8::StaticOrder, true, true>(F.lds, g, S, E);
                } else post_phase(F, a, l, ((int)blockIdx.x - 128) * NWAVES + F.wave, (F.G - 128) * NWAVES);
            } else if (k == 4 && (PHM & 64)) {
                pg8::Gemm g{(const bf16*)(a.ws + WS_OBR), (const bf16*)(a.ws + WS_WBR) + (size_t)l * 3 * DM * 1024, 3 * TOK, 3 * DM, 1024};
                pg8::BranchOrder S; S.base.init(TOK, DM, F.G, (int)blockIdx.x);
                pg8::EpiBranch E{PROJ, a.in[27] + (size_t)l * 3 * DM, (bf16*)(a.ws + WS_ACCF), (bf16*)(a.ws + WS_MRG)};
                pg8::gemm_phase<pg8::EpiBranch, pg8::BranchOrder, true, true>(F.lds, g, S, E);
            } else if (k == 5 && (PHM & 128)) {
                pg8::Gemm g{(const bf16*)(a.ws + WS_MRG), (const bf16*)(a.ws + WS_WOUT) + (size_t)l * DM * DM, TOK, DM, DM}; pg8::StaticOrder S; S.init(TOK, DM, F.G, (int)blockIdx.x);
                pg8::EpiResid E{l == 0 ? a.in[0] : a.out, a.out, l + 1 < DEPTH ? XN : nullptr, a.in[1] + (size_t)(l + 1 < DEPTH ? l + 1 : 0) * DM, (unsigned long long*)(a.ws + WS_CTL + CTL_SS) + (size_t)(l + 1 < DEPTH ? l + 1 : 0) * TOK};
                pg8::gemm_phase<pg8::EpiResid, pg8::StaticOrder, true, true>(F.lds, g, S, E);
            }
            if (REPM && !rep && ((REPM >> k) & 1)) { rep = 1; __syncthreads(); continue; }
            rep = 0;
        }
        if (ph + 1 < a.ph_hi) {
            xcd_barrier(bar);
            if (REPM & 256) xcd_barrier(bar);
        }
        ++ph;
    }
}

#ifndef MK_MULTI
#define MK_MULTI 0
#endif
extern "C" void kernel_launch(void* const* d_in, const int* in_sizes, int n_in, void* d_out, int out_size, void* d_ws, size_t ws_size, hipStream_t stream) {
    static int grid = 0;
    if (grid == 0) {
        if (n_in != 31 || out_size != TOK * DM || ws_size < WS_END) { fprintf(stderr, "kernel_launch: unexpected shapes (n_in %d out %d ws %zu)\n", n_in, out_size, ws_size); grid = -1; return; }
        int dev = 0, cus = 0, per_cu = 0;
        hipGetDevice(&dev); hipDeviceGetAttribute(&cus, hipDeviceAttributeMultiprocessorCount, dev);
        if (hipFuncSetAttribute((const void*)hybrid_fwd, hipFuncAttributeMaxDynamicSharedMemorySize, LDS_BYTES) != hipSuccess) { fprintf(stderr, "kernel_launch: hipFuncSetAttribute failed\n"); grid = -1; return; }
        if (hipOccupancyMaxActiveBlocksPerMultiprocessor(&per_cu, (const void*)hybrid_fwd, NTHREADS, LDS_BYTES) != hipSuccess || per_cu < 1) per_cu = 1;
        (void)hipGetLastError();
        grid = cus * per_cu;
        fprintf(stderr, "kernel_launch: grid %d (cus %d x %d)\n", grid, cus, per_cu);
    }
    if (grid < 0) return;
    if (hipMemsetAsync((char*)d_ws + WS_CTL, 0, CTL_ZERO_BYTES, stream) != hipSuccess) { fprintf(stderr, "kernel_launch: memset failed\n"); return; }
    Args a{};
    for (int i = 0; i < 31; ++i) a.in[i] = (const float*)d_in[i];
    a.out = (float*)d_out; a.ws = (unsigned char*)d_ws;
#if MK_MULTI
    for (int ph = 0; ph < NPHASES; ++ph) { a.ph_lo = ph; a.ph_hi = ph + 1; hipLaunchKernelGGL(hybrid_fwd, dim3(grid), dim3(NTHREADS), LDS_BYTES, stream, a); }
#else
    a.ph_lo = 0; a.ph_hi = NPHASES;
    void* args[] = {&a};
    const hipError_t e = hipLaunchCooperativeKernel((const void*)hybrid_fwd, dim3(grid), dim3(NTHREADS), args, LDS_BYTES, stream);
    if (e != hipSuccess) fprintf(stderr, "kernel_launch: cooperative launch failed: %s (grid %d)\n", hipGetErrorString(e), grid);
#endif
}
```

```cpp
#include <hip/hip_runtime.h>
#include <hip/hip_cooperative_groups.h>
#include <cstdio>
#include <cstdint>
namespace cg = cooperative_groups;
namespace pg8 {
#define PG8_LAS __attribute__((address_space(3)))
typedef unsigned short bf16_t;
typedef short bf16x8 __attribute__((ext_vector_type(8)));
typedef float f32x4 __attribute__((ext_vector_type(4)));
typedef unsigned u32x4 __attribute__((ext_vector_type(4)));
constexpr int BM = 256, BK = 64, HALF = 128, HTB = HALF * BK * 2  , STAGE_BYTES = 8 * HTB, NXCD = 8, WGM = 8;

__host__ __device__ __forceinline__ int lds_byte(int r, int c) { const int st = (r >> 4) * 2 + (c >> 5), rr = r & 15, cc = c & 31, ob = rr * 64 + cc * 2; return st * 1024 + (ob ^ (((ob >> 9) & 1) << 5)); }
__host__ __device__ __forceinline__ void stage_rc(int b, int& R, int& C) { const int st = b / 1024, sb = b % 1024, swz = sb ^ (((sb >> 9) & 1) << 5); R = (st >> 1) * 16 + swz / 64; C = (st & 1) * 32 + (swz % 64) / 2; }
__host__ __device__ __forceinline__ int perm32(int rho) { const int n = rho >> 4, i = rho & 15; return 8 * (i >> 2) + 4 * n + (i & 3); }

struct Unit { int pm, pn; };
struct Gemm { const bf16_t* A; const bf16_t* Bt; int M, N, K, ld; };

struct StaticOrder {
    int nM, nN, nwg, G, c;
    __host__ __device__ void init(int M, int N, int G_, int c_) { nM = M / BM; nN = N / BM; nwg = nM * nN; G = G_; c = c_; }
    __host__ __device__ bool next(int i, Unit& u) const {
        const long L = (long)i * G + c; if (L >= nwg) return false;
        int wgid = (int)L; { const int q = nwg / NXCD, r = nwg % NXCD, xcd = wgid % NXCD, off = wgid / NXCD; wgid = (xcd < r ? xcd * (q + 1) : r * (q + 1) + (xcd - r) * q) + off; }
        const int nig = WGM * nN, gid = wgid / nig, fm = gid * WGM, gsz = (nM - fm) < WGM ? (nM - fm) : WGM;
        u.pm = fm + ((wgid % nig) % gsz); u.pn = (wgid % nig) / gsz; return true;
    }
    __device__ __forceinline__ void a_ready(const Unit&) const {}
    __device__ __forceinline__ void done(const Unit&) const {}
};

__device__ __forceinline__ unsigned cvt_pk_bf16(float lo, float hi) { unsigned r; asm volatile("v_cvt_pk_bf16_f32 %0, %1, %2" : "=v"(r) : "v"(lo), "v"(hi)); return r; }
typedef float f32x2 __attribute__((ext_vector_type(2)));
__device__ __forceinline__ f32x2 gelu_pk(f32x2 v) {
    const f32x2 av = __builtin_elementwise_abs(v), d = av * 0.2316418882f + 1.0f;
    f32x2 t; t.x = __builtin_amdgcn_rcpf(d.x); t.y = __builtin_amdgcn_rcpf(d.y);
    f32x2 q = t * 0.5307027145f + (-0.7265760135f); q = q * t + 0.7107068705f; q = q * t + (-0.142248368f); q = q * t + 0.127414796f; q = q * t;
    const f32x2 s = (v * v) * (-0.72134752044f);
    f32x2 e; e.x = __builtin_amdgcn_exp2f(s.x); e.y = __builtin_amdgcn_exp2f(s.y);
    const f32x2 m = v * (q * e), r = v - m;
    f32x2 o; o.x = v.x < 0.f ? m.x : r.x; o.y = v.y < 0.f ? m.y : r.y; return o;
}

template <int ACT  > struct EpiBf16 {
    static constexpr bool PERM = true, AFTER_DRAIN = false; static_assert(ACT == 0 || ACT == 1, "EpiBf16: ACT is 0 (none) or 1 (gelu_pk)");
    bf16_t* O; int ldc; const float* bias; int split_cols; size_t split_stride; float scale0;
    __device__ __forceinline__ void operator()(const f32x4 (&acc)[2][2][4][2], const Unit& u, int wr, int wc, int fr, int fq) const {
        const int row0 = u.pm * BM + wr * 64 + fr; int colt = u.pn * BM; bf16_t* base = O;
        float sc = 1.f; if (split_cols) { const int t = colt / split_cols; base += (size_t)t * split_stride; colt -= t * split_cols; if (t == 0) sc = scale0; }
        const int col0 = colt + wc * 32 + 8 * fq, bcol0 = u.pn * BM + wc * 32 + 8 * fq;
        f32x4 bv[2][2];
#pragma unroll
        for (int bj = 0; bj < 2; ++bj)
#pragma unroll
            for (int n = 0; n < 2; ++n) bv[bj][n] = bias ? *(const f32x4*)(bias + bcol0 + bj * HALF + 4 * n) : (f32x4){0.f, 0.f, 0.f, 0.f};
#pragma unroll
        for (int ai = 0; ai < 2; ++ai)
#pragma unroll
            for (int m = 0; m < 4; ++m) { bf16_t* rowp = base + (size_t)(row0 + ai * HALF + m * 16) * ldc + col0;
#pragma unroll
                for (int bj = 0; bj < 2; ++bj) { f32x4 v0 = acc[ai][bj][m][0] + bv[bj][0], v1 = acc[ai][bj][m][1] + bv[bj][1];
                    if (ACT == 1) { f32x2 a = gelu_pk((f32x2){v0[0], v0[1]}), b = gelu_pk((f32x2){v0[2], v0[3]}), c = gelu_pk((f32x2){v1[0], v1[1]}), d = gelu_pk((f32x2){v1[2], v1[3]});
                        v0 = (f32x4){a.x, a.y, b.x, b.y}; v1 = (f32x4){c.x, c.y, d.x, d.y}; }
                    v0 = v0 * sc; v1 = v1 * sc; u32x4 w; w.x = cvt_pk_bf16(v0[0], v0[1]); w.y = cvt_pk_bf16(v0[2], v0[3]); w.z = cvt_pk_bf16(v1[0], v1[1]); w.w = cvt_pk_bf16(v1[2], v1[3]);
                    *(u32x4*)(rowp + bj * HALF) = w; } }
    }
};

template <class Epi, class Sched, bool ALIGN_EPI = false, bool SP2 = false>
__device__ __forceinline__ void gemm_phase(PG8_LAS unsigned char* lds, const Gemm g, const Sched& S, const Epi& E) {
    int tid_ = threadIdx.x; asm volatile("" : "+v"(tid_));
    const int tid = tid_, wid = __builtin_amdgcn_readfirstlane(tid >> 6), lane = tid & 63, wr = wid >> 2, wc = wid & 3, fr = lane & 15, fq = lane >> 4;
    const int K = g.K, nt = K / BK, LD = g.ld ? g.ld : g.K;
    unsigned voffA[2], voffB[2];
#pragma unroll
    for (int i = 0; i < 2; ++i) { int R, C; stage_rc(tid * 16 + i * 8192, R, C); const int Rb = Epi::PERM ? ((R & ~31) + perm32(R & 31)) : R;
        voffA[i] = (unsigned)(R * LD + C) * 2u; voffB[i] = (unsigned)(Rb * LD + C) * 2u; }
    const size_t kstep = (size_t)(BK * 2);
    const size_t hstep = (size_t)HALF * LD * 2;
    const size_t tstep = 2 * hstep;
    const unsigned ldsw = (unsigned)wid * 1024u;
    const int aoff = lds_byte(wr * 64 + fr, fq * 8), boff = lds_byte(wc * 32 + fr, fq * 8);
#define PG8_SA(b, h) (((b) * 2 + (h)) * HTB)
#define PG8_SB(b, h) ((4 + (b) * 2 + (h)) * HTB)
#define PG8_STAGE(bufoff, gbase, voff) do { _Pragma("unroll") for (int _i = 0; _i < 2; ++_i) \
        __builtin_amdgcn_global_load_lds((const unsigned*)((const char*)(gbase) + (voff)[_i]), (PG8_LAS unsigned*)(lds + (bufoff) + ldsw + _i * 8192), 16, 0, 0); } while (0)
#define PG8_LDA(dst, b, h) do { _Pragma("unroll") for (int m = 0; m < 4; ++m) _Pragma("unroll") for (int k = 0; k < 2; ++k) dst[m][k] = *(const PG8_LAS bf16x8*)(lds + PG8_SA(b, h) + aoff + m * 2048 + k * 1024); } while (0)
#define PG8_LDB(dst, b, h) do { _Pragma("unroll") for (int n = 0; n < 2; ++n) _Pragma("unroll") for (int k = 0; k < 2; ++k) dst[n][k] = *(const PG8_LAS bf16x8*)(lds + PG8_SB(b, h) + boff + n * 2048 + k * 1024); } while (0)
#define PG8_MMA(ai, bj, At, Bt) do { __builtin_amdgcn_s_setprio(1); _Pragma("unroll") for (int m = 0; m < 4; ++m) _Pragma("unroll") for (int n = 0; n < 2; ++n) _Pragma("unroll") for (int k = 0; k < 2; ++k) \
        acc[ai][bj][m][n] = __builtin_amdgcn_mfma_f32_16x16x32_bf16(Bt[n][k], At[m][k], acc[ai][bj][m][n], 0, 0, 0); __builtin_amdgcn_s_setprio(0); } while (0)
#define PG8_WAIT_V(n) asm volatile("s_waitcnt vmcnt(" #n ")" ::: "memory")
#define PG8_WAIT_L(n) asm volatile("s_waitcnt lgkmcnt(" #n ")" ::: "memory")
#define PG8_BAR __builtin_amdgcn_s_barrier()
#define PG8_SCHED __builtin_amdgcn_sched_barrier(0)
    Unit cur, nxt; int ui = 0;
    if (!S.next(0, cur)) return;
    f32x4 acc[2][2][4][2];
#pragma unroll
    for (int a = 0; a < 2; ++a)
#pragma unroll
        for (int b = 0; b < 2; ++b)
#pragma unroll
            for (int m = 0; m < 4; ++m)
#pragma unroll
                for (int n = 0; n < 2; ++n) acc[a][b][m][n] = (f32x4){0.f, 0.f, 0.f, 0.f};
    bf16x8 At[4][2], B0[2][2], B1[2][2];
    const char* cA = (const char*)g.A + (size_t)cur.pm * tstep; const char* cB = (const char*)g.Bt + (size_t)cur.pn * tstep;
    S.a_ready(cur);
    if constexpr (SP2) {
        PG8_STAGE(PG8_SB(0, 0), cB, voffB); PG8_STAGE(PG8_SB(0, 1), cB + hstep, voffB); PG8_STAGE(PG8_SA(0, 0), cA, voffA); PG8_STAGE(PG8_SA(0, 1), cA + hstep, voffA);
        if (wr == 1) PG8_BAR;
        PG8_WAIT_V(2); PG8_BAR;
        PG8_STAGE(PG8_SB(1, 0), cB + kstep, voffB); PG8_STAGE(PG8_SA(1, 0), cA + kstep, voffA); PG8_STAGE(PG8_SB(1, 1), cB + hstep + kstep, voffB);
        PG8_WAIT_V(6); PG8_BAR;
    } else {
        PG8_STAGE(PG8_SB(0, 0), cB, voffB); PG8_STAGE(PG8_SA(0, 0), cA, voffA); PG8_STAGE(PG8_SB(0, 1), cB + hstep, voffB); PG8_STAGE(PG8_SA(0, 1), cA + hstep, voffA);
        if (wr == 1) PG8_BAR;
        PG8_WAIT_V(4); PG8_BAR;
        PG8_STAGE(PG8_SB(1, 0), cB + kstep, voffB); PG8_STAGE(PG8_SA(1, 0), cA + kstep, voffA); PG8_STAGE(PG8_SB(1, 1), cB + hstep + kstep, voffB);
        PG8_WAIT_V(6); PG8_BAR;
    }
    for (;;) {
        const bool has_next = S.next(ui + 1, nxt);
        const char* nA = has_next ? (const char*)g.A + (size_t)nxt.pm * tstep : cA; const char* nB = has_next ? (const char*)g.Bt + (size_t)nxt.pn * tstep : cB;
        for (int t = 0; t < nt; t += 2) {
            const bool last = (t == nt - 2);
            const char* a1 = cA + (size_t)(t + 1) * kstep;
            const char* a2 = last ? nA : cA + (size_t)(t + 2) * kstep; const char* b2 = last ? nB : cB + (size_t)(t + 2) * kstep;
            const char* a3 = a2 + kstep; const char* b3 = b2 + kstep;
            if (last && has_next) S.a_ready(nxt);
            if constexpr (SP2) {
            PG8_LDB(B0, 0, 0); PG8_LDB(B1, 0, 1); PG8_SCHED; PG8_LDA(At, 0, 0); PG8_STAGE(PG8_SA(1, 1), a1 + hstep, voffA);
            PG8_WAIT_V(8); PG8_WAIT_L(0); PG8_BAR; PG8_MMA(0, 0, At, B0); PG8_MMA(0, 1, At, B1); PG8_BAR; PG8_SCHED;
            PG8_LDA(At, 0, 1); PG8_STAGE(PG8_SB(0, 0), b2, voffB); PG8_STAGE(PG8_SB(0, 1), b2 + hstep, voffB); PG8_STAGE(PG8_SA(0, 0), a2, voffA);
            PG8_WAIT_V(8); PG8_WAIT_L(0); PG8_BAR; PG8_MMA(1, 0, At, B0); PG8_MMA(1, 1, At, B1); PG8_BAR; PG8_SCHED;
            PG8_LDB(B0, 1, 0); PG8_LDB(B1, 1, 1); PG8_SCHED; PG8_LDA(At, 1, 0); PG8_STAGE(PG8_SA(0, 1), a2 + hstep, voffA);
            PG8_WAIT_V(8); PG8_WAIT_L(0); PG8_BAR; PG8_MMA(0, 0, At, B0); PG8_MMA(0, 1, At, B1); PG8_BAR; PG8_SCHED;
            PG8_LDA(At, 1, 1); PG8_STAGE(PG8_SB(1, 0), b3, voffB); PG8_STAGE(PG8_SB(1, 1), b3 + hstep, voffB); PG8_STAGE(PG8_SA(1, 0), a3, voffA);
            PG8_WAIT_V(8); PG8_WAIT_L(0); PG8_BAR; PG8_MMA(1, 0, At, B0); PG8_MMA(1, 1, At, B1); PG8_BAR; PG8_SCHED;
            } else {
            PG8_LDB(B0, 0, 0); PG8_SCHED; PG8_LDA(At, 0, 0); PG8_STAGE(PG8_SA(1, 1), a1 + hstep, voffA);
            PG8_WAIT_L(8); PG8_BAR; PG8_WAIT_L(0); PG8_MMA(0, 0, At, B0); PG8_BAR; PG8_SCHED;
            PG8_LDB(B1, 0, 1); PG8_STAGE(PG8_SB(0, 0), b2, voffB);
            PG8_BAR; PG8_WAIT_L(0); PG8_MMA(0, 1, At, B1); PG8_BAR;
            PG8_LDA(At, 0, 1); PG8_STAGE(PG8_SA(0, 0), a2, voffA);
            PG8_BAR; PG8_WAIT_L(0); PG8_MMA(1, 0, At, B0); PG8_BAR; PG8_SCHED;
            PG8_STAGE(PG8_SB(0, 1), b2 + hstep, voffB);
            PG8_WAIT_V(6); PG8_BAR; PG8_MMA(1, 1, At, B1); PG8_BAR;
            PG8_LDB(B0, 1, 0); PG8_SCHED; PG8_LDA(At, 1, 0); PG8_STAGE(PG8_SA(0, 1), a2 + hstep, voffA);
            PG8_WAIT_L(8); PG8_BAR; PG8_WAIT_L(0); PG8_MMA(0, 0, At, B0); PG8_BAR; PG8_SCHED;
            PG8_LDB(B1, 1, 1); PG8_STAGE(PG8_SB(1, 0), b3, voffB);
            PG8_BAR; PG8_WAIT_L(0); PG8_MMA(0, 1, At, B1); PG8_BAR;
            PG8_LDA(At, 1, 1); PG8_STAGE(PG8_SA(1, 0), a3, voffA);
            PG8_BAR; PG8_WAIT_L(0); PG8_MMA(1, 0, At, B0); PG8_BAR; PG8_SCHED;
            PG8_STAGE(PG8_SB(1, 1), b3 + hstep, voffB);
            PG8_WAIT_V(6); PG8_BAR; PG8_MMA(1, 1, At, B1); PG8_BAR;
            }
        }
        if constexpr (ALIGN_EPI) { if (wr == 0) PG8_BAR; }
        if constexpr (!Epi::AFTER_DRAIN) { E(acc, cur, wr, wc, fr, fq); S.done(cur); }
        if (!has_next) break;
#pragma unroll
        for (int a = 0; a < 2; ++a)
#pragma unroll
            for (int b = 0; b < 2; ++b)
#pragma unroll
                for (int m = 0; m < 4; ++m)
#pragma unroll
                    for (int n = 0; n < 2; ++n) acc[a][b][m][n] = (f32x4){0.f, 0.f, 0.f, 0.f};
        cur = nxt; cA = nA; cB = nB; ++ui;
        if constexpr (ALIGN_EPI) { if (wr == 1) PG8_BAR; }
    }
    PG8_WAIT_V(0);
    if constexpr (!ALIGN_EPI) { if (wr == 0) PG8_BAR; }
    PG8_BAR;
    if constexpr (Epi::AFTER_DRAIN) { E.fused(acc, cur, wr, wc, fr, fq, lds, wid, lane); S.done(cur); }
#undef PG8_SA
#undef PG8_SB
#undef PG8_STAGE
#undef PG8_LDA
#undef PG8_LDB
#undef PG8_MMA
#undef PG8_WAIT_V
#undef PG8_WAIT_L
#undef PG8_BAR
#undef PG8_SCHED
}
}

#define GAS __attribute__((address_space(1)))
#define LAS __attribute__((address_space(3)))
typedef unsigned short bf16;
typedef unsigned u32x4 __attribute__((ext_vector_type(4)));
typedef unsigned u32x2 __attribute__((ext_vector_type(2)));
typedef float f32x4 __attribute__((ext_vector_type(4)));
typedef float f32x2 __attribute__((ext_vector_type(2)));
typedef short bf16x8_t __attribute__((ext_vector_type(8)));

constexpr int NBATCH = 4, SEQ = 2048, TOK = NBATCH * SEQ, DM = 2048, DEPTH = 4;
constexpr int NIN = 16592, NINP = 16640;
constexpr int C_GQKV = 0, C_GZ = 3072, C_GB = 4096, C_GA = 4104, C_RF = 4112, C_RZ = 7376, C_SU = 8400, C_SZ = 9424, C_GATE = 10448;
constexpr int NWAVES = 8, NTHREADS = 512;
constexpr int LDS_BYTES = 147456;
constexpr int PH_PER_LAYER = 6, NPHASES = 2 + DEPTH * PH_PER_LAYER;

constexpr size_t MiB = 1u << 20;
constexpr size_t WS_WIN = 0, WS_WGLU = 260 * MiB, WS_WBR = 268 * MiB, WS_WOUT = 316 * MiB, WS_XN = 348 * MiB, WS_PROJ = 380 * MiB;
constexpr size_t WS_GQ = 640 * MiB, WS_GK = 672 * MiB, WS_GV = 704 * MiB, WS_GEG = 736 * MiB, WS_GBE = 737 * MiB, WS_GSC = 737 * MiB + 512 * 1024, WS_GO = 738 * MiB;
constexpr size_t WS_RR = 770 * MiB, WS_RW = 802 * MiB, WS_RK = 834 * MiB, WS_RV = 866 * MiB, WS_RKK = 898 * MiB, WS_RKA = 930 * MiB, WS_RBON = 962 * MiB, WS_RY = 963 * MiB;
constexpr size_t WS_SY = 995 * MiB, WS_OBR = 1011 * MiB, WS_ACCF = 1059 * MiB, WS_MRG = 1123 * MiB, WS_CTL = 1155 * MiB, WS_LORA = 1156 * MiB, WS_END = 1158 * MiB;
constexpr size_t CTL_SS = 65536, CTL_ZERO_BYTES = CTL_SS + (size_t)DEPTH * TOK * 8;
constexpr int MISC_OFF = 147392;
static_assert((size_t)DEPTH * NINP * DM * 2 == 260 * MiB && (size_t)TOK * NINP * 2 == 260 * MiB, "ws map");

__device__ __forceinline__ unsigned f2bf(float f) { unsigned u = __builtin_bit_cast(unsigned, f); return (u + 0x7fffu + ((u >> 16) & 1u)) >> 16; }
__device__ __forceinline__ unsigned pk2(float lo, float hi) { unsigned r; asm("v_cvt_pk_bf16_f32 %0, %1, %2" : "=v"(r) : "v"(lo), "v"(hi)); return r; }
__device__ __forceinline__ float bflo(unsigned w) { return __builtin_bit_cast(float, w << 16); }
__device__ __forceinline__ float bfhi(unsigned w) { return __builtin_bit_cast(float, w & 0xffff0000u); }
__device__ __forceinline__ float bf1(bf16 h) { return __builtin_bit_cast(float, (unsigned)h << 16); }
__device__ __forceinline__ float sigmoidf_(float x) { return __builtin_amdgcn_rcpf(1.f + __expf(-x)); }
__device__ __forceinline__ float siluf_(float x) { return x * __builtin_amdgcn_rcpf(1.f + __expf(-x)); }
__device__ __forceinline__ float softplusf_(float x) { return x > 20.f ? x : log1pf(expf(x)); }
__device__ __forceinline__ float gelu_tanh(float y) { const float t = 0.7978845608028654f * (y + 0.044715f * y * y * y); const float th = 1.f - 2.f * __builtin_amdgcn_rcpf(1.f + __expf(2.f * t)); return 0.5f * y * (1.f + th); }
template <int CTRL> __device__ __forceinline__ float dppf(float v) { return __builtin_bit_cast(float, __builtin_amdgcn_update_dpp(0, __builtin_bit_cast(int, v), CTRL, 0xF, 0xF, true)); }
__device__ __forceinline__ float allred8(float v) { v += dppf<0xB1>(v); v += dppf<0x4E>(v); v += dppf<0x141>(v); return v; }
__device__ __forceinline__ float allred16(float v) { v = allred8(v); v += dppf<0x140>(v); return v; }
__device__ __forceinline__ float wave_sum(float v) {
#pragma unroll
    for (int o = 1; o < 64; o <<= 1) v += __shfl_xor(v, o);
    return v;
}
__device__ __forceinline__ void unpack8(const u32x4 w, float (&f)[8]) { f[0] = bflo(w.x); f[1] = bfhi(w.x); f[2] = bflo(w.y); f[3] = bfhi(w.y); f[4] = bflo(w.z); f[5] = bfhi(w.z); f[6] = bflo(w.w); f[7] = bfhi(w.w); }
__device__ __forceinline__ u32x4 pack8(const float (&f)[8]) { u32x4 w; w.x = pk2(f[0], f[1]); w.y = pk2(f[2], f[3]); w.z = pk2(f[4], f[5]); w.w = pk2(f[6], f[7]); return w; }

namespace pg8 {
struct EpiGlu {
    static constexpr bool PERM = true, AFTER_DRAIN = false;
    const bf16* Y1; const bf16* PROJ; const float* bias; bf16* O;
    __device__ __forceinline__ void operator()(const f32x4 (&acc)[2][2][4][2], const Unit& u, int wr, int wc, int fr, int fq) const {
        int row0 = u.pm * BM + wr * 64 + fr, col0 = u.pn * BM + wc * 32 + 8 * fq;
        asm volatile("" : "+v"(row0), "+v"(col0));
        f32x4 bb[2][2];
#pragma unroll
        for (int bj = 0; bj < 2; ++bj) { bb[bj][0] = *(const f32x4*)(bias + col0 + bj * HALF); bb[bj][1] = *(const f32x4*)(bias + col0 + bj * HALF + 4); }
        u32x4 yc = *(const u32x4*)(Y1 + (size_t)row0 * 1024 + col0), zc = *(const u32x4*)(PROJ + (size_t)row0 * NINP + C_SZ + col0);
#pragma unroll
        for (int it = 0; it < 16; ++it) {
            const int bj = it >> 3, ai = (it >> 2) & 1, m = it & 3;
            const size_t row = (size_t)(row0 + ai * HALF + m * 16); const int col = col0 + bj * HALF;
            u32x4 yn = yc, zn = zc;
            if (it + 1 < 16) { const int nb = (it + 1) >> 3, na = ((it + 1) >> 2) & 1, nm = (it + 1) & 3; const size_t nrow = (size_t)(row0 + na * HALF + nm * 16); const int ncol = col0 + nb * HALF;
                yn = *(const u32x4*)(Y1 + nrow * 1024 + ncol); zn = *(const u32x4*)(PROJ + nrow * NINP + C_SZ + ncol); }
            float y[8], z[8], o[8]; unpack8(yc, y); unpack8(zc, z);
            const f32x4 v0 = acc[ai][bj][m][0] + bb[bj][0], v1 = acc[ai][bj][m][1] + bb[bj][1];
            const float a[8] = {v0[0], v0[1], v0[2], v0[3], v1[0], v1[1], v1[2], v1[3]};
#pragma unroll
            for (int e = 0; e < 8; ++e) o[e] = y[e] * sigmoidf_(a[e]) * siluf_(z[e]);
            *(u32x4*)(O + row * 1024 + col) = pack8(o);
            yc = yn; zc = zn;
            asm volatile("" ::: "memory");
        }
    }
};
struct EpiBranch {
    static constexpr bool PERM = true, AFTER_DRAIN = false;
    const bf16* PROJ; const float* gate_b; bf16* ACC; bf16* MRG;
    __device__ __forceinline__ void operator()(const f32x4 (&acc)[2][2][4][2], const Unit& u, int wr, int wc, int fr, int fq) const {
        const int br = u.pm >> 5, pm = u.pm & 31, pn = u.pn & 7;
        int row0 = pm * BM + wr * 64 + fr, col0 = pn * BM + wc * 32 + 8 * fq;
        asm volatile("" : "+v"(row0), "+v"(col0));
        bf16* dst = br < 2 ? ACC : MRG;
        const bf16* gl = PROJ + C_GATE + br * DM;
        f32x4 gb[2][2];
#pragma unroll
        for (int bj = 0; bj < 2; ++bj) { gb[bj][0] = *(const f32x4*)(gate_b + br * DM + col0 + bj * HALF); gb[bj][1] = *(const f32x4*)(gate_b + br * DM + col0 + bj * HALF + 4); }
        const u32x4 zero = {0u, 0u, 0u, 0u};
        u32x4 lc = *(const u32x4*)(gl + (size_t)row0 * NINP + col0), pc = br > 0 ? *(const u32x4*)(ACC + (size_t)row0 * DM + col0) : zero;
#pragma unroll
        for (int it = 0; it < 16; ++it) {
            const int bj = it >> 3, ai = (it >> 2) & 1, m = it & 3;
            const size_t row = (size_t)(row0 + ai * HALF + m * 16); const int col = col0 + bj * HALF;
            u32x4 ln = lc, pn_ = pc;
            if (it + 1 < 16) { const int nb = (it + 1) >> 3, na = ((it + 1) >> 2) & 1, nm = (it + 1) & 3; const size_t nrow = (size_t)(row0 + na * HALF + nm * 16); const int ncol = col0 + nb * HALF;
                ln = *(const u32x4*)(gl + nrow * NINP + ncol); pn_ = br > 0 ? *(const u32x4*)(ACC + nrow * DM + ncol) : zero; }
            float g[8], p[8], o[8]; unpack8(lc, g); unpack8(pc, p);
            const f32x4 v0 = acc[ai][bj][m][0], v1 = acc[ai][bj][m][1];
            const float a[8] = {v0[0], v0[1], v0[2], v0[3], v1[0], v1[1], v1[2], v1[3]};
            const float gbv[8] = {gb[bj][0][0], gb[bj][0][1], gb[bj][0][2], gb[bj][0][3], gb[bj][1][0], gb[bj][1][1], gb[bj][1][2], gb[bj][1][3]};
#pragma unroll
            for (int e = 0; e < 8; ++e) o[e] = sigmoidf_(g[e] + gbv[e]) * a[e] + p[e];
            *(u32x4*)(dst + row * DM + col) = pack8(o);
            lc = ln; pc = pn_;
            asm volatile("" ::: "memory");
        }
    }
};
struct EpiResid {
    static constexpr bool PERM = true, AFTER_DRAIN = false;
    const float* base; float* out; bf16* xn; const float* nw; unsigned long long* ss;
    __device__ __forceinline__ void operator()(const f32x4 (&acc)[2][2][4][2], const Unit& u, int wr, int wc, int fr, int fq) const {
        int row0 = u.pm * BM + wr * 64 + fr, col0 = u.pn * BM + wc * 32 + 8 * fq;
        asm volatile("" : "+v"(row0), "+v"(col0));
        f32x4 ww[2][2];
#pragma unroll
        for (int bj = 0; bj < 2; ++bj) { ww[bj][0] = *(const f32x4*)(nw + col0 + bj * HALF); ww[bj][1] = *(const f32x4*)(nw + col0 + bj * HALF + 4); }
        f32x4 bc[2][2];
#pragma unroll
        for (int bj = 0; bj < 2; ++bj) { const size_t off = (size_t)row0 * DM + col0 + bj * HALF; bc[bj][0] = *(const f32x4*)(base + off); bc[bj][1] = *(const f32x4*)(base + off + 4); }
#pragma unroll
        for (int it = 0; it < 8; ++it) {
            const int ai = it >> 2, m = it & 3; const int row = row0 + ai * HALF + m * 16;
            f32x4 bn[2][2];
#pragma unroll
            for (int bj = 0; bj < 2; ++bj) { bn[bj][0] = bc[bj][0]; bn[bj][1] = bc[bj][1]; }
            if (it + 1 < 8) { const int nrow = row0 + ((it + 1) >> 2) * HALF + ((it + 1) & 3) * 16;
#pragma unroll
                for (int bj = 0; bj < 2; ++bj) { const size_t off = (size_t)nrow * DM + col0 + bj * HALF; bn[bj][0] = *(const f32x4*)(base + off); bn[bj][1] = *(const f32x4*)(base + off + 4); } }
            float sq = 0.f;
#pragma unroll
            for (int bj = 0; bj < 2; ++bj) {
                const size_t off = (size_t)row * DM + col0 + bj * HALF;
                const f32x4 o0 = bc[bj][0] + acc[ai][bj][m][0], o1 = bc[bj][1] + acc[ai][bj][m][1];
                *(f32x4*)(out + off) = o0; *(f32x4*)(out + off + 4) = o1;
                if (xn) { const f32x4 w0 = ww[bj][0], w1 = ww[bj][1];
                    sq += (o0.x * o0.x + o0.y * o0.y) + (o0.z * o0.z + o0.w * o0.w) + (o1.x * o1.x + o1.y * o1.y) + (o1.z * o1.z + o1.w * o1.w);
                    u32x4 p; p.x = pk2(o0.x * w0.x, o0.y * w0.y); p.y = pk2(o0.z * w0.z, o0.w * w0.w); p.z = pk2(o1.x * w1.x, o1.y * w1.y); p.w = pk2(o1.z * w1.z, o1.w * w1.w);
                    *(u32x4*)(xn + off) = p; }
            }
            if (xn) { sq += __shfl_xor(sq, 16); sq += __shfl_xor(sq, 32); if (fq == 0) atomicAdd(ss + row, (unsigned long long)(sq * 65536.f + 0.5f)); }
#pragma unroll
            for (int bj = 0; bj < 2; ++bj) { bc[bj][0] = bn[bj][0]; bc[bj][1] = bn[bj][1]; }
            asm volatile("" ::: "memory");
        }
    }
};
struct EpiBf16Rs {
    static constexpr bool PERM = true, AFTER_DRAIN = false;
    bf16* O; int ldc; const unsigned long long* ss;
    __device__ __forceinline__ void operator()(const f32x4 (&acc)[2][2][4][2], const Unit& u, int wr, int wc, int fr, int fq) const {
        int row0 = u.pm * BM + wr * 64 + fr, col0 = u.pn * BM + wc * 32 + 8 * fq;
        asm volatile("" : "+v"(row0), "+v"(col0));
#pragma unroll
        for (int ai = 0; ai < 2; ++ai)
#pragma unroll
            for (int m = 0; m < 4; ++m) { const int row = row0 + ai * HALF + m * 16; const float rs = 1.f / sqrtf((float)ss[row] * (1.f / (65536.f * DM)) + 1e-6f);
                bf16* rowp = O + (size_t)row * ldc + col0;
#pragma unroll
                for (int bj = 0; bj < 2; ++bj) { const f32x4 v0 = acc[ai][bj][m][0] * rs, v1 = acc[ai][bj][m][1] * rs;
                    u32x4 w; w.x = cvt_pk_bf16(v0[0], v0[1]); w.y = cvt_pk_bf16(v0[2], v0[3]); w.z = cvt_pk_bf16(v1[0], v1[1]); w.w = cvt_pk_bf16(v1[2], v1[3]);
                    *(u32x4*)(rowp + bj * HALF) = w; } }
    }
};
struct BranchOrder {
    StaticOrder base;
    __device__ bool next(int i, Unit& u) const { Unit t; const int r = i / 3, br = i - 3 * r; if (!base.next(r, t)) return false; u.pm = br * 32 + t.pm; u.pn = br * 8 + t.pn; return true; }
    __device__ __forceinline__ void a_ready(const Unit&) const {}
    __device__ __forceinline__ void done(const Unit&) const {}
};
}

#define XB_TMO      128
#define XB_XCNT(j)  (256  + 64 * (j))
#define XB_XSUB(j)  (1280 + 64 * (j))
#define XB_XGEN(j)  (2304 + 64 * (j))
#define XB_TOP      3328
#define XB_TOPGEN   3392
#define XCD_BAR_WORDS 3456
#define XB_SPIN_CAP (1u << 18)

__device__ __forceinline__ unsigned xb_ld(unsigned* p)              { return __hip_atomic_load(p, __ATOMIC_RELAXED, __HIP_MEMORY_SCOPE_AGENT); }
__device__ __forceinline__ unsigned xb_add(unsigned* p, unsigned v) { return __hip_atomic_fetch_add(p, v, __ATOMIC_RELAXED, __HIP_MEMORY_SCOPE_AGENT); }
__device__ __forceinline__ unsigned xb_xcc_id() { return (unsigned)__builtin_amdgcn_s_getreg((3 << 11) | 20) & 0xFu; }
#define XB_SPIN(cond, bar) do { unsigned _sp = 0; while (cond) { __builtin_amdgcn_s_sleep(1); \
    if ((++_sp & 255u) == 0u) { if (xb_ld(&(bar)[XB_TMO])) break; if (_sp > XB_SPIN_CAP) { atomicAdd(&(bar)[XB_TMO], 1u); break; } } } } while (0)

struct XcdBarrier {
    unsigned* bar; unsigned x;
    volatile LAS unsigned* st;
};

__device__ __forceinline__ XcdBarrier xcd_barrier_post(unsigned* bar, volatile LAS unsigned* st) {
    XcdBarrier b; b.bar = bar; b.x = xb_xcc_id(); b.st = st;
    if (threadIdx.x == 0) (void)xb_add(&bar[XB_XCNT(b.x)], 1u);
    return b;
}
__device__ __forceinline__ void xcd_barrier_complete(unsigned* bar, unsigned x, unsigned& nloc, unsigned& nx) {
    const unsigned G = gridDim.x * gridDim.y * gridDim.z;
    unsigned sum, cnt, mine, sp = 0u;
    for (;;) {
        sum = 0u; cnt = 0u; mine = 0u;
#pragma unroll
        for (unsigned j = 0; j < 16; ++j) { const unsigned c = xb_ld(&bar[XB_XCNT(j)]); sum += c; cnt += (c > 0u) ? 1u : 0u; mine = (j == x) ? c : mine; }
        if (sum == G) break;
        __builtin_amdgcn_s_sleep(1);
        if ((++sp & 255u) == 0u) { if (xb_ld(&bar[XB_TMO])) break; if (sp > XB_SPIN_CAP) { atomicAdd(&bar[XB_TMO], 1u); break; } }
    }
    nloc = mine > 0u ? mine : 1u; nx = cnt > 0u ? cnt : 1u;
}

__device__ __forceinline__ void xcd_barrier(const XcdBarrier& b) {
    asm volatile("s_waitcnt vmcnt(0)" ::: "memory");
    __syncthreads();
    if (threadIdx.x == 0) {
        unsigned* bar = b.bar;
        __builtin_amdgcn_s_waitcnt(0);
        unsigned nloc = b.st[0], nx = b.st[1];
        if (nloc == 0u) { xcd_barrier_complete(bar, b.x, nloc, nx); b.st[0] = nloc; b.st[1] = nx; }
        const unsigned old = xb_add(&bar[XB_XSUB(b.x)], 1u);
        const unsigned gen = old / nloc;
        if (old + 1u == (gen + 1u) * nloc) {
            __builtin_amdgcn_fence(__ATOMIC_RELEASE, "agent");
            asm volatile("s_waitcnt vmcnt(0)" ::: "memory");
            const unsigned og = xb_add(&bar[XB_TOP], 1u);
            const unsigned tg = og / nx;
            if (og + 1u == (tg + 1u) * nx) xb_add(&bar[XB_TOPGEN], 1u);
            else XB_SPIN(xb_ld(&bar[XB_TOPGEN]) == tg, bar);
            __builtin_amdgcn_fence(__ATOMIC_ACQUIRE, "agent");
            xb_add(&bar[XB_XGEN(b.x)], 1u);
            asm volatile("s_waitcnt vmcnt(0)" ::: "memory");
        } else {
            XB_SPIN(xb_ld(&bar[XB_XGEN(b.x)]) == gen, bar);
            __builtin_amdgcn_fence(__ATOMIC_ACQUIRE, "agent");
            asm volatile("s_waitcnt vmcnt(0)" ::: "memory");
        }
    }
    __syncthreads();
}

struct Args { const float* in[31]; float* out; unsigned char* ws; int ph_lo, ph_hi; };
struct Ctx { int tid, lane, wave, vcu, G, gw, NGW; LAS unsigned char* lds; unsigned char* ws; };

__device__ __forceinline__ void transpose_item(const float* W, int K, int N, bf16* WT, LAS float* scr, int kb, int nb, int lane) {
    const int k0 = 64 * kb, n0 = 64 * nb, nq = 4 * (lane & 15), kr = lane >> 4; const bool nv = n0 + nq < N;
    f32x4 v[16];
#pragma unroll
    for (int i = 0; i < 16; ++i) v[i] = nv ? *(const f32x4*)(W + (size_t)(k0 + 4 * i + kr) * N + n0 + nq) : (f32x4){0.f, 0.f, 0.f, 0.f};
#pragma unroll
    for (int i = 0; i < 16; ++i) { LAS float* d = scr + (4 * i + kr) * 65 + nq; d[0] = v[i].x; d[1] = v[i].y; d[2] = v[i].z; d[3] = v[i].w; }
    asm volatile("s_waitcnt lgkmcnt(0)" ::: "memory");
    const int c = lane & 7;
#pragma unroll
    for (int j = 0; j < 8; ++j) { const int nn = (lane >> 3) + 8 * j; const LAS float* s = scr + (8 * c) * 65 + nn;
        u32x4 o; o.x = pk2(s[0 * 65], s[1 * 65]); o.y = pk2(s[2 * 65], s[3 * 65]); o.z = pk2(s[4 * 65], s[5 * 65]); o.w = pk2(s[6 * 65], s[7 * 65]);
        *(u32x4*)(WT + (size_t)(n0 + nn) * K + k0 + 8 * c) = o; }
    asm volatile("s_waitcnt lgkmcnt(0)" ::: "memory");
}

__device__ __forceinline__ void rms_row(const float* xrow, const float* w, bf16* obf, unsigned long long* ss, float* of32, int lane) {
    f32x4 v[8]; float s = 0.f;
#pragma unroll
    for (int j = 0; j < 8; ++j) { v[j] = *(const f32x4*)(xrow + 4 * lane + 256 * j); s += (v[j].x * v[j].x + v[j].y * v[j].y) + (v[j].z * v[j].z + v[j].w * v[j].w); }
    s = wave_sum(s);
    const float r = obf ? 1.f : 1.f / sqrtf(s * (1.f / DM) + 1e-6f);
#pragma unroll
    for (int j = 0; j < 8; ++j) { const f32x4 ww = *(const f32x4*)(w + 4 * lane + 256 * j); const f32x4 o = v[j] * r * ww;
        if (obf) { u32x2 p; p.x = pk2(o.x, o.y); p.y = pk2(o.z, o.w); *(u32x2*)(obf + 4 * lane + 256 * j) = p; }
        else *(f32x4*)(of32 + 4 * lane + 256 * j) = o; }
    if (obf && lane == 0) *ss = (unsigned long long)(s * 65536.f + 0.5f);
}

__device__ __forceinline__ void phase0(const Ctx& F, const Args& a) {
    LAS float* scr = (LAS float*)(F.lds + F.wave * 16640);
    constexpr int I_IN = 32 * 260, I_GLU = 16 * 16, I_BR = 16 * 32, I_OUT = 32 * 32, IL = I_IN + I_GLU + 3 * I_BR + I_OUT;
    bf16* WIN = (bf16*)(F.ws + WS_WIN); bf16* WGLU = (bf16*)(F.ws + WS_WGLU); bf16* WBR = (bf16*)(F.ws + WS_WBR); bf16* WOUT = (bf16*)(F.ws + WS_WOUT);
    for (int it = F.gw; it < DEPTH * IL; it += F.NGW) {
        const int l = it / IL; int r = it - l * IL;
        if (r < I_IN) { transpose_item(a.in[2] + (size_t)l * DM * NIN, DM, NIN, WIN + (size_t)l * NINP * DM, scr, r / 260, r % 260, F.lane); continue; } r -= I_IN;
        if (r < I_GLU) { transpose_item(a.in[25] + (size_t)l * 1024 * 1024, 1024, 1024, WGLU + (size_t)l * 1024 * 1024, scr, r / 16, r % 16, F.lane); continue; } r -= I_GLU;
        if (r < 3 * I_BR) { const int br = r / I_BR, r2 = r - br * I_BR;
            transpose_item(a.in[28] + (size_t)(l * 3 + br) * 1024 * DM, 1024, DM, WBR + (size_t)(l * 3 + br) * DM * 1024, scr, r2 / 32, r2 % 32, F.lane); continue; } r -= 3 * I_BR;
        transpose_item(a.in[29] + (size_t)l * DM * DM, DM, DM, WOUT + (size_t)l * DM * DM, scr, r / 32, r % 32, F.lane);
    }
    bf16* XN = (bf16*)(F.ws + WS_XN);
    {
        bf16* LT = (bf16*)(F.ws + WS_LORA);
        for (int it = F.gw * 64 + F.lane; it < DEPTH * 2 * 1024 * 12; it += F.NGW * 64) {
            const int kg = it % 12, n = (it / 12) & 1023, lw = it / (12 * 1024), l = lw >> 1, which = lw & 1;
            const float* src = (which ? a.in[11] : a.in[9]) + (size_t)l * 96 * 1024 + (size_t)(8 * kg) * 1024 + n;
            u32x4 o; o.x = pk2(src[0], src[1024]); o.y = pk2(src[2048], src[3072]); o.z = pk2(src[4096], src[5120]); o.w = pk2(src[6144], src[7168]);
            *(u32x4*)(LT + ((size_t)lw * 1024 + n) * 96 + 8 * kg) = o;
        }
    }
    unsigned long long* SS0 = (unsigned long long*)(F.ws + WS_CTL + CTL_SS);
    for (int m = F.gw; m < TOK; m += F.NGW) rms_row(a.in[0] + (size_t)m * DM, a.in[1], XN + (size_t)m * DM, SS0 + m, nullptr, F.lane);
}

__device__ __forceinline__ void prep_gdn(const Ctx& F, const Args& a, int l) {
    const bf16* PROJ = (const bf16*)(F.ws + WS_PROJ);
    float* GQ = (float*)(F.ws + WS_GQ); float* GK = (float*)(F.ws + WS_GK); float* GV = (float*)(F.ws + WS_GV); float* GEG = (float*)(F.ws + WS_GEG); float* GBE = (float*)(F.ws + WS_GBE); f32x4* GSC = (f32x4*)(F.ws + WS_GSC);
    const float* cw = a.in[3] + (size_t)l * 4 * 3072;
    for (int it = F.gw; it < 2048; it += F.NGW) {
        const int h = it & 7, ch = (it >> 3) & 63, b = it >> 9;
        const int t0 = ch * 32; const int c = 2 * F.lane;
        float w[3][4][2], hist[3][3][2];
#pragma unroll
        for (int p = 0; p < 3; ++p)
#pragma unroll
            for (int j = 0; j < 4; ++j) { const f32x2 ww = *(const f32x2*)(cw + j * 3072 + p * 1024 + h * 128 + c); w[p][j][0] = ww.x; w[p][j][1] = ww.y; }
#pragma unroll
        for (int p = 0; p < 3; ++p)
#pragma unroll
            for (int j = 0; j < 3; ++j) { const int t = t0 - 3 + j; unsigned x = 0u;
                if (t >= 0) x = *(const unsigned*)(PROJ + (size_t)(b * SEQ + t) * NINP + C_GQKV + p * 1024 + h * 128 + c);
                hist[p][j][0] = bflo(x); hist[p][j][1] = bfhi(x); }
        const float alog = a.in[4][l * 8 + h], dtb = a.in[5][l * 8 + h]; const float aexp = expf(alog);
        float kp0 = 0.f, kp1 = 0.f, qkprev = 0.f;
        unsigned raw[3][32];
#pragma unroll
        for (int tt = 0; tt < 32; ++tt)
#pragma unroll
            for (int p = 0; p < 3; ++p) raw[p][tt] = *(const unsigned*)(PROJ + (size_t)(b * SEQ + t0 + tt) * NINP + C_GQKV + p * 1024 + h * 128 + c);
#pragma unroll
        for (int tt = 0; tt < 32; ++tt) {
            const size_t tok = (size_t)(b * SEQ + t0 + tt);
            float o[3][2];
#pragma unroll
            for (int p = 0; p < 3; ++p) {
                const unsigned x = raw[p][tt];
                const float x0 = bflo(x), x1 = bfhi(x);
                const float y0 = w[p][0][0] * hist[p][0][0] + w[p][1][0] * hist[p][1][0] + w[p][2][0] * hist[p][2][0] + w[p][3][0] * x0;
                const float y1 = w[p][0][1] * hist[p][0][1] + w[p][1][1] * hist[p][1][1] + w[p][2][1] * hist[p][2][1] + w[p][3][1] * x1;
                hist[p][0][0] = hist[p][1][0]; hist[p][1][0] = hist[p][2][0]; hist[p][2][0] = x0;
                hist[p][0][1] = hist[p][1][1]; hist[p][1][1] = hist[p][2][1]; hist[p][2][1] = x1;
                o[p][0] = siluf_(y0); o[p][1] = siluf_(y1);
            }
            const float sq = wave_sum(o[0][0] * o[0][0] + o[0][1] * o[0][1]), sk = wave_sum(o[1][0] * o[1][0] + o[1][1] * o[1][1]);
            const float rq = 0.08838834764831845f * rsqrtf(sq + 1e-6f), rk = rsqrtf(sk + 1e-6f);
            const size_t off = tok * 1024 + h * 128 + c;
            const unsigned qp = pk2(o[0][0] * rq, o[0][1] * rq), kp = pk2(o[1][0] * rk, o[1][1] * rk);
            *(unsigned*)((bf16*)GQ + off) = qp;
            *(unsigned*)((bf16*)GK + off) = kp;
            *(unsigned*)((bf16*)GV + off) = pk2(o[2][0], o[2][1]);
            {
                const float qn0 = bflo(qp), qn1 = bfhi(qp), kn0 = bflo(kp), kn1 = bfhi(kp);
                const float qk = wave_sum(qn0 * kn0 + qn1 * kn1);
                if (tt & 1) { const float kk = wave_sum(kp0 * kn0 + kp1 * kn1), qkp = wave_sum(qn0 * kp0 + qn1 * kp1);
                    if (F.lane == 0) GSC[(tok >> 1) * 8 + h] = (f32x4){kk, qkprev, qkp, qk}; }
                else { kp0 = kn0; kp1 = kn1; qkprev = qk; }
            }
            if (F.lane == 0) {
                const float bl = bf1(PROJ[tok * NINP + C_GB + h]), al = bf1(PROJ[tok * NINP + C_GA + h]);
                GBE[tok * 8 + h] = sigmoidf_(bl);
                GEG[tok * 8 + h] = expf(-aexp * softplusf_(al + dtb));
            }
        }
    }
}

__device__ __forceinline__ float mix2(unsigned c, unsigned p, float mu0, float mu1, float& o1) {
    const float c0 = bflo(c), c1 = bfhi(c), p0 = bflo(p), p1 = bfhi(p);
    o1 = c1 + (p1 - c1) * mu1; return c0 + (p0 - c0) * mu0;
}
__device__ __forceinline__ void prep_rwkv(const Ctx& F, const Args& a, int l) {
    const bf16* PROJ = (const bf16*)(F.ws + WS_PROJ);
    float* RR = (float*)(F.ws + WS_RR); float* RW = (float*)(F.ws + WS_RW); float* RK = (float*)(F.ws + WS_RK); float* RV = (float*)(F.ws + WS_RV);
    float* RKK = (float*)(F.ws + WS_RKK); float* RKA = (float*)(F.ws + WS_RKA); float* RBON = (float*)(F.ws + WS_RBON);
    const float* mu = a.in[7] + (size_t)l * 3264; const float* w0 = a.in[8] + l * 1024; const float* wup = a.in[9] + (size_t)l * 96 * 1024;
    const float* a0 = a.in[10] + l * 1024; const float* aup = a.in[11] + (size_t)l * 96 * 1024; const float* kk_ = a.in[12] + l * 1024; const float* ka_ = a.in[13] + l * 1024; const float* rk_ = a.in[14] + l * 1024;
    constexpr int AROW = 104;
    LAS bf16* A1 = (LAS bf16*)F.lds; LAS bf16* A2 = A1 + 16 * AROW;
    LAS float* LW = (LAS float*)(F.lds + 8192); LAS float* LA = LW + 16 * 1024;
    const bf16* LTw = (const bf16*)(F.ws + WS_LORA) + (size_t)(2 * l) * 1024 * 96; const bf16* LTa = LTw + 1024 * 96;
    const int j = F.tid, c = 2 * j;
    const f32x2 mur = *(const f32x2*)(mu + c), muk = *(const f32x2*)(mu + 1024 + c), muv = *(const f32x2*)(mu + 2048 + c);
    const f32x2 w0v = *(const f32x2*)(w0 + c), a0v = *(const f32x2*)(a0 + c), kkv = *(const f32x2*)(kk_ + c), kav = *(const f32x2*)(ka_ + c), rkv = *(const f32x2*)(rk_ + c);
    for (int tile = F.vcu; tile < TOK / 16; tile += F.G) {
        __syncthreads();
        for (int e = F.tid; e < 16 * 192; e += NTHREADS) {
            const int tl = e / 192, i = e - tl * 192; const size_t tok = (size_t)tile * 16 + tl;
            const float cur = bf1(PROJ[tok * NINP + C_RF + 3072 + i]);
            const float prv = (tok & (SEQ - 1)) ? bf1(PROJ[(tok - 1) * NINP + C_RF + 3072 + i]) : 0.f;
            const float m = cur + (prv - cur) * mu[3072 + i];
            if (i < 96) A1[tl * AROW + i] = (bf16)f2bf(tanhf(m)); else A2[tl * AROW + i - 96] = (bf16)f2bf(m);
        }
        __syncthreads();
        {
            const int row = F.lane & 15, quad = F.lane >> 4;
            bf16x8_t fw[3], fa[3];
#pragma unroll
            for (int ks = 0; ks < 3; ++ks) { fw[ks] = *(const LAS bf16x8_t*)(A1 + row * AROW + 32 * ks + 8 * quad); fa[ks] = *(const LAS bf16x8_t*)(A2 + row * AROW + 32 * ks + 8 * quad); }
#pragma unroll 2
            for (int nt = 0; nt < 8; ++nt) {
                const int n = 128 * F.wave + 16 * nt + row;
                f32x4 aw = {0.f, 0.f, 0.f, 0.f}, aa = {0.f, 0.f, 0.f, 0.f};
#pragma unroll
                for (int ks = 0; ks < 3; ++ks) {
                    const bf16x8_t bw = *(const bf16x8_t*)(LTw + (size_t)n * 96 + 32 * ks + 8 * quad), ba = *(const bf16x8_t*)(LTa + (size_t)n * 96 + 32 * ks + 8 * quad);
                    aw = __builtin_amdgcn_mfma_f32_16x16x32_bf16(fw[ks], bw, aw, 0, 0, 0); aa = __builtin_amdgcn_mfma_f32_16x16x32_bf16(fa[ks], ba, aa, 0, 0, 0);
                    asm volatile("" :: "v"(bw), "v"(ba));
                }
#pragma unroll
                for (int r = 0; r < 4; ++r) { LW[(4 * quad + r) * 1024 + n] = aw[r]; LA[(4 * quad + r) * 1024 + n] = aa[r]; }
            }
        }
        __syncthreads();
        unsigned rw[17][3];
#pragma unroll
        for (int tl = 0; tl < 17; ++tl) { const size_t tok = (size_t)tile * 16 + tl - 1; const bool ok = tl > 0 || ((tok + 1) & (SEQ - 1)) != 0;
            const bf16* cp = PROJ + tok * NINP + C_RF + c;
#pragma unroll
            for (int q = 0; q < 3; ++q) rw[tl][q] = ok ? *(const unsigned*)(cp + 1024 * q) : 0u; }
#pragma unroll
        for (int tl = 0; tl < 16; ++tl) {
            const size_t tok = (size_t)tile * 16 + tl; const bool hp = (tok & (SEQ - 1)) != 0;
            const unsigned cr = rw[tl + 1][0], ck = rw[tl + 1][1], cv = rw[tl + 1][2];
            const unsigned pr = hp ? rw[tl][0] : 0u, pk = hp ? rw[tl][1] : 0u, pv = hp ? rw[tl][2] : 0u;
            float r1, k1, v1; const float r0 = mix2(cr, pr, mur.x, mur.y, r1), k0 = mix2(ck, pk, muk.x, muk.y, k1), v0 = mix2(cv, pv, muv.x, muv.y, v1);
            const f32x2 lw = *(const LAS f32x2*)(LW + tl * 1024 + c), la = *(const LAS f32x2*)(LA + tl * 1024 + c);
            const float wp0 = w0v.x + lw.x, wp1 = w0v.y + lw.y;
            const float d0 = __expf(-0.6065306597126334f * sigmoidf_(wp0)), d1 = __expf(-0.6065306597126334f * sigmoidf_(wp1));
            const float aa0 = sigmoidf_(a0v.x + la.x), aa1 = sigmoidf_(a0v.y + la.y);
            const float q0 = k0 * kkv.x, q1 = k1 * kkv.y;
            float ss = q0 * q0 + q1 * q1;
#pragma unroll
            for (int o = 1; o < 32; o <<= 1) ss += __shfl_xor(ss, o);
            const float rn = rsqrtf(ss + 1e-6f); const float n0 = q0 * rn, n1 = q1 * rn;
            const float km0 = k0 * (1.f + (aa0 - 1.f) * kav.x), km1 = k1 * (1.f + (aa1 - 1.f) * kav.y);
            float bo = r0 * km0 * rkv.x + r1 * km1 * rkv.y;
#pragma unroll
            for (int o = 1; o < 32; o <<= 1) bo += __shfl_xor(bo, o);
            const size_t off = tok * 1024 + c;
            *(unsigned*)((bf16*)RR + off) = pk2(r0, r1); *(f32x2*)(RW + off) = (f32x2){d0, d1}; *(unsigned*)((bf16*)RK + off) = pk2(km0, km1); *(unsigned*)((bf16*)RV + off) = pk2(v0, v1);
            *(f32x2*)(RKK + off) = (f32x2){-n0, -n1}; *(unsigned*)((bf16*)RKA + off) = pk2(n0 * aa0, n1 * aa1);
            if ((F.lane & 31) == 0) RBON[tok * 16 + (c >> 6)] = bo;
        }
    }
}

#ifndef SCM
#define SCM 7
#endif
#ifndef REPM
#define REPM 0
#endif
constexpr int CH = 32;
#define WFENCE() do { __builtin_amdgcn_fence(__ATOMIC_RELEASE, "wavefront"); asm volatile("s_waitcnt lgkmcnt(0)" ::: "memory"); __builtin_amdgcn_wave_barrier(); __builtin_amdgcn_fence(__ATOMIC_ACQUIRE, "wavefront"); } while (0)

struct GPair { f32x4 k1a, k1b, k2a, k2b, q1a, q1b, q2a, q2b, eb, sc; float v1, v2; };
constexpr int G_BUF = 2 * CH * 128 + CH * 32 + 4 * CH;
__device__ __forceinline__ void gdn_lds(GPair& s, const LAS float* buf, int pr, int rg, int colL) {
    const LAS float* kp = buf + 2 * pr * 128 + rg * 4; const LAS float* qp = kp + CH * 128;
    s.k1a = *(const LAS f32x4*)kp; s.k1b = *(const LAS f32x4*)(kp + 64); s.k2a = *(const LAS f32x4*)(kp + 128); s.k2b = *(const LAS f32x4*)(kp + 192);
    s.q1a = *(const LAS f32x4*)qp; s.q1b = *(const LAS f32x4*)(qp + 64); s.q2a = *(const LAS f32x4*)(qp + 128); s.q2b = *(const LAS f32x4*)(qp + 192);
    s.v1 = buf[2 * CH * 128 + 2 * pr * 32 + colL]; s.v2 = buf[2 * CH * 128 + (2 * pr + 1) * 32 + colL];
    s.eb = *(const LAS f32x4*)(buf + 2 * CH * 128 + CH * 32 + 4 * pr); s.sc = *(const LAS f32x4*)(buf + 2 * CH * 128 + CH * 32 + 2 * CH + 4 * pr);
}
__device__ __forceinline__ float dot8(const f32x4 a, const f32x4 b, const f32x2 (&S)[4]) { const f32x2 t = (a.xy * S[0] + a.zw * S[1]) + (b.xy * S[2] + b.zw * S[3]); return t.x + t.y; }
#define DPP4(CTRL) do { d1 += dppf<CTRL>(d1); d2 += dppf<CTRL>(d2); e1 += dppf<CTRL>(e1); e2 += dppf<CTRL>(e2); } while (0)
__device__ __forceinline__ void gdn_pair(const GPair& s, f32x2 (&S)[4], LAS float* ob, bool wr) {
    float d1 = dot8(s.k1a, s.k1b, S), d2 = dot8(s.k2a, s.k2b, S), e1 = dot8(s.q1a, s.q1b, S), e2 = dot8(s.q2a, s.q2b, S);
    DPP4(0xB1); DPP4(0x4E); DPP4(0x141); DPP4(0x140);
    const float g1 = s.eb.x, b1 = s.eb.y, g2 = s.eb.z, b2 = s.eb.w;
    const float c1 = b1 * (s.v1 - g1 * d1);
    const float c2 = b2 * (s.v2 - g2 * (g1 * d2 + c1 * s.sc.x));
    const float o1 = g1 * e1 + c1 * s.sc.y;
    const float o2 = g2 * (g1 * e2 + c1 * s.sc.z) + c2 * s.sc.w;
    const float gg = g1 * g2, f1 = g2 * c1;
    S[0] = S[0] * gg + s.k1a.xy * f1 + s.k2a.xy * c2; S[1] = S[1] * gg + s.k1a.zw * f1 + s.k2a.zw * c2;
    S[2] = S[2] * gg + s.k1b.xy * f1 + s.k2b.xy * c2; S[3] = S[3] * gg + s.k1b.zw * f1 + s.k2b.zw * c2;
    if (wr) { ob[0] = o1; ob[32] = o2; }
}
#undef DPP4
struct GStage { u32x4 k, q, v; f32x4 sc; float e; };
__device__ __forceinline__ void gdn_gload(GStage& g, const bf16* GK, const bf16* GQ, const bf16* GV, const float* GEG, const float* GBE, const f32x4* GSC, int t0, int tid) {
    { const int st = tid >> 4, f8 = tid & 15; g.k = *(const u32x4*)(GK + (size_t)(t0 + st) * 1024 + 8 * f8); g.q = *(const u32x4*)(GQ + (size_t)(t0 + st) * 1024 + 8 * f8); }
    { const int i = tid & 127; g.v = *(const u32x4*)(GV + (size_t)(t0 + (i >> 2)) * 1024 + 8 * (i & 3)); }
    { const int i = tid & 63; const float* p = (i < 32 ? GEG : GBE); g.e = p[(size_t)(t0 + (i & 31)) * 8]; }
    g.sc = GSC[(size_t)((t0 >> 1) + (tid & 15)) * 8];
}
__device__ __forceinline__ void st8(LAS float* d, const u32x4 w) { float f[8]; unpack8(w, f); *(LAS f32x4*)d = (f32x4){f[0], f[1], f[2], f[3]}; *(LAS f32x4*)(d + 4) = (f32x4){f[4], f[5], f[6], f[7]}; }
__device__ __forceinline__ void gdn_gstore(const GStage& g, LAS float* buf, int tid) {
    st8(buf + 8 * tid, g.k); st8(buf + CH * 128 + 8 * tid, g.q);
    if (tid < 128) st8(buf + 2 * CH * 128 + 8 * tid, g.v);
    else if (tid >= 256 && tid < 320) { const int i = tid - 256, st = i & 31, wh = i >> 5; buf[2 * CH * 128 + CH * 32 + (st >> 1) * 4 + (st & 1) * 2 + wh] = g.e; }
    else if (tid >= 320 && tid < 336) *(LAS f32x4*)(buf + 2 * CH * 128 + CH * 32 + 2 * CH + 4 * (tid - 320)) = g.sc;
}
__device__ __forceinline__ void gdn_block(const Ctx& F, int vb) {
    const int bh = vb >> 2, qt = vb & 3, b = bh >> 3, h = bh & 7, colL = F.wave * 4 + (F.lane >> 4), rg = F.lane & 15;
    const size_t base = (size_t)b * SEQ;
    const bf16* GK = (const bf16*)(F.ws + WS_GK) + base * 1024 + h * 128; const bf16* GQ = (const bf16*)(F.ws + WS_GQ) + base * 1024 + h * 128;
    const bf16* GV = (const bf16*)(F.ws + WS_GV) + base * 1024 + h * 128 + qt * 32;
    const float* GEG = (const float*)(F.ws + WS_GEG) + base * 8 + h; const float* GBE = (const float*)(F.ws + WS_GBE) + base * 8 + h;
    const f32x4* GSC = (const f32x4*)(F.ws + WS_GSC) + (base >> 1) * 8 + h;
    float* GO = (float*)(F.ws + WS_GO) + base * 1024 + h * 128 + qt * 32;
    LAS float* lb = (LAS float*)F.lds; LAS float* obase = lb + 2 * G_BUF;
    f32x2 S[4] = {{0.f, 0.f}, {0.f, 0.f}, {0.f, 0.f}, {0.f, 0.f}};
    const bool wr = rg == 0;
    GStage g;
    gdn_gload(g, GK, GQ, GV, GEG, GBE, GSC, 0, F.tid); gdn_gstore(g, lb, F.tid);
    __syncthreads();
    for (int c = 0; c < SEQ / CH; ++c) {
        const LAS float* buf = lb + (c & 1) * G_BUF; LAS float* ob = obase + (c & 1) * (CH * 32) + colL;
        if (c + 1 < SEQ / CH) gdn_gload(g, GK, GQ, GV, GEG, GBE, GSC, (c + 1) * CH, F.tid);
        GPair P0, P1;
        gdn_lds(P0, buf, 0, rg, colL);
#pragma unroll 1
        for (int pr = 0; pr < CH / 2; pr += 2) {
            gdn_lds(P1, buf, pr + 1, rg, colL); gdn_pair(P0, S, ob + 2 * pr * 32, wr);
            gdn_lds(P0, buf, (pr + 2) & (CH / 2 - 1), rg, colL); gdn_pair(P1, S, ob + (2 * pr + 2) * 32, wr);
        }
        if (c + 1 < SEQ / CH) gdn_gstore(g, lb + ((c + 1) & 1) * G_BUF, F.tid);
        __syncthreads();
        if (F.tid < 256) *(f32x4*)(GO + (size_t)(c * CH + (F.tid >> 3)) * 1024 + 4 * (F.tid & 7)) = *(const LAS f32x4*)(obase + (c & 1) * (CH * 32) + 4 * F.tid);
    }
}

struct RStep { f32x4 w, n, a, k, r; float v; };
constexpr int R_BUF = CH * (5 * 64 + 32);
__device__ __forceinline__ void rwkv_lds(RStep& s, const LAS float* buf, int st, int cq, int rowL) {
    s.w = *(const LAS f32x4*)(buf + st * 64 + 4 * cq); s.n = *(const LAS f32x4*)(buf + CH * 64 + st * 64 + 4 * cq); s.a = *(const LAS f32x4*)(buf + 2 * CH * 64 + st * 64 + 4 * cq);
    s.k = *(const LAS f32x4*)(buf + 3 * CH * 64 + st * 64 + 4 * cq); s.r = *(const LAS f32x4*)(buf + 4 * CH * 64 + st * 64 + 4 * cq); s.v = buf[5 * CH * 64 + st * 32 + rowL];
}
__device__ __forceinline__ void rwkv_step(const RStep& s, f32x4& S, LAS float* ob, bool wr) {
    float sa = (S.x * s.n.x + S.y * s.n.y) + (S.z * s.n.z + S.w * s.n.w);
    sa = allred16(sa);
    S = S * s.w + sa * s.a + s.v * s.k;
    float y = (S.x * s.r.x + S.y * s.r.y) + (S.z * s.r.z + S.w * s.r.w);
    y = allred16(y);
    if (wr) *ob = y;
}
struct RStage { f32x4 x[2]; u32x4 y[3], v; };
__device__ __forceinline__ void rwkv_gload(RStage& g, const float* RW, const float* RN, const bf16* RA, const bf16* RKp, const bf16* RRp, const bf16* RV, int t0, int tid) {
    { const int st = tid >> 4, f4 = tid & 15; g.x[0] = *(const f32x4*)(RW + (size_t)(t0 + st) * 1024 + 4 * f4); g.x[1] = *(const f32x4*)(RN + (size_t)(t0 + st) * 1024 + 4 * f4); }
    { const int i = tid & 255; const size_t o = (size_t)(t0 + (i >> 3)) * 1024 + 8 * (i & 7); g.y[0] = *(const u32x4*)(RA + o); g.y[1] = *(const u32x4*)(RKp + o); g.y[2] = *(const u32x4*)(RRp + o); }
    { const int i = tid & 127; g.v = *(const u32x4*)(RV + (size_t)(t0 + (i >> 2)) * 1024 + 8 * (i & 3)); }
}
__device__ __forceinline__ void rwkv_gstore(const RStage& g, LAS float* buf, int tid) {
    *(LAS f32x4*)(buf + 4 * tid) = g.x[0]; *(LAS f32x4*)(buf + CH * 64 + 4 * tid) = g.x[1];
    if (tid < 256) { st8(buf + 2 * CH * 64 + 8 * tid, g.y[0]); st8(buf + 3 * CH * 64 + 8 * tid, g.y[1]); st8(buf + 4 * CH * 64 + 8 * tid, g.y[2]); }
    else if (tid < 384) st8(buf + 5 * CH * 64 + 8 * (tid - 256), g.v);
}
__device__ __forceinline__ void rwkv_block(const Ctx& F, int vb) {
    const int bh = vb >> 1, hf = vb & 1, b = bh >> 4, h = bh & 15, rowL = F.wave * 4 + (F.lane >> 4), cq = F.lane & 15;
    const size_t base = (size_t)b * SEQ * 1024 + h * 64;
    const float* RW = (const float*)(F.ws + WS_RW) + base; const float* RN = (const float*)(F.ws + WS_RKK) + base;
    const bf16* RA = (const bf16*)(F.ws + WS_RKA) + base; const bf16* RKp = (const bf16*)(F.ws + WS_RK) + base; const bf16* RRp = (const bf16*)(F.ws + WS_RR) + base;
    const bf16* RV = (const bf16*)(F.ws + WS_RV) + base + hf * 32;
    float* RY = (float*)(F.ws + WS_RY) + base + hf * 32;
    LAS float* lb = (LAS float*)F.lds; LAS float* obase = lb + 2 * R_BUF;
    f32x4 S = {0.f, 0.f, 0.f, 0.f};
    const bool wr = cq == 0;
    RStage g;
    rwkv_gload(g, RW, RN, RA, RKp, RRp, RV, 0, F.tid); rwkv_gstore(g, lb, F.tid);
    __syncthreads();
    for (int c = 0; c < SEQ / CH; ++c) {
        const LAS float* buf = lb + (c & 1) * R_BUF; LAS float* ob = obase + (c & 1) * (CH * 32) + rowL;
        if (c + 1 < SEQ / CH) rwkv_gload(g, RW, RN, RA, RKp, RRp, RV, (c + 1) * CH, F.tid);
        RStep R0, R1, R2, R3;
        rwkv_lds(R0, buf, 0, cq, rowL); rwkv_lds(R1, buf, 1, cq, rowL);
#pragma unroll 1
        for (int s = 0; s < CH; s += 4) {
            rwkv_lds(R2, buf, s + 2, cq, rowL); rwkv_step(R0, S, ob + s * 32, wr);
            rwkv_lds(R3, buf, s + 3, cq, rowL); rwkv_step(R1, S, ob + (s + 1) * 32, wr);
            rwkv_lds(R0, buf, (s + 4) & (CH - 1), cq, rowL); rwkv_step(R2, S, ob + (s + 2) * 32, wr);
            rwkv_lds(R1, buf, (s + 5) & (CH - 1), cq, rowL); rwkv_step(R3, S, ob + (s + 3) * 32, wr);
        }
        if (c + 1 < SEQ / CH) rwkv_gstore(g, lb + ((c + 1) & 1) * R_BUF, F.tid);
        __syncthreads();
        if (F.tid < 256) *(f32x4*)(RY + (size_t)(c * CH + (F.tid >> 3)) * 1024 + 4 * (F.tid & 7)) = *(const LAS f32x4*)(obase + (c & 1) * (CH * 32) + 4 * F.tid);
    }
}

constexpr int S5_SROW = 136;
constexpr int S5_BROW = 20;
constexpr int S5_WAVE_B = 16 * S5_SROW * 2 + 1024 + 128 * S5_BROW * 4;
__device__ __forceinline__ void s5_block(const Ctx& F, const Args& a, int l, int it) {
    const int b = it >> 6, g = it & 63, p = F.lane, tl = F.lane >> 4, c = F.lane & 15, w = F.wave;
    const bf16* PROJ = (const bf16*)(F.ws + WS_PROJ); bf16* SY = (bf16*)(F.ws + WS_SY);
    LAS float* se = (LAS float*)F.lds;
    LAS unsigned char* wb = F.lds + 4096 + w * S5_WAVE_B;
    LAS bf16* sbuf = (LAS bf16*)wb; LAS float* uall = (LAS float*)(wb + 16 * S5_SROW * 2); LAS float* BU = uall + 256;
    const float dt = expf(a.in[19][l * 64 + g]);
    float abr, abi;
    {   const size_t gp = ((size_t)l * 64 + g) * 64 + p; const float are = a.in[17][gp], aim = a.in[18][gp]; const float mag = expf(are * dt); abr = mag * cosf(aim * dt); abi = mag * sinf(aim * dt); }
    bf16x8_t Bf[8];
    {   const int hl = tl >> 1, c0 = 8 * (tl & 1);
#pragma unroll
        for (int jj = 0; jj < 4; ++jj) {
            const size_t gp2 = ((size_t)l * 64 + g) * 64 + 16 * jj + c; const float are = a.in[17][gp2], aim = a.in[18][gp2];
            const float mag = expf(are * dt), ar = mag * cosf(aim * dt), ai = mag * sinf(aim * dt);
            const float den = are * are + aim * aim, cr = ((ar - 1.f) * are + ai * aim) / den, ci = (ai * are - (ar - 1.f) * aim) / den;
            const f32x4 r0 = *(const f32x4*)(a.in[20] + gp2 * 16 + c0), r1 = *(const f32x4*)(a.in[20] + gp2 * 16 + c0 + 4), i0 = *(const f32x4*)(a.in[21] + gp2 * 16 + c0), i1 = *(const f32x4*)(a.in[21] + gp2 * 16 + c0 + 4);
            const float br[8] = {r0.x, r0.y, r0.z, r0.w, r1.x, r1.y, r1.z, r1.w}, bi[8] = {i0.x, i0.y, i0.z, i0.w, i1.x, i1.y, i1.z, i1.w};
            float vr[8], vi[8];
#pragma unroll
            for (int e = 0; e < 8; ++e) { const float xr = cr * br[e] - ci * bi[e], xi = cr * bi[e] + ci * br[e];
                const float hr = bflo(pk2(xr, 0.f)), hi = bflo(pk2(xi, 0.f)); vr[e] = hl ? xr - hr : hr; vi[e] = hl ? xi - hi : hi; }
            Bf[jj] = __builtin_bit_cast(bf16x8_t, pack8(vr)); Bf[4 + jj] = __builtin_bit_cast(bf16x8_t, pack8(vi));
        }
    }
    bf16x8_t Cf[4];
    { const size_t cb = (((size_t)l * 64 + g) * 16 + c) * 64;
#pragma unroll
      for (int m = 0; m < 4; ++m) { const int k0 = 32 * m + 8 * tl; const float* src = (k0 < 64 ? a.in[22] + cb + k0 : a.in[23] + cb + (k0 - 64)); const float sg = k0 < 64 ? 1.f : -1.f;
          const f32x4 x0 = *(const f32x4*)src, x1 = *(const f32x4*)(src + 4);
          u32x4 pk; pk.x = pk2(sg * x0.x, sg * x0.y); pk.y = pk2(sg * x0.z, sg * x0.w); pk.z = pk2(sg * x1.x, sg * x1.y); pk.w = pk2(sg * x1.z, sg * x1.w);
          Cf[m] = __builtin_bit_cast(bf16x8_t, pk); } }
    const float dsk = a.in[24][l * 1024 + g * 16 + c];
    const int tw = 256 * w;
    const bf16* up = PROJ + ((size_t)b * SEQ + tw + c) * NINP + C_SU + g * 16 + 8 * (tl & 1);
    float sr = 0.f, si = 0.f;
#define S5_BU(UF) do { const bf16x8_t af_ = __builtin_bit_cast(bf16x8_t, UF); \
        _Pragma("unroll") for (int j = 0; j < 8; ++j) { const f32x4 z_ = {0.f, 0.f, 0.f, 0.f}; const f32x4 d_ = __builtin_amdgcn_mfma_f32_16x16x32_bf16(af_, Bf[j], z_, 0, 0, 0); \
            *(LAS f32x4*)(BU + (16 * j + c) * S5_BROW + 4 * tl) = d_; } asm volatile("" :: "v"(af_)); } while (0)
    {
        u32x4 ucur = *(const u32x4*)up;
        for (int t = 0; t < 256; t += 16) {
            const u32x4 unxt = *(const u32x4*)(up + (size_t)((t + 16 < 256) ? t + 16 : t) * NINP);
            S5_BU(ucur);
            WFENCE();
            float br_[16], bi_[16];
#pragma unroll
            for (int q = 0; q < 4; ++q) { const f32x4 x = *(const LAS f32x4*)(BU + p * S5_BROW + 4 * q), y = *(const LAS f32x4*)(BU + (64 + p) * S5_BROW + 4 * q);
                br_[4 * q] = x.x; br_[4 * q + 1] = x.y; br_[4 * q + 2] = x.z; br_[4 * q + 3] = x.w; bi_[4 * q] = y.x; bi_[4 * q + 1] = y.y; bi_[4 * q + 2] = y.z; bi_[4 * q + 3] = y.w; }
#pragma unroll
            for (int s = 0; s < 16; ++s) { const float nr = abr * sr - abi * si + br_[s], ni = abr * si + abi * sr + bi_[s]; sr = nr; si = ni; }
            WFENCE();
            ucur = unxt;
        }
    }
    se[w * 128 + p] = sr; se[w * 128 + 64 + p] = si;
    __syncthreads();
    {
        float pr = abr, pi = abi;
#pragma unroll
        for (int i = 0; i < 8; ++i) { const float nr = pr * pr - pi * pi, ni = 2.f * pr * pi; pr = nr; pi = ni; }
        sr = 0.f; si = 0.f;
        for (int j = 0; j < w; ++j) { const float er = se[j * 128 + p], ei = se[j * 128 + 64 + p]; const float nr = pr * sr - pi * si + er, ni = pr * si + pi * sr + ei; sr = nr; si = ni; }
    }
    {
        u32x4 ucur = *(const u32x4*)up;
        for (int t = 0; t < 256; t += 16) {
            const u32x4 unxt = *(const u32x4*)(up + (size_t)((t + 16 < 256) ? t + 16 : t) * NINP);
            S5_BU(ucur);
            if (tl < 2) { float uf[8]; unpack8(ucur, uf); *(LAS f32x4*)(uall + c * 16 + 8 * tl) = (f32x4){uf[0], uf[1], uf[2], uf[3]}; *(LAS f32x4*)(uall + c * 16 + 8 * tl + 4) = (f32x4){uf[4], uf[5], uf[6], uf[7]}; }
            WFENCE();
            float br_[16], bi_[16];
#pragma unroll
            for (int q = 0; q < 4; ++q) { const f32x4 x = *(const LAS f32x4*)(BU + p * S5_BROW + 4 * q), y = *(const LAS f32x4*)(BU + (64 + p) * S5_BROW + 4 * q);
                br_[4 * q] = x.x; br_[4 * q + 1] = x.y; br_[4 * q + 2] = x.z; br_[4 * q + 3] = x.w; bi_[4 * q] = y.x; bi_[4 * q + 1] = y.y; bi_[4 * q + 2] = y.z; bi_[4 * q + 3] = y.w; }
#pragma unroll
            for (int s = 0; s < 16; ++s) { const float nr = abr * sr - abi * si + br_[s], ni = abr * si + abi * sr + bi_[s]; sr = nr; si = ni;
                const unsigned pk = pk2(sr, si); sbuf[s * S5_SROW + p] = (bf16)(pk & 0xffffu); sbuf[s * S5_SROW + 64 + p] = (bf16)(pk >> 16); }
            WFENCE();
            f32x4 acc = {0.f, 0.f, 0.f, 0.f};
#pragma unroll
            for (int m = 0; m < 4; ++m) { const bf16x8_t af = *(const LAS bf16x8_t*)(sbuf + c * S5_SROW + 32 * m + 8 * tl);
                acc = __builtin_amdgcn_mfma_f32_16x16x32_bf16(af, Cf[m], acc, 0, 0, 0); asm volatile("" :: "v"(af)); }
#pragma unroll
            for (int r = 0; r < 4; ++r) { const int st = 4 * tl + r; const float y = acc[r] + dsk * uall[st * 16 + c];
                SY[((size_t)b * SEQ + tw + t + st) * 1024 + g * 16 + c] = (bf16)(pk2(gelu_tanh(y), 0.f) & 0xffffu); }
            WFENCE();
            ucur = unxt;
        }
    }
#undef S5_BU
    __syncthreads();
}

__device__ __forceinline__ void scan_phase(const Ctx& F, const Args& a, int l) {
    for (int r5 = 0; r5 < 1 + ((REPM >> 9) & 1); ++r5) for (int vb = F.vcu; vb < 256; vb += F.G) s5_block(F, a, l, vb);
    for (int rg_ = 0; rg_ < 1 + ((REPM >> 10) & 1); ++rg_) for (int vb = F.vcu; vb < 256; vb += F.G) {
        if (vb < 128) { gdn_block(F, vb); if (REPM & 2048) gdn_block(F, vb); }
        else { rwkv_block(F, vb - 128); if (REPM & 4096) rwkv_block(F, vb - 128); }
    }
}

__device__ __forceinline__ void post_phase(const Ctx& F, const Args& a, int l, int gw, int ngw) {
    const bf16* PROJ = (const bf16*)(F.ws + WS_PROJ); bf16* OBR = (bf16*)(F.ws + WS_OBR);
    const float* GO = (const float*)(F.ws + WS_GO); const float* RY = (const float*)(F.ws + WS_RY); const float* RV = (const float*)(F.ws + WS_RV); const float* RBON = (const float*)(F.ws + WS_RBON);
    const int c0 = 16 * F.lane;
    float nw[16], lw[16], lb[16];
#pragma unroll
    for (int e = 0; e < 16; ++e) { nw[e] = a.in[6][l * 128 + (c0 & 127) + e]; lw[e] = a.in[15][l * 1024 + c0 + e]; lb[e] = a.in[16][l * 1024 + c0 + e]; }
    for (int tok = gw; tok < TOK; tok += ngw) {
        { float o[16];
#pragma unroll
          for (int q = 0; q < 4; ++q) { const f32x4 v = *(const f32x4*)(GO + (size_t)tok * 1024 + c0 + 4 * q); o[4 * q] = v.x; o[4 * q + 1] = v.y; o[4 * q + 2] = v.z; o[4 * q + 3] = v.w; }
          float ss = 0.f;
#pragma unroll
          for (int e = 0; e < 16; ++e) ss += o[e] * o[e];
          ss = allred8(ss);
          const float rs = rsqrtf(ss * (1.f / 128.f) + 1e-6f);
          float z[16]; { float z0[8], z1[8]; unpack8(*(const u32x4*)(PROJ + (size_t)tok * NINP + C_GZ + c0), z0); unpack8(*(const u32x4*)(PROJ + (size_t)tok * NINP + C_GZ + c0 + 8), z1);
#pragma unroll
              for (int e = 0; e < 8; ++e) { z[e] = z0[e]; z[8 + e] = z1[e]; } }
          float r0[8], r1[8];
#pragma unroll
          for (int e = 0; e < 8; ++e) { r0[e] = o[e] * rs * nw[e] * siluf_(z[e]); r1[e] = o[8 + e] * rs * nw[8 + e] * siluf_(z[8 + e]); }
          *(u32x4*)(OBR + (size_t)tok * 1024 + c0) = pack8(r0); *(u32x4*)(OBR + (size_t)tok * 1024 + c0 + 8) = pack8(r1); }
        { float y[16], v[16];
#pragma unroll
          for (int q = 0; q < 4; ++q) { const f32x4 t = *(const f32x4*)(RY + (size_t)tok * 1024 + c0 + 4 * q); y[4 * q] = t.x; y[4 * q + 1] = t.y; y[4 * q + 2] = t.z; y[4 * q + 3] = t.w;
          }
          { float va[8], vb[8]; unpack8(*(const u32x4*)((const bf16*)RV + (size_t)tok * 1024 + c0), va); unpack8(*(const u32x4*)((const bf16*)RV + (size_t)tok * 1024 + c0 + 8), vb);
#pragma unroll
              for (int e = 0; e < 8; ++e) { v[e] = va[e]; v[8 + e] = vb[e]; } }
          float s = 0.f;
#pragma unroll
          for (int e = 0; e < 16; ++e) s += y[e];
          s += dppf<0xB1>(s); s += dppf<0x4E>(s);
          const float mean = s * (1.f / 64.f); float q2 = 0.f;
#pragma unroll
          for (int e = 0; e < 16; ++e) { const float d = y[e] - mean; q2 += d * d; }
          q2 += dppf<0xB1>(q2); q2 += dppf<0x4E>(q2);
          const float rs = rsqrtf(q2 * (1.f / 64.f) + 64e-5f);
          const float bon = RBON[(size_t)tok * 16 + (c0 >> 6)];
          float z[16]; { float z0[8], z1[8]; unpack8(*(const u32x4*)(PROJ + (size_t)tok * NINP + C_RZ + c0), z0); unpack8(*(const u32x4*)(PROJ + (size_t)tok * NINP + C_RZ + c0 + 8), z1);
#pragma unroll
              for (int e = 0; e < 8; ++e) { z[e] = z0[e]; z[8 + e] = z1[e]; } }
          float r0[8], r1[8];
#pragma unroll
          for (int e = 0; e < 8; ++e) { r0[e] = ((y[e] - mean) * rs * lw[e] + lb[e] + bon * v[e]) * siluf_(z[e]); r1[e] = ((y[8 + e] - mean) * rs * lw[8 + e] + lb[8 + e] + bon * v[8 + e]) * siluf_(z[8 + e]); }
          bf16* ob = OBR + (size_t)TOK * 1024 + (size_t)tok * 1024 + c0;
          *(u32x4*)ob = pack8(r0); *(u32x4*)(ob + 8) = pack8(r1); }
    }
}

#ifndef PHM
#define PHM 0xFFFF
#endif
#ifndef REPM
#define REPM 0
#endif
__global__ void __launch_bounds__(NTHREADS, 2) hybrid_fwd(Args a) {
    extern __shared__ __attribute__((aligned(16))) unsigned char lds_raw[];
    Ctx F;
    F.lds = (LAS unsigned char*)lds_raw; F.ws = a.ws;
    F.G = gridDim.x; { const int bx = blockIdx.x; F.vcu = (F.G % 8 == 0) ? (bx % 8) * (F.G / 8) + bx / 8 : bx; }
    F.NGW = F.G * NWAVES;
    cg::grid_group grid = cg::this_grid();
    if (threadIdx.x < 8) ((volatile LAS unsigned*)(F.lds + MISC_OFF))[threadIdx.x] = 0u;
    __syncthreads();
    grid.sync();
    XcdBarrier bar = xcd_barrier_post((unsigned*)(a.ws + WS_CTL), (volatile LAS unsigned*)(F.lds + MISC_OFF));
    bf16* XN = (bf16*)(a.ws + WS_XN); bf16* PROJ = (bf16*)(a.ws + WS_PROJ);
    int rep = 0;
    for (int ph = a.ph_lo; ph < a.ph_hi; ) {
        { int t_ = threadIdx.x; asm volatile("" : "+v"(t_)); F.tid = t_; F.lane = t_ & 63; F.wave = __builtin_amdgcn_readfirstlane(t_ >> 6); F.gw = F.vcu * NWAVES + F.wave; }
        if (ph == NPHASES - 1) { for (int m = F.gw; m < TOK; m += F.NGW) rms_row(a.out + (size_t)m * DM, a.in[30], nullptr, nullptr, a.out + (size_t)m * DM, F.lane); }
        else if (ph == 0) { if (PHM & 1) phase0(F, a);
            if (REPM & 128) { if (!rep) { rep = 1; __syncthreads(); continue; } rep = 0; } }
        else {
            const int l = (ph - 1) / PH_PER_LAYER, k = (ph - 1) % PH_PER_LAYER;
            if (k == 0 && (PHM & 2)) {
                pg8::Gemm g{XN, (const bf16*)(a.ws + WS_WIN) + (size_t)l * NINP * DM, TOK, NINP, DM}; pg8::StaticOrder S; S.init(TOK, NINP, F.G, (int)blockIdx.x);
                pg8::EpiBf16Rs E{PROJ, NINP, (const unsigned long long*)(a.ws + WS_CTL + CTL_SS) + (size_t)l * TOK};
                pg8::gemm_phase<pg8::EpiBf16Rs, pg8::StaticOrder, true, true>(F.lds, g, S, E);
            } else if (k == 1) { prep_gdn(F, a, l); if (REPM & 8192) prep_gdn(F, a, l); prep_rwkv(F, a, l); if (REPM & 16384) prep_rwkv(F, a, l); }
            else if (k == 2) { if (PHM & 16) scan_phase(F, a, l); }
            else if (k == 3 && (PHM & 32)) {
                const bool split = F.G >= 192;
                if (!split) { post_phase(F, a, l, F.gw, F.NGW); __syncthreads(); }
                if (!split || (int)blockIdx.x < 128) {
                    pg8::Gemm g{(const bf16*)(a.ws + WS_SY), (const bf16*)(a.ws + WS_WGLU) + (size_t)l * 1024 * 1024, TOK, 1024, 1024}; pg8::StaticOrder S; S.init(TOK, 1024, F.G, (int)blockIdx.x);
                    pg8::EpiGlu E{(const bf16*)(a.ws + WS_SY), PROJ, a.in[26] + l * 1024, (bf16*)(a.ws + WS_OBR) + (size_t)2 * TOK * 1024};
                    pg8::gemm_phase<pg8::EpiGlu, pg8::StaticOrder, true, true>(F.lds, g, S, E);
                } else post_phase(F, a, l, ((int)blockIdx.x - 128) * NWAVES + F.wave, (F.G - 128) * NWAVES);
            } else if (k == 4 && (PHM & 64)) {
                pg8::Gemm g{(const bf16*)(a.ws + WS_OBR), (const bf16*)(a.ws + WS_WBR) + (size_t)l * 3 * DM * 1024, 3 * TOK, 3 * DM, 1024};
                pg8::BranchOrder S; S.base.init(TOK, DM, F.G, (int)blockIdx.x);
                pg8::EpiBranch E{PROJ, a.in[27] + (size_t)l * 3 * DM, (bf16*)(a.ws + WS_ACCF), (bf16*)(a.ws + WS_MRG)};
                pg8::gemm_phase<pg8::EpiBranch, pg8::BranchOrder, true, true>(F.lds, g, S, E);
            } else if (k == 5 && (PHM & 128)) {
                pg8::Gemm g{(const bf16*)(a.ws + WS_MRG), (const bf16*)(a.ws + WS_WOUT) + (size_t)l * DM * DM, TOK, DM, DM}; pg8::StaticOrder S; S.init(TOK, DM, F.G, (int)blockIdx.x);
                pg8::EpiResid E{l == 0 ? a.in[0] : a.out, a.out, l + 1 < DEPTH ? XN : nullptr, a.in[1] + (size_t)(l + 1 < DEPTH ? l + 1 : 0) * DM, (unsigned long long*)(a.ws + WS_CTL + CTL_SS) + (size_t)(l + 1 < DEPTH ? l + 1 : 0) * TOK};
                pg8::gemm_phase<pg8::EpiResid, pg8::StaticOrder, true, true>(F.lds, g, S, E);
            }
            if (REPM && !rep && ((REPM >> k) & 1)) { rep = 1; __syncthreads(); continue; }
            rep = 0;
        }
        if (ph + 1 < a.ph_hi) {
            xcd_barrier(bar);
            if (REPM & 256) xcd_barrier(bar);
        }
        ++ph;
    }
}

#ifndef MK_MULTI
#define MK_MULTI 0
#endif
extern "C" void kernel_launch(void* const* d_in, const int* in_sizes, int n_in, void* d_out, int out_size, void* d_ws, size_t ws_size, hipStream_t stream) {
    static int grid = 0;
    if (grid == 0) {
        if (n_in != 31 || out_size != TOK * DM || ws_size < WS_END) { fprintf(stderr, "kernel_launch: unexpected shapes (n_in %d out %d ws %zu)\n", n_in, out_size, ws_size); grid = -1; return; }
        int dev = 0, cus = 0, per_cu = 0;
        hipGetDevice(&dev); hipDeviceGetAttribute(&cus, hipDeviceAttributeMultiprocessorCount, dev);
        if (hipFuncSetAttribute((const void*)hybrid_fwd, hipFuncAttributeMaxDynamicSharedMemorySize, LDS_BYTES) != hipSuccess) { fprintf(stderr, "kernel_launch: hipFuncSetAttribute failed\n"); grid = -1; return; }
        if (hipOccupancyMaxActiveBlocksPerMultiprocessor(&per_cu, (const void*)hybrid_fwd, NTHREADS, LDS_BYTES) != hipSuccess || per_cu < 1) per_cu = 1;
        (void)hipGetLastError();
        grid = cus * per_cu;
        fprintf(stderr, "kernel_launch: grid %d (cus %d x %d)\n", grid, cus, per_cu);
    }
    if (grid < 0) return;
    if (hipMemsetAsync((char*)d_ws + WS_CTL, 0, CTL_ZERO_BYTES, stream) != hipSuccess) { fprintf(stderr, "kernel_launch: memset failed\n"); return; }
    Args a{};
    for (int i = 0; i < 31; ++i) a.in[i] = (const float*)d_in[i];
    a.out = (float*)d_out; a.ws = (unsigned char*)d_ws;
#if MK_MULTI
    for (int ph = 0; ph < NPHASES; ++ph) { a.ph_lo = ph; a.ph_hi = ph + 1; hipLaunchKernelGGL(hybrid_fwd, dim3(grid), dim3(NTHREADS), LDS_BYTES, stream, a); }
#else
    a.ph_lo = 0; a.ph_hi = NPHASES;
    void* args[] = {&a};
    const hipError_t e = hipLaunchCooperativeKernel((const void*)hybrid_fwd, dim3(grid), dim3(NTHREADS), args, LDS_BYTES, stream);
    if (e != hipSuccess) fprintf(stderr, "kernel_launch: cooperative launch failed: %s (grid %d)\n", hipGetErrorString(e), grid);
#endif
}
```

```cpp
#include <hip/hip_runtime.h>
#include <hip/hip_cooperative_groups.h>
#include <cstdio>
#include <cstdint>
namespace cg = cooperative_groups;
namespace pg8 {
#define PG8_LAS __attribute__((address_space(3)))
typedef unsigned short bf16_t;
typedef short bf16x8 __attribute__((ext_vector_type(8)));
typedef float f32x4 __attribute__((ext_vector_type(4)));
typedef unsigned u32x4 __attribute__((ext_vector_type(4)));
constexpr int BM = 256, BK = 64, HALF = 128, HTB = HALF * BK * 2  , STAGE_BYTES = 8 * HTB, NXCD = 8, WGM = 8;

__host__ __device__ __forceinline__ int lds_byte(int r, int c) { const int st = (r >> 4) * 2 + (c >> 5), rr = r & 15, cc = c & 31, ob = rr * 64 + cc * 2; return st * 1024 + (ob ^ (((ob >> 9) & 1) << 5)); }
__host__ __device__ __forceinline__ void stage_rc(int b, int& R, int& C) { const int st = b / 1024, sb = b % 1024, swz = sb ^ (((sb >> 9) & 1) << 5); R = (st >> 1) * 16 + swz / 64; C = (st & 1) * 32 + (swz % 64) / 2; }
__host__ __device__ __forceinline__ int perm32(int rho) { const int n = rho >> 4, i = rho & 15; return 8 * (i >> 2) + 4 * n + (i & 3); }

struct Unit { int pm, pn; };
struct Gemm { const bf16_t* A; const bf16_t* Bt; int M, N, K, ld; };

struct StaticOrder {
    int nM, nN, nwg, G, c;
    __host__ __device__ void init(int M, int N, int G_, int c_) { nM = M / BM; nN = N / BM; nwg = nM * nN; G = G_; c = c_; }
    __host__ __device__ bool next(int i, Unit& u) const {
        const long L = (long)i * G + c; if (L >= nwg) return false;
        int wgid = (int)L; { const int q = nwg / NXCD, r = nwg % NXCD, xcd = wgid % NXCD, off = wgid / NXCD; wgid = (xcd < r ? xcd * (q + 1) : r * (q + 1) + (xcd - r) * q) + off; }
        const int nig = WGM * nN, gid = wgid / nig, fm = gid * WGM, gsz = (nM - fm) < WGM ? (nM - fm) : WGM;
        u.pm = fm + ((wgid % nig) % gsz); u.pn = (wgid % nig) / gsz; return true;
    }
    __device__ __forceinline__ void a_ready(const Unit&) const {}
    __device__ __forceinline__ void done(const Unit&) const {}
};

__device__ __forceinline__ unsigned cvt_pk_bf16(float lo, float hi) { unsigned r; asm volatile("v_cvt_pk_bf16_f32 %0, %1, %2" : "=v"(r) : "v"(lo), "v"(hi)); return r; }
typedef float f32x2 __attribute__((ext_vector_type(2)));
__device__ __forceinline__ f32x2 gelu_pk(f32x2 v) {
    const f32x2 av = __builtin_elementwise_abs(v), d = av * 0.2316418882f + 1.0f;
    f32x2 t; t.x = __builtin_amdgcn_rcpf(d.x); t.y = __builtin_amdgcn_rcpf(d.y);
    f32x2 q = t * 0.5307027145f + (-0.7265760135f); q = q * t + 0.7107068705f; q = q * t + (-0.142248368f); q = q * t + 0.127414796f; q = q * t;
    const f32x2 s = (v * v) * (-0.72134752044f);
    f32x2 e; e.x = __builtin_amdgcn_exp2f(s.x); e.y = __builtin_amdgcn_exp2f(s.y);
    const f32x2 m = v * (q * e), r = v - m;
    f32x2 o; o.x = v.x < 0.f ? m.x : r.x; o.y = v.y < 0.f ? m.y : r.y; return o;
}

template <int ACT  > struct EpiBf16 {
    static constexpr bool PERM = true, AFTER_DRAIN = false; static_assert(ACT == 0 || ACT == 1, "EpiBf16: ACT is 0 (none) or 1 (gelu_pk)");
    bf16_t* O; int ldc; const float* bias; int split_cols; size_t split_stride; float scale0;
    __device__ __forceinline__ void operator()(const f32x4 (&acc)[2][2][4][2], const Unit& u, int wr, int wc, int fr, int fq) const {
        const int row0 = u.pm * BM + wr * 64 + fr; int colt = u.pn * BM; bf16_t* base = O;
        float sc = 1.f; if (split_cols) { const int t = colt / split_cols; base += (size_t)t * split_stride; colt -= t * split_cols; if (t == 0) sc = scale0; }
        const int col0 = colt + wc * 32 + 8 * fq, bcol0 = u.pn * BM + wc * 32 + 8 * fq;
        f32x4 bv[2][2];
#pragma unroll
        for (int bj = 0; bj < 2; ++bj)
#pragma unroll
            for (int n = 0; n < 2; ++n) bv[bj][n] = bias ? *(const f32x4*)(bias + bcol0 + bj * HALF + 4 * n) : (f32x4){0.f, 0.f, 0.f, 0.f};
#pragma unroll
        for (int ai = 0; ai < 2; ++ai)
#pragma unroll
            for (int m = 0; m < 4; ++m) { bf16_t* rowp = base + (size_t)(row0 + ai * HALF + m * 16) * ldc + col0;
#pragma unroll
                for (int bj = 0; bj < 2; ++bj) { f32x4 v0 = acc[ai][bj][m][0] + bv[bj][0], v1 = acc[ai][bj][m][1] + bv[bj][1];
                    if (ACT == 1) { f32x2 a = gelu_pk((f32x2){v0[0], v0[1]}), b = gelu_pk((f32x2){v0[2], v0[3]}), c = gelu_pk((f32x2){v1[0], v1[1]}), d = gelu_pk((f32x2){v1[2], v1[3]});
                        v0 = (f32x4){a.x, a.y, b.x, b.y}; v1 = (f32x4){c.x, c.y, d.x, d.y}; }
                    v0 = v0 * sc; v1 = v1 * sc; u32x4 w; w.x = cvt_pk_bf16(v0[0], v0[1]); w.y = cvt_pk_bf16(v0[2], v0[3]); w.z = cvt_pk_bf16(v1[0], v1[1]); w.w = cvt_pk_bf16(v1[2], v1[3]);
                    *(u32x4*)(rowp + bj * HALF) = w; } }
    }
};

template <class Epi, class Sched, bool ALIGN_EPI = false, bool SP2 = false>
__device__ __forceinline__ void gemm_phase(PG8_LAS unsigned char* lds, const Gemm g, const Sched& S, const Epi& E) {
    int tid_ = threadIdx.x; asm volatile("" : "+v"(tid_));
    const int tid = tid_, wid = __builtin_amdgcn_readfirstlane(tid >> 6), lane = tid & 63, wr = wid >> 2, wc = wid & 3, fr = lane & 15, fq = lane >> 4;
    const int K = g.K, nt = K / BK, LD = g.ld ? g.ld : g.K;
    unsigned voffA[2], voffB[2];
#pragma unroll
    for (int i = 0; i < 2; ++i) { int R, C; stage_rc(tid * 16 + i * 8192, R, C); const int Rb = Epi::PERM ? ((R & ~31) + perm32(R & 31)) : R;
        voffA[i] = (unsigned)(R * LD + C) * 2u; voffB[i] = (unsigned)(Rb * LD + C) * 2u; }
    const size_t kstep = (size_t)(BK * 2);
    const size_t hstep = (size_t)HALF * LD * 2;
    const size_t tstep = 2 * hstep;
    const unsigned ldsw = (unsigned)wid * 1024u;
    const int aoff = lds_byte(wr * 64 + fr, fq * 8), boff = lds_byte(wc * 32 + fr, fq * 8);
#define PG8_SA(b, h) (((b) * 2 + (h)) * HTB)
#define PG8_SB(b, h) ((4 + (b) * 2 + (h)) * HTB)
#define PG8_STAGE(bufoff, gbase, voff) do { _Pragma("unroll") for (int _i = 0; _i < 2; ++_i) \
        __builtin_amdgcn_global_load_lds((const unsigned*)((const char*)(gbase) + (voff)[_i]), (PG8_LAS unsigned*)(lds + (bufoff) + ldsw + _i * 8192), 16, 0, 0); } while (0)
#define PG8_LDA(dst, b, h) do { _Pragma("unroll") for (int m = 0; m < 4; ++m) _Pragma("unroll") for (int k = 0; k < 2; ++k) dst[m][k] = *(const PG8_LAS bf16x8*)(lds + PG8_SA(b, h) + aoff + m * 2048 + k * 1024); } while (0)
#define PG8_LDB(dst, b, h) do { _Pragma("unroll") for (int n = 0; n < 2; ++n) _Pragma("unroll") for (int k = 0; k < 2; ++k) dst[n][k] = *(const PG8_LAS bf16x8*)(lds + PG8_SB(b, h) + boff + n * 2048 + k * 1024); } while (0)
#define PG8_MMA(ai, bj, At, Bt) do { __builtin_amdgcn_s_setprio(1); _Pragma("unroll") for (int m = 0; m < 4; ++m) _Pragma("unroll") for (int n = 0; n < 2; ++n) _Pragma("unroll") for (int k = 0; k < 2; ++k) \
        acc[ai][bj][m][n] = __builtin_amdgcn_mfma_f32_16x16x32_bf16(Bt[n][k], At[m][k], acc[ai][bj][m][n], 0, 0, 0); __builtin_amdgcn_s_setprio(0); } while (0)
#define PG8_WAIT_V(n) asm volatile("s_waitcnt vmcnt(" #n ")" ::: "memory")
#define PG8_WAIT_L(n) asm volatile("s_waitcnt lgkmcnt(" #n ")" ::: "memory")
#define PG8_BAR __builtin_amdgcn_s_barrier()
#define PG8_SCHED __builtin_amdgcn_sched_barrier(0)
    Unit cur, nxt; int ui = 0;
    if (!S.next(0, cur)) return;
    f32x4 acc[2][2][4][2];
#pragma unroll
    for (int a = 0; a < 2; ++a)
#pragma unroll
        for (int b = 0; b < 2; ++b)
#pragma unroll
            for (int m = 0; m < 4; ++m)
#pragma unroll
                for (int n = 0; n < 2; ++n) acc[a][b][m][n] = (f32x4){0.f, 0.f, 0.f, 0.f};
    bf16x8 At[4][2], B0[2][2], B1[2][2];
    const char* cA = (const char*)g.A + (size_t)cur.pm * tstep; const char* cB = (const char*)g.Bt + (size_t)cur.pn * tstep;
    S.a_ready(cur);
    if constexpr (SP2) {
        PG8_STAGE(PG8_SB(0, 0), cB, voffB); PG8_STAGE(PG8_SB(0, 1), cB + hstep, voffB); PG8_STAGE(PG8_SA(0, 0), cA, voffA); PG8_STAGE(PG8_SA(0, 1), cA + hstep, voffA);
        if (wr == 1) PG8_BAR;
        PG8_WAIT_V(2); PG8_BAR;
        PG8_STAGE(PG8_SB(1, 0), cB + kstep, voffB); PG8_STAGE(PG8_SA(1, 0), cA + kstep, voffA); PG8_STAGE(PG8_SB(1, 1), cB + hstep + kstep, voffB);
        PG8_WAIT_V(6); PG8_BAR;
    } else {
        PG8_STAGE(PG8_SB(0, 0), cB, voffB); PG8_STAGE(PG8_SA(0, 0), cA, voffA); PG8_STAGE(PG8_SB(0, 1), cB + hstep, voffB); PG8_STAGE(PG8_SA(0, 1), cA + hstep, voffA);
        if (wr == 1) PG8_BAR;
        PG8_WAIT_V(4); PG8_BAR;
        PG8_STAGE(PG8_SB(1, 0), cB + kstep, voffB); PG8_STAGE(PG8_SA(1, 0), cA + kstep, voffA); PG8_STAGE(PG8_SB(1, 1), cB + hstep + kstep, voffB);
        PG8_WAIT_V(6); PG8_BAR;
    }
    for (;;) {
        const bool has_next = S.next(ui + 1, nxt);
        const char* nA = has_next ? (const char*)g.A + (size_t)nxt.pm * tstep : cA; const char* nB = has_next ? (const char*)g.Bt + (size_t)nxt.pn * tstep : cB;
        for (int t = 0; t < nt; t += 2) {
            const bool last = (t == nt - 2);
            const char* a1 = cA + (size_t)(t + 1) * kstep;
            const char* a2 = last ? nA : cA + (size_t)(t + 2) * kstep; const char* b2 = last ? nB : cB + (size_t)(t + 2) * kstep;
            const char* a3 = a2 + kstep; const char* b3 = b2 + kstep;
            if (last && has_next) S.a_ready(nxt);
            if constexpr (SP2) {
            PG8_LDB(B0, 0, 0); PG8_LDB(B1, 0, 1); PG8_SCHED; PG8_LDA(At, 0, 0); PG8_STAGE(PG8_SA(1, 1), a1 + hstep, voffA);
            PG8_WAIT_V(8); PG8_WAIT_L(0); PG8_BAR; PG8_MMA(0, 0, At, B0); PG8_MMA(0, 1, At, B1); PG8_BAR; PG8_SCHED;
            PG8_LDA(At, 0, 1); PG8_STAGE(PG8_SB(0, 0), b2, voffB); PG8_STAGE(PG8_SB(0, 1), b2 + hstep, voffB); PG8_STAGE(PG8_SA(0, 0), a2, voffA);
            PG8_WAIT_V(8); PG8_WAIT_L(0); PG8_BAR; PG8_MMA(1, 0, At, B0); PG8_MMA(1, 1, At, B1); PG8_BAR; PG8_SCHED;
            PG8_LDB(B0, 1, 0); PG8_LDB(B1, 1, 1); PG8_SCHED; PG8_LDA(At, 1, 0); PG8_STAGE(PG8_SA(0, 1), a2 + hstep, voffA);
            PG8_WAIT_V(8); PG8_WAIT_L(0); PG8_BAR; PG8_MMA(0, 0, At, B0); PG8_MMA(0, 1, At, B1); PG8_BAR; PG8_SCHED;
            PG8_LDA(At, 1, 1); PG8_STAGE(PG8_SB(1, 0), b3, voffB); PG8_STAGE(PG8_SB(1, 1), b3 + hstep, voffB); PG8_STAGE(PG8_SA(1, 0), a3, voffA);
            PG8_WAIT_V(8); PG8_WAIT_L(0); PG8_BAR; PG8_MMA(1, 0, At, B0); PG8_MMA(1, 1, At, B1); PG8_BAR; PG8_SCHED;
            } else {
            PG8_LDB(B0, 0, 0); PG8_SCHED; PG8_LDA(At, 0, 0); PG8_STAGE(PG8_SA(1, 1), a1 + hstep, voffA);
            PG8_WAIT_L(8); PG8_BAR; PG8_WAIT_L(0); PG8_MMA(0, 0, At, B0); PG8_BAR; PG8_SCHED;
            PG8_LDB(B1, 0, 1); PG8_STAGE(PG8_SB(0, 0), b2, voffB);
            PG8_BAR; PG8_WAIT_L(0); PG8_MMA(0, 1, At, B1); PG8_BAR;
            PG8_LDA(At, 0, 1); PG8_STAGE(PG8_SA(0, 0), a2, voffA);
            PG8_BAR; PG8_WAIT_L(0); PG8_MMA(1, 0, At, B0); PG8_BAR; PG8_SCHED;
            PG8_STAGE(PG8_SB(0, 1), b2 + hstep, voffB);
            PG8_WAIT_V(6); PG8_BAR; PG8_MMA(1, 1, At, B1); PG8_BAR;
            PG8_LDB(B0, 1, 0); PG8_SCHED; PG8_LDA(At, 1, 0); PG8_STAGE(PG8_SA(0, 1), a2 + hstep, voffA);
            PG8_WAIT_L(8); PG8_BAR; PG8_WAIT_L(0); PG8_MMA(0, 0, At, B0); PG8_BAR; PG8_SCHED;
            PG8_LDB(B1, 1, 1); PG8_STAGE(PG8_SB(1, 0), b3, voffB);
            PG8_BAR; PG8_WAIT_L(0); PG8_MMA(0, 1, At, B1); PG8_BAR;
            PG8_LDA(At, 1, 1); PG8_STAGE(PG8_SA(1, 0), a3, voffA);
            PG8_BAR; PG8_WAIT_L(0); PG8_MMA(1, 0, At, B0); PG8_BAR; PG8_SCHED;
            PG8_STAGE(PG8_SB(1, 1), b3 + hstep, voffB);
            PG8_WAIT_V(6); PG8_BAR; PG8_MMA(1, 1, At, B1); PG8_BAR;
            }
        }
        if constexpr (ALIGN_EPI) { if (wr == 0) PG8_BAR; }
        if constexpr (!Epi::AFTER_DRAIN) { E(acc, cur, wr, wc, fr, fq); S.done(cur); }
        if (!has_next) break;
#pragma unroll
        for (int a = 0; a < 2; ++a)
#pragma unroll
            for (int b = 0; b < 2; ++b)
#pragma unroll
                for (int m = 0; m < 4; ++m)
#pragma unroll
                    for (int n = 0; n < 2; ++n) acc[a][b][m][n] = (f32x4){0.f, 0.f, 0.f, 0.f};
        cur = nxt; cA = nA; cB = nB; ++ui;
        if constexpr (ALIGN_EPI) { if (wr == 1) PG8_BAR; }
    }
    PG8_WAIT_V(0);
    if constexpr (!ALIGN_EPI) { if (wr == 0) PG8_BAR; }
    PG8_BAR;
    if constexpr (Epi::AFTER_DRAIN) { E.fused(acc, cur, wr, wc, fr, fq, lds, wid, lane); S.done(cur); }
#undef PG8_SA
#undef PG8_SB
#undef PG8_STAGE
#undef PG8_LDA
#undef PG8_LDB
#undef PG8_MMA
#undef PG8_WAIT_V
#undef PG8_WAIT_L
#undef PG8_BAR
#undef PG8_SCHED
}
}

#define GAS __attribute__((address_space(1)))
#define LAS __attribute__((address_space(3)))
typedef unsigned short bf16;
typedef unsigned u32x4 __attribute__((ext_vector_type(4)));
typedef unsigned u32x2 __attribute__((ext_vector_type(2)));
typedef float f32x4 __attribute__((ext_vector_type(4)));
typedef float f32x2 __attribute__((ext_vector_type(2)));
typedef short bf16x8_t __attribute__((ext_vector_type(8)));

constexpr int NBATCH = 4, SEQ = 2048, TOK = NBATCH * SEQ, DM = 2048, DEPTH = 4;
constexpr int NIN = 16592, NINP = 16640;
constexpr int C_GQKV = 0, C_GZ = 3072, C_GB = 4096, C_GA = 4104, C_RF = 4112, C_RZ = 7376, C_SU = 8400, C_SZ = 9424, C_GATE = 10448;
constexpr int NWAVES = 8, NTHREADS = 512;
constexpr int LDS_BYTES = 147456;
constexpr int PH_PER_LAYER = 6, NPHASES = 2 + DEPTH * PH_PER_LAYER;

constexpr size_t MiB = 1u << 20;
constexpr size_t WS_WIN = 0, WS_WGLU = 260 * MiB, WS_WBR = 268 * MiB, WS_WOUT = 316 * MiB, WS_XN = 348 * MiB, WS_PROJ = 380 * MiB;
constexpr size_t WS_GQ = 640 * MiB, WS_GK = 672 * MiB, WS_GV = 704 * MiB, WS_GEG = 736 * MiB, WS_GBE = 737 * MiB, WS_GSC = 737 * MiB + 512 * 1024, WS_GO = 738 * MiB;
constexpr size_t WS_RR = 770 * MiB, WS_RW = 802 * MiB, WS_RK = 834 * MiB, WS_RV = 866 * MiB, WS_RKK = 898 * MiB, WS_RKA = 930 * MiB, WS_RBON = 962 * MiB, WS_RY = 963 * MiB;
constexpr size_t WS_SY = 995 * MiB, WS_OBR = 1011 * MiB, WS_ACCF = 1059 * MiB, WS_MRG = 1123 * MiB, WS_CTL = 1155 * MiB, WS_LORA = 1156 * MiB, WS_END = 1158 * MiB;
constexpr size_t CTL_SS = 65536, CTL_ZERO_BYTES = CTL_SS + (size_t)DEPTH * TOK * 8;
constexpr int MISC_OFF = 147392;
static_assert((size_t)DEPTH * NINP * DM * 2 == 260 * MiB && (size_t)TOK * NINP * 2 == 260 * MiB, "ws map");

__device__ __forceinline__ unsigned f2bf(float f) { unsigned u = __builtin_bit_cast(unsigned, f); return (u + 0x7fffu + ((u >> 16) & 1u)) >> 16; }
__device__ __forceinline__ unsigned pk2(float lo, float hi) { unsigned r; asm("v_cvt_pk_bf16_f32 %0, %1, %2" : "=v"(r) : "v"(lo), "v"(hi)); return r; }
__device__ __forceinline__ float bflo(unsigned w) { return __builtin_bit_cast(float, w << 16); }
__device__ __forceinline__ float bfhi(unsigned w) { return __builtin_bit_cast(float, w & 0xffff0000u); }
__device__ __forceinline__ float bf1(bf16 h) { return __builtin_bit_cast(float, (unsigned)h << 16); }
__device__ __forceinline__ float sigmoidf_(float x) { return __builtin_amdgcn_rcpf(1.f + __expf(-x)); }
__device__ __forceinline__ float siluf_(float x) { return x * __builtin_amdgcn_rcpf(1.f + __expf(-x)); }
__device__ __forceinline__ float softplusf_(float x) { return x > 20.f ? x : log1pf(expf(x)); }
__device__ __forceinline__ float gelu_tanh(float y) { const float t = 0.7978845608028654f * (y + 0.044715f * y * y * y); const float th = 1.f - 2.f * __builtin_amdgcn_rcpf(1.f + __expf(2.f * t)); return 0.5f * y * (1.f + th); }
template <int CTRL> __device__ __forceinline__ float dppf(float v) { return __builtin_bit_cast(float, __builtin_amdgcn_update_dpp(0, __builtin_bit_cast(int, v), CTRL, 0xF, 0xF, true)); }
__device__ __forceinline__ float allred8(float v) { v += dppf<0xB1>(v); v += dppf<0x4E>(v); v += dppf<0x141>(v); return v; }
__device__ __forceinline__ float allred16(float v) { v = allred8(v); v += dppf<0x140>(v); return v; }
__device__ __forceinline__ float wave_sum(float v) {
#pragma unroll
    for (int o = 1; o < 64; o <<= 1) v += __shfl_xor(v, o);
    return v;
}
__device__ __forceinline__ void unpack8(const u32x4 w, float (&f)[8]) { f[0] = bflo(w.x); f[1] = bfhi(w.x); f[2] = bflo(w.y); f[3] = bfhi(w.y); f[4] = bflo(w.z); f[5] = bfhi(w.z); f[6] = bflo(w.w); f[7] = bfhi(w.w); }
__device__ __forceinline__ u32x4 pack8(const float (&f)[8]) { u32x4 w; w.x = pk2(f[0], f[1]); w.y = pk2(f[2], f[3]); w.z = pk2(f[4], f[5]); w.w = pk2(f[6], f[7]); return w; }

namespace pg8 {
struct EpiGlu {
    static constexpr bool PERM = true, AFTER_DRAIN = false;
    const bf16* Y1; const bf16* PROJ; const float* bias; bf16* O;
    __device__ __forceinline__ void operator()(const f32x4 (&acc)[2][2][4][2], const Unit& u, int wr, int wc, int fr, int fq) const {
        int row0 = u.pm * BM + wr * 64 + fr, col0 = u.pn * BM + wc * 32 + 8 * fq;
        asm volatile("" : "+v"(row0), "+v"(col0));
        f32x4 bb[2][2];
#pragma unroll
        for (int bj = 0; bj < 2; ++bj) { bb[bj][0] = *(const f32x4*)(bias + col0 + bj * HALF); bb[bj][1] = *(const f32x4*)(bias + col0 + bj * HALF + 4); }
        u32x4 yc = *(const u32x4*)(Y1 + (size_t)row0 * 1024 + col0), zc = *(const u32x4*)(PROJ + (size_t)row0 * NINP + C_SZ + col0);
#pragma unroll
        for (int it = 0; it < 16; ++it) {
            const int bj = it >> 3, ai = (it >> 2) & 1, m = it & 3;
            const size_t row = (size_t)(row0 + ai * HALF + m * 16); const int col = col0 + bj * HALF;
            u32x4 yn = yc, zn = zc;
            if (it + 1 < 16) { const int nb = (it + 1) >> 3, na = ((it + 1) >> 2) & 1, nm = (it + 1) & 3; const size_t nrow = (size_t)(row0 + na * HALF + nm * 16); const int ncol = col0 + nb * HALF;
                yn = *(const u32x4*)(Y1 + nrow * 1024 + ncol); zn = *(const u32x4*)(PROJ + nrow * NINP + C_SZ + ncol); }
            float y[8], z[8], o[8]; unpack8(yc, y); unpack8(zc, z);
            const f32x4 v0 = acc[ai][bj][m][0] + bb[bj][0], v1 = acc[ai][bj][m][1] + bb[bj][1];
            const float a[8] = {v0[0], v0[1], v0[2], v0[3], v1[0], v1[1], v1[2], v1[3]};
#pragma unroll
            for (int e = 0; e < 8; ++e) o[e] = y[e] * sigmoidf_(a[e]) * siluf_(z[e]);
            *(u32x4*)(O + row * 1024 + col) = pack8(o);
            yc = yn; zc = zn;
            asm volatile("" ::: "memory");
        }
    }
};
struct EpiBranch {
    static constexpr bool PERM = true, AFTER_DRAIN = false;
    const bf16* PROJ; const float* gate_b; bf16* ACC; bf16* MRG;
    __device__ __forceinline__ void operator()(const f32x4 (&acc)[2][2][4][2], const Unit& u, int wr, int wc, int fr, int fq) const {
        const int br = u.pm >> 5, pm = u.pm & 31, pn = u.pn & 7;
        int row0 = pm * BM + wr * 64 + fr, col0 = pn * BM + wc * 32 + 8 * fq;
        asm volatile("" : "+v"(row0), "+v"(col0));
        bf16* dst = br < 2 ? ACC : MRG;
        const bf16* gl = PROJ + C_GATE + br * DM;
        f32x4 gb[2][2];
#pragma unroll
        for (int bj = 0; bj < 2; ++bj) { gb[bj][0] = *(const f32x4*)(gate_b + br * DM + col0 + bj * HALF); gb[bj][1] = *(const f32x4*)(gate_b + br * DM + col0 + bj * HALF + 4); }
        const u32x4 zero = {0u, 0u, 0u, 0u};
        u32x4 lc = *(const u32x4*)(gl + (size_t)row0 * NINP + col0), pc = br > 0 ? *(const u32x4*)(ACC + (size_t)row0 * DM + col0) : zero;
#pragma unroll
        for (int it = 0; it < 16; ++it) {
            const int bj = it >> 3, ai = (it >> 2) & 1, m = it & 3;
            const size_t row = (size_t)(row0 + ai * HALF + m * 16); const int col = col0 + bj * HALF;
            u32x4 ln = lc, pn_ = pc;
            if (it + 1 < 16) { const int nb = (it + 1) >> 3, na = ((it + 1) >> 2) & 1, nm = (it + 1) & 3; const size_t nrow = (size_t)(row0 + na * HALF + nm * 16); const int ncol = col0 + nb * HALF;
                ln = *(const u32x4*)(gl + nrow * NINP + ncol); pn_ = br > 0 ? *(const u32x4*)(ACC + nrow * DM + ncol) : zero; }
            float g[8], p[8], o[8]; unpack8(lc, g); unpack8(pc, p);
            const f32x4 v0 = acc[ai][bj][m][0], v1 = acc[ai][bj][m][1];
            const float a[8] = {v0[0], v0[1], v0[2], v0[3], v1[0], v1[1], v1[2], v1[3]};
            const float gbv[8] = {gb[bj][0][0], gb[bj][0][1], gb[bj][0][2], gb[bj][0][3], gb[bj][1][0], gb[bj][1][1], gb[bj][1][2], gb[bj][1][3]};
#pragma unroll
            for (int e = 0; e < 8; ++e) o[e] = sigmoidf_(g[e] + gbv[e]) * a[e] + p[e];
            *(u32x4*)(dst + row * DM + col) = pack8(o);
            lc = ln; pc = pn_;
            asm volatile("" ::: "memory");
        }
    }
};
struct EpiResid {
    static constexpr bool PERM = true, AFTER_DRAIN = false;
    const float* base; float* out; bf16* xn; const float* nw; unsigned long long* ss;
    __device__ __forceinline__ void operator()(const f32x4 (&acc)[2][2][4][2], const Unit& u, int wr, int wc, int fr, int fq) const {
        int row0 = u.pm * BM + wr * 64 + fr, col0 = u.pn * BM + wc * 32 + 8 * fq;
        asm volatile("" : "+v"(row0), "+v"(col0));
        f32x4 ww[2][2];
#pragma unroll
        for (int bj = 0; bj < 2; ++bj) { ww[bj][0] = *(const f32x4*)(nw + col0 + bj * HALF); ww[bj][1] = *(const f32x4*)(nw + col0 + bj * HALF + 4); }
        f32x4 bc[2][2];
#pragma unroll
        for (int bj = 0; bj < 2; ++bj) { const size_t off = (size_t)row0 * DM + col0 + bj * HALF; bc[bj][0] = *(const f32x4*)(base + off); bc[bj][1] = *(const f32x4*)(base + off + 4); }
#pragma unroll
        for (int it = 0; it < 8; ++it) {
            const int ai = it >> 2, m = it & 3; const int row = row0 + ai * HALF + m * 16;
            f32x4 bn[2][2];
#pragma unroll
            for (int bj = 0; bj < 2; ++bj) { bn[bj][0] = bc[bj][0]; bn[bj][1] = bc[bj][1]; }
            if (it + 1 < 8) { const int nrow = row0 + ((it + 1) >> 2) * HALF + ((it + 1) & 3) * 16;
#pragma unroll
                for (int bj = 0; bj < 2; ++bj) { const size_t off = (size_t)nrow * DM + col0 + bj * HALF; bn[bj][0] = *(const f32x4*)(base + off); bn[bj][1] = *(const f32x4*)(base + off + 4); } }
            float sq = 0.f;
#pragma unroll
            for (int bj = 0; bj < 2; ++bj) {
                const size_t off = (size_t)row * DM + col0 + bj * HALF;
                const f32x4 o0 = bc[bj][0] + acc[ai][bj][m][0], o1 = bc[bj][1] + acc[ai][bj][m][1];
                *(f32x4*)(out + off) = o0; *(f32x4*)(out + off + 4) = o1;
                if (xn) { const f32x4 w0 = ww[bj][0], w1 = ww[bj][1];
                    sq += (o0.x * o0.x + o0.y * o0.y) + (o0.z * o0.z + o0.w * o0.w) + (o1.x * o1.x + o1.y * o1.y) + (o1.z * o1.z + o1.w * o1.w);
                    u32x4 p; p.x = pk2(o0.x * w0.x, o0.y * w0.y); p.y = pk2(o0.z * w0.z, o0.w * w0.w); p.z = pk2(o1.x * w1.x, o1.y * w1.y); p.w = pk2(o1.z * w1.z, o1.w * w1.w);
                    *(u32x4*)(xn + off) = p; }
            }
            if (xn) { sq += __shfl_xor(sq, 16); sq += __shfl_xor(sq, 32); if (fq == 0) atomicAdd(ss + row, (unsigned long long)(sq * 65536.f + 0.5f)); }
#pragma unroll
            for (int bj = 0; bj < 2; ++bj) { bc[bj][0] = bn[bj][0]; bc[bj][1] = bn[bj][1]; }
            asm volatile("" ::: "memory");
        }
    }
};
struct EpiBf16Rs {
    static constexpr bool PERM = true, AFTER_DRAIN = false;
    bf16* O; int ldc; const unsigned long long* ss;
    __device__ __forceinline__ void operator()(const f32x4 (&acc)[2][2][4][2], const Unit& u, int wr, int wc, int fr, int fq) const {
        int row0 = u.pm * BM + wr * 64 + fr, col0 = u.pn * BM + wc * 32 + 8 * fq;
        asm volatile("" : "+v"(row0), "+v"(col0));
#pragma unroll
        for (int ai = 0; ai < 2; ++ai)
#pragma unroll
            for (int m = 0; m < 4; ++m) { const int row = row0 + ai * HALF + m * 16; const float rs = 1.f / sqrtf((float)ss[row] * (1.f / (65536.f * DM)) + 1e-6f);
                bf16* rowp = O + (size_t)row * ldc + col0;
#pragma unroll
                for (int bj = 0; bj < 2; ++bj) { const f32x4 v0 = acc[ai][bj][m][0] * rs, v1 = acc[ai][bj][m][1] * rs;
                    u32x4 w; w.x = cvt_pk_bf16(v0[0], v0[1]); w.y = cvt_pk_bf16(v0[2], v0[3]); w.z = cvt_pk_bf16(v1[0], v1[1]); w.w = cvt_pk_bf16(v1[2], v1[3]);
                    *(u32x4*)(rowp + bj * HALF) = w; } }
    }
};
struct BranchOrder {
    StaticOrder base;
    __device__ bool next(int i, Unit& u) const { Unit t; const int r = i / 3, br = i - 3 * r; if (!base.next(r, t)) return false; u.pm = br * 32 + t.pm; u.pn = br * 8 + t.pn; return true; }
    __device__ __forceinline__ void a_ready(const Unit&) const {}
    __device__ __forceinline__ void done(const Unit&) const {}
};
}

#define XB_TMO      128
#define XB_XCNT(j)  (256  + 64 * (j))
#define XB_XSUB(j)  (1280 + 64 * (j))
#define XB_XGEN(j)  (2304 + 64 * (j))
#define XB_TOP      3328
#define XB_TOPGEN   3392
#define XCD_BAR_WORDS 3456
#define XB_SPIN_CAP (1u << 18)

__device__ __forceinline__ unsigned xb_ld(unsigned* p)              { return __hip_atomic_load(p, __ATOMIC_RELAXED, __HIP_MEMORY_SCOPE_AGENT); }
__device__ __forceinline__ unsigned xb_add(unsigned* p, unsigned v) { return __hip_atomic_fetch_add(p, v, __ATOMIC_RELAXED, __HIP_MEMORY_SCOPE_AGENT); }
__device__ __forceinline__ unsigned xb_xcc_id() { return (unsigned)__builtin_amdgcn_s_getreg((3 << 11) | 20) & 0xFu; }
#define XB_SPIN(cond, bar) do { unsigned _sp = 0; while (cond) { __builtin_amdgcn_s_sleep(1); \
    if ((++_sp & 255u) == 0u) { if (xb_ld(&(bar)[XB_TMO])) break; if (_sp > XB_SPIN_CAP) { atomicAdd(&(bar)[XB_TMO], 1u); break; } } } } while (0)

struct XcdBarrier {
    unsigned* bar; unsigned x;
    volatile LAS unsigned* st;
};

__device__ __forceinline__ XcdBarrier xcd_barrier_post(unsigned* bar, volatile LAS unsigned* st) {
    XcdBarrier b; b.bar = bar; b.x = xb_xcc_id(); b.st = st;
    if (threadIdx.x == 0) (void)xb_add(&bar[XB_XCNT(b.x)], 1u);
    return b;
}
__device__ __forceinline__ void xcd_barrier_complete(unsigned* bar, unsigned x, unsigned& nloc, unsigned& nx) {
    const unsigned G = gridDim.x * gridDim.y * gridDim.z;
    unsigned sum, cnt, mine, sp = 0u;
    for (;;) {
        sum = 0u; cnt = 0u; mine = 0u;
#pragma unroll
        for (unsigned j = 0; j < 16; ++j) { const unsigned c = xb_ld(&bar[XB_XCNT(j)]); sum += c; cnt += (c > 0u) ? 1u : 0u; mine = (j == x) ? c : mine; }
        if (sum == G) break;
        __builtin_amdgcn_s_sleep(1);
        if ((++sp & 255u) == 0u) { if (xb_ld(&bar[XB_TMO])) break; if (sp > XB_SPIN_CAP) { atomicAdd(&bar[XB_TMO], 1u); break; } }
    }
    nloc = mine > 0u ? mine : 1u; nx = cnt > 0u ? cnt : 1u;
}

__device__ __forceinline__ void xcd_barrier(const XcdBarrier& b) {
    asm volatile("s_waitcnt vmcnt(0)" ::: "memory");
    __syncthreads();
    if (threadIdx.x == 0) {
        unsigned* bar = b.bar;
        __builtin_amdgcn_s_waitcnt(0);
        unsigned nloc = b.st[0], nx = b.st[1];
        if (nloc == 0u) { xcd_barrier_complete(bar, b.x, nloc, nx); b.st[0] = nloc; b.st[1] = nx; }
        const unsigned old = xb_add(&bar[XB_XSUB(b.x)], 1u);
        const unsigned gen = old / nloc;
        if (old + 1u == (gen + 1u) * nloc) {
            __builtin_amdgcn_fence(__ATOMIC_RELEASE, "agent");
            asm volatile("s_waitcnt vmcnt(0)" ::: "memory");
            const unsigned og = xb_add(&bar[XB_TOP], 1u);
            const unsigned tg = og / nx;
            if (og + 1u == (tg + 1u) * nx) xb_add(&bar[XB_TOPGEN], 1u);
            else XB_SPIN(xb_ld(&bar[XB_TOPGEN]) == tg, bar);
            __builtin_amdgcn_fence(__ATOMIC_ACQUIRE, "agent");
            xb_add(&bar[XB_XGEN(b.x)], 1u);
            asm volatile("s_waitcnt vmcnt(0)" ::: "memory");
        } else {
            XB_SPIN(xb_ld(&bar[XB_XGEN(b.x)]) == gen, bar);
            __builtin_amdgcn_fence(__ATOMIC_ACQUIRE, "agent");
            asm volatile("s_waitcnt vmcnt(0)" ::: "memory");
        }
    }
    __syncthreads();
}

struct Args { const float* in[31]; float* out; unsigned char* ws; int ph_lo, ph_hi; };
struct Ctx { int tid, lane, wave, vcu, G, gw, NGW; LAS unsigned char* lds; unsigned char* ws; };

__device__ __forceinline__ void transpose_item(const float* W, int K, int N, bf16* WT, LAS float* scr, int kb, int nb, int lane) {
    const int k0 = 64 * kb, n0 = 64 * nb, nq = 4 * (lane & 15), kr = lane >> 4; const bool nv = n0 + nq < N;
    f32x4 v[16];
#pragma unroll
    for (int i = 0; i < 16; ++i) v[i] = nv ? *(const f32x4*)(W + (size_t)(k0 + 4 * i + kr) * N + n0 + nq) : (f32x4){0.f, 0.f, 0.f, 0.f};
#pragma unroll
    for (int i = 0; i < 16; ++i) { LAS float* d = scr + (4 * i + kr) * 65 + nq; d[0] = v[i].x; d[1] = v[i].y; d[2] = v[i].z; d[3] = v[i].w; }
    asm volatile("s_waitcnt lgkmcnt(0)" ::: "memory");
    const int c = lane & 7;
#pragma unroll
    for (int j = 0; j < 8; ++j) { const int nn = (lane >> 3) + 8 * j; const LAS float* s = scr + (8 * c) * 65 + nn;
        u32x4 o; o.x = pk2(s[0 * 65], s[1 * 65]); o.y = pk2(s[2 * 65], s[3 * 65]); o.z = pk2(s[4 * 65], s[5 * 65]); o.w = pk2(s[6 * 65], s[7 * 65]);
        *(u32x4*)(WT + (size_t)(n0 + nn) * K + k0 + 8 * c) = o; }
    asm volatile("s_waitcnt lgkmcnt(0)" ::: "memory");
}

__device__ __forceinline__ void rms_row(const float* xrow, const float* w, bf16* obf, unsigned long long* ss, float* of32, int lane) {
    f32x4 v[8]; float s = 0.f;
#pragma unroll
    for (int j = 0; j < 8; ++j) { v[j] = *(const f32x4*)(xrow + 4 * lane + 256 * j); s += (v[j].x * v[j].x + v[j].y * v[j].y) + (v[j].z * v[j].z + v[j].w * v[j].w); }
    s = wave_sum(s);
    const float r = obf ? 1.f : 1.f / sqrtf(s * (1.f / DM) + 1e-6f);
#pragma unroll
    for (int j = 0; j < 8; ++j) { const f32x4 ww = *(const f32x4*)(w + 4 * lane + 256 * j); const f32x4 o = v[j] * r * ww;
        if (obf) { u32x2 p; p.x = pk2(o.x, o.y); p.y = pk2(o.z, o.w); *(u32x2*)(obf + 4 * lane + 256 * j) = p; }
        else *(f32x4*)(of32 + 4 * lane + 256 * j) = o; }
    if (obf && lane == 0) *ss = (unsigned long long)(s * 65536.f + 0.5f);
}

constexpr int CV_ALL = 32 * 260 + 16 * 16 + 3 * 16 * 32 + 32 * 32, CV_DED = 9600;
__device__ __forceinline__ void convert_layer(const Ctx& F, const Args& a, int l, int gw, int ngw, int lo = 0, int hi = CV_ALL) {
    LAS float* scr = (LAS float*)(F.lds + F.wave * 16640);
    constexpr int I_IN = 32 * 260, I_GLU = 16 * 16, I_BR = 16 * 32, I_OUT = 32 * 32, IL = I_IN + I_GLU + 3 * I_BR + I_OUT;
    bf16* WIN = (bf16*)(F.ws + WS_WIN); bf16* WGLU = (bf16*)(F.ws + WS_WGLU); bf16* WBR = (bf16*)(F.ws + WS_WBR); bf16* WOUT = (bf16*)(F.ws + WS_WOUT);
    for (int it = lo + gw; it < hi; it += ngw) {
        int r = it;
        if (r < I_IN) { transpose_item(a.in[2] + (size_t)l * DM * NIN, DM, NIN, WIN + (size_t)l * NINP * DM, scr, r / 260, r % 260, F.lane); continue; } r -= I_IN;
        if (r < I_GLU) { transpose_item(a.in[25] + (size_t)l * 1024 * 1024, 1024, 1024, WGLU + (size_t)l * 1024 * 1024, scr, r / 16, r % 16, F.lane); continue; } r -= I_GLU;
        if (r < 3 * I_BR) { const int br = r / I_BR, r2 = r - br * I_BR;
            transpose_item(a.in[28] + (size_t)(l * 3 + br) * 1024 * DM, 1024, DM, WBR + (size_t)(l * 3 + br) * DM * 1024, scr, r2 / 32, r2 % 32, F.lane); continue; } r -= 3 * I_BR;
        transpose_item(a.in[29] + (size_t)l * DM * DM, DM, DM, WOUT + (size_t)l * DM * DM, scr, r / 32, r % 32, F.lane);
    }
}

__device__ __forceinline__ void phase0(const Ctx& F, const Args& a) {
    convert_layer(F, a, 0, F.gw, F.NGW);
    {
        bf16* LT = (bf16*)(F.ws + WS_LORA);
        for (int it = F.gw * 64 + F.lane; it < DEPTH * 2 * 1024 * 12; it += F.NGW * 64) {
            const int kg = it % 12, n = (it / 12) & 1023, lw = it / (12 * 1024), l = lw >> 1, which = lw & 1;
            const float* src = (which ? a.in[11] : a.in[9]) + (size_t)l * 96 * 1024 + (size_t)(8 * kg) * 1024 + n;
            u32x4 o; o.x = pk2(src[0], src[1024]); o.y = pk2(src[2048], src[3072]); o.z = pk2(src[4096], src[5120]); o.w = pk2(src[6144], src[7168]);
            *(u32x4*)(LT + ((size_t)lw * 1024 + n) * 96 + 8 * kg) = o;
        }
    }
    bf16* XN = (bf16*)(F.ws + WS_XN);
    unsigned long long* SS0 = (unsigned long long*)(F.ws + WS_CTL + CTL_SS);
    for (int m = F.gw; m < TOK; m += F.NGW) rms_row(a.in[0] + (size_t)m * DM, a.in[1], XN + (size_t)m * DM, SS0 + m, nullptr, F.lane);
}

__device__ __forceinline__ void prep_gdn(const Ctx& F, const Args& a, int l) {
    const bf16* PROJ = (const bf16*)(F.ws + WS_PROJ);
    float* GQ = (float*)(F.ws + WS_GQ); float* GK = (float*)(F.ws + WS_GK); float* GV = (float*)(F.ws + WS_GV); float* GEG = (float*)(F.ws + WS_GEG); float* GBE = (float*)(F.ws + WS_GBE); f32x4* GSC = (f32x4*)(F.ws + WS_GSC);
    const float* cw = a.in[3] + (size_t)l * 4 * 3072;
    for (int it = F.gw; it < 2048; it += F.NGW) {
        const int h = it & 7, ch = (it >> 3) & 63, b = it >> 9;
        const int t0 = ch * 32; const int c = 2 * F.lane;
        float w[3][4][2], hist[3][3][2];
#pragma unroll
        for (int p = 0; p < 3; ++p)
#pragma unroll
            for (int j = 0; j < 4; ++j) { const f32x2 ww = *(const f32x2*)(cw + j * 3072 + p * 1024 + h * 128 + c); w[p][j][0] = ww.x; w[p][j][1] = ww.y; }
#pragma unroll
        for (int p = 0; p < 3; ++p)
#pragma unroll
            for (int j = 0; j < 3; ++j) { const int t = t0 - 3 + j; unsigned x = 0u;
                if (t >= 0) x = *(const unsigned*)(PROJ + (size_t)(b * SEQ + t) * NINP + C_GQKV + p * 1024 + h * 128 + c);
                hist[p][j][0] = bflo(x); hist[p][j][1] = bfhi(x); }
        const float alog = a.in[4][l * 8 + h], dtb = a.in[5][l * 8 + h]; const float aexp = expf(alog);
        float kp0 = 0.f, kp1 = 0.f, qkprev = 0.f;
        unsigned raw[3][32];
#pragma unroll
        for (int tt = 0; tt < 32; ++tt)
#pragma unroll
            for (int p = 0; p < 3; ++p) raw[p][tt] = *(const unsigned*)(PROJ + (size_t)(b * SEQ + t0 + tt) * NINP + C_GQKV + p * 1024 + h * 128 + c);
#pragma unroll
        for (int tt = 0; tt < 32; ++tt) {
            const size_t tok = (size_t)(b * SEQ + t0 + tt);
            float o[3][2];
#pragma unroll
            for (int p = 0; p < 3; ++p) {
                const unsigned x = raw[p][tt];
                const float x0 = bflo(x), x1 = bfhi(x);
                const float y0 = w[p][0][0] * hist[p][0][0] + w[p][1][0] * hist[p][1][0] + w[p][2][0] * hist[p][2][0] + w[p][3][0] * x0;
                const float y1 = w[p][0][1] * hist[p][0][1] + w[p][1][1] * hist[p][1][1] + w[p][2][1] * hist[p][2][1] + w[p][3][1] * x1;
                hist[p][0][0] = hist[p][1][0]; hist[p][1][0] = hist[p][2][0]; hist[p][2][0] = x0;
                hist[p][0][1] = hist[p][1][1]; hist[p][1][1] = hist[p][2][1]; hist[p][2][1] = x1;
                o[p][0] = siluf_(y0); o[p][1] = siluf_(y1);
            }
            const float sq = wave_sum(o[0][0] * o[0][0] + o[0][1] * o[0][1]), sk = wave_sum(o[1][0] * o[1][0] + o[1][1] * o[1][1]);
            const float rq = 0.08838834764831845f * rsqrtf(sq + 1e-6f), rk = rsqrtf(sk + 1e-6f);
            const size_t off = tok * 1024 + h * 128 + c;
            const unsigned qp = pk2(o[0][0] * rq, o[0][1] * rq), kp = pk2(o[1][0] * rk, o[1][1] * rk);
            *(unsigned*)((bf16*)GQ + off) = qp;
            *(unsigned*)((bf16*)GK + off) = kp;
            *(unsigned*)((bf16*)GV + off) = pk2(o[2][0], o[2][1]);
            {
                const float qn0 = bflo(qp), qn1 = bfhi(qp), kn0 = bflo(kp), kn1 = bfhi(kp);
                const float qk = wave_sum(qn0 * kn0 + qn1 * kn1);
                if (tt & 1) { const float kk = wave_sum(kp0 * kn0 + kp1 * kn1), qkp = wave_sum(qn0 * kp0 + qn1 * kp1);
                    if (F.lane == 0) GSC[(tok >> 1) * 8 + h] = (f32x4){kk, qkprev, qkp, qk}; }
                else { kp0 = kn0; kp1 = kn1; qkprev = qk; }
            }
            if (F.lane == 0) {
                const float bl = bf1(PROJ[tok * NINP + C_GB + h]), al = bf1(PROJ[tok * NINP + C_GA + h]);
                GBE[tok * 8 + h] = sigmoidf_(bl);
                GEG[tok * 8 + h] = expf(-aexp * softplusf_(al + dtb));
            }
        }
    }
}

__device__ __forceinline__ float mix2(unsigned c, unsigned p, float mu0, float mu1, float& o1) {
    const float c0 = bflo(c), c1 = bfhi(c), p0 = bflo(p), p1 = bfhi(p);
    o1 = c1 + (p1 - c1) * mu1; return c0 + (p0 - c0) * mu0;
}
__device__ __forceinline__ void prep_rwkv(const Ctx& F, const Args& a, int l) {
    const bf16* PROJ = (const bf16*)(F.ws + WS_PROJ);
    float* RR = (float*)(F.ws + WS_RR); float* RW = (float*)(F.ws + WS_RW); float* RK = (float*)(F.ws + WS_RK); float* RV = (float*)(F.ws + WS_RV);
    float* RKK = (float*)(F.ws + WS_RKK); float* RKA = (float*)(F.ws + WS_RKA); float* RBON = (float*)(F.ws + WS_RBON);
    const float* mu = a.in[7] + (size_t)l * 3264; const float* w0 = a.in[8] + l * 1024; const float* wup = a.in[9] + (size_t)l * 96 * 1024;
    const float* a0 = a.in[10] + l * 1024; const float* aup = a.in[11] + (size_t)l * 96 * 1024; const float* kk_ = a.in[12] + l * 1024; const float* ka_ = a.in[13] + l * 1024; const float* rk_ = a.in[14] + l * 1024;
    constexpr int AROW = 104;
    LAS bf16* A1 = (LAS bf16*)F.lds; LAS bf16* A2 = A1 + 16 * AROW;
    LAS float* LW = (LAS float*)(F.lds + 8192); LAS float* LA = LW + 16 * 1024;
    const bf16* LTw = (const bf16*)(F.ws + WS_LORA) + (size_t)(2 * l) * 1024 * 96; const bf16* LTa = LTw + 1024 * 96;
    const int j = F.tid, c = 2 * j;
    const f32x2 mur = *(const f32x2*)(mu + c), muk = *(const f32x2*)(mu + 1024 + c), muv = *(const f32x2*)(mu + 2048 + c);
    const f32x2 w0v = *(const f32x2*)(w0 + c), a0v = *(const f32x2*)(a0 + c), kkv = *(const f32x2*)(kk_ + c), kav = *(const f32x2*)(ka_ + c), rkv = *(const f32x2*)(rk_ + c);
    for (int tile = F.vcu; tile < TOK / 16; tile += F.G) {
        __syncthreads();
        for (int e = F.tid; e < 16 * 192; e += NTHREADS) {
            const int tl = e / 192, i = e - tl * 192; const size_t tok = (size_t)tile * 16 + tl;
            const float cur = bf1(PROJ[tok * NINP + C_RF + 3072 + i]);
            const float prv = (tok & (SEQ - 1)) ? bf1(PROJ[(tok - 1) * NINP + C_RF + 3072 + i]) : 0.f;
            const float m = cur + (prv - cur) * mu[3072 + i];
            if (i < 96) A1[tl * AROW + i] = (bf16)f2bf(tanhf(m)); else A2[tl * AROW + i - 96] = (bf16)f2bf(m);
        }
        __syncthreads();
        {
            const int row = F.lane & 15, quad = F.lane >> 4;
            bf16x8_t fw[3], fa[3];
#pragma unroll
            for (int ks = 0; ks < 3; ++ks) { fw[ks] = *(const LAS bf16x8_t*)(A1 + row * AROW + 32 * ks + 8 * quad); fa[ks] = *(const LAS bf16x8_t*)(A2 + row * AROW + 32 * ks + 8 * quad); }
#pragma unroll 2
            for (int nt = 0; nt < 8; ++nt) {
                const int n = 128 * F.wave + 16 * nt + row;
                f32x4 aw = {0.f, 0.f, 0.f, 0.f}, aa = {0.f, 0.f, 0.f, 0.f};
#pragma unroll
                for (int ks = 0; ks < 3; ++ks) {
                    const bf16x8_t bw = *(const bf16x8_t*)(LTw + (size_t)n * 96 + 32 * ks + 8 * quad), ba = *(const bf16x8_t*)(LTa + (size_t)n * 96 + 32 * ks + 8 * quad);
                    aw = __builtin_amdgcn_mfma_f32_16x16x32_bf16(fw[ks], bw, aw, 0, 0, 0); aa = __builtin_amdgcn_mfma_f32_16x16x32_bf16(fa[ks], ba, aa, 0, 0, 0);
                    asm volatile("" :: "v"(bw), "v"(ba));
                }
#pragma unroll
                for (int r = 0; r < 4; ++r) { LW[(4 * quad + r) * 1024 + n] = aw[r]; LA[(4 * quad + r) * 1024 + n] = aa[r]; }
            }
        }
        __syncthreads();
        unsigned rw[17][3];
#pragma unroll
        for (int tl = 0; tl < 17; ++tl) { const size_t tok = (size_t)tile * 16 + tl - 1; const bool ok = tl > 0 || ((tok + 1) & (SEQ - 1)) != 0;
            const bf16* cp = PROJ + tok * NINP + C_RF + c;
#pragma unroll
            for (int q = 0; q < 3; ++q) rw[tl][q] = ok ? *(const unsigned*)(cp + 1024 * q) : 0u; }
#pragma unroll
        for (int tl = 0; tl < 16; ++tl) {
            const size_t tok = (size_t)tile * 16 + tl; const bool hp = (tok & (SEQ - 1)) != 0;
            const unsigned cr = rw[tl + 1][0], ck = rw[tl + 1][1], cv = rw[tl + 1][2];
            const unsigned pr = hp ? rw[tl][0] : 0u, pk = hp ? rw[tl][1] : 0u, pv = hp ? rw[tl][2] : 0u;
            float r1, k1, v1; const float r0 = mix2(cr, pr, mur.x, mur.y, r1), k0 = mix2(ck, pk, muk.x, muk.y, k1), v0 = mix2(cv, pv, muv.x, muv.y, v1);
            const f32x2 lw = *(const LAS f32x2*)(LW + tl * 1024 + c), la = *(const LAS f32x2*)(LA + tl * 1024 + c);
            const float wp0 = w0v.x + lw.x, wp1 = w0v.y + lw.y;
            const float d0 = __expf(-0.6065306597126334f * sigmoidf_(wp0)), d1 = __expf(-0.6065306597126334f * sigmoidf_(wp1));
            const float aa0 = sigmoidf_(a0v.x + la.x), aa1 = sigmoidf_(a0v.y + la.y);
            const float q0 = k0 * kkv.x, q1 = k1 * kkv.y;
            float ss = q0 * q0 + q1 * q1;
#pragma unroll
            for (int o = 1; o < 32; o <<= 1) ss += __shfl_xor(ss, o);
            const float rn = rsqrtf(ss + 1e-6f); const float n0 = q0 * rn, n1 = q1 * rn;
            const float km0 = k0 * (1.f + (aa0 - 1.f) * kav.x), km1 = k1 * (1.f + (aa1 - 1.f) * kav.y);
            float bo = r0 * km0 * rkv.x + r1 * km1 * rkv.y;
#pragma unroll
            for (int o = 1; o < 32; o <<= 1) bo += __shfl_xor(bo, o);
            const size_t off = tok * 1024 + c;
            *(unsigned*)((bf16*)RR + off) = pk2(r0, r1); *(f32x2*)(RW + off) = (f32x2){d0, d1}; *(unsigned*)((bf16*)RK + off) = pk2(km0, km1); *(unsigned*)((bf16*)RV + off) = pk2(v0, v1);
            *(f32x2*)(RKK + off) = (f32x2){-n0, -n1}; *(unsigned*)((bf16*)RKA + off) = pk2(n0 * aa0, n1 * aa1);
            if ((F.lane & 31) == 0) RBON[tok * 16 + (c >> 6)] = bo;
        }
    }
}

#ifndef SCM
#define SCM 7
#endif
#ifndef REPM
#define REPM 0
#endif
constexpr int CH = 32;
#define WFENCE() do { __builtin_amdgcn_fence(__ATOMIC_RELEASE, "wavefront"); asm volatile("s_waitcnt lgkmcnt(0)" ::: "memory"); __builtin_amdgcn_wave_barrier(); __builtin_amdgcn_fence(__ATOMIC_ACQUIRE, "wavefront"); } while (0)

struct GPair { f32x4 k1a, k1b, k2a, k2b, q1a, q1b, q2a, q2b, eb, sc; float v1, v2; };
constexpr int G_BUF = 2 * CH * 128 + CH * 32 + 4 * CH;
__device__ __forceinline__ void gdn_lds(GPair& s, const LAS float* buf, int pr, int rg, int colL) {
    const LAS float* kp = buf + 2 * pr * 128 + rg * 4; const LAS float* qp = kp + CH * 128;
    s.k1a = *(const LAS f32x4*)kp; s.k1b = *(const LAS f32x4*)(kp + 64); s.k2a = *(const LAS f32x4*)(kp + 128); s.k2b = *(const LAS f32x4*)(kp + 192);
    s.q1a = *(const LAS f32x4*)qp; s.q1b = *(const LAS f32x4*)(qp + 64); s.q2a = *(const LAS f32x4*)(qp + 128); s.q2b = *(const LAS f32x4*)(qp + 192);
    s.v1 = buf[2 * CH * 128 + 2 * pr * 32 + colL]; s.v2 = buf[2 * CH * 128 + (2 * pr + 1) * 32 + colL];
    s.eb = *(const LAS f32x4*)(buf + 2 * CH * 128 + CH * 32 + 4 * pr); s.sc = *(const LAS f32x4*)(buf + 2 * CH * 128 + CH * 32 + 2 * CH + 4 * pr);
}
__device__ __forceinline__ float dot8(const f32x4 a, const f32x4 b, const f32x2 (&S)[4]) { const f32x2 t = (a.xy * S[0] + a.zw * S[1]) + (b.xy * S[2] + b.zw * S[3]); return t.x + t.y; }
#define DPP4(CTRL) do { d1 += dppf<CTRL>(d1); d2 += dppf<CTRL>(d2); e1 += dppf<CTRL>(e1); e2 += dppf<CTRL>(e2); } while (0)
__device__ __forceinline__ void gdn_pair(const GPair& s, f32x2 (&S)[4], LAS float* ob, bool wr) {
    float d1 = dot8(s.k1a, s.k1b, S), d2 = dot8(s.k2a, s.k2b, S), e1 = dot8(s.q1a, s.q1b, S), e2 = dot8(s.q2a, s.q2b, S);
    DPP4(0xB1); DPP4(0x4E); DPP4(0x141); DPP4(0x140);
    const float g1 = s.eb.x, b1 = s.eb.y, g2 = s.eb.z, b2 = s.eb.w;
    const float c1 = b1 * (s.v1 - g1 * d1);
    const float c2 = b2 * (s.v2 - g2 * (g1 * d2 + c1 * s.sc.x));
    const float o1 = g1 * e1 + c1 * s.sc.y;
    const float o2 = g2 * (g1 * e2 + c1 * s.sc.z) + c2 * s.sc.w;
    const float gg = g1 * g2, f1 = g2 * c1;
    S[0] = S[0] * gg + s.k1a.xy * f1 + s.k2a.xy * c2; S[1] = S[1] * gg + s.k1a.zw * f1 + s.k2a.zw * c2;
    S[2] = S[2] * gg + s.k1b.xy * f1 + s.k2b.xy * c2; S[3] = S[3] * gg + s.k1b.zw * f1 + s.k2b.zw * c2;
    if (wr) { ob[0] = o1; ob[32] = o2; }
}
#undef DPP4
struct GStage { u32x4 k, q, v; f32x4 sc; float e; };
__device__ __forceinline__ void gdn_gload(GStage& g, const bf16* GK, const bf16* GQ, const bf16* GV, const float* GEG, const float* GBE, const f32x4* GSC, int t0, int tid) {
    { const int st = tid >> 4, f8 = tid & 15; g.k = *(const u32x4*)(GK + (size_t)(t0 + st) * 1024 + 8 * f8); g.q = *(const u32x4*)(GQ + (size_t)(t0 + st) * 1024 + 8 * f8); }
    { const int i = tid & 127; g.v = *(const u32x4*)(GV + (size_t)(t0 + (i >> 2)) * 1024 + 8 * (i & 3)); }
    { const int i = tid & 63; const float* p = (i < 32 ? GEG : GBE); g.e = p[(size_t)(t0 + (i & 31)) * 8]; }
    g.sc = GSC[(size_t)((t0 >> 1) + (tid & 15)) * 8];
}
__device__ __forceinline__ void st8(LAS float* d, const u32x4 w) { float f[8]; unpack8(w, f); *(LAS f32x4*)d = (f32x4){f[0], f[1], f[2], f[3]}; *(LAS f32x4*)(d + 4) = (f32x4){f[4], f[5], f[6], f[7]}; }
__device__ __forceinline__ void gdn_gstore(const GStage& g, LAS float* buf, int tid) {
    st8(buf + 8 * tid, g.k); st8(buf + CH * 128 + 8 * tid, g.q);
    if (tid < 128) st8(buf + 2 * CH * 128 + 8 * tid, g.v);
    else if (tid >= 256 && tid < 320) { const int i = tid - 256, st = i & 31, wh = i >> 5; buf[2 * CH * 128 + CH * 32 + (st >> 1) * 4 + (st & 1) * 2 + wh] = g.e; }
    else if (tid >= 320 && tid < 336) *(LAS f32x4*)(buf + 2 * CH * 128 + CH * 32 + 2 * CH + 4 * (tid - 320)) = g.sc;
}
__device__ __forceinline__ void gdn_block(const Ctx& F, int vb) {
    const int bh = vb >> 2, qt = vb & 3, b = bh >> 3, h = bh & 7, colL = F.wave * 4 + (F.lane >> 4), rg = F.lane & 15;
    const size_t base = (size_t)b * SEQ;
    const bf16* GK = (const bf16*)(F.ws + WS_GK) + base * 1024 + h * 128; const bf16* GQ = (const bf16*)(F.ws + WS_GQ) + base * 1024 + h * 128;
    const bf16* GV = (const bf16*)(F.ws + WS_GV) + base * 1024 + h * 128 + qt * 32;
    const float* GEG = (const float*)(F.ws + WS_GEG) + base * 8 + h; const float* GBE = (const float*)(F.ws + WS_GBE) + base * 8 + h;
    const f32x4* GSC = (const f32x4*)(F.ws + WS_GSC) + (base >> 1) * 8 + h;
    float* GO = (float*)(F.ws + WS_GO) + base * 1024 + h * 128 + qt * 32;
    LAS float* lb = (LAS float*)F.lds; LAS float* obase = lb + 2 * G_BUF;
    f32x2 S[4] = {{0.f, 0.f}, {0.f, 0.f}, {0.f, 0.f}, {0.f, 0.f}};
    const bool wr = rg == 0;
    GStage g;
    gdn_gload(g, GK, GQ, GV, GEG, GBE, GSC, 0, F.tid); gdn_gstore(g, lb, F.tid);
    __syncthreads();
    for (int c = 0; c < SEQ / CH; ++c) {
        const LAS float* buf = lb + (c & 1) * G_BUF; LAS float* ob = obase + (c & 1) * (CH * 32) + colL;
        if (c + 1 < SEQ / CH) gdn_gload(g, GK, GQ, GV, GEG, GBE, GSC, (c + 1) * CH, F.tid);
        GPair P0, P1;
        gdn_lds(P0, buf, 0, rg, colL);
#pragma unroll 1
        for (int pr = 0; pr < CH / 2; pr += 2) {
            gdn_lds(P1, buf, pr + 1, rg, colL); gdn_pair(P0, S, ob + 2 * pr * 32, wr);
            gdn_lds(P0, buf, (pr + 2) & (CH / 2 - 1), rg, colL); gdn_pair(P1, S, ob + (2 * pr + 2) * 32, wr);
        }
        if (c + 1 < SEQ / CH) gdn_gstore(g, lb + ((c + 1) & 1) * G_BUF, F.tid);
        __syncthreads();
        if (F.tid < 256) *(f32x4*)(GO + (size_t)(c * CH + (F.tid >> 3)) * 1024 + 4 * (F.tid & 7)) = *(const LAS f32x4*)(obase + (c & 1) * (CH * 32) + 4 * F.tid);
    }
}

struct RStep { f32x4 w, n, a, k, r; float v; };
constexpr int R_BUF = CH * (5 * 64 + 32);
__device__ __forceinline__ void rwkv_lds(RStep& s, const LAS float* buf, int st, int cq, int rowL) {
    s.w = *(const LAS f32x4*)(buf + st * 64 + 4 * cq); s.n = *(const LAS f32x4*)(buf + CH * 64 + st * 64 + 4 * cq); s.a = *(const LAS f32x4*)(buf + 2 * CH * 64 + st * 64 + 4 * cq);
    s.k = *(const LAS f32x4*)(buf + 3 * CH * 64 + st * 64 + 4 * cq); s.r = *(const LAS f32x4*)(buf + 4 * CH * 64 + st * 64 + 4 * cq); s.v = buf[5 * CH * 64 + st * 32 + rowL];
}
__device__ __forceinline__ void rwkv_step(const RStep& s, f32x4& S, LAS float* ob, bool wr) {
    float sa = (S.x * s.n.x + S.y * s.n.y) + (S.z * s.n.z + S.w * s.n.w);
    sa = allred16(sa);
    S = S * s.w + sa * s.a + s.v * s.k;
    float y = (S.x * s.r.x + S.y * s.r.y) + (S.z * s.r.z + S.w * s.r.w);
    y = allred16(y);
    if (wr) *ob = y;
}
struct RStage { f32x4 x[2]; u32x4 y[3], v; };
__device__ __forceinline__ void rwkv_gload(RStage& g, const float* RW, const float* RN, const bf16* RA, const bf16* RKp, const bf16* RRp, const bf16* RV, int t0, int tid) {
    { const int st = tid >> 4, f4 = tid & 15; g.x[0] = *(const f32x4*)(RW + (size_t)(t0 + st) * 1024 + 4 * f4); g.x[1] = *(const f32x4*)(RN + (size_t)(t0 + st) * 1024 + 4 * f4); }
    { const int i = tid & 255; const size_t o = (size_t)(t0 + (i >> 3)) * 1024 + 8 * (i & 7); g.y[0] = *(const u32x4*)(RA + o); g.y[1] = *(const u32x4*)(RKp + o); g.y[2] = *(const u32x4*)(RRp + o); }
    { const int i = tid & 127; g.v = *(const u32x4*)(RV + (size_t)(t0 + (i >> 2)) * 1024 + 8 * (i & 3)); }
}
__device__ __forceinline__ void rwkv_gstore(const RStage& g, LAS float* buf, int tid) {
    *(LAS f32x4*)(buf + 4 * tid) = g.x[0]; *(LAS f32x4*)(buf + CH * 64 + 4 * tid) = g.x[1];
    if (tid < 256) { st8(buf + 2 * CH * 64 + 8 * tid, g.y[0]); st8(buf + 3 * CH * 64 + 8 * tid, g.y[1]); st8(buf + 4 * CH * 64 + 8 * tid, g.y[2]); }
    else if (tid < 384) st8(buf + 5 * CH * 64 + 8 * (tid - 256), g.v);
}
__device__ __forceinline__ void rwkv_block(const Ctx& F, int vb) {
    const int bh = vb >> 1, hf = vb & 1, b = bh >> 4, h = bh & 15, rowL = F.wave * 4 + (F.lane >> 4), cq = F.lane & 15;
    const size_t base = (size_t)b * SEQ * 1024 + h * 64;
    const float* RW = (const float*)(F.ws + WS_RW) + base; const float* RN = (const float*)(F.ws + WS_RKK) + base;
    const bf16* RA = (const bf16*)(F.ws + WS_RKA) + base; const bf16* RKp = (const bf16*)(F.ws + WS_RK) + base; const bf16* RRp = (const bf16*)(F.ws + WS_RR) + base;
    const bf16* RV = (const bf16*)(F.ws + WS_RV) + base + hf * 32;
    float* RY = (float*)(F.ws + WS_RY) + base + hf * 32;
    LAS float* lb = (LAS float*)F.lds; LAS float* obase = lb + 2 * R_BUF;
    f32x4 S = {0.f, 0.f, 0.f, 0.f};
    const bool wr = cq == 0;
    RStage g;
    rwkv_gload(g, RW, RN, RA, RKp, RRp, RV, 0, F.tid); rwkv_gstore(g, lb, F.tid);
    __syncthreads();
    for (int c = 0; c < SEQ / CH; ++c) {
        const LAS float* buf = lb + (c & 1) * R_BUF; LAS float* ob = obase + (c & 1) * (CH * 32) + rowL;
        if (c + 1 < SEQ / CH) rwkv_gload(g, RW, RN, RA, RKp, RRp, RV, (c + 1) * CH, F.tid);
        RStep R0, R1, R2, R3;
        rwkv_lds(R0, buf, 0, cq, rowL); rwkv_lds(R1, buf, 1, cq, rowL);
#pragma unroll 1
        for (int s = 0; s < CH; s += 4) {
            rwkv_lds(R2, buf, s + 2, cq, rowL); rwkv_step(R0, S, ob + s * 32, wr);
            rwkv_lds(R3, buf, s + 3, cq, rowL); rwkv_step(R1, S, ob + (s + 1) * 32, wr);
            rwkv_lds(R0, buf, (s + 4) & (CH - 1), cq, rowL); rwkv_step(R2, S, ob + (s + 2) * 32, wr);
            rwkv_lds(R1, buf, (s + 5) & (CH - 1), cq, rowL); rwkv_step(R3, S, ob + (s + 3) * 32, wr);
        }
        if (c + 1 < SEQ / CH) rwkv_gstore(g, lb + ((c + 1) & 1) * R_BUF, F.tid);
        __syncthreads();
        if (F.tid < 256) *(f32x4*)(RY + (size_t)(c * CH + (F.tid >> 3)) * 1024 + 4 * (F.tid & 7)) = *(const LAS f32x4*)(obase + (c & 1) * (CH * 32) + 4 * F.tid);
    }
}

constexpr int S5_SROW = 136;
constexpr int S5_BROW = 20;
constexpr int S5_WAVE_B = 16 * S5_SROW * 2 + 1024 + 128 * S5_BROW * 4;
__device__ __forceinline__ void s5_block(const Ctx& F, const Args& a, int l, int it) {
    const int b = it >> 6, g = it & 63, p = F.lane, tl = F.lane >> 4, c = F.lane & 15, w = F.wave;
    const bf16* PROJ = (const bf16*)(F.ws + WS_PROJ); bf16* SY = (bf16*)(F.ws + WS_SY);
    LAS float* se = (LAS float*)F.lds;
    LAS unsigned char* wb = F.lds + 4096 + w * S5_WAVE_B;
    LAS bf16* sbuf = (LAS bf16*)wb; LAS float* uall = (LAS float*)(wb + 16 * S5_SROW * 2); LAS float* BU = uall + 256;
    const float dt = expf(a.in[19][l * 64 + g]);
    float abr, abi;
    {   const size_t gp = ((size_t)l * 64 + g) * 64 + p; const float are = a.in[17][gp], aim = a.in[18][gp]; const float mag = expf(are * dt); abr = mag * cosf(aim * dt); abi = mag * sinf(aim * dt); }
    bf16x8_t Bf[8];
    {   const int hl = tl >> 1, c0 = 8 * (tl & 1);
#pragma unroll
        for (int jj = 0; jj < 4; ++jj) {
            const size_t gp2 = ((size_t)l * 64 + g) * 64 + 16 * jj + c; const float are = a.in[17][gp2], aim = a.in[18][gp2];
            const float mag = expf(are * dt), ar = mag * cosf(aim * dt), ai = mag * sinf(aim * dt);
            const float den = are * are + aim * aim, cr = ((ar - 1.f) * are + ai * aim) / den, ci = (ai * are - (ar - 1.f) * aim) / den;
            const f32x4 r0 = *(const f32x4*)(a.in[20] + gp2 * 16 + c0), r1 = *(const f32x4*)(a.in[20] + gp2 * 16 + c0 + 4), i0 = *(const f32x4*)(a.in[21] + gp2 * 16 + c0), i1 = *(const f32x4*)(a.in[21] + gp2 * 16 + c0 + 4);
            const float br[8] = {r0.x, r0.y, r0.z, r0.w, r1.x, r1.y, r1.z, r1.w}, bi[8] = {i0.x, i0.y, i0.z, i0.w, i1.x, i1.y, i1.z, i1.w};
            float vr[8], vi[8];
#pragma unroll
            for (int e = 0; e < 8; ++e) { const float xr = cr * br[e] - ci * bi[e], xi = cr * bi[e] + ci * br[e];
                const float hr = bflo(pk2(xr, 0.f)), hi = bflo(pk2(xi, 0.f)); vr[e] = hl ? xr - hr : hr; vi[e] = hl ? xi - hi : hi; }
            Bf[jj] = __builtin_bit_cast(bf16x8_t, pack8(vr)); Bf[4 + jj] = __builtin_bit_cast(bf16x8_t, pack8(vi));
        }
    }
    bf16x8_t Cf[4];
    { const size_t cb = (((size_t)l * 64 + g) * 16 + c) * 64;
#pragma unroll
      for (int m = 0; m < 4; ++m) { const int k0 = 32 * m + 8 * tl; const float* src = (k0 < 64 ? a.in[22] + cb + k0 : a.in[23] + cb + (k0 - 64)); const float sg = k0 < 64 ? 1.f : -1.f;
          const f32x4 x0 = *(const f32x4*)src, x1 = *(const f32x4*)(src + 4);
          u32x4 pk; pk.x = pk2(sg * x0.x, sg * x0.y); pk.y = pk2(sg * x0.z, sg * x0.w); pk.z = pk2(sg * x1.x, sg * x1.y); pk.w = pk2(sg * x1.z, sg * x1.w);
          Cf[m] = __builtin_bit_cast(bf16x8_t, pk); } }
    const float dsk = a.in[24][l * 1024 + g * 16 + c];
    const int tw = 256 * w;
    const bf16* up = PROJ + ((size_t)b * SEQ + tw + c) * NINP + C_SU + g * 16 + 8 * (tl & 1);
    float sr = 0.f, si = 0.f;
#define S5_BU(UF) do { const bf16x8_t af_ = __builtin_bit_cast(bf16x8_t, UF); \
        _Pragma("unroll") for (int j = 0; j < 8; ++j) { const f32x4 z_ = {0.f, 0.f, 0.f, 0.f}; const f32x4 d_ = __builtin_amdgcn_mfma_f32_16x16x32_bf16(af_, Bf[j], z_, 0, 0, 0); \
            *(LAS f32x4*)(BU + (16 * j + c) * S5_BROW + 4 * tl) = d_; } asm volatile("" :: "v"(af_)); } while (0)
    {
        u32x4 ucur = *(const u32x4*)up;
        for (int t = 0; t < 256; t += 16) {
            const u32x4 unxt = *(const u32x4*)(up + (size_t)((t + 16 < 256) ? t + 16 : t) * NINP);
            S5_BU(ucur);
            WFENCE();
            float br_[16], bi_[16];
#pragma unroll
            for (int q = 0; q < 4; ++q) { const f32x4 x = *(const LAS f32x4*)(BU + p * S5_BROW + 4 * q), y = *(const LAS f32x4*)(BU + (64 + p) * S5_BROW + 4 * q);
                br_[4 * q] = x.x; br_[4 * q + 1] = x.y; br_[4 * q + 2] = x.z; br_[4 * q + 3] = x.w; bi_[4 * q] = y.x; bi_[4 * q + 1] = y.y; bi_[4 * q + 2] = y.z; bi_[4 * q + 3] = y.w; }
#pragma unroll
            for (int s = 0; s < 16; ++s) { const float nr = abr * sr - abi * si + br_[s], ni = abr * si + abi * sr + bi_[s]; sr = nr; si = ni; }
            WFENCE();
            ucur = unxt;
        }
    }
    se[w * 128 + p] = sr; se[w * 128 + 64 + p] = si;
    __syncthreads();
    {
        float pr = abr, pi = abi;
#pragma unroll
        for (int i = 0; i < 8; ++i) { const float nr = pr * pr - pi * pi, ni = 2.f * pr * pi; pr = nr; pi = ni; }
        sr = 0.f; si = 0.f;
        for (int j = 0; j < w; ++j) { const float er = se[j * 128 + p], ei = se[j * 128 + 64 + p]; const float nr = pr * sr - pi * si + er, ni = pr * si + pi * sr + ei; sr = nr; si = ni; }
    }
    {
        u32x4 ucur = *(const u32x4*)up;
        for (int t = 0; t < 256; t += 16) {
            const u32x4 unxt = *(const u32x4*)(up + (size_t)((t + 16 < 256) ? t + 16 : t) * NINP);
            S5_BU(ucur);
            if (tl < 2) { float uf[8]; unpack8(ucur, uf); *(LAS f32x4*)(uall + c * 16 + 8 * tl) = (f32x4){uf[0], uf[1], uf[2], uf[3]}; *(LAS f32x4*)(uall + c * 16 + 8 * tl + 4) = (f32x4){uf[4], uf[5], uf[6], uf[7]}; }
            WFENCE();
            float br_[16], bi_[16];
#pragma unroll
            for (int q = 0; q < 4; ++q) { const f32x4 x = *(const LAS f32x4*)(BU + p * S5_BROW + 4 * q), y = *(const LAS f32x4*)(BU + (64 + p) * S5_BROW + 4 * q);
                br_[4 * q] = x.x; br_[4 * q + 1] = x.y; br_[4 * q + 2] = x.z; br_[4 * q + 3] = x.w; bi_[4 * q] = y.x; bi_[4 * q + 1] = y.y; bi_[4 * q + 2] = y.z; bi_[4 * q + 3] = y.w; }
#pragma unroll
            for (int s = 0; s < 16; ++s) { const float nr = abr * sr - abi * si + br_[s], ni = abr * si + abi * sr + bi_[s]; sr = nr; si = ni;
                const unsigned pk = pk2(sr, si); sbuf[s * S5_SROW + p] = (bf16)(pk & 0xffffu); sbuf[s * S5_SROW + 64 + p] = (bf16)(pk >> 16); }
            WFENCE();
            f32x4 acc = {0.f, 0.f, 0.f, 0.f};
#pragma unroll
            for (int m = 0; m < 4; ++m) { const bf16x8_t af = *(const LAS bf16x8_t*)(sbuf + c * S5_SROW + 32 * m + 8 * tl);
                acc = __builtin_amdgcn_mfma_f32_16x16x32_bf16(af, Cf[m], acc, 0, 0, 0); asm volatile("" :: "v"(af)); }
#pragma unroll
            for (int r = 0; r < 4; ++r) { const int st = 4 * tl + r; const float y = acc[r] + dsk * uall[st * 16 + c];
                SY[((size_t)b * SEQ + tw + t + st) * 1024 + g * 16 + c] = (bf16)(pk2(gelu_tanh(y), 0.f) & 0xffffu); }
            WFENCE();
            ucur = unxt;
        }
    }
#undef S5_BU
    __syncthreads();
}

__device__ __forceinline__ void scan_phase(const Ctx& F, const Args& a, int l) {
    for (int r5 = 0; r5 < 1 + ((REPM >> 9) & 1); ++r5) for (int vb = F.vcu; vb < 256; vb += F.G) s5_block(F, a, l, vb);
    for (int rg_ = 0; rg_ < 1 + ((REPM >> 10) & 1); ++rg_) for (int vb = F.vcu; vb < 256; vb += F.G) {
        if (vb < 128) { gdn_block(F, vb); if (REPM & 2048) gdn_block(F, vb); }
        else { rwkv_block(F, vb - 128); if (REPM & 4096) rwkv_block(F, vb - 128); }
    }
}

__device__ __forceinline__ void post_phase(const Ctx& F, const Args& a, int l, int gw, int ngw) {
    const bf16* PROJ = (const bf16*)(F.ws + WS_PROJ); bf16* OBR = (bf16*)(F.ws + WS_OBR);
    const float* GO = (const float*)(F.ws + WS_GO); const float* RY = (const float*)(F.ws + WS_RY); const float* RV = (const float*)(F.ws + WS_RV); const float* RBON = (const float*)(F.ws + WS_RBON);
    const int c0 = 16 * F.lane;
    float nw[16], lw[16], lb[16];
#pragma unroll
    for (int e = 0; e < 16; ++e) { nw[e] = a.in[6][l * 128 + (c0 & 127) + e]; lw[e] = a.in[15][l * 1024 + c0 + e]; lb[e] = a.in[16][l * 1024 + c0 + e]; }
    for (int tok = gw; tok < TOK; tok += ngw) {
        { float o[16];
#pragma unroll
          for (int q = 0; q < 4; ++q) { const f32x4 v = *(const f32x4*)(GO + (size_t)tok * 1024 + c0 + 4 * q); o[4 * q] = v.x; o[4 * q + 1] = v.y; o[4 * q + 2] = v.z; o[4 * q + 3] = v.w; }
          float ss = 0.f;
#pragma unroll
          for (int e = 0; e < 16; ++e) ss += o[e] * o[e];
          ss = allred8(ss);
          const float rs = rsqrtf(ss * (1.f / 128.f) + 1e-6f);
          float z[16]; { float z0[8], z1[8]; unpack8(*(const u32x4*)(PROJ + (size_t)tok * NINP + C_GZ + c0), z0); unpack8(*(const u32x4*)(PROJ + (size_t)tok * NINP + C_GZ + c0 + 8), z1);
#pragma unroll
              for (int e = 0; e < 8; ++e) { z[e] = z0[e]; z[8 + e] = z1[e]; } }
          float r0[8], r1[8];
#pragma unroll
          for (int e = 0; e < 8; ++e) { r0[e] = o[e] * rs * nw[e] * siluf_(z[e]); r1[e] = o[8 + e] * rs * nw[8 + e] * siluf_(z[8 + e]); }
          *(u32x4*)(OBR + (size_t)tok * 1024 + c0) = pack8(r0); *(u32x4*)(OBR + (size_t)tok * 1024 + c0 + 8) = pack8(r1); }
        { float y[16], v[16];
#pragma unroll
          for (int q = 0; q < 4; ++q) { const f32x4 t = *(const f32x4*)(RY + (size_t)tok * 1024 + c0 + 4 * q); y[4 * q] = t.x; y[4 * q + 1] = t.y; y[4 * q + 2] = t.z; y[4 * q + 3] = t.w;
          }
          { float va[8], vb[8]; unpack8(*(const u32x4*)((const bf16*)RV + (size_t)tok * 1024 + c0), va); unpack8(*(const u32x4*)((const bf16*)RV + (size_t)tok * 1024 + c0 + 8), vb);
#pragma unroll
              for (int e = 0; e < 8; ++e) { v[e] = va[e]; v[8 + e] = vb[e]; } }
          float s = 0.f;
#pragma unroll
          for (int e = 0; e < 16; ++e) s += y[e];
          s += dppf<0xB1>(s); s += dppf<0x4E>(s);
          const float mean = s * (1.f / 64.f); float q2 = 0.f;
#pragma unroll
          for (int e = 0; e < 16; ++e) { const float d = y[e] - mean; q2 += d * d; }
          q2 += dppf<0xB1>(q2); q2 += dppf<0x4E>(q2);
          const float rs = rsqrtf(q2 * (1.f / 64.f) + 64e-5f);
          const float bon = RBON[(size_t)tok * 16 + (c0 >> 6)];
          float z[16]; { float z0[8], z1[8]; unpack8(*(const u32x4*)(PROJ + (size_t)tok * NINP + C_RZ + c0), z0); unpack8(*(const u32x4*)(PROJ + (size_t)tok * NINP + C_RZ + c0 + 8), z1);
#pragma unroll
              for (int e = 0; e < 8; ++e) { z[e] = z0[e]; z[8 + e] = z1[e]; } }
          float r0[8], r1[8];
#pragma unroll
          for (int e = 0; e < 8; ++e) { r0[e] = ((y[e] - mean) * rs * lw[e] + lb[e] + bon * v[e]) * siluf_(z[e]); r1[e] = ((y[8 + e] - mean) * rs * lw[8 + e] + lb[8 + e] + bon * v[8 + e]) * siluf_(z[8 + e]); }
          bf16* ob = OBR + (size_t)TOK * 1024 + (size_t)tok * 1024 + c0;
          *(u32x4*)ob = pack8(r0); *(u32x4*)(ob + 8) = pack8(r1); }
    }
}

#ifndef PHM
#define PHM 0xFFFF
#endif
#ifndef REPM
#define REPM 0
#endif
__global__ void __launch_bounds__(NTHREADS, 2) hybrid_fwd(Args a) {
    extern __shared__ __attribute__((aligned(16))) unsigned char lds_raw[];
    Ctx F;
    F.lds = (LAS unsigned char*)lds_raw; F.ws = a.ws;
    F.G = gridDim.x; { const int bx = blockIdx.x; F.vcu = (F.G % 8 == 0) ? (bx % 8) * (F.G / 8) + bx / 8 : bx; }
    F.NGW = F.G * NWAVES;
    cg::grid_group grid = cg::this_grid();
    if (threadIdx.x < 8) ((volatile LAS unsigned*)(F.lds + MISC_OFF))[threadIdx.x] = 0u;
    __syncthreads();
    grid.sync();
    XcdBarrier bar = xcd_barrier_post((unsigned*)(a.ws + WS_CTL), (volatile LAS unsigned*)(F.lds + MISC_OFF));
    bf16* XN = (bf16*)(a.ws + WS_XN); bf16* PROJ = (bf16*)(a.ws + WS_PROJ);
    int rep = 0;
    for (int ph = a.ph_lo; ph < a.ph_hi; ) {
        { int t_ = threadIdx.x; asm volatile("" : "+v"(t_)); F.tid = t_; F.lane = t_ & 63; F.wave = __builtin_amdgcn_readfirstlane(t_ >> 6); F.gw = F.vcu * NWAVES + F.wave; }
        if (ph == NPHASES - 1) { for (int m = F.gw; m < TOK; m += F.NGW) rms_row(a.out + (size_t)m * DM, a.in[30], nullptr, nullptr, a.out + (size_t)m * DM, F.lane); }
        else if (ph == 0) { if (PHM & 1) phase0(F, a);
            if (REPM & 128) { if (!rep) { rep = 1; __syncthreads(); continue; } rep = 0; } }
        else {
            const int l = (ph - 1) / PH_PER_LAYER, k = (ph - 1) % PH_PER_LAYER;
            if (k == 0 && (PHM & 2)) {
                const bool conv = (l + 1 < DEPTH) && F.G == 256; const int gG = conv ? 232 : F.G;
                if (conv && (int)blockIdx.x >= gG) convert_layer(F, a, l + 1, ((int)blockIdx.x - gG) * NWAVES + F.wave, (F.G - gG) * NWAVES, 0, CV_DED);
                else {
                    pg8::Gemm g{XN, (const bf16*)(a.ws + WS_WIN) + (size_t)l * NINP * DM, TOK, NINP, DM}; pg8::StaticOrder S; S.init(TOK, NINP, gG, (int)blockIdx.x);
                    pg8::EpiBf16Rs E{PROJ, NINP, (const unsigned long long*)(a.ws + WS_CTL + CTL_SS) + (size_t)l * TOK};
                    pg8::gemm_phase<pg8::EpiBf16Rs, pg8::StaticOrder, true, true>(F.lds, g, S, E);
                    if (conv) convert_layer(F, a, l + 1, (int)blockIdx.x * NWAVES + F.wave, gG * NWAVES, CV_DED, CV_ALL);
                    else if (l + 1 < DEPTH) convert_layer(F, a, l + 1, F.gw, F.NGW);
                }
            } else if (k == 1) { prep_gdn(F, a, l); if (REPM & 8192) prep_gdn(F, a, l); prep_rwkv(F, a, l); if (REPM & 16384) prep_rwkv(F, a, l); }
            else if (k == 2) { if (PHM & 16) scan_phase(F, a, l); }
            else if (k == 3 && (PHM & 32)) {
                const bool split = F.G >= 192;
                if (!split) { post_phase(F, a, l, F.gw, F.NGW); __syncthreads(); }
                if (!split || (int)blockIdx.x < 128) {
                    pg8::Gemm g{(const bf16*)(a.ws + WS_SY), (const bf16*)(a.ws + WS_WGLU) + (size_t)l * 1024 * 1024, TOK, 1024, 1024}; pg8::StaticOrder S; S.init(TOK, 1024, F.G, (int)blockIdx.x);
                    pg8::EpiGlu E{(const bf16*)(a.ws + WS_SY), PROJ, a.in[26] + l * 1024, (bf16*)(a.ws + WS_OBR) + (size_t)2 * TOK * 1024};
                    pg8::gemm_phase<pg8::EpiGlu, pg8::StaticOrder, true, true>(F.lds, g, S, E);
                } else post_phase(F, a, l, ((int)blockIdx.x - 128) * NWAVES + F.wave, (F.G - 128) * NWAVES);
            } else if (k == 4 && (PHM & 64)) {
                pg8::Gemm g{(const bf16*)(a.ws + WS_OBR), (const bf16*)(a.ws + WS_WBR) + (size_t)l * 3 * DM * 1024, 3 * TOK, 3 * DM, 1024};
                pg8::BranchOrder S; S.base.init(TOK, DM, F.G, (int)blockIdx.x);
                pg8::EpiBranch E{PROJ, a.in[27] + (size_t)l * 3 * DM, (bf16*)(a.ws + WS_ACCF), (bf16*)(a.ws + WS_MRG)};
                pg8::gemm_phase<pg8::EpiBranch, pg8::BranchOrder, true, true>(F.lds, g, S, E);
            } else if (k == 5 && (PHM & 128)) {
                pg8::Gemm g{(const bf16*)(a.ws + WS_MRG), (const bf16*)(a.ws + WS_WOUT) + (size_t)l * DM * DM, TOK, DM, DM}; pg8::StaticOrder S; S.init(TOK, DM, F.G, (int)blockIdx.x);
                pg8::EpiResid E{l == 0 ? a.in[0] : a.out, a.out, l + 1 < DEPTH ? XN : nullptr, a.in[1] + (size_t)(l + 1 < DEPTH ? l + 1 : 0) * DM, (unsigned long long*)(a.ws + WS_CTL + CTL_SS) + (size_t)(l + 1 < DEPTH ? l + 1 : 0) * TOK};
                pg8::gemm_phase<pg8::EpiResid, pg8::StaticOrder, true, true>(F.lds, g, S, E);
            }
            if (REPM && !rep && ((REPM >> k) & 1)) { rep = 1; __syncthreads(); continue; }
            rep = 0;
        }
        if (ph + 1 < a.ph_hi) {
            xcd_barrier(bar);
            if (REPM & 256) xcd_barrier(bar);
        }
        ++ph;
    }
}

#ifndef MK_MULTI
#define MK_MULTI 0
#endif
extern "C" void kernel_launch(void* const* d_in, const int* in_sizes, int n_in, void* d_out, int out_size, void* d_ws, size_t ws_size, hipStream_t stream) {
    static int grid = 0;
    if (grid == 0) {
        if (n_in != 31 || out_size != TOK * DM || ws_size < WS_END) { fprintf(stderr, "kernel_launch: unexpected shapes (n_in %d out %d ws %zu)\n", n_in, out_size, ws_size); grid = -1; return; }
        int dev = 0, cus = 0, per_cu = 0;
        hipGetDevice(&dev); hipDeviceGetAttribute(&cus, hipDeviceAttributeMultiprocessorCount, dev);
        if (hipFuncSetAttribute((const void*)hybrid_fwd, hipFuncAttributeMaxDynamicSharedMemorySize, LDS_BYTES) != hipSuccess) { fprintf(stderr, "kernel_launch: hipFuncSetAttribute failed\n"); grid = -1; return; }
        if (hipOccupancyMaxActiveBlocksPerMultiprocessor(&per_cu, (const void*)hybrid_fwd, NTHREADS, LDS_BYTES) != hipSuccess || per_cu < 1) per_cu = 1;
        (void)hipGetLastError();
        grid = cus * per_cu;
        fprintf(stderr, "kernel_launch: grid %d (cus %d x %d)\n", grid, cus, per_cu);
    }
    if (grid < 0) return;
    if (hipMemsetAsync((char*)d_ws + WS_CTL, 0, CTL_ZERO_BYTES, stream) != hipSuccess) { fprintf(stderr, "kernel_launch: memset failed\n"); return; }
    Args a{};
    for (int i = 0; i < 31; ++i) a.in[i] = (const float*)d_in[i];
    a.out = (float*)d_out; a.ws = (unsigned char*)d_ws;
#if MK_MULTI
    for (int ph = 0; ph < NPHASES; ++ph) { a.ph_lo = ph; a.ph_hi = ph + 1; hipLaunchKernelGGL(hybrid_fwd, dim3(grid), dim3(NTHREADS), LDS_BYTES, stream, a); }
#else
    a.ph_lo = 0; a.ph_hi = NPHASES;
    void* args[] = {&a};
    const hipError_t e = hipLaunchCooperativeKernel((const void*)hybrid_fwd, dim3(grid), dim3(NTHREADS), args, LDS_BYTES, stream);
    if (e != hipSuccess) fprintf(stderr, "kernel_launch: cooperative launch failed: %s (grid %d)\n", hipGetErrorString(e), grid);
#endif
}
```

```cpp
#include <hip/hip_runtime.h>
#include <hip/hip_cooperative_groups.h>
#include <cstdio>
#include <cstdint>
namespace cg = cooperative_groups;
namespace pg8 {
#define PG8_LAS __attribute__((address_space(3)))
typedef unsigned short bf16_t;
typedef short bf16x8 __attribute__((ext_vector_type(8)));
typedef float f32x4 __attribute__((ext_vector_type(4)));
typedef unsigned u32x4 __attribute__((ext_vector_type(4)));
constexpr int BM = 256, BK = 64, HALF = 128, HTB = HALF * BK * 2  , STAGE_BYTES = 8 * HTB, NXCD = 8, WGM = 8;

__host__ __device__ __forceinline__ int lds_byte(int r, int c) { const int st = (r >> 4) * 2 + (c >> 5), rr = r & 15, cc = c & 31, ob = rr * 64 + cc * 2; return st * 1024 + (ob ^ (((ob >> 9) & 1) << 5)); }
__host__ __device__ __forceinline__ void stage_rc(int b, int& R, int& C) { const int st = b / 1024, sb = b % 1024, swz = sb ^ (((sb >> 9) & 1) << 5); R = (st >> 1) * 16 + swz / 64; C = (st & 1) * 32 + (swz % 64) / 2; }
__host__ __device__ __forceinline__ int perm32(int rho) { const int n = rho >> 4, i = rho & 15; return 8 * (i >> 2) + 4 * n + (i & 3); }

struct Unit { int pm, pn; };
struct Gemm { const bf16_t* A; const bf16_t* Bt; int M, N, K, ld; };

struct StaticOrder {
    int nM, nN, nwg, G, c;
    __host__ __device__ void init(int M, int N, int G_, int c_) { nM = M / BM; nN = N / BM; nwg = nM * nN; G = G_; c = c_; }
    __host__ __device__ bool next(int i, Unit& u) const {
        const long L = (long)i * G + c; if (L >= nwg) return false;
        int wgid = (int)L; { const int q = nwg / NXCD, r = nwg % NXCD, xcd = wgid % NXCD, off = wgid / NXCD; wgid = (xcd < r ? xcd * (q + 1) : r * (q + 1) + (xcd - r) * q) + off; }
        const int nig = WGM * nN, gid = wgid / nig, fm = gid * WGM, gsz = (nM - fm) < WGM ? (nM - fm) : WGM;
        u.pm = fm + ((wgid % nig) % gsz); u.pn = (wgid % nig) / gsz; return true;
    }
    __device__ __forceinline__ void a_ready(const Unit&) const {}
    __device__ __forceinline__ void done(const Unit&) const {}
};

__device__ __forceinline__ unsigned cvt_pk_bf16(float lo, float hi) { unsigned r; asm volatile("v_cvt_pk_bf16_f32 %0, %1, %2" : "=v"(r) : "v"(lo), "v"(hi)); return r; }
typedef float f32x2 __attribute__((ext_vector_type(2)));
__device__ __forceinline__ f32x2 gelu_pk(f32x2 v) {
    const f32x2 av = __builtin_elementwise_abs(v), d = av * 0.2316418882f + 1.0f;
    f32x2 t; t.x = __builtin_amdgcn_rcpf(d.x); t.y = __builtin_amdgcn_rcpf(d.y);
    f32x2 q = t * 0.5307027145f + (-0.7265760135f); q = q * t + 0.7107068705f; q = q * t + (-0.142248368f); q = q * t + 0.127414796f; q = q * t;
    const f32x2 s = (v * v) * (-0.72134752044f);
    f32x2 e; e.x = __builtin_amdgcn_exp2f(s.x); e.y = __builtin_amdgcn_exp2f(s.y);
    const f32x2 m = v * (q * e), r = v - m;
    f32x2 o; o.x = v.x < 0.f ? m.x : r.x; o.y = v.y < 0.f ? m.y : r.y; return o;
}

template <int ACT  > struct EpiBf16 {
    static constexpr bool PERM = true, AFTER_DRAIN = false; static_assert(ACT == 0 || ACT == 1, "EpiBf16: ACT is 0 (none) or 1 (gelu_pk)");
    bf16_t* O; int ldc; const float* bias; int split_cols; size_t split_stride; float scale0;
    __device__ __forceinline__ void operator()(const f32x4 (&acc)[2][2][4][2], const Unit& u, int wr, int wc, int fr, int fq) const {
        const int row0 = u.pm * BM + wr * 64 + fr; int colt = u.pn * BM; bf16_t* base = O;
        float sc = 1.f; if (split_cols) { const int t = colt / split_cols; base += (size_t)t * split_stride; colt -= t * split_cols; if (t == 0) sc = scale0; }
        const int col0 = colt + wc * 32 + 8 * fq, bcol0 = u.pn * BM + wc * 32 + 8 * fq;
        f32x4 bv[2][2];
#pragma unroll
        for (int bj = 0; bj < 2; ++bj)
#pragma unroll
            for (int n = 0; n < 2; ++n) bv[bj][n] = bias ? *(const f32x4*)(bias + bcol0 + bj * HALF + 4 * n) : (f32x4){0.f, 0.f, 0.f, 0.f};
#pragma unroll
        for (int ai = 0; ai < 2; ++ai)
#pragma unroll
            for (int m = 0; m < 4; ++m) { bf16_t* rowp = base + (size_t)(row0 + ai * HALF + m * 16) * ldc + col0;
#pragma unroll
                for (int bj = 0; bj < 2; ++bj) { f32x4 v0 = acc[ai][bj][m][0] + bv[bj][0], v1 = acc[ai][bj][m][1] + bv[bj][1];
                    if (ACT == 1) { f32x2 a = gelu_pk((f32x2){v0[0], v0[1]}), b = gelu_pk((f32x2){v0[2], v0[3]}), c = gelu_pk((f32x2){v1[0], v1[1]}), d = gelu_pk((f32x2){v1[2], v1[3]});
                        v0 = (f32x4){a.x, a.y, b.x, b.y}; v1 = (f32x4){c.x, c.y, d.x, d.y}; }
                    v0 = v0 * sc; v1 = v1 * sc; u32x4 w; w.x = cvt_pk_bf16(v0[0], v0[1]); w.y = cvt_pk_bf16(v0[2], v0[3]); w.z = cvt_pk_bf16(v1[0], v1[1]); w.w = cvt_pk_bf16(v1[2], v1[3]);
                    *(u32x4*)(rowp + bj * HALF) = w; } }
    }
};

template <class Epi, class Sched, bool ALIGN_EPI = false, bool SP2 = false>
__device__ __forceinline__ void gemm_phase(PG8_LAS unsigned char* lds, const Gemm g, const Sched& S, const Epi& E) {
    int tid_ = threadIdx.x; asm volatile("" : "+v"(tid_));
    const int tid = tid_, wid = __builtin_amdgcn_readfirstlane(tid >> 6), lane = tid & 63, wr = wid >> 2, wc = wid & 3, fr = lane & 15, fq = lane >> 4;
    const int K = g.K, nt = K / BK, LD = g.ld ? g.ld : g.K;
    unsigned voffA[2], voffB[2];
#pragma unroll
    for (int i = 0; i < 2; ++i) { int R, C; stage_rc(tid * 16 + i * 8192, R, C); const int Rb = Epi::PERM ? ((R & ~31) + perm32(R & 31)) : R;
        voffA[i] = (unsigned)(R * LD + C) * 2u; voffB[i] = (unsigned)(Rb * LD + C) * 2u; }
    const size_t kstep = (size_t)(BK * 2);
    const size_t hstep = (size_t)HALF * LD * 2;
    const size_t tstep = 2 * hstep;
    const unsigned ldsw = (unsigned)wid * 1024u;
    const int aoff = lds_byte(wr * 64 + fr, fq * 8), boff = lds_byte(wc * 32 + fr, fq * 8);
#define PG8_SA(b, h) (((b) * 2 + (h)) * HTB)
#define PG8_SB(b, h) ((4 + (b) * 2 + (h)) * HTB)
#define PG8_STAGE(bufoff, gbase, voff) do { _Pragma("unroll") for (int _i = 0; _i < 2; ++_i) \
        __builtin_amdgcn_global_load_lds((const unsigned*)((const char*)(gbase) + (voff)[_i]), (PG8_LAS unsigned*)(lds + (bufoff) + ldsw + _i * 8192), 16, 0, 0); } while (0)
#define PG8_LDA(dst, b, h) do { _Pragma("unroll") for (int m = 0; m < 4; ++m) _Pragma("unroll") for (int k = 0; k < 2; ++k) dst[m][k] = *(const PG8_LAS bf16x8*)(lds + PG8_SA(b, h) + aoff + m * 2048 + k * 1024); } while (0)
#define PG8_LDB(dst, b, h) do { _Pragma("unroll") for (int n = 0; n < 2; ++n) _Pragma("unroll") for (int k = 0; k < 2; ++k) dst[n][k] = *(const PG8_LAS bf16x8*)(lds + PG8_SB(b, h) + boff + n * 2048 + k * 1024); } while (0)
#define PG8_MMA(ai, bj, At, Bt) do { __builtin_amdgcn_s_setprio(1); _Pragma("unroll") for (int m = 0; m < 4; ++m) _Pragma("unroll") for (int n = 0; n < 2; ++n) _Pragma("unroll") for (int k = 0; k < 2; ++k) \
        acc[ai][bj][m][n] = __builtin_amdgcn_mfma_f32_16x16x32_bf16(Bt[n][k], At[m][k], acc[ai][bj][m][n], 0, 0, 0); __builtin_amdgcn_s_setprio(0); } while (0)
#define PG8_WAIT_V(n) asm volatile("s_waitcnt vmcnt(" #n ")" ::: "memory")
#define PG8_WAIT_L(n) asm volatile("s_waitcnt lgkmcnt(" #n ")" ::: "memory")
#define PG8_BAR __builtin_amdgcn_s_barrier()
#define PG8_SCHED __builtin_amdgcn_sched_barrier(0)
    Unit cur, nxt; int ui = 0;
    if (!S.next(0, cur)) return;
    f32x4 acc[2][2][4][2];
#pragma unroll
    for (int a = 0; a < 2; ++a)
#pragma unroll
        for (int b = 0; b < 2; ++b)
#pragma unroll
            for (int m = 0; m < 4; ++m)
#pragma unroll
                for (int n = 0; n < 2; ++n) acc[a][b][m][n] = (f32x4){0.f, 0.f, 0.f, 0.f};
    bf16x8 At[4][2], B0[2][2], B1[2][2];
    const char* cA = (const char*)g.A + (size_t)cur.pm * tstep; const char* cB = (const char*)g.Bt + (size_t)cur.pn * tstep;
    S.a_ready(cur);
    if constexpr (SP2) {
        PG8_STAGE(PG8_SB(0, 0), cB, voffB); PG8_STAGE(PG8_SB(0, 1), cB + hstep, voffB); PG8_STAGE(PG8_SA(0, 0), cA, voffA); PG8_STAGE(PG8_SA(0, 1), cA + hstep, voffA);
        if (wr == 1) PG8_BAR;
        PG8_WAIT_V(2); PG8_BAR;
        PG8_STAGE(PG8_SB(1, 0), cB + kstep, voffB); PG8_STAGE(PG8_SA(1, 0), cA + kstep, voffA); PG8_STAGE(PG8_SB(1, 1), cB + hstep + kstep, voffB);
        PG8_WAIT_V(6); PG8_BAR;
    } else {
        PG8_STAGE(PG8_SB(0, 0), cB, voffB); PG8_STAGE(PG8_SA(0, 0), cA, voffA); PG8_STAGE(PG8_SB(0, 1), cB + hstep, voffB); PG8_STAGE(PG8_SA(0, 1), cA + hstep, voffA);
        if (wr == 1) PG8_BAR;
        PG8_WAIT_V(4); PG8_BAR;
        PG8_STAGE(PG8_SB(1, 0), cB + kstep, voffB); PG8_STAGE(PG8_SA(1, 0), cA + kstep, voffA); PG8_STAGE(PG8_SB(1, 1), cB + hstep + kstep, voffB);
        PG8_WAIT_V(6); PG8_BAR;
    }
    for (;;) {
        const bool has_next = S.next(ui + 1, nxt);
        const char* nA = has_next ? (const char*)g.A + (size_t)nxt.pm * tstep : cA; const char* nB = has_next ? (const char*)g.Bt + (size_t)nxt.pn * tstep : cB;
        for (int t = 0; t < nt; t += 2) {
            const bool last = (t == nt - 2);
            const char* a1 = cA + (size_t)(t + 1) * kstep;
            const char* a2 = last ? nA : cA + (size_t)(t + 2) * kstep; const char* b2 = last ? nB : cB + (size_t)(t + 2) * kstep;
            const char* a3 = a2 + kstep; const char* b3 = b2 + kstep;
            if (last && has_next) S.a_ready(nxt);
            if constexpr (SP2) {
            PG8_LDB(B0, 0, 0); PG8_LDB(B1, 0, 1); PG8_SCHED; PG8_LDA(At, 0, 0); PG8_STAGE(PG8_SA(1, 1), a1 + hstep, voffA);
            PG8_WAIT_V(8); PG8_WAIT_L(0); PG8_BAR; PG8_MMA(0, 0, At, B0); PG8_MMA(0, 1, At, B1); PG8_BAR; PG8_SCHED;
            PG8_LDA(At, 0, 1); PG8_STAGE(PG8_SB(0, 0), b2, voffB); PG8_STAGE(PG8_SB(0, 1), b2 + hstep, voffB); PG8_STAGE(PG8_SA(0, 0), a2, voffA);
            PG8_WAIT_V(8); PG8_WAIT_L(0); PG8_BAR; PG8_MMA(1, 0, At, B0); PG8_MMA(1, 1, At, B1); PG8_BAR; PG8_SCHED;
            PG8_LDB(B0, 1, 0); PG8_LDB(B1, 1, 1); PG8_SCHED; PG8_LDA(At, 1, 0); PG8_STAGE(PG8_SA(0, 1), a2 + hstep, voffA);
            PG8_WAIT_V(8); PG8_WAIT_L(0); PG8_BAR; PG8_MMA(0, 0, At, B0); PG8_MMA(0, 1, At, B1); PG8_BAR; PG8_SCHED;
            PG8_LDA(At, 1, 1); PG8_STAGE(PG8_SB(1, 0), b3, voffB); PG8_STAGE(PG8_SB(1, 1), b3 + hstep, voffB); PG8_STAGE(PG8_SA(1, 0), a3, voffA);
            PG8_WAIT_V(8); PG8_WAIT_L(0); PG8_BAR; PG8_MMA(1, 0, At, B0); PG8_MMA(1, 1, At, B1); PG8_BAR; PG8_SCHED;
            } else {
            PG8_LDB(B0, 0, 0); PG8_SCHED; PG8_LDA(At, 0, 0); PG8_STAGE(PG8_SA(1, 1), a1 + hstep, voffA);
            PG8_WAIT_L(8); PG8_BAR; PG8_WAIT_L(0); PG8_MMA(0, 0, At, B0); PG8_BAR; PG8_SCHED;
            PG8_LDB(B1, 0, 1); PG8_STAGE(PG8_SB(0, 0), b2, voffB);
            PG8_BAR; PG8_WAIT_L(0); PG8_MMA(0, 1, At, B1); PG8_BAR;
            PG8_LDA(At, 0, 1); PG8_STAGE(PG8_SA(0, 0), a2, voffA);
            PG8_BAR; PG8_WAIT_L(0); PG8_MMA(1, 0, At, B0); PG8_BAR; PG8_SCHED;
            PG8_STAGE(PG8_SB(0, 1), b2 + hstep, voffB);
            PG8_WAIT_V(6); PG8_BAR; PG8_MMA(1, 1, At, B1); PG8_BAR;
            PG8_LDB(B0, 1, 0); PG8_SCHED; PG8_LDA(At, 1, 0); PG8_STAGE(PG8_SA(0, 1), a2 + hstep, voffA);
            PG8_WAIT_L(8); PG8_BAR; PG8_WAIT_L(0); PG8_MMA(0, 0, At, B0); PG8_BAR; PG8_SCHED;
            PG8_LDB(B1, 1, 1); PG8_STAGE(PG8_SB(1, 0), b3, voffB);
            PG8_BAR; PG8_WAIT_L(0); PG8_MMA(0, 1, At, B1); PG8_BAR;
            PG8_LDA(At, 1, 1); PG8_STAGE(PG8_SA(1, 0), a3, voffA);
            PG8_BAR; PG8_WAIT_L(0); PG8_MMA(1, 0, At, B0); PG8_BAR; PG8_SCHED;
            PG8_STAGE(PG8_SB(1, 1), b3 + hstep, voffB);
            PG8_WAIT_V(6); PG8_BAR; PG8_MMA(1, 1, At, B1); PG8_BAR;
            }
        }
        if constexpr (ALIGN_EPI) { if (wr == 0) PG8_BAR; }
        if constexpr (!Epi::AFTER_DRAIN) { E(acc, cur, wr, wc, fr, fq); S.done(cur); }
        if (!has_next) break;
#pragma unroll
        for (int a = 0; a < 2; ++a)
#pragma unroll
            for (int b = 0; b < 2; ++b)
#pragma unroll
                for (int m = 0; m < 4; ++m)
#pragma unroll
                    for (int n = 0; n < 2; ++n) acc[a][b][m][n] = (f32x4){0.f, 0.f, 0.f, 0.f};
        cur = nxt; cA = nA; cB = nB; ++ui;
        if constexpr (ALIGN_EPI) { if (wr == 1) PG8_BAR; }
    }
    PG8_WAIT_V(0);
    if constexpr (!ALIGN_EPI) { if (wr == 0) PG8_BAR; }
    PG8_BAR;
    if constexpr (Epi::AFTER_DRAIN) { E.fused(acc, cur, wr, wc, fr, fq, lds, wid, lane); S.done(cur); }
#undef PG8_SA
#undef PG8_SB
#undef PG8_STAGE
#undef PG8_LDA
#undef PG8_LDB
#undef PG8_MMA
#undef PG8_WAIT_V
#undef PG8_WAIT_L
#undef PG8_BAR
#undef PG8_SCHED
}
}

#define GAS __attribute__((address_space(1)))
#define LAS __attribute__((address_space(3)))
typedef unsigned short bf16;
typedef unsigned u32x4 __attribute__((ext_vector_type(4)));
typedef unsigned u32x2 __attribute__((ext_vector_type(2)));
typedef float f32x4 __attribute__((ext_vector_type(4)));
typedef float f32x2 __attribute__((ext_vector_type(2)));
typedef short bf16x8_t __attribute__((ext_vector_type(8)));

constexpr int NBATCH = 4, SEQ = 2048, TOK = NBATCH * SEQ, DM = 2048, DEPTH = 4;
constexpr int NIN = 16592, NINP = 16640;
constexpr int C_GQKV = 0, C_GZ = 3072, C_GB = 4096, C_GA = 4104, C_RF = 4112, C_RZ = 7376, C_SU = 8400, C_SZ = 9424, C_GATE = 10448;
constexpr int NWAVES = 8, NTHREADS = 512;
constexpr int LDS_BYTES = 147456;
constexpr int PH_PER_LAYER = 6, NPHASES = 2 + DEPTH * PH_PER_LAYER;

constexpr size_t MiB = 1u << 20;
constexpr size_t WS_WIN = 0, WS_WGLU = 260 * MiB, WS_WBR = 268 * MiB, WS_WOUT = 316 * MiB, WS_XN = 348 * MiB, WS_PROJ = 380 * MiB;
constexpr size_t WS_GQ = 640 * MiB, WS_GK = 672 * MiB, WS_GV = 704 * MiB, WS_GEG = 736 * MiB, WS_GBE = 737 * MiB, WS_GSC = 737 * MiB + 512 * 1024, WS_GO = 738 * MiB;
constexpr size_t WS_RR = 770 * MiB, WS_RW = 802 * MiB, WS_RK = 834 * MiB, WS_RV = 866 * MiB, WS_RKK = 898 * MiB, WS_RKA = 930 * MiB, WS_RBON = 962 * MiB, WS_RY = 963 * MiB;
constexpr size_t WS_SY = 995 * MiB, WS_OBR = 1011 * MiB, WS_ACCF = 1059 * MiB, WS_MRG = 1123 * MiB, WS_CTL = 1155 * MiB, WS_LORA = 1156 * MiB, WS_END = 1158 * MiB;
constexpr size_t CTL_SS = 65536, CTL_ZERO_BYTES = CTL_SS + (size_t)DEPTH * TOK * 8;
constexpr int MISC_OFF = 147392;
static_assert((size_t)DEPTH * NINP * DM * 2 == 260 * MiB && (size_t)TOK * NINP * 2 == 260 * MiB, "ws map");

__device__ __forceinline__ unsigned f2bf(float f) { unsigned u = __builtin_bit_cast(unsigned, f); return (u + 0x7fffu + ((u >> 16) & 1u)) >> 16; }
__device__ __forceinline__ unsigned pk2(float lo, float hi) { unsigned r; asm("v_cvt_pk_bf16_f32 %0, %1, %2" : "=v"(r) : "v"(lo), "v"(hi)); return r; }
__device__ __forceinline__ float bflo(unsigned w) { return __builtin_bit_cast(float, w << 16); }
__device__ __forceinline__ float bfhi(unsigned w) { return __builtin_bit_cast(float, w & 0xffff0000u); }
__device__ __forceinline__ float bf1(bf16 h) { return __builtin_bit_cast(float, (unsigned)h << 16); }
__device__ __forceinline__ float sigmoidf_(float x) { return __builtin_amdgcn_rcpf(1.f + __expf(-x)); }
__device__ __forceinline__ float siluf_(float x) { return x * __builtin_amdgcn_rcpf(1.f + __expf(-x)); }
__device__ __forceinline__ float softplusf_(float x) { return x > 20.f ? x : log1pf(expf(x)); }
__device__ __forceinline__ float gelu_tanh(float y) { const float t = 0.7978845608028654f * (y + 0.044715f * y * y * y); const float th = 1.f - 2.f * __builtin_amdgcn_rcpf(1.f + __expf(2.f * t)); return 0.5f * y * (1.f + th); }
template <int CTRL> __device__ __forceinline__ float dppf(float v) { return __builtin_bit_cast(float, __builtin_amdgcn_update_dpp(0, __builtin_bit_cast(int, v), CTRL, 0xF, 0xF, true)); }
__device__ __forceinline__ float allred8(float v) { v += dppf<0xB1>(v); v += dppf<0x4E>(v); v += dppf<0x141>(v); return v; }
__device__ __forceinline__ float allred16(float v) { v = allred8(v); v += dppf<0x140>(v); return v; }
__device__ __forceinline__ float wave_sum(float v) {
#pragma unroll
    for (int o = 1; o < 64; o <<= 1) v += __shfl_xor(v, o);
    return v;
}
__device__ __forceinline__ void unpack8(const u32x4 w, float (&f)[8]) { f[0] = bflo(w.x); f[1] = bfhi(w.x); f[2] = bflo(w.y); f[3] = bfhi(w.y); f[4] = bflo(w.z); f[5] = bfhi(w.z); f[6] = bflo(w.w); f[7] = bfhi(w.w); }
__device__ __forceinline__ u32x4 pack8(const float (&f)[8]) { u32x4 w; w.x = pk2(f[0], f[1]); w.y = pk2(f[2], f[3]); w.z = pk2(f[4], f[5]); w.w = pk2(f[6], f[7]); return w; }

namespace pg8 {
struct EpiGlu {
    static constexpr bool PERM = true, AFTER_DRAIN = false;
    const bf16* Y1; const bf16* PROJ; const float* bias; bf16* O;
    __device__ __forceinline__ void operator()(const f32x4 (&acc)[2][2][4][2], const Unit& u, int wr, int wc, int fr, int fq) const {
        int row0 = u.pm * BM + wr * 64 + fr, col0 = u.pn * BM + wc * 32 + 8 * fq;
        asm volatile("" : "+v"(row0), "+v"(col0));
        f32x4 bb[2][2];
#pragma unroll
        for (int bj = 0; bj < 2; ++bj) { bb[bj][0] = *(const f32x4*)(bias + col0 + bj * HALF); bb[bj][1] = *(const f32x4*)(bias + col0 + bj * HALF + 4); }
        u32x4 yc = *(const u32x4*)(Y1 + (size_t)row0 * 1024 + col0), zc = *(const u32x4*)(PROJ + (size_t)row0 * NINP + C_SZ + col0);
#pragma unroll
        for (int it = 0; it < 16; ++it) {
            const int bj = it >> 3, ai = (it >> 2) & 1, m = it & 3;
            const size_t row = (size_t)(row0 + ai * HALF + m * 16); const int col = col0 + bj * HALF;
            u32x4 yn = yc, zn = zc;
            if (it + 1 < 16) { const int nb = (it + 1) >> 3, na = ((it + 1) >> 2) & 1, nm = (it + 1) & 3; const size_t nrow = (size_t)(row0 + na * HALF + nm * 16); const int ncol = col0 + nb * HALF;
                yn = *(const u32x4*)(Y1 + nrow * 1024 + ncol); zn = *(const u32x4*)(PROJ + nrow * NINP + C_SZ + ncol); }
            float y[8], z[8], o[8]; unpack8(yc, y); unpack8(zc, z);
            const f32x4 v0 = acc[ai][bj][m][0] + bb[bj][0], v1 = acc[ai][bj][m][1] + bb[bj][1];
            const float a[8] = {v0[0], v0[1], v0[2], v0[3], v1[0], v1[1], v1[2], v1[3]};
#pragma unroll
            for (int e = 0; e < 8; ++e) o[e] = y[e] * sigmoidf_(a[e]) * siluf_(z[e]);
            *(u32x4*)(O + row * 1024 + col) = pack8(o);
            yc = yn; zc = zn;
            asm volatile("" ::: "memory");
        }
    }
};
struct EpiBranch {
    static constexpr bool PERM = true, AFTER_DRAIN = false;
    const bf16* PROJ; const float* gate_b; bf16* ACC; bf16* MRG;
    __device__ __forceinline__ void operator()(const f32x4 (&acc)[2][2][4][2], const Unit& u, int wr, int wc, int fr, int fq) const {
        const int br = u.pm >> 5, pm = u.pm & 31, pn = u.pn & 7;
        int row0 = pm * BM + wr * 64 + fr, col0 = pn * BM + wc * 32 + 8 * fq;
        asm volatile("" : "+v"(row0), "+v"(col0));
        bf16* dst = br < 2 ? ACC : MRG;
        const bf16* gl = PROJ + C_GATE + br * DM;
        f32x4 gb[2][2];
#pragma unroll
        for (int bj = 0; bj < 2; ++bj) { gb[bj][0] = *(const f32x4*)(gate_b + br * DM + col0 + bj * HALF); gb[bj][1] = *(const f32x4*)(gate_b + br * DM + col0 + bj * HALF + 4); }
        const u32x4 zero = {0u, 0u, 0u, 0u};
        u32x4 lc = *(const u32x4*)(gl + (size_t)row0 * NINP + col0), pc = br > 0 ? *(const u32x4*)(ACC + (size_t)row0 * DM + col0) : zero;
#pragma unroll
        for (int it = 0; it < 16; ++it) {
            const int bj = it >> 3, ai = (it >> 2) & 1, m = it & 3;
            const size_t row = (size_t)(row0 + ai * HALF + m * 16); const int col = col0 + bj * HALF;
            u32x4 ln = lc, pn_ = pc;
            if (it + 1 < 16) { const int nb = (it + 1) >> 3, na = ((it + 1) >> 2) & 1, nm = (it + 1) & 3; const size_t nrow = (size_t)(row0 + na * HALF + nm * 16); const int ncol = col0 + nb * HALF;
                ln = *(const u32x4*)(gl + nrow * NINP + ncol); pn_ = br > 0 ? *(const u32x4*)(ACC + nrow * DM + ncol) : zero; }
            float g[8], p[8], o[8]; unpack8(lc, g); unpack8(pc, p);
            const f32x4 v0 = acc[ai][bj][m][0], v1 = acc[ai][bj][m][1];
            const float a[8] = {v0[0], v0[1], v0[2], v0[3], v1[0], v1[1], v1[2], v1[3]};
            const float gbv[8] = {gb[bj][0][0], gb[bj][0][1], gb[bj][0][2], gb[bj][0][3], gb[bj][1][0], gb[bj][1][1], gb[bj][1][2], gb[bj][1][3]};
#pragma unroll
            for (int e = 0; e < 8; ++e) o[e] = sigmoidf_(g[e] + gbv[e]) * a[e] + p[e];
            *(u32x4*)(dst + row * DM + col) = pack8(o);
            lc = ln; pc = pn_;
            asm volatile("" ::: "memory");
        }
    }
};
struct EpiResid {
    static constexpr bool PERM = true, AFTER_DRAIN = false;
    const float* base; float* out; bf16* xn; const float* nw; unsigned long long* ss;
    __device__ __forceinline__ void operator()(const f32x4 (&acc)[2][2][4][2], const Unit& u, int wr, int wc, int fr, int fq) const {
        int row0 = u.pm * BM + wr * 64 + fr, col0 = u.pn * BM + wc * 32 + 8 * fq;
        asm volatile("" : "+v"(row0), "+v"(col0));
        f32x4 ww[2][2];
#pragma unroll
        for (int bj = 0; bj < 2; ++bj) { ww[bj][0] = *(const f32x4*)(nw + col0 + bj * HALF); ww[bj][1] = *(const f32x4*)(nw + col0 + bj * HALF + 4); }
        f32x4 bc[2][2];
#pragma unroll
        for (int bj = 0; bj < 2; ++bj) { const size_t off = (size_t)row0 * DM + col0 + bj * HALF; bc[bj][0] = *(const f32x4*)(base + off); bc[bj][1] = *(const f32x4*)(base + off + 4); }
#pragma unroll
        for (int it = 0; it < 8; ++it) {
            const int ai = it >> 2, m = it & 3; const int row = row0 + ai * HALF + m * 16;
            f32x4 bn[2][2];
#pragma unroll
            for (int bj = 0; bj < 2; ++bj) { bn[bj][0] = bc[bj][0]; bn[bj][1] = bc[bj][1]; }
            if (it + 1 < 8) { const int nrow = row0 + ((it + 1) >> 2) * HALF + ((it + 1) & 3) * 16;
#pragma unroll
                for (int bj = 0; bj < 2; ++bj) { const size_t off = (size_t)nrow * DM + col0 + bj * HALF; bn[bj][0] = *(const f32x4*)(base + off); bn[bj][1] = *(const f32x4*)(base + off + 4); } }
            float sq = 0.f;
#pragma unroll
            for (int bj = 0; bj < 2; ++bj) {
                const size_t off = (size_t)row * DM + col0 + bj * HALF;
                const f32x4 o0 = bc[bj][0] + acc[ai][bj][m][0], o1 = bc[bj][1] + acc[ai][bj][m][1];
                *(f32x4*)(out + off) = o0; *(f32x4*)(out + off + 4) = o1;
                if (xn) { const f32x4 w0 = ww[bj][0], w1 = ww[bj][1];
                    sq += (o0.x * o0.x + o0.y * o0.y) + (o0.z * o0.z + o0.w * o0.w) + (o1.x * o1.x + o1.y * o1.y) + (o1.z * o1.z + o1.w * o1.w);
                    u32x4 p; p.x = pk2(o0.x * w0.x, o0.y * w0.y); p.y = pk2(o0.z * w0.z, o0.w * w0.w); p.z = pk2(o1.x * w1.x, o1.y * w1.y); p.w = pk2(o1.z * w1.z, o1.w * w1.w);
                    *(u32x4*)(xn + off) = p; }
            }
            if (xn) { sq += __shfl_xor(sq, 16); sq += __shfl_xor(sq, 32); if (fq == 0) atomicAdd(ss + row, (unsigned long long)(sq * 65536.f + 0.5f)); }
#pragma unroll
            for (int bj = 0; bj < 2; ++bj) { bc[bj][0] = bn[bj][0]; bc[bj][1] = bn[bj][1]; }
            asm volatile("" ::: "memory");
        }
    }
};
struct EpiBf16Rs {
    static constexpr bool PERM = true, AFTER_DRAIN = false;
    bf16* O; int ldc; const unsigned long long* ss;
    __device__ __forceinline__ void operator()(const f32x4 (&acc)[2][2][4][2], const Unit& u, int wr, int wc, int fr, int fq) const {
        int row0 = u.pm * BM + wr * 64 + fr, col0 = u.pn * BM + wc * 32 + 8 * fq;
        asm volatile("" : "+v"(row0), "+v"(col0));
#pragma unroll
        for (int ai = 0; ai < 2; ++ai)
#pragma unroll
            for (int m = 0; m < 4; ++m) { const int row = row0 + ai * HALF + m * 16; const float rs = 1.f / sqrtf((float)ss[row] * (1.f / (65536.f * DM)) + 1e-6f);
                bf16* rowp = O + (size_t)row * ldc + col0;
#pragma unroll
                for (int bj = 0; bj < 2; ++bj) { const f32x4 v0 = acc[ai][bj][m][0] * rs, v1 = acc[ai][bj][m][1] * rs;
                    u32x4 w; w.x = cvt_pk_bf16(v0[0], v0[1]); w.y = cvt_pk_bf16(v0[2], v0[3]); w.z = cvt_pk_bf16(v1[0], v1[1]); w.w = cvt_pk_bf16(v1[2], v1[3]);
                    *(u32x4*)(rowp + bj * HALF) = w; } }
    }
};
struct BranchOrder {
    StaticOrder base;
    __device__ bool next(int i, Unit& u) const { Unit t; const int r = i / 3, br = i - 3 * r; if (!base.next(r, t)) return false; u.pm = br * 32 + t.pm; u.pn = br * 8 + t.pn; return true; }
    __device__ __forceinline__ void a_ready(const Unit&) const {}
    __device__ __forceinline__ void done(const Unit&) const {}
};
}

#define XB_TMO      128
#define XB_XCNT(j)  (256  + 64 * (j))
#define XB_XSUB(j)  (1280 + 64 * (j))
#define XB_XGEN(j)  (2304 + 64 * (j))
#define XB_TOP      3328
#define XB_TOPGEN   3392
#define XCD_BAR_WORDS 3456
#define XB_SPIN_CAP (1u << 18)

__device__ __forceinline__ unsigned xb_ld(unsigned* p)              { return __hip_atomic_load(p, __ATOMIC_RELAXED, __HIP_MEMORY_SCOPE_AGENT); }
__device__ __forceinline__ unsigned xb_add(unsigned* p, unsigned v) { return __hip_atomic_fetch_add(p, v, __ATOMIC_RELAXED, __HIP_MEMORY_SCOPE_AGENT); }
__device__ __forceinline__ unsigned xb_xcc_id() { return (unsigned)__builtin_amdgcn_s_getreg((3 << 11) | 20) & 0xFu; }
#define XB_SPIN(cond, bar) do { unsigned _sp = 0; while (cond) { __builtin_amdgcn_s_sleep(1); \
    if ((++_sp & 255u) == 0u) { if (xb_ld(&(bar)[XB_TMO])) break; if (_sp > XB_SPIN_CAP) { atomicAdd(&(bar)[XB_TMO], 1u); break; } } } } while (0)

struct XcdBarrier {
    unsigned* bar; unsigned x;
    volatile LAS unsigned* st;
};

__device__ __forceinline__ XcdBarrier xcd_barrier_post(unsigned* bar, volatile LAS unsigned* st) {
    XcdBarrier b; b.bar = bar; b.x = xb_xcc_id(); b.st = st;
    if (threadIdx.x == 0) (void)xb_add(&bar[XB_XCNT(b.x)], 1u);
    return b;
}
__device__ __forceinline__ void xcd_barrier_complete(unsigned* bar, unsigned x, unsigned& nloc, unsigned& nx) {
    const unsigned G = gridDim.x * gridDim.y * gridDim.z;
    unsigned sum, cnt, mine, sp = 0u;
    for (;;) {
        sum = 0u; cnt = 0u; mine = 0u;
#pragma unroll
        for (unsigned j = 0; j < 16; ++j) { const unsigned c = xb_ld(&bar[XB_XCNT(j)]); sum += c; cnt += (c > 0u) ? 1u : 0u; mine = (j == x) ? c : mine; }
        if (sum == G) break;
        __builtin_amdgcn_s_sleep(1);
        if ((++sp & 255u) == 0u) { if (xb_ld(&bar[XB_TMO])) break; if (sp > XB_SPIN_CAP) { atomicAdd(&bar[XB_TMO], 1u); break; } }
    }
    nloc = mine > 0u ? mine : 1u; nx = cnt > 0u ? cnt : 1u;
}

__device__ __forceinline__ void xcd_barrier(const XcdBarrier& b) {
    asm volatile("s_waitcnt vmcnt(0)" ::: "memory");
    __syncthreads();
    if (threadIdx.x == 0) {
        unsigned* bar = b.bar;
        __builtin_amdgcn_s_waitcnt(0);
        unsigned nloc = b.st[0], nx = b.st[1];
        if (nloc == 0u) { xcd_barrier_complete(bar, b.x, nloc, nx); b.st[0] = nloc; b.st[1] = nx; }
        const unsigned old = xb_add(&bar[XB_XSUB(b.x)], 1u);
        const unsigned gen = old / nloc;
        if (old + 1u == (gen + 1u) * nloc) {
            __builtin_amdgcn_fence(__ATOMIC_RELEASE, "agent");
            asm volatile("s_waitcnt vmcnt(0)" ::: "memory");
            const unsigned og = xb_add(&bar[XB_TOP], 1u);
            const unsigned tg = og / nx;
            if (og + 1u == (tg + 1u) * nx) xb_add(&bar[XB_TOPGEN], 1u);
            else XB_SPIN(xb_ld(&bar[XB_TOPGEN]) == tg, bar);
            __builtin_amdgcn_fence(__ATOMIC_ACQUIRE, "agent");
            xb_add(&bar[XB_XGEN(b.x)], 1u);
            asm volatile("s_waitcnt vmcnt(0)" ::: "memory");
        } else {
            XB_SPIN(xb_ld(&bar[XB_XGEN(b.x)]) == gen, bar);
            __builtin_amdgcn_fence(__ATOMIC_ACQUIRE, "agent");
            asm volatile("s_waitcnt vmcnt(0)" ::: "memory");
        }
    }
    __syncthreads();
}

struct Args { const float* in[31]; float* out; unsigned char* ws; int ph_lo, ph_hi; };
struct Ctx { int tid, lane, wave, vcu, G, gw, NGW; LAS unsigned char* lds; unsigned char* ws; };

__device__ __forceinline__ void transpose_item(const float* W, int K, int N, bf16* WT, LAS float* scr, int kb, int nb, int lane) {
    const int k0 = 64 * kb, n0 = 64 * nb, nq = 4 * (lane & 15), kr = lane >> 4; const bool nv = n0 + nq < N;
    f32x4 v[16];
#pragma unroll
    for (int i = 0; i < 16; ++i) v[i] = nv ? __builtin_nontemporal_load((const f32x4*)(W + (size_t)(k0 + 4 * i + kr) * N + n0 + nq)) : (f32x4){0.f, 0.f, 0.f, 0.f};
#pragma unroll
    for (int i = 0; i < 16; ++i) { LAS float* d = scr + (4 * i + kr) * 65 + nq; d[0] = v[i].x; d[1] = v[i].y; d[2] = v[i].z; d[3] = v[i].w; }
    asm volatile("s_waitcnt lgkmcnt(0)" ::: "memory");
    const int c = lane & 7;
#pragma unroll
    for (int j = 0; j < 8; ++j) { const int nn = (lane >> 3) + 8 * j; const LAS float* s = scr + (8 * c) * 65 + nn;
        u32x4 o; o.x = pk2(s[0 * 65], s[1 * 65]); o.y = pk2(s[2 * 65], s[3 * 65]); o.z = pk2(s[4 * 65], s[5 * 65]); o.w = pk2(s[6 * 65], s[7 * 65]);
        __builtin_nontemporal_store(o, (u32x4*)(WT + (size_t)(n0 + nn) * K + k0 + 8 * c)); }
    asm volatile("s_waitcnt lgkmcnt(0)" ::: "memory");
}

__device__ __forceinline__ void rms_row(const float* xrow, const float* w, bf16* obf, unsigned long long* ss, float* of32, int lane) {
    f32x4 v[8]; float s = 0.f;
#pragma unroll
    for (int j = 0; j < 8; ++j) { v[j] = *(const f32x4*)(xrow + 4 * lane + 256 * j); s += (v[j].x * v[j].x + v[j].y * v[j].y) + (v[j].z * v[j].z + v[j].w * v[j].w); }
    s = wave_sum(s);
    const float r = obf ? 1.f : 1.f / sqrtf(s * (1.f / DM) + 1e-6f);
#pragma unroll
    for (int j = 0; j < 8; ++j) { const f32x4 ww = *(const f32x4*)(w + 4 * lane + 256 * j); const f32x4 o = v[j] * r * ww;
        if (obf) { u32x2 p; p.x = pk2(o.x, o.y); p.y = pk2(o.z, o.w); *(u32x2*)(obf + 4 * lane + 256 * j) = p; }
        else *(f32x4*)(of32 + 4 * lane + 256 * j) = o; }
    if (obf && lane == 0) *ss = (unsigned long long)(s * 65536.f + 0.5f);
}

__device__ __forceinline__ void convert_layer(const Ctx& F, const Args& a, int l, int gw, int ngw) {
    LAS float* scr = (LAS float*)(F.lds + F.wave * 16640);
    constexpr int I_IN = 32 * 260, I_GLU = 16 * 16, I_BR = 16 * 32, I_OUT = 32 * 32, IL = I_IN + I_GLU + 3 * I_BR + I_OUT;
    bf16* WIN = (bf16*)(F.ws + WS_WIN); bf16* WGLU = (bf16*)(F.ws + WS_WGLU); bf16* WBR = (bf16*)(F.ws + WS_WBR); bf16* WOUT = (bf16*)(F.ws + WS_WOUT);
    for (int it = gw; it < IL; it += ngw) {
        int r = it;
        if (r < I_IN) { transpose_item(a.in[2] + (size_t)l * DM * NIN, DM, NIN, WIN + (size_t)l * NINP * DM, scr, r / 260, r % 260, F.lane); continue; } r -= I_IN;
        if (r < I_GLU) { transpose_item(a.in[25] + (size_t)l * 1024 * 1024, 1024, 1024, WGLU + (size_t)l * 1024 * 1024, scr, r / 16, r % 16, F.lane); continue; } r -= I_GLU;
        if (r < 3 * I_BR) { const int br = r / I_BR, r2 = r - br * I_BR;
            transpose_item(a.in[28] + (size_t)(l * 3 + br) * 1024 * DM, 1024, DM, WBR + (size_t)(l * 3 + br) * DM * 1024, scr, r2 / 32, r2 % 32, F.lane); continue; } r -= 3 * I_BR;
        transpose_item(a.in[29] + (size_t)l * DM * DM, DM, DM, WOUT + (size_t)l * DM * DM, scr, r / 32, r % 32, F.lane);
    }
}

__device__ __forceinline__ void phase0(const Ctx& F, const Args& a) {
    convert_layer(F, a, 0, F.gw, F.NGW);
    {
        bf16* LT = (bf16*)(F.ws + WS_LORA);
        for (int it = F.gw * 64 + F.lane; it < DEPTH * 2 * 1024 * 12; it += F.NGW * 64) {
            const int kg = it % 12, n = (it / 12) & 1023, lw = it / (12 * 1024), l = lw >> 1, which = lw & 1;
            const float* src = (which ? a.in[11] : a.in[9]) + (size_t)l * 96 * 1024 + (size_t)(8 * kg) * 1024 + n;
            u32x4 o; o.x = pk2(src[0], src[1024]); o.y = pk2(src[2048], src[3072]); o.z = pk2(src[4096], src[5120]); o.w = pk2(src[6144], src[7168]);
            *(u32x4*)(LT + ((size_t)lw * 1024 + n) * 96 + 8 * kg) = o;
        }
    }
    bf16* XN = (bf16*)(F.ws + WS_XN);
    unsigned long long* SS0 = (unsigned long long*)(F.ws + WS_CTL + CTL_SS);
    for (int m = F.gw; m < TOK; m += F.NGW) rms_row(a.in[0] + (size_t)m * DM, a.in[1], XN + (size_t)m * DM, SS0 + m, nullptr, F.lane);
}

__device__ __forceinline__ void prep_gdn(const Ctx& F, const Args& a, int l) {
    const bf16* PROJ = (const bf16*)(F.ws + WS_PROJ);
    float* GQ = (float*)(F.ws + WS_GQ); float* GK = (float*)(F.ws + WS_GK); float* GV = (float*)(F.ws + WS_GV); float* GEG = (float*)(F.ws + WS_GEG); float* GBE = (float*)(F.ws + WS_GBE); f32x4* GSC = (f32x4*)(F.ws + WS_GSC);
    const float* cw = a.in[3] + (size_t)l * 4 * 3072;
    for (int it = F.gw; it < 2048; it += F.NGW) {
        const int h = it & 7, ch = (it >> 3) & 63, b = it >> 9;
        const int t0 = ch * 32; const int c = 2 * F.lane;
        float w[3][4][2], hist[3][3][2];
#pragma unroll
        for (int p = 0; p < 3; ++p)
#pragma unroll
            for (int j = 0; j < 4; ++j) { const f32x2 ww = *(const f32x2*)(cw + j * 3072 + p * 1024 + h * 128 + c); w[p][j][0] = ww.x; w[p][j][1] = ww.y; }
#pragma unroll
        for (int p = 0; p < 3; ++p)
#pragma unroll
            for (int j = 0; j < 3; ++j) { const int t = t0 - 3 + j; unsigned x = 0u;
                if (t >= 0) x = *(const unsigned*)(PROJ + (size_t)(b * SEQ + t) * NINP + C_GQKV + p * 1024 + h * 128 + c);
                hist[p][j][0] = bflo(x); hist[p][j][1] = bfhi(x); }
        const float alog = a.in[4][l * 8 + h], dtb = a.in[5][l * 8 + h]; const float aexp = expf(alog);
        float kp0 = 0.f, kp1 = 0.f, qkprev = 0.f;
        unsigned raw[3][32];
#pragma unroll
        for (int tt = 0; tt < 32; ++tt)
#pragma unroll
            for (int p = 0; p < 3; ++p) raw[p][tt] = *(const unsigned*)(PROJ + (size_t)(b * SEQ + t0 + tt) * NINP + C_GQKV + p * 1024 + h * 128 + c);
#pragma unroll
        for (int tt = 0; tt < 32; ++tt) {
            const size_t tok = (size_t)(b * SEQ + t0 + tt);
            float o[3][2];
#pragma unroll
            for (int p = 0; p < 3; ++p) {
                const unsigned x = raw[p][tt];
                const float x0 = bflo(x), x1 = bfhi(x);
                const float y0 = w[p][0][0] * hist[p][0][0] + w[p][1][0] * hist[p][1][0] + w[p][2][0] * hist[p][2][0] + w[p][3][0] * x0;
                const float y1 = w[p][0][1] * hist[p][0][1] + w[p][1][1] * hist[p][1][1] + w[p][2][1] * hist[p][2][1] + w[p][3][1] * x1;
                hist[p][0][0] = hist[p][1][0]; hist[p][1][0] = hist[p][2][0]; hist[p][2][0] = x0;
                hist[p][0][1] = hist[p][1][1]; hist[p][1][1] = hist[p][2][1]; hist[p][2][1] = x1;
                o[p][0] = siluf_(y0); o[p][1] = siluf_(y1);
            }
            const float sq = wave_sum(o[0][0] * o[0][0] + o[0][1] * o[0][1]), sk = wave_sum(o[1][0] * o[1][0] + o[1][1] * o[1][1]);
            const float rq = 0.08838834764831845f * rsqrtf(sq + 1e-6f), rk = rsqrtf(sk + 1e-6f);
            const size_t off = tok * 1024 + h * 128 + c;
            const unsigned qp = pk2(o[0][0] * rq, o[0][1] * rq), kp = pk2(o[1][0] * rk, o[1][1] * rk);
            *(unsigned*)((bf16*)GQ + off) = qp;
            *(unsigned*)((bf16*)GK + off) = kp;
            *(unsigned*)((bf16*)GV + off) = pk2(o[2][0], o[2][1]);
            {
                const float qn0 = bflo(qp), qn1 = bfhi(qp), kn0 = bflo(kp), kn1 = bfhi(kp);
                const float qk = wave_sum(qn0 * kn0 + qn1 * kn1);
                if (tt & 1) { const float kk = wave_sum(kp0 * kn0 + kp1 * kn1), qkp = wave_sum(qn0 * kp0 + qn1 * kp1);
                    if (F.lane == 0) GSC[(tok >> 1) * 8 + h] = (f32x4){kk, qkprev, qkp, qk}; }
                else { kp0 = kn0; kp1 = kn1; qkprev = qk; }
            }
            if (F.lane == 0) {
                const float bl = bf1(PROJ[tok * NINP + C_GB + h]), al = bf1(PROJ[tok * NINP + C_GA + h]);
                GBE[tok * 8 + h] = sigmoidf_(bl);
                GEG[tok * 8 + h] = expf(-aexp * softplusf_(al + dtb));
            }
        }
    }
}

__device__ __forceinline__ float mix2(unsigned c, unsigned p, float mu0, float mu1, float& o1) {
    const float c0 = bflo(c), c1 = bfhi(c), p0 = bflo(p), p1 = bfhi(p);
    o1 = c1 + (p1 - c1) * mu1; return c0 + (p0 - c0) * mu0;
}
__device__ __forceinline__ void prep_rwkv(const Ctx& F, const Args& a, int l) {
    const bf16* PROJ = (const bf16*)(F.ws + WS_PROJ);
    float* RR = (float*)(F.ws + WS_RR); float* RW = (float*)(F.ws + WS_RW); float* RK = (float*)(F.ws + WS_RK); float* RV = (float*)(F.ws + WS_RV);
    float* RKK = (float*)(F.ws + WS_RKK); float* RKA = (float*)(F.ws + WS_RKA); float* RBON = (float*)(F.ws + WS_RBON);
    const float* mu = a.in[7] + (size_t)l * 3264; const float* w0 = a.in[8] + l * 1024; const float* wup = a.in[9] + (size_t)l * 96 * 1024;
    const float* a0 = a.in[10] + l * 1024; const float* aup = a.in[11] + (size_t)l * 96 * 1024; const float* kk_ = a.in[12] + l * 1024; const float* ka_ = a.in[13] + l * 1024; const float* rk_ = a.in[14] + l * 1024;
    constexpr int AROW = 104;
    LAS bf16* A1 = (LAS bf16*)F.lds; LAS bf16* A2 = A1 + 16 * AROW;
    LAS float* LW = (LAS float*)(F.lds + 8192); LAS float* LA = LW + 16 * 1024;
    const bf16* LTw = (const bf16*)(F.ws + WS_LORA) + (size_t)(2 * l) * 1024 * 96; const bf16* LTa = LTw + 1024 * 96;
    const int j = F.tid, c = 2 * j;
    const f32x2 mur = *(const f32x2*)(mu + c), muk = *(const f32x2*)(mu + 1024 + c), muv = *(const f32x2*)(mu + 2048 + c);
    const f32x2 w0v = *(const f32x2*)(w0 + c), a0v = *(const f32x2*)(a0 + c), kkv = *(const f32x2*)(kk_ + c), kav = *(const f32x2*)(ka_ + c), rkv = *(const f32x2*)(rk_ + c);
    for (int tile = F.vcu; tile < TOK / 16; tile += F.G) {
        __syncthreads();
        for (int e = F.tid; e < 16 * 192; e += NTHREADS) {
            const int tl = e / 192, i = e - tl * 192; const size_t tok = (size_t)tile * 16 + tl;
            const float cur = bf1(PROJ[tok * NINP + C_RF + 3072 + i]);
            const float prv = (tok & (SEQ - 1)) ? bf1(PROJ[(tok - 1) * NINP + C_RF + 3072 + i]) : 0.f;
            const float m = cur + (prv - cur) * mu[3072 + i];
            if (i < 96) A1[tl * AROW + i] = (bf16)f2bf(tanhf(m)); else A2[tl * AROW + i - 96] = (bf16)f2bf(m);
        }
        __syncthreads();
        {
            const int row = F.lane & 15, quad = F.lane >> 4;
            bf16x8_t fw[3], fa[3];
#pragma unroll
            for (int ks = 0; ks < 3; ++ks) { fw[ks] = *(const LAS bf16x8_t*)(A1 + row * AROW + 32 * ks + 8 * quad); fa[ks] = *(const LAS bf16x8_t*)(A2 + row * AROW + 32 * ks + 8 * quad); }
#pragma unroll 2
            for (int nt = 0; nt < 8; ++nt) {
                const int n = 128 * F.wave + 16 * nt + row;
                f32x4 aw = {0.f, 0.f, 0.f, 0.f}, aa = {0.f, 0.f, 0.f, 0.f};
#pragma unroll
                for (int ks = 0; ks < 3; ++ks) {
                    const bf16x8_t bw = *(const bf16x8_t*)(LTw + (size_t)n * 96 + 32 * ks + 8 * quad), ba = *(const bf16x8_t*)(LTa + (size_t)n * 96 + 32 * ks + 8 * quad);
                    aw = __builtin_amdgcn_mfma_f32_16x16x32_bf16(fw[ks], bw, aw, 0, 0, 0); aa = __builtin_amdgcn_mfma_f32_16x16x32_bf16(fa[ks], ba, aa, 0, 0, 0);
                    asm volatile("" :: "v"(bw), "v"(ba));
                }
#pragma unroll
                for (int r = 0; r < 4; ++r) { LW[(4 * quad + r) * 1024 + n] = aw[r]; LA[(4 * quad + r) * 1024 + n] = aa[r]; }
            }
        }
        __syncthreads();
        unsigned rw[17][3];
#pragma unroll
        for (int tl = 0; tl < 17; ++tl) { const size_t tok = (size_t)tile * 16 + tl - 1; const bool ok = tl > 0 || ((tok + 1) & (SEQ - 1)) != 0;
            const bf16* cp = PROJ + tok * NINP + C_RF + c;
#pragma unroll
            for (int q = 0; q < 3; ++q) rw[tl][q] = ok ? *(const unsigned*)(cp + 1024 * q) : 0u; }
#pragma unroll
        for (int tl = 0; tl < 16; ++tl) {
            const size_t tok = (size_t)tile * 16 + tl; const bool hp = (tok & (SEQ - 1)) != 0;
            const unsigned cr = rw[tl + 1][0], ck = rw[tl + 1][1], cv = rw[tl + 1][2];
            const unsigned pr = hp ? rw[tl][0] : 0u, pk = hp ? rw[tl][1] : 0u, pv = hp ? rw[tl][2] : 0u;
            float r1, k1, v1; const float r0 = mix2(cr, pr, mur.x, mur.y, r1), k0 = mix2(ck, pk, muk.x, muk.y, k1), v0 = mix2(cv, pv, muv.x, muv.y, v1);
            const f32x2 lw = *(const LAS f32x2*)(LW + tl * 1024 + c), la = *(const LAS f32x2*)(LA + tl * 1024 + c);
            const float wp0 = w0v.x + lw.x, wp1 = w0v.y + lw.y;
            const float d0 = __expf(-0.6065306597126334f * sigmoidf_(wp0)), d1 = __expf(-0.6065306597126334f * sigmoidf_(wp1));
            const float aa0 = sigmoidf_(a0v.x + la.x), aa1 = sigmoidf_(a0v.y + la.y);
            const float q0 = k0 * kkv.x, q1 = k1 * kkv.y;
            float ss = q0 * q0 + q1 * q1;
#pragma unroll
            for (int o = 1; o < 32; o <<= 1) ss += __shfl_xor(ss, o);
            const float rn = rsqrtf(ss + 1e-6f); const float n0 = q0 * rn, n1 = q1 * rn;
            const float km0 = k0 * (1.f + (aa0 - 1.f) * kav.x), km1 = k1 * (1.f + (aa1 - 1.f) * kav.y);
            float bo = r0 * km0 * rkv.x + r1 * km1 * rkv.y;
#pragma unroll
            for (int o = 1; o < 32; o <<= 1) bo += __shfl_xor(bo, o);
            const size_t off = tok * 1024 + c;
            *(unsigned*)((bf16*)RR + off) = pk2(r0, r1); *(f32x2*)(RW + off) = (f32x2){d0, d1}; *(unsigned*)((bf16*)RK + off) = pk2(km0, km1); *(unsigned*)((bf16*)RV + off) = pk2(v0, v1);
            *(f32x2*)(RKK + off) = (f32x2){-n0, -n1}; *(unsigned*)((bf16*)RKA + off) = pk2(n0 * aa0, n1 * aa1);
            if ((F.lane & 31) == 0) RBON[tok * 16 + (c >> 6)] = bo;
        }
    }
}

#ifndef SCM
#define SCM 7
#endif
#ifndef REPM
#define REPM 0
#endif
constexpr int CH = 32;
#define WFENCE() do { __builtin_amdgcn_fence(__ATOMIC_RELEASE, "wavefront"); asm volatile("s_waitcnt lgkmcnt(0)" ::: "memory"); __builtin_amdgcn_wave_barrier(); __builtin_amdgcn_fence(__ATOMIC_ACQUIRE, "wavefront"); } while (0)

struct GPair { f32x4 k1a, k1b, k2a, k2b, q1a, q1b, q2a, q2b, eb, sc; float v1, v2; };
constexpr int G_BUF = 2 * CH * 128 + CH * 32 + 4 * CH;
__device__ __forceinline__ void gdn_lds(GPair& s, const LAS float* buf, int pr, int rg, int colL) {
    const LAS float* kp = buf + 2 * pr * 128 + rg * 4; const LAS float* qp = kp + CH * 128;
    s.k1a = *(const LAS f32x4*)kp; s.k1b = *(const LAS f32x4*)(kp + 64); s.k2a = *(const LAS f32x4*)(kp + 128); s.k2b = *(const LAS f32x4*)(kp + 192);
    s.q1a = *(const LAS f32x4*)qp; s.q1b = *(const LAS f32x4*)(qp + 64); s.q2a = *(const LAS f32x4*)(qp + 128); s.q2b = *(const LAS f32x4*)(qp + 192);
    s.v1 = buf[2 * CH * 128 + 2 * pr * 32 + colL]; s.v2 = buf[2 * CH * 128 + (2 * pr + 1) * 32 + colL];
    s.eb = *(const LAS f32x4*)(buf + 2 * CH * 128 + CH * 32 + 4 * pr); s.sc = *(const LAS f32x4*)(buf + 2 * CH * 128 + CH * 32 + 2 * CH + 4 * pr);
}
__device__ __forceinline__ float dot8(const f32x4 a, const f32x4 b, const f32x2 (&S)[4]) { const f32x2 t = (a.xy * S[0] + a.zw * S[1]) + (b.xy * S[2] + b.zw * S[3]); return t.x + t.y; }
#define DPP4(CTRL) do { d1 += dppf<CTRL>(d1); d2 += dppf<CTRL>(d2); e1 += dppf<CTRL>(e1); e2 += dppf<CTRL>(e2); } while (0)
__device__ __forceinline__ void gdn_pair(const GPair& s, f32x2 (&S)[4], LAS float* ob, bool wr) {
    float d1 = dot8(s.k1a, s.k1b, S), d2 = dot8(s.k2a, s.k2b, S), e1 = dot8(s.q1a, s.q1b, S), e2 = dot8(s.q2a, s.q2b, S);
    DPP4(0xB1); DPP4(0x4E); DPP4(0x141); DPP4(0x140);
    const float g1 = s.eb.x, b1 = s.eb.y, g2 = s.eb.z, b2 = s.eb.w;
    const float c1 = b1 * (s.v1 - g1 * d1);
    const float c2 = b2 * (s.v2 - g2 * (g1 * d2 + c1 * s.sc.x));
    const float o1 = g1 * e1 + c1 * s.sc.y;
    const float o2 = g2 * (g1 * e2 + c1 * s.sc.z) + c2 * s.sc.w;
    const float gg = g1 * g2, f1 = g2 * c1;
    S[0] = S[0] * gg + s.k1a.xy * f1 + s.k2a.xy * c2; S[1] = S[1] * gg + s.k1a.zw * f1 + s.k2a.zw * c2;
    S[2] = S[2] * gg + s.k1b.xy * f1 + s.k2b.xy * c2; S[3] = S[3] * gg + s.k1b.zw * f1 + s.k2b.zw * c2;
    if (wr) { ob[0] = o1; ob[32] = o2; }
}
#undef DPP4
struct GStage { u32x4 k, q, v; f32x4 sc; float e; };
__device__ __forceinline__ void gdn_gload(GStage& g, const bf16* GK, const bf16* GQ, const bf16* GV, const float* GEG, const float* GBE, const f32x4* GSC, int t0, int tid) {
    { const int st = tid >> 4, f8 = tid & 15; g.k = *(const u32x4*)(GK + (size_t)(t0 + st) * 1024 + 8 * f8); g.q = *(const u32x4*)(GQ + (size_t)(t0 + st) * 1024 + 8 * f8); }
    { const int i = tid & 127; g.v = *(const u32x4*)(GV + (size_t)(t0 + (i >> 2)) * 1024 + 8 * (i & 3)); }
    { const int i = tid & 63; const float* p = (i < 32 ? GEG : GBE); g.e = p[(size_t)(t0 + (i & 31)) * 8]; }
    g.sc = GSC[(size_t)((t0 >> 1) + (tid & 15)) * 8];
}
__device__ __forceinline__ void st8(LAS float* d, const u32x4 w) { float f[8]; unpack8(w, f); *(LAS f32x4*)d = (f32x4){f[0], f[1], f[2], f[3]}; *(LAS f32x4*)(d + 4) = (f32x4){f[4], f[5], f[6], f[7]}; }
__device__ __forceinline__ void gdn_gstore(const GStage& g, LAS float* buf, int tid) {
    st8(buf + 8 * tid, g.k); st8(buf + CH * 128 + 8 * tid, g.q);
    if (tid < 128) st8(buf + 2 * CH * 128 + 8 * tid, g.v);
    else if (tid >= 256 && tid < 320) { const int i = tid - 256, st = i & 31, wh = i >> 5; buf[2 * CH * 128 + CH * 32 + (st >> 1) * 4 + (st & 1) * 2 + wh] = g.e; }
    else if (tid >= 320 && tid < 336) *(LAS f32x4*)(buf + 2 * CH * 128 + CH * 32 + 2 * CH + 4 * (tid - 320)) = g.sc;
}
__device__ __forceinline__ void gdn_block(const Ctx& F, int vb) {
    const int bh = vb >> 2, qt = vb & 3, b = bh >> 3, h = bh & 7, colL = F.wave * 4 + (F.lane >> 4), rg = F.lane & 15;
    const size_t base = (size_t)b * SEQ;
    const bf16* GK = (const bf16*)(F.ws + WS_GK) + base * 1024 + h * 128; const bf16* GQ = (const bf16*)(F.ws + WS_GQ) + base * 1024 + h * 128;
    const bf16* GV = (const bf16*)(F.ws + WS_GV) + base * 1024 + h * 128 + qt * 32;
    const float* GEG = (const float*)(F.ws + WS_GEG) + base * 8 + h; const float* GBE = (const float*)(F.ws + WS_GBE) + base * 8 + h;
    const f32x4* GSC = (const f32x4*)(F.ws + WS_GSC) + (base >> 1) * 8 + h;
    float* GO = (float*)(F.ws + WS_GO) + base * 1024 + h * 128 + qt * 32;
    LAS float* lb = (LAS float*)F.lds; LAS float* obase = lb + 2 * G_BUF;
    f32x2 S[4] = {{0.f, 0.f}, {0.f, 0.f}, {0.f, 0.f}, {0.f, 0.f}};
    const bool wr = rg == 0;
    GStage g;
    gdn_gload(g, GK, GQ, GV, GEG, GBE, GSC, 0, F.tid); gdn_gstore(g, lb, F.tid);
    __syncthreads();
    for (int c = 0; c < SEQ / CH; ++c) {
        const LAS float* buf = lb + (c & 1) * G_BUF; LAS float* ob = obase + (c & 1) * (CH * 32) + colL;
        if (c + 1 < SEQ / CH) gdn_gload(g, GK, GQ, GV, GEG, GBE, GSC, (c + 1) * CH, F.tid);
        GPair P0, P1;
        gdn_lds(P0, buf, 0, rg, colL);
#pragma unroll 1
        for (int pr = 0; pr < CH / 2; pr += 2) {
            gdn_lds(P1, buf, pr + 1, rg, colL); gdn_pair(P0, S, ob + 2 * pr * 32, wr);
            gdn_lds(P0, buf, (pr + 2) & (CH / 2 - 1), rg, colL); gdn_pair(P1, S, ob + (2 * pr + 2) * 32, wr);
        }
        if (c + 1 < SEQ / CH) gdn_gstore(g, lb + ((c + 1) & 1) * G_BUF, F.tid);
        __syncthreads();
        if (F.tid < 256) *(f32x4*)(GO + (size_t)(c * CH + (F.tid >> 3)) * 1024 + 4 * (F.tid & 7)) = *(const LAS f32x4*)(obase + (c & 1) * (CH * 32) + 4 * F.tid);
    }
}

struct RStep { f32x4 w, n, a, k, r; float v; };
constexpr int R_BUF = CH * (5 * 64 + 32);
__device__ __forceinline__ void rwkv_lds(RStep& s, const LAS float* buf, int st, int cq, int rowL) {
    s.w = *(const LAS f32x4*)(buf + st * 64 + 4 * cq); s.n = *(const LAS f32x4*)(buf + CH * 64 + st * 64 + 4 * cq); s.a = *(const LAS f32x4*)(buf + 2 * CH * 64 + st * 64 + 4 * cq);
    s.k = *(const LAS f32x4*)(buf + 3 * CH * 64 + st * 64 + 4 * cq); s.r = *(const LAS f32x4*)(buf + 4 * CH * 64 + st * 64 + 4 * cq); s.v = buf[5 * CH * 64 + st * 32 + rowL];
}
__device__ __forceinline__ void rwkv_step(const RStep& s, f32x4& S, LAS float* ob, bool wr) {
    float sa = (S.x * s.n.x + S.y * s.n.y) + (S.z * s.n.z + S.w * s.n.w);
    sa = allred16(sa);
    S = S * s.w + sa * s.a + s.v * s.k;
    float y = (S.x * s.r.x + S.y * s.r.y) + (S.z * s.r.z + S.w * s.r.w);
    y = allred16(y);
    if (wr) *ob = y;
}
struct RStage { f32x4 x[2]; u32x4 y[3], v; };
__device__ __forceinline__ void rwkv_gload(RStage& g, const float* RW, const float* RN, const bf16* RA, const bf16* RKp, const bf16* RRp, const bf16* RV, int t0, int tid) {
    { const int st = tid >> 4, f4 = tid & 15; g.x[0] = *(const f32x4*)(RW + (size_t)(t0 + st) * 1024 + 4 * f4); g.x[1] = *(const f32x4*)(RN + (size_t)(t0 + st) * 1024 + 4 * f4); }
    { const int i = tid & 255; const size_t o = (size_t)(t0 + (i >> 3)) * 1024 + 8 * (i & 7); g.y[0] = *(const u32x4*)(RA + o); g.y[1] = *(const u32x4*)(RKp + o); g.y[2] = *(const u32x4*)(RRp + o); }
    { const int i = tid & 127; g.v = *(const u32x4*)(RV + (size_t)(t0 + (i >> 2)) * 1024 + 8 * (i & 3)); }
}
__device__ __forceinline__ void rwkv_gstore(const RStage& g, LAS float* buf, int tid) {
    *(LAS f32x4*)(buf + 4 * tid) = g.x[0]; *(LAS f32x4*)(buf + CH * 64 + 4 * tid) = g.x[1];
    if (tid < 256) { st8(buf + 2 * CH * 64 + 8 * tid, g.y[0]); st8(buf + 3 * CH * 64 + 8 * tid, g.y[1]); st8(buf + 4 * CH * 64 + 8 * tid, g.y[2]); }
    else if (tid < 384) st8(buf + 5 * CH * 64 + 8 * (tid - 256), g.v);
}
__device__ __forceinline__ void rwkv_block(const Ctx& F, int vb) {
    const int bh = vb >> 1, hf = vb & 1, b = bh >> 4, h = bh & 15, rowL = F.wave * 4 + (F.lane >> 4), cq = F.lane & 15;
    const size_t base = (size_t)b * SEQ * 1024 + h * 64;
    const float* RW = (const float*)(F.ws + WS_RW) + base; const float* RN = (const float*)(F.ws + WS_RKK) + base;
    const bf16* RA = (const bf16*)(F.ws + WS_RKA) + base; const bf16* RKp = (const bf16*)(F.ws + WS_RK) + base; const bf16* RRp = (const bf16*)(F.ws + WS_RR) + base;
    const bf16* RV = (const bf16*)(F.ws + WS_RV) + base + hf * 32;
    float* RY = (float*)(F.ws + WS_RY) + base + hf * 32;
    LAS float* lb = (LAS float*)F.lds; LAS float* obase = lb + 2 * R_BUF;
    f32x4 S = {0.f, 0.f, 0.f, 0.f};
    const bool wr = cq == 0;
    RStage g;
    rwkv_gload(g, RW, RN, RA, RKp, RRp, RV, 0, F.tid); rwkv_gstore(g, lb, F.tid);
    __syncthreads();
    for (int c = 0; c < SEQ / CH; ++c) {
        const LAS float* buf = lb + (c & 1) * R_BUF; LAS float* ob = obase + (c & 1) * (CH * 32) + rowL;
        if (c + 1 < SEQ / CH) rwkv_gload(g, RW, RN, RA, RKp, RRp, RV, (c + 1) * CH, F.tid);
        RStep R0, R1, R2, R3;
        rwkv_lds(R0, buf, 0, cq, rowL); rwkv_lds(R1, buf, 1, cq, rowL);
#pragma unroll 1
        for (int s = 0; s < CH; s += 4) {
            rwkv_lds(R2, buf, s + 2, cq, rowL); rwkv_step(R0, S, ob + s * 32, wr);
            rwkv_lds(R3, buf, s + 3, cq, rowL); rwkv_step(R1, S, ob + (s + 1) * 32, wr);
            rwkv_lds(R0, buf, (s + 4) & (CH - 1), cq, rowL); rwkv_step(R2, S, ob + (s + 2) * 32, wr);
            rwkv_lds(R1, buf, (s + 5) & (CH - 1), cq, rowL); rwkv_step(R3, S, ob + (s + 3) * 32, wr);
        }
        if (c + 1 < SEQ / CH) rwkv_gstore(g, lb + ((c + 1) & 1) * R_BUF, F.tid);
        __syncthreads();
        if (F.tid < 256) *(f32x4*)(RY + (size_t)(c * CH + (F.tid >> 3)) * 1024 + 4 * (F.tid & 7)) = *(const LAS f32x4*)(obase + (c & 1) * (CH * 32) + 4 * F.tid);
    }
}

constexpr int S5_SROW = 136;
constexpr int S5_BROW = 20;
constexpr int S5_WAVE_B = 16 * S5_SROW * 2 + 1024 + 128 * S5_BROW * 4;
__device__ __forceinline__ void s5_block(const Ctx& F, const Args& a, int l, int it) {
    const int b = it >> 6, g = it & 63, p = F.lane, tl = F.lane >> 4, c = F.lane & 15, w = F.wave;
    const bf16* PROJ = (const bf16*)(F.ws + WS_PROJ); bf16* SY = (bf16*)(F.ws + WS_SY);
    LAS float* se = (LAS float*)F.lds;
    LAS unsigned char* wb = F.lds + 4096 + w * S5_WAVE_B;
    LAS bf16* sbuf = (LAS bf16*)wb; LAS float* uall = (LAS float*)(wb + 16 * S5_SROW * 2); LAS float* BU = uall + 256;
    const float dt = expf(a.in[19][l * 64 + g]);
    float abr, abi;
    {   const size_t gp = ((size_t)l * 64 + g) * 64 + p; const float are = a.in[17][gp], aim = a.in[18][gp]; const float mag = expf(are * dt); abr = mag * cosf(aim * dt); abi = mag * sinf(aim * dt); }
    bf16x8_t Bf[8];
    {   const int hl = tl >> 1, c0 = 8 * (tl & 1);
#pragma unroll
        for (int jj = 0; jj < 4; ++jj) {
            const size_t gp2 = ((size_t)l * 64 + g) * 64 + 16 * jj + c; const float are = a.in[17][gp2], aim = a.in[18][gp2];
            const float mag = expf(are * dt), ar = mag * cosf(aim * dt), ai = mag * sinf(aim * dt);
            const float den = are * are + aim * aim, cr = ((ar - 1.f) * are + ai * aim) / den, ci = (ai * are - (ar - 1.f) * aim) / den;
            const f32x4 r0 = *(const f32x4*)(a.in[20] + gp2 * 16 + c0), r1 = *(const f32x4*)(a.in[20] + gp2 * 16 + c0 + 4), i0 = *(const f32x4*)(a.in[21] + gp2 * 16 + c0), i1 = *(const f32x4*)(a.in[21] + gp2 * 16 + c0 + 4);
            const float br[8] = {r0.x, r0.y, r0.z, r0.w, r1.x, r1.y, r1.z, r1.w}, bi[8] = {i0.x, i0.y, i0.z, i0.w, i1.x, i1.y, i1.z, i1.w};
            float vr[8], vi[8];
#pragma unroll
            for (int e = 0; e < 8; ++e) { const float xr = cr * br[e] - ci * bi[e], xi = cr * bi[e] + ci * br[e];
                const float hr = bflo(pk2(xr, 0.f)), hi = bflo(pk2(xi, 0.f)); vr[e] = hl ? xr - hr : hr; vi[e] = hl ? xi - hi : hi; }
            Bf[jj] = __builtin_bit_cast(bf16x8_t, pack8(vr)); Bf[4 + jj] = __builtin_bit_cast(bf16x8_t, pack8(vi));
        }
    }
    bf16x8_t Cf[4];
    { const size_t cb = (((size_t)l * 64 + g) * 16 + c) * 64;
#pragma unroll
      for (int m = 0; m < 4; ++m) { const int k0 = 32 * m + 8 * tl; const float* src = (k0 < 64 ? a.in[22] + cb + k0 : a.in[23] + cb + (k0 - 64)); const float sg = k0 < 64 ? 1.f : -1.f;
          const f32x4 x0 = *(const f32x4*)src, x1 = *(const f32x4*)(src + 4);
          u32x4 pk; pk.x = pk2(sg * x0.x, sg * x0.y); pk.y = pk2(sg * x0.z, sg * x0.w); pk.z = pk2(sg * x1.x, sg * x1.y); pk.w = pk2(sg * x1.z, sg * x1.w);
          Cf[m] = __builtin_bit_cast(bf16x8_t, pk); } }
    const float dsk = a.in[24][l * 1024 + g * 16 + c];
    const int tw = 256 * w;
    const bf16* up = PROJ + ((size_t)b * SEQ + tw + c) * NINP + C_SU + g * 16 + 8 * (tl & 1);
    float sr = 0.f, si = 0.f;
#define S5_BU(UF) do { const bf16x8_t af_ = __builtin_bit_cast(bf16x8_t, UF); \
        _Pragma("unroll") for (int j = 0; j < 8; ++j) { const f32x4 z_ = {0.f, 0.f, 0.f, 0.f}; const f32x4 d_ = __builtin_amdgcn_mfma_f32_16x16x32_bf16(af_, Bf[j], z_, 0, 0, 0); \
            *(LAS f32x4*)(BU + (16 * j + c) * S5_BROW + 4 * tl) = d_; } asm volatile("" :: "v"(af_)); } while (0)
    {
        u32x4 ucur = *(const u32x4*)up;
        for (int t = 0; t < 256; t += 16) {
            const u32x4 unxt = *(const u32x4*)(up + (size_t)((t + 16 < 256) ? t + 16 : t) * NINP);
            S5_BU(ucur);
            WFENCE();
            float br_[16], bi_[16];
#pragma unroll
            for (int q = 0; q < 4; ++q) { const f32x4 x = *(const LAS f32x4*)(BU + p * S5_BROW + 4 * q), y = *(const LAS f32x4*)(BU + (64 + p) * S5_BROW + 4 * q);
                br_[4 * q] = x.x; br_[4 * q + 1] = x.y; br_[4 * q + 2] = x.z; br_[4 * q + 3] = x.w; bi_[4 * q] = y.x; bi_[4 * q + 1] = y.y; bi_[4 * q + 2] = y.z; bi_[4 * q + 3] = y.w; }
#pragma unroll
            for (int s = 0; s < 16; ++s) { const float nr = abr * sr - abi * si + br_[s], ni = abr * si + abi * sr + bi_[s]; sr = nr; si = ni; }
            WFENCE();
            ucur = unxt;
        }
    }
    se[w * 128 + p] = sr; se[w * 128 + 64 + p] = si;
    __syncthreads();
    {
        float pr = abr, pi = abi;
#pragma unroll
        for (int i = 0; i < 8; ++i) { const float nr = pr * pr - pi * pi, ni = 2.f * pr * pi; pr = nr; pi = ni; }
        sr = 0.f; si = 0.f;
        for (int j = 0; j < w; ++j) { const float er = se[j * 128 + p], ei = se[j * 128 + 64 + p]; const float nr = pr * sr - pi * si + er, ni = pr * si + pi * sr + ei; sr = nr; si = ni; }
    }
    {
        u32x4 ucur = *(const u32x4*)up;
        for (int t = 0; t < 256; t += 16) {
            const u32x4 unxt = *(const u32x4*)(up + (size_t)((t + 16 < 256) ? t + 16 : t) * NINP);
            S5_BU(ucur);
            if (tl < 2) { float uf[8]; unpack8(ucur, uf); *(LAS f32x4*)(uall + c * 16 + 8 * tl) = (f32x4){uf[0], uf[1], uf[2], uf[3]}; *(LAS f32x4*)(uall + c * 16 + 8 * tl + 4) = (f32x4){uf[4], uf[5], uf[6], uf[7]}; }
            WFENCE();
            float br_[16], bi_[16];
#pragma unroll
            for (int q = 0; q < 4; ++q) { const f32x4 x = *(const LAS f32x4*)(BU + p * S5_BROW + 4 * q), y = *(const LAS f32x4*)(BU + (64 + p) * S5_BROW + 4 * q);
                br_[4 * q] = x.x; br_[4 * q + 1] = x.y; br_[4 * q + 2] = x.z; br_[4 * q + 3] = x.w; bi_[4 * q] = y.x; bi_[4 * q + 1] = y.y; bi_[4 * q + 2] = y.z; bi_[4 * q + 3] = y.w; }
#pragma unroll
            for (int s = 0; s < 16; ++s) { const float nr = abr * sr - abi * si + br_[s], ni = abr * si + abi * sr + bi_[s]; sr = nr; si = ni;
                const unsigned pk = pk2(sr, si); sbuf[s * S5_SROW + p] = (bf16)(pk & 0xffffu); sbuf[s * S5_SROW + 64 + p] = (bf16)(pk >> 16); }
            WFENCE();
            f32x4 acc = {0.f, 0.f, 0.f, 0.f};
#pragma unroll
            for (int m = 0; m < 4; ++m) { const bf16x8_t af = *(const LAS bf16x8_t*)(sbuf + c * S5_SROW + 32 * m + 8 * tl);
                acc = __builtin_amdgcn_mfma_f32_16x16x32_bf16(af, Cf[m], acc, 0, 0, 0); asm volatile("" :: "v"(af)); }
#pragma unroll
            for (int r = 0; r < 4; ++r) { const int st = 4 * tl + r; const float y = acc[r] + dsk * uall[st * 16 + c];
                SY[((size_t)b * SEQ + tw + t + st) * 1024 + g * 16 + c] = (bf16)(pk2(gelu_tanh(y), 0.f) & 0xffffu); }
            WFENCE();
            ucur = unxt;
        }
    }
#undef S5_BU
    __syncthreads();
}

__device__ __forceinline__ void scan_phase(const Ctx& F, const Args& a, int l) {
    for (int r5 = 0; r5 < 1 + ((REPM >> 9) & 1); ++r5) for (int vb = F.vcu; vb < 256; vb += F.G) s5_block(F, a, l, vb);
    for (int rg_ = 0; rg_ < 1 + ((REPM >> 10) & 1); ++rg_) for (int vb = F.vcu; vb < 256; vb += F.G) {
        if (vb < 128) { gdn_block(F, vb); if (REPM & 2048) gdn_block(F, vb); }
        else { rwkv_block(F, vb - 128); if (REPM & 4096) rwkv_block(F, vb - 128); }
    }
}

__device__ __forceinline__ void post_phase(const Ctx& F, const Args& a, int l, int gw, int ngw) {
    const bf16* PROJ = (const bf16*)(F.ws + WS_PROJ); bf16* OBR = (bf16*)(F.ws + WS_OBR);
    const float* GO = (const float*)(F.ws + WS_GO); const float* RY = (const float*)(F.ws + WS_RY); const float* RV = (const float*)(F.ws + WS_RV); const float* RBON = (const float*)(F.ws + WS_RBON);
    const int c0 = 16 * F.lane;
    float nw[16], lw[16], lb[16];
#pragma unroll
    for (int e = 0; e < 16; ++e) { nw[e] = a.in[6][l * 128 + (c0 & 127) + e]; lw[e] = a.in[15][l * 1024 + c0 + e]; lb[e] = a.in[16][l * 1024 + c0 + e]; }
    for (int tok = gw; tok < TOK; tok += ngw) {
        { float o[16];
#pragma unroll
          for (int q = 0; q < 4; ++q) { const f32x4 v = *(const f32x4*)(GO + (size_t)tok * 1024 + c0 + 4 * q); o[4 * q] = v.x; o[4 * q + 1] = v.y; o[4 * q + 2] = v.z; o[4 * q + 3] = v.w; }
          float ss = 0.f;
#pragma unroll
          for (int e = 0; e < 16; ++e) ss += o[e] * o[e];
          ss = allred8(ss);
          const float rs = rsqrtf(ss * (1.f / 128.f) + 1e-6f);
          float z[16]; { float z0[8], z1[8]; unpack8(*(const u32x4*)(PROJ + (size_t)tok * NINP + C_GZ + c0), z0); unpack8(*(const u32x4*)(PROJ + (size_t)tok * NINP + C_GZ + c0 + 8), z1);
#pragma unroll
              for (int e = 0; e < 8; ++e) { z[e] = z0[e]; z[8 + e] = z1[e]; } }
          float r0[8], r1[8];
#pragma unroll
          for (int e = 0; e < 8; ++e) { r0[e] = o[e] * rs * nw[e] * siluf_(z[e]); r1[e] = o[8 + e] * rs * nw[8 + e] * siluf_(z[8 + e]); }
          *(u32x4*)(OBR + (size_t)tok * 1024 + c0) = pack8(r0); *(u32x4*)(OBR + (size_t)tok * 1024 + c0 + 8) = pack8(r1); }
        { float y[16], v[16];
#pragma unroll
          for (int q = 0; q < 4; ++q) { const f32x4 t = *(const f32x4*)(RY + (size_t)tok * 1024 + c0 + 4 * q); y[4 * q] = t.x; y[4 * q + 1] = t.y; y[4 * q + 2] = t.z; y[4 * q + 3] = t.w;
          }
          { float va[8], vb[8]; unpack8(*(const u32x4*)((const bf16*)RV + (size_t)tok * 1024 + c0), va); unpack8(*(const u32x4*)((const bf16*)RV + (size_t)tok * 1024 + c0 + 8), vb);
#pragma unroll
              for (int e = 0; e < 8; ++e) { v[e] = va[e]; v[8 + e] = vb[e]; } }
          float s = 0.f;
#pragma unroll
          for (int e = 0; e < 16; ++e) s += y[e];
          s += dppf<0xB1>(s); s += dppf<0x4E>(s);
          const float mean = s * (1.f / 64.f); float q2 = 0.f;
#pragma unroll
          for (int e = 0; e < 16; ++e) { const float d = y[e] - mean; q2 += d * d; }
          q2 += dppf<0xB1>(q2); q2 += dppf<0x4E>(q2);
          const float rs = rsqrtf(q2 * (1.f / 64.f) + 64e-5f);
          const float bon = RBON[(size_t)tok * 16 + (c0 >> 6)];
          float z[16]; { float z0[8], z1[8]; unpack8(*(const u32x4*)(PROJ + (size_t)tok * NINP + C_RZ + c0), z0); unpack8(*(const u32x4*)(PROJ + (size_t)tok * NINP + C_RZ + c0 + 8), z1);
#pragma unroll
              for (int e = 0; e < 8; ++e) { z[e] = z0[e]; z[8 + e] = z1[e]; } }
          float r0[8], r1[8];
#pragma unroll
          for (int e = 0; e < 8; ++e) { r0[e] = ((y[e] - mean) * rs * lw[e] + lb[e] + bon * v[e]) * siluf_(z[e]); r1[e] = ((y[8 + e] - mean) * rs * lw[8 + e] + lb[8 + e] + bon * v[8 + e]) * siluf_(z[8 + e]); }
          bf16* ob = OBR + (size_t)TOK * 1024 + (size_t)tok * 1024 + c0;
          *(u32x4*)ob = pack8(r0); *(u32x4*)(ob + 8) = pack8(r1); }
    }
}

#ifndef PHM
#define PHM 0xFFFF
#endif
#ifndef REPM
#define REPM 0
#endif
__global__ void __launch_bounds__(NTHREADS, 2) hybrid_fwd(Args a) {
    extern __shared__ __attribute__((aligned(16))) unsigned char lds_raw[];
    Ctx F;
    F.lds = (LAS unsigned char*)lds_raw; F.ws = a.ws;
    F.G = gridDim.x; { const int bx = blockIdx.x; F.vcu = (F.G % 8 == 0) ? (bx % 8) * (F.G / 8) + bx / 8 : bx; }
    F.NGW = F.G * NWAVES;
    cg::grid_group grid = cg::this_grid();
    if (threadIdx.x < 8) ((volatile LAS unsigned*)(F.lds + MISC_OFF))[threadIdx.x] = 0u;
    __syncthreads();
    grid.sync();
    XcdBarrier bar = xcd_barrier_post((unsigned*)(a.ws + WS_CTL), (volatile LAS unsigned*)(F.lds + MISC_OFF));
    bf16* XN = (bf16*)(a.ws + WS_XN); bf16* PROJ = (bf16*)(a.ws + WS_PROJ);
    int rep = 0;
    for (int ph = a.ph_lo; ph < a.ph_hi; ) {
        { int t_ = threadIdx.x; asm volatile("" : "+v"(t_)); F.tid = t_; F.lane = t_ & 63; F.wave = __builtin_amdgcn_readfirstlane(t_ >> 6); F.gw = F.vcu * NWAVES + F.wave; }
        if (ph == NPHASES - 1) { for (int m = F.gw; m < TOK; m += F.NGW) rms_row(a.out + (size_t)m * DM, a.in[30], nullptr, nullptr, a.out + (size_t)m * DM, F.lane); }
        else if (ph == 0) { if (PHM & 1) phase0(F, a);
            if (REPM & 128) { if (!rep) { rep = 1; __syncthreads(); continue; } rep = 0; } }
        else {
            const int l = (ph - 1) / PH_PER_LAYER, k = (ph - 1) % PH_PER_LAYER;
            if (k == 0 && (PHM & 2)) {
                pg8::Gemm g{XN, (const bf16*)(a.ws + WS_WIN) + (size_t)l * NINP * DM, TOK, NINP, DM}; pg8::StaticOrder S; S.init(TOK, NINP, F.G, (int)blockIdx.x);
                pg8::EpiBf16Rs E{PROJ, NINP, (const unsigned long long*)(a.ws + WS_CTL + CTL_SS) + (size_t)l * TOK};
                pg8::gemm_phase<pg8::EpiBf16Rs, pg8::StaticOrder, true, true>(F.lds, g, S, E);
                if (l + 1 < DEPTH) {
                    const int rem = ((TOK / 256) * (NINP / 256)) % F.G, bx = (int)blockIdx.x;
                    if (rem == 0) convert_layer(F, a, l + 1, F.gw, F.NGW);
                    else if (bx >= rem) convert_layer(F, a, l + 1, (bx - rem) * NWAVES + F.wave, (F.G - rem) * NWAVES);
                }
            } else if (k == 1) { prep_gdn(F, a, l); if (REPM & 8192) prep_gdn(F, a, l); prep_rwkv(F, a, l); if (REPM & 16384) prep_rwkv(F, a, l); }
            else if (k == 2) { if (PHM & 16) scan_phase(F, a, l); }
            else if (k == 3 && (PHM & 32)) {
                const bool split = F.G >= 192;
                if (!split) { post_phase(F, a, l, F.gw, F.NGW); __syncthreads(); }
                if (!split || (int)blockIdx.x < 128) {
                    pg8::Gemm g{(const bf16*)(a.ws + WS_SY), (const bf16*)(a.ws + WS_WGLU) + (size_t)l * 1024 * 1024, TOK, 1024, 1024}; pg8::StaticOrder S; S.init(TOK, 1024, F.G, (int)blockIdx.x);
                    pg8::EpiGlu E{(const bf16*)(a.ws + WS_SY), PROJ, a.in[26] + l * 1024, (bf16*)(a.ws + WS_OBR) + (size_t)2 * TOK * 1024};
                    pg8::gemm_phase<pg8::EpiGlu, pg8::StaticOrder, true, true>(F.lds, g, S, E);
                } else post_phase(F, a, l, ((int)blockIdx.x - 128) * NWAVES + F.wave, (F.G - 128) * NWAVES);
            } else if (k == 4 && (PHM & 64)) {
                pg8::Gemm g{(const bf16*)(a.ws + WS_OBR), (const bf16*)(a.ws + WS_WBR) + (size_t)l * 3 * DM * 1024, 3 * TOK, 3 * DM, 1024};
                pg8::BranchOrder S; S.base.init(TOK, DM, F.G, (int)blockIdx.x);
                pg8::EpiBranch E{PROJ, a.in[27] + (size_t)l * 3 * DM, (bf16*)(a.ws + WS_ACCF), (bf16*)(a.ws + WS_MRG)};
                pg8::gemm_phase<pg8::EpiBranch, pg8::BranchOrder, true, true>(F.lds, g, S, E);
            } else if (k == 5 && (PHM & 128)) {
                pg8::Gemm g{(const bf16*)(a.ws + WS_MRG), (const bf16*)(a.ws + WS_WOUT) + (size_t)l * DM * DM, TOK, DM, DM}; pg8::StaticOrder S; S.init(TOK, DM, F.G, (int)blockIdx.x);
                pg8::EpiResid E{l == 0 ? a.in[0] : a.out, a.out, l + 1 < DEPTH ? XN : nullptr, a.in[1] + (size_t)(l + 1 < DEPTH ? l + 1 : 0) * DM, (unsigned long long*)(a.ws + WS_CTL + CTL_SS) + (size_t)(l + 1 < DEPTH ? l + 1 : 0) * TOK};
                pg8::gemm_phase<pg8::EpiResid, pg8::StaticOrder, true, true>(F.lds, g, S, E);
            }
            if (REPM && !rep && ((REPM >> k) & 1)) { rep = 1; __syncthreads(); continue; }
            rep = 0;
        }
        if (ph + 1 < a.ph_hi) {
            xcd_barrier(bar);
            if (REPM & 256) xcd_barrier(bar);
        }
        ++ph;
    }
}

#ifndef MK_MULTI
#define MK_MULTI 0
#endif
extern "C" void kernel_launch(void* const* d_in, const int* in_sizes, int n_in, void* d_out, int out_size, void* d_ws, size_t ws_size, hipStream_t stream) {
    static int grid = 0;
    if (grid == 0) {
        if (n_in != 31 || out_size != TOK * DM || ws_size < WS_END) { fprintf(stderr, "kernel_launch: unexpected shapes (n_in %d out %d ws %zu)\n", n_in, out_size, ws_size); grid = -1; return; }
        int dev = 0, cus = 0, per_cu = 0;
        hipGetDevice(&dev); hipDeviceGetAttribute(&cus, hipDeviceAttributeMultiprocessorCount, dev);
        if (hipFuncSetAttribute((const void*)hybrid_fwd, hipFuncAttributeMaxDynamicSharedMemorySize, LDS_BYTES) != hipSuccess) { fprintf(stderr, "kernel_launch: hipFuncSetAttribute failed\n"); grid = -1; return; }
        if (hipOccupancyMaxActiveBlocksPerMultiprocessor(&per_cu, (const void*)hybrid_fwd, NTHREADS, LDS_BYTES) != hipSuccess || per_cu < 1) per_cu = 1;
        (void)hipGetLastError();
        grid = cus * per_cu;
        fprintf(stderr, "kernel_launch: grid %d (cus %d x %d)\n", grid, cus, per_cu);
    }
    if (grid < 0) return;
    if (hipMemsetAsync((char*)d_ws + WS_CTL, 0, CTL_ZERO_BYTES, stream) != hipSuccess) { fprintf(stderr, "kernel_launch: memset failed\n"); return; }
    Args a{};
    for (int i = 0; i < 31; ++i) a.in[i] = (const float*)d_in[i];
    a.out = (float*)d_out; a.ws = (unsigned char*)d_ws;
#if MK_MULTI
    for (int ph = 0; ph < NPHASES; ++ph) { a.ph_lo = ph; a.ph_hi = ph + 1; hipLaunchKernelGGL(hybrid_fwd, dim3(grid), dim3(NTHREADS), LDS_BYTES, stream, a); }
#else
    a.ph_lo = 0; a.ph_hi = NPHASES;
    void* args[] = {&a};
    const hipError_t e = hipLaunchCooperativeKernel((const void*)hybrid_fwd, dim3(grid), dim3(NTHREADS), args, LDS_BYTES, stream);
    if (e != hipSuccess) fprintf(stderr, "kernel_launch: cooperative launch failed: %s (grid %d)\n", hipGetErrorString(e), grid);
#endif
}
```

```cpp
#include <hip/hip_runtime.h>
#include <hip/hip_cooperative_groups.h>
#include <cstdio>
#include <cstdint>
namespace cg = cooperative_groups;
namespace pg8 {
#define PG8_LAS __attribute__((address_space(3)))
typedef unsigned short bf16_t;
typedef short bf16x8 __attribute__((ext_vector_type(8)));
typedef float f32x4 __attribute__((ext_vector_type(4)));
typedef unsigned u32x4 __attribute__((ext_vector_type(4)));
constexpr int BM = 256, BK = 64, HALF = 128, HTB = HALF * BK * 2  , STAGE_BYTES = 8 * HTB, NXCD = 8, WGM = 8;

__host__ __device__ __forceinline__ int lds_byte(int r, int c) { const int st = (r >> 4) * 2 + (c >> 5), rr = r & 15, cc = c & 31, ob = rr * 64 + cc * 2; return st * 1024 + (ob ^ (((ob >> 9) & 1) << 5)); }
__host__ __device__ __forceinline__ void stage_rc(int b, int& R, int& C) { const int st = b / 1024, sb = b % 1024, swz = sb ^ (((sb >> 9) & 1) << 5); R = (st >> 1) * 16 + swz / 64; C = (st & 1) * 32 + (swz % 64) / 2; }
__host__ __device__ __forceinline__ int perm32(int rho) { const int n = rho >> 4, i = rho & 15; return 8 * (i >> 2) + 4 * n + (i & 3); }

struct Unit { int pm, pn; };
struct Gemm { const bf16_t* A; const bf16_t* Bt; int M, N, K, ld; };

struct StaticOrder {
    int nM, nN, nwg, G, c;
    __host__ __device__ void init(int M, int N, int G_, int c_) { nM = M / BM; nN = N / BM; nwg = nM * nN; G = G_; c = c_; }
    __host__ __device__ bool next(int i, Unit& u) const {
        const long L = (long)i * G + c; if (L >= nwg) return false;
        int wgid = (int)L; { const int q = nwg / NXCD, r = nwg % NXCD, xcd = wgid % NXCD, off = wgid / NXCD; wgid = (xcd < r ? xcd * (q + 1) : r * (q + 1) + (xcd - r) * q) + off; }
        const int nig = WGM * nN, gid = wgid / nig, fm = gid * WGM, gsz = (nM - fm) < WGM ? (nM - fm) : WGM;
        u.pm = fm + ((wgid % nig) % gsz); u.pn = (wgid % nig) / gsz; return true;
    }
    __device__ __forceinline__ void a_ready(const Unit&) const {}
    __device__ __forceinline__ void done(const Unit&) const {}
};

__device__ __forceinline__ unsigned cvt_pk_bf16(float lo, float hi) { unsigned r; asm volatile("v_cvt_pk_bf16_f32 %0, %1, %2" : "=v"(r) : "v"(lo), "v"(hi)); return r; }
typedef float f32x2 __attribute__((ext_vector_type(2)));
__device__ __forceinline__ f32x2 gelu_pk(f32x2 v) {
    const f32x2 av = __builtin_elementwise_abs(v), d = av * 0.2316418882f + 1.0f;
    f32x2 t; t.x = __builtin_amdgcn_rcpf(d.x); t.y = __builtin_amdgcn_rcpf(d.y);
    f32x2 q = t * 0.5307027145f + (-0.7265760135f); q = q * t + 0.7107068705f; q = q * t + (-0.142248368f); q = q * t + 0.127414796f; q = q * t;
    const f32x2 s = (v * v) * (-0.72134752044f);
    f32x2 e; e.x = __builtin_amdgcn_exp2f(s.x); e.y = __builtin_amdgcn_exp2f(s.y);
    const f32x2 m = v * (q * e), r = v - m;
    f32x2 o; o.x = v.x < 0.f ? m.x : r.x; o.y = v.y < 0.f ? m.y : r.y; return o;
}

template <int ACT  > struct EpiBf16 {
    static constexpr bool PERM = true, AFTER_DRAIN = false; static_assert(ACT == 0 || ACT == 1, "EpiBf16: ACT is 0 (none) or 1 (gelu_pk)");
    bf16_t* O; int ldc; const float* bias; int split_cols; size_t split_stride; float scale0;
    __device__ __forceinline__ void operator()(const f32x4 (&acc)[2][2][4][2], const Unit& u, int wr, int wc, int fr, int fq) const {
        const int row0 = u.pm * BM + wr * 64 + fr; int colt = u.pn * BM; bf16_t* base = O;
        float sc = 1.f; if (split_cols) { const int t = colt / split_cols; base += (size_t)t * split_stride; colt -= t * split_cols; if (t == 0) sc = scale0; }
        const int col0 = colt + wc * 32 + 8 * fq, bcol0 = u.pn * BM + wc * 32 + 8 * fq;
        f32x4 bv[2][2];
#pragma unroll
        for (int bj = 0; bj < 2; ++bj)
#pragma unroll
            for (int n = 0; n < 2; ++n) bv[bj][n] = bias ? *(const f32x4*)(bias + bcol0 + bj * HALF + 4 * n) : (f32x4){0.f, 0.f, 0.f, 0.f};
#pragma unroll
        for (int ai = 0; ai < 2; ++ai)
#pragma unroll
            for (int m = 0; m < 4; ++m) { bf16_t* rowp = base + (size_t)(row0 + ai * HALF + m * 16) * ldc + col0;
#pragma unroll
                for (int bj = 0; bj < 2; ++bj) { f32x4 v0 = acc[ai][bj][m][0] + bv[bj][0], v1 = acc[ai][bj][m][1] + bv[bj][1];
                    if (ACT == 1) { f32x2 a = gelu_pk((f32x2){v0[0], v0[1]}), b = gelu_pk((f32x2){v0[2], v0[3]}), c = gelu_pk((f32x2){v1[0], v1[1]}), d = gelu_pk((f32x2){v1[2], v1[3]});
                        v0 = (f32x4){a.x, a.y, b.x, b.y}; v1 = (f32x4){c.x, c.y, d.x, d.y}; }
                    v0 = v0 * sc; v1 = v1 * sc; u32x4 w; w.x = cvt_pk_bf16(v0[0], v0[1]); w.y = cvt_pk_bf16(v0[2], v0[3]); w.z = cvt_pk_bf16(v1[0], v1[1]); w.w = cvt_pk_bf16(v1[2], v1[3]);
                    *(u32x4*)(rowp + bj * HALF) = w; } }
    }
};

template <class Epi, class Sched, bool ALIGN_EPI = false, bool SP2 = false>
__device__ __forceinline__ void gemm_phase(PG8_LAS unsigned char* lds, const Gemm g, const Sched& S, const Epi& E) {
    int tid_ = threadIdx.x; asm volatile("" : "+v"(tid_));
    const int tid = tid_, wid = __builtin_amdgcn_readfirstlane(tid >> 6), lane = tid & 63, wr = wid >> 2, wc = wid & 3, fr = lane & 15, fq = lane >> 4;
    const int K = g.K, nt = K / BK, LD = g.ld ? g.ld : g.K;
    unsigned voffA[2], voffB[2];
#pragma unroll
    for (int i = 0; i < 2; ++i) { int R, C; stage_rc(tid * 16 + i * 8192, R, C); const int Rb = Epi::PERM ? ((R & ~31) + perm32(R & 31)) : R;
        voffA[i] = (unsigned)(R * LD + C) * 2u; voffB[i] = (unsigned)(Rb * LD + C) * 2u; }
    const size_t kstep = (size_t)(BK * 2);
    const size_t hstep = (size_t)HALF * LD * 2;
    const size_t tstep = 2 * hstep;
    const unsigned ldsw = (unsigned)wid * 1024u;
    const int aoff = lds_byte(wr * 64 + fr, fq * 8), boff = lds_byte(wc * 32 + fr, fq * 8);
#define PG8_SA(b, h) (((b) * 2 + (h)) * HTB)
#define PG8_SB(b, h) ((4 + (b) * 2 + (h)) * HTB)
#define PG8_STAGE(bufoff, gbase, voff) do { _Pragma("unroll") for (int _i = 0; _i < 2; ++_i) \
        __builtin_amdgcn_global_load_lds((const unsigned*)((const char*)(gbase) + (voff)[_i]), (PG8_LAS unsigned*)(lds + (bufoff) + ldsw + _i * 8192), 16, 0, 0); } while (0)
#define PG8_LDA(dst, b, h) do { _Pragma("unroll") for (int m = 0; m < 4; ++m) _Pragma("unroll") for (int k = 0; k < 2; ++k) dst[m][k] = *(const PG8_LAS bf16x8*)(lds + PG8_SA(b, h) + aoff + m * 2048 + k * 1024); } while (0)
#define PG8_LDB(dst, b, h) do { _Pragma("unroll") for (int n = 0; n < 2; ++n) _Pragma("unroll") for (int k = 0; k < 2; ++k) dst[n][k] = *(const PG8_LAS bf16x8*)(lds + PG8_SB(b, h) + boff + n * 2048 + k * 1024); } while (0)
#define PG8_MMA(ai, bj, At, Bt) do { __builtin_amdgcn_s_setprio(1); _Pragma("unroll") for (int m = 0; m < 4; ++m) _Pragma("unroll") for (int n = 0; n < 2; ++n) _Pragma("unroll") for (int k = 0; k < 2; ++k) \
        acc[ai][bj][m][n] = __builtin_amdgcn_mfma_f32_16x16x32_bf16(Bt[n][k], At[m][k], acc[ai][bj][m][n], 0, 0, 0); __builtin_amdgcn_s_setprio(0); } while (0)
#define PG8_WAIT_V(n) asm volatile("s_waitcnt vmcnt(" #n ")" ::: "memory")
#define PG8_WAIT_L(n) asm volatile("s_waitcnt lgkmcnt(" #n ")" ::: "memory")
#define PG8_BAR __builtin_amdgcn_s_barrier()
#define PG8_SCHED __builtin_amdgcn_sched_barrier(0)
    Unit cur, nxt; int ui = 0;
    if (!S.next(0, cur)) return;
    f32x4 acc[2][2][4][2];
#pragma unroll
    for (int a = 0; a < 2; ++a)
#pragma unroll
        for (int b = 0; b < 2; ++b)
#pragma unroll
            for (int m = 0; m < 4; ++m)
#pragma unroll
                for (int n = 0; n < 2; ++n) acc[a][b][m][n] = (f32x4){0.f, 0.f, 0.f, 0.f};
    bf16x8 At[4][2], B0[2][2], B1[2][2];
    const char* cA = (const char*)g.A + (size_t)cur.pm * tstep; const char* cB = (const char*)g.Bt + (size_t)cur.pn * tstep;
    S.a_ready(cur);
    if constexpr (SP2) {
        PG8_STAGE(PG8_SB(0, 0), cB, voffB); PG8_STAGE(PG8_SB(0, 1), cB + hstep, voffB); PG8_STAGE(PG8_SA(0, 0), cA, voffA); PG8_STAGE(PG8_SA(0, 1), cA + hstep, voffA);
        if (wr == 1) PG8_BAR;
        PG8_WAIT_V(2); PG8_BAR;
        PG8_STAGE(PG8_SB(1, 0), cB + kstep, voffB); PG8_STAGE(PG8_SA(1, 0), cA + kstep, voffA); PG8_STAGE(PG8_SB(1, 1), cB + hstep + kstep, voffB);
        PG8_WAIT_V(6); PG8_BAR;
    } else {
        PG8_STAGE(PG8_SB(0, 0), cB, voffB); PG8_STAGE(PG8_SA(0, 0), cA, voffA); PG8_STAGE(PG8_SB(0, 1), cB + hstep, voffB); PG8_STAGE(PG8_SA(0, 1), cA + hstep, voffA);
        if (wr == 1) PG8_BAR;
        PG8_WAIT_V(4); PG8_BAR;
        PG8_STAGE(PG8_SB(1, 0), cB + kstep, voffB); PG8_STAGE(PG8_SA(1, 0), cA + kstep, voffA); PG8_STAGE(PG8_SB(1, 1), cB + hstep + kstep, voffB);
        PG8_WAIT_V(6); PG8_BAR;
    }
    for (;;) {
        const bool has_next = S.next(ui + 1, nxt);
        const char* nA = has_next ? (const char*)g.A + (size_t)nxt.pm * tstep : cA; const char* nB = has_next ? (const char*)g.Bt + (size_t)nxt.pn * tstep : cB;
        for (int t = 0; t < nt; t += 2) {
            const bool last = (t == nt - 2);
            const char* a1 = cA + (size_t)(t + 1) * kstep;
            const char* a2 = last ? nA : cA + (size_t)(t + 2) * kstep; const char* b2 = last ? nB : cB + (size_t)(t + 2) * kstep;
            const char* a3 = a2 + kstep; const char* b3 = b2 + kstep;
            if (last && has_next) S.a_ready(nxt);
            if constexpr (SP2) {
            PG8_LDB(B0, 0, 0); PG8_LDB(B1, 0, 1); PG8_SCHED; PG8_LDA(At, 0, 0); PG8_STAGE(PG8_SA(1, 1), a1 + hstep, voffA);
            PG8_WAIT_V(8); PG8_WAIT_L(0); PG8_BAR; PG8_MMA(0, 0, At, B0); PG8_MMA(0, 1, At, B1); PG8_BAR; PG8_SCHED;
            PG8_LDA(At, 0, 1); PG8_STAGE(PG8_SB(0, 0), b2, voffB); PG8_STAGE(PG8_SB(0, 1), b2 + hstep, voffB); PG8_STAGE(PG8_SA(0, 0), a2, voffA);
            PG8_WAIT_V(8); PG8_WAIT_L(0); PG8_BAR; PG8_MMA(1, 0, At, B0); PG8_MMA(1, 1, At, B1); PG8_BAR; PG8_SCHED;
            PG8_LDB(B0, 1, 0); PG8_LDB(B1, 1, 1); PG8_SCHED; PG8_LDA(At, 1, 0); PG8_STAGE(PG8_SA(0, 1), a2 + hstep, voffA);
            PG8_WAIT_V(8); PG8_WAIT_L(0); PG8_BAR; PG8_MMA(0, 0, At, B0); PG8_MMA(0, 1, At, B1); PG8_BAR; PG8_SCHED;
            PG8_LDA(At, 1, 1); PG8_STAGE(PG8_SB(1, 0), b3, voffB); PG8_STAGE(PG8_SB(1, 1), b3 + hstep, voffB); PG8_STAGE(PG8_SA(1, 0), a3, voffA);
            PG8_WAIT_V(8); PG8_WAIT_L(0); PG8_BAR; PG8_MMA(1, 0, At, B0); PG8_MMA(1, 1, At, B1); PG8_BAR; PG8_SCHED;
            } else {
            PG8_LDB(B0, 0, 0); PG8_SCHED; PG8_LDA(At, 0, 0); PG8_STAGE(PG8_SA(1, 1), a1 + hstep, voffA);
            PG8_WAIT_L(8); PG8_BAR; PG8_WAIT_L(0); PG8_MMA(0, 0, At, B0); PG8_BAR; PG8_SCHED;
            PG8_LDB(B1, 0, 1); PG8_STAGE(PG8_SB(0, 0), b2, voffB);
            PG8_BAR; PG8_WAIT_L(0); PG8_MMA(0, 1, At, B1); PG8_BAR;
            PG8_LDA(At, 0, 1); PG8_STAGE(PG8_SA(0, 0), a2, voffA);
            PG8_BAR; PG8_WAIT_L(0); PG8_MMA(1, 0, At, B0); PG8_BAR; PG8_SCHED;
            PG8_STAGE(PG8_SB(0, 1), b2 + hstep, voffB);
            PG8_WAIT_V(6); PG8_BAR; PG8_MMA(1, 1, At, B1); PG8_BAR;
            PG8_LDB(B0, 1, 0); PG8_SCHED; PG8_LDA(At, 1, 0); PG8_STAGE(PG8_SA(0, 1), a2 + hstep, voffA);
            PG8_WAIT_L(8); PG8_BAR; PG8_WAIT_L(0); PG8_MMA(0, 0, At, B0); PG8_BAR; PG8_SCHED;
            PG8_LDB(B1, 1, 1); PG8_STAGE(PG8_SB(1, 0), b3, voffB);
            PG8_BAR; PG8_WAIT_L(0); PG8_MMA(0, 1, At, B1); PG8_BAR;
            PG8_LDA(At, 1, 1); PG8_STAGE(PG8_SA(1, 0), a3, voffA);
            PG8_BAR; PG8_WAIT_L(0); PG8_MMA(1, 0, At, B0); PG8_BAR; PG8_SCHED;
            PG8_STAGE(PG8_SB(1, 1), b3 + hstep, voffB);
            PG8_WAIT_V(6); PG8_BAR; PG8_MMA(1, 1, At, B1); PG8_BAR;
            }
        }
        if constexpr (ALIGN_EPI) { if (wr == 0) PG8_BAR; }
        if constexpr (!Epi::AFTER_DRAIN) { E(acc, cur, wr, wc, fr, fq); S.done(cur); }
        if (!has_next) break;
#pragma unroll
        for (int a = 0; a < 2; ++a)
#pragma unroll
            for (int b = 0; b < 2; ++b)
#pragma unroll
                for (int m = 0; m < 4; ++m)
#pragma unroll
                    for (int n = 0; n < 2; ++n) acc[a][b][m][n] = (f32x4){0.f, 0.f, 0.f, 0.f};
        cur = nxt; cA = nA; cB = nB; ++ui;
        if constexpr (ALIGN_EPI) { if (wr == 1) PG8_BAR; }
    }
    PG8_WAIT_V(0);
    if constexpr (!ALIGN_EPI) { if (wr == 0) PG8_BAR; }
    PG8_BAR;
    if constexpr (Epi::AFTER_DRAIN) { E.fused(acc, cur, wr, wc, fr, fq, lds, wid, lane); S.done(cur); }
#undef PG8_SA
#undef PG8_SB
#undef PG8_STAGE
#undef PG8_LDA
#undef PG8_LDB
#undef PG8_MMA
#undef PG8_WAIT_V
#undef PG8_WAIT_L
#undef PG8_BAR
#undef PG8_SCHED
}
}

#define GAS __attribute__((address_space(1)))
#define LAS __attribute__((address_space(3)))
typedef unsigned short bf16;
typedef unsigned u32x4 __attribute__((ext_vector_type(4)));
typedef unsigned u32x2 __attribute__((ext_vector_type(2)));
typedef float f32x4 __attribute__((ext_vector_type(4)));
typedef float f32x2 __attribute__((ext_vector_type(2)));
typedef short bf16x8_t __attribute__((ext_vector_type(8)));

constexpr int NBATCH = 4, SEQ = 2048, TOK = NBATCH * SEQ, DM = 2048, DEPTH = 4;
constexpr int NIN = 16592, NINP = 16640;
constexpr int C_GQKV = 0, C_GZ = 3072, C_GB = 4096, C_GA = 4104, C_RF = 4112, C_RZ = 7376, C_SU = 8400, C_SZ = 9424, C_GATE = 10448;
constexpr int NWAVES = 8, NTHREADS = 512;
constexpr int LDS_BYTES = 147456;
constexpr int PH_PER_LAYER = 6, NPHASES = 2 + DEPTH * PH_PER_LAYER;

constexpr size_t MiB = 1u << 20;
constexpr size_t WS_WIN = 0, WS_WGLU = 260 * MiB, WS_WBR = 268 * MiB, WS_WOUT = 316 * MiB, WS_XN = 348 * MiB, WS_PROJ = 380 * MiB;
constexpr size_t WS_GQ = 640 * MiB, WS_GK = 672 * MiB, WS_GV = 704 * MiB, WS_GEG = 736 * MiB, WS_GBE = 737 * MiB, WS_GSC = 737 * MiB + 512 * 1024, WS_GO = 738 * MiB;
constexpr size_t WS_RR = 770 * MiB, WS_RW = 802 * MiB, WS_RK = 834 * MiB, WS_RV = 866 * MiB, WS_RKK = 898 * MiB, WS_RKA = 930 * MiB, WS_RBON = 962 * MiB, WS_RY = 963 * MiB;
constexpr size_t WS_SY = 995 * MiB, WS_OBR = 1011 * MiB, WS_ACCF = 1059 * MiB, WS_MRG = 1123 * MiB, WS_CTL = 1155 * MiB, WS_LORA = 1156 * MiB, WS_END = 1158 * MiB;
constexpr size_t CTL_SS = 65536, CTL_ZERO_BYTES = CTL_SS + (size_t)DEPTH * TOK * 8;
constexpr int MISC_OFF = 147392;
static_assert((size_t)DEPTH * NINP * DM * 2 == 260 * MiB && (size_t)TOK * NINP * 2 == 260 * MiB, "ws map");

__device__ __forceinline__ unsigned f2bf(float f) { unsigned u = __builtin_bit_cast(unsigned, f); return (u + 0x7fffu + ((u >> 16) & 1u)) >> 16; }
__device__ __forceinline__ unsigned pk2(float lo, float hi) { unsigned r; asm("v_cvt_pk_bf16_f32 %0, %1, %2" : "=v"(r) : "v"(lo), "v"(hi)); return r; }
__device__ __forceinline__ float bflo(unsigned w) { return __builtin_bit_cast(float, w << 16); }
__device__ __forceinline__ float bfhi(unsigned w) { return __builtin_bit_cast(float, w & 0xffff0000u); }
__device__ __forceinline__ float bf1(bf16 h) { return __builtin_bit_cast(float, (unsigned)h << 16); }
__device__ __forceinline__ float sigmoidf_(float x) { return __builtin_amdgcn_rcpf(1.f + __expf(-x)); }
__device__ __forceinline__ float siluf_(float x) { return x * __builtin_amdgcn_rcpf(1.f + __expf(-x)); }
__device__ __forceinline__ float softplusf_(float x) { return x > 20.f ? x : log1pf(expf(x)); }
__device__ __forceinline__ float gelu_tanh(float y) { const float t = 0.7978845608028654f * (y + 0.044715f * y * y * y); const float th = 1.f - 2.f * __builtin_amdgcn_rcpf(1.f + __expf(2.f * t)); return 0.5f * y * (1.f + th); }
template <int CTRL> __device__ __forceinline__ float dppf(float v) { return __builtin_bit_cast(float, __builtin_amdgcn_update_dpp(0, __builtin_bit_cast(int, v), CTRL, 0xF, 0xF, true)); }
__device__ __forceinline__ float allred8(float v) { v += dppf<0xB1>(v); v += dppf<0x4E>(v); v += dppf<0x141>(v); return v; }
__device__ __forceinline__ float allred16(float v) { v = allred8(v); v += dppf<0x140>(v); return v; }
__device__ __forceinline__ float wave_sum(float v) {
#pragma unroll
    for (int o = 1; o < 64; o <<= 1) v += __shfl_xor(v, o);
    return v;
}
__device__ __forceinline__ void unpack8(const u32x4 w, float (&f)[8]) { f[0] = bflo(w.x); f[1] = bfhi(w.x); f[2] = bflo(w.y); f[3] = bfhi(w.y); f[4] = bflo(w.z); f[5] = bfhi(w.z); f[6] = bflo(w.w); f[7] = bfhi(w.w); }
__device__ __forceinline__ u32x4 pack8(const float (&f)[8]) { u32x4 w; w.x = pk2(f[0], f[1]); w.y = pk2(f[2], f[3]); w.z = pk2(f[4], f[5]); w.w = pk2(f[6], f[7]); return w; }

namespace pg8 {
struct EpiGlu {
    static constexpr bool PERM = true, AFTER_DRAIN = false;
    const bf16* Y1; const bf16* PROJ; const float* bias; bf16* O;
    __device__ __forceinline__ void operator()(const f32x4 (&acc)[2][2][4][2], const Unit& u, int wr, int wc, int fr, int fq) const {
        int row0 = u.pm * BM + wr * 64 + fr, col0 = u.pn * BM + wc * 32 + 8 * fq;
        asm volatile("" : "+v"(row0), "+v"(col0));
        f32x4 bb[2][2];
#pragma unroll
        for (int bj = 0; bj < 2; ++bj) { bb[bj][0] = *(const f32x4*)(bias + col0 + bj * HALF); bb[bj][1] = *(const f32x4*)(bias + col0 + bj * HALF + 4); }
        u32x4 yc = *(const u32x4*)(Y1 + (size_t)row0 * 1024 + col0), zc = *(const u32x4*)(PROJ + (size_t)row0 * NINP + C_SZ + col0);
#pragma unroll
        for (int it = 0; it < 16; ++it) {
            const int bj = it >> 3, ai = (it >> 2) & 1, m = it & 3;
            const size_t row = (size_t)(row0 + ai * HALF + m * 16); const int col = col0 + bj * HALF;
            u32x4 yn = yc, zn = zc;
            if (it + 1 < 16) { const int nb = (it + 1) >> 3, na = ((it + 1) >> 2) & 1, nm = (it + 1) & 3; const size_t nrow = (size_t)(row0 + na * HALF + nm * 16); const int ncol = col0 + nb * HALF;
                yn = *(const u32x4*)(Y1 + nrow * 1024 + ncol); zn = *(const u32x4*)(PROJ + nrow * NINP + C_SZ + ncol); }
            float y[8], z[8], o[8]; unpack8(yc, y); unpack8(zc, z);
            const f32x4 v0 = acc[ai][bj][m][0] + bb[bj][0], v1 = acc[ai][bj][m][1] + bb[bj][1];
            const float a[8] = {v0[0], v0[1], v0[2], v0[3], v1[0], v1[1], v1[2], v1[3]};
#pragma unroll
            for (int e = 0; e < 8; ++e) o[e] = y[e] * sigmoidf_(a[e]) * siluf_(z[e]);
            *(u32x4*)(O + row * 1024 + col) = pack8(o);
            yc = yn; zc = zn;
            asm volatile("" ::: "memory");
        }
    }
};
struct EpiBranch {
    static constexpr bool PERM = true, AFTER_DRAIN = false;
    const bf16* PROJ; const float* gate_b; bf16* ACC; bf16* MRG;
    __device__ __forceinline__ void operator()(const f32x4 (&acc)[2][2][4][2], const Unit& u, int wr, int wc, int fr, int fq) const {
        const int br = u.pm >> 5, pm = u.pm & 31, pn = u.pn & 7;
        int row0 = pm * BM + wr * 64 + fr, col0 = pn * BM + wc * 32 + 8 * fq;
        asm volatile("" : "+v"(row0), "+v"(col0));
        bf16* dst = br < 2 ? ACC : MRG;
        const bf16* gl = PROJ + C_GATE + br * DM;
        f32x4 gb[2][2];
#pragma unroll
        for (int bj = 0; bj < 2; ++bj) { gb[bj][0] = *(const f32x4*)(gate_b + br * DM + col0 + bj * HALF); gb[bj][1] = *(const f32x4*)(gate_b + br * DM + col0 + bj * HALF + 4); }
        const u32x4 zero = {0u, 0u, 0u, 0u};
        u32x4 lc = *(const u32x4*)(gl + (size_t)row0 * NINP + col0), pc = br > 0 ? *(const u32x4*)(ACC + (size_t)row0 * DM + col0) : zero;
#pragma unroll
        for (int it = 0; it < 16; ++it) {
            const int bj = it >> 3, ai = (it >> 2) & 1, m = it & 3;
            const size_t row = (size_t)(row0 + ai * HALF + m * 16); const int col = col0 + bj * HALF;
            u32x4 ln = lc, pn_ = pc;
            if (it + 1 < 16) { const int nb = (it + 1) >> 3, na = ((it + 1) >> 2) & 1, nm = (it + 1) & 3; const size_t nrow = (size_t)(row0 + na * HALF + nm * 16); const int ncol = col0 + nb * HALF;
                ln = *(const u32x4*)(gl + nrow * NINP + ncol); pn_ = br > 0 ? *(const u32x4*)(ACC + nrow * DM + ncol) : zero; }
            float g[8], p[8], o[8]; unpack8(lc, g); unpack8(pc, p);
            const f32x4 v0 = acc[ai][bj][m][0], v1 = acc[ai][bj][m][1];
            const float a[8] = {v0[0], v0[1], v0[2], v0[3], v1[0], v1[1], v1[2], v1[3]};
            const float gbv[8] = {gb[bj][0][0], gb[bj][0][1], gb[bj][0][2], gb[bj][0][3], gb[bj][1][0], gb[bj][1][1], gb[bj][1][2], gb[bj][1][3]};
#pragma unroll
            for (int e = 0; e < 8; ++e) o[e] = sigmoidf_(g[e] + gbv[e]) * a[e] + p[e];
            *(u32x4*)(dst + row * DM + col) = pack8(o);
            lc = ln; pc = pn_;
            asm volatile("" ::: "memory");
        }
    }
};
struct EpiResid {
    static constexpr bool PERM = true, AFTER_DRAIN = false;
    const float* base; float* out; bf16* xn; const float* nw; unsigned long long* ss;
    __device__ __forceinline__ void operator()(const f32x4 (&acc)[2][2][4][2], const Unit& u, int wr, int wc, int fr, int fq) const {
        int row0 = u.pm * BM + wr * 64 + fr, col0 = u.pn * BM + wc * 32 + 8 * fq;
        asm volatile("" : "+v"(row0), "+v"(col0));
        f32x4 ww[2][2];
#pragma unroll
        for (int bj = 0; bj < 2; ++bj) { ww[bj][0] = *(const f32x4*)(nw + col0 + bj * HALF); ww[bj][1] = *(const f32x4*)(nw + col0 + bj * HALF + 4); }
        f32x4 bc[2][2];
#pragma unroll
        for (int bj = 0; bj < 2; ++bj) { const size_t off = (size_t)row0 * DM + col0 + bj * HALF; bc[bj][0] = *(const f32x4*)(base + off); bc[bj][1] = *(const f32x4*)(base + off + 4); }
#pragma unroll
        for (int it = 0; it < 8; ++it) {
            const int ai = it >> 2, m = it & 3; const int row = row0 + ai * HALF + m * 16;
            f32x4 bn[2][2];
#pragma unroll
            for (int bj = 0; bj < 2; ++bj) { bn[bj][0] = bc[bj][0]; bn[bj][1] = bc[bj][1]; }
            if (it + 1 < 8) { const int nrow = row0 + ((it + 1) >> 2) * HALF + ((it + 1) & 3) * 16;
#pragma unroll
                for (int bj = 0; bj < 2; ++bj) { const size_t off = (size_t)nrow * DM + col0 + bj * HALF; bn[bj][0] = *(const f32x4*)(base + off); bn[bj][1] = *(const f32x4*)(base + off + 4); } }
            float sq = 0.f;
#pragma unroll
            for (int bj = 0; bj < 2; ++bj) {
                const size_t off = (size_t)row * DM + col0 + bj * HALF;
                const f32x4 o0 = bc[bj][0] + acc[ai][bj][m][0], o1 = bc[bj][1] + acc[ai][bj][m][1];
                *(f32x4*)(out + off) = o0; *(f32x4*)(out + off + 4) = o1;
                if (xn) { const f32x4 w0 = ww[bj][0], w1 = ww[bj][1];
                    sq += (o0.x * o0.x + o0.y * o0.y) + (o0.z * o0.z + o0.w * o0.w) + (o1.x * o1.x + o1.y * o1.y) + (o1.z * o1.z + o1.w * o1.w);
                    u32x4 p; p.x = pk2(o0.x * w0.x, o0.y * w0.y); p.y = pk2(o0.z * w0.z, o0.w * w0.w); p.z = pk2(o1.x * w1.x, o1.y * w1.y); p.w = pk2(o1.z * w1.z, o1.w * w1.w);
                    *(u32x4*)(xn + off) = p; }
            }
            if (xn) { sq += __shfl_xor(sq, 16); sq += __shfl_xor(sq, 32); if (fq == 0) atomicAdd(ss + row, (unsigned long long)(sq * 65536.f + 0.5f)); }
#pragma unroll
            for (int bj = 0; bj < 2; ++bj) { bc[bj][0] = bn[bj][0]; bc[bj][1] = bn[bj][1]; }
            asm volatile("" ::: "memory");
        }
    }
};
struct EpiBf16Rs {
    static constexpr bool PERM = true, AFTER_DRAIN = false;
    bf16* O; int ldc; const unsigned long long* ss;
    __device__ __forceinline__ void operator()(const f32x4 (&acc)[2][2][4][2], const Unit& u, int wr, int wc, int fr, int fq) const {
        int row0 = u.pm * BM + wr * 64 + fr, col0 = u.pn * BM + wc * 32 + 8 * fq;
        asm volatile("" : "+v"(row0), "+v"(col0));
#pragma unroll
        for (int ai = 0; ai < 2; ++ai)
#pragma unroll
            for (int m = 0; m < 4; ++m) { const int row = row0 + ai * HALF + m * 16; const float rs = 1.f / sqrtf((float)ss[row] * (1.f / (65536.f * DM)) + 1e-6f);
                bf16* rowp = O + (size_t)row * ldc + col0;
#pragma unroll
                for (int bj = 0; bj < 2; ++bj) { const f32x4 v0 = acc[ai][bj][m][0] * rs, v1 = acc[ai][bj][m][1] * rs;
                    u32x4 w; w.x = cvt_pk_bf16(v0[0], v0[1]); w.y = cvt_pk_bf16(v0[2], v0[3]); w.z = cvt_pk_bf16(v1[0], v1[1]); w.w = cvt_pk_bf16(v1[2], v1[3]);
                    *(u32x4*)(rowp + bj * HALF) = w; } }
    }
};
struct BranchOrder {
    StaticOrder base;
    __device__ bool next(int i, Unit& u) const { Unit t; const int r = i / 3, br = i - 3 * r; if (!base.next(r, t)) return false; u.pm = br * 32 + t.pm; u.pn = br * 8 + t.pn; return true; }
    __device__ __forceinline__ void a_ready(const Unit&) const {}
    __device__ __forceinline__ void done(const Unit&) const {}
};
}

#define XB_TMO      128
#define XB_XCNT(j)  (256  + 64 * (j))
#define XB_XSUB(j)  (1280 + 64 * (j))
#define XB_XGEN(j)  (2304 + 64 * (j))
#define XB_TOP      3328
#define XB_TOPGEN   3392
#define XCD_BAR_WORDS 3456
#define XB_SPIN_CAP (1u << 18)

__device__ __forceinline__ unsigned xb_ld(unsigned* p)              { return __hip_atomic_load(p, __ATOMIC_RELAXED, __HIP_MEMORY_SCOPE_AGENT); }
__device__ __forceinline__ unsigned xb_add(unsigned* p, unsigned v) { return __hip_atomic_fetch_add(p, v, __ATOMIC_RELAXED, __HIP_MEMORY_SCOPE_AGENT); }
__device__ __forceinline__ unsigned xb_xcc_id() { return (unsigned)__builtin_amdgcn_s_getreg((3 << 11) | 20) & 0xFu; }
#define XB_SPIN(cond, bar) do { unsigned _sp = 0; while (cond) { __builtin_amdgcn_s_sleep(1); \
    if ((++_sp & 255u) == 0u) { if (xb_ld(&(bar)[XB_TMO])) break; if (_sp > XB_SPIN_CAP) { atomicAdd(&(bar)[XB_TMO], 1u); break; } } } } while (0)

struct XcdBarrier {
    unsigned* bar; unsigned x;
    volatile LAS unsigned* st;
};

__device__ __forceinline__ XcdBarrier xcd_barrier_post(unsigned* bar, volatile LAS unsigned* st) {
    XcdBarrier b; b.bar = bar; b.x = xb_xcc_id(); b.st = st;
    if (threadIdx.x == 0) (void)xb_add(&bar[XB_XCNT(b.x)], 1u);
    return b;
}
__device__ __forceinline__ void xcd_barrier_complete(unsigned* bar, unsigned x, unsigned& nloc, unsigned& nx) {
    const unsigned G = gridDim.x * gridDim.y * gridDim.z;
    unsigned sum, cnt, mine, sp = 0u;
    for (;;) {
        sum = 0u; cnt = 0u; mine = 0u;
#pragma unroll
        for (unsigned j = 0; j < 16; ++j) { const unsigned c = xb_ld(&bar[XB_XCNT(j)]); sum += c; cnt += (c > 0u) ? 1u : 0u; mine = (j == x) ? c : mine; }
        if (sum == G) break;
        __builtin_amdgcn_s_sleep(1);
        if ((++sp & 255u) == 0u) { if (xb_ld(&bar[XB_TMO])) break; if (sp > XB_SPIN_CAP) { atomicAdd(&bar[XB_TMO], 1u); break; } }
    }
    nloc = mine > 0u ? mine : 1u; nx = cnt > 0u ? cnt : 1u;
}

__device__ __forceinline__ void xcd_barrier(const XcdBarrier& b) {
    asm volatile("s_waitcnt vmcnt(0)" ::: "memory");
    __syncthreads();
    if (threadIdx.x == 0) {
        unsigned* bar = b.bar;
        __builtin_amdgcn_s_waitcnt(0);
        unsigned nloc = b.st[0], nx = b.st[1];
        if (nloc == 0u) { xcd_barrier_complete(bar, b.x, nloc, nx); b.st[0] = nloc; b.st[1] = nx; }
        const unsigned old = xb_add(&bar[XB_XSUB(b.x)], 1u);
        const unsigned gen = old / nloc;
        if (old + 1u == (gen + 1u) * nloc) {
            __builtin_amdgcn_fence(__ATOMIC_RELEASE, "agent");
            asm volatile("s_waitcnt vmcnt(0)" ::: "memory");
            const unsigned og = xb_add(&bar[XB_TOP], 1u);
            const unsigned tg = og / nx;
            if (og + 1u == (tg + 1u) * nx) xb_add(&bar[XB_TOPGEN], 1u);
            else XB_SPIN(xb_ld(&bar[XB_TOPGEN]) == tg, bar);
            __builtin_amdgcn_fence(__ATOMIC_ACQUIRE, "agent");
            xb_add(&bar[XB_XGEN(b.x)], 1u);
            asm volatile("s_waitcnt vmcnt(0)" ::: "memory");
        } else {
            XB_SPIN(xb_ld(&bar[XB_XGEN(b.x)]) == gen, bar);
            __builtin_amdgcn_fence(__ATOMIC_ACQUIRE, "agent");
            asm volatile("s_waitcnt vmcnt(0)" ::: "memory");
        }
    }
    __syncthreads();
}

struct Args { const float* in[31]; float* out; unsigned char* ws; int ph_lo, ph_hi; };
struct Ctx { int tid, lane, wave, vcu, G, gw, NGW; LAS unsigned char* lds; unsigned char* ws; };

__device__ __forceinline__ void transpose_item(const float* W, int K, int N, bf16* WT, LAS float* scr, int kb, int nb, int lane) {
    const int k0 = 64 * kb, n0 = 64 * nb, nq = 4 * (lane & 15), kr = lane >> 4; const bool nv = n0 + nq < N;
    f32x4 v[16];
#pragma unroll
    for (int i = 0; i < 16; ++i) v[i] = nv ? *(const f32x4*)(W + (size_t)(k0 + 4 * i + kr) * N + n0 + nq) : (f32x4){0.f, 0.f, 0.f, 0.f};
#pragma unroll
    for (int i = 0; i < 16; ++i) { LAS float* d = scr + (4 * i + kr) * 65 + nq; d[0] = v[i].x; d[1] = v[i].y; d[2] = v[i].z; d[3] = v[i].w; }
    asm volatile("s_waitcnt lgkmcnt(0)" ::: "memory");
    const int c = lane & 7;
#pragma unroll
    for (int j = 0; j < 8; ++j) { const int nn = (lane >> 3) + 8 * j; const LAS float* s = scr + (8 * c) * 65 + nn;
        u32x4 o; o.x = pk2(s[0 * 65], s[1 * 65]); o.y = pk2(s[2 * 65], s[3 * 65]); o.z = pk2(s[4 * 65], s[5 * 65]); o.w = pk2(s[6 * 65], s[7 * 65]);
        *(u32x4*)(WT + (size_t)(n0 + nn) * K + k0 + 8 * c) = o; }
    asm volatile("s_waitcnt lgkmcnt(0)" ::: "memory");
}

__device__ __forceinline__ void rms_row(const float* xrow, const float* w, bf16* obf, unsigned long long* ss, float* of32, int lane) {
    f32x4 v[8]; float s = 0.f;
#pragma unroll
    for (int j = 0; j < 8; ++j) { v[j] = *(const f32x4*)(xrow + 4 * lane + 256 * j); s += (v[j].x * v[j].x + v[j].y * v[j].y) + (v[j].z * v[j].z + v[j].w * v[j].w); }
    s = wave_sum(s);
    const float r = obf ? 1.f : 1.f / sqrtf(s * (1.f / DM) + 1e-6f);
#pragma unroll
    for (int j = 0; j < 8; ++j) { const f32x4 ww = *(const f32x4*)(w + 4 * lane + 256 * j); const f32x4 o = v[j] * r * ww;
        if (obf) { u32x2 p; p.x = pk2(o.x, o.y); p.y = pk2(o.z, o.w); *(u32x2*)(obf + 4 * lane + 256 * j) = p; }
        else *(f32x4*)(of32 + 4 * lane + 256 * j) = o; }
    if (obf && lane == 0) *ss = (unsigned long long)(s * 65536.f + 0.5f);
}

__device__ __forceinline__ void convert_layer(const Ctx& F, const Args& a, int l, int gw, int ngw) {
    LAS float* scr = (LAS float*)(F.lds + F.wave * 16640);
    constexpr int I_IN = 32 * 260, I_GLU = 16 * 16, I_BR = 16 * 32, I_OUT = 32 * 32, IL = I_IN + I_GLU + 3 * I_BR + I_OUT;
    bf16* WIN = (bf16*)(F.ws + WS_WIN); bf16* WGLU = (bf16*)(F.ws + WS_WGLU); bf16* WBR = (bf16*)(F.ws + WS_WBR); bf16* WOUT = (bf16*)(F.ws + WS_WOUT);
    for (int it = gw; it < IL; it += ngw) {
        int r = it;
        if (r < I_IN) { transpose_item(a.in[2] + (size_t)l * DM * NIN, DM, NIN, WIN + (size_t)l * NINP * DM, scr, r / 260, r % 260, F.lane); continue; } r -= I_IN;
        if (r < I_GLU) { transpose_item(a.in[25] + (size_t)l * 1024 * 1024, 1024, 1024, WGLU + (size_t)l * 1024 * 1024, scr, r / 16, r % 16, F.lane); continue; } r -= I_GLU;
        if (r < 3 * I_BR) { const int br = r / I_BR, r2 = r - br * I_BR;
            transpose_item(a.in[28] + (size_t)(l * 3 + br) * 1024 * DM, 1024, DM, WBR + (size_t)(l * 3 + br) * DM * 1024, scr, r2 / 32, r2 % 32, F.lane); continue; } r -= 3 * I_BR;
        transpose_item(a.in[29] + (size_t)l * DM * DM, DM, DM, WOUT + (size_t)l * DM * DM, scr, r / 32, r % 32, F.lane);
    }
}

__device__ __forceinline__ void phase0(const Ctx& F, const Args& a) {
    convert_layer(F, a, 0, F.gw, F.NGW);
    {
        bf16* LT = (bf16*)(F.ws + WS_LORA);
        for (int it = F.gw * 64 + F.lane; it < DEPTH * 2 * 1024 * 12; it += F.NGW * 64) {
            const int kg = it % 12, n = (it / 12) & 1023, lw = it / (12 * 1024), l = lw >> 1, which = lw & 1;
            const float* src = (which ? a.in[11] : a.in[9]) + (size_t)l * 96 * 1024 + (size_t)(8 * kg) * 1024 + n;
            u32x4 o; o.x = pk2(src[0], src[1024]); o.y = pk2(src[2048], src[3072]); o.z = pk2(src[4096], src[5120]); o.w = pk2(src[6144], src[7168]);
            *(u32x4*)(LT + ((size_t)lw * 1024 + n) * 96 + 8 * kg) = o;
        }
    }
    bf16* XN = (bf16*)(F.ws + WS_XN);
    unsigned long long* SS0 = (unsigned long long*)(F.ws + WS_CTL + CTL_SS);
    for (int m = F.gw; m < TOK; m += F.NGW) rms_row(a.in[0] + (size_t)m * DM, a.in[1], XN + (size_t)m * DM, SS0 + m, nullptr, F.lane);
}

__device__ __forceinline__ void prep_gdn(const Ctx& F, const Args& a, int l) {
    const bf16* PROJ = (const bf16*)(F.ws + WS_PROJ);
    float* GQ = (float*)(F.ws + WS_GQ); float* GK = (float*)(F.ws + WS_GK); float* GV = (float*)(F.ws + WS_GV); float* GEG = (float*)(F.ws + WS_GEG); float* GBE = (float*)(F.ws + WS_GBE); f32x4* GSC = (f32x4*)(F.ws + WS_GSC);
    const float* cw = a.in[3] + (size_t)l * 4 * 3072;
    for (int it = F.gw; it < 2048; it += F.NGW) {
        const int h = it & 7, ch = (it >> 3) & 63, b = it >> 9;
        const int t0 = ch * 32; const int c = 2 * F.lane;
        float w[3][4][2], hist[3][3][2];
#pragma unroll
        for (int p = 0; p < 3; ++p)
#pragma unroll
            for (int j = 0; j < 4; ++j) { const f32x2 ww = *(const f32x2*)(cw + j * 3072 + p * 1024 + h * 128 + c); w[p][j][0] = ww.x; w[p][j][1] = ww.y; }
#pragma unroll
        for (int p = 0; p < 3; ++p)
#pragma unroll
            for (int j = 0; j < 3; ++j) { const int t = t0 - 3 + j; unsigned x = 0u;
                if (t >= 0) x = *(const unsigned*)(PROJ + (size_t)(b * SEQ + t) * NINP + C_GQKV + p * 1024 + h * 128 + c);
                hist[p][j][0] = bflo(x); hist[p][j][1] = bfhi(x); }
        const float alog = a.in[4][l * 8 + h], dtb = a.in[5][l * 8 + h]; const float aexp = expf(alog);
        float kp0 = 0.f, kp1 = 0.f, qkprev = 0.f;
        unsigned raw[3][32];
#pragma unroll
        for (int tt = 0; tt < 32; ++tt)
#pragma unroll
            for (int p = 0; p < 3; ++p) raw[p][tt] = *(const unsigned*)(PROJ + (size_t)(b * SEQ + t0 + tt) * NINP + C_GQKV + p * 1024 + h * 128 + c);
#pragma unroll
        for (int tt = 0; tt < 32; ++tt) {
            const size_t tok = (size_t)(b * SEQ + t0 + tt);
            float o[3][2];
#pragma unroll
            for (int p = 0; p < 3; ++p) {
                const unsigned x = raw[p][tt];
                const float x0 = bflo(x), x1 = bfhi(x);
                const float y0 = w[p][0][0] * hist[p][0][0] + w[p][1][0] * hist[p][1][0] + w[p][2][0] * hist[p][2][0] + w[p][3][0] * x0;
                const float y1 = w[p][0][1] * hist[p][0][1] + w[p][1][1] * hist[p][1][1] + w[p][2][1] * hist[p][2][1] + w[p][3][1] * x1;
                hist[p][0][0] = hist[p][1][0]; hist[p][1][0] = hist[p][2][0]; hist[p][2][0] = x0;
                hist[p][0][1] = hist[p][1][1]; hist[p][1][1] = hist[p][2][1]; hist[p][2][1] = x1;
                o[p][0] = siluf_(y0); o[p][1] = siluf_(y1);
            }
            const float sq = wave_sum(o[0][0] * o[0][0] + o[0][1] * o[0][1]), sk = wave_sum(o[1][0] * o[1][0] + o[1][1] * o[1][1]);
            const float rq = 0.08838834764831845f * rsqrtf(sq + 1e-6f), rk = rsqrtf(sk + 1e-6f);
            const size_t off = tok * 1024 + h * 128 + c;
            const unsigned qp = pk2(o[0][0] * rq, o[0][1] * rq), kp = pk2(o[1][0] * rk, o[1][1] * rk);
            *(unsigned*)((bf16*)GQ + off) = qp;
            *(unsigned*)((bf16*)GK + off) = kp;
            *(unsigned*)((bf16*)GV + off) = pk2(o[2][0], o[2][1]);
            {
                const float qn0 = bflo(qp), qn1 = bfhi(qp), kn0 = bflo(kp), kn1 = bfhi(kp);
                const float qk = wave_sum(qn0 * kn0 + qn1 * kn1);
                if (tt & 1) { const float kk = wave_sum(kp0 * kn0 + kp1 * kn1), qkp = wave_sum(qn0 * kp0 + qn1 * kp1);
                    if (F.lane == 0) GSC[(tok >> 1) * 8 + h] = (f32x4){kk, qkprev, qkp, qk}; }
                else { kp0 = kn0; kp1 = kn1; qkprev = qk; }
            }
            if (F.lane == 0) {
                const float bl = bf1(PROJ[tok * NINP + C_GB + h]), al = bf1(PROJ[tok * NINP + C_GA + h]);
                GBE[tok * 8 + h] = sigmoidf_(bl);
                GEG[tok * 8 + h] = expf(-aexp * softplusf_(al + dtb));
            }
        }
    }
}

__device__ __forceinline__ float mix2(unsigned c, unsigned p, float mu0, float mu1, float& o1) {
    const float c0 = bflo(c), c1 = bfhi(c), p0 = bflo(p), p1 = bfhi(p);
    o1 = c1 + (p1 - c1) * mu1; return c0 + (p0 - c0) * mu0;
}
__device__ __forceinline__ void prep_rwkv(const Ctx& F, const Args& a, int l) {
    const bf16* PROJ = (const bf16*)(F.ws + WS_PROJ);
    float* RR = (float*)(F.ws + WS_RR); float* RW = (float*)(F.ws + WS_RW); float* RK = (float*)(F.ws + WS_RK); float* RV = (float*)(F.ws + WS_RV);
    float* RKK = (float*)(F.ws + WS_RKK); float* RKA = (float*)(F.ws + WS_RKA); float* RBON = (float*)(F.ws + WS_RBON);
    const float* mu = a.in[7] + (size_t)l * 3264; const float* w0 = a.in[8] + l * 1024; const float* wup = a.in[9] + (size_t)l * 96 * 1024;
    const float* a0 = a.in[10] + l * 1024; const float* aup = a.in[11] + (size_t)l * 96 * 1024; const float* kk_ = a.in[12] + l * 1024; const float* ka_ = a.in[13] + l * 1024; const float* rk_ = a.in[14] + l * 1024;
    constexpr int AROW = 104;
    LAS bf16* A1 = (LAS bf16*)F.lds; LAS bf16* A2 = A1 + 16 * AROW;
    LAS float* LW = (LAS float*)(F.lds + 8192); LAS float* LA = LW + 16 * 1024;
    const bf16* LTw = (const bf16*)(F.ws + WS_LORA) + (size_t)(2 * l) * 1024 * 96; const bf16* LTa = LTw + 1024 * 96;
    const int j = F.tid, c = 2 * j;
    const f32x2 mur = *(const f32x2*)(mu + c), muk = *(const f32x2*)(mu + 1024 + c), muv = *(const f32x2*)(mu + 2048 + c);
    const f32x2 w0v = *(const f32x2*)(w0 + c), a0v = *(const f32x2*)(a0 + c), kkv = *(const f32x2*)(kk_ + c), kav = *(const f32x2*)(ka_ + c), rkv = *(const f32x2*)(rk_ + c);
    for (int tile = F.vcu; tile < TOK / 16; tile += F.G) {
        __syncthreads();
        for (int e = F.tid; e < 16 * 192; e += NTHREADS) {
            const int tl = e / 192, i = e - tl * 192; const size_t tok = (size_t)tile * 16 + tl;
            const float cur = bf1(PROJ[tok * NINP + C_RF + 3072 + i]);
            const float prv = (tok & (SEQ - 1)) ? bf1(PROJ[(tok - 1) * NINP + C_RF + 3072 + i]) : 0.f;
            const float m = cur + (prv - cur) * mu[3072 + i];
            if (i < 96) A1[tl * AROW + i] = (bf16)f2bf(tanhf(m)); else A2[tl * AROW + i - 96] = (bf16)f2bf(m);
        }
        __syncthreads();
        {
            const int row = F.lane & 15, quad = F.lane >> 4;
            bf16x8_t fw[3], fa[3];
#pragma unroll
            for (int ks = 0; ks < 3; ++ks) { fw[ks] = *(const LAS bf16x8_t*)(A1 + row * AROW + 32 * ks + 8 * quad); fa[ks] = *(const LAS bf16x8_t*)(A2 + row * AROW + 32 * ks + 8 * quad); }
#pragma unroll 2
            for (int nt = 0; nt < 8; ++nt) {
                const int n = 128 * F.wave + 16 * nt + row;
                f32x4 aw = {0.f, 0.f, 0.f, 0.f}, aa = {0.f, 0.f, 0.f, 0.f};
#pragma unroll
                for (int ks = 0; ks < 3; ++ks) {
                    const bf16x8_t bw = *(const bf16x8_t*)(LTw + (size_t)n * 96 + 32 * ks + 8 * quad), ba = *(const bf16x8_t*)(LTa + (size_t)n * 96 + 32 * ks + 8 * quad);
                    aw = __builtin_amdgcn_mfma_f32_16x16x32_bf16(fw[ks], bw, aw, 0, 0, 0); aa = __builtin_amdgcn_mfma_f32_16x16x32_bf16(fa[ks], ba, aa, 0, 0, 0);
                    asm volatile("" :: "v"(bw), "v"(ba));
                }
#pragma unroll
                for (int r = 0; r < 4; ++r) { LW[(4 * quad + r) * 1024 + n] = aw[r]; LA[(4 * quad + r) * 1024 + n] = aa[r]; }
            }
        }
        __syncthreads();
        unsigned rw[17][3];
#pragma unroll
        for (int tl = 0; tl < 17; ++tl) { const size_t tok = (size_t)tile * 16 + tl - 1; const bool ok = tl > 0 || ((tok + 1) & (SEQ - 1)) != 0;
            const bf16* cp = PROJ + tok * NINP + C_RF + c;
#pragma unroll
            for (int q = 0; q < 3; ++q) rw[tl][q] = ok ? *(const unsigned*)(cp + 1024 * q) : 0u; }
#pragma unroll
        for (int tl = 0; tl < 16; ++tl) {
            const size_t tok = (size_t)tile * 16 + tl; const bool hp = (tok & (SEQ - 1)) != 0;
            const unsigned cr = rw[tl + 1][0], ck = rw[tl + 1][1], cv = rw[tl + 1][2];
            const unsigned pr = hp ? rw[tl][0] : 0u, pk = hp ? rw[tl][1] : 0u, pv = hp ? rw[tl][2] : 0u;
            float r1, k1, v1; const float r0 = mix2(cr, pr, mur.x, mur.y, r1), k0 = mix2(ck, pk, muk.x, muk.y, k1), v0 = mix2(cv, pv, muv.x, muv.y, v1);
            const f32x2 lw = *(const LAS f32x2*)(LW + tl * 1024 + c), la = *(const LAS f32x2*)(LA + tl * 1024 + c);
            const float wp0 = w0v.x + lw.x, wp1 = w0v.y + lw.y;
            const float d0 = __expf(-0.6065306597126334f * sigmoidf_(wp0)), d1 = __expf(-0.6065306597126334f * sigmoidf_(wp1));
            const float aa0 = sigmoidf_(a0v.x + la.x), aa1 = sigmoidf_(a0v.y + la.y);
            const float q0 = k0 * kkv.x, q1 = k1 * kkv.y;
            float ss = q0 * q0 + q1 * q1;
#pragma unroll
            for (int o = 1; o < 32; o <<= 1) ss += __shfl_xor(ss, o);
            const float rn = rsqrtf(ss + 1e-6f); const float n0 = q0 * rn, n1 = q1 * rn;
            const float km0 = k0 * (1.f + (aa0 - 1.f) * kav.x), km1 = k1 * (1.f + (aa1 - 1.f) * kav.y);
            float bo = r0 * km0 * rkv.x + r1 * km1 * rkv.y;
#pragma unroll
            for (int o = 1; o < 32; o <<= 1) bo += __shfl_xor(bo, o);
            const size_t off = tok * 1024 + c;
            *(unsigned*)((bf16*)RR + off) = pk2(r0, r1); *(f32x2*)(RW + off) = (f32x2){d0, d1}; *(unsigned*)((bf16*)RK + off) = pk2(km0, km1); *(unsigned*)((bf16*)RV + off) = pk2(v0, v1);
            *(f32x2*)(RKK + off) = (f32x2){-n0, -n1}; *(unsigned*)((bf16*)RKA + off) = pk2(n0 * aa0, n1 * aa1);
            if ((F.lane & 31) == 0) RBON[tok * 16 + (c >> 6)] = bo;
        }
    }
}

#ifndef SCM
#define SCM 7
#endif
#ifndef REPM
#define REPM 0
#endif
constexpr int CH = 32;
#define WFENCE() do { __builtin_amdgcn_fence(__ATOMIC_RELEASE, "wavefront"); asm volatile("s_waitcnt lgkmcnt(0)" ::: "memory"); __builtin_amdgcn_wave_barrier(); __builtin_amdgcn_fence(__ATOMIC_ACQUIRE, "wavefront"); } while (0)

struct GPair { f32x4 k1a, k1b, k2a, k2b, q1a, q1b, q2a, q2b, eb, sc; float v1, v2; };
constexpr int G_BUF = 2 * CH * 128 + CH * 32 + 4 * CH;
__device__ __forceinline__ void gdn_lds(GPair& s, const LAS float* buf, int pr, int rg, int colL) {
    const LAS float* kp = buf + 2 * pr * 128 + rg * 4; const LAS float* qp = kp + CH * 128;
    s.k1a = *(const LAS f32x4*)kp; s.k1b = *(const LAS f32x4*)(kp + 64); s.k2a = *(const LAS f32x4*)(kp + 128); s.k2b = *(const LAS f32x4*)(kp + 192);
    s.q1a = *(const LAS f32x4*)qp; s.q1b = *(const LAS f32x4*)(qp + 64); s.q2a = *(const LAS f32x4*)(qp + 128); s.q2b = *(const LAS f32x4*)(qp + 192);
    s.v1 = buf[2 * CH * 128 + 2 * pr * 32 + colL]; s.v2 = buf[2 * CH * 128 + (2 * pr + 1) * 32 + colL];
    s.eb = *(const LAS f32x4*)(buf + 2 * CH * 128 + CH * 32 + 4 * pr); s.sc = *(const LAS f32x4*)(buf + 2 * CH * 128 + CH * 32 + 2 * CH + 4 * pr);
}
__device__ __forceinline__ float dot8(const f32x4 a, const f32x4 b, const f32x2 (&S)[4]) { const f32x2 t = (a.xy * S[0] + a.zw * S[1]) + (b.xy * S[2] + b.zw * S[3]); return t.x + t.y; }
#define DPP4(CTRL) do { d1 += dppf<CTRL>(d1); d2 += dppf<CTRL>(d2); e1 += dppf<CTRL>(e1); e2 += dppf<CTRL>(e2); } while (0)
__device__ __forceinline__ void gdn_pair(const GPair& s, f32x2 (&S)[4], LAS float* ob, bool wr) {
    float d1 = dot8(s.k1a, s.k1b, S), d2 = dot8(s.k2a, s.k2b, S), e1 = dot8(s.q1a, s.q1b, S), e2 = dot8(s.q2a, s.q2b, S);
    DPP4(0xB1); DPP4(0x4E); DPP4(0x141); DPP4(0x140);
    const float g1 = s.eb.x, b1 = s.eb.y, g2 = s.eb.z, b2 = s.eb.w;
    const float c1 = b1 * (s.v1 - g1 * d1);
    const float c2 = b2 * (s.v2 - g2 * (g1 * d2 + c1 * s.sc.x));
    const float o1 = g1 * e1 + c1 * s.sc.y;
    const float o2 = g2 * (g1 * e2 + c1 * s.sc.z) + c2 * s.sc.w;
    const float gg = g1 * g2, f1 = g2 * c1;
    S[0] = S[0] * gg + s.k1a.xy * f1 + s.k2a.xy * c2; S[1] = S[1] * gg + s.k1a.zw * f1 + s.k2a.zw * c2;
    S[2] = S[2] * gg + s.k1b.xy * f1 + s.k2b.xy * c2; S[3] = S[3] * gg + s.k1b.zw * f1 + s.k2b.zw * c2;
    if (wr) { ob[0] = o1; ob[32] = o2; }
}
#undef DPP4
struct GStage { u32x4 k, q, v; f32x4 sc; float e; };
__device__ __forceinline__ void gdn_gload(GStage& g, const bf16* GK, const bf16* GQ, const bf16* GV, const float* GEG, const float* GBE, const f32x4* GSC, int t0, int tid) {
    { const int st = tid >> 4, f8 = tid & 15; g.k = *(const u32x4*)(GK + (size_t)(t0 + st) * 1024 + 8 * f8); g.q = *(const u32x4*)(GQ + (size_t)(t0 + st) * 1024 + 8 * f8); }
    { const int i = tid & 127; g.v = *(const u32x4*)(GV + (size_t)(t0 + (i >> 2)) * 1024 + 8 * (i & 3)); }
    { const int i = tid & 63; const float* p = (i < 32 ? GEG : GBE); g.e = p[(size_t)(t0 + (i & 31)) * 8]; }
    g.sc = GSC[(size_t)((t0 >> 1) + (tid & 15)) * 8];
}
__device__ __forceinline__ void st8(LAS float* d, const u32x4 w) { float f[8]; unpack8(w, f); *(LAS f32x4*)d = (f32x4){f[0], f[1], f[2], f[3]}; *(LAS f32x4*)(d + 4) = (f32x4){f[4], f[5], f[6], f[7]}; }
__device__ __forceinline__ void gdn_gstore(const GStage& g, LAS float* buf, int tid) {
    st8(buf + 8 * tid, g.k); st8(buf + CH * 128 + 8 * tid, g.q);
    if (tid < 128) st8(buf + 2 * CH * 128 + 8 * tid, g.v);
    else if (tid >= 256 && tid < 320) { const int i = tid - 256, st = i & 31, wh = i >> 5; buf[2 * CH * 128 + CH * 32 + (st >> 1) * 4 + (st & 1) * 2 + wh] = g.e; }
    else if (tid >= 320 && tid < 336) *(LAS f32x4*)(buf + 2 * CH * 128 + CH * 32 + 2 * CH + 4 * (tid - 320)) = g.sc;
}
__device__ __forceinline__ void gdn_block(const Ctx& F, int vb) {
    const int bh = vb >> 2, qt = vb & 3, b = bh >> 3, h = bh & 7, colL = F.wave * 4 + (F.lane >> 4), rg = F.lane & 15;
    const size_t base = (size_t)b * SEQ;
    const bf16* GK = (const bf16*)(F.ws + WS_GK) + base * 1024 + h * 128; const bf16* GQ = (const bf16*)(F.ws + WS_GQ) + base * 1024 + h * 128;
    const bf16* GV = (const bf16*)(F.ws + WS_GV) + base * 1024 + h * 128 + qt * 32;
    const float* GEG = (const float*)(F.ws + WS_GEG) + base * 8 + h; const float* GBE = (const float*)(F.ws + WS_GBE) + base * 8 + h;
    const f32x4* GSC = (const f32x4*)(F.ws + WS_GSC) + (base >> 1) * 8 + h;
    float* GO = (float*)(F.ws + WS_GO) + base * 1024 + h * 128 + qt * 32;
    LAS float* lb = (LAS float*)F.lds; LAS float* obase = lb + 2 * G_BUF;
    f32x2 S[4] = {{0.f, 0.f}, {0.f, 0.f}, {0.f, 0.f}, {0.f, 0.f}};
    const bool wr = rg == 0;
    GStage g;
    gdn_gload(g, GK, GQ, GV, GEG, GBE, GSC, 0, F.tid); gdn_gstore(g, lb, F.tid);
    __syncthreads();
    for (int c = 0; c < SEQ / CH; ++c) {
        const LAS float* buf = lb + (c & 1) * G_BUF; LAS float* ob = obase + (c & 1) * (CH * 32) + colL;
        if (c + 1 < SEQ / CH) gdn_gload(g, GK, GQ, GV, GEG, GBE, GSC, (c + 1) * CH, F.tid);
        GPair P0, P1;
        gdn_lds(P0, buf, 0, rg, colL);
#pragma unroll 2
        for (int pr = 0; pr < CH / 2; pr += 2) {
            gdn_lds(P1, buf, pr + 1, rg, colL); gdn_pair(P0, S, ob + 2 * pr * 32, wr);
            gdn_lds(P0, buf, (pr + 2) & (CH / 2 - 1), rg, colL); gdn_pair(P1, S, ob + (2 * pr + 2) * 32, wr);
        }
        if (c + 1 < SEQ / CH) gdn_gstore(g, lb + ((c + 1) & 1) * G_BUF, F.tid);
        __syncthreads();
        if (F.tid < 256) *(f32x4*)(GO + (size_t)(c * CH + (F.tid >> 3)) * 1024 + 4 * (F.tid & 7)) = *(const LAS f32x4*)(obase + (c & 1) * (CH * 32) + 4 * F.tid);
    }
}

struct RStep { f32x4 w, n, a, k, r; float v; };
constexpr int R_BUF = CH * (5 * 64 + 32);
__device__ __forceinline__ void rwkv_lds(RStep& s, const LAS float* buf, int st, int cq, int rowL) {
    s.w = *(const LAS f32x4*)(buf + st * 64 + 4 * cq); s.n = *(const LAS f32x4*)(buf + CH * 64 + st * 64 + 4 * cq); s.a = *(const LAS f32x4*)(buf + 2 * CH * 64 + st * 64 + 4 * cq);
    s.k = *(const LAS f32x4*)(buf + 3 * CH * 64 + st * 64 + 4 * cq); s.r = *(const LAS f32x4*)(buf + 4 * CH * 64 + st * 64 + 4 * cq); s.v = buf[5 * CH * 64 + st * 32 + rowL];
}
__device__ __forceinline__ void rwkv_step(const RStep& s, f32x4& S, LAS float* ob, bool wr) {
    float sa = (S.x * s.n.x + S.y * s.n.y) + (S.z * s.n.z + S.w * s.n.w);
    sa = allred16(sa);
    S = S * s.w + sa * s.a + s.v * s.k;
    float y = (S.x * s.r.x + S.y * s.r.y) + (S.z * s.r.z + S.w * s.r.w);
    y = allred16(y);
    if (wr) *ob = y;
}
struct RStage { f32x4 x[2]; u32x4 y[3], v; };
__device__ __forceinline__ void rwkv_gload(RStage& g, const float* RW, const float* RN, const bf16* RA, const bf16* RKp, const bf16* RRp, const bf16* RV, int t0, int tid) {
    { const int st = tid >> 4, f4 = tid & 15; g.x[0] = *(const f32x4*)(RW + (size_t)(t0 + st) * 1024 + 4 * f4); g.x[1] = *(const f32x4*)(RN + (size_t)(t0 + st) * 1024 + 4 * f4); }
    { const int i = tid & 255; const size_t o = (size_t)(t0 + (i >> 3)) * 1024 + 8 * (i & 7); g.y[0] = *(const u32x4*)(RA + o); g.y[1] = *(const u32x4*)(RKp + o); g.y[2] = *(const u32x4*)(RRp + o); }
    { const int i = tid & 127; g.v = *(const u32x4*)(RV + (size_t)(t0 + (i >> 2)) * 1024 + 8 * (i & 3)); }
}
__device__ __forceinline__ void rwkv_gstore(const RStage& g, LAS float* buf, int tid) {
    *(LAS f32x4*)(buf + 4 * tid) = g.x[0]; *(LAS f32x4*)(buf + CH * 64 + 4 * tid) = g.x[1];
    if (tid < 256) { st8(buf + 2 * CH * 64 + 8 * tid, g.y[0]); st8(buf + 3 * CH * 64 + 8 * tid, g.y[1]); st8(buf + 4 * CH * 64 + 8 * tid, g.y[2]); }
    else if (tid < 384) st8(buf + 5 * CH * 64 + 8 * (tid - 256), g.v);
}
__device__ __forceinline__ void rwkv_block(const Ctx& F, int vb) {
    const int bh = vb >> 1, hf = vb & 1, b = bh >> 4, h = bh & 15, rowL = F.wave * 4 + (F.lane >> 4), cq = F.lane & 15;
    const size_t base = (size_t)b * SEQ * 1024 + h * 64;
    const float* RW = (const float*)(F.ws + WS_RW) + base; const float* RN = (const float*)(F.ws + WS_RKK) + base;
    const bf16* RA = (const bf16*)(F.ws + WS_RKA) + base; const bf16* RKp = (const bf16*)(F.ws + WS_RK) + base; const bf16* RRp = (const bf16*)(F.ws + WS_RR) + base;
    const bf16* RV = (const bf16*)(F.ws + WS_RV) + base + hf * 32;
    float* RY = (float*)(F.ws + WS_RY) + base + hf * 32;
    LAS float* lb = (LAS float*)F.lds; LAS float* obase = lb + 2 * R_BUF;
    f32x4 S = {0.f, 0.f, 0.f, 0.f};
    const bool wr = cq == 0;
    RStage g;
    rwkv_gload(g, RW, RN, RA, RKp, RRp, RV, 0, F.tid); rwkv_gstore(g, lb, F.tid);
    __syncthreads();
    for (int c = 0; c < SEQ / CH; ++c) {
        const LAS float* buf = lb + (c & 1) * R_BUF; LAS float* ob = obase + (c & 1) * (CH * 32) + rowL;
        if (c + 1 < SEQ / CH) rwkv_gload(g, RW, RN, RA, RKp, RRp, RV, (c + 1) * CH, F.tid);
        RStep R0, R1, R2, R3;
        rwkv_lds(R0, buf, 0, cq, rowL); rwkv_lds(R1, buf, 1, cq, rowL);
#pragma unroll 2
        for (int s = 0; s < CH; s += 4) {
            rwkv_lds(R2, buf, s + 2, cq, rowL); rwkv_step(R0, S, ob + s * 32, wr);
            rwkv_lds(R3, buf, s + 3, cq, rowL); rwkv_step(R1, S, ob + (s + 1) * 32, wr);
            rwkv_lds(R0, buf, (s + 4) & (CH - 1), cq, rowL); rwkv_step(R2, S, ob + (s + 2) * 32, wr);
            rwkv_lds(R1, buf, (s + 5) & (CH - 1), cq, rowL); rwkv_step(R3, S, ob + (s + 3) * 32, wr);
        }
        if (c + 1 < SEQ / CH) rwkv_gstore(g, lb + ((c + 1) & 1) * R_BUF, F.tid);
        __syncthreads();
        if (F.tid < 256) *(f32x4*)(RY + (size_t)(c * CH + (F.tid >> 3)) * 1024 + 4 * (F.tid & 7)) = *(const LAS f32x4*)(obase + (c & 1) * (CH * 32) + 4 * F.tid);
    }
}

constexpr int S5_SROW = 136;
constexpr int S5_BROW = 20;
constexpr int S5_WAVE_B = 16 * S5_SROW * 2 + 1024 + 128 * S5_BROW * 4;
__device__ __forceinline__ void s5_block(const Ctx& F, const Args& a, int l, int it) {
    const int b = it >> 6, g = it & 63, p = F.lane, tl = F.lane >> 4, c = F.lane & 15, w = F.wave;
    const bf16* PROJ = (const bf16*)(F.ws + WS_PROJ); bf16* SY = (bf16*)(F.ws + WS_SY);
    LAS float* se = (LAS float*)F.lds;
    LAS unsigned char* wb = F.lds + 4096 + w * S5_WAVE_B;
    LAS bf16* sbuf = (LAS bf16*)wb; LAS float* uall = (LAS float*)(wb + 16 * S5_SROW * 2); LAS float* BU = uall + 256;
    const float dt = expf(a.in[19][l * 64 + g]);
    float abr, abi;
    {   const size_t gp = ((size_t)l * 64 + g) * 64 + p; const float are = a.in[17][gp], aim = a.in[18][gp]; const float mag = expf(are * dt); abr = mag * cosf(aim * dt); abi = mag * sinf(aim * dt); }
    bf16x8_t Bf[8];
    {   const int hl = tl >> 1, c0 = 8 * (tl & 1);
#pragma unroll
        for (int jj = 0; jj < 4; ++jj) {
            const size_t gp2 = ((size_t)l * 64 + g) * 64 + 16 * jj + c; const float are = a.in[17][gp2], aim = a.in[18][gp2];
            const float mag = expf(are * dt), ar = mag * cosf(aim * dt), ai = mag * sinf(aim * dt);
            const float den = are * are + aim * aim, cr = ((ar - 1.f) * are + ai * aim) / den, ci = (ai * are - (ar - 1.f) * aim) / den;
            const f32x4 r0 = *(const f32x4*)(a.in[20] + gp2 * 16 + c0), r1 = *(const f32x4*)(a.in[20] + gp2 * 16 + c0 + 4), i0 = *(const f32x4*)(a.in[21] + gp2 * 16 + c0), i1 = *(const f32x4*)(a.in[21] + gp2 * 16 + c0 + 4);
            const float br[8] = {r0.x, r0.y, r0.z, r0.w, r1.x, r1.y, r1.z, r1.w}, bi[8] = {i0.x, i0.y, i0.z, i0.w, i1.x, i1.y, i1.z, i1.w};
            float vr[8], vi[8];
#pragma unroll
            for (int e = 0; e < 8; ++e) { const float xr = cr * br[e] - ci * bi[e], xi = cr * bi[e] + ci * br[e];
                const float hr = bflo(pk2(xr, 0.f)), hi = bflo(pk2(xi, 0.f)); vr[e] = hl ? xr - hr : hr; vi[e] = hl ? xi - hi : hi; }
            Bf[jj] = __builtin_bit_cast(bf16x8_t, pack8(vr)); Bf[4 + jj] = __builtin_bit_cast(bf16x8_t, pack8(vi));
        }
    }
    bf16x8_t Cf[4];
    { const size_t cb = (((size_t)l * 64 + g) * 16 + c) * 64;
#pragma unroll
      for (int m = 0; m < 4; ++m) { const int k0 = 32 * m + 8 * tl; const float* src = (k0 < 64 ? a.in[22] + cb + k0 : a.in[23] + cb + (k0 - 64)); const float sg = k0 < 64 ? 1.f : -1.f;
          const f32x4 x0 = *(const f32x4*)src, x1 = *(const f32x4*)(src + 4);
          u32x4 pk; pk.x = pk2(sg * x0.x, sg * x0.y); pk.y = pk2(sg * x0.z, sg * x0.w); pk.z = pk2(sg * x1.x, sg * x1.y); pk.w = pk2(sg * x1.z, sg * x1.w);
          Cf[m] = __builtin_bit_cast(bf16x8_t, pk); } }
    const float dsk = a.in[24][l * 1024 + g * 16 + c];
    const int tw = 256 * w;
    const bf16* up = PROJ + ((size_t)b * SEQ + tw + c) * NINP + C_SU + g * 16 + 8 * (tl & 1);
    float sr = 0.f, si = 0.f;
#define S5_BU(UF) do { const bf16x8_t af_ = __builtin_bit_cast(bf16x8_t, UF); \
        _Pragma("unroll") for (int j = 0; j < 8; ++j) { const f32x4 z_ = {0.f, 0.f, 0.f, 0.f}; const f32x4 d_ = __builtin_amdgcn_mfma_f32_16x16x32_bf16(af_, Bf[j], z_, 0, 0, 0); \
            *(LAS f32x4*)(BU + (16 * j + c) * S5_BROW + 4 * tl) = d_; } asm volatile("" :: "v"(af_)); } while (0)
    {
        u32x4 ucur = *(const u32x4*)up;
        for (int t = 0; t < 256; t += 16) {
            const u32x4 unxt = *(const u32x4*)(up + (size_t)((t + 16 < 256) ? t + 16 : t) * NINP);
            S5_BU(ucur);
            WFENCE();
            float br_[16], bi_[16];
#pragma unroll
            for (int q = 0; q < 4; ++q) { const f32x4 x = *(const LAS f32x4*)(BU + p * S5_BROW + 4 * q), y = *(const LAS f32x4*)(BU + (64 + p) * S5_BROW + 4 * q);
                br_[4 * q] = x.x; br_[4 * q + 1] = x.y; br_[4 * q + 2] = x.z; br_[4 * q + 3] = x.w; bi_[4 * q] = y.x; bi_[4 * q + 1] = y.y; bi_[4 * q + 2] = y.z; bi_[4 * q + 3] = y.w; }
#pragma unroll
            for (int s = 0; s < 16; ++s) { const float nr = abr * sr - abi * si + br_[s], ni = abr * si + abi * sr + bi_[s]; sr = nr; si = ni; }
            WFENCE();
            ucur = unxt;
        }
    }
    se[w * 128 + p] = sr; se[w * 128 + 64 + p] = si;
    __syncthreads();
    {
        float pr = abr, pi = abi;
#pragma unroll
        for (int i = 0; i < 8; ++i) { const float nr = pr * pr - pi * pi, ni = 2.f * pr * pi; pr = nr; pi = ni; }
        sr = 0.f; si = 0.f;
        for (int j = 0; j < w; ++j) { const float er = se[j * 128 + p], ei = se[j * 128 + 64 + p]; const float nr = pr * sr - pi * si + er, ni = pr * si + pi * sr + ei; sr = nr; si = ni; }
    }
    {
        u32x4 ucur = *(const u32x4*)up;
        for (int t = 0; t < 256; t += 16) {
            const u32x4 unxt = *(const u32x4*)(up + (size_t)((t + 16 < 256) ? t + 16 : t) * NINP);
            S5_BU(ucur);
            if (tl < 2) { float uf[8]; unpack8(ucur, uf); *(LAS f32x4*)(uall + c * 16 + 8 * tl) = (f32x4){uf[0], uf[1], uf[2], uf[3]}; *(LAS f32x4*)(uall + c * 16 + 8 * tl + 4) = (f32x4){uf[4], uf[5], uf[6], uf[7]}; }
            WFENCE();
            float br_[16], bi_[16];
#pragma unroll
            for (int q = 0; q < 4; ++q) { const f32x4 x = *(const LAS f32x4*)(BU + p * S5_BROW + 4 * q), y = *(const LAS f32x4*)(BU + (64 + p) * S5_BROW + 4 * q);
                br_[4 * q] = x.x; br_[4 * q + 1] = x.y; br_[4 * q + 2] = x.z; br_[4 * q + 3] = x.w; bi_[4 * q] = y.x; bi_[4 * q + 1] = y.y; bi_[4 * q + 2] = y.z; bi_[4 * q + 3] = y.w; }
#pragma unroll
            for (int s = 0; s < 16; ++s) { const float nr = abr * sr - abi * si + br_[s], ni = abr * si + abi * sr + bi_[s]; sr = nr; si = ni;
                const unsigned pk = pk2(sr, si); sbuf[s * S5_SROW + p] = (bf16)(pk & 0xffffu); sbuf[s * S5_SROW + 64 + p] = (bf16)(pk >> 16); }
            WFENCE();
            f32x4 acc = {0.f, 0.f, 0.f, 0.f};
#pragma unroll
            for (int m = 0; m < 4; ++m) { const bf16x8_t af = *(const LAS bf16x8_t*)(sbuf + c * S5_SROW + 32 * m + 8 * tl);
                acc = __builtin_amdgcn_mfma_f32_16x16x32_bf16(af, Cf[m], acc, 0, 0, 0); asm volatile("" :: "v"(af)); }
#pragma unroll
            for (int r = 0; r < 4; ++r) { const int st = 4 * tl + r; const float y = acc[r] + dsk * uall[st * 16 + c];
                SY[((size_t)b * SEQ + tw + t + st) * 1024 + g * 16 + c] = (bf16)(pk2(gelu_tanh(y), 0.f) & 0xffffu); }
            WFENCE();
            ucur = unxt;
        }
    }
#undef S5_BU
    __syncthreads();
}

__device__ __forceinline__ void scan_phase(const Ctx& F, const Args& a, int l) {
    for (int r5 = 0; r5 < 1 + ((REPM >> 9) & 1); ++r5) for (int vb = F.vcu; vb < 256; vb += F.G) s5_block(F, a, l, vb);
    for (int rg_ = 0; rg_ < 1 + ((REPM >> 10) & 1); ++rg_) for (int vb = F.vcu; vb < 256; vb += F.G) {
        if (vb < 128) { gdn_block(F, vb); if (REPM & 2048) gdn_block(F, vb); }
        else { rwkv_block(F, vb - 128); if (REPM & 4096) rwkv_block(F, vb - 128); }
    }
}

__device__ __forceinline__ void post_phase(const Ctx& F, const Args& a, int l, int gw, int ngw) {
    const bf16* PROJ = (const bf16*)(F.ws + WS_PROJ); bf16* OBR = (bf16*)(F.ws + WS_OBR);
    const float* GO = (const float*)(F.ws + WS_GO); const float* RY = (const float*)(F.ws + WS_RY); const float* RV = (const float*)(F.ws + WS_RV); const float* RBON = (const float*)(F.ws + WS_RBON);
    const int c0 = 16 * F.lane;
    float nw[16], lw[16], lb[16];
#pragma unroll
    for (int e = 0; e < 16; ++e) { nw[e] = a.in[6][l * 128 + (c0 & 127) + e]; lw[e] = a.in[15][l * 1024 + c0 + e]; lb[e] = a.in[16][l * 1024 + c0 + e]; }
    for (int tok = gw; tok < TOK; tok += ngw) {
        { float o[16];
#pragma unroll
          for (int q = 0; q < 4; ++q) { const f32x4 v = *(const f32x4*)(GO + (size_t)tok * 1024 + c0 + 4 * q); o[4 * q] = v.x; o[4 * q + 1] = v.y; o[4 * q + 2] = v.z; o[4 * q + 3] = v.w; }
          float ss = 0.f;
#pragma unroll
          for (int e = 0; e < 16; ++e) ss += o[e] * o[e];
          ss = allred8(ss);
          const float rs = rsqrtf(ss * (1.f / 128.f) + 1e-6f);
          float z[16]; { float z0[8], z1[8]; unpack8(*(const u32x4*)(PROJ + (size_t)tok * NINP + C_GZ + c0), z0); unpack8(*(const u32x4*)(PROJ + (size_t)tok * NINP + C_GZ + c0 + 8), z1);
#pragma unroll
              for (int e = 0; e < 8; ++e) { z[e] = z0[e]; z[8 + e] = z1[e]; } }
          float r0[8], r1[8];
#pragma unroll
          for (int e = 0; e < 8; ++e) { r0[e] = o[e] * rs * nw[e] * siluf_(z[e]); r1[e] = o[8 + e] * rs * nw[8 + e] * siluf_(z[8 + e]); }
          *(u32x4*)(OBR + (size_t)tok * 1024 + c0) = pack8(r0); *(u32x4*)(OBR + (size_t)tok * 1024 + c0 + 8) = pack8(r1); }
        { float y[16], v[16];
#pragma unroll
          for (int q = 0; q < 4; ++q) { const f32x4 t = *(const f32x4*)(RY + (size_t)tok * 1024 + c0 + 4 * q); y[4 * q] = t.x; y[4 * q + 1] = t.y; y[4 * q + 2] = t.z; y[4 * q + 3] = t.w;
          }
          { float va[8], vb[8]; unpack8(*(const u32x4*)((const bf16*)RV + (size_t)tok * 1024 + c0), va); unpack8(*(const u32x4*)((const bf16*)RV + (size_t)tok * 1024 + c0 + 8), vb);
#pragma unroll
              for (int e = 0; e < 8; ++e) { v[e] = va[e]; v[8 + e] = vb[e]; } }
          float s = 0.f;
#pragma unroll
          for (int e = 0; e < 16; ++e) s += y[e];
          s += dppf<0xB1>(s); s += dppf<0x4E>(s);
          const float mean = s * (1.f / 64.f); float q2 = 0.f;
#pragma unroll
          for (int e = 0; e < 16; ++e) { const float d = y[e] - mean; q2 += d * d; }
          q2 += dppf<0xB1>(q2); q2 += dppf<0x4E>(q2);
          const float rs = rsqrtf(q2 * (1.f / 64.f) + 64e-5f);
          const float bon = RBON[(size_t)tok * 16 + (c0 >> 6)];
          float z[16]; { float z0[8], z1[8]; unpack8(*(const u32x4*)(PROJ + (size_t)tok * NINP + C_RZ + c0), z0); unpack8(*(const u32x4*)(PROJ + (size_t)tok * NINP + C_RZ + c0 + 8), z1);
#pragma unroll
              for (int e = 0; e < 8; ++e) { z[e] = z0[e]; z[8 + e] = z1[e]; } }
          float r0[8], r1[8];
#pragma unroll
          for (int e = 0; e < 8; ++e) { r0[e] = ((y[e] - mean) * rs * lw[e] + lb[e] + bon * v[e]) * siluf_(z[e]); r1[e] = ((y[8 + e] - mean) * rs * lw[8 + e] + lb[8 + e] + bon * v[8 + e]) * siluf_(z[8 + e]); }
          bf16* ob = OBR + (size_t)TOK * 1024 + (size_t)tok * 1024 + c0;
          *(u32x4*)ob = pack8(r0); *(u32x4*)(ob + 8) = pack8(r1); }
    }
}

#ifndef PHM
#define PHM 0xFFFF
#endif
#ifndef REPM
#define REPM 0
#endif
__global__ void __launch_bounds__(NTHREADS, 2) hybrid_fwd(Args a) {
    extern __shared__ __attribute__((aligned(16))) unsigned char lds_raw[];
    Ctx F;
    F.lds = (LAS unsigned char*)lds_raw; F.ws = a.ws;
    F.G = gridDim.x; { const int bx = blockIdx.x; F.vcu = (F.G % 8 == 0) ? (bx % 8) * (F.G / 8) + bx / 8 : bx; }
    F.NGW = F.G * NWAVES;
    cg::grid_group grid = cg::this_grid();
    if (threadIdx.x < 8) ((volatile LAS unsigned*)(F.lds + MISC_OFF))[threadIdx.x] = 0u;
    __syncthreads();
    grid.sync();
    XcdBarrier bar = xcd_barrier_post((unsigned*)(a.ws + WS_CTL), (volatile LAS unsigned*)(F.lds + MISC_OFF));
    bf16* XN = (bf16*)(a.ws + WS_XN); bf16* PROJ = (bf16*)(a.ws + WS_PROJ);
    int rep = 0;
    for (int ph = a.ph_lo; ph < a.ph_hi; ) {
        { int t_ = threadIdx.x; asm volatile("" : "+v"(t_)); F.tid = t_; F.lane = t_ & 63; F.wave = __builtin_amdgcn_readfirstlane(t_ >> 6); F.gw = F.vcu * NWAVES + F.wave; }
        if (ph == NPHASES - 1) { for (int m = F.gw; m < TOK; m += F.NGW) rms_row(a.out + (size_t)m * DM, a.in[30], nullptr, nullptr, a.out + (size_t)m * DM, F.lane); }
        else if (ph == 0) { if (PHM & 1) phase0(F, a);
            if (REPM & 128) { if (!rep) { rep = 1; __syncthreads(); continue; } rep = 0; } }
        else {
            const int l = (ph - 1) / PH_PER_LAYER, k = (ph - 1) % PH_PER_LAYER;
            if (k == 0 && (PHM & 2)) {
                pg8::Gemm g{XN, (const bf16*)(a.ws + WS_WIN) + (size_t)l * NINP * DM, TOK, NINP, DM}; pg8::StaticOrder S; S.init(TOK, NINP, F.G, (int)blockIdx.x);
                pg8::EpiBf16Rs E{PROJ, NINP, (const unsigned long long*)(a.ws + WS_CTL + CTL_SS) + (size_t)l * TOK};
                pg8::gemm_phase<pg8::EpiBf16Rs, pg8::StaticOrder, true, true>(F.lds, g, S, E);
                if (l + 1 < DEPTH) {
                    const int rem = ((TOK / 256) * (NINP / 256)) % F.G, bx = (int)blockIdx.x;
                    if (rem == 0) convert_layer(F, a, l + 1, F.gw, F.NGW);
                    else if (bx >= rem) convert_layer(F, a, l + 1, (bx - rem) * NWAVES + F.wave, (F.G - rem) * NWAVES);
                }
            } else if (k == 1) { prep_gdn(F, a, l); if (REPM & 8192) prep_gdn(F, a, l); prep_rwkv(F, a, l); if (REPM & 16384) prep_rwkv(F, a, l); }
            else if (k == 2) { if (PHM & 16) scan_phase(F, a, l); }
            else if (k == 3 && (PHM & 32)) {
                const bool split = F.G >= 192;
                if (!split) { post_phase(F, a, l, F.gw, F.NGW); __syncthreads(); }
                if (!split || (int)blockIdx.x < 128) {
                    pg8::Gemm g{(const bf16*)(a.ws + WS_SY), (const bf16*)(a.ws + WS_WGLU) + (size_t)l * 1024 * 1024, TOK, 1024, 1024}; pg8::StaticOrder S; S.init(TOK, 1024, F.G, (int)blockIdx.x);
                    pg8::EpiGlu E{(const bf16*)(a.ws + WS_SY), PROJ, a.in[26] + l * 1024, (bf16*)(a.ws + WS_OBR) + (size_t)2 * TOK * 1024};
                    pg8::gemm_phase<pg8::EpiGlu, pg8::StaticOrder, true, true>(F.lds, g, S, E);
                } else post_phase(F, a, l, ((int)blockIdx.x - 128) * NWAVES + F.wave, (F.G - 128) * NWAVES);
            } else if (k == 4 && (PHM & 64)) {
                pg8::Gemm g{(const bf16*)(a.ws + WS_OBR), (const bf16*)(a.ws + WS_WBR) + (size_t)l * 3 * DM * 1024, 3 * TOK, 3 * DM, 1024};
                pg8::BranchOrder S; S.base.init(TOK, DM, F.G, (int)blockIdx.x);
                pg8::EpiBranch E{PROJ, a.in[27] + (size_t)l * 3 * DM, (bf16*)(a.ws + WS_ACCF), (bf16*)(a.ws + WS_MRG)};
                pg8::gemm_phase<pg8::EpiBranch, pg8::BranchOrder, true, true>(F.lds, g, S, E);
            } else if (k == 5 && (PHM & 128)) {
                pg8::Gemm g{(const bf16*)(a.ws + WS_MRG), (const bf16*)(a.ws + WS_WOUT) + (size_t)l * DM * DM, TOK, DM, DM}; pg8::StaticOrder S; S.init(TOK, DM, F.G, (int)blockIdx.x);
                pg8::EpiResid E{l == 0 ? a.in[0] : a.out, a.out, l + 1 < DEPTH ? XN : nullptr, a.in[1] + (size_t)(l + 1 < DEPTH ? l + 1 : 0) * DM, (unsigned long long*)(a.ws + WS_CTL + CTL_SS) + (size_t)(l + 1 < DEPTH ? l + 1 : 0) * TOK};
                pg8::gemm_phase<pg8::EpiResid, pg8::StaticOrder, true, true>(F.lds, g, S, E);
            }
            if (REPM && !rep && ((REPM >> k) & 1)) { rep = 1; __syncthreads(); continue; }
            rep = 0;
        }
        if (ph + 1 < a.ph_hi) {
            xcd_barrier(bar);
            if (REPM & 256) xcd_barrier(bar);
        }
        ++ph;
    }
}

#ifndef MK_MULTI
#define MK_MULTI 0
#endif
extern "C" void kernel_launch(void* const* d_in, const int* in_sizes, int n_in, void* d_out, int out_size, void* d_ws, size_t ws_size, hipStream_t stream) {
    static int grid = 0;
    if (grid == 0) {
        if (n_in != 31 || out_size != TOK * DM || ws_size < WS_END) { fprintf(stderr, "kernel_launch: unexpected shapes (n_in %d out %d ws %zu)\n", n_in, out_size, ws_size); grid = -1; return; }
        int dev = 0, cus = 0, per_cu = 0;
        hipGetDevice(&dev); hipDeviceGetAttribute(&cus, hipDeviceAttributeMultiprocessorCount, dev);
        if (hipFuncSetAttribute((const void*)hybrid_fwd, hipFuncAttributeMaxDynamicSharedMemorySize, LDS_BYTES) != hipSuccess) { fprintf(stderr, "kernel_launch: hipFuncSetAttribute failed\n"); grid = -1; return; }
        if (hipOccupancyMaxActiveBlocksPerMultiprocessor(&per_cu, (const void*)hybrid_fwd, NTHREADS, LDS_BYTES) != hipSuccess || per_cu < 1) per_cu = 1;
        (void)hipGetLastError();
        grid = cus * per_cu;
        fprintf(stderr, "kernel_launch: grid %d (cus %d x %d)\n", grid, cus, per_cu);
    }
    if (grid < 0) return;
    if (hipMemsetAsync((char*)d_ws + WS_CTL, 0, CTL_ZERO_BYTES, stream) != hipSuccess) { fprintf(stderr, "kernel_launch: memset failed\n"); return; }
    Args a{};
    for (int i = 0; i < 31; ++i) a.in[i] = (const float*)d_in[i];
    a.out = (float*)d_out; a.ws = (unsigned char*)d_ws;
#if MK_MULTI
    for (int ph = 0; ph < NPHASES; ++ph) { a.ph_lo = ph; a.ph_hi = ph + 1; hipLaunchKernelGGL(hybrid_fwd, dim3(grid), dim3(NTHREADS), LDS_BYTES, stream, a); }
#else
    a.ph_lo = 0; a.ph_hi = NPHASES;
    void* args[] = {&a};
    const hipError_t e = hipLaunchCooperativeKernel((const void*)hybrid_fwd, dim3(grid), dim3(NTHREADS), args, LDS_BYTES, stream);
    if (e != hipSuccess) fprintf(stderr, "kernel_launch: cooperative launch failed: %s (grid %d)\n", hipGetErrorString(e), grid);
#endif
}
```

```cpp
#include <hip/hip_runtime.h>
#include <hip/hip_cooperative_groups.h>
#include <cstdio>
#include <cstdint>
namespace cg = cooperative_groups;
namespace pg8 {
#define PG8_LAS __attribute__((address_space(3)))
typedef unsigned short bf16_t;
typedef short bf16x8 __attribute__((ext_vector_type(8)));
typedef float f32x4 __attribute__((ext_vector_type(4)));
typedef unsigned u32x4 __attribute__((ext_vector_type(4)));
constexpr int BM = 256, BK = 64, HALF = 128, HTB = HALF * BK * 2  , STAGE_BYTES = 8 * HTB, NXCD = 8, WGM = 8;

__host__ __device__ __forceinline__ int lds_byte(int r, int c) { const int st = (r >> 4) * 2 + (c >> 5), rr = r & 15, cc = c & 31, ob = rr * 64 + cc * 2; return st * 1024 + (ob ^ (((ob >> 9) & 1) << 5)); }
__host__ __device__ __forceinline__ void stage_rc(int b, int& R, int& C) { const int st = b / 1024, sb = b % 1024, swz = sb ^ (((sb >> 9) & 1) << 5); R = (st >> 1) * 16 + swz / 64; C = (st & 1) * 32 + (swz % 64) / 2; }
__host__ __device__ __forceinline__ int perm32(int rho) { const int n = rho >> 4, i = rho & 15; return 8 * (i >> 2) + 4 * n + (i & 3); }

struct Unit { int pm, pn; };
struct Gemm { const bf16_t* A; const bf16_t* Bt; int M, N, K, ld; };

struct StaticOrder {
    int nM, nN, nwg, G, c;
    __host__ __device__ void init(int M, int N, int G_, int c_) { nM = M / BM; nN = N / BM; nwg = nM * nN; G = G_; c = c_; }
    __host__ __device__ bool next(int i, Unit& u) const {
        const long L = (long)i * G + c; if (L >= nwg) return false;
        int wgid = (int)L; { const int q = nwg / NXCD, r = nwg % NXCD, xcd = wgid % NXCD, off = wgid / NXCD; wgid = (xcd < r ? xcd * (q + 1) : r * (q + 1) + (xcd - r) * q) + off; }
        const int nig = WGM * nN, gid = wgid / nig, fm = gid * WGM, gsz = (nM - fm) < WGM ? (nM - fm) : WGM;
        u.pm = fm + ((wgid % nig) % gsz); u.pn = (wgid % nig) / gsz; return true;
    }
    __device__ __forceinline__ void a_ready(const Unit&) const {}
    __device__ __forceinline__ void done(const Unit&) const {}
};

__device__ __forceinline__ unsigned cvt_pk_bf16(float lo, float hi) { unsigned r; asm volatile("v_cvt_pk_bf16_f32 %0, %1, %2" : "=v"(r) : "v"(lo), "v"(hi)); return r; }
typedef float f32x2 __attribute__((ext_vector_type(2)));
__device__ __forceinline__ f32x2 gelu_pk(f32x2 v) {
    const f32x2 av = __builtin_elementwise_abs(v), d = av * 0.2316418882f + 1.0f;
    f32x2 t; t.x = __builtin_amdgcn_rcpf(d.x); t.y = __builtin_amdgcn_rcpf(d.y);
    f32x2 q = t * 0.5307027145f + (-0.7265760135f); q = q * t + 0.7107068705f; q = q * t + (-0.142248368f); q = q * t + 0.127414796f; q = q * t;
    const f32x2 s = (v * v) * (-0.72134752044f);
    f32x2 e; e.x = __builtin_amdgcn_exp2f(s.x); e.y = __builtin_amdgcn_exp2f(s.y);
    const f32x2 m = v * (q * e), r = v - m;
    f32x2 o; o.x = v.x < 0.f ? m.x : r.x; o.y = v.y < 0.f ? m.y : r.y; return o;
}

template <int ACT  > struct EpiBf16 {
    static constexpr bool PERM = true, AFTER_DRAIN = false; static_assert(ACT == 0 || ACT == 1, "EpiBf16: ACT is 0 (none) or 1 (gelu_pk)");
    bf16_t* O; int ldc; const float* bias; int split_cols; size_t split_stride; float scale0;
    __device__ __forceinline__ void operator()(const f32x4 (&acc)[2][2][4][2], const Unit& u, int wr, int wc, int fr, int fq) const {
        const int row0 = u.pm * BM + wr * 64 + fr; int colt = u.pn * BM; bf16_t* base = O;
        float sc = 1.f; if (split_cols) { const int t = colt / split_cols; base += (size_t)t * split_stride; colt -= t * split_cols; if (t == 0) sc = scale0; }
        const int col0 = colt + wc * 32 + 8 * fq, bcol0 = u.pn * BM + wc * 32 + 8 * fq;
        f32x4 bv[2][2];
#pragma unroll
        for (int bj = 0; bj < 2; ++bj)
#pragma unroll
            for (int n = 0; n < 2; ++n) bv[bj][n] = bias ? *(const f32x4*)(bias + bcol0 + bj * HALF + 4 * n) : (f32x4){0.f, 0.f, 0.f, 0.f};
#pragma unroll
        for (int ai = 0; ai < 2; ++ai)
#pragma unroll
            for (int m = 0; m < 4; ++m) { bf16_t* rowp = base + (size_t)(row0 + ai * HALF + m * 16) * ldc + col0;
#pragma unroll
                for (int bj = 0; bj < 2; ++bj) { f32x4 v0 = acc[ai][bj][m][0] + bv[bj][0], v1 = acc[ai][bj][m][1] + bv[bj][1];
                    if (ACT == 1) { f32x2 a = gelu_pk((f32x2){v0[0], v0[1]}), b = gelu_pk((f32x2){v0[2], v0[3]}), c = gelu_pk((f32x2){v1[0], v1[1]}), d = gelu_pk((f32x2){v1[2], v1[3]});
                        v0 = (f32x4){a.x, a.y, b.x, b.y}; v1 = (f32x4){c.x, c.y, d.x, d.y}; }
                    v0 = v0 * sc; v1 = v1 * sc; u32x4 w; w.x = cvt_pk_bf16(v0[0], v0[1]); w.y = cvt_pk_bf16(v0[2], v0[3]); w.z = cvt_pk_bf16(v1[0], v1[1]); w.w = cvt_pk_bf16(v1[2], v1[3]);
                    *(u32x4*)(rowp + bj * HALF) = w; } }
    }
};

template <class Epi, class Sched, bool ALIGN_EPI = false, bool SP2 = false>
__device__ __forceinline__ void gemm_phase(PG8_LAS unsigned char* lds, const Gemm g, const Sched& S, const Epi& E) {
    int tid_ = threadIdx.x; asm volatile("" : "+v"(tid_));
    const int tid = tid_, wid = __builtin_amdgcn_readfirstlane(tid >> 6), lane = tid & 63, wr = wid >> 2, wc = wid & 3, fr = lane & 15, fq = lane >> 4;
    const int K = g.K, nt = K / BK, LD = g.ld ? g.ld : g.K;
    unsigned voffA[2], voffB[2];
#pragma unroll
    for (int i = 0; i < 2; ++i) { int R, C; stage_rc(tid * 16 + i * 8192, R, C); const int Rb = Epi::PERM ? ((R & ~31) + perm32(R & 31)) : R;
        voffA[i] = (unsigned)(R * LD + C) * 2u; voffB[i] = (unsigned)(Rb * LD + C) * 2u; }
    const size_t kstep = (size_t)(BK * 2);
    const size_t hstep = (size_t)HALF * LD * 2;
    const size_t tstep = 2 * hstep;
    const unsigned ldsw = (unsigned)wid * 1024u;
    const int aoff = lds_byte(wr * 64 + fr, fq * 8), boff = lds_byte(wc * 32 + fr, fq * 8);
#define PG8_SA(b, h) (((b) * 2 + (h)) * HTB)
#define PG8_SB(b, h) ((4 + (b) * 2 + (h)) * HTB)
#define PG8_STAGE(bufoff, gbase, voff) do { _Pragma("unroll") for (int _i = 0; _i < 2; ++_i) \
        __builtin_amdgcn_global_load_lds((const unsigned*)((const char*)(gbase) + (voff)[_i]), (PG8_LAS unsigned*)(lds + (bufoff) + ldsw + _i * 8192), 16, 0, 0); } while (0)
#define PG8_LDA(dst, b, h) do { _Pragma("unroll") for (int m = 0; m < 4; ++m) _Pragma("unroll") for (int k = 0; k < 2; ++k) dst[m][k] = *(const PG8_LAS bf16x8*)(lds + PG8_SA(b, h) + aoff + m * 2048 + k * 1024); } while (0)
#define PG8_LDB(dst, b, h) do { _Pragma("unroll") for (int n = 0; n < 2; ++n) _Pragma("unroll") for (int k = 0; k < 2; ++k) dst[n][k] = *(const PG8_LAS bf16x8*)(lds + PG8_SB(b, h) + boff + n * 2048 + k * 1024); } while (0)
#define PG8_MMA(ai, bj, At, Bt) do { __builtin_amdgcn_s_setprio(1); _Pragma("unroll") for (int m = 0; m < 4; ++m) _Pragma("unroll") for (int n = 0; n < 2; ++n) _Pragma("unroll") for (int k = 0; k < 2; ++k) \
        acc[ai][bj][m][n] = __builtin_amdgcn_mfma_f32_16x16x32_bf16(Bt[n][k], At[m][k], acc[ai][bj][m][n], 0, 0, 0); __builtin_amdgcn_s_setprio(0); } while (0)
#define PG8_WAIT_V(n) asm volatile("s_waitcnt vmcnt(" #n ")" ::: "memory")
#define PG8_WAIT_L(n) asm volatile("s_waitcnt lgkmcnt(" #n ")" ::: "memory")
#define PG8_BAR __builtin_amdgcn_s_barrier()
#define PG8_SCHED __builtin_amdgcn_sched_barrier(0)
    Unit cur, nxt; int ui = 0;
    if (!S.next(0, cur)) return;
    f32x4 acc[2][2][4][2];
#pragma unroll
    for (int a = 0; a < 2; ++a)
#pragma unroll
        for (int b = 0; b < 2; ++b)
#pragma unroll
            for (int m = 0; m < 4; ++m)
#pragma unroll
                for (int n = 0; n < 2; ++n) acc[a][b][m][n] = (f32x4){0.f, 0.f, 0.f, 0.f};
    bf16x8 At[4][2], B0[2][2], B1[2][2];
    const char* cA = (const char*)g.A + (size_t)cur.pm * tstep; const char* cB = (const char*)g.Bt + (size_t)cur.pn * tstep;
    S.a_ready(cur);
    if constexpr (SP2) {
        PG8_STAGE(PG8_SB(0, 0), cB, voffB); PG8_STAGE(PG8_SB(0, 1), cB + hstep, voffB); PG8_STAGE(PG8_SA(0, 0), cA, voffA); PG8_STAGE(PG8_SA(0, 1), cA + hstep, voffA);
        if (wr == 1) PG8_BAR;
        PG8_WAIT_V(2); PG8_BAR;
        PG8_STAGE(PG8_SB(1, 0), cB + kstep, voffB); PG8_STAGE(PG8_SA(1, 0), cA + kstep, voffA); PG8_STAGE(PG8_SB(1, 1), cB + hstep + kstep, voffB);
        PG8_WAIT_V(6); PG8_BAR;
    } else {
        PG8_STAGE(PG8_SB(0, 0), cB, voffB); PG8_STAGE(PG8_SA(0, 0), cA, voffA); PG8_STAGE(PG8_SB(0, 1), cB + hstep, voffB); PG8_STAGE(PG8_SA(0, 1), cA + hstep, voffA);
        if (wr == 1) PG8_BAR;
        PG8_WAIT_V(4); PG8_BAR;
        PG8_STAGE(PG8_SB(1, 0), cB + kstep, voffB); PG8_STAGE(PG8_SA(1, 0), cA + kstep, voffA); PG8_STAGE(PG8_SB(1, 1), cB + hstep + kstep, voffB);
        PG8_WAIT_V(6); PG8_BAR;
    }
    for (;;) {
        const bool has_next = S.next(ui + 1, nxt);
        const char* nA = has_next ? (const char*)g.A + (size_t)nxt.pm * tstep : cA; const char* nB = has_next ? (const char*)g.Bt + (size_t)nxt.pn * tstep : cB;
        for (int t = 0; t < nt; t += 2) {
            const bool last = (t == nt - 2);
            const char* a1 = cA + (size_t)(t + 1) * kstep;
            const char* a2 = last ? nA : cA + (size_t)(t + 2) * kstep; const char* b2 = last ? nB : cB + (size_t)(t + 2) * kstep;
            const char* a3 = a2 + kstep; const char* b3 = b2 + kstep;
            if (last && has_next) S.a_ready(nxt);
            if constexpr (SP2) {
            PG8_LDB(B0, 0, 0); PG8_LDB(B1, 0, 1); PG8_SCHED; PG8_LDA(At, 0, 0); PG8_STAGE(PG8_SA(1, 1), a1 + hstep, voffA);
            PG8_WAIT_V(8); PG8_WAIT_L(0); PG8_BAR; PG8_MMA(0, 0, At, B0); PG8_MMA(0, 1, At, B1); PG8_BAR; PG8_SCHED;
            PG8_LDA(At, 0, 1); PG8_STAGE(PG8_SB(0, 0), b2, voffB); PG8_STAGE(PG8_SB(0, 1), b2 + hstep, voffB); PG8_STAGE(PG8_SA(0, 0), a2, voffA);
            PG8_WAIT_V(8); PG8_WAIT_L(0); PG8_BAR; PG8_MMA(1, 0, At, B0); PG8_MMA(1, 1, At, B1); PG8_BAR; PG8_SCHED;
            PG8_LDB(B0, 1, 0); PG8_LDB(B1, 1, 1); PG8_SCHED; PG8_LDA(At, 1, 0); PG8_STAGE(PG8_SA(0, 1), a2 + hstep, voffA);
            PG8_WAIT_V(8); PG8_WAIT_L(0); PG8_BAR; PG8_MMA(0, 0, At, B0); PG8_MMA(0, 1, At, B1); PG8_BAR; PG8_SCHED;
            PG8_LDA(At, 1, 1); PG8_STAGE(PG8_SB(1, 0), b3, voffB); PG8_STAGE(PG8_SB(1, 1), b3 + hstep, voffB); PG8_STAGE(PG8_SA(1, 0), a3, voffA);
            PG8_WAIT_V(8); PG8_WAIT_L(0); PG8_BAR; PG8_MMA(1, 0, At, B0); PG8_MMA(1, 1, At, B1); PG8_BAR; PG8_SCHED;
            } else {
            PG8_LDB(B0, 0, 0); PG8_SCHED; PG8_LDA(At, 0, 0); PG8_STAGE(PG8_SA(1, 1), a1 + hstep, voffA);
            PG8_WAIT_L(8); PG8_BAR; PG8_WAIT_L(0); PG8_MMA(0, 0, At, B0); PG8_BAR; PG8_SCHED;
            PG8_LDB(B1, 0, 1); PG8_STAGE(PG8_SB(0, 0), b2, voffB);
            PG8_BAR; PG8_WAIT_L(0); PG8_MMA(0, 1, At, B1); PG8_BAR;
            PG8_LDA(At, 0, 1); PG8_STAGE(PG8_SA(0, 0), a2, voffA);
            PG8_BAR; PG8_WAIT_L(0); PG8_MMA(1, 0, At, B0); PG8_BAR; PG8_SCHED;
            PG8_STAGE(PG8_SB(0, 1), b2 + hstep, voffB);
            PG8_WAIT_V(6); PG8_BAR; PG8_MMA(1, 1, At, B1); PG8_BAR;
            PG8_LDB(B0, 1, 0); PG8_SCHED; PG8_LDA(At, 1, 0); PG8_STAGE(PG8_SA(0, 1), a2 + hstep, voffA);
            PG8_WAIT_L(8); PG8_BAR; PG8_WAIT_L(0); PG8_MMA(0, 0, At, B0); PG8_BAR; PG8_SCHED;
            PG8_LDB(B1, 1, 1); PG8_STAGE(PG8_SB(1, 0), b3, voffB);
            PG8_BAR; PG8_WAIT_L(0); PG8_MMA(0, 1, At, B1); PG8_BAR;
            PG8_LDA(At, 1, 1); PG8_STAGE(PG8_SA(1, 0), a3, voffA);
            PG8_BAR; PG8_WAIT_L(0); PG8_MMA(1, 0, At, B0); PG8_BAR; PG8_SCHED;
            PG8_STAGE(PG8_SB(1, 1), b3 + hstep, voffB);
            PG8_WAIT_V(6); PG8_BAR; PG8_MMA(1, 1, At, B1); PG8_BAR;
            }
        }
        if constexpr (ALIGN_EPI) { if (wr == 0) PG8_BAR; }
        if constexpr (!Epi::AFTER_DRAIN) { E(acc, cur, wr, wc, fr, fq); S.done(cur); }
        if (!has_next) break;
#pragma unroll
        for (int a = 0; a < 2; ++a)
#pragma unroll
            for (int b = 0; b < 2; ++b)
#pragma unroll
                for (int m = 0; m < 4; ++m)
#pragma unroll
                    for (int n = 0; n < 2; ++n) acc[a][b][m][n] = (f32x4){0.f, 0.f, 0.f, 0.f};
        cur = nxt; cA = nA; cB = nB; ++ui;
        if constexpr (ALIGN_EPI) { if (wr == 1) PG8_BAR; }
    }
    PG8_WAIT_V(0);
    if constexpr (!ALIGN_EPI) { if (wr == 0) PG8_BAR; }
    PG8_BAR;
    if constexpr (Epi::AFTER_DRAIN) { E.fused(acc, cur, wr, wc, fr, fq, lds, wid, lane); S.done(cur); }
#undef PG8_SA
#undef PG8_SB
#undef PG8_STAGE
#undef PG8_LDA
#undef PG8_LDB
#undef PG8_MMA
#undef PG8_WAIT_V
#undef PG8_WAIT_L
#undef PG8_BAR
#undef PG8_SCHED
}
}

#define GAS __attribute__((address_space(1)))
#define LAS __attribute__((address_space(3)))
typedef unsigned short bf16;
typedef unsigned u32x4 __attribute__((ext_vector_type(4)));
typedef unsigned u32x2 __attribute__((ext_vector_type(2)));
typedef float f32x4 __attribute__((ext_vector_type(4)));
typedef float f32x2 __attribute__((ext_vector_type(2)));
typedef short bf16x8_t __attribute__((ext_vector_type(8)));

constexpr int NBATCH = 4, SEQ = 2048, TOK = NBATCH * SEQ, DM = 2048, DEPTH = 4;
constexpr int NIN = 16592, NINP = 16640;
constexpr int C_GQKV = 0, C_GZ = 3072, C_GB = 4096, C_GA = 4104, C_RF = 4112, C_RZ = 7376, C_SU = 8400, C_SZ = 9424, C_GATE = 10448;
constexpr int NWAVES = 8, NTHREADS = 512;
constexpr int LDS_BYTES = 147456;
constexpr int PH_PER_LAYER = 6, NPHASES = 2 + DEPTH * PH_PER_LAYER;

constexpr size_t MiB = 1u << 20;
constexpr size_t WS_WIN = 0, WS_WGLU = 260 * MiB, WS_WBR = 268 * MiB, WS_WOUT = 316 * MiB, WS_XN = 348 * MiB, WS_PROJ = 380 * MiB;
constexpr size_t WS_GQ = 640 * MiB, WS_GK = 672 * MiB, WS_GV = 704 * MiB, WS_GEG = 736 * MiB, WS_GBE = 737 * MiB, WS_GSC = 737 * MiB + 512 * 1024, WS_GO = 738 * MiB;
constexpr size_t WS_RR = 770 * MiB, WS_RW = 802 * MiB, WS_RK = 834 * MiB, WS_RV = 866 * MiB, WS_RKK = 898 * MiB, WS_RKA = 930 * MiB, WS_RBON = 962 * MiB, WS_RY = 963 * MiB;
constexpr size_t WS_SY = 995 * MiB, WS_OBR = 1011 * MiB, WS_ACCF = 1059 * MiB, WS_MRG = 1123 * MiB, WS_CTL = 1155 * MiB, WS_LORA = 1156 * MiB, WS_END = 1158 * MiB;
constexpr size_t CTL_SS = 65536, CTL_ZERO_BYTES = CTL_SS + (size_t)DEPTH * TOK * 8;
constexpr int MISC_OFF = 147392;
static_assert((size_t)DEPTH * NINP * DM * 2 == 260 * MiB && (size_t)TOK * NINP * 2 == 260 * MiB, "ws map");

__device__ __forceinline__ unsigned f2bf(float f) { unsigned u = __builtin_bit_cast(unsigned, f); return (u + 0x7fffu + ((u >> 16) & 1u)) >> 16; }
__device__ __forceinline__ unsigned pk2(float lo, float hi) { unsigned r; asm("v_cvt_pk_bf16_f32 %0, %1, %2" : "=v"(r) : "v"(lo), "v"(hi)); return r; }
__device__ __forceinline__ float bflo(unsigned w) { return __builtin_bit_cast(float, w << 16); }
__device__ __forceinline__ float bfhi(unsigned w) { return __builtin_bit_cast(float, w & 0xffff0000u); }
__device__ __forceinline__ float bf1(bf16 h) { return __builtin_bit_cast(float, (unsigned)h << 16); }
__device__ __forceinline__ float sigmoidf_(float x) { return __builtin_amdgcn_rcpf(1.f + __expf(-x)); }
__device__ __forceinline__ float siluf_(float x) { return x * __builtin_amdgcn_rcpf(1.f + __expf(-x)); }
__device__ __forceinline__ float softplusf_(float x) { return x > 20.f ? x : log1pf(expf(x)); }
__device__ __forceinline__ float gelu_tanh(float y) { const float t = 0.7978845608028654f * (y + 0.044715f * y * y * y); const float th = 1.f - 2.f * __builtin_amdgcn_rcpf(1.f + __expf(2.f * t)); return 0.5f * y * (1.f + th); }
template <int CTRL> __device__ __forceinline__ float dppf(float v) { return __builtin_bit_cast(float, __builtin_amdgcn_update_dpp(0, __builtin_bit_cast(int, v), CTRL, 0xF, 0xF, true)); }
__device__ __forceinline__ float allred8(float v) { v += dppf<0xB1>(v); v += dppf<0x4E>(v); v += dppf<0x141>(v); return v; }
__device__ __forceinline__ float allred16(float v) { v = allred8(v); v += dppf<0x140>(v); return v; }
__device__ __forceinline__ float wave_sum(float v) {
#pragma unroll
    for (int o = 1; o < 64; o <<= 1) v += __shfl_xor(v, o);
    return v;
}
__device__ __forceinline__ void unpack8(const u32x4 w, float (&f)[8]) { f[0] = bflo(w.x); f[1] = bfhi(w.x); f[2] = bflo(w.y); f[3] = bfhi(w.y); f[4] = bflo(w.z); f[5] = bfhi(w.z); f[6] = bflo(w.w); f[7] = bfhi(w.w); }
__device__ __forceinline__ u32x4 pack8(const float (&f)[8]) { u32x4 w; w.x = pk2(f[0], f[1]); w.y = pk2(f[2], f[3]); w.z = pk2(f[4], f[5]); w.w = pk2(f[6], f[7]); return w; }

namespace pg8 {
struct EpiGlu {
    static constexpr bool PERM = true, AFTER_DRAIN = false;
    const bf16* Y1; const bf16* PROJ; const float* bias; bf16* O;
    __device__ __forceinline__ void operator()(const f32x4 (&acc)[2][2][4][2], const Unit& u, int wr, int wc, int fr, int fq) const {
        int row0 = u.pm * BM + wr * 64 + fr, col0 = u.pn * BM + wc * 32 + 8 * fq;
        asm volatile("" : "+v"(row0), "+v"(col0));
        f32x4 bb[2][2];
#pragma unroll
        for (int bj = 0; bj < 2; ++bj) { bb[bj][0] = *(const f32x4*)(bias + col0 + bj * HALF); bb[bj][1] = *(const f32x4*)(bias + col0 + bj * HALF + 4); }
        u32x4 yc = *(const u32x4*)(Y1 + (size_t)row0 * 1024 + col0), zc = *(const u32x4*)(PROJ + (size_t)row0 * NINP + C_SZ + col0);
#pragma unroll
        for (int it = 0; it < 16; ++it) {
            const int bj = it >> 3, ai = (it >> 2) & 1, m = it & 3;
            const size_t row = (size_t)(row0 + ai * HALF + m * 16); const int col = col0 + bj * HALF;
            u32x4 yn = yc, zn = zc;
            if (it + 1 < 16) { const int nb = (it + 1) >> 3, na = ((it + 1) >> 2) & 1, nm = (it + 1) & 3; const size_t nrow = (size_t)(row0 + na * HALF + nm * 16); const int ncol = col0 + nb * HALF;
                yn = *(const u32x4*)(Y1 + nrow * 1024 + ncol); zn = *(const u32x4*)(PROJ + nrow * NINP + C_SZ + ncol); }
            float y[8], z[8], o[8]; unpack8(yc, y); unpack8(zc, z);
            const f32x4 v0 = acc[ai][bj][m][0] + bb[bj][0], v1 = acc[ai][bj][m][1] + bb[bj][1];
            const float a[8] = {v0[0], v0[1], v0[2], v0[3], v1[0], v1[1], v1[2], v1[3]};
#pragma unroll
            for (int e = 0; e < 8; ++e) o[e] = y[e] * sigmoidf_(a[e]) * siluf_(z[e]);
            *(u32x4*)(O + row * 1024 + col) = pack8(o);
            yc = yn; zc = zn;
            asm volatile("" ::: "memory");
        }
    }
};
struct EpiBranch {
    static constexpr bool PERM = true, AFTER_DRAIN = false;
    const bf16* PROJ; const float* gate_b; bf16* ACC; bf16* MRG;
    __device__ __forceinline__ void operator()(const f32x4 (&acc)[2][2][4][2], const Unit& u, int wr, int wc, int fr, int fq) const {
        const int br = u.pm >> 5, pm = u.pm & 31, pn = u.pn & 7;
        int row0 = pm * BM + wr * 64 + fr, col0 = pn * BM + wc * 32 + 8 * fq;
        asm volatile("" : "+v"(row0), "+v"(col0));
        bf16* dst = br < 2 ? ACC : MRG;
        const bf16* gl = PROJ + C_GATE + br * DM;
        f32x4 gb[2][2];
#pragma unroll
        for (int bj = 0; bj < 2; ++bj) { gb[bj][0] = *(const f32x4*)(gate_b + br * DM + col0 + bj * HALF); gb[bj][1] = *(const f32x4*)(gate_b + br * DM + col0 + bj * HALF + 4); }
        const u32x4 zero = {0u, 0u, 0u, 0u};
        u32x4 lc = *(const u32x4*)(gl + (size_t)row0 * NINP + col0), pc = br > 0 ? *(const u32x4*)(ACC + (size_t)row0 * DM + col0) : zero;
#pragma unroll
        for (int it = 0; it < 16; ++it) {
            const int bj = it >> 3, ai = (it >> 2) & 1, m = it & 3;
            const size_t row = (size_t)(row0 + ai * HALF + m * 16); const int col = col0 + bj * HALF;
            u32x4 ln = lc, pn_ = pc;
            if (it + 1 < 16) { const int nb = (it + 1) >> 3, na = ((it + 1) >> 2) & 1, nm = (it + 1) & 3; const size_t nrow = (size_t)(row0 + na * HALF + nm * 16); const int ncol = col0 + nb * HALF;
                ln = *(const u32x4*)(gl + nrow * NINP + ncol); pn_ = br > 0 ? *(const u32x4*)(ACC + nrow * DM + ncol) : zero; }
            float g[8], p[8], o[8]; unpack8(lc, g); unpack8(pc, p);
            const f32x4 v0 = acc[ai][bj][m][0], v1 = acc[ai][bj][m][1];
            const float a[8] = {v0[0], v0[1], v0[2], v0[3], v1[0], v1[1], v1[2], v1[3]};
            const float gbv[8] = {gb[bj][0][0], gb[bj][0][1], gb[bj][0][2], gb[bj][0][3], gb[bj][1][0], gb[bj][1][1], gb[bj][1][2], gb[bj][1][3]};
#pragma unroll
            for (int e = 0; e < 8; ++e) o[e] = sigmoidf_(g[e] + gbv[e]) * a[e] + p[e];
            *(u32x4*)(dst + row * DM + col) = pack8(o);
            lc = ln; pc = pn_;
            asm volatile("" ::: "memory");
        }
    }
};
struct EpiResid {
    static constexpr bool PERM = true, AFTER_DRAIN = false;
    const float* base; float* out; bf16* xn; const float* nw; unsigned long long* ss;
    __device__ __forceinline__ void operator()(const f32x4 (&acc)[2][2][4][2], const Unit& u, int wr, int wc, int fr, int fq) const {
        int row0 = u.pm * BM + wr * 64 + fr, col0 = u.pn * BM + wc * 32 + 8 * fq;
        asm volatile("" : "+v"(row0), "+v"(col0));
        f32x4 ww[2][2];
#pragma unroll
        for (int bj = 0; bj < 2; ++bj) { ww[bj][0] = *(const f32x4*)(nw + col0 + bj * HALF); ww[bj][1] = *(const f32x4*)(nw + col0 + bj * HALF + 4); }
        f32x4 bc[2][2];
#pragma unroll
        for (int bj = 0; bj < 2; ++bj) { const size_t off = (size_t)row0 * DM + col0 + bj * HALF; bc[bj][0] = *(const f32x4*)(base + off); bc[bj][1] = *(const f32x4*)(base + off + 4); }
#pragma unroll
        for (int it = 0; it < 8; ++it) {
            const int ai = it >> 2, m = it & 3; const int row = row0 + ai * HALF + m * 16;
            f32x4 bn[2][2];
#pragma unroll
            for (int bj = 0; bj < 2; ++bj) { bn[bj][0] = bc[bj][0]; bn[bj][1] = bc[bj][1]; }
            if (it + 1 < 8) { const int nrow = row0 + ((it + 1) >> 2) * HALF + ((it + 1) & 3) * 16;
#pragma unroll
                for (int bj = 0; bj < 2; ++bj) { const size_t off = (size_t)nrow * DM + col0 + bj * HALF; bn[bj][0] = *(const f32x4*)(base + off); bn[bj][1] = *(const f32x4*)(base + off + 4); } }
            float sq = 0.f;
#pragma unroll
            for (int bj = 0; bj < 2; ++bj) {
                const size_t off = (size_t)row * DM + col0 + bj * HALF;
                const f32x4 o0 = bc[bj][0] + acc[ai][bj][m][0], o1 = bc[bj][1] + acc[ai][bj][m][1];
                *(f32x4*)(out + off) = o0; *(f32x4*)(out + off + 4) = o1;
                if (xn) { const f32x4 w0 = ww[bj][0], w1 = ww[bj][1];
                    sq += (o0.x * o0.x + o0.y * o0.y) + (o0.z * o0.z + o0.w * o0.w) + (o1.x * o1.x + o1.y * o1.y) + (o1.z * o1.z + o1.w * o1.w);
                    u32x4 p; p.x = pk2(o0.x * w0.x, o0.y * w0.y); p.y = pk2(o0.z * w0.z, o0.w * w0.w); p.z = pk2(o1.x * w1.x, o1.y * w1.y); p.w = pk2(o1.z * w1.z, o1.w * w1.w);
                    *(u32x4*)(xn + off) = p; }
            }
            if (xn) { sq += __shfl_xor(sq, 16); sq += __shfl_xor(sq, 32); if (fq == 0) atomicAdd(ss + row, (unsigned long long)(sq * 65536.f + 0.5f)); }
#pragma unroll
            for (int bj = 0; bj < 2; ++bj) { bc[bj][0] = bn[bj][0]; bc[bj][1] = bn[bj][1]; }
            asm volatile("" ::: "memory");
        }
    }
};
struct EpiBf16Rs {
    static constexpr bool PERM = true, AFTER_DRAIN = false;
    bf16* O; int ldc; const unsigned long long* ss;
    __device__ __forceinline__ void operator()(const f32x4 (&acc)[2][2][4][2], const Unit& u, int wr, int wc, int fr, int fq) const {
        int row0 = u.pm * BM + wr * 64 + fr, col0 = u.pn * BM + wc * 32 + 8 * fq;
        asm volatile("" : "+v"(row0), "+v"(col0));
#pragma unroll
        for (int ai = 0; ai < 2; ++ai)
#pragma unroll
            for (int m = 0; m < 4; ++m) { const int row = row0 + ai * HALF + m * 16; const float rs = 1.f / sqrtf((float)ss[row] * (1.f / (65536.f * DM)) + 1e-6f);
                bf16* rowp = O + (size_t)row * ldc + col0;
#pragma unroll
                for (int bj = 0; bj < 2; ++bj) { const f32x4 v0 = acc[ai][bj][m][0] * rs, v1 = acc[ai][bj][m][1] * rs;
                    u32x4 w; w.x = cvt_pk_bf16(v0[0], v0[1]); w.y = cvt_pk_bf16(v0[2], v0[3]); w.z = cvt_pk_bf16(v1[0], v1[1]); w.w = cvt_pk_bf16(v1[2], v1[3]);
                    *(u32x4*)(rowp + bj * HALF) = w; } }
    }
};
struct BranchOrder {
    StaticOrder base;
    __device__ bool next(int i, Unit& u) const { Unit t; const int r = i / 3, br = i - 3 * r; if (!base.next(r, t)) return false; u.pm = br * 32 + t.pm; u.pn = br * 8 + t.pn; return true; }
    __device__ __forceinline__ void a_ready(const Unit&) const {}
    __device__ __forceinline__ void done(const Unit&) const {}
};
}

#define XB_TMO      128
#define XB_XCNT(j)  (256  + 64 * (j))
#define XB_XSUB(j)  (1280 + 64 * (j))
#define XB_XGEN(j)  (2304 + 64 * (j))
#define XB_TOP      3328
#define XB_TOPGEN   3392
#define XCD_BAR_WORDS 3456
#define XB_SPIN_CAP (1u << 18)

__device__ __forceinline__ unsigned xb_ld(unsigned* p)              { return __hip_atomic_load(p, __ATOMIC_RELAXED, __HIP_MEMORY_SCOPE_AGENT); }
__device__ __forceinline__ unsigned xb_add(unsigned* p, unsigned v) { return __hip_atomic_fetch_add(p, v, __ATOMIC_RELAXED, __HIP_MEMORY_SCOPE_AGENT); }
__device__ __forceinline__ unsigned xb_xcc_id() { return (unsigned)__builtin_amdgcn_s_getreg((3 << 11) | 20) & 0xFu; }
#define XB_SPIN(cond, bar) do { unsigned _sp = 0; while (cond) { __builtin_amdgcn_s_sleep(1); \
    if ((++_sp & 255u) == 0u) { if (xb_ld(&(bar)[XB_TMO])) break; if (_sp > XB_SPIN_CAP) { atomicAdd(&(bar)[XB_TMO], 1u); break; } } } } while (0)

struct XcdBarrier {
    unsigned* bar; unsigned x;
    volatile LAS unsigned* st;
};

__device__ __forceinline__ XcdBarrier xcd_barrier_post(unsigned* bar, volatile LAS unsigned* st) {
    XcdBarrier b; b.bar = bar; b.x = xb_xcc_id(); b.st = st;
    if (threadIdx.x == 0) (void)xb_add(&bar[XB_XCNT(b.x)], 1u);
    return b;
}
__device__ __forceinline__ void xcd_barrier_complete(unsigned* bar, unsigned x, unsigned& nloc, unsigned& nx) {
    const unsigned G = gridDim.x * gridDim.y * gridDim.z;
    unsigned sum, cnt, mine, sp = 0u;
    for (;;) {
        sum = 0u; cnt = 0u; mine = 0u;
#pragma unroll
        for (unsigned j = 0; j < 16; ++j) { const unsigned c = xb_ld(&bar[XB_XCNT(j)]); sum += c; cnt += (c > 0u) ? 1u : 0u; mine = (j == x) ? c : mine; }
        if (sum == G) break;
        __builtin_amdgcn_s_sleep(1);
        if ((++sp & 255u) == 0u) { if (xb_ld(&bar[XB_TMO])) break; if (sp > XB_SPIN_CAP) { atomicAdd(&bar[XB_TMO], 1u); break; } }
    }
    nloc = mine > 0u ? mine : 1u; nx = cnt > 0u ? cnt : 1u;
}

__device__ __forceinline__ void xcd_barrier(const XcdBarrier& b) {
    asm volatile("s_waitcnt vmcnt(0)" ::: "memory");
    __syncthreads();
    if (threadIdx.x == 0) {
        unsigned* bar = b.bar;
        __builtin_amdgcn_s_waitcnt(0);
        unsigned nloc = b.st[0], nx = b.st[1];
        if (nloc == 0u) { xcd_barrier_complete(bar, b.x, nloc, nx); b.st[0] = nloc; b.st[1] = nx; }
        const unsigned old = xb_add(&bar[XB_XSUB(b.x)], 1u);
        const unsigned gen = old / nloc;
        if (old + 1u == (gen + 1u) * nloc) {
            __builtin_amdgcn_fence(__ATOMIC_RELEASE, "agent");
            asm volatile("s_waitcnt vmcnt(0)" ::: "memory");
            const unsigned og = xb_add(&bar[XB_TOP], 1u);
            const unsigned tg = og / nx;
            if (og + 1u == (tg + 1u) * nx) xb_add(&bar[XB_TOPGEN], 1u);
            else XB_SPIN(xb_ld(&bar[XB_TOPGEN]) == tg, bar);
            __builtin_amdgcn_fence(__ATOMIC_ACQUIRE, "agent");
            xb_add(&bar[XB_XGEN(b.x)], 1u);
            asm volatile("s_waitcnt vmcnt(0)" ::: "memory");
        } else {
            XB_SPIN(xb_ld(&bar[XB_XGEN(b.x)]) == gen, bar);
            __builtin_amdgcn_fence(__ATOMIC_ACQUIRE, "agent");
            asm volatile("s_waitcnt vmcnt(0)" ::: "memory");
        }
    }
    __syncthreads();
}

struct Args { const float* in[31]; float* out; unsigned char* ws; int ph_lo, ph_hi; };
struct Ctx { int tid, lane, wave, vcu, G, gw, NGW; LAS unsigned char* lds; unsigned char* ws; };

__device__ __forceinline__ void transpose_item(const float* W, int K, int N, bf16* WT, LAS float* scr, int kb, int nb, int lane) {
    const int k0 = 64 * kb, n0 = 64 * nb, nq = 4 * (lane & 15), kr = lane >> 4; const bool nv = n0 + nq < N;
    f32x4 v[16];
#pragma unroll
    for (int i = 0; i < 16; ++i) v[i] = nv ? *(const f32x4*)(W + (size_t)(k0 + 4 * i + kr) * N + n0 + nq) : (f32x4){0.f, 0.f, 0.f, 0.f};
#pragma unroll
    for (int i = 0; i < 16; ++i) { LAS float* d = scr + (4 * i + kr) * 65 + nq; d[0] = v[i].x; d[1] = v[i].y; d[2] = v[i].z; d[3] = v[i].w; }
    asm volatile("s_waitcnt lgkmcnt(0)" ::: "memory");
    const int c = lane & 7;
#pragma unroll
    for (int j = 0; j < 8; ++j) { const int nn = (lane >> 3) + 8 * j; const LAS float* s = scr + (8 * c) * 65 + nn;
        u32x4 o; o.x = pk2(s[0 * 65], s[1 * 65]); o.y = pk2(s[2 * 65], s[3 * 65]); o.z = pk2(s[4 * 65], s[5 * 65]); o.w = pk2(s[6 * 65], s[7 * 65]);
        *(u32x4*)(WT + (size_t)(n0 + nn) * K + k0 + 8 * c) = o; }
    asm volatile("s_waitcnt lgkmcnt(0)" ::: "memory");
}

__device__ __forceinline__ void rms_row(const float* xrow, const float* w, bf16* obf, unsigned long long* ss, float* of32, int lane) {
    f32x4 v[8]; float s = 0.f;
#pragma unroll
    for (int j = 0; j < 8; ++j) { v[j] = *(const f32x4*)(xrow + 4 * lane + 256 * j); s += (v[j].x * v[j].x + v[j].y * v[j].y) + (v[j].z * v[j].z + v[j].w * v[j].w); }
    s = wave_sum(s);
    const float r = obf ? 1.f : 1.f / sqrtf(s * (1.f / DM) + 1e-6f);
#pragma unroll
    for (int j = 0; j < 8; ++j) { const f32x4 ww = *(const f32x4*)(w + 4 * lane + 256 * j); const f32x4 o = v[j] * r * ww;
        if (obf) { u32x2 p; p.x = pk2(o.x, o.y); p.y = pk2(o.z, o.w); *(u32x2*)(obf + 4 * lane + 256 * j) = p; }
        else *(f32x4*)(of32 + 4 * lane + 256 * j) = o; }
    if (obf && lane == 0) *ss = (unsigned long long)(s * 65536.f + 0.5f);
}

__device__ __forceinline__ void convert_layer(const Ctx& F, const Args& a, int l, int gw, int ngw) {
    LAS float* scr = (LAS float*)(F.lds + F.wave * 16640);
    constexpr int I_IN = 32 * 260, I_GLU = 16 * 16, I_BR = 16 * 32, I_OUT = 32 * 32, IL = I_IN + I_GLU + 3 * I_BR + I_OUT;
    bf16* WIN = (bf16*)(F.ws + WS_WIN); bf16* WGLU = (bf16*)(F.ws + WS_WGLU); bf16* WBR = (bf16*)(F.ws + WS_WBR); bf16* WOUT = (bf16*)(F.ws + WS_WOUT);
    for (int it = gw; it < IL; it += ngw) {
        int r = it;
        if (r < I_IN) { transpose_item(a.in[2] + (size_t)l * DM * NIN, DM, NIN, WIN + (size_t)l * NINP * DM, scr, r / 260, r % 260, F.lane); continue; } r -= I_IN;
        if (r < I_GLU) { transpose_item(a.in[25] + (size_t)l * 1024 * 1024, 1024, 1024, WGLU + (size_t)l * 1024 * 1024, scr, r / 16, r % 16, F.lane); continue; } r -= I_GLU;
        if (r < 3 * I_BR) { const int br = r / I_BR, r2 = r - br * I_BR;
            transpose_item(a.in[28] + (size_t)(l * 3 + br) * 1024 * DM, 1024, DM, WBR + (size_t)(l * 3 + br) * DM * 1024, scr, r2 / 32, r2 % 32, F.lane); continue; } r -= 3 * I_BR;
        transpose_item(a.in[29] + (size_t)l * DM * DM, DM, DM, WOUT + (size_t)l * DM * DM, scr, r / 32, r % 32, F.lane);
    }
}

__device__ __forceinline__ void phase0(const Ctx& F, const Args& a) {
    convert_layer(F, a, 0, F.gw, F.NGW);
    {
        bf16* LT = (bf16*)(F.ws + WS_LORA);
        for (int it = F.gw * 64 + F.lane; it < DEPTH * 2 * 1024 * 12; it += F.NGW * 64) {
            const int kg = it % 12, n = (it / 12) & 1023, lw = it / (12 * 1024), l = lw >> 1, which = lw & 1;
            const float* src = (which ? a.in[11] : a.in[9]) + (size_t)l * 96 * 1024 + (size_t)(8 * kg) * 1024 + n;
            u32x4 o; o.x = pk2(src[0], src[1024]); o.y = pk2(src[2048], src[3072]); o.z = pk2(src[4096], src[5120]); o.w = pk2(src[6144], src[7168]);
            *(u32x4*)(LT + ((size_t)lw * 1024 + n) * 96 + 8 * kg) = o;
        }
    }
    bf16* XN = (bf16*)(F.ws + WS_XN);
    unsigned long long* SS0 = (unsigned long long*)(F.ws + WS_CTL + CTL_SS);
    for (int m = F.gw; m < TOK; m += F.NGW) rms_row(a.in[0] + (size_t)m * DM, a.in[1], XN + (size_t)m * DM, SS0 + m, nullptr, F.lane);
}

__device__ __forceinline__ void prep_gdn(const Ctx& F, const Args& a, int l) {
    const bf16* PROJ = (const bf16*)(F.ws + WS_PROJ);
    float* GQ = (float*)(F.ws + WS_GQ); float* GK = (float*)(F.ws + WS_GK); float* GV = (float*)(F.ws + WS_GV); float* GEG = (float*)(F.ws + WS_GEG); float* GBE = (float*)(F.ws + WS_GBE); f32x4* GSC = (f32x4*)(F.ws + WS_GSC);
    const float* cw = a.in[3] + (size_t)l * 4 * 3072;
    for (int it = F.gw; it < 2048; it += F.NGW) {
        const int h = it & 7, ch = (it >> 3) & 63, b = it >> 9;
        const int t0 = ch * 32; const int c = 2 * F.lane;
        float w[3][4][2], hist[3][3][2];
#pragma unroll
        for (int p = 0; p < 3; ++p)
#pragma unroll
            for (int j = 0; j < 4; ++j) { const f32x2 ww = *(const f32x2*)(cw + j * 3072 + p * 1024 + h * 128 + c); w[p][j][0] = ww.x; w[p][j][1] = ww.y; }
#pragma unroll
        for (int p = 0; p < 3; ++p)
#pragma unroll
            for (int j = 0; j < 3; ++j) { const int t = t0 - 3 + j; unsigned x = 0u;
                if (t >= 0) x = *(const unsigned*)(PROJ + (size_t)(b * SEQ + t) * NINP + C_GQKV + p * 1024 + h * 128 + c);
                hist[p][j][0] = bflo(x); hist[p][j][1] = bfhi(x); }
        const float alog = a.in[4][l * 8 + h], dtb = a.in[5][l * 8 + h]; const float aexp = expf(alog);
        float kp0 = 0.f, kp1 = 0.f, qkprev = 0.f;
        unsigned raw[3][32];
#pragma unroll
        for (int tt = 0; tt < 32; ++tt)
#pragma unroll
            for (int p = 0; p < 3; ++p) raw[p][tt] = *(const unsigned*)(PROJ + (size_t)(b * SEQ + t0 + tt) * NINP + C_GQKV + p * 1024 + h * 128 + c);
#pragma unroll
        for (int tt = 0; tt < 32; ++tt) {
            const size_t tok = (size_t)(b * SEQ + t0 + tt);
            float o[3][2];
#pragma unroll
            for (int p = 0; p < 3; ++p) {
                const unsigned x = raw[p][tt];
                const float x0 = bflo(x), x1 = bfhi(x);
                const float y0 = w[p][0][0] * hist[p][0][0] + w[p][1][0] * hist[p][1][0] + w[p][2][0] * hist[p][2][0] + w[p][3][0] * x0;
                const float y1 = w[p][0][1] * hist[p][0][1] + w[p][1][1] * hist[p][1][1] + w[p][2][1] * hist[p][2][1] + w[p][3][1] * x1;
                hist[p][0][0] = hist[p][1][0]; hist[p][1][0] = hist[p][2][0]; hist[p][2][0] = x0;
                hist[p][0][1] = hist[p][1][1]; hist[p][1][1] = hist[p][2][1]; hist[p][2][1] = x1;
                o[p][0] = siluf_(y0); o[p][1] = siluf_(y1);
            }
            const float sq = wave_sum(o[0][0] * o[0][0] + o[0][1] * o[0][1]), sk = wave_sum(o[1][0] * o[1][0] + o[1][1] * o[1][1]);
            const float rq = 0.08838834764831845f * rsqrtf(sq + 1e-6f), rk = rsqrtf(sk + 1e-6f);
            const size_t off = tok * 1024 + h * 128 + c;
            const unsigned qp = pk2(o[0][0] * rq, o[0][1] * rq), kp = pk2(o[1][0] * rk, o[1][1] * rk);
            *(unsigned*)((bf16*)GQ + off) = qp;
            *(unsigned*)((bf16*)GK + off) = kp;
            *(unsigned*)((bf16*)GV + off) = pk2(o[2][0], o[2][1]);
            {
                const float qn0 = bflo(qp), qn1 = bfhi(qp), kn0 = bflo(kp), kn1 = bfhi(kp);
                const float qk = wave_sum(qn0 * kn0 + qn1 * kn1);
                if (tt & 1) { const float kk = wave_sum(kp0 * kn0 + kp1 * kn1), qkp = wave_sum(qn0 * kp0 + qn1 * kp1);
                    if (F.lane == 0) GSC[(tok >> 1) * 8 + h] = (f32x4){kk, qkprev, qkp, qk}; }
                else { kp0 = kn0; kp1 = kn1; qkprev = qk; }
            }
            if (F.lane == 0) {
                const float bl = bf1(PROJ[tok * NINP + C_GB + h]), al = bf1(PROJ[tok * NINP + C_GA + h]);
                GBE[tok * 8 + h] = sigmoidf_(bl);
                GEG[tok * 8 + h] = expf(-aexp * softplusf_(al + dtb));
            }
        }
    }
}

__device__ __forceinline__ float mix2(unsigned c, unsigned p, float mu0, float mu1, float& o1) {
    const float c0 = bflo(c), c1 = bfhi(c), p0 = bflo(p), p1 = bfhi(p);
    o1 = c1 + (p1 - c1) * mu1; return c0 + (p0 - c0) * mu0;
}
__device__ __forceinline__ void prep_rwkv(const Ctx& F, const Args& a, int l) {
    const bf16* PROJ = (const bf16*)(F.ws + WS_PROJ);
    float* RR = (float*)(F.ws + WS_RR); float* RW = (float*)(F.ws + WS_RW); float* RK = (float*)(F.ws + WS_RK); float* RV = (float*)(F.ws + WS_RV);
    float* RKK = (float*)(F.ws + WS_RKK); float* RKA = (float*)(F.ws + WS_RKA); float* RBON = (float*)(F.ws + WS_RBON);
    const float* mu = a.in[7] + (size_t)l * 3264; const float* w0 = a.in[8] + l * 1024; const float* wup = a.in[9] + (size_t)l * 96 * 1024;
    const float* a0 = a.in[10] + l * 1024; const float* aup = a.in[11] + (size_t)l * 96 * 1024; const float* kk_ = a.in[12] + l * 1024; const float* ka_ = a.in[13] + l * 1024; const float* rk_ = a.in[14] + l * 1024;
    constexpr int AROW = 104;
    LAS bf16* A1 = (LAS bf16*)F.lds; LAS bf16* A2 = A1 + 16 * AROW;
    LAS float* LW = (LAS float*)(F.lds + 8192); LAS float* LA = LW + 16 * 1024;
    const bf16* LTw = (const bf16*)(F.ws + WS_LORA) + (size_t)(2 * l) * 1024 * 96; const bf16* LTa = LTw + 1024 * 96;
    const int j = F.tid, c = 2 * j;
    const f32x2 mur = *(const f32x2*)(mu + c), muk = *(const f32x2*)(mu + 1024 + c), muv = *(const f32x2*)(mu + 2048 + c);
    const f32x2 w0v = *(const f32x2*)(w0 + c), a0v = *(const f32x2*)(a0 + c), kkv = *(const f32x2*)(kk_ + c), kav = *(const f32x2*)(ka_ + c), rkv = *(const f32x2*)(rk_ + c);
    for (int tile = F.vcu; tile < TOK / 16; tile += F.G) {
        __syncthreads();
        for (int e = F.tid; e < 16 * 192; e += NTHREADS) {
            const int tl = e / 192, i = e - tl * 192; const size_t tok = (size_t)tile * 16 + tl;
            const float cur = bf1(PROJ[tok * NINP + C_RF + 3072 + i]);
            const float prv = (tok & (SEQ - 1)) ? bf1(PROJ[(tok - 1) * NINP + C_RF + 3072 + i]) : 0.f;
            const float m = cur + (prv - cur) * mu[3072 + i];
            if (i < 96) A1[tl * AROW + i] = (bf16)f2bf(tanhf(m)); else A2[tl * AROW + i - 96] = (bf16)f2bf(m);
        }
        __syncthreads();
        {
            const int row = F.lane & 15, quad = F.lane >> 4;
            bf16x8_t fw[3], fa[3];
#pragma unroll
            for (int ks = 0; ks < 3; ++ks) { fw[ks] = *(const LAS bf16x8_t*)(A1 + row * AROW + 32 * ks + 8 * quad); fa[ks] = *(const LAS bf16x8_t*)(A2 + row * AROW + 32 * ks + 8 * quad); }
#pragma unroll 2
            for (int nt = 0; nt < 8; ++nt) {
                const int n = 128 * F.wave + 16 * nt + row;
                f32x4 aw = {0.f, 0.f, 0.f, 0.f}, aa = {0.f, 0.f, 0.f, 0.f};
#pragma unroll
                for (int ks = 0; ks < 3; ++ks) {
                    const bf16x8_t bw = *(const bf16x8_t*)(LTw + (size_t)n * 96 + 32 * ks + 8 * quad), ba = *(const bf16x8_t*)(LTa + (size_t)n * 96 + 32 * ks + 8 * quad);
                    aw = __builtin_amdgcn_mfma_f32_16x16x32_bf16(fw[ks], bw, aw, 0, 0, 0); aa = __builtin_amdgcn_mfma_f32_16x16x32_bf16(fa[ks], ba, aa, 0, 0, 0);
                    asm volatile("" :: "v"(bw), "v"(ba));
                }
#pragma unroll
                for (int r = 0; r < 4; ++r) { LW[(4 * quad + r) * 1024 + n] = aw[r]; LA[(4 * quad + r) * 1024 + n] = aa[r]; }
            }
        }
        __syncthreads();
        unsigned rw[17][3];
#pragma unroll
        for (int tl = 0; tl < 17; ++tl) { const size_t tok = (size_t)tile * 16 + tl - 1; const bool ok = tl > 0 || ((tok + 1) & (SEQ - 1)) != 0;
            const bf16* cp = PROJ + tok * NINP + C_RF + c;
#pragma unroll
            for (int q = 0; q < 3; ++q) rw[tl][q] = ok ? *(const unsigned*)(cp + 1024 * q) : 0u; }
#pragma unroll
        for (int tl = 0; tl < 16; ++tl) {
            const size_t tok = (size_t)tile * 16 + tl; const bool hp = (tok & (SEQ - 1)) != 0;
            const unsigned cr = rw[tl + 1][0], ck = rw[tl + 1][1], cv = rw[tl + 1][2];
            const unsigned pr = hp ? rw[tl][0] : 0u, pk = hp ? rw[tl][1] : 0u, pv = hp ? rw[tl][2] : 0u;
            float r1, k1, v1; const float r0 = mix2(cr, pr, mur.x, mur.y, r1), k0 = mix2(ck, pk, muk.x, muk.y, k1), v0 = mix2(cv, pv, muv.x, muv.y, v1);
            const f32x2 lw = *(const LAS f32x2*)(LW + tl * 1024 + c), la = *(const LAS f32x2*)(LA + tl * 1024 + c);
            const float wp0 = w0v.x + lw.x, wp1 = w0v.y + lw.y;
            const float d0 = __expf(-0.6065306597126334f * sigmoidf_(wp0)), d1 = __expf(-0.6065306597126334f * sigmoidf_(wp1));
            const float aa0 = sigmoidf_(a0v.x + la.x), aa1 = sigmoidf_(a0v.y + la.y);
            const float q0 = k0 * kkv.x, q1 = k1 * kkv.y;
            float ss = q0 * q0 + q1 * q1;
#pragma unroll
            for (int o = 1; o < 32; o <<= 1) ss += __shfl_xor(ss, o);
            const float rn = rsqrtf(ss + 1e-6f); const float n0 = q0 * rn, n1 = q1 * rn;
            const float km0 = k0 * (1.f + (aa0 - 1.f) * kav.x), km1 = k1 * (1.f + (aa1 - 1.f) * kav.y);
            float bo = r0 * km0 * rkv.x + r1 * km1 * rkv.y;
#pragma unroll
            for (int o = 1; o < 32; o <<= 1) bo += __shfl_xor(bo, o);
            const size_t off = tok * 1024 + c;
            *(unsigned*)((bf16*)RR + off) = pk2(r0, r1); *(f32x2*)(RW + off) = (f32x2){d0, d1}; *(unsigned*)((bf16*)RK + off) = pk2(km0, km1); *(unsigned*)((bf16*)RV + off) = pk2(v0, v1);
            *(f32x2*)(RKK + off) = (f32x2){-n0, -n1}; *(unsigned*)((bf16*)RKA + off) = pk2(n0 * aa0, n1 * aa1);
            if ((F.lane & 31) == 0) RBON[tok * 16 + (c >> 6)] = bo;
        }
    }
}

#ifndef SCM
#define SCM 7
#endif
#ifndef REPM
#define REPM 0
#endif
constexpr int CH = 32;
#define WFENCE() do { __builtin_amdgcn_fence(__ATOMIC_RELEASE, "wavefront"); asm volatile("s_waitcnt lgkmcnt(0)" ::: "memory"); __builtin_amdgcn_wave_barrier(); __builtin_amdgcn_fence(__ATOMIC_ACQUIRE, "wavefront"); } while (0)

struct GPair { f32x4 k1a, k1b, k2a, k2b, q1a, q1b, q2a, q2b, eb, sc; float v1, v2; };
constexpr int G_BUF = 2 * CH * 128 + CH * 32 + 4 * CH;
__device__ __forceinline__ void gdn_lds(GPair& s, const LAS float* buf, int pr, int rg, int colL) {
    const LAS float* kp = buf + 2 * pr * 128 + rg * 4; const LAS float* qp = kp + CH * 128;
    s.k1a = *(const LAS f32x4*)kp; s.k1b = *(const LAS f32x4*)(kp + 64); s.k2a = *(const LAS f32x4*)(kp + 128); s.k2b = *(const LAS f32x4*)(kp + 192);
    s.q1a = *(const LAS f32x4*)qp; s.q1b = *(const LAS f32x4*)(qp + 64); s.q2a = *(const LAS f32x4*)(qp + 128); s.q2b = *(const LAS f32x4*)(qp + 192);
    s.v1 = buf[2 * CH * 128 + 2 * pr * 32 + colL]; s.v2 = buf[2 * CH * 128 + (2 * pr + 1) * 32 + colL];
    s.eb = *(const LAS f32x4*)(buf + 2 * CH * 128 + CH * 32 + 4 * pr); s.sc = *(const LAS f32x4*)(buf + 2 * CH * 128 + CH * 32 + 2 * CH + 4 * pr);
}
__device__ __forceinline__ float dot8(const f32x4 a, const f32x4 b, const f32x2 (&S)[4]) { const f32x2 t = (a.xy * S[0] + a.zw * S[1]) + (b.xy * S[2] + b.zw * S[3]); return t.x + t.y; }
#define DPP4(CTRL) do { d1 += dppf<CTRL>(d1); d2 += dppf<CTRL>(d2); e1 += dppf<CTRL>(e1); e2 += dppf<CTRL>(e2); } while (0)
__device__ __forceinline__ void gdn_pair(const GPair& s, f32x2 (&S)[4], LAS float* ob, bool wr) {
    float d1 = dot8(s.k1a, s.k1b, S), d2 = dot8(s.k2a, s.k2b, S), e1 = dot8(s.q1a, s.q1b, S), e2 = dot8(s.q2a, s.q2b, S);
    DPP4(0xB1); DPP4(0x4E); DPP4(0x141); DPP4(0x140);
    const float g1 = s.eb.x, b1 = s.eb.y, g2 = s.eb.z, b2 = s.eb.w;
    const float c1 = b1 * (s.v1 - g1 * d1);
    const float c2 = b2 * (s.v2 - g2 * (g1 * d2 + c1 * s.sc.x));
    const float o1 = g1 * e1 + c1 * s.sc.y;
    const float o2 = g2 * (g1 * e2 + c1 * s.sc.z) + c2 * s.sc.w;
    const float gg = g1 * g2, f1 = g2 * c1;
    S[0] = S[0] * gg + s.k1a.xy * f1 + s.k2a.xy * c2; S[1] = S[1] * gg + s.k1a.zw * f1 + s.k2a.zw * c2;
    S[2] = S[2] * gg + s.k1b.xy * f1 + s.k2b.xy * c2; S[3] = S[3] * gg + s.k1b.zw * f1 + s.k2b.zw * c2;
    if (wr) { ob[0] = o1; ob[32] = o2; }
}
#undef DPP4
struct GStage { u32x4 k, q, v; f32x4 sc; float e; };
__device__ __forceinline__ void gdn_gload(GStage& g, const bf16* GK, const bf16* GQ, const bf16* GV, const float* GEG, const float* GBE, const f32x4* GSC, int t0, int tid) {
    { const int st = tid >> 4, f8 = tid & 15; g.k = *(const u32x4*)(GK + (size_t)(t0 + st) * 1024 + 8 * f8); g.q = *(const u32x4*)(GQ + (size_t)(t0 + st) * 1024 + 8 * f8); }
    { const int i = tid & 127; g.v = *(const u32x4*)(GV + (size_t)(t0 + (i >> 2)) * 1024 + 8 * (i & 3)); }
    { const int i = tid & 63; const float* p = (i < 32 ? GEG : GBE); g.e = p[(size_t)(t0 + (i & 31)) * 8]; }
    g.sc = GSC[(size_t)((t0 >> 1) + (tid & 15)) * 8];
}
__device__ __forceinline__ void st8(LAS float* d, const u32x4 w) { float f[8]; unpack8(w, f); *(LAS f32x4*)d = (f32x4){f[0], f[1], f[2], f[3]}; *(LAS f32x4*)(d + 4) = (f32x4){f[4], f[5], f[6], f[7]}; }
__device__ __forceinline__ void gdn_gstore(const GStage& g, LAS float* buf, int tid) {
    st8(buf + 8 * tid, g.k); st8(buf + CH * 128 + 8 * tid, g.q);
    if (tid < 128) st8(buf + 2 * CH * 128 + 8 * tid, g.v);
    else if (tid >= 256 && tid < 320) { const int i = tid - 256, st = i & 31, wh = i >> 5; buf[2 * CH * 128 + CH * 32 + (st >> 1) * 4 + (st & 1) * 2 + wh] = g.e; }
    else if (tid >= 320 && tid < 336) *(LAS f32x4*)(buf + 2 * CH * 128 + CH * 32 + 2 * CH + 4 * (tid - 320)) = g.sc;
}
__device__ __forceinline__ void gdn_block(const Ctx& F, int vb) {
    const int bh = vb >> 2, qt = vb & 3, b = bh >> 3, h = bh & 7, colL = F.wave * 4 + (F.lane >> 4), rg = F.lane & 15;
    const size_t base = (size_t)b * SEQ;
    const bf16* GK = (const bf16*)(F.ws + WS_GK) + base * 1024 + h * 128; const bf16* GQ = (const bf16*)(F.ws + WS_GQ) + base * 1024 + h * 128;
    const bf16* GV = (const bf16*)(F.ws + WS_GV) + base * 1024 + h * 128 + qt * 32;
    const float* GEG = (const float*)(F.ws + WS_GEG) + base * 8 + h; const float* GBE = (const float*)(F.ws + WS_GBE) + base * 8 + h;
    const f32x4* GSC = (const f32x4*)(F.ws + WS_GSC) + (base >> 1) * 8 + h;
    float* GO = (float*)(F.ws + WS_GO) + base * 1024 + h * 128 + qt * 32;
    LAS float* lb = (LAS float*)F.lds; LAS float* obase = lb + 2 * G_BUF;
    f32x2 S[4] = {{0.f, 0.f}, {0.f, 0.f}, {0.f, 0.f}, {0.f, 0.f}};
    const bool wr = rg == 0;
    GStage g;
    gdn_gload(g, GK, GQ, GV, GEG, GBE, GSC, 0, F.tid); gdn_gstore(g, lb, F.tid);
    __syncthreads();
    for (int c = 0; c < SEQ / CH; ++c) {
        const LAS float* buf = lb + (c & 1) * G_BUF; LAS float* ob = obase + (c & 1) * (CH * 32) + colL;
        if (c + 1 < SEQ / CH) gdn_gload(g, GK, GQ, GV, GEG, GBE, GSC, (c + 1) * CH, F.tid);
        GPair P0, P1;
        gdn_lds(P0, buf, 0, rg, colL);
#pragma unroll 4
        for (int pr = 0; pr < CH / 2; pr += 2) {
            gdn_lds(P1, buf, pr + 1, rg, colL); gdn_pair(P0, S, ob + 2 * pr * 32, wr);
            gdn_lds(P0, buf, (pr + 2) & (CH / 2 - 1), rg, colL); gdn_pair(P1, S, ob + (2 * pr + 2) * 32, wr);
        }
        if (c + 1 < SEQ / CH) gdn_gstore(g, lb + ((c + 1) & 1) * G_BUF, F.tid);
        __syncthreads();
        if (F.tid < 256) *(f32x4*)(GO + (size_t)(c * CH + (F.tid >> 3)) * 1024 + 4 * (F.tid & 7)) = *(const LAS f32x4*)(obase + (c & 1) * (CH * 32) + 4 * F.tid);
    }
}

struct RStep { f32x4 w, n, a, k, r; float v; };
constexpr int R_BUF = CH * (5 * 64 + 32);
__device__ __forceinline__ void rwkv_lds(RStep& s, const LAS float* buf, int st, int cq, int rowL) {
    s.w = *(const LAS f32x4*)(buf + st * 64 + 4 * cq); s.n = *(const LAS f32x4*)(buf + CH * 64 + st * 64 + 4 * cq); s.a = *(const LAS f32x4*)(buf + 2 * CH * 64 + st * 64 + 4 * cq);
    s.k = *(const LAS f32x4*)(buf + 3 * CH * 64 + st * 64 + 4 * cq); s.r = *(const LAS f32x4*)(buf + 4 * CH * 64 + st * 64 + 4 * cq); s.v = buf[5 * CH * 64 + st * 32 + rowL];
}
__device__ __forceinline__ void rwkv_step(const RStep& s, f32x4& S, LAS float* ob, bool wr) {
    float sa = (S.x * s.n.x + S.y * s.n.y) + (S.z * s.n.z + S.w * s.n.w);
    sa = allred16(sa);
    S = S * s.w + sa * s.a + s.v * s.k;
    float y = (S.x * s.r.x + S.y * s.r.y) + (S.z * s.r.z + S.w * s.r.w);
    y = allred16(y);
    if (wr) *ob = y;
}
struct RStage { f32x4 x[2]; u32x4 y[3], v; };
__device__ __forceinline__ void rwkv_gload(RStage& g, const float* RW, const float* RN, const bf16* RA, const bf16* RKp, const bf16* RRp, const bf16* RV, int t0, int tid) {
    { const int st = tid >> 4, f4 = tid & 15; g.x[0] = *(const f32x4*)(RW + (size_t)(t0 + st) * 1024 + 4 * f4); g.x[1] = *(const f32x4*)(RN + (size_t)(t0 + st) * 1024 + 4 * f4); }
    { const int i = tid & 255; const size_t o = (size_t)(t0 + (i >> 3)) * 1024 + 8 * (i & 7); g.y[0] = *(const u32x4*)(RA + o); g.y[1] = *(const u32x4*)(RKp + o); g.y[2] = *(const u32x4*)(RRp + o); }
    { const int i = tid & 127; g.v = *(const u32x4*)(RV + (size_t)(t0 + (i >> 2)) * 1024 + 8 * (i & 3)); }
}
__device__ __forceinline__ void rwkv_gstore(const RStage& g, LAS float* buf, int tid) {
    *(LAS f32x4*)(buf + 4 * tid) = g.x[0]; *(LAS f32x4*)(buf + CH * 64 + 4 * tid) = g.x[1];
    if (tid < 256) { st8(buf + 2 * CH * 64 + 8 * tid, g.y[0]); st8(buf + 3 * CH * 64 + 8 * tid, g.y[1]); st8(buf + 4 * CH * 64 + 8 * tid, g.y[2]); }
    else if (tid < 384) st8(buf + 5 * CH * 64 + 8 * (tid - 256), g.v);
}
__device__ __forceinline__ void rwkv_block(const Ctx& F, int vb) {
    const int bh = vb >> 1, hf = vb & 1, b = bh >> 4, h = bh & 15, rowL = F.wave * 4 + (F.lane >> 4), cq = F.lane & 15;
    const size_t base = (size_t)b * SEQ * 1024 + h * 64;
    const float* RW = (const float*)(F.ws + WS_RW) + base; const float* RN = (const float*)(F.ws + WS_RKK) + base;
    const bf16* RA = (const bf16*)(F.ws + WS_RKA) + base; const bf16* RKp = (const bf16*)(F.ws + WS_RK) + base; const bf16* RRp = (const bf16*)(F.ws + WS_RR) + base;
    const bf16* RV = (const bf16*)(F.ws + WS_RV) + base + hf * 32;
    float* RY = (float*)(F.ws + WS_RY) + base + hf * 32;
    LAS float* lb = (LAS float*)F.lds; LAS float* obase = lb + 2 * R_BUF;
    f32x4 S = {0.f, 0.f, 0.f, 0.f};
    const bool wr = cq == 0;
    RStage g;
    rwkv_gload(g, RW, RN, RA, RKp, RRp, RV, 0, F.tid); rwkv_gstore(g, lb, F.tid);
    __syncthreads();
    for (int c = 0; c < SEQ / CH; ++c) {
        const LAS float* buf = lb + (c & 1) * R_BUF; LAS float* ob = obase + (c & 1) * (CH * 32) + rowL;
        if (c + 1 < SEQ / CH) rwkv_gload(g, RW, RN, RA, RKp, RRp, RV, (c + 1) * CH, F.tid);
        RStep R0, R1, R2, R3;
        rwkv_lds(R0, buf, 0, cq, rowL); rwkv_lds(R1, buf, 1, cq, rowL);
#pragma unroll 4
        for (int s = 0; s < CH; s += 4) {
            rwkv_lds(R2, buf, s + 2, cq, rowL); rwkv_step(R0, S, ob + s * 32, wr);
            rwkv_lds(R3, buf, s + 3, cq, rowL); rwkv_step(R1, S, ob + (s + 1) * 32, wr);
            rwkv_lds(R0, buf, (s + 4) & (CH - 1), cq, rowL); rwkv_step(R2, S, ob + (s + 2) * 32, wr);
            rwkv_lds(R1, buf, (s + 5) & (CH - 1), cq, rowL); rwkv_step(R3, S, ob + (s + 3) * 32, wr);
        }
        if (c + 1 < SEQ / CH) rwkv_gstore(g, lb + ((c + 1) & 1) * R_BUF, F.tid);
        __syncthreads();
        if (F.tid < 256) *(f32x4*)(RY + (size_t)(c * CH + (F.tid >> 3)) * 1024 + 4 * (F.tid & 7)) = *(const LAS f32x4*)(obase + (c & 1) * (CH * 32) + 4 * F.tid);
    }
}

constexpr int S5_SROW = 136;
constexpr int S5_BROW = 20;
constexpr int S5_WAVE_B = 16 * S5_SROW * 2 + 1024 + 128 * S5_BROW * 4;
__device__ __forceinline__ void s5_block(const Ctx& F, const Args& a, int l, int it) {
    const int b = it >> 6, g = it & 63, p = F.lane, tl = F.lane >> 4, c = F.lane & 15, w = F.wave;
    const bf16* PROJ = (const bf16*)(F.ws + WS_PROJ); bf16* SY = (bf16*)(F.ws + WS_SY);
    LAS float* se = (LAS float*)F.lds;
    LAS unsigned char* wb = F.lds + 4096 + w * S5_WAVE_B;
    LAS bf16* sbuf = (LAS bf16*)wb; LAS float* uall = (LAS float*)(wb + 16 * S5_SROW * 2); LAS float* BU = uall + 256;
    const float dt = expf(a.in[19][l * 64 + g]);
    float abr, abi;
    {   const size_t gp = ((size_t)l * 64 + g) * 64 + p; const float are = a.in[17][gp], aim = a.in[18][gp]; const float mag = expf(are * dt); abr = mag * cosf(aim * dt); abi = mag * sinf(aim * dt); }
    bf16x8_t Bf[8];
    {   const int hl = tl >> 1, c0 = 8 * (tl & 1);
#pragma unroll
        for (int jj = 0; jj < 4; ++jj) {
            const size_t gp2 = ((size_t)l * 64 + g) * 64 + 16 * jj + c; const float are = a.in[17][gp2], aim = a.in[18][gp2];
            const float mag = expf(are * dt), ar = mag * cosf(aim * dt), ai = mag * sinf(aim * dt);
            const float den = are * are + aim * aim, cr = ((ar - 1.f) * are + ai * aim) / den, ci = (ai * are - (ar - 1.f) * aim) / den;
            const f32x4 r0 = *(const f32x4*)(a.in[20] + gp2 * 16 + c0), r1 = *(const f32x4*)(a.in[20] + gp2 * 16 + c0 + 4), i0 = *(const f32x4*)(a.in[21] + gp2 * 16 + c0), i1 = *(const f32x4*)(a.in[21] + gp2 * 16 + c0 + 4);
            const float br[8] = {r0.x, r0.y, r0.z, r0.w, r1.x, r1.y, r1.z, r1.w}, bi[8] = {i0.x, i0.y, i0.z, i0.w, i1.x, i1.y, i1.z, i1.w};
            float vr[8], vi[8];
#pragma unroll
            for (int e = 0; e < 8; ++e) { const float xr = cr * br[e] - ci * bi[e], xi = cr * bi[e] + ci * br[e];
                const float hr = bflo(pk2(xr, 0.f)), hi = bflo(pk2(xi, 0.f)); vr[e] = hl ? xr - hr : hr; vi[e] = hl ? xi - hi : hi; }
            Bf[jj] = __builtin_bit_cast(bf16x8_t, pack8(vr)); Bf[4 + jj] = __builtin_bit_cast(bf16x8_t, pack8(vi));
        }
    }
    bf16x8_t Cf[4];
    { const size_t cb = (((size_t)l * 64 + g) * 16 + c) * 64;
#pragma unroll
      for (int m = 0; m < 4; ++m) { const int k0 = 32 * m + 8 * tl; const float* src = (k0 < 64 ? a.in[22] + cb + k0 : a.in[23] + cb + (k0 - 64)); const float sg = k0 < 64 ? 1.f : -1.f;
          const f32x4 x0 = *(const f32x4*)src, x1 = *(const f32x4*)(src + 4);
          u32x4 pk; pk.x = pk2(sg * x0.x, sg * x0.y); pk.y = pk2(sg * x0.z, sg * x0.w); pk.z = pk2(sg * x1.x, sg * x1.y); pk.w = pk2(sg * x1.z, sg * x1.w);
          Cf[m] = __builtin_bit_cast(bf16x8_t, pk); } }
    const float dsk = a.in[24][l * 1024 + g * 16 + c];
    const int tw = 256 * w;
    const bf16* up = PROJ + ((size_t)b * SEQ + tw + c) * NINP + C_SU + g * 16 + 8 * (tl & 1);
    float sr = 0.f, si = 0.f;
#define S5_BU(UF) do { const bf16x8_t af_ = __builtin_bit_cast(bf16x8_t, UF); \
        _Pragma("unroll") for (int j = 0; j < 8; ++j) { const f32x4 z_ = {0.f, 0.f, 0.f, 0.f}; const f32x4 d_ = __builtin_amdgcn_mfma_f32_16x16x32_bf16(af_, Bf[j], z_, 0, 0, 0); \
            *(LAS f32x4*)(BU + (16 * j + c) * S5_BROW + 4 * tl) = d_; } asm volatile("" :: "v"(af_)); } while (0)
    {
        u32x4 ucur = *(const u32x4*)up;
        for (int t = 0; t < 256; t += 16) {
            const u32x4 unxt = *(const u32x4*)(up + (size_t)((t + 16 < 256) ? t + 16 : t) * NINP);
            S5_BU(ucur);
            WFENCE();
            float br_[16], bi_[16];
#pragma unroll
            for (int q = 0; q < 4; ++q) { const f32x4 x = *(const LAS f32x4*)(BU + p * S5_BROW + 4 * q), y = *(const LAS f32x4*)(BU + (64 + p) * S5_BROW + 4 * q);
                br_[4 * q] = x.x; br_[4 * q + 1] = x.y; br_[4 * q + 2] = x.z; br_[4 * q + 3] = x.w; bi_[4 * q] = y.x; bi_[4 * q + 1] = y.y; bi_[4 * q + 2] = y.z; bi_[4 * q + 3] = y.w; }
#pragma unroll
            for (int s = 0; s < 16; ++s) { const float nr = abr * sr - abi * si + br_[s], ni = abr * si + abi * sr + bi_[s]; sr = nr; si = ni; }
            WFENCE();
            ucur = unxt;
        }
    }
    se[w * 128 + p] = sr; se[w * 128 + 64 + p] = si;
    __syncthreads();
    {
        float pr = abr, pi = abi;
#pragma unroll
        for (int i = 0; i < 8; ++i) { const float nr = pr * pr - pi * pi, ni = 2.f * pr * pi; pr = nr; pi = ni; }
        sr = 0.f; si = 0.f;
        for (int j = 0; j < w; ++j) { const float er = se[j * 128 + p], ei = se[j * 128 + 64 + p]; const float nr = pr * sr - pi * si + er, ni = pr * si + pi * sr + ei; sr = nr; si = ni; }
    }
    {
        u32x4 ucur = *(const u32x4*)up;
        for (int t = 0; t < 256; t += 16) {
            const u32x4 unxt = *(const u32x4*)(up + (size_t)((t + 16 < 256) ? t + 16 : t) * NINP);
            S5_BU(ucur);
            if (tl < 2) { float uf[8]; unpack8(ucur, uf); *(LAS f32x4*)(uall + c * 16 + 8 * tl) = (f32x4){uf[0], uf[1], uf[2], uf[3]}; *(LAS f32x4*)(uall + c * 16 + 8 * tl + 4) = (f32x4){uf[4], uf[5], uf[6], uf[7]}; }
            WFENCE();
            float br_[16], bi_[16];
#pragma unroll
            for (int q = 0; q < 4; ++q) { const f32x4 x = *(const LAS f32x4*)(BU + p * S5_BROW + 4 * q), y = *(const LAS f32x4*)(BU + (64 + p) * S5_BROW + 4 * q);
                br_[4 * q] = x.x; br_[4 * q + 1] = x.y; br_[4 * q + 2] = x.z; br_[4 * q + 3] = x.w; bi_[4 * q] = y.x; bi_[4 * q + 1] = y.y; bi_[4 * q + 2] = y.z; bi_[4 * q + 3] = y.w; }
#pragma unroll
            for (int s = 0; s < 16; ++s) { const float nr = abr * sr - abi * si + br_[s], ni = abr * si + abi * sr + bi_[s]; sr = nr; si = ni;
                const unsigned pk = pk2(sr, si); sbuf[s * S5_SROW + p] = (bf16)(pk & 0xffffu); sbuf[s * S5_SROW + 64 + p] = (bf16)(pk >> 16); }
            WFENCE();
            f32x4 acc = {0.f, 0.f, 0.f, 0.f};
#pragma unroll
            for (int m = 0; m < 4; ++m) { const bf16x8_t af = *(const LAS bf16x8_t*)(sbuf + c * S5_SROW + 32 * m + 8 * tl);
                acc = __builtin_amdgcn_mfma_f32_16x16x32_bf16(af, Cf[m], acc, 0, 0, 0); asm volatile("" :: "v"(af)); }
#pragma unroll
            for (int r = 0; r < 4; ++r) { const int st = 4 * tl + r; const float y = acc[r] + dsk * uall[st * 16 + c];
                SY[((size_t)b * SEQ + tw + t + st) * 1024 + g * 16 + c] = (bf16)(pk2(gelu_tanh(y), 0.f) & 0xffffu); }
            WFENCE();
            ucur = unxt;
        }
    }
#undef S5_BU
    __syncthreads();
}

__device__ __forceinline__ void scan_phase(const Ctx& F, const Args& a, int l) {
    for (int r5 = 0; r5 < 1 + ((REPM >> 9) & 1); ++r5) for (int vb = F.vcu; vb < 256; vb += F.G) s5_block(F, a, l, vb);
    for (int rg_ = 0; rg_ < 1 + ((REPM >> 10) & 1); ++rg_) for (int vb = F.vcu; vb < 256; vb += F.G) {
        if (vb < 128) { gdn_block(F, vb); if (REPM & 2048) gdn_block(F, vb); }
        else { rwkv_block(F, vb - 128); if (REPM & 4096) rwkv_block(F, vb - 128); }
    }
}

__device__ __forceinline__ void post_phase(const Ctx& F, const Args& a, int l, int gw, int ngw) {
    const bf16* PROJ = (const bf16*)(F.ws + WS_PROJ); bf16* OBR = (bf16*)(F.ws + WS_OBR);
    const float* GO = (const float*)(F.ws + WS_GO); const float* RY = (const float*)(F.ws + WS_RY); const float* RV = (const float*)(F.ws + WS_RV); const float* RBON = (const float*)(F.ws + WS_RBON);
    const int c0 = 16 * F.lane;
    float nw[16], lw[16], lb[16];
#pragma unroll
    for (int e = 0; e < 16; ++e) { nw[e] = a.in[6][l * 128 + (c0 & 127) + e]; lw[e] = a.in[15][l * 1024 + c0 + e]; lb[e] = a.in[16][l * 1024 + c0 + e]; }
    for (int tok = gw; tok < TOK; tok += ngw) {
        { float o[16];
#pragma unroll
          for (int q = 0; q < 4; ++q) { const f32x4 v = *(const f32x4*)(GO + (size_t)tok * 1024 + c0 + 4 * q); o[4 * q] = v.x; o[4 * q + 1] = v.y; o[4 * q + 2] = v.z; o[4 * q + 3] = v.w; }
          float ss = 0.f;
#pragma unroll
          for (int e = 0; e < 16; ++e) ss += o[e] * o[e];
          ss = allred8(ss);
          const float rs = rsqrtf(ss * (1.f / 128.f) + 1e-6f);
          float z[16]; { float z0[8], z1[8]; unpack8(*(const u32x4*)(PROJ + (size_t)tok * NINP + C_GZ + c0), z0); unpack8(*(const u32x4*)(PROJ + (size_t)tok * NINP + C_GZ + c0 + 8), z1);
#pragma unroll
              for (int e = 0; e < 8; ++e) { z[e] = z0[e]; z[8 + e] = z1[e]; } }
          float r0[8], r1[8];
#pragma unroll
          for (int e = 0; e < 8; ++e) { r0[e] = o[e] * rs * nw[e] * siluf_(z[e]); r1[e] = o[8 + e] * rs * nw[8 + e] * siluf_(z[8 + e]); }
          *(u32x4*)(OBR + (size_t)tok * 1024 + c0) = pack8(r0); *(u32x4*)(OBR + (size_t)tok * 1024 + c0 + 8) = pack8(r1); }
        { float y[16], v[16];
#pragma unroll
          for (int q = 0; q < 4; ++q) { const f32x4 t = *(const f32x4*)(RY + (size_t)tok * 1024 + c0 + 4 * q); y[4 * q] = t.x; y[4 * q + 1] = t.y; y[4 * q + 2] = t.z; y[4 * q + 3] = t.w;
          }
          { float va[8], vb[8]; unpack8(*(const u32x4*)((const bf16*)RV + (size_t)tok * 1024 + c0), va); unpack8(*(const u32x4*)((const bf16*)RV + (size_t)tok * 1024 + c0 + 8), vb);
#pragma unroll
              for (int e = 0; e < 8; ++e) { v[e] = va[e]; v[8 + e] = vb[e]; } }
          float s = 0.f;
#pragma unroll
          for (int e = 0; e < 16; ++e) s += y[e];
          s += dppf<0xB1>(s); s += dppf<0x4E>(s);
          const float mean = s * (1.f / 64.f); float q2 = 0.f;
#pragma unroll
          for (int e = 0; e < 16; ++e) { const float d = y[e] - mean; q2 += d * d; }
          q2 += dppf<0xB1>(q2); q2 += dppf<0x4E>(q2);
          const float rs = rsqrtf(q2 * (1.f / 64.f) + 64e-5f);
          const float bon = RBON[(size_t)tok * 16 + (c0 >> 6)];
          float z[16]; { float z0[8], z1[8]; unpack8(*(const u32x4*)(PROJ + (size_t)tok * NINP + C_RZ + c0), z0); unpack8(*(const u32x4*)(PROJ + (size_t)tok * NINP + C_RZ + c0 + 8), z1);
#pragma unroll
              for (int e = 0; e < 8; ++e) { z[e] = z0[e]; z[8 + e] = z1[e]; } }
          float r0[8], r1[8];
#pragma unroll
          for (int e = 0; e < 8; ++e) { r0[e] = ((y[e] - mean) * rs * lw[e] + lb[e] + bon * v[e]) * siluf_(z[e]); r1[e] = ((y[8 + e] - mean) * rs * lw[8 + e] + lb[8 + e] + bon * v[8 + e]) * siluf_(z[8 + e]); }
          bf16* ob = OBR + (size_t)TOK * 1024 + (size_t)tok * 1024 + c0;
          *(u32x4*)ob = pack8(r0); *(u32x4*)(ob + 8) = pack8(r1); }
    }
}

#ifndef PHM
#define PHM 0xFFFF
#endif
#ifndef REPM
#define REPM 0
#endif
__global__ void __launch_bounds__(NTHREADS, 2) hybrid_fwd(Args a) {
    extern __shared__ __attribute__((aligned(16))) unsigned char lds_raw[];
    Ctx F;
    F.lds = (LAS unsigned char*)lds_raw; F.ws = a.ws;
    F.G = gridDim.x; { const int bx = blockIdx.x; F.vcu = (F.G % 8 == 0) ? (bx % 8) * (F.G / 8) + bx / 8 : bx; }
    F.NGW = F.G * NWAVES;
    cg::grid_group grid = cg::this_grid();
    if (threadIdx.x < 8) ((volatile LAS unsigned*)(F.lds + MISC_OFF))[threadIdx.x] = 0u;
    __syncthreads();
    grid.sync();
    XcdBarrier bar = xcd_barrier_post((unsigned*)(a.ws + WS_CTL), (volatile LAS unsigned*)(F.lds + MISC_OFF));
    bf16* XN = (bf16*)(a.ws + WS_XN); bf16* PROJ = (bf16*)(a.ws + WS_PROJ);
    int rep = 0;
    for (int ph = a.ph_lo; ph < a.ph_hi; ) {
        { int t_ = threadIdx.x; asm volatile("" : "+v"(t_)); F.tid = t_; F.lane = t_ & 63; F.wave = __builtin_amdgcn_readfirstlane(t_ >> 6); F.gw = F.vcu * NWAVES + F.wave; }
        if (ph == NPHASES - 1) { for (int m = F.gw; m < TOK; m += F.NGW) rms_row(a.out + (size_t)m * DM, a.in[30], nullptr, nullptr, a.out + (size_t)m * DM, F.lane); }
        else if (ph == 0) { if (PHM & 1) phase0(F, a);
            if (REPM & 128) { if (!rep) { rep = 1; __syncthreads(); continue; } rep = 0; } }
        else {
            const int l = (ph - 1) / PH_PER_LAYER, k = (ph - 1) % PH_PER_LAYER;
            if (k == 0 && (PHM & 2)) {
                pg8::Gemm g{XN, (const bf16*)(a.ws + WS_WIN) + (size_t)l * NINP * DM, TOK, NINP, DM}; pg8::StaticOrder S; S.init(TOK, NINP, F.G, (int)blockIdx.x);
                pg8::EpiBf16Rs E{PROJ, NINP, (const unsigned long long*)(a.ws + WS_CTL + CTL_SS) + (size_t)l * TOK};
                pg8::gemm_phase<pg8::EpiBf16Rs, pg8::StaticOrder, true, true>(F.lds, g, S, E);
                if (l + 1 < DEPTH) {
                    const int rem = ((TOK / 256) * (NINP / 256)) % F.G, bx = (int)blockIdx.x;
                    if (rem == 0) convert_layer(F, a, l + 1, F.gw, F.NGW);
                    else if (bx >= rem) convert_layer(F, a, l + 1, (bx - rem) * NWAVES + F.wave, (F.G - rem) * NWAVES);
                }
            } else if (k == 1) { prep_gdn(F, a, l); if (REPM & 8192) prep_gdn(F, a, l); prep_rwkv(F, a, l); if (REPM & 16384) prep_rwkv(F, a, l); }
            else if (k == 2) { if (PHM & 16) scan_phase(F, a, l); }
            else if (k == 3 && (PHM & 32)) {
                const bool split = F.G >= 192;
                if (!split) { post_phase(F, a, l, F.gw, F.NGW); __syncthreads(); }
                if (!split || (int)blockIdx.x < 128) {
                    pg8::Gemm g{(const bf16*)(a.ws + WS_SY), (const bf16*)(a.ws + WS_WGLU) + (size_t)l * 1024 * 1024, TOK, 1024, 1024}; pg8::StaticOrder S; S.init(TOK, 1024, F.G, (int)blockIdx.x);
                    pg8::EpiGlu E{(const bf16*)(a.ws + WS_SY), PROJ, a.in[26] + l * 1024, (bf16*)(a.ws + WS_OBR) + (size_t)2 * TOK * 1024};
                    pg8::gemm_phase<pg8::EpiGlu, pg8::StaticOrder, true, true>(F.lds, g, S, E);
                } else post_phase(F, a, l, ((int)blockIdx.x - 128) * NWAVES + F.wave, (F.G - 128) * NWAVES);
            } else if (k == 4 && (PHM & 64)) {
                pg8::Gemm g{(const bf16*)(a.ws + WS_OBR), (const bf16*)(a.ws + WS_WBR) + (size_t)l * 3 * DM * 1024, 3 * TOK, 3 * DM, 1024};
                pg8::BranchOrder S; S.base.init(TOK, DM, F.G, (int)blockIdx.x);
                pg8::EpiBranch E{PROJ, a.in[27] + (size_t)l * 3 * DM, (bf16*)(a.ws + WS_ACCF), (bf16*)(a.ws + WS_MRG)};
                pg8::gemm_phase<pg8::EpiBranch, pg8::BranchOrder, true, true>(F.lds, g, S, E);
            } else if (k == 5 && (PHM & 128)) {
                pg8::Gemm g{(const bf16*)(a.ws + WS_MRG), (const bf16*)(a.ws + WS_WOUT) + (size_t)l * DM * DM, TOK, DM, DM}; pg8::StaticOrder S; S.init(TOK, DM, F.G, (int)blockIdx.x);
                pg8::EpiResid E{l == 0 ? a.in[0] : a.out, a.out, l + 1 < DEPTH ? XN : nullptr, a.in[1] + (size_t)(l + 1 < DEPTH ? l + 1 : 0) * DM, (unsigned long long*)(a.ws + WS_CTL + CTL_SS) + (size_t)(l + 1 < DEPTH ? l + 1 : 0) * TOK};
                pg8::gemm_phase<pg8::EpiResid, pg8::StaticOrder, true, true>(F.lds, g, S, E);
            }
            if (REPM && !rep && ((REPM >> k) & 1)) { rep = 1; __syncthreads(); continue; }
            rep = 0;
        }
        if (ph + 1 < a.ph_hi) {
            xcd_barrier(bar);
            if (REPM & 256) xcd_barrier(bar);
        }
        ++ph;
    }
}

#ifndef MK_MULTI
#define MK_MULTI 0
#endif
extern "C" void kernel_launch(void* const* d_in, const int* in_sizes, int n_in, void* d_out, int out_size, void* d_ws, size_t ws_size, hipStream_t stream) {
    static int grid = 0;
    if (grid == 0) {
        if (n_in != 31 || out_size != TOK * DM || ws_size < WS_END) { fprintf(stderr, "kernel_launch: unexpected shapes (n_in %d out %d ws %zu)\n", n_in, out_size, ws_size); grid = -1; return; }
        int dev = 0, cus = 0, per_cu = 0;
        hipGetDevice(&dev); hipDeviceGetAttribute(&cus, hipDeviceAttributeMultiprocessorCount, dev);
        if (hipFuncSetAttribute((const void*)hybrid_fwd, hipFuncAttributeMaxDynamicSharedMemorySize, LDS_BYTES) != hipSuccess) { fprintf(stderr, "kernel_launch: hipFuncSetAttribute failed\n"); grid = -1; return; }
        if (hipOccupancyMaxActiveBlocksPerMultiprocessor(&per_cu, (const void*)hybrid_fwd, NTHREADS, LDS_BYTES) != hipSuccess || per_cu < 1) per_cu = 1;
        (void)hipGetLastError();
        grid = cus * per_cu;
        fprintf(stderr, "kernel_launch: grid %d (cus %d x %d)\n", grid, cus, per_cu);
    }
    if (grid < 0) return;
    if (hipMemsetAsync((char*)d_ws + WS_CTL, 0, CTL_ZERO_BYTES, stream) != hipSuccess) { fprintf(stderr, "kernel_launch: memset failed\n"); return; }
    Args a{};
    for (int i = 0; i < 31; ++i) a.in[i] = (const float*)d_in[i];
    a.out = (float*)d_out; a.ws = (unsigned char*)d_ws;
#if MK_MULTI
    for (int ph = 0; ph < NPHASES; ++ph) { a.ph_lo = ph; a.ph_hi = ph + 1; hipLaunchKernelGGL(hybrid_fwd, dim3(grid), dim3(NTHREADS), LDS_BYTES, stream, a); }
#else
    a.ph_lo = 0; a.ph_hi = NPHASES;
    void* args[] = {&a};
    const hipError_t e = hipLaunchCooperativeKernel((const void*)hybrid_fwd, dim3(grid), dim3(NTHREADS), args, LDS_BYTES, stream);
    if (e != hipSuccess) fprintf(stderr, "kernel_launch: cooperative launch failed: %s (grid %d)\n", hipGetErrorString(e), grid);
#endif
}
```

```cpp
#include <hip/hip_runtime.h>
#include <hip/hip_cooperative_groups.h>
#include <cstdio>
#include <cstdint>
namespace cg = cooperative_groups;
namespace pg8 {
#define PG8_LAS __attribute__((address_space(3)))
typedef unsigned short bf16_t;
typedef short bf16x8 __attribute__((ext_vector_type(8)));
typedef float f32x4 __attribute__((ext_vector_type(4)));
typedef unsigned u32x4 __attribute__((ext_vector_type(4)));
constexpr int BM = 256, BK = 64, HALF = 128, HTB = HALF * BK * 2  , STAGE_BYTES = 8 * HTB, NXCD = 8, WGM = 8;

__host__ __device__ __forceinline__ int lds_byte(int r, int c) { const int st = (r >> 4) * 2 + (c >> 5), rr = r & 15, cc = c & 31, ob = rr * 64 + cc * 2; return st * 1024 + (ob ^ (((ob >> 9) & 1) << 5)); }
__host__ __device__ __forceinline__ void stage_rc(int b, int& R, int& C) { const int st = b / 1024, sb = b % 1024, swz = sb ^ (((sb >> 9) & 1) << 5); R = (st >> 1) * 16 + swz / 64; C = (st & 1) * 32 + (swz % 64) / 2; }
__host__ __device__ __forceinline__ int perm32(int rho) { const int n = rho >> 4, i = rho & 15; return 8 * (i >> 2) + 4 * n + (i & 3); }

struct Unit { int pm, pn; };
struct Gemm { const bf16_t* A; const bf16_t* Bt; int M, N, K, ld; };

struct StaticOrder {
    int nM, nN, nwg, G, c;
    __host__ __device__ void init(int M, int N, int G_, int c_) { nM = M / BM; nN = N / BM; nwg = nM * nN; G = G_; c = c_; }
    __host__ __device__ bool next(int i, Unit& u) const {
        const long L = (long)i * G + c; if (L >= nwg) return false;
        int wgid = (int)L; { const int q = nwg / NXCD, r = nwg % NXCD, xcd = wgid % NXCD, off = wgid / NXCD; wgid = (xcd < r ? xcd * (q + 1) : r * (q + 1) + (xcd - r) * q) + off; }
        const int nig = WGM * nN, gid = wgid / nig, fm = gid * WGM, gsz = (nM - fm) < WGM ? (nM - fm) : WGM;
        u.pm = fm + ((wgid % nig) % gsz); u.pn = (wgid % nig) / gsz; return true;
    }
    __device__ __forceinline__ void a_ready(const Unit&) const {}
    __device__ __forceinline__ void done(const Unit&) const {}
};

__device__ __forceinline__ unsigned cvt_pk_bf16(float lo, float hi) { unsigned r; asm volatile("v_cvt_pk_bf16_f32 %0, %1, %2" : "=v"(r) : "v"(lo), "v"(hi)); return r; }
typedef float f32x2 __attribute__((ext_vector_type(2)));
__device__ __forceinline__ f32x2 gelu_pk(f32x2 v) {
    const f32x2 av = __builtin_elementwise_abs(v), d = av * 0.2316418882f + 1.0f;
    f32x2 t; t.x = __builtin_amdgcn_rcpf(d.x); t.y = __builtin_amdgcn_rcpf(d.y);
    f32x2 q = t * 0.5307027145f + (-0.7265760135f); q = q * t + 0.7107068705f; q = q * t + (-0.142248368f); q = q * t + 0.127414796f; q = q * t;
    const f32x2 s = (v * v) * (-0.72134752044f);
    f32x2 e; e.x = __builtin_amdgcn_exp2f(s.x); e.y = __builtin_amdgcn_exp2f(s.y);
    const f32x2 m = v * (q * e), r = v - m;
    f32x2 o; o.x = v.x < 0.f ? m.x : r.x; o.y = v.y < 0.f ? m.y : r.y; return o;
}

template <int ACT  > struct EpiBf16 {
    static constexpr bool PERM = true, AFTER_DRAIN = false; static_assert(ACT == 0 || ACT == 1, "EpiBf16: ACT is 0 (none) or 1 (gelu_pk)");
    bf16_t* O; int ldc; const float* bias; int split_cols; size_t split_stride; float scale0;
    __device__ __forceinline__ void operator()(const f32x4 (&acc)[2][2][4][2], const Unit& u, int wr, int wc, int fr, int fq) const {
        const int row0 = u.pm * BM + wr * 64 + fr; int colt = u.pn * BM; bf16_t* base = O;
        float sc = 1.f; if (split_cols) { const int t = colt / split_cols; base += (size_t)t * split_stride; colt -= t * split_cols; if (t == 0) sc = scale0; }
        const int col0 = colt + wc * 32 + 8 * fq, bcol0 = u.pn * BM + wc * 32 + 8 * fq;
        f32x4 bv[2][2];
#pragma unroll
        for (int bj = 0; bj < 2; ++bj)
#pragma unroll
            for (int n = 0; n < 2; ++n) bv[bj][n] = bias ? *(const f32x4*)(bias + bcol0 + bj * HALF + 4 * n) : (f32x4){0.f, 0.f, 0.f, 0.f};
#pragma unroll
        for (int ai = 0; ai < 2; ++ai)
#pragma unroll
            for (int m = 0; m < 4; ++m) { bf16_t* rowp = base + (size_t)(row0 + ai * HALF + m * 16) * ldc + col0;
#pragma unroll
                for (int bj = 0; bj < 2; ++bj) { f32x4 v0 = acc[ai][bj][m][0] + bv[bj][0], v1 = acc[ai][bj][m][1] + bv[bj][1];
                    if (ACT == 1) { f32x2 a = gelu_pk((f32x2){v0[0], v0[1]}), b = gelu_pk((f32x2){v0[2], v0[3]}), c = gelu_pk((f32x2){v1[0], v1[1]}), d = gelu_pk((f32x2){v1[2], v1[3]});
                        v0 = (f32x4){a.x, a.y, b.x, b.y}; v1 = (f32x4){c.x, c.y, d.x, d.y}; }
                    v0 = v0 * sc; v1 = v1 * sc; u32x4 w; w.x = cvt_pk_bf16(v0[0], v0[1]); w.y = cvt_pk_bf16(v0[2], v0[3]); w.z = cvt_pk_bf16(v1[0], v1[1]); w.w = cvt_pk_bf16(v1[2], v1[3]);
                    *(u32x4*)(rowp + bj * HALF) = w; } }
    }
};

template <class Epi, class Sched, bool ALIGN_EPI = false, bool SP2 = false>
__device__ __forceinline__ void gemm_phase(PG8_LAS unsigned char* lds, const Gemm g, const Sched& S, const Epi& E) {
    int tid_ = threadIdx.x; asm volatile("" : "+v"(tid_));
    const int tid = tid_, wid = __builtin_amdgcn_readfirstlane(tid >> 6), lane = tid & 63, wr = wid >> 2, wc = wid & 3, fr = lane & 15, fq = lane >> 4;
    const int K = g.K, nt = K / BK, LD = g.ld ? g.ld : g.K;
    unsigned voffA[2], voffB[2];
#pragma unroll
    for (int i = 0; i < 2; ++i) { int R, C; stage_rc(tid * 16 + i * 8192, R, C); const int Rb = Epi::PERM ? ((R & ~31) + perm32(R & 31)) : R;
        voffA[i] = (unsigned)(R * LD + C) * 2u; voffB[i] = (unsigned)(Rb * LD + C) * 2u; }
    const size_t kstep = (size_t)(BK * 2);
    const size_t hstep = (size_t)HALF * LD * 2;
    const size_t tstep = 2 * hstep;
    const unsigned ldsw = (unsigned)wid * 1024u;
    const int aoff = lds_byte(wr * 64 + fr, fq * 8), boff = lds_byte(wc * 32 + fr, fq * 8);
#define PG8_SA(b, h) (((b) * 2 + (h)) * HTB)
#define PG8_SB(b, h) ((4 + (b) * 2 + (h)) * HTB)
#define PG8_STAGE(bufoff, gbase, voff) do { _Pragma("unroll") for (int _i = 0; _i < 2; ++_i) \
        __builtin_amdgcn_global_load_lds((const unsigned*)((const char*)(gbase) + (voff)[_i]), (PG8_LAS unsigned*)(lds + (bufoff) + ldsw + _i * 8192), 16, 0, 0); } while (0)
#define PG8_LDA(dst, b, h) do { _Pragma("unroll") for (int m = 0; m < 4; ++m) _Pragma("unroll") for (int k = 0; k < 2; ++k) dst[m][k] = *(const PG8_LAS bf16x8*)(lds + PG8_SA(b, h) + aoff + m * 2048 + k * 1024); } while (0)
#define PG8_LDB(dst, b, h) do { _Pragma("unroll") for (int n = 0; n < 2; ++n) _Pragma("unroll") for (int k = 0; k < 2; ++k) dst[n][k] = *(const PG8_LAS bf16x8*)(lds + PG8_SB(b, h) + boff + n * 2048 + k * 1024); } while (0)
#define PG8_MMA(ai, bj, At, Bt) do { __builtin_amdgcn_s_setprio(1); _Pragma("unroll") for (int m = 0; m < 4; ++m) _Pragma("unroll") for (int n = 0; n < 2; ++n) _Pragma("unroll") for (int k = 0; k < 2; ++k) \
        acc[ai][bj][m][n] = __builtin_amdgcn_mfma_f32_16x16x32_bf16(Bt[n][k], At[m][k], acc[ai][bj][m][n], 0, 0, 0); __builtin_amdgcn_s_setprio(0); } while (0)
#define PG8_WAIT_V(n) asm volatile("s_waitcnt vmcnt(" #n ")" ::: "memory")
#define PG8_WAIT_L(n) asm volatile("s_waitcnt lgkmcnt(" #n ")" ::: "memory")
#define PG8_BAR __builtin_amdgcn_s_barrier()
#define PG8_SCHED __builtin_amdgcn_sched_barrier(0)
    Unit cur, nxt; int ui = 0;
    if (!S.next(0, cur)) return;
    f32x4 acc[2][2][4][2];
#pragma unroll
    for (int a = 0; a < 2; ++a)
#pragma unroll
        for (int b = 0; b < 2; ++b)
#pragma unroll
            for (int m = 0; m < 4; ++m)
#pragma unroll
                for (int n = 0; n < 2; ++n) acc[a][b][m][n] = (f32x4){0.f, 0.f, 0.f, 0.f};
    bf16x8 At[4][2], B0[2][2], B1[2][2];
    const char* cA = (const char*)g.A + (size_t)cur.pm * tstep; const char* cB = (const char*)g.Bt + (size_t)cur.pn * tstep;
    S.a_ready(cur);
    if constexpr (SP2) {
        PG8_STAGE(PG8_SB(0, 0), cB, voffB); PG8_STAGE(PG8_SB(0, 1), cB + hstep, voffB); PG8_STAGE(PG8_SA(0, 0), cA, voffA); PG8_STAGE(PG8_SA(0, 1), cA + hstep, voffA);
        if (wr == 1) PG8_BAR;
        PG8_WAIT_V(2); PG8_BAR;
        PG8_STAGE(PG8_SB(1, 0), cB + kstep, voffB); PG8_STAGE(PG8_SA(1, 0), cA + kstep, voffA); PG8_STAGE(PG8_SB(1, 1), cB + hstep + kstep, voffB);
        PG8_WAIT_V(6); PG8_BAR;
    } else {
        PG8_STAGE(PG8_SB(0, 0), cB, voffB); PG8_STAGE(PG8_SA(0, 0), cA, voffA); PG8_STAGE(PG8_SB(0, 1), cB + hstep, voffB); PG8_STAGE(PG8_SA(0, 1), cA + hstep, voffA);
        if (wr == 1) PG8_BAR;
        PG8_WAIT_V(4); PG8_BAR;
        PG8_STAGE(PG8_SB(1, 0), cB + kstep, voffB); PG8_STAGE(PG8_SA(1, 0), cA + kstep, voffA); PG8_STAGE(PG8_SB(1, 1), cB + hstep + kstep, voffB);
        PG8_WAIT_V(6); PG8_BAR;
    }
    for (;;) {
        const bool has_next = S.next(ui + 1, nxt);
        const char* nA = has_next ? (const char*)g.A + (size_t)nxt.pm * tstep : cA; const char* nB = has_next ? (const char*)g.Bt + (size_t)nxt.pn * tstep : cB;
        for (int t = 0; t < nt; t += 2) {
            const bool last = (t == nt - 2);
            const char* a1 = cA + (size_t)(t + 1) * kstep;
            const char* a2 = last ? nA : cA + (size_t)(t + 2) * kstep; const char* b2 = last ? nB : cB + (size_t)(t + 2) * kstep;
            const char* a3 = a2 + kstep; const char* b3 = b2 + kstep;
            if (last && has_next) S.a_ready(nxt);
            if constexpr (SP2) {
            PG8_LDB(B0, 0, 0); PG8_LDB(B1, 0, 1); PG8_SCHED; PG8_LDA(At, 0, 0); PG8_STAGE(PG8_SA(1, 1), a1 + hstep, voffA);
            PG8_WAIT_V(8); PG8_WAIT_L(0); PG8_BAR; PG8_MMA(0, 0, At, B0); PG8_MMA(0, 1, At, B1); PG8_BAR; PG8_SCHED;
            PG8_LDA(At, 0, 1); PG8_STAGE(PG8_SB(0, 0), b2, voffB); PG8_STAGE(PG8_SB(0, 1), b2 + hstep, voffB); PG8_STAGE(PG8_SA(0, 0), a2, voffA);
            PG8_WAIT_V(8); PG8_WAIT_L(0); PG8_BAR; PG8_MMA(1, 0, At, B0); PG8_MMA(1, 1, At, B1); PG8_BAR; PG8_SCHED;
            PG8_LDB(B0, 1, 0); PG8_LDB(B1, 1, 1); PG8_SCHED; PG8_LDA(At, 1, 0); PG8_STAGE(PG8_SA(0, 1), a2 + hstep, voffA);
            PG8_WAIT_V(8); PG8_WAIT_L(0); PG8_BAR; PG8_MMA(0, 0, At, B0); PG8_MMA(0, 1, At, B1); PG8_BAR; PG8_SCHED;
            PG8_LDA(At, 1, 1); PG8_STAGE(PG8_SB(1, 0), b3, voffB); PG8_STAGE(PG8_SB(1, 1), b3 + hstep, voffB); PG8_STAGE(PG8_SA(1, 0), a3, voffA);
            PG8_WAIT_V(8); PG8_WAIT_L(0); PG8_BAR; PG8_MMA(1, 0, At, B0); PG8_MMA(1, 1, At, B1); PG8_BAR; PG8_SCHED;
            } else {
            PG8_LDB(B0, 0, 0); PG8_SCHED; PG8_LDA(At, 0, 0); PG8_STAGE(PG8_SA(1, 1), a1 + hstep, voffA);
            PG8_WAIT_L(8); PG8_BAR; PG8_WAIT_L(0); PG8_MMA(0, 0, At, B0); PG8_BAR; PG8_SCHED;
            PG8_LDB(B1, 0, 1); PG8_STAGE(PG8_SB(0, 0), b2, voffB);
            PG8_BAR; PG8_WAIT_L(0); PG8_MMA(0, 1, At, B1); PG8_BAR;
            PG8_LDA(At, 0, 1); PG8_STAGE(PG8_SA(0, 0), a2, voffA);
            PG8_BAR; PG8_WAIT_L(0); PG8_MMA(1, 0, At, B0); PG8_BAR; PG8_SCHED;
            PG8_STAGE(PG8_SB(0, 1), b2 + hstep, voffB);
            PG8_WAIT_V(6); PG8_BAR; PG8_MMA(1, 1, At, B1); PG8_BAR;
            PG8_LDB(B0, 1, 0); PG8_SCHED; PG8_LDA(At, 1, 0); PG8_STAGE(PG8_SA(0, 1), a2 + hstep, voffA);
            PG8_WAIT_L(8); PG8_BAR; PG8_WAIT_L(0); PG8_MMA(0, 0, At, B0); PG8_BAR; PG8_SCHED;
            PG8_LDB(B1, 1, 1); PG8_STAGE(PG8_SB(1, 0), b3, voffB);
            PG8_BAR; PG8_WAIT_L(0); PG8_MMA(0, 1, At, B1); PG8_BAR;
            PG8_LDA(At, 1, 1); PG8_STAGE(PG8_SA(1, 0), a3, voffA);
            PG8_BAR; PG8_WAIT_L(0); PG8_MMA(1, 0, At, B0); PG8_BAR; PG8_SCHED;
            PG8_STAGE(PG8_SB(1, 1), b3 + hstep, voffB);
            PG8_WAIT_V(6); PG8_BAR; PG8_MMA(1, 1, At, B1); PG8_BAR;
            }
        }
        if constexpr (ALIGN_EPI) { if (wr == 0) PG8_BAR; }
        if constexpr (!Epi::AFTER_DRAIN) { E(acc, cur, wr, wc, fr, fq); S.done(cur); }
        if (!has_next) break;
#pragma unroll
        for (int a = 0; a < 2; ++a)
#pragma unroll
            for (int b = 0; b < 2; ++b)
#pragma unroll
                for (int m = 0; m < 4; ++m)
#pragma unroll
                    for (int n = 0; n < 2; ++n) acc[a][b][m][n] = (f32x4){0.f, 0.f, 0.f, 0.f};
        cur = nxt; cA = nA; cB = nB; ++ui;
        if constexpr (ALIGN_EPI) { if (wr == 1) PG8_BAR; }
    }
    PG8_WAIT_V(0);
    if constexpr (!ALIGN_EPI) { if (wr == 0) PG8_BAR; }
    PG8_BAR;
    if constexpr (Epi::AFTER_DRAIN) { E.fused(acc, cur, wr, wc, fr, fq, lds, wid, lane); S.done(cur); }
#undef PG8_SA
#undef PG8_SB
#undef PG8_STAGE
#undef PG8_LDA
#undef PG8_LDB
#undef PG8_MMA
#undef PG8_WAIT_V
#undef PG8_WAIT_L
#undef PG8_BAR
#undef PG8_SCHED
}
}

#define GAS __attribute__((address_space(1)))
#define LAS __attribute__((address_space(3)))
typedef unsigned short bf16;
typedef unsigned u32x4 __attribute__((ext_vector_type(4)));
typedef unsigned u32x2 __attribute__((ext_vector_type(2)));
typedef float f32x4 __attribute__((ext_vector_type(4)));
typedef float f32x2 __attribute__((ext_vector_type(2)));
typedef short bf16x8_t __attribute__((ext_vector_type(8)));

constexpr int NBATCH = 4, SEQ = 2048, TOK = NBATCH * SEQ, DM = 2048, DEPTH = 4;
constexpr int NIN = 16592, NINP = 16640;
constexpr int C_GQKV = 0, C_GZ = 3072, C_GB = 4096, C_GA = 4104, C_RF = 4112, C_RZ = 7376, C_SU = 8400, C_SZ = 9424, C_GATE = 10448;
constexpr int NWAVES = 8, NTHREADS = 512;
constexpr int LDS_BYTES = 147456;
constexpr int PH_PER_LAYER = 6, NPHASES = 2 + DEPTH * PH_PER_LAYER;

constexpr size_t MiB = 1u << 20;
constexpr size_t WS_WIN = 0, WS_WGLU = 260 * MiB, WS_WBR = 268 * MiB, WS_WOUT = 316 * MiB, WS_XN = 348 * MiB, WS_PROJ = 380 * MiB;
constexpr size_t WS_GQ = 640 * MiB, WS_GK = 672 * MiB, WS_GV = 704 * MiB, WS_GEG = 736 * MiB, WS_GBE = 737 * MiB, WS_GSC = 737 * MiB + 512 * 1024, WS_GO = 738 * MiB;
constexpr size_t WS_RR = 770 * MiB, WS_RW = 802 * MiB, WS_RK = 834 * MiB, WS_RV = 866 * MiB, WS_RKK = 898 * MiB, WS_RKA = 930 * MiB, WS_RBON = 962 * MiB, WS_RY = 963 * MiB;
constexpr size_t WS_SY = 995 * MiB, WS_OBR = 1011 * MiB, WS_ACCF = 1059 * MiB, WS_MRG = 1123 * MiB, WS_CTL = 1155 * MiB, WS_LORA = 1156 * MiB, WS_END = 1158 * MiB;
constexpr size_t CTL_SS = 65536, CTL_ZERO_BYTES = CTL_SS + (size_t)DEPTH * TOK * 8;
constexpr int MISC_OFF = 147392;
static_assert((size_t)DEPTH * NINP * DM * 2 == 260 * MiB && (size_t)TOK * NINP * 2 == 260 * MiB, "ws map");

__device__ __forceinline__ unsigned f2bf(float f) { unsigned u = __builtin_bit_cast(unsigned, f); return (u + 0x7fffu + ((u >> 16) & 1u)) >> 16; }
__device__ __forceinline__ unsigned pk2(float lo, float hi) { unsigned r; asm("v_cvt_pk_bf16_f32 %0, %1, %2" : "=v"(r) : "v"(lo), "v"(hi)); return r; }
__device__ __forceinline__ float bflo(unsigned w) { return __builtin_bit_cast(float, w << 16); }
__device__ __forceinline__ float bfhi(unsigned w) { return __builtin_bit_cast(float, w & 0xffff0000u); }
__device__ __forceinline__ float bf1(bf16 h) { return __builtin_bit_cast(float, (unsigned)h << 16); }
__device__ __forceinline__ float sigmoidf_(float x) { return __builtin_amdgcn_rcpf(1.f + __expf(-x)); }
__device__ __forceinline__ float siluf_(float x) { return x * __builtin_amdgcn_rcpf(1.f + __expf(-x)); }
__device__ __forceinline__ float softplusf_(float x) { return x > 20.f ? x : log1pf(expf(x)); }
__device__ __forceinline__ float gelu_tanh(float y) { const float t = 0.7978845608028654f * (y + 0.044715f * y * y * y); const float th = 1.f - 2.f * __builtin_amdgcn_rcpf(1.f + __expf(2.f * t)); return 0.5f * y * (1.f + th); }
template <int CTRL> __device__ __forceinline__ float dppf(float v) { return __builtin_bit_cast(float, __builtin_amdgcn_update_dpp(0, __builtin_bit_cast(int, v), CTRL, 0xF, 0xF, true)); }
__device__ __forceinline__ float allred8(float v) { v += dppf<0xB1>(v); v += dppf<0x4E>(v); v += dppf<0x141>(v); return v; }
__device__ __forceinline__ float allred16(float v) { v = allred8(v); v += dppf<0x140>(v); return v; }
__device__ __forceinline__ float wave_sum(float v) {
#pragma unroll
    for (int o = 1; o < 64; o <<= 1) v += __shfl_xor(v, o);
    return v;
}
__device__ __forceinline__ void unpack8(const u32x4 w, float (&f)[8]) { f[0] = bflo(w.x); f[1] = bfhi(w.x); f[2] = bflo(w.y); f[3] = bfhi(w.y); f[4] = bflo(w.z); f[5] = bfhi(w.z); f[6] = bflo(w.w); f[7] = bfhi(w.w); }
__device__ __forceinline__ u32x4 pack8(const float (&f)[8]) { u32x4 w; w.x = pk2(f[0], f[1]); w.y = pk2(f[2], f[3]); w.z = pk2(f[4], f[5]); w.w = pk2(f[6], f[7]); return w; }

namespace pg8 {
struct EpiGlu {
    static constexpr bool PERM = true, AFTER_DRAIN = false;
    const bf16* Y1; const bf16* PROJ; const float* bias; bf16* O;
    __device__ __forceinline__ void operator()(const f32x4 (&acc)[2][2][4][2], const Unit& u, int wr, int wc, int fr, int fq) const {
        int row0 = u.pm * BM + wr * 64 + fr, col0 = u.pn * BM + wc * 32 + 8 * fq;
        asm volatile("" : "+v"(row0), "+v"(col0));
        f32x4 bb[2][2];
#pragma unroll
        for (int bj = 0; bj < 2; ++bj) { bb[bj][0] = *(const f32x4*)(bias + col0 + bj * HALF); bb[bj][1] = *(const f32x4*)(bias + col0 + bj * HALF + 4); }
        u32x4 yc = *(const u32x4*)(Y1 + (size_t)row0 * 1024 + col0), zc = *(const u32x4*)(PROJ + (size_t)row0 * NINP + C_SZ + col0);
#pragma unroll
        for (int it = 0; it < 16; ++it) {
            const int bj = it >> 3, ai = (it >> 2) & 1, m = it & 3;
            const size_t row = (size_t)(row0 + ai * HALF + m * 16); const int col = col0 + bj * HALF;
            u32x4 yn = yc, zn = zc;
            if (it + 1 < 16) { const int nb = (it + 1) >> 3, na = ((it + 1) >> 2) & 1, nm = (it + 1) & 3; const size_t nrow = (size_t)(row0 + na * HALF + nm * 16); const int ncol = col0 + nb * HALF;
                yn = *(const u32x4*)(Y1 + nrow * 1024 + ncol); zn = *(const u32x4*)(PROJ + nrow * NINP + C_SZ + ncol); }
            float y[8], z[8], o[8]; unpack8(yc, y); unpack8(zc, z);
            const f32x4 v0 = acc[ai][bj][m][0] + bb[bj][0], v1 = acc[ai][bj][m][1] + bb[bj][1];
            const float a[8] = {v0[0], v0[1], v0[2], v0[3], v1[0], v1[1], v1[2], v1[3]};
#pragma unroll
            for (int e = 0; e < 8; ++e) o[e] = y[e] * sigmoidf_(a[e]) * siluf_(z[e]);
            *(u32x4*)(O + row * 1024 + col) = pack8(o);
            yc = yn; zc = zn;
            asm volatile("" ::: "memory");
        }
    }
};
struct EpiBranch {
    static constexpr bool PERM = true, AFTER_DRAIN = false;
    const bf16* PROJ; const float* gate_b; bf16* ACC; bf16* MRG;
    __device__ __forceinline__ void operator()(const f32x4 (&acc)[2][2][4][2], const Unit& u, int wr, int wc, int fr, int fq) const {
        const int br = u.pm >> 5, pm = u.pm & 31, pn = u.pn & 7;
        int row0 = pm * BM + wr * 64 + fr, col0 = pn * BM + wc * 32 + 8 * fq;
        asm volatile("" : "+v"(row0), "+v"(col0));
        bf16* dst = br < 2 ? ACC : MRG;
        const bf16* gl = PROJ + C_GATE + br * DM;
        f32x4 gb[2][2];
#pragma unroll
        for (int bj = 0; bj < 2; ++bj) { gb[bj][0] = *(const f32x4*)(gate_b + br * DM + col0 + bj * HALF); gb[bj][1] = *(const f32x4*)(gate_b + br * DM + col0 + bj * HALF + 4); }
        const u32x4 zero = {0u, 0u, 0u, 0u};
        u32x4 lc = *(const u32x4*)(gl + (size_t)row0 * NINP + col0), pc = br > 0 ? *(const u32x4*)(ACC + (size_t)row0 * DM + col0) : zero;
#pragma unroll
        for (int it = 0; it < 16; ++it) {
            const int bj = it >> 3, ai = (it >> 2) & 1, m = it & 3;
            const size_t row = (size_t)(row0 + ai * HALF + m * 16); const int col = col0 + bj * HALF;
            u32x4 ln = lc, pn_ = pc;
            if (it + 1 < 16) { const int nb = (it + 1) >> 3, na = ((it + 1) >> 2) & 1, nm = (it + 1) & 3; const size_t nrow = (size_t)(row0 + na * HALF + nm * 16); const int ncol = col0 + nb * HALF;
                ln = *(const u32x4*)(gl + nrow * NINP + ncol); pn_ = br > 0 ? *(const u32x4*)(ACC + nrow * DM + ncol) : zero; }
            float g[8], p[8], o[8]; unpack8(lc, g); unpack8(pc, p);
            const f32x4 v0 = acc[ai][bj][m][0], v1 = acc[ai][bj][m][1];
            const float a[8] = {v0[0], v0[1], v0[2], v0[3], v1[0], v1[1], v1[2], v1[3]};
            const float gbv[8] = {gb[bj][0][0], gb[bj][0][1], gb[bj][0][2], gb[bj][0][3], gb[bj][1][0], gb[bj][1][1], gb[bj][1][2], gb[bj][1][3]};
#pragma unroll
            for (int e = 0; e < 8; ++e) o[e] = sigmoidf_(g[e] + gbv[e]) * a[e] + p[e];
            *(u32x4*)(dst + row * DM + col) = pack8(o);
            lc = ln; pc = pn_;
            asm volatile("" ::: "memory");
        }
    }
};
struct EpiResid {
    static constexpr bool PERM = true, AFTER_DRAIN = false;
    const float* base; float* out; bf16* xn; const float* nw; unsigned long long* ss;
    __device__ __forceinline__ void operator()(const f32x4 (&acc)[2][2][4][2], const Unit& u, int wr, int wc, int fr, int fq) const {
        int row0 = u.pm * BM + wr * 64 + fr, col0 = u.pn * BM + wc * 32 + 8 * fq;
        asm volatile("" : "+v"(row0), "+v"(col0));
        f32x4 ww[2][2];
#pragma unroll
        for (int bj = 0; bj < 2; ++bj) { ww[bj][0] = *(const f32x4*)(nw + col0 + bj * HALF); ww[bj][1] = *(const f32x4*)(nw + col0 + bj * HALF + 4); }
        f32x4 bc[2][2];
#pragma unroll
        for (int bj = 0; bj < 2; ++bj) { const size_t off = (size_t)row0 * DM + col0 + bj * HALF; bc[bj][0] = *(const f32x4*)(base + off); bc[bj][1] = *(const f32x4*)(base + off + 4); }
#pragma unroll
        for (int it = 0; it < 8; ++it) {
            const int ai = it >> 2, m = it & 3; const int row = row0 + ai * HALF + m * 16;
            f32x4 bn[2][2];
#pragma unroll
            for (int bj = 0; bj < 2; ++bj) { bn[bj][0] = bc[bj][0]; bn[bj][1] = bc[bj][1]; }
            if (it + 1 < 8) { const int nrow = row0 + ((it + 1) >> 2) * HALF + ((it + 1) & 3) * 16;
#pragma unroll
                for (int bj = 0; bj < 2; ++bj) { const size_t off = (size_t)nrow * DM + col0 + bj * HALF; bn[bj][0] = *(const f32x4*)(base + off); bn[bj][1] = *(const f32x4*)(base + off + 4); } }
            float sq = 0.f;
#pragma unroll
            for (int bj = 0; bj < 2; ++bj) {
                const size_t off = (size_t)row * DM + col0 + bj * HALF;
                const f32x4 o0 = bc[bj][0] + acc[ai][bj][m][0], o1 = bc[bj][1] + acc[ai][bj][m][1];
                *(f32x4*)(out + off) = o0; *(f32x4*)(out + off + 4) = o1;
                if (xn) { const f32x4 w0 = ww[bj][0], w1 = ww[bj][1];
                    sq += (o0.x * o0.x + o0.y * o0.y) + (o0.z * o0.z + o0.w * o0.w) + (o1.x * o1.x + o1.y * o1.y) + (o1.z * o1.z + o1.w * o1.w);
                    u32x4 p; p.x = pk2(o0.x * w0.x, o0.y * w0.y); p.y = pk2(o0.z * w0.z, o0.w * w0.w); p.z = pk2(o1.x * w1.x, o1.y * w1.y); p.w = pk2(o1.z * w1.z, o1.w * w1.w);
                    *(u32x4*)(xn + off) = p; }
            }
            if (xn) { sq += __shfl_xor(sq, 16); sq += __shfl_xor(sq, 32); if (fq == 0) atomicAdd(ss + row, (unsigned long long)(sq * 65536.f + 0.5f)); }
#pragma unroll
            for (int bj = 0; bj < 2; ++bj) { bc[bj][0] = bn[bj][0]; bc[bj][1] = bn[bj][1]; }
            asm volatile("" ::: "memory");
        }
    }
};
struct EpiBf16Rs {
    static constexpr bool PERM = true, AFTER_DRAIN = false;
    bf16* O; int ldc; const unsigned long long* ss;
    __device__ __forceinline__ void operator()(const f32x4 (&acc)[2][2][4][2], const Unit& u, int wr, int wc, int fr, int fq) const {
        int row0 = u.pm * BM + wr * 64 + fr, col0 = u.pn * BM + wc * 32 + 8 * fq;
        asm volatile("" : "+v"(row0), "+v"(col0));
#pragma unroll
        for (int ai = 0; ai < 2; ++ai)
#pragma unroll
            for (int m = 0; m < 4; ++m) { const int row = row0 + ai * HALF + m * 16; const float rs = 1.f / sqrtf((float)ss[row] * (1.f / (65536.f * DM)) + 1e-6f);
                bf16* rowp = O + (size_t)row * ldc + col0;
#pragma unroll
                for (int bj = 0; bj < 2; ++bj) { const f32x4 v0 = acc[ai][bj][m][0] * rs, v1 = acc[ai][bj][m][1] * rs;
                    u32x4 w; w.x = cvt_pk_bf16(v0[0], v0[1]); w.y = cvt_pk_bf16(v0[2], v0[3]); w.z = cvt_pk_bf16(v1[0], v1[1]); w.w = cvt_pk_bf16(v1[2], v1[3]);
                    *(u32x4*)(rowp + bj * HALF) = w; } }
    }
};
struct BranchOrder {
    StaticOrder base;
    __device__ bool next(int i, Unit& u) const { Unit t; const int r = i / 3, br = i - 3 * r; if (!base.next(r, t)) return false; u.pm = br * 32 + t.pm; u.pn = br * 8 + t.pn; return true; }
    __device__ __forceinline__ void a_ready(const Unit&) const {}
    __device__ __forceinline__ void done(const Unit&) const {}
};
}

#define XB_TMO      128
#define XB_XCNT(j)  (256  + 64 * (j))
#define XB_XSUB(j)  (1280 + 64 * (j))
#define XB_XGEN(j)  (2304 + 64 * (j))
#define XB_TOP      3328
#define XB_TOPGEN   3392
#define XCD_BAR_WORDS 3456
#define XB_SPIN_CAP (1u << 18)

__device__ __forceinline__ unsigned xb_ld(unsigned* p)              { return __hip_atomic_load(p, __ATOMIC_RELAXED, __HIP_MEMORY_SCOPE_AGENT); }
__device__ __forceinline__ unsigned xb_add(unsigned* p, unsigned v) { return __hip_atomic_fetch_add(p, v, __ATOMIC_RELAXED, __HIP_MEMORY_SCOPE_AGENT); }
__device__ __forceinline__ unsigned xb_xcc_id() { return (unsigned)__builtin_amdgcn_s_getreg((3 << 11) | 20) & 0xFu; }
#define XB_SPIN(cond, bar) do { unsigned _sp = 0; while (cond) { __builtin_amdgcn_s_sleep(1); \
    if ((++_sp & 255u) == 0u) { if (xb_ld(&(bar)[XB_TMO])) break; if (_sp > XB_SPIN_CAP) { atomicAdd(&(bar)[XB_TMO], 1u); break; } } } } while (0)

struct XcdBarrier {
    unsigned* bar; unsigned x;
    volatile LAS unsigned* st;
};

__device__ __forceinline__ XcdBarrier xcd_barrier_post(unsigned* bar, volatile LAS unsigned* st) {
    XcdBarrier b; b.bar = bar; b.x = xb_xcc_id(); b.st = st;
    if (threadIdx.x == 0) (void)xb_add(&bar[XB_XCNT(b.x)], 1u);
    return b;
}
__device__ __forceinline__ void xcd_barrier_complete(unsigned* bar, unsigned x, unsigned& nloc, unsigned& nx) {
    const unsigned G = gridDim.x * gridDim.y * gridDim.z;
    unsigned sum, cnt, mine, sp = 0u;
    for (;;) {
        sum = 0u; cnt = 0u; mine = 0u;
#pragma unroll
        for (unsigned j = 0; j < 16; ++j) { const unsigned c = xb_ld(&bar[XB_XCNT(j)]); sum += c; cnt += (c > 0u) ? 1u : 0u; mine = (j == x) ? c : mine; }
        if (sum == G) break;
        __builtin_amdgcn_s_sleep(1);
        if ((++sp & 255u) == 0u) { if (xb_ld(&bar[XB_TMO])) break; if (sp > XB_SPIN_CAP) { atomicAdd(&bar[XB_TMO], 1u); break; } }
    }
    nloc = mine > 0u ? mine : 1u; nx = cnt > 0u ? cnt : 1u;
}

__device__ __forceinline__ void xcd_barrier(const XcdBarrier& b) {
    asm volatile("s_waitcnt vmcnt(0)" ::: "memory");
    __syncthreads();
    if (threadIdx.x == 0) {
        unsigned* bar = b.bar;
        __builtin_amdgcn_s_waitcnt(0);
        unsigned nloc = b.st[0], nx = b.st[1];
        if (nloc == 0u) { xcd_barrier_complete(bar, b.x, nloc, nx); b.st[0] = nloc; b.st[1] = nx; }
        const unsigned old = xb_add(&bar[XB_XSUB(b.x)], 1u);
        const unsigned gen = old / nloc;
        if (old + 1u == (gen + 1u) * nloc) {
            __builtin_amdgcn_fence(__ATOMIC_RELEASE, "agent");
            asm volatile("s_waitcnt vmcnt(0)" ::: "memory");
            const unsigned og = xb_add(&bar[XB_TOP], 1u);
            const unsigned tg = og / nx;
            if (og + 1u == (tg + 1u) * nx) xb_add(&bar[XB_TOPGEN], 1u);
            else XB_SPIN(xb_ld(&bar[XB_TOPGEN]) == tg, bar);
            __builtin_amdgcn_fence(__ATOMIC_ACQUIRE, "agent");
            xb_add(&bar[XB_XGEN(b.x)], 1u);
            asm volatile("s_waitcnt vmcnt(0)" ::: "memory");
        } else {
            XB_SPIN(xb_ld(&bar[XB_XGEN(b.x)]) == gen, bar);
            __builtin_amdgcn_fence(__ATOMIC_ACQUIRE, "agent");
            asm volatile("s_waitcnt vmcnt(0)" ::: "memory");
        }
    }
    __syncthreads();
}

struct Args { const float* in[31]; float* out; unsigned char* ws; int ph_lo, ph_hi; };
struct Ctx { int tid, lane, wave, vcu, G, gw, NGW; LAS unsigned char* lds; unsigned char* ws; };

__device__ __forceinline__ void transpose_item(const float* W, int K, int N, bf16* WT, LAS float* scr, int kb, int nb, int lane) {
    const int k0 = 64 * kb, n0 = 64 * nb, nq = 4 * (lane & 15), kr = lane >> 4; const bool nv = n0 + nq < N;
    f32x4 v[16];
#pragma unroll
    for (int i = 0; i < 16; ++i) v[i] = nv ? *(const f32x4*)(W + (size_t)(k0 + 4 * i + kr) * N + n0 + nq) : (f32x4){0.f, 0.f, 0.f, 0.f};
#pragma unroll
    for (int i = 0; i < 16; ++i) { LAS float* d = scr + (4 * i + kr) * 65 + nq; d[0] = v[i].x; d[1] = v[i].y; d[2] = v[i].z; d[3] = v[i].w; }
    asm volatile("s_waitcnt lgkmcnt(0)" ::: "memory");
    const int c = lane & 7;
#pragma unroll
    for (int j = 0; j < 8; ++j) { const int nn = (lane >> 3) + 8 * j; const LAS float* s = scr + (8 * c) * 65 + nn;
        u32x4 o; o.x = pk2(s[0 * 65], s[1 * 65]); o.y = pk2(s[2 * 65], s[3 * 65]); o.z = pk2(s[4 * 65], s[5 * 65]); o.w = pk2(s[6 * 65], s[7 * 65]);
        *(u32x4*)(WT + (size_t)(n0 + nn) * K + k0 + 8 * c) = o; }
    asm volatile("s_waitcnt lgkmcnt(0)" ::: "memory");
}

__device__ __forceinline__ void rms_row(const float* xrow, const float* w, bf16* obf, unsigned long long* ss, float* of32, int lane) {
    f32x4 v[8]; float s = 0.f;
#pragma unroll
    for (int j = 0; j < 8; ++j) { v[j] = *(const f32x4*)(xrow + 4 * lane + 256 * j); s += (v[j].x * v[j].x + v[j].y * v[j].y) + (v[j].z * v[j].z + v[j].w * v[j].w); }
    s = wave_sum(s);
    const float r = obf ? 1.f : 1.f / sqrtf(s * (1.f / DM) + 1e-6f);
#pragma unroll
    for (int j = 0; j < 8; ++j) { const f32x4 ww = *(const f32x4*)(w + 4 * lane + 256 * j); const f32x4 o = v[j] * r * ww;
        if (obf) { u32x2 p; p.x = pk2(o.x, o.y); p.y = pk2(o.z, o.w); *(u32x2*)(obf + 4 * lane + 256 * j) = p; }
        else *(f32x4*)(of32 + 4 * lane + 256 * j) = o; }
    if (obf && lane == 0) *ss = (unsigned long long)(s * 65536.f + 0.5f);
}

__device__ __forceinline__ void convert_layer(const Ctx& F, const Args& a, int l, int gw, int ngw) {
    LAS float* scr = (LAS float*)(F.lds + F.wave * 16640);
    constexpr int I_IN = 32 * 260, I_GLU = 16 * 16, I_BR = 16 * 32, I_OUT = 32 * 32, IL = I_IN + I_GLU + 3 * I_BR + I_OUT;
    bf16* WIN = (bf16*)(F.ws + WS_WIN); bf16* WGLU = (bf16*)(F.ws + WS_WGLU); bf16* WBR = (bf16*)(F.ws + WS_WBR); bf16* WOUT = (bf16*)(F.ws + WS_WOUT);
    for (int it = gw; it < IL; it += ngw) {
        int r = it;
        if (r < I_IN) { transpose_item(a.in[2] + (size_t)l * DM * NIN, DM, NIN, WIN + (size_t)l * NINP * DM, scr, r / 260, r % 260, F.lane); continue; } r -= I_IN;
        if (r < I_GLU) { transpose_item(a.in[25] + (size_t)l * 1024 * 1024, 1024, 1024, WGLU + (size_t)l * 1024 * 1024, scr, r / 16, r % 16, F.lane); continue; } r -= I_GLU;
        if (r < 3 * I_BR) { const int br = r / I_BR, r2 = r - br * I_BR;
            transpose_item(a.in[28] + (size_t)(l * 3 + br) * 1024 * DM, 1024, DM, WBR + (size_t)(l * 3 + br) * DM * 1024, scr, r2 / 32, r2 % 32, F.lane); continue; } r -= 3 * I_BR;
        transpose_item(a.in[29] + (size_t)l * DM * DM, DM, DM, WOUT + (size_t)l * DM * DM, scr, r / 32, r % 32, F.lane);
    }
}

__device__ __forceinline__ void phase0(const Ctx& F, const Args& a) {
    convert_layer(F, a, 0, F.gw, F.NGW);
    {
        bf16* LT = (bf16*)(F.ws + WS_LORA);
        for (int it = F.gw * 64 + F.lane; it < DEPTH * 2 * 1024 * 12; it += F.NGW * 64) {
            const int kg = it % 12, n = (it / 12) & 1023, lw = it / (12 * 1024), l = lw >> 1, which = lw & 1;
            const float* src = (which ? a.in[11] : a.in[9]) + (size_t)l * 96 * 1024 + (size_t)(8 * kg) * 1024 + n;
            u32x4 o; o.x = pk2(src[0], src[1024]); o.y = pk2(src[2048], src[3072]); o.z = pk2(src[4096], src[5120]); o.w = pk2(src[6144], src[7168]);
            *(u32x4*)(LT + ((size_t)lw * 1024 + n) * 96 + 8 * kg) = o;
        }
    }
    bf16* XN = (bf16*)(F.ws + WS_XN);
    unsigned long long* SS0 = (unsigned long long*)(F.ws + WS_CTL + CTL_SS);
    for (int m = F.gw; m < TOK; m += F.NGW) rms_row(a.in[0] + (size_t)m * DM, a.in[1], XN + (size_t)m * DM, SS0 + m, nullptr, F.lane);
}

__device__ __forceinline__ void prep_gdn(const Ctx& F, const Args& a, int l) {
    const bf16* PROJ = (const bf16*)(F.ws + WS_PROJ);
    float* GQ = (float*)(F.ws + WS_GQ); float* GK = (float*)(F.ws + WS_GK); float* GV = (float*)(F.ws + WS_GV); float* GEG = (float*)(F.ws + WS_GEG); float* GBE = (float*)(F.ws + WS_GBE); f32x4* GSC = (f32x4*)(F.ws + WS_GSC);
    const float* cw = a.in[3] + (size_t)l * 4 * 3072;
    for (int it = F.gw; it < 2048; it += F.NGW) {
        const int h = it & 7, ch = (it >> 3) & 63, b = it >> 9;
        const int t0 = ch * 32; const int c = 2 * F.lane;
        float w[3][4][2], hist[3][3][2];
#pragma unroll
        for (int p = 0; p < 3; ++p)
#pragma unroll
            for (int j = 0; j < 4; ++j) { const f32x2 ww = *(const f32x2*)(cw + j * 3072 + p * 1024 + h * 128 + c); w[p][j][0] = ww.x; w[p][j][1] = ww.y; }
#pragma unroll
        for (int p = 0; p < 3; ++p)
#pragma unroll
            for (int j = 0; j < 3; ++j) { const int t = t0 - 3 + j; unsigned x = 0u;
                if (t >= 0) x = *(const unsigned*)(PROJ + (size_t)(b * SEQ + t) * NINP + C_GQKV + p * 1024 + h * 128 + c);
                hist[p][j][0] = bflo(x); hist[p][j][1] = bfhi(x); }
        const float alog = a.in[4][l * 8 + h], dtb = a.in[5][l * 8 + h]; const float aexp = expf(alog);
        float kp0 = 0.f, kp1 = 0.f, qkprev = 0.f;
        unsigned raw[3][32];
#pragma unroll
        for (int tt = 0; tt < 32; ++tt)
#pragma unroll
            for (int p = 0; p < 3; ++p) raw[p][tt] = *(const unsigned*)(PROJ + (size_t)(b * SEQ + t0 + tt) * NINP + C_GQKV + p * 1024 + h * 128 + c);
#pragma unroll
        for (int tt = 0; tt < 32; ++tt) {
            const size_t tok = (size_t)(b * SEQ + t0 + tt);
            float o[3][2];
#pragma unroll
            for (int p = 0; p < 3; ++p) {
                const unsigned x = raw[p][tt];
                const float x0 = bflo(x), x1 = bfhi(x);
                const float y0 = w[p][0][0] * hist[p][0][0] + w[p][1][0] * hist[p][1][0] + w[p][2][0] * hist[p][2][0] + w[p][3][0] * x0;
                const float y1 = w[p][0][1] * hist[p][0][1] + w[p][1][1] * hist[p][1][1] + w[p][2][1] * hist[p][2][1] + w[p][3][1] * x1;
                hist[p][0][0] = hist[p][1][0]; hist[p][1][0] = hist[p][2][0]; hist[p][2][0] = x0;
                hist[p][0][1] = hist[p][1][1]; hist[p][1][1] = hist[p][2][1]; hist[p][2][1] = x1;
                o[p][0] = siluf_(y0); o[p][1] = siluf_(y1);
            }
            const float sq = wave_sum(o[0][0] * o[0][0] + o[0][1] * o[0][1]), sk = wave_sum(o[1][0] * o[1][0] + o[1][1] * o[1][1]);
            const float rq = 0.08838834764831845f * rsqrtf(sq + 1e-6f), rk = rsqrtf(sk + 1e-6f);
            const size_t off = tok * 1024 + h * 128 + c;
            const unsigned qp = pk2(o[0][0] * rq, o[0][1] * rq), kp = pk2(o[1][0] * rk, o[1][1] * rk);
            *(unsigned*)((bf16*)GQ + off) = qp;
            *(unsigned*)((bf16*)GK + off) = kp;
            *(unsigned*)((bf16*)GV + off) = pk2(o[2][0], o[2][1]);
            {
                const float qn0 = bflo(qp), qn1 = bfhi(qp), kn0 = bflo(kp), kn1 = bfhi(kp);
                const float qk = wave_sum(qn0 * kn0 + qn1 * kn1);
                if (tt & 1) { const float kk = wave_sum(kp0 * kn0 + kp1 * kn1), qkp = wave_sum(qn0 * kp0 + qn1 * kp1);
                    if (F.lane == 0) GSC[(tok >> 1) * 8 + h] = (f32x4){kk, qkprev, qkp, qk}; }
                else { kp0 = kn0; kp1 = kn1; qkprev = qk; }
            }
            if (F.lane == 0) {
                const float bl = bf1(PROJ[tok * NINP + C_GB + h]), al = bf1(PROJ[tok * NINP + C_GA + h]);
                GBE[tok * 8 + h] = sigmoidf_(bl);
                GEG[tok * 8 + h] = expf(-aexp * softplusf_(al + dtb));
            }
        }
    }
}

__device__ __forceinline__ float mix2(unsigned c, unsigned p, float mu0, float mu1, float& o1) {
    const float c0 = bflo(c), c1 = bfhi(c), p0 = bflo(p), p1 = bfhi(p);
    o1 = c1 + (p1 - c1) * mu1; return c0 + (p0 - c0) * mu0;
}
__device__ __forceinline__ void prep_rwkv(const Ctx& F, const Args& a, int l) {
    const bf16* PROJ = (const bf16*)(F.ws + WS_PROJ);
    float* RR = (float*)(F.ws + WS_RR); float* RW = (float*)(F.ws + WS_RW); float* RK = (float*)(F.ws + WS_RK); float* RV = (float*)(F.ws + WS_RV);
    float* RKK = (float*)(F.ws + WS_RKK); float* RKA = (float*)(F.ws + WS_RKA); float* RBON = (float*)(F.ws + WS_RBON);
    const float* mu = a.in[7] + (size_t)l * 3264; const float* w0 = a.in[8] + l * 1024; const float* wup = a.in[9] + (size_t)l * 96 * 1024;
    const float* a0 = a.in[10] + l * 1024; const float* aup = a.in[11] + (size_t)l * 96 * 1024; const float* kk_ = a.in[12] + l * 1024; const float* ka_ = a.in[13] + l * 1024; const float* rk_ = a.in[14] + l * 1024;
    constexpr int AROW = 104;
    LAS bf16* A1 = (LAS bf16*)F.lds; LAS bf16* A2 = A1 + 16 * AROW;
    LAS float* LW = (LAS float*)(F.lds + 8192); LAS float* LA = LW + 16 * 1024;
    const bf16* LTw = (const bf16*)(F.ws + WS_LORA) + (size_t)(2 * l) * 1024 * 96; const bf16* LTa = LTw + 1024 * 96;
    const int j = F.tid, c = 2 * j;
    const f32x2 mur = *(const f32x2*)(mu + c), muk = *(const f32x2*)(mu + 1024 + c), muv = *(const f32x2*)(mu + 2048 + c);
    const f32x2 w0v = *(const f32x2*)(w0 + c), a0v = *(const f32x2*)(a0 + c), kkv = *(const f32x2*)(kk_ + c), kav = *(const f32x2*)(ka_ + c), rkv = *(const f32x2*)(rk_ + c);
    for (int tile = F.vcu; tile < TOK / 16; tile += F.G) {
        __syncthreads();
        for (int e = F.tid; e < 16 * 192; e += NTHREADS) {
            const int tl = e / 192, i = e - tl * 192; const size_t tok = (size_t)tile * 16 + tl;
            const float cur = bf1(PROJ[tok * NINP + C_RF + 3072 + i]);
            const float prv = (tok & (SEQ - 1)) ? bf1(PROJ[(tok - 1) * NINP + C_RF + 3072 + i]) : 0.f;
            const float m = cur + (prv - cur) * mu[3072 + i];
            if (i < 96) A1[tl * AROW + i] = (bf16)f2bf(tanhf(m)); else A2[tl * AROW + i - 96] = (bf16)f2bf(m);
        }
        __syncthreads();
        {
            const int row = F.lane & 15, quad = F.lane >> 4;
            bf16x8_t fw[3], fa[3];
#pragma unroll
            for (int ks = 0; ks < 3; ++ks) { fw[ks] = *(const LAS bf16x8_t*)(A1 + row * AROW + 32 * ks + 8 * quad); fa[ks] = *(const LAS bf16x8_t*)(A2 + row * AROW + 32 * ks + 8 * quad); }
#pragma unroll 2
            for (int nt = 0; nt < 8; ++nt) {
                const int n = 128 * F.wave + 16 * nt + row;
                f32x4 aw = {0.f, 0.f, 0.f, 0.f}, aa = {0.f, 0.f, 0.f, 0.f};
#pragma unroll
                for (int ks = 0; ks < 3; ++ks) {
                    const bf16x8_t bw = *(const bf16x8_t*)(LTw + (size_t)n * 96 + 32 * ks + 8 * quad), ba = *(const bf16x8_t*)(LTa + (size_t)n * 96 + 32 * ks + 8 * quad);
                    aw = __builtin_amdgcn_mfma_f32_16x16x32_bf16(fw[ks], bw, aw, 0, 0, 0); aa = __builtin_amdgcn_mfma_f32_16x16x32_bf16(fa[ks], ba, aa, 0, 0, 0);
                    asm volatile("" :: "v"(bw), "v"(ba));
                }
#pragma unroll
                for (int r = 0; r < 4; ++r) { LW[(4 * quad + r) * 1024 + n] = aw[r]; LA[(4 * quad + r) * 1024 + n] = aa[r]; }
            }
        }
        __syncthreads();
        unsigned rw[17][3];
#pragma unroll
        for (int tl = 0; tl < 17; ++tl) { const size_t tok = (size_t)tile * 16 + tl - 1; const bool ok = tl > 0 || ((tok + 1) & (SEQ - 1)) != 0;
            const bf16* cp = PROJ + tok * NINP + C_RF + c;
#pragma unroll
            for (int q = 0; q < 3; ++q) rw[tl][q] = ok ? *(const unsigned*)(cp + 1024 * q) : 0u; }
#pragma unroll
        for (int tl = 0; tl < 16; ++tl) {
            const size_t tok = (size_t)tile * 16 + tl; const bool hp = (tok & (SEQ - 1)) != 0;
            const unsigned cr = rw[tl + 1][0], ck = rw[tl + 1][1], cv = rw[tl + 1][2];
            const unsigned pr = hp ? rw[tl][0] : 0u, pk = hp ? rw[tl][1] : 0u, pv = hp ? rw[tl][2] : 0u;
            float r1, k1, v1; const float r0 = mix2(cr, pr, mur.x, mur.y, r1), k0 = mix2(ck, pk, muk.x, muk.y, k1), v0 = mix2(cv, pv, muv.x, muv.y, v1);
            const f32x2 lw = *(const LAS f32x2*)(LW + tl * 1024 + c), la = *(const LAS f32x2*)(LA + tl * 1024 + c);
            const float wp0 = w0v.x + lw.x, wp1 = w0v.y + lw.y;
            const float d0 = __expf(-0.6065306597126334f * sigmoidf_(wp0)), d1 = __expf(-0.6065306597126334f * sigmoidf_(wp1));
            const float aa0 = sigmoidf_(a0v.x + la.x), aa1 = sigmoidf_(a0v.y + la.y);
            const float q0 = k0 * kkv.x, q1 = k1 * kkv.y;
            float ss = q0 * q0 + q1 * q1;
#pragma unroll
            for (int o = 1; o < 32; o <<= 1) ss += __shfl_xor(ss, o);
            const float rn = rsqrtf(ss + 1e-6f); const float n0 = q0 * rn, n1 = q1 * rn;
            const float km0 = k0 * (1.f + (aa0 - 1.f) * kav.x), km1 = k1 * (1.f + (aa1 - 1.f) * kav.y);
            float bo = r0 * km0 * rkv.x + r1 * km1 * rkv.y;
#pragma unroll
            for (int o = 1; o < 32; o <<= 1) bo += __shfl_xor(bo, o);
            const size_t off = tok * 1024 + c;
            *(unsigned*)((bf16*)RR + off) = pk2(r0, r1); *(f32x2*)(RW + off) = (f32x2){d0, d1}; *(unsigned*)((bf16*)RK + off) = pk2(km0, km1); *(unsigned*)((bf16*)RV + off) = pk2(v0, v1);
            *(f32x2*)(RKK + off) = (f32x2){-n0, -n1}; *(unsigned*)((bf16*)RKA + off) = pk2(n0 * aa0, n1 * aa1);
            if ((F.lane & 31) == 0) RBON[tok * 16 + (c >> 6)] = bo;
        }
    }
}

#ifndef SCM
#define SCM 7
#endif
#ifndef REPM
#define REPM 0
#endif
constexpr int CH = 32;
#define WFENCE() do { __builtin_amdgcn_fence(__ATOMIC_RELEASE, "wavefront"); asm volatile("s_waitcnt lgkmcnt(0)" ::: "memory"); __builtin_amdgcn_wave_barrier(); __builtin_amdgcn_fence(__ATOMIC_ACQUIRE, "wavefront"); } while (0)

struct GPair { f32x4 k1a, k1b, k2a, k2b, q1a, q1b, q2a, q2b, eb, sc; float v1, v2; };
constexpr int G_BUF = 2 * CH * 128 + CH * 32 + 4 * CH;
__device__ __forceinline__ void gdn_lds(GPair& s, const LAS float* buf, int pr, int rg, int colL) {
    const LAS float* kp = buf + 2 * pr * 128 + rg * 4; const LAS float* qp = kp + CH * 128;
    s.k1a = *(const LAS f32x4*)kp; s.k1b = *(const LAS f32x4*)(kp + 64); s.k2a = *(const LAS f32x4*)(kp + 128); s.k2b = *(const LAS f32x4*)(kp + 192);
    s.q1a = *(const LAS f32x4*)qp; s.q1b = *(const LAS f32x4*)(qp + 64); s.q2a = *(const LAS f32x4*)(qp + 128); s.q2b = *(const LAS f32x4*)(qp + 192);
    s.v1 = buf[2 * CH * 128 + 2 * pr * 32 + colL]; s.v2 = buf[2 * CH * 128 + (2 * pr + 1) * 32 + colL];
    s.eb = *(const LAS f32x4*)(buf + 2 * CH * 128 + CH * 32 + 4 * pr); s.sc = *(const LAS f32x4*)(buf + 2 * CH * 128 + CH * 32 + 2 * CH + 4 * pr);
}
__device__ __forceinline__ float dot8(const f32x4 a, const f32x4 b, const f32x2 (&S)[4]) { const f32x2 t = (a.xy * S[0] + a.zw * S[1]) + (b.xy * S[2] + b.zw * S[3]); return t.x + t.y; }
#define DPP4(CTRL) do { d1 += dppf<CTRL>(d1); d2 += dppf<CTRL>(d2); e1 += dppf<CTRL>(e1); e2 += dppf<CTRL>(e2); } while (0)
__device__ __forceinline__ void gdn_pair(const GPair& s, f32x2 (&S)[4], LAS float* ob, bool wr) {
    float d1 = dot8(s.k1a, s.k1b, S), d2 = dot8(s.k2a, s.k2b, S), e1 = dot8(s.q1a, s.q1b, S), e2 = dot8(s.q2a, s.q2b, S);
    DPP4(0xB1); DPP4(0x4E); DPP4(0x141); DPP4(0x140);
    const float g1 = s.eb.x, b1 = s.eb.y, g2 = s.eb.z, b2 = s.eb.w;
    const float c1 = b1 * (s.v1 - g1 * d1);
    const float c2 = b2 * (s.v2 - g2 * (g1 * d2 + c1 * s.sc.x));
    const float o1 = g1 * e1 + c1 * s.sc.y;
    const float o2 = g2 * (g1 * e2 + c1 * s.sc.z) + c2 * s.sc.w;
    const float gg = g1 * g2, f1 = g2 * c1;
    S[0] = S[0] * gg + s.k1a.xy * f1 + s.k2a.xy * c2; S[1] = S[1] * gg + s.k1a.zw * f1 + s.k2a.zw * c2;
    S[2] = S[2] * gg + s.k1b.xy * f1 + s.k2b.xy * c2; S[3] = S[3] * gg + s.k1b.zw * f1 + s.k2b.zw * c2;
    if (wr) { ob[0] = o1; ob[32] = o2; }
}
#undef DPP4
struct GStage { u32x4 k, q, v; f32x4 sc; float e; };
__device__ __forceinline__ void gdn_gload(GStage& g, const bf16* GK, const bf16* GQ, const bf16* GV, const float* GEG, const float* GBE, const f32x4* GSC, int t0, int tid) {
    { const int st = tid >> 4, f8 = tid & 15; g.k = *(const u32x4*)(GK + (size_t)(t0 + st) * 1024 + 8 * f8); g.q = *(const u32x4*)(GQ + (size_t)(t0 + st) * 1024 + 8 * f8); }
    { const int i = tid & 127; g.v = *(const u32x4*)(GV + (size_t)(t0 + (i >> 2)) * 1024 + 8 * (i & 3)); }
    { const int i = tid & 63; const float* p = (i < 32 ? GEG : GBE); g.e = p[(size_t)(t0 + (i & 31)) * 8]; }
    g.sc = GSC[(size_t)((t0 >> 1) + (tid & 15)) * 8];
}
__device__ __forceinline__ void st8(LAS float* d, const u32x4 w) { float f[8]; unpack8(w, f); *(LAS f32x4*)d = (f32x4){f[0], f[1], f[2], f[3]}; *(LAS f32x4*)(d + 4) = (f32x4){f[4], f[5], f[6], f[7]}; }
__device__ __forceinline__ void gdn_gstore(const GStage& g, LAS float* buf, int tid) {
    st8(buf + 8 * tid, g.k); st8(buf + CH * 128 + 8 * tid, g.q);
    if (tid < 128) st8(buf + 2 * CH * 128 + 8 * tid, g.v);
    else if (tid >= 256 && tid < 320) { const int i = tid - 256, st = i & 31, wh = i >> 5; buf[2 * CH * 128 + CH * 32 + (st >> 1) * 4 + (st & 1) * 2 + wh] = g.e; }
    else if (tid >= 320 && tid < 336) *(LAS f32x4*)(buf + 2 * CH * 128 + CH * 32 + 2 * CH + 4 * (tid - 320)) = g.sc;
}
__device__ __forceinline__ void gdn_block(const Ctx& F, int vb) {
    const int bh = vb >> 2, qt = vb & 3, b = bh >> 3, h = bh & 7, colL = F.wave * 4 + (F.lane >> 4), rg = F.lane & 15;
    const size_t base = (size_t)b * SEQ;
    const bf16* GK = (const bf16*)(F.ws + WS_GK) + base * 1024 + h * 128; const bf16* GQ = (const bf16*)(F.ws + WS_GQ) + base * 1024 + h * 128;
    const bf16* GV = (const bf16*)(F.ws + WS_GV) + base * 1024 + h * 128 + qt * 32;
    const float* GEG = (const float*)(F.ws + WS_GEG) + base * 8 + h; const float* GBE = (const float*)(F.ws + WS_GBE) + base * 8 + h;
    const f32x4* GSC = (const f32x4*)(F.ws + WS_GSC) + (base >> 1) * 8 + h;
    float* GO = (float*)(F.ws + WS_GO) + base * 1024 + h * 128 + qt * 32;
    LAS float* lb = (LAS float*)F.lds; LAS float* obase = lb + 2 * G_BUF;
    f32x2 S[4] = {{0.f, 0.f}, {0.f, 0.f}, {0.f, 0.f}, {0.f, 0.f}};
    const bool wr = rg == 0;
    GStage g;
    gdn_gload(g, GK, GQ, GV, GEG, GBE, GSC, 0, F.tid); gdn_gstore(g, lb, F.tid);
    __syncthreads();
    for (int c = 0; c < SEQ / CH; ++c) {
        const LAS float* buf = lb + (c & 1) * G_BUF; LAS float* ob = obase + (c & 1) * (CH * 32) + colL;
        if (c + 1 < SEQ / CH) gdn_gload(g, GK, GQ, GV, GEG, GBE, GSC, (c + 1) * CH, F.tid);
        GPair P0, P1;
        gdn_lds(P0, buf, 0, rg, colL);
#pragma unroll
        for (int pr = 0; pr < CH / 2; pr += 2) {
            gdn_lds(P1, buf, pr + 1, rg, colL); gdn_pair(P0, S, ob + 2 * pr * 32, wr);
            gdn_lds(P0, buf, (pr + 2) & (CH / 2 - 1), rg, colL); gdn_pair(P1, S, ob + (2 * pr + 2) * 32, wr);
        }
        if (c + 1 < SEQ / CH) gdn_gstore(g, lb + ((c + 1) & 1) * G_BUF, F.tid);
        __syncthreads();
        if (F.tid < 256) *(f32x4*)(GO + (size_t)(c * CH + (F.tid >> 3)) * 1024 + 4 * (F.tid & 7)) = *(const LAS f32x4*)(obase + (c & 1) * (CH * 32) + 4 * F.tid);
    }
}

struct RStep { f32x4 w, n, a, k, r; float v; };
constexpr int R_BUF = CH * (5 * 64 + 32);
__device__ __forceinline__ void rwkv_lds(RStep& s, const LAS float* buf, int st, int cq, int rowL) {
    s.w = *(const LAS f32x4*)(buf + st * 64 + 4 * cq); s.n = *(const LAS f32x4*)(buf + CH * 64 + st * 64 + 4 * cq); s.a = *(const LAS f32x4*)(buf + 2 * CH * 64 + st * 64 + 4 * cq);
    s.k = *(const LAS f32x4*)(buf + 3 * CH * 64 + st * 64 + 4 * cq); s.r = *(const LAS f32x4*)(buf + 4 * CH * 64 + st * 64 + 4 * cq); s.v = buf[5 * CH * 64 + st * 32 + rowL];
}
__device__ __forceinline__ void rwkv_step(const RStep& s, f32x4& S, LAS float* ob, bool wr) {
    float sa = (S.x * s.n.x + S.y * s.n.y) + (S.z * s.n.z + S.w * s.n.w);
    sa = allred16(sa);
    S = S * s.w + sa * s.a + s.v * s.k;
    float y = (S.x * s.r.x + S.y * s.r.y) + (S.z * s.r.z + S.w * s.r.w);
    y = allred16(y);
    if (wr) *ob = y;
}
struct RStage { f32x4 x[2]; u32x4 y[3], v; };
__device__ __forceinline__ void rwkv_gload(RStage& g, const float* RW, const float* RN, const bf16* RA, const bf16* RKp, const bf16* RRp, const bf16* RV, int t0, int tid) {
    { const int st = tid >> 4, f4 = tid & 15; g.x[0] = *(const f32x4*)(RW + (size_t)(t0 + st) * 1024 + 4 * f4); g.x[1] = *(const f32x4*)(RN + (size_t)(t0 + st) * 1024 + 4 * f4); }
    { const int i = tid & 255; const size_t o = (size_t)(t0 + (i >> 3)) * 1024 + 8 * (i & 7); g.y[0] = *(const u32x4*)(RA + o); g.y[1] = *(const u32x4*)(RKp + o); g.y[2] = *(const u32x4*)(RRp + o); }
    { const int i = tid & 127; g.v = *(const u32x4*)(RV + (size_t)(t0 + (i >> 2)) * 1024 + 8 * (i & 3)); }
}
__device__ __forceinline__ void rwkv_gstore(const RStage& g, LAS float* buf, int tid) {
    *(LAS f32x4*)(buf + 4 * tid) = g.x[0]; *(LAS f32x4*)(buf + CH * 64 + 4 * tid) = g.x[1];
    if (tid < 256) { st8(buf + 2 * CH * 64 + 8 * tid, g.y[0]); st8(buf + 3 * CH * 64 + 8 * tid, g.y[1]); st8(buf + 4 * CH * 64 + 8 * tid, g.y[2]); }
    else if (tid < 384) st8(buf + 5 * CH * 64 + 8 * (tid - 256), g.v);
}
__device__ __forceinline__ void rwkv_block(const Ctx& F, int vb) {
    const int bh = vb >> 1, hf = vb & 1, b = bh >> 4, h = bh & 15, rowL = F.wave * 4 + (F.lane >> 4), cq = F.lane & 15;
    const size_t base = (size_t)b * SEQ * 1024 + h * 64;
    const float* RW = (const float*)(F.ws + WS_RW) + base; const float* RN = (const float*)(F.ws + WS_RKK) + base;
    const bf16* RA = (const bf16*)(F.ws + WS_RKA) + base; const bf16* RKp = (const bf16*)(F.ws + WS_RK) + base; const bf16* RRp = (const bf16*)(F.ws + WS_RR) + base;
    const bf16* RV = (const bf16*)(F.ws + WS_RV) + base + hf * 32;
    float* RY = (float*)(F.ws + WS_RY) + base + hf * 32;
    LAS float* lb = (LAS float*)F.lds; LAS float* obase = lb + 2 * R_BUF;
    f32x4 S = {0.f, 0.f, 0.f, 0.f};
    const bool wr = cq == 0;
    RStage g;
    rwkv_gload(g, RW, RN, RA, RKp, RRp, RV, 0, F.tid); rwkv_gstore(g, lb, F.tid);
    __syncthreads();
    for (int c = 0; c < SEQ / CH; ++c) {
        const LAS float* buf = lb + (c & 1) * R_BUF; LAS float* ob = obase + (c & 1) * (CH * 32) + rowL;
        if (c + 1 < SEQ / CH) rwkv_gload(g, RW, RN, RA, RKp, RRp, RV, (c + 1) * CH, F.tid);
        RStep R0, R1, R2, R3;
        rwkv_lds(R0, buf, 0, cq, rowL); rwkv_lds(R1, buf, 1, cq, rowL);
#pragma unroll
        for (int s = 0; s < CH; s += 4) {
            rwkv_lds(R2, buf, s + 2, cq, rowL); rwkv_step(R0, S, ob + s * 32, wr);
            rwkv_lds(R3, buf, s + 3, cq, rowL); rwkv_step(R1, S, ob + (s + 1) * 32, wr);
            rwkv_lds(R0, buf, (s + 4) & (CH - 1), cq, rowL); rwkv_step(R2, S, ob + (s + 2) * 32, wr);
            rwkv_lds(R1, buf, (s + 5) & (CH - 1), cq, rowL); rwkv_step(R3, S, ob + (s + 3) * 32, wr);
        }
        if (c + 1 < SEQ / CH) rwkv_gstore(g, lb + ((c + 1) & 1) * R_BUF, F.tid);
        __syncthreads();
        if (F.tid < 256) *(f32x4*)(RY + (size_t)(c * CH + (F.tid >> 3)) * 1024 + 4 * (F.tid & 7)) = *(const LAS f32x4*)(obase + (c & 1) * (CH * 32) + 4 * F.tid);
    }
}

constexpr int S5_SROW = 136;
constexpr int S5_BROW = 20;
constexpr int S5_WAVE_B = 16 * S5_SROW * 2 + 1024 + 128 * S5_BROW * 4;
__device__ __forceinline__ void s5_block(const Ctx& F, const Args& a, int l, int it) {
    const int b = it >> 6, g = it & 63, p = F.lane, tl = F.lane >> 4, c = F.lane & 15, w = F.wave;
    const bf16* PROJ = (const bf16*)(F.ws + WS_PROJ); bf16* SY = (bf16*)(F.ws + WS_SY);
    LAS float* se = (LAS float*)F.lds;
    LAS unsigned char* wb = F.lds + 4096 + w * S5_WAVE_B;
    LAS bf16* sbuf = (LAS bf16*)wb; LAS float* uall = (LAS float*)(wb + 16 * S5_SROW * 2); LAS float* BU = uall + 256;
    const float dt = expf(a.in[19][l * 64 + g]);
    float abr, abi;
    {   const size_t gp = ((size_t)l * 64 + g) * 64 + p; const float are = a.in[17][gp], aim = a.in[18][gp]; const float mag = expf(are * dt); abr = mag * cosf(aim * dt); abi = mag * sinf(aim * dt); }
    bf16x8_t Bf[8];
    {   const int hl = tl >> 1, c0 = 8 * (tl & 1);
#pragma unroll
        for (int jj = 0; jj < 4; ++jj) {
            const size_t gp2 = ((size_t)l * 64 + g) * 64 + 16 * jj + c; const float are = a.in[17][gp2], aim = a.in[18][gp2];
            const float mag = expf(are * dt), ar = mag * cosf(aim * dt), ai = mag * sinf(aim * dt);
            const float den = are * are + aim * aim, cr = ((ar - 1.f) * are + ai * aim) / den, ci = (ai * are - (ar - 1.f) * aim) / den;
            const f32x4 r0 = *(const f32x4*)(a.in[20] + gp2 * 16 + c0), r1 = *(const f32x4*)(a.in[20] + gp2 * 16 + c0 + 4), i0 = *(const f32x4*)(a.in[21] + gp2 * 16 + c0), i1 = *(const f32x4*)(a.in[21] + gp2 * 16 + c0 + 4);
            const float br[8] = {r0.x, r0.y, r0.z, r0.w, r1.x, r1.y, r1.z, r1.w}, bi[8] = {i0.x, i0.y, i0.z, i0.w, i1.x, i1.y, i1.z, i1.w};
            float vr[8], vi[8];
#pragma unroll
            for (int e = 0; e < 8; ++e) { const float xr = cr * br[e] - ci * bi[e], xi = cr * bi[e] + ci * br[e];
                const float hr = bflo(pk2(xr, 0.f)), hi = bflo(pk2(xi, 0.f)); vr[e] = hl ? xr - hr : hr; vi[e] = hl ? xi - hi : hi; }
            Bf[jj] = __builtin_bit_cast(bf16x8_t, pack8(vr)); Bf[4 + jj] = __builtin_bit_cast(bf16x8_t, pack8(vi));
        }
    }
    bf16x8_t Cf[4];
    { const size_t cb = (((size_t)l * 64 + g) * 16 + c) * 64;
#pragma unroll
      for (int m = 0; m < 4; ++m) { const int k0 = 32 * m + 8 * tl; const float* src = (k0 < 64 ? a.in[22] + cb + k0 : a.in[23] + cb + (k0 - 64)); const float sg = k0 < 64 ? 1.f : -1.f;
          const f32x4 x0 = *(const f32x4*)src, x1 = *(const f32x4*)(src + 4);
          u32x4 pk; pk.x = pk2(sg * x0.x, sg * x0.y); pk.y = pk2(sg * x0.z, sg * x0.w); pk.z = pk2(sg * x1.x, sg * x1.y); pk.w = pk2(sg * x1.z, sg * x1.w);
          Cf[m] = __builtin_bit_cast(bf16x8_t, pk); } }
    const float dsk = a.in[24][l * 1024 + g * 16 + c];
    const int tw = 256 * w;
    const bf16* up = PROJ + ((size_t)b * SEQ + tw + c) * NINP + C_SU + g * 16 + 8 * (tl & 1);
    float sr = 0.f, si = 0.f;
#define S5_BU(UF) do { const bf16x8_t af_ = __builtin_bit_cast(bf16x8_t, UF); \
        _Pragma("unroll") for (int j = 0; j < 8; ++j) { const f32x4 z_ = {0.f, 0.f, 0.f, 0.f}; const f32x4 d_ = __builtin_amdgcn_mfma_f32_16x16x32_bf16(af_, Bf[j], z_, 0, 0, 0); \
            *(LAS f32x4*)(BU + (16 * j + c) * S5_BROW + 4 * tl) = d_; } asm volatile("" :: "v"(af_)); } while (0)
    {
        u32x4 ucur = *(const u32x4*)up;
        for (int t = 0; t < 256; t += 16) {
            const u32x4 unxt = *(const u32x4*)(up + (size_t)((t + 16 < 256) ? t + 16 : t) * NINP);
            S5_BU(ucur);
            WFENCE();
            float br_[16], bi_[16];
#pragma unroll
            for (int q = 0; q < 4; ++q) { const f32x4 x = *(const LAS f32x4*)(BU + p * S5_BROW + 4 * q), y = *(const LAS f32x4*)(BU + (64 + p) * S5_BROW + 4 * q);
                br_[4 * q] = x.x; br_[4 * q + 1] = x.y; br_[4 * q + 2] = x.z; br_[4 * q + 3] = x.w; bi_[4 * q] = y.x; bi_[4 * q + 1] = y.y; bi_[4 * q + 2] = y.z; bi_[4 * q + 3] = y.w; }
#pragma unroll
            for (int s = 0; s < 16; ++s) { const float nr = abr * sr - abi * si + br_[s], ni = abr * si + abi * sr + bi_[s]; sr = nr; si = ni; }
            WFENCE();
            ucur = unxt;
        }
    }
    se[w * 128 + p] = sr; se[w * 128 + 64 + p] = si;
    __syncthreads();
    {
        float pr = abr, pi = abi;
#pragma unroll
        for (int i = 0; i < 8; ++i) { const float nr = pr * pr - pi * pi, ni = 2.f * pr * pi; pr = nr; pi = ni; }
        sr = 0.f; si = 0.f;
        for (int j = 0; j < w; ++j) { const float er = se[j * 128 + p], ei = se[j * 128 + 64 + p]; const float nr = pr * sr - pi * si + er, ni = pr * si + pi * sr + ei; sr = nr; si = ni; }
    }
    {
        u32x4 ucur = *(const u32x4*)up;
        for (int t = 0; t < 256; t += 16) {
            const u32x4 unxt = *(const u32x4*)(up + (size_t)((t + 16 < 256) ? t + 16 : t) * NINP);
            S5_BU(ucur);
            if (tl < 2) { float uf[8]; unpack8(ucur, uf); *(LAS f32x4*)(uall + c * 16 + 8 * tl) = (f32x4){uf[0], uf[1], uf[2], uf[3]}; *(LAS f32x4*)(uall + c * 16 + 8 * tl + 4) = (f32x4){uf[4], uf[5], uf[6], uf[7]}; }
            WFENCE();
            float br_[16], bi_[16];
#pragma unroll
            for (int q = 0; q < 4; ++q) { const f32x4 x = *(const LAS f32x4*)(BU + p * S5_BROW + 4 * q), y = *(const LAS f32x4*)(BU + (64 + p) * S5_BROW + 4 * q);
                br_[4 * q] = x.x; br_[4 * q + 1] = x.y; br_[4 * q + 2] = x.z; br_[4 * q + 3] = x.w; bi_[4 * q] = y.x; bi_[4 * q + 1] = y.y; bi_[4 * q + 2] = y.z; bi_[4 * q + 3] = y.w; }
#pragma unroll
            for (int s = 0; s < 16; ++s) { const float nr = abr * sr - abi * si + br_[s], ni = abr * si + abi * sr + bi_[s]; sr = nr; si = ni;
                const unsigned pk = pk2(sr, si); sbuf[s * S5_SROW + p] = (bf16)(pk & 0xffffu); sbuf[s * S5_SROW + 64 + p] = (bf16)(pk >> 16); }
            WFENCE();
            f32x4 acc = {0.f, 0.f, 0.f, 0.f};
#pragma unroll
            for (int m = 0; m < 4; ++m) { const bf16x8_t af = *(const LAS bf16x8_t*)(sbuf + c * S5_SROW + 32 * m + 8 * tl);
                acc = __builtin_amdgcn_mfma_f32_16x16x32_bf16(af, Cf[m], acc, 0, 0, 0); asm volatile("" :: "v"(af)); }
#pragma unroll
            for (int r = 0; r < 4; ++r) { const int st = 4 * tl + r; const float y = acc[r] + dsk * uall[st * 16 + c];
                SY[((size_t)b * SEQ + tw + t + st) * 1024 + g * 16 + c] = (bf16)(pk2(gelu_tanh(y), 0.f) & 0xffffu); }
            WFENCE();
            ucur = unxt;
        }
    }
#undef S5_BU
    __syncthreads();
}

__device__ __forceinline__ void scan_phase(const Ctx& F, const Args& a, int l) {
    for (int r5 = 0; r5 < 1 + ((REPM >> 9) & 1); ++r5) for (int vb = F.vcu; vb < 256; vb += F.G) s5_block(F, a, l, vb);
    for (int rg_ = 0; rg_ < 1 + ((REPM >> 10) & 1); ++rg_) for (int vb = F.vcu; vb < 256; vb += F.G) {
        if (vb < 128) { gdn_block(F, vb); if (REPM & 2048) gdn_block(F, vb); }
        else { rwkv_block(F, vb - 128); if (REPM & 4096) rwkv_block(F, vb - 128); }
    }
}

__device__ __forceinline__ void post_phase(const Ctx& F, const Args& a, int l, int gw, int ngw) {
    const bf16* PROJ = (const bf16*)(F.ws + WS_PROJ); bf16* OBR = (bf16*)(F.ws + WS_OBR);
    const float* GO = (const float*)(F.ws + WS_GO); const float* RY = (const float*)(F.ws + WS_RY); const float* RV = (const float*)(F.ws + WS_RV); const float* RBON = (const float*)(F.ws + WS_RBON);
    const int c0 = 16 * F.lane;
    float nw[16], lw[16], lb[16];
#pragma unroll
    for (int e = 0; e < 16; ++e) { nw[e] = a.in[6][l * 128 + (c0 & 127) + e]; lw[e] = a.in[15][l * 1024 + c0 + e]; lb[e] = a.in[16][l * 1024 + c0 + e]; }
    for (int tok = gw; tok < TOK; tok += ngw) {
        { float o[16];
#pragma unroll
          for (int q = 0; q < 4; ++q) { const f32x4 v = *(const f32x4*)(GO + (size_t)tok * 1024 + c0 + 4 * q); o[4 * q] = v.x; o[4 * q + 1] = v.y; o[4 * q + 2] = v.z; o[4 * q + 3] = v.w; }
          float ss = 0.f;
#pragma unroll
          for (int e = 0; e < 16; ++e) ss += o[e] * o[e];
          ss = allred8(ss);
          const float rs = rsqrtf(ss * (1.f / 128.f) + 1e-6f);
          float z[16]; { float z0[8], z1[8]; unpack8(*(const u32x4*)(PROJ + (size_t)tok * NINP + C_GZ + c0), z0); unpack8(*(const u32x4*)(PROJ + (size_t)tok * NINP + C_GZ + c0 + 8), z1);
#pragma unroll
              for (int e = 0; e < 8; ++e) { z[e] = z0[e]; z[8 + e] = z1[e]; } }
          float r0[8], r1[8];
#pragma unroll
          for (int e = 0; e < 8; ++e) { r0[e] = o[e] * rs * nw[e] * siluf_(z[e]); r1[e] = o[8 + e] * rs * nw[8 + e] * siluf_(z[8 + e]); }
          *(u32x4*)(OBR + (size_t)tok * 1024 + c0) = pack8(r0); *(u32x4*)(OBR + (size_t)tok * 1024 + c0 + 8) = pack8(r1); }
        { float y[16], v[16];
#pragma unroll
          for (int q = 0; q < 4; ++q) { const f32x4 t = *(const f32x4*)(RY + (size_t)tok * 1024 + c0 + 4 * q); y[4 * q] = t.x; y[4 * q + 1] = t.y; y[4 * q + 2] = t.z; y[4 * q + 3] = t.w;
          }
          { float va[8], vb[8]; unpack8(*(const u32x4*)((const bf16*)RV + (size_t)tok * 1024 + c0), va); unpack8(*(const u32x4*)((const bf16*)RV + (size_t)tok * 1024 + c0 + 8), vb);
#pragma unroll
              for (int e = 0; e < 8; ++e) { v[e] = va[e]; v[8 + e] = vb[e]; } }
          float s = 0.f;
#pragma unroll
          for (int e = 0; e < 16; ++e) s += y[e];
          s += dppf<0xB1>(s); s += dppf<0x4E>(s);
          const float mean = s * (1.f / 64.f); float q2 = 0.f;
#pragma unroll
          for (int e = 0; e < 16; ++e) { const float d = y[e] - mean; q2 += d * d; }
          q2 += dppf<0xB1>(q2); q2 += dppf<0x4E>(q2);
          const float rs = rsqrtf(q2 * (1.f / 64.f) + 64e-5f);
          const float bon = RBON[(size_t)tok * 16 + (c0 >> 6)];
          float z[16]; { float z0[8], z1[8]; unpack8(*(const u32x4*)(PROJ + (size_t)tok * NINP + C_RZ + c0), z0); unpack8(*(const u32x4*)(PROJ + (size_t)tok * NINP + C_RZ + c0 + 8), z1);
#pragma unroll
              for (int e = 0; e < 8; ++e) { z[e] = z0[e]; z[8 + e] = z1[e]; } }
          float r0[8], r1[8];
#pragma unroll
          for (int e = 0; e < 8; ++e) { r0[e] = ((y[e] - mean) * rs * lw[e] + lb[e] + bon * v[e]) * siluf_(z[e]); r1[e] = ((y[8 + e] - mean) * rs * lw[8 + e] + lb[8 + e] + bon * v[8 + e]) * siluf_(z[8 + e]); }
          bf16* ob = OBR + (size_t)TOK * 1024 + (size_t)tok * 1024 + c0;
          *(u32x4*)ob = pack8(r0); *(u32x4*)(ob + 8) = pack8(r1); }
    }
}

#ifndef PHM
#define PHM 0xFFFF
#endif
#ifndef REPM
#define REPM 0
#endif
__global__ void __launch_bounds__(NTHREADS, 2) hybrid_fwd(Args a) {
    extern __shared__ __attribute__((aligned(16))) unsigned char lds_raw[];
    Ctx F;
    F.lds = (LAS unsigned char*)lds_raw; F.ws = a.ws;
    F.G = gridDim.x; { const int bx = blockIdx.x; F.vcu = (F.G % 8 == 0) ? (bx % 8) * (F.G / 8) + bx / 8 : bx; }
    F.NGW = F.G * NWAVES;
    cg::grid_group grid = cg::this_grid();
    if (threadIdx.x < 8) ((volatile LAS unsigned*)(F.lds + MISC_OFF))[threadIdx.x] = 0u;
    __syncthreads();
    grid.sync();
    XcdBarrier bar = xcd_barrier_post((unsigned*)(a.ws + WS_CTL), (volatile LAS unsigned*)(F.lds + MISC_OFF));
    bf16* XN = (bf16*)(a.ws + WS_XN); bf16* PROJ = (bf16*)(a.ws + WS_PROJ);
    int rep = 0;
    for (int ph = a.ph_lo; ph < a.ph_hi; ) {
        { int t_ = threadIdx.x; asm volatile("" : "+v"(t_)); F.tid = t_; F.lane = t_ & 63; F.wave = __builtin_amdgcn_readfirstlane(t_ >> 6); F.gw = F.vcu * NWAVES + F.wave; }
        if (ph == NPHASES - 1) { for (int m = F.gw; m < TOK; m += F.NGW) rms_row(a.out + (size_t)m * DM, a.in[30], nullptr, nullptr, a.out + (size_t)m * DM, F.lane); }
        else if (ph == 0) { if (PHM & 1) phase0(F, a);
            if (REPM & 128) { if (!rep) { rep = 1; __syncthreads(); continue; } rep = 0; } }
        else {
            const int l = (ph - 1) / PH_PER_LAYER, k = (ph - 1) % PH_PER_LAYER;
            if (k == 0 && (PHM & 2)) {
                pg8::Gemm g{XN, (const bf16*)(a.ws + WS_WIN) + (size_t)l * NINP * DM, TOK, NINP, DM}; pg8::StaticOrder S; S.init(TOK, NINP, F.G, (int)blockIdx.x);
                pg8::EpiBf16Rs E{PROJ, NINP, (const unsigned long long*)(a.ws + WS_CTL + CTL_SS) + (size_t)l * TOK};
                pg8::gemm_phase<pg8::EpiBf16Rs, pg8::StaticOrder, true, true>(F.lds, g, S, E);
                if (l + 1 < DEPTH) {
                    const int rem = ((TOK / 256) * (NINP / 256)) % F.G, bx = (int)blockIdx.x;
                    if (rem == 0) convert_layer(F, a, l + 1, F.gw, F.NGW);
                    else if (bx >= rem) convert_layer(F, a, l + 1, (bx - rem) * NWAVES + F.wave, (F.G - rem) * NWAVES);
                }
            } else if (k == 1) { prep_gdn(F, a, l); if (REPM & 8192) prep_gdn(F, a, l); prep_rwkv(F, a, l); if (REPM & 16384) prep_rwkv(F, a, l); }
            else if (k == 2) { if (PHM & 16) scan_phase(F, a, l); }
            else if (k == 3 && (PHM & 32)) {
                const bool split = F.G >= 192;
                if (!split) { post_phase(F, a, l, F.gw, F.NGW); __syncthreads(); }
                if (!split || (int)blockIdx.x < 128) {
                    pg8::Gemm g{(const bf16*)(a.ws + WS_SY), (const bf16*)(a.ws + WS_WGLU) + (size_t)l * 1024 * 1024, TOK, 1024, 1024}; pg8::StaticOrder S; S.init(TOK, 1024, F.G, (int)blockIdx.x);
                    pg8::EpiGlu E{(const bf16*)(a.ws + WS_SY), PROJ, a.in[26] + l * 1024, (bf16*)(a.ws + WS_OBR) + (size_t)2 * TOK * 1024};
                    pg8::gemm_phase<pg8::EpiGlu, pg8::StaticOrder, true, true>(F.lds, g, S, E);
                } else post_phase(F, a, l, ((int)blockIdx.x - 128) * NWAVES + F.wave, (F.G - 128) * NWAVES);
            } else if (k == 4 && (PHM & 64)) {
                pg8::Gemm g{(const bf16*)(a.ws + WS_OBR), (const bf16*)(a.ws + WS_WBR) + (size_t)l * 3 * DM * 1024, 3 * TOK, 3 * DM, 1024};
                pg8::BranchOrder S; S.base.init(TOK, DM, F.G, (int)blockIdx.x);
                pg8::EpiBranch E{PROJ, a.in[27] + (size_t)l * 3 * DM, (bf16*)(a.ws + WS_ACCF), (bf16*)(a.ws + WS_MRG)};
                pg8::gemm_phase<pg8::EpiBranch, pg8::BranchOrder, true, true>(F.lds, g, S, E);
            } else if (k == 5 && (PHM & 128)) {
                pg8::Gemm g{(const bf16*)(a.ws + WS_MRG), (const bf16*)(a.ws + WS_WOUT) + (size_t)l * DM * DM, TOK, DM, DM}; pg8::StaticOrder S; S.init(TOK, DM, F.G, (int)blockIdx.x);
                pg8::EpiResid E{l == 0 ? a.in[0] : a.out, a.out, l + 1 < DEPTH ? XN : nullptr, a.in[1] + (size_t)(l + 1 < DEPTH ? l + 1 : 0) * DM, (unsigned long long*)(a.ws + WS_CTL + CTL_SS) + (size_t)(l + 1 < DEPTH ? l + 1 : 0) * TOK};
                pg8::gemm_phase<pg8::EpiResid, pg8::StaticOrder, true, true>(F.lds, g, S, E);
            }
            if (REPM && !rep && ((REPM >> k) & 1)) { rep = 1; __syncthreads(); continue; }
            rep = 0;
        }
        if (ph + 1 < a.ph_hi) {
            xcd_barrier(bar);
            if (REPM & 256) xcd_barrier(bar);
        }
        ++ph;
    }
}

#ifndef MK_MULTI
#define MK_MULTI 0
#endif
extern "C" void kernel_launch(void* const* d_in, const int* in_sizes, int n_in, void* d_out, int out_size, void* d_ws, size_t ws_size, hipStream_t stream) {
    static int grid = 0;
    if (grid == 0) {
        if (n_in != 31 || out_size != TOK * DM || ws_size < WS_END) { fprintf(stderr, "kernel_launch: unexpected shapes (n_in %d out %d ws %zu)\n", n_in, out_size, ws_size); grid = -1; return; }
        int dev = 0, cus = 0, per_cu = 0;
        hipGetDevice(&dev); hipDeviceGetAttribute(&cus, hipDeviceAttributeMultiprocessorCount, dev);
        if (hipFuncSetAttribute((const void*)hybrid_fwd, hipFuncAttributeMaxDynamicSharedMemorySize, LDS_BYTES) != hipSuccess) { fprintf(stderr, "kernel_launch: hipFuncSetAttribute failed\n"); grid = -1; return; }
        if (hipOccupancyMaxActiveBlocksPerMultiprocessor(&per_cu, (const void*)hybrid_fwd, NTHREADS, LDS_BYTES) != hipSuccess || per_cu < 1) per_cu = 1;
        (void)hipGetLastError();
        grid = cus * per_cu;
        fprintf(stderr, "kernel_launch: grid %d (cus %d x %d)\n", grid, cus, per_cu);
    }
    if (grid < 0) return;
    if (hipMemsetAsync((char*)d_ws + WS_CTL, 0, CTL_ZERO_BYTES, stream) != hipSuccess) { fprintf(stderr, "kernel_launch: memset failed\n"); return; }
    Args a{};
    for (int i = 0; i < 31; ++i) a.in[i] = (const float*)d_in[i];
    a.out = (float*)d_out; a.ws = (unsigned char*)d_ws;
#if MK_MULTI
    for (int ph = 0; ph < NPHASES; ++ph) { a.ph_lo = ph; a.ph_hi = ph + 1; hipLaunchKernelGGL(hybrid_fwd, dim3(grid), dim3(NTHREADS), LDS_BYTES, stream, a); }
#else
    a.ph_lo = 0; a.ph_hi = NPHASES;
    void* args[] = {&a};
    const hipError_t e = hipLaunchCooperativeKernel((const void*)hybrid_fwd, dim3(grid), dim3(NTHREADS), args, LDS_BYTES, stream);
    if (e != hipSuccess) fprintf(stderr, "kernel_launch: cooperative launch failed: %s (grid %d)\n", hipGetErrorString(e), grid);
#endif
}
```
